# Optimizing an MI355X kernel written in HIP

```python
import math
import jax
import jax.numpy as jnp
from jax import lax
import numpy as np

D_MODEL = 1024
BATCH = 4
SEQ = 4096
DEPTH = 1

HG_HEADS = 8
HG_DK = 128
HG_DV = 128
HG_WIDTH = HG_HEADS * HG_DK
HG_VWIDTH = HG_HEADS * HG_DV
HG_CHUNK = 64
NSA_HEADS = 16
NSA_KV = 4
NSA_GROUP = NSA_HEADS // NSA_KV
NSA_DH = 64
NSA_WIDTH = NSA_HEADS * NSA_DH
NSA_KVW = NSA_KV * NSA_DH
CMP_LEN = 32
CMP_STRIDE = 16
CMP_HIDDEN = 256
SEL_BLOCK = 64
SEL_TOPK = 16
WINDOW = 512
Q_BLOCK = 64
ROPE_THETA = 500000.0
ROPE_DIM = NSA_DH // 4
D_FF = 4 * D_MODEL
PLE_DIM = 256
EPS = 1e-6
NEG = -1e30

IN_SIZES = [HG_WIDTH, HG_WIDTH, HG_VWIDTH, HG_VWIDTH,
            NSA_WIDTH, 6 * NSA_KVW, 3 * NSA_HEADS,
            D_MODEL, D_MODEL]
N_IN = int(sum(IN_SIZES))
SPLIT_POINTS = [int(v) for v in np.cumsum(IN_SIZES)[:-1]]

kernel_name = "hybrid_hgrn2_nsa_sandwich_block"


def rms_norm(x, w):
    xf = x.astype(jnp.float32)
    y = xf * lax.rsqrt(jnp.mean(xf * xf, axis=-1, keepdims=True) + EPS)
    return y.astype(x.dtype) * w


def masked_softmax(s, mask):
    s = jnp.where(mask, s.astype(jnp.float32), NEG)
    pr = jax.nn.softmax(s, axis=-1)
    return jnp.where(mask, pr, 0.0)


def rope_tables(T):
    half = ROPE_DIM // 2
    inv = jnp.asarray(ROPE_THETA ** (-np.arange(half) * 2.0 / ROPE_DIM), jnp.float32)
    ang = jnp.arange(T, dtype=jnp.float32)[:, None] * inv[None, :]
    return jnp.cos(ang), jnp.sin(ang)


def apply_partial_rope(x, cos, sin):
    half = ROPE_DIM // 2
    extra = x.ndim - 3
    shp = (cos.shape[0],) + (1,) * extra + (half,)
    c = cos.reshape(shp).astype(x.dtype)
    s = sin.reshape(shp).astype(x.dtype)
    x1 = x[..., :half]
    x2 = x[..., half:ROPE_DIM]
    rest = x[..., ROPE_DIM:]
    return jnp.concatenate([x1 * c - x2 * s, x2 * c + x1 * s, rest], axis=-1)


def hgrn2_mixer(q, f_pre, i_in, g, lb, gnorm_w):
    B, T, _ = q.shape
    n = T // HG_CHUNK
    f32 = jnp.float32
    qf = jax.nn.silu(q.astype(f32)) * (HG_DK ** -0.5)
    forget = lb + (1.0 - lb) * jax.nn.sigmoid(f_pre.astype(f32))
    k = 1.0 - forget
    logf = jnp.log(forget)

    def heads(t, d):
        return t.reshape(B, n, HG_CHUNK, HG_HEADS, d).transpose(1, 0, 3, 2, 4)

    qc, kc, lc = heads(qf, HG_DK), heads(k, HG_DK), heads(logf, HG_DK)
    vc = heads(i_in.astype(f32), HG_DV)
    causal = jnp.tril(jnp.ones((HG_CHUNK, HG_CHUNK), dtype=bool))

    def step(S, inp):
        qj, kj, vj, lj = inp
        b = jnp.cumsum(lj, axis=2)
        o_inter = jnp.einsum('bhtk,bhkv->bhtv', qj * jnp.exp(b), S)
        rel = b[:, :, :, None, :] - b[:, :, None, :, :]
        decay = jnp.exp(jnp.where(causal[:, :, None], rel, -jnp.inf))
        A = jnp.einsum('bhtk,bhsk,bhtsk->bhts', qj, kj, decay)
        o = o_inter + jnp.einsum('bhts,bhsv->bhtv', A, vj)
        b_last = b[:, :, -1:, :]
        S = jnp.exp(b_last[:, :, 0, :, None]) * S + jnp.einsum(
            'bhsk,bhsv->bhkv', kj * jnp.exp(b_last - b), vj)
        return S, o

    S0 = jnp.zeros((B, HG_HEADS, HG_DK, HG_DV), f32)
    _, o = lax.scan(step, S0, (qc, kc, vc, lc))
    o = o.transpose(1, 0, 3, 2, 4).reshape(B, T, HG_HEADS, HG_DV)
    gh = g.astype(f32).reshape(B, T, HG_HEADS, HG_DV)
    o = rms_norm(o, gnorm_w.astype(f32)) * jax.nn.silu(gh)
    return o.reshape(B, T, HG_VWIDTH).astype(q.dtype)


def nsa_mixer(q, kc, vc, ks, vs, kw, vw, gates, pe_k, pe_v, wk1, wk2, wv1, wv2):
    B, T, _ = q.shape
    G, R, Dh = NSA_KV, NSA_GROUP, NSA_DH
    scale = Dh ** -0.5
    cos, sin = rope_tables(T)
    q = q.reshape(B, T, G, R, Dh) * scale
    q_rot = apply_partial_rope(q, cos, sin)
    kvh = lambda t: t.reshape(B, T, G, Dh)
    ks = apply_partial_rope(kvh(ks), cos, sin)
    kw = apply_partial_rope(kvh(kw), cos, sin)

    n_cmp = (T - CMP_LEN) // CMP_STRIDE + 1
    blk_idx = np.arange(n_cmp)[:, None] * CMP_STRIDE + np.arange(CMP_LEN)[None, :]
    cmp_end = blk_idx[:, -1]

    def compress(t, pe, w1, w2):
        blocks = kvh(t)[:, blk_idx] + pe[:, None, :]
        flat = blocks.transpose(0, 1, 3, 2, 4).reshape(B, n_cmp, G, CMP_LEN * Dh)
        out = jax.nn.gelu(flat @ w1) @ w2
        return out.transpose(0, 2, 1, 3)

    k_cmp = compress(kc, pe_k, wk1, wk2)
    v_cmp = compress(vc, pe_v, wv1, wv2)

    n_sel = T // SEL_BLOCK
    top = min(SEL_TOPK, n_sel)
    sel_start = np.arange(n_sel) * SEL_BLOCK
    overlap = jnp.asarray(((blk_idx[:, :1] < sel_start[None, :] + SEL_BLOCK)
                           & (cmp_end[:, None] >= sel_start[None, :])).astype(np.float32))
    ks_blocks = ks.transpose(0, 2, 1, 3).reshape(B, G, n_sel, SEL_BLOCK * Dh)
    vs_blocks = kvh(vs).transpose(0, 2, 1, 3).reshape(B, G, n_sel, SEL_BLOCK * Dh)
    sel_ids = jnp.arange(n_sel)

    pad = ((0, 0), (0, 0), (WINDOW, 0), (0, 0))
    kw_pad = jnp.pad(kw.transpose(0, 2, 1, 3), pad)
    vw_pad = jnp.pad(kvh(vw).transpose(0, 2, 1, 3), pad)

    q_all = q.transpose(0, 2, 3, 1, 4)
    qr_all = q_rot.transpose(0, 2, 3, 1, 4)

    def block(c):
        s0 = c * Q_BLOCK
        t_pos = s0 + jnp.arange(Q_BLOCK)
        qb = lax.dynamic_slice_in_dim(q_all, s0, Q_BLOCK, axis=3)
        qr = lax.dynamic_slice_in_dim(qr_all, s0, Q_BLOCK, axis=3)
        s = jnp.einsum('bgrqd,bgnd->bgrqn', qb, k_cmp)
        p_cmp = masked_softmax(s, cmp_end[None, :] <= t_pos[:, None])
        o_cmp = jnp.einsum('bgrqn,bgnd->bgrqd', p_cmp, v_cmp)
        imp = jnp.einsum('bgrqn,ns->bgqs', p_cmp, overlap)
        cur = t_pos // SEL_BLOCK
        forced = ((sel_ids[None, :] == 0) | (sel_ids[None, :] == cur[:, None])
                  | (sel_ids[None, :] == cur[:, None] - 1))
        causal_blk = sel_ids[None, :] * SEL_BLOCK <= t_pos[:, None]
        imp = jnp.where(forced, jnp.inf, imp)
        imp = jnp.where(causal_blk, imp, -jnp.inf)
        _, idx = lax.top_k(imp, top)
        flat_idx = idx.reshape(B, G, Q_BLOCK * top, 1)
        kg = jnp.take_along_axis(ks_blocks, flat_idx, axis=2).reshape(
            B, G, Q_BLOCK, top * SEL_BLOCK, Dh)
        vg = jnp.take_along_axis(vs_blocks, flat_idx, axis=2).reshape(
            B, G, Q_BLOCK, top * SEL_BLOCK, Dh)
        key_pos = (idx[..., None] * SEL_BLOCK + jnp.arange(SEL_BLOCK)).reshape(
            B, G, Q_BLOCK, top * SEL_BLOCK)
        m_sel = (key_pos <= t_pos[None, None, :, None])[:, :, None]
        s = jnp.einsum('bgrqd,bgqkd->bgrqk', qr, kg)
        o_sel = jnp.einsum('bgrqk,bgqkd->bgrqd', masked_softmax(s, m_sel), vg)
        kwb = lax.dynamic_slice_in_dim(kw_pad, s0, WINDOW + Q_BLOCK, axis=2)
        vwb = lax.dynamic_slice_in_dim(vw_pad, s0, WINDOW + Q_BLOCK, axis=2)
        wpos = s0 - WINDOW + jnp.arange(WINDOW + Q_BLOCK)
        diff = t_pos[:, None] - wpos[None, :]
        m_win = (diff >= 0) & (diff < WINDOW) & (wpos[None, :] >= 0)
        s = jnp.einsum('bgrqd,bgkd->bgrqk', qr, kwb)
        o_win = jnp.einsum('bgrqk,bgkd->bgrqd', masked_softmax(s, m_win), vwb)
        return o_cmp, o_sel, o_win

    o_cmp, o_sel, o_win = lax.map(block, jnp.arange(T // Q_BLOCK))
    to_bthd = lambda o: o.transpose(1, 0, 4, 2, 3, 5).reshape(B, T, NSA_HEADS, Dh)
    gt = jax.nn.sigmoid(gates.astype(jnp.float32)).reshape(B, T, 3, NSA_HEADS, 1)
    out = (gt[:, :, 0] * to_bthd(o_cmp) + gt[:, :, 1] * to_bthd(o_sel)
           + gt[:, :, 2] * to_bthd(o_win))
    return out.reshape(B, T, NSA_WIDTH).astype(q.dtype)


def setup_inputs(seed: int = 0) -> dict:
    key = jax.random.key(seed)
    k = jax.random.split(key, 24)
    f32 = jnp.float32
    nrm = lambda kk, shape, sc: jax.random.normal(kk, shape, f32) * sc
    gain = lambda kk, n: 1.0 + 0.05 * jax.random.normal(kk, (DEPTH, n), f32)
    return {
        "x": nrm(k[0], (BATCH, SEQ, D_MODEL), 1.0),
        "p": nrm(k[1], (DEPTH, BATCH, SEQ, PLE_DIM), 1.0),
        "w_in": nrm(k[2], (DEPTH, D_MODEL, N_IN), D_MODEL ** -0.5),
        "w_branch_a": nrm(k[3], (DEPTH, HG_VWIDTH, D_MODEL), HG_VWIDTH ** -0.5),
        "w_branch_b": nrm(k[4], (DEPTH, NSA_WIDTH, D_MODEL), NSA_WIDTH ** -0.5),
        "w_out": nrm(k[5], (DEPTH, D_MODEL, D_MODEL), D_MODEL ** -0.5),
        "norm_pre_mix": gain(k[6], D_MODEL),
        "norm_post_mix": gain(k[7], D_MODEL),
        "norm_pre_mlp": gain(k[8], D_MODEL),
        "norm_post_mlp": gain(k[9], D_MODEL),
        "hg_lb_logits": nrm(k[10], (DEPTH + 1, HG_WIDTH), 0.5),
        "hg_gnorm": gain(k[11], HG_DV),
        "cmp_pe_k": nrm(k[12], (DEPTH, CMP_LEN, NSA_DH), 0.1),
        "cmp_pe_v": nrm(k[13], (DEPTH, CMP_LEN, NSA_DH), 0.1),
        "cmp_wk1": nrm(k[14], (DEPTH, CMP_LEN * NSA_DH, CMP_HIDDEN), (CMP_LEN * NSA_DH) ** -0.5),
        "cmp_wk2": nrm(k[15], (DEPTH, CMP_HIDDEN, NSA_DH), CMP_HIDDEN ** -0.5),
        "cmp_wv1": nrm(k[16], (DEPTH, CMP_LEN * NSA_DH, CMP_HIDDEN), (CMP_LEN * NSA_DH) ** -0.5),
        "cmp_wv2": nrm(k[17], (DEPTH, CMP_HIDDEN, NSA_DH), CMP_HIDDEN ** -0.5),
        "w_up": nrm(k[18], (DEPTH, D_MODEL, D_FF), D_MODEL ** -0.5),
        "w_down": nrm(k[19], (DEPTH, D_FF, D_MODEL), D_FF ** -0.5),
        "w_ple": nrm(k[20], (DEPTH, PLE_DIM, D_MODEL), PLE_DIM ** -0.5),
        "w_ple_gate": nrm(k[21], (DEPTH, D_MODEL, D_MODEL), D_MODEL ** -0.5),
        "norm_ple": gain(k[22], D_MODEL),
    }


def reference(x, p, w_in, w_branch_a, w_branch_b, w_out, norm_pre_mix, norm_post_mix,
              norm_pre_mlp, norm_post_mlp, hg_lb_logits, hg_gnorm, cmp_pe_k, cmp_pe_v,
              cmp_wk1, cmp_wk2, cmp_wv1, cmp_wv2, w_up, w_down, w_ple, w_ple_gate,
              norm_ple):
    lower_bounds = jnp.cumsum(jax.nn.softmax(hg_lb_logits.astype(jnp.float32), axis=0), axis=0)
    h = x
    for i in range(DEPTH):
        u = rms_norm(h, norm_pre_mix[i])
        proj = u @ w_in[i]
        hq, hf, hi, hg, nq, nkv, ngate, ga, gb = jnp.split(proj, SPLIT_POINTS, axis=-1)
        kc, vc, ks, vs, kw, vw = jnp.split(nkv, 6, axis=-1)
        y_a = hgrn2_mixer(hq, hf, hi, hg, lower_bounds[i], hg_gnorm[i])
        y_b = nsa_mixer(nq, kc, vc, ks, vs, kw, vw, ngate, cmp_pe_k[i], cmp_pe_v[i],
                        cmp_wk1[i], cmp_wk2[i], cmp_wv1[i], cmp_wv2[i])
        merged = (jax.nn.sigmoid(ga) * (y_a @ w_branch_a[i])
                  + jax.nn.sigmoid(gb) * (y_b @ w_branch_b[i]))
        h = h + rms_norm(merged @ w_out[i], norm_post_mix[i])
        v = rms_norm(h, norm_pre_mlp[i])
        ff = jnp.square(jax.nn.relu(v @ w_up[i])) @ w_down[i]
        h = h + rms_norm(ff, norm_post_mlp[i])
        e = (p[i] @ w_ple[i]) * jax.nn.sigmoid(h @ w_ple_gate[i])
        h = h + rms_norm(e, norm_ple[i])
    return h
```

```cpp
#include <hip/hip_runtime.h>
#include <hip/hip_cooperative_groups.h>
#include <cstdio>
#include <cstdint>
namespace cg = cooperative_groups;

#ifndef MEGA
#define MEGA 1
#endif
#ifndef PROBE_DUP
#define PROBE_DUP 0
#endif

typedef unsigned short u16;
typedef __attribute__((ext_vector_type(8))) short bf16x8;
typedef __attribute__((ext_vector_type(4))) float f32x4;
typedef __attribute__((ext_vector_type(4))) unsigned u32x4;
typedef __attribute__((ext_vector_type(2))) unsigned u32x2;

#define MFMA(a, b, c) __builtin_amdgcn_mfma_f32_16x16x32_bf16(a, b, c, 0, 0, 0)
#define MIB ((size_t)1 << 20)

#define OFF_U       (0 * MIB)
#define OFF_YB0     (0 * MIB)
#define OFF_WA_T    (16 * MIB)
#define OFF_WB_T    (18 * MIB)
#define OFF_WOUT_T  (20 * MIB)
#define OFF_WPG_T   (22 * MIB)
#define OFF_WPLE_T  (24 * MIB)
#define OFF_WIN_T   (32 * MIB)
#define OFF_WUP_T   (32 * MIB)
#define OFF_WDOWN_T (40 * MIB)
#define OFF_WK1T    (50 * MIB)
#define OFF_WV1T    (51 * MIB)
#define OFF_WK2T    (52 * MIB)
#define OFF_WV2T    (52 * MIB + 32768)
#define OFF_ROPE    (52 * MIB + 65536)
#define OFF_BIAS1   (52 * MIB + 65536 + 262144)
#define OFF_LB      (52 * MIB + 65536 + 262144 + 4096)
#define OFF_BIAS1P  (52 * MIB + 65536 + 262144 + 16384)
#define OFF_NGATE   (53 * MIB)
#define OFF_SG      (56 * MIB)
#define OFF_NQ      (88 * MIB)
#define OFF_QF      (120 * MIB)
#define OFF_LOGF    (136 * MIB)
#define OFF_YB1     (136 * MIB)
#define OFF_HVT     (152 * MIB)
#define OFF_ABUF    (168 * MIB)
#define OFF_UST     (176 * MIB)
#define OFF_KV      (208 * MIB)
#define OFF_NQR     (224 * MIB)
#define OFF_VST     (228 * MIB)
#define OFF_VWT     (232 * MIB)
#define OFF_DCY     (236 * MIB)
#define OFF_HIDK    (236 * MIB + 524288)
#define OFF_HIDV    (237 * MIB + 524288)
#define OFF_KCMP    (238 * MIB + 524288)
#define OFF_VCMPT   (238 * MIB + 524288 + 262144)
#define OFF_MERGED  (88 * MIB)
#define OFF_Z1      (152 * MIB)
#define OFF_V       (56 * MIB)
#define OFF_FFH     (120 * MIB)
#define OFF_Z2      (56 * MIB)
#define OFF_H2B     (120 * MIB)
#define OFF_PB      (152 * MIB)
#define OFF_Z3      (160 * MIB)

struct Params {
  const float *x, *p, *w_in, *w_a, *w_b, *w_out, *n_pre_mix, *n_post_mix, *n_pre_mlp, *n_post_mlp;
  const float *lb_logits, *gnorm, *pe_k, *pe_v, *wk1, *wk2, *wv1, *wv2, *w_up, *w_down, *w_ple, *w_pg, *n_ple;
  float* out;
  char* ws;
};

__device__ __forceinline__ int bid_() { int b = blockIdx.x; asm volatile("" : "+s"(b)); return b; }
__device__ __forceinline__ int tid_() { int t = threadIdx.x; asm volatile("" : "+v"(t)); return t; }
typedef __attribute__((ext_vector_type(2))) float f32x2_t;
typedef __attribute__((ext_vector_type(2))) __bf16 bf16x2_t;
__device__ __forceinline__ uint32_t pack2(float a, float b) {
  f32x2_t v = {a, b};
  return __builtin_bit_cast(uint32_t, __builtin_convertvector(v, bf16x2_t));
}
__device__ __forceinline__ u16 f2bf(float f) { return (u16)(pack2(f, f) & 0xffffu); }
__device__ __forceinline__ float bf2f(u16 h) { return __uint_as_float(((uint32_t)h) << 16); }
__device__ __forceinline__ float shx_f(float v, int src_lane) { return __int_as_float(__builtin_amdgcn_ds_bpermute(src_lane << 2, __float_as_int(v))); }
__device__ __forceinline__ uint32_t shx_u(uint32_t v, int src_lane) { return (uint32_t)__builtin_amdgcn_ds_bpermute(src_lane << 2, (int)v); }
#define SHX(v, m) shx_f((v), lane ^ (m))
#define SHXU(v, m) shx_u((v), lane ^ (m))
__device__ __forceinline__ float sigm(float x) { return __builtin_amdgcn_rcpf(1.f + __expf(-x)); }
__device__ __forceinline__ float siluf(float x) { return x * __builtin_amdgcn_rcpf(1.f + __expf(-x)); }
__device__ __forceinline__ float gelu_tanh(float x) {
  float u = 0.7978845608028654f * (x + 0.044715f * x * x * x);
  float t = 1.f - 2.f * __builtin_amdgcn_rcpf(__expf(2.f * u) + 1.f);
  return 0.5f * x * (1.f + t);
}
__device__ __forceinline__ bf16x8 mk8(uint32_t a, uint32_t b, uint32_t c, uint32_t d) {
  u32x4 v = {a, b, c, d};
  return __builtin_bit_cast(bf16x8, v);
}
__device__ __forceinline__ bf16x8 ld8(const u16* p) { return *(const bf16x8*)p; }

template <int AMODE, int DEEP>
__device__ __forceinline__ void gemm_tile(const u16* __restrict__ A, long lda, int m0, int M,
                                          const u16* __restrict__ Bt, long ldb, int n0, int N, int K,
                                          int coloff, f32x4 (&acc)[4][4], u16* sA, u16* sB) {
  const int tid = tid_(), lane = tid & 63, wave = tid >> 6;
  const int l15 = lane & 15, G = lane >> 4;
  const int wm = wave >> 1, wn = wave & 1;
  const int lr = tid >> 3, ch = tid & 7;
  const char* Ab = (const char*)A;
  const char* Bb = (const char*)Bt;
  unsigned oa[4], ob[4];
  int tok0[4];
#pragma unroll
  for (int i = 0; i < 4; ++i) {
    int r = m0 + lr + 32 * i;
    if (AMODE == 0) {
      if (r > M - 1) r = M - 1;
      oa[i] = (unsigned)(((long)r * lda + ch * 8) * 2);
      tok0[i] = 0;
    } else {
      int grp = r >> 8, n = r & 255;
      int bl = grp >> 2, g = grp & 3;
      tok0[i] = n * 16;
      oa[i] = (unsigned)((bl * 4096 * 1024 + coloff + g * 64 + ch * 8) * 2);
    }
    int rn = n0 + lr + 32 * i;
    if (rn > N - 1) rn = N - 1;
    ob[i] = (unsigned)(((long)rn * ldb + ch * 8) * 2);
  }
#define G_LOAD(RA, RB, KT)                                                                                   \
  {                                                                                                          \
    const char* Ak_ = Ab + (size_t)(KT) * 128;                                                               \
    const char* Bk_ = Bb + (size_t)(KT) * 128;                                                               \
    _Pragma("unroll") for (int i = 0; i < 4; ++i) {                                                          \
      if (AMODE == 0) RA[i] = *(const u32x4*)(Ak_ + oa[i]);                                                  \
      else { int tok = tok0[i] + (KT); if (tok > 4095) tok = 4095; RA[i] = *(const u32x4*)(Ab + (oa[i] + (unsigned)tok * 2048u)); } \
      RB[i] = *(const u32x4*)(Bk_ + ob[i]);                                                                  \
    }                                                                                                        \
  }
#define L_STORE(RA, RB)                                                                                      \
  _Pragma("unroll") for (int i = 0; i < 4; ++i) {                                                            \
    *(u32x4*)&sA[(lr + 32 * i) * 80 + ch * 8] = RA[i];                                                       \
    *(u32x4*)&sB[(lr + 32 * i) * 80 + ch * 8] = RB[i];                                                       \
  }
#define T_COMPUTE()                                                                                          \
  _Pragma("unroll") for (int ks = 0; ks < 2; ++ks) {                                                         \
    bf16x8 af[4], bfr[4];                                                                                    \
    _Pragma("unroll") for (int i = 0; i < 4; ++i) af[i] = ld8(&sA[(wm * 64 + 16 * i + l15) * 80 + ks * 32 + G * 8]);  \
    _Pragma("unroll") for (int j = 0; j < 4; ++j) bfr[j] = ld8(&sB[(wn * 64 + 16 * j + l15) * 80 + ks * 32 + G * 8]); \
    _Pragma("unroll") for (int i = 0; i < 4; ++i)                                                            \
      _Pragma("unroll") for (int j = 0; j < 4; ++j) acc[i][j] = MFMA(af[i], bfr[j], acc[i][j]);              \
  }                                                                                                          \
     \
  __builtin_amdgcn_sched_group_barrier(0x100, 8, 0);                                                         \
  _Pragma("unroll") for (int z = 0; z < 8; ++z) {                                                            \
    __builtin_amdgcn_sched_group_barrier(0x008, 2, 0);                                                       \
    __builtin_amdgcn_sched_group_barrier(0x100, 1, 0);                                                       \
  }                                                                                                          \
  __builtin_amdgcn_sched_group_barrier(0x008, 16, 0);
  const int nk = K >> 6;
  if (DEEP == 2) {
    u32x4 ra0[4], rb0[4], ra1[4], rb1[4];
    const int kl = nk - 1;
    G_LOAD(ra0, rb0, 0);
    G_LOAD(ra1, rb1, 1);
    for (int kt = 0; kt < nk; kt += 2) {
      L_STORE(ra0, rb0);
      __syncthreads();
      G_LOAD(ra0, rb0, (kt + 2 < kl ? kt + 2 : kl));
      T_COMPUTE();
      __syncthreads();
      L_STORE(ra1, rb1);
      __syncthreads();
      G_LOAD(ra1, rb1, (kt + 3 < kl ? kt + 3 : kl));
      T_COMPUTE();
      __syncthreads();
    }
  } else {
    u32x4 ra0[4], rb0[4];
    G_LOAD(ra0, rb0, 0);
    for (int kt = 0; kt < nk; ++kt) {
      L_STORE(ra0, rb0);
      __syncthreads();
      if (kt + 1 < nk) G_LOAD(ra0, rb0, kt + 1);
      T_COMPUTE();
      __syncthreads();
    }
  }
#undef G_LOAD
#undef L_STORE
#undef T_COMPUTE
}

__device__ __forceinline__ void zero_acc(f32x4 (&acc)[4][4]) {
#pragma unroll
  for (int i = 0; i < 4; ++i)
#pragma unroll
    for (int j = 0; j < 4; ++j) acc[i][j] = (f32x4){0.f, 0.f, 0.f, 0.f};
}

#define EPI_VARS                                                         \
  const int tid = tid_(), lane = tid & 63, wave = tid >> 6;         \
  const int l15 = lane & 15, G = lane >> 4;                              \
  const int wm = wave >> 1, wn = wave & 1;                               \
  (void)l15; (void)G; (void)wm; (void)wn;

__device__ __forceinline__ void transpose_tile(const float* __restrict__ W, int ldw, int oc0, int valid, int k0, u16* __restrict__ out,
                               long Kdim, int n0, float* s  ) {
  const int tid = tid_();
  __syncthreads();
  {
    const bool vec = (valid == 64) && (((oc0 | ldw) & 3) == 0);
    if (vec) {
      const int n4 = (tid & 15) * 4;
      float4 v[4];
#pragma unroll
      for (int i = 0; i < 4; ++i) v[i] = *(const float4*)(W + (long)(k0 + (tid >> 4) + 16 * i) * ldw + oc0 + n4);
#pragma unroll
      for (int i = 0; i < 4; ++i) {
        float* d = &s[((tid >> 4) + 16 * i) * 65 + n4];
        d[0] = v[i].x; d[1] = v[i].y; d[2] = v[i].z; d[3] = v[i].w;
      }
    } else {
      const int n = tid & 63;
      for (int kk = tid >> 6; kk < 64; kk += 4) {
        float v = 0.f;
        if (n < valid) v = W[(long)(k0 + kk) * ldw + oc0 + n];
        s[kk * 65 + n] = v;
      }
    }
  }
  __syncthreads();
  {
    const int nn = tid >> 2, kq = (tid & 3) * 16;
    uint32_t w[8];
#pragma unroll
    for (int e = 0; e < 8; ++e) w[e] = pack2(s[(kq + 2 * e) * 65 + nn], s[(kq + 2 * e + 1) * 65 + nn]);
    u16* dst = out + (long)(n0 + nn) * Kdim + k0 + kq;
    *(u32x4*)dst = (u32x4){w[0], w[1], w[2], w[3]};
    *(u32x4*)(dst + 8) = (u32x4){w[4], w[5], w[6], w[7]};
  }
}

__device__ __forceinline__ void transpose_job(const float* W, int N, int K, u16* out, int tile, float* s) {
  const int kt_n = K >> 6;
  const int nt = tile / kt_n, kt = tile % kt_n;
  transpose_tile(W, N, nt * 64, 64, kt * 64, out, K, nt * 64, s);
}

__device__ __forceinline__ void phase_prep(const Params& P, char* smem) {
  const int tid = tid_(), lane = tid & 63, wave = tid >> 6;
  char* ws = P.ws;
  float* sf = (float*)smem;
  {
    u16* U = (u16*)(ws + OFF_U);
    for (int un = bid_(); un < 2048; un += gridDim.x) {
      const int row0 = un * 8 + wave * 2;
      float4 v[2][4];
      float ss[2] = {0.f, 0.f};
#pragma unroll
      for (int rr = 0; rr < 2; ++rr)
#pragma unroll
        for (int j = 0; j < 4; ++j) v[rr][j] = *(const float4*)(P.x + (long)(row0 + rr) * 1024 + j * 256 + lane * 4);
#pragma unroll
      for (int rr = 0; rr < 2; ++rr) {
#pragma unroll
        for (int j = 0; j < 4; ++j)
          ss[rr] += v[rr][j].x * v[rr][j].x + v[rr][j].y * v[rr][j].y + v[rr][j].z * v[rr][j].z + v[rr][j].w * v[rr][j].w;
#pragma unroll
        for (int o = 32; o >= 1; o >>= 1) ss[rr] += SHX(ss[rr], o);
        const float r = rsqrtf(ss[rr] * (1.f / 1024.f) + 1e-6f);
#pragma unroll
        for (int j = 0; j < 4; ++j) {
          const float4 w = *(const float4*)(P.n_pre_mix + j * 256 + lane * 4);
          u32x2 o2 = {pack2(v[rr][j].x * r * w.x, v[rr][j].y * r * w.y), pack2(v[rr][j].z * r * w.z, v[rr][j].w * r * w.w)};
          *(u32x2*)(U + (long)(row0 + rr) * 1024 + j * 256 + lane * 4) = o2;
        }
      }
    }
  }
  {
    u16* WT = (u16*)(ws + OFF_WIN_T);
    for (int t = bid_(); t < 140 * 16; t += gridDim.x) {
      const int nt = t >> 4, kt = t & 15;
      const int nr0 = nt * 64;
      int oc0, valid;
      if (nr0 < 6656) { oc0 = nr0; valid = 64; }
      else if (nr0 < 8704) { oc0 = nr0 + 48; valid = 64; }
      else if (nr0 == 8704) { oc0 = 6656; valid = 48; }
      else { oc0 = 0; valid = 0; }
      transpose_tile(P.w_in, 8752, oc0, valid, kt * 64, WT, 1024, nr0, sf);
    }
    for (int t = bid_(); t < 128; t += gridDim.x) transpose_job(P.wk1, 256, 2048, (u16*)(ws + OFF_WK1T), t, sf);
    for (int t = bid_(); t < 128; t += gridDim.x) transpose_job(P.wv1, 256, 2048, (u16*)(ws + OFF_WV1T), t, sf);
    for (int t = bid_(); t < 4; t += gridDim.x) transpose_job(P.wk2, 64, 256, (u16*)(ws + OFF_WK2T), t, sf);
    for (int t = bid_(); t < 4; t += gridDim.x) transpose_job(P.wv2, 64, 256, (u16*)(ws + OFF_WV2T), t, sf);
  }
  {
    float2* RT = (float2*)(ws + OFF_ROPE);
    for (int un = bid_(); un < 128; un += gridDim.x) {
      const int idx = un * 256 + tid;
      const int t = idx >> 3, j = idx & 7;
      const float inv = (j == 0) ? 1.0f : (j == 1) ? 0.1939227432012558f : (j == 2) ? 0.03760603070259094f
                      : (j == 3) ? 0.007292664609849453f : (j == 4) ? 0.0014142135623842478f
                      : (j == 5) ? 0.00027424818836152554f : (j == 6) ? 5.3182957344688475e-05f : 1.0313385246263351e-05f;
      const float ang = (float)t * inv;
      const double ad = (double)ang;
      const double kq = rint(ad * 0.15915494309189535);
      const float rr = (float)(ad - kq * 6.283185307179586);
      float sn, cs;
      sincosf(rr, &sn, &cs);
      RT[idx] = make_float2(cs, sn);
    }
  }
  {
    float* B1P = (float*)(ws + OFF_BIAS1P);
    for (int un = bid_(); un < 16; un += gridDim.x) {
      const int kvi = un >> 3, part = un & 7;
      const float* pe = kvi ? P.pe_v : P.pe_k;
      const float* w1 = kvi ? P.wv1 : P.wk1;
      float4 a = make_float4(0.f, 0.f, 0.f, 0.f);
      const int k0 = part * 256 + wave * 64;
#pragma unroll 8
      for (int k = k0; k < k0 + 64; ++k) {
        const float pv = pe[k];
        const float4 w = *(const float4*)(w1 + (long)k * 256 + lane * 4);
        a.x += pv * w.x; a.y += pv * w.y; a.z += pv * w.z; a.w += pv * w.w;
      }
      __syncthreads();
      *(float4*)&sf[wave * 256 + lane * 4] = a;
      __syncthreads();
      B1P[un * 256 + tid] = sf[tid] + sf[256 + tid] + sf[512 + tid] + sf[768 + tid];
      __syncthreads();
    }
  }
  {
    float* LB = (float*)(ws + OFF_LB);
    for (int un = bid_(); un < 4; un += gridDim.x) {
      const int c = un * 256 + tid;
      const float l0 = P.lb_logits[c], l1 = P.lb_logits[1024 + c];
      LB[c] = 1.f / (1.f + expf(l1 - l0));
    }
  }
}

__device__ __forceinline__ void phase_late_weights(const Params& P, char* smem) {
  char* ws = P.ws;
  float* sf = (float*)smem;
  for (int t = bid_(); t < 256; t += gridDim.x) transpose_job(P.w_a, 1024, 1024, (u16*)(ws + OFF_WA_T), t, sf);
  for (int t = bid_(); t < 256; t += gridDim.x) transpose_job(P.w_b, 1024, 1024, (u16*)(ws + OFF_WB_T), t, sf);
  for (int t = bid_(); t < 256; t += gridDim.x) transpose_job(P.w_out, 1024, 1024, (u16*)(ws + OFF_WOUT_T), t, sf);
  for (int t = bid_(); t < 256; t += gridDim.x) transpose_job(P.w_pg, 1024, 1024, (u16*)(ws + OFF_WPG_T), t, sf);
  for (int t = bid_(); t < 1024; t += gridDim.x) transpose_job(P.w_up, 4096, 1024, (u16*)(ws + OFF_WUP_T), t, sf);
  for (int t = bid_(); t < 1024; t += gridDim.x) transpose_job(P.w_down, 1024, 4096, (u16*)(ws + OFF_WDOWN_T), t, sf);
  for (int t = bid_(); t < 64; t += gridDim.x) transpose_job(P.w_ple, 1024, 256, (u16*)(ws + OFF_WPLE_T), t, sf);
}

__device__ __forceinline__ void gemm_tile_wide(const u16* __restrict__ A, long lda, int m0, const u16* __restrict__ Bt, long ldb, int n0, int K,
                                               f32x4 (&acc)[4][8], u16* sA) {
  const int tid = tid_(), lane = tid & 63, wave = tid >> 6;
  const int l15 = lane & 15, G = lane >> 4;
  const int wm = wave >> 1, wn = wave & 1;
  const int lr = tid >> 3, ch = tid & 7;
  u16* sB = sA + 128 * 80;
  const char* Ab = (const char*)A;
  const char* Bb = (const char*)Bt;
  unsigned oa[4], ob[8];
#pragma unroll
  for (int i = 0; i < 4; ++i) oa[i] = (unsigned)(((long)(m0 + lr + 32 * i) * lda + ch * 8) * 2);
#pragma unroll
  for (int i = 0; i < 8; ++i) ob[i] = (unsigned)(((long)(n0 + lr + 32 * i) * ldb + ch * 8) * 2);
  u32x4 ra[4], rb[8];
#pragma unroll
  for (int i = 0; i < 4; ++i) ra[i] = *(const u32x4*)(Ab + oa[i]);
#pragma unroll
  for (int i = 0; i < 8; ++i) rb[i] = *(const u32x4*)(Bb + ob[i]);
  const int nk = K >> 6;
  for (int kt = 0; kt < nk; ++kt) {
#pragma unroll
    for (int i = 0; i < 4; ++i) *(u32x4*)&sA[(lr + 32 * i) * 80 + ch * 8] = ra[i];
#pragma unroll
    for (int i = 0; i < 8; ++i) *(u32x4*)&sB[(lr + 32 * i) * 80 + ch * 8] = rb[i];
    __syncthreads();
    {
      const int kn = (kt + 1 < nk) ? kt + 1 : kt;
      const char* Ak = Ab + (size_t)kn * 128;
      const char* Bk = Bb + (size_t)kn * 128;
#pragma unroll
      for (int i = 0; i < 4; ++i) ra[i] = *(const u32x4*)(Ak + oa[i]);
#pragma unroll
      for (int i = 0; i < 8; ++i) rb[i] = *(const u32x4*)(Bk + ob[i]);
    }
#pragma unroll
    for (int ks = 0; ks < 2; ++ks) {
      bf16x8 af[4];
#pragma unroll
      for (int i = 0; i < 4; ++i) af[i] = ld8(&sA[(wm * 64 + 16 * i + l15) * 80 + ks * 32 + G * 8]);
#pragma unroll
      for (int jh = 0; jh < 2; ++jh) {
        bf16x8 bfr[4];
#pragma unroll
        for (int j = 0; j < 4; ++j) bfr[j] = ld8(&sB[(wn * 128 + 64 * jh + 16 * j + l15) * 80 + ks * 32 + G * 8]);
#pragma unroll
        for (int i = 0; i < 4; ++i)
#pragma unroll
          for (int j = 0; j < 4; ++j) acc[i][4 * jh + j] = MFMA(af[i], bfr[j], acc[i][4 * jh + j]);
      }
    }
    __syncthreads();
  }
}


__device__ __forceinline__ void phase_inproj_wide(const Params& P, int half, char* smem) {
  char* ws = P.ws;
  u16* sA = (u16*)smem;
  const u16* U = (const u16*)(ws + OFF_U) + (long)half * 8192 * 1024;
  const u16* WT = (const u16*)(ws + OFF_WIN_T);
  u16* QF = (u16*)(ws + OFF_QF);
  _Float16* LOGF = (_Float16*)(ws + OFF_LOGF);
  u16* HVT = (u16*)(ws + OFF_HVT);
  u16* SG = (u16*)(ws + OFF_SG) + (long)half * 8192 * 1024;
  u16* NQ = (u16*)(ws + OFF_NQ) + (long)half * 8192 * 1024;
  u16* NQR = (u16*)(ws + OFF_NQR);
  u16* KV = (u16*)(ws + OFF_KV);
  u16* VST = (u16*)(ws + OFF_VST);
  u16* VWT = (u16*)(ws + OFF_VWT);
  u16* GATES = (u16*)P.out + (long)half * 8192 * 2048;
  float* NGATE = (float*)(ws + OFF_NGATE) + (long)half * 8192 * 48;
  const float2* RT = (const float2*)(ws + OFF_ROPE);
  const float* LB = (const float*)(ws + OFF_LB);
  for (int t = bid_(); t < 64 * 32; t += gridDim.x) {
    const int ntw = t >> 6, mt = t & 63;
    const int m0 = mt * 128, n0 = ntw * 256;
    const int nt = n0 >> 7;
    f32x4 acc[4][8];
#pragma unroll
    for (int i = 0; i < 4; ++i)
#pragma unroll
      for (int j = 0; j < 8; ++j) acc[i][j] = (f32x4){0.f, 0.f, 0.f, 0.f};
    gemm_tile_wide(U, 1024, m0, WT, 1024, n0, 1024, acc, sA);
    u16* sT = sA;
    u16* dbase = nullptr;
    int dstride = 1024, dcol = 0;
    bool staged = true;
    if (nt < 8) { dbase = QF; dcol = n0; }
    else if (nt < 16) { dbase = (u16*)LOGF; dcol = n0 - 1024; }
    else if (nt < 24) staged = false;
    else if (nt < 32) { dbase = SG; dcol = n0 - 3072; }
    else if (nt < 40) { dbase = NQ; dcol = n0 - 4096; }
    else if (nt < 52) {
      const int sub0 = (n0 - 5120) >> 8;
      if (sub0 == 3 || sub0 == 5) staged = false;
      else { dbase = KV; dcol = (sub0 == 0) ? 0 : (sub0 == 1) ? 256 : (sub0 == 2) ? 512 : 768; }
    } else if (nt < 68) { dbase = GATES; dstride = 2048; dcol = n0 - 6656; }
    else staged = false;
    EPI_VARS
#pragma unroll
    for (int i = 0; i < 4; ++i) {
      const int rbase = m0 + wm * 64 + 16 * i + G * 4;
#pragma unroll
      for (int j = 0; j < 8; ++j) {
        const int col = n0 + wn * 128 + 16 * j + l15;
        const f32x4 a = acc[i][j];
        if (nt < 8) {
#pragma unroll
          for (int e = 0; e < 4; ++e) sT[(wm * 64 + 16 * i + G * 4 + e) * 264 + wn * 128 + 16 * j + l15] = f2bf(siluf(a[e]) * 0.08838834764831845f);
        } else if (nt < 16) {
          const int c = col - 1024;
          const float lbv = LB[c];
#pragma unroll
          for (int e = 0; e < 4; ++e) {
            const float f = lbv + (1.f - lbv) * sigm(a[e]);
            sT[(wm * 64 + 16 * i + G * 4 + e) * 264 + wn * 128 + 16 * j + l15] = __builtin_bit_cast(u16, (_Float16)logf(f));
          }
        } else if (nt < 24) {
          const int c = col - 2048;
          const int h = c >> 7, dv = c & 127;
          const int bl = rbase >> 12, tt = rbase & 4095;
          const int cidx = tt >> 6, s = tt & 63;
          const unsigned uo = ((unsigned)(((bl * 8 + h) * 64 + cidx) * 128 + dv) * 64u + (unsigned)s) * 2u;
          u32x2 o2 = {pack2(a[0], a[1]), pack2(a[2], a[3])};
          *(u32x2*)((char*)HVT + uo) = o2;
        } else if (nt < 32) {
          const int c = col - 3072;
#pragma unroll
          for (int e = 0; e < 4; ++e) sT[(wm * 64 + 16 * i + G * 4 + e) * 264 + wn * 128 + 16 * j + l15] = f2bf(siluf(a[e]));
        } else if (nt < 40) {
          const int c = col - 4096;
#pragma unroll
          for (int e = 0; e < 4; ++e) {
            const float v = a[e] * 0.18033688011112042f;
            sT[(wm * 64 + 16 * i + G * 4 + e) * 264 + wn * 128 + 16 * j + l15] = f2bf(v);
            if ((j & 3) == 0) {
              const float pr = SHX(v, 8);
              const int tt = (rbase + e) & 4095;
              const float2 cs = RT[tt * 8 + (l15 & 7)];
              const float o = (l15 < 8) ? (v * cs.x - pr * cs.y) : (v * cs.x + pr * cs.y);
              NQR[(long)(rbase + e) * 256 + (c >> 6) * 16 + l15] = f2bf(o);
            }
          }
        } else if (nt < 52) {
          const int c = col - 5120;
          const int sub = c >> 8, cc = c & 255;
          if (sub == 0 || sub == 1) {
#pragma unroll
            for (int e = 0; e < 4; ++e) sT[(wm * 64 + 16 * i + G * 4 + e) * 264 + wn * 128 + 16 * j + l15] = f2bf(a[e]);
          } else if (sub == 2 || sub == 4) {
            const int dst = (sub == 2) ? 512 : 768;
#pragma unroll
            for (int e = 0; e < 4; ++e) {
              float v = a[e];
              if ((j & 3) == 0) {
                const float pr = SHX(v, 8);
                const int tt = (rbase + e) & 4095;
                const float2 cs = RT[tt * 8 + (l15 & 7)];
                v = (l15 < 8) ? (v * cs.x - pr * cs.y) : (v * cs.x + pr * cs.y);
              }
              sT[(wm * 64 + 16 * i + G * 4 + e) * 264 + wn * 128 + 16 * j + l15] = f2bf(v);
            }
          } else {
            u16* VT = (sub == 3) ? VST : VWT;
            const int g = cc >> 6, d = cc & 63;
            const int bl = rbase >> 12, tt = rbase & 4095;
            u32x2 o2 = {pack2(a[0], a[1]), pack2(a[2], a[3])};
            *(u32x2*)((char*)VT + ((unsigned)((bl * 4 + g) * 64 + d) * 4096u + (unsigned)tt) * 2u) = o2;
          }
        } else if (nt < 68) {
          const int c = col - 6656;
#pragma unroll
          for (int e = 0; e < 4; ++e) sT[(wm * 64 + 16 * i + G * 4 + e) * 264 + wn * 128 + 16 * j + l15] = f2bf(sigm(a[e]));
        } else {
          const int c = col - 8704;
          if (c < 48) {
#pragma unroll
            for (int e = 0; e < 4; ++e) NGATE[(long)(rbase + e) * 48 + c] = sigm(a[e]);
          }
        }
      }
    }
    if (staged) {
      __syncthreads();
      const int tc = tid_();
#pragma unroll
      for (int k16 = 0; k16 < 16; ++k16) {
        const int id = tc + 256 * k16;
        const int row = id >> 5, cch = (id & 31) * 8;
        *(u32x4*)(dbase + (long)(m0 + row) * dstride + dcol + cch) = *(const u32x4*)&sT[row * 264 + cch];
      }
      __syncthreads();
    }
  }
}


__device__ __forceinline__ void phase_inproj_narrow(const Params& P, int half, char* smem) {
  char* ws = P.ws;
  u16* sA = (u16*)smem;
  u16* sB = sA + 128 * 80;
  const u16* U = (const u16*)(ws + OFF_U) + (long)half * 8192 * 1024;
  const u16* WT = (const u16*)(ws + OFF_WIN_T);
  u16* QF = (u16*)(ws + OFF_QF);
  _Float16* LOGF = (_Float16*)(ws + OFF_LOGF);
  u16* HVT = (u16*)(ws + OFF_HVT);
  u16* SG = (u16*)(ws + OFF_SG) + (long)half * 8192 * 1024;
  u16* NQ = (u16*)(ws + OFF_NQ) + (long)half * 8192 * 1024;
  u16* NQR = (u16*)(ws + OFF_NQR);
  u16* KV = (u16*)(ws + OFF_KV);
  u16* VST = (u16*)(ws + OFF_VST);
  u16* VWT = (u16*)(ws + OFF_VWT);
  u16* GATES = (u16*)P.out + (long)half * 8192 * 2048;
  float* NGATE = (float*)(ws + OFF_NGATE) + (long)half * 8192 * 48;
  const float2* RT = (const float2*)(ws + OFF_ROPE);
  const float* LB = (const float*)(ws + OFF_LB);
  EPI_VARS
  for (int t = bid_(); t < 64 * 5; t += gridDim.x) {
    const int nt = 64 + (t >> 6), mt = t & 63;
    const int m0 = mt * 128, n0 = nt * 128;
    f32x4 acc[4][4];
    zero_acc(acc);
    gemm_tile<0, 2>(U, 1024, m0, 8192, WT, 1024, n0, 8832, 1024, 0, acc, sA, sB);
    u16* sT = sA;
    u16* dbase = nullptr;
    int dstride = 1024, dcol = 0;
    bool staged = true;
    if (nt < 8) { dbase = QF; dcol = n0; }
    else if (nt < 16) { dbase = (u16*)LOGF; dcol = n0 - 1024; }
    else if (nt < 24) staged = false;
    else if (nt < 32) { dbase = SG; dcol = n0 - 3072; }
    else if (nt < 40) { dbase = NQ; dcol = n0 - 4096; }
    else if (nt < 52) {
      const int c0 = n0 - 5120, sub0 = c0 >> 8;
      if (sub0 == 3 || sub0 == 5) staged = false;
      else { dbase = KV; dcol = ((sub0 == 0) ? 0 : (sub0 == 1) ? 256 : (sub0 == 2) ? 512 : 768) + (c0 & 255); }
    } else if (nt < 68) { dbase = GATES; dstride = 2048; dcol = n0 - 6656; }
    else staged = false;
#pragma unroll
    for (int i = 0; i < 4; ++i) {
      const int rbase = m0 + wm * 64 + 16 * i + G * 4;
#pragma unroll
      for (int j = 0; j < 4; ++j) {
        const int col = n0 + wn * 64 + 16 * j + l15;
        const f32x4 a = acc[i][j];
        if (nt < 8) {
#pragma unroll
          for (int e = 0; e < 4; ++e) sT[(wm * 64 + 16 * i + G * 4 + e) * 136 + wn * 64 + 16 * j + l15] = f2bf(siluf(a[e]) * 0.08838834764831845f);
        } else if (nt < 16) {
          const int c = col - 1024;
          const float lbv = LB[c];
#pragma unroll
          for (int e = 0; e < 4; ++e) {
            const float f = lbv + (1.f - lbv) * sigm(a[e]);
            sT[(wm * 64 + 16 * i + G * 4 + e) * 136 + wn * 64 + 16 * j + l15] = __builtin_bit_cast(u16, (_Float16)logf(f));
          }
        } else if (nt < 24) {
          const int c = col - 2048;
          const int h = c >> 7, dv = c & 127;
          const int bl = rbase >> 12, tt = rbase & 4095;
          const int cidx = tt >> 6, s = tt & 63;
          const long uu = (long)(bl * 8 + h) * 64 + cidx;
          u32x2 o2 = {pack2(a[0], a[1]), pack2(a[2], a[3])};
          *(u32x2*)(HVT + (uu * 128 + dv) * 64 + s) = o2;
        } else if (nt < 32) {
          const int c = col - 3072;
#pragma unroll
          for (int e = 0; e < 4; ++e) sT[(wm * 64 + 16 * i + G * 4 + e) * 136 + wn * 64 + 16 * j + l15] = f2bf(siluf(a[e]));
        } else if (nt < 40) {
          const int c = col - 4096;
#pragma unroll
          for (int e = 0; e < 4; ++e) {
            const float v = a[e] * 0.18033688011112042f;
            sT[(wm * 64 + 16 * i + G * 4 + e) * 136 + wn * 64 + 16 * j + l15] = f2bf(v);
            if (j == 0) {
              const float pr = SHX(v, 8);
              const int tt = (rbase + e) & 4095;
              const float2 cs = RT[tt * 8 + (l15 & 7)];
              const float o = (l15 < 8) ? (v * cs.x - pr * cs.y) : (v * cs.x + pr * cs.y);
              NQR[(long)(rbase + e) * 256 + (c >> 6) * 16 + l15] = f2bf(o);
            }
          }
        } else if (nt < 52) {
          const int c = col - 5120;
          const int sub = c >> 8, cc = c & 255;
          if (sub == 0 || sub == 1) {
#pragma unroll
            for (int e = 0; e < 4; ++e) sT[(wm * 64 + 16 * i + G * 4 + e) * 136 + wn * 64 + 16 * j + l15] = f2bf(a[e]);
          } else if (sub == 2 || sub == 4) {
            const int dst = (sub == 2) ? 512 : 768;
#pragma unroll
            for (int e = 0; e < 4; ++e) {
              float v = a[e];
              if (j == 0) {
                const float pr = SHX(v, 8);
                const int tt = (rbase + e) & 4095;
                const float2 cs = RT[tt * 8 + (l15 & 7)];
                v = (l15 < 8) ? (v * cs.x - pr * cs.y) : (v * cs.x + pr * cs.y);
              }
              sT[(wm * 64 + 16 * i + G * 4 + e) * 136 + wn * 64 + 16 * j + l15] = f2bf(v);
            }
          } else {
            u16* VT = (sub == 3) ? VST : VWT;
            const int g = cc >> 6, d = cc & 63;
            const int bl = rbase >> 12, tt = rbase & 4095;
            u32x2 o2 = {pack2(a[0], a[1]), pack2(a[2], a[3])};
            *(u32x2*)(VT + ((long)(bl * 4 + g) * 64 + d) * 4096 + tt) = o2;
          }
        } else if (nt < 68) {
          const int c = col - 6656;
#pragma unroll
          for (int e = 0; e < 4; ++e) sT[(wm * 64 + 16 * i + G * 4 + e) * 136 + wn * 64 + 16 * j + l15] = f2bf(sigm(a[e]));
        } else {
          const int c = col - 8704;
          if (c < 48) {
#pragma unroll
            for (int e = 0; e < 4; ++e) NGATE[(long)(rbase + e) * 48 + c] = sigm(a[e]);
          }
        }
      }
    }
    if (staged) {
      __syncthreads();
      const int tc = tid_();
#pragma unroll
      for (int k8 = 0; k8 < 8; ++k8) {
        const int id = tc + 256 * k8;
        const int row = id >> 4, cch = (id & 15) * 8;
        *(u32x4*)(dbase + (long)(m0 + row) * dstride + dcol + cch) = *(const u32x4*)&sT[row * 136 + cch];
      }
      __syncthreads();
    }
  }
}

__device__ __forceinline__ void hgrn_intra_unit(const Params& P, int uu, char* smem) {
  char* ws = P.ws;
  const int tid = tid_(), lane = tid & 63, wave = tid >> 6;
  const int l15 = lane & 15, G = lane >> 4;
  float* sBc = (float*)smem;
  u16* sQ = (u16*)(smem + 64 * 132 * 4);
  const int bl = uu >> 9, h = (uu >> 6) & 7, c = uu & 63;
  const long r0 = (long)bl * 4096 + c * 64;
  u16* QF = (u16*)(ws + OFF_QF);
  const _Float16* LOGF = (const _Float16*)(ws + OFF_LOGF);
  const u16* HVT = (const u16*)(ws + OFF_HVT);
  u16* ABUF = (u16*)(ws + OFF_ABUF);
  u16* UST = (u16*)(ws + OFF_UST);
  float* DCY = (float*)(ws + OFF_DCY);

  __syncthreads();
#pragma unroll
  for (int i = 0; i < 4; ++i) {
    const int id = tid + 256 * i;
    const int row = id >> 4, cc = (id & 15) * 8;
    const u32x4 lf = *(const u32x4*)(LOGF + (r0 + row) * 1024 + h * 128 + cc);
    const _Float16* hp = (const _Float16*)&lf;
#pragma unroll
    for (int e = 0; e < 8; ++e) sBc[row * 132 + cc + e] = (float)hp[e];
    *(u32x4*)&sQ[row * 136 + cc] = *(const u32x4*)(QF + (r0 + row) * 1024 + h * 128 + cc);
  }
  __syncthreads();
  if (tid < 128) {
    float run = 0.f;
    for (int s = 0; s < 64; ++s) {
      run += sBc[s * 132 + tid];
      sBc[s * 132 + tid] = run;
    }
  }
  __syncthreads();
#pragma unroll
  for (int i = 0; i < 4; ++i) {
    const int id = tid + 256 * i;
    const int row = id >> 4, cc = (id & 15) * 8;
    uint32_t w[4];
#pragma unroll
    for (int e = 0; e < 4; ++e) {
      const float q0 = bf2f(sQ[row * 136 + cc + 2 * e]) * __expf(sBc[row * 132 + cc + 2 * e]);
      const float q1 = bf2f(sQ[row * 136 + cc + 2 * e + 1]) * __expf(sBc[row * 132 + cc + 2 * e + 1]);
      w[e] = pack2(q0, q1);
    }
    *(u32x4*)(QF + (r0 + row) * 1024 + h * 128 + cc) = (u32x4){w[0], w[1], w[2], w[3]};
  }
  if (tid < 128) DCY[(long)uu * 128 + tid] = __expf(sBc[63 * 132 + tid]);
  for (int idx = tid; idx < 4096; idx += 256) {
    const int t = idx >> 6, s = idx & 63;
    if ((s >> 4) > (t >> 4)) ABUF[(long)uu * 4096 + idx] = 0;
  }
  for (int ti = wave; ti < 10; ti += 4) {
    int i, j;
    if (ti == 0) { i = 0; j = 0; }
    else if (ti < 3) { i = 1; j = ti - 1; }
    else if (ti < 6) { i = 2; j = ti - 3; }
    else { i = 3; j = ti - 6; }
    f32x4 a4 = {0.f, 0.f, 0.f, 0.f};
    const int t = 16 * i + l15, s = 16 * j + l15;
#pragma unroll
    for (int ks = 0; ks < 4; ++ks) {
      const int dk0 = ks * 32 + G * 8;
      uint32_t aw[4], bw[4];
#pragma unroll
      for (int e2 = 0; e2 < 4; ++e2) {
        float av[2], bv[2];
#pragma unroll
        for (int z = 0; z < 2; ++z) {
          const int dk = dk0 + 2 * e2 + z;
          const float br = sBc[(16 * i) * 132 + dk];
          const float bt = sBc[t * 132 + dk];
          av[z] = bf2f(sQ[t * 136 + dk]) * __expf(bt - br);
          const float bs = sBc[s * 132 + dk];
          const float bp = (s > 0) ? sBc[(s - 1) * 132 + dk] : 0.f;
          const float kk = 1.f - __expf(bs - bp);
          bv[z] = kk * __expf(br - bs);
        }
        aw[e2] = pack2(av[0], av[1]);
        bw[e2] = pack2(bv[0], bv[1]);
      }
      a4 = MFMA(mk8(aw[0], aw[1], aw[2], aw[3]), mk8(bw[0], bw[1], bw[2], bw[3]), a4);
    }
#pragma unroll
    for (int e = 0; e < 4; ++e) {
      const int tr = 16 * i + G * 4 + e, sc = 16 * j + l15;
      const float v = (sc <= tr) ? a4[e] : 0.f;
      ABUF[(long)uu * 4096 + tr * 64 + sc] = f2bf(v);
    }
  }
  {
    f32x4 ua[8][2];
#pragma unroll
    for (int rt = 0; rt < 8; ++rt) { ua[rt][0] = (f32x4){0.f, 0.f, 0.f, 0.f}; ua[rt][1] = (f32x4){0.f, 0.f, 0.f, 0.f}; }
#pragma unroll
    for (int ks = 0; ks < 2; ++ks) {
      bf16x8 bfr[2];
#pragma unroll
      for (int ct = 0; ct < 2; ++ct) {
        const int dk = (2 * wave + ct) * 16 + l15;
        const float blast = sBc[63 * 132 + dk];
        const int s0 = ks * 32 + G * 8;
        float prev = (s0 > 0) ? sBc[(s0 - 1) * 132 + dk] : 0.f;
        uint32_t bw[4];
#pragma unroll
        for (int e2 = 0; e2 < 4; ++e2) {
          const float b0 = sBc[(s0 + 2 * e2) * 132 + dk];
          const float b1 = sBc[(s0 + 2 * e2 + 1) * 132 + dk];
          const float k0 = (1.f - __expf(b0 - prev)) * __expf(blast - b0);
          const float k1 = (1.f - __expf(b1 - b0)) * __expf(blast - b1);
          prev = b1;
          bw[e2] = pack2(k0, k1);
        }
        bfr[ct] = mk8(bw[0], bw[1], bw[2], bw[3]);
      }
#pragma unroll
      for (int rt = 0; rt < 8; ++rt) {
        const int dv = rt * 16 + l15;
        const bf16x8 af = ld8(HVT + ((long)uu * 128 + dv) * 64 + ks * 32 + G * 8);
        ua[rt][0] = MFMA(af, bfr[0], ua[rt][0]);
        ua[rt][1] = MFMA(af, bfr[1], ua[rt][1]);
      }
    }
#pragma unroll
    for (int rt = 0; rt < 8; ++rt)
#pragma unroll
      for (int ct = 0; ct < 2; ++ct)
#pragma unroll
        for (int e = 0; e < 4; ++e) {
          const int dv = rt * 16 + G * 4 + e, dk = (2 * wave + ct) * 16 + l15;
          UST[((long)uu * 128 + dv) * 128 + dk] = f2bf(ua[rt][ct][e]);
        }
  }
}

__device__ __forceinline__ void cmp_gemm1_tile(const Params& P, int t, char* smem) {
  char* ws = P.ws;
  u16* sA = (u16*)smem;
  u16* sB = sA + 128 * 80;
  EPI_VARS
  const int kv = t >> 5, rem = t & 31;
  const int mt = rem >> 1, nt = rem & 1;
  const int m0 = mt * 128, n0 = nt * 128;
  const u16* KV = (const u16*)(ws + OFF_KV);
  const u16* W1T = (const u16*)(ws + (kv ? OFF_WV1T : OFF_WK1T));
  u16* HID = (u16*)(ws + (kv ? OFF_HIDV : OFF_HIDK));
  const float* B1P = (const float*)(ws + OFF_BIAS1P) + kv * 2048;
  f32x4 acc[4][4];
  zero_acc(acc);
  gemm_tile<1, 2>(KV, 1024, m0, 2048, W1T, 2048, n0, 256, 2048, kv * 256, acc, sA, sB);
#pragma unroll
  for (int i = 0; i < 4; ++i)
#pragma unroll
    for (int j = 0; j < 4; ++j) {
      const int col = n0 + wn * 64 + 16 * j + l15;
      float bias = 0.f;
#pragma unroll
      for (int pp = 0; pp < 8; ++pp) bias += B1P[pp * 256 + col];
#pragma unroll
      for (int e = 0; e < 4; ++e) {
        const int row = m0 + wm * 64 + 16 * i + G * 4 + e;
        HID[(long)row * 256 + col] = f2bf(gelu_tanh(acc[i][j][e] + bias));
      }
    }
}

__device__ __forceinline__ void cmp_gemm2_tile(const Params& P, int t, char* smem) {
  char* ws = P.ws;
  u16* sA = (u16*)smem;
  u16* sB = sA + 128 * 80;
  EPI_VARS
  const int kv = t >> 4, mt = t & 15;
  const int m0 = mt * 128;
  const u16* HID = (const u16*)(ws + (kv ? OFF_HIDV : OFF_HIDK));
  const u16* W2T = (const u16*)(ws + (kv ? OFF_WV2T : OFF_WK2T));
  u16* KCMP = (u16*)(ws + OFF_KCMP);
  u16* VCMPT = (u16*)(ws + OFF_VCMPT);
  f32x4 acc[4][4];
  zero_acc(acc);
  gemm_tile<0, 1>(HID, 256, m0, 2048, W2T, 256, 0, 64, 256, 0, acc, sA, sB);
  if (wn == 0) {
#pragma unroll
    for (int i = 0; i < 4; ++i)
#pragma unroll
      for (int j = 0; j < 4; ++j) {
        const int col = 16 * j + l15;
        const int rbase = m0 + wm * 64 + 16 * i + G * 4;
        if (kv == 0) {
#pragma unroll
          for (int e = 0; e < 4; ++e) KCMP[(long)(rbase + e) * 64 + col] = f2bf(acc[i][j][e]);
        } else {
          const int grp = rbase >> 8, n = rbase & 255;
          u32x2 o2 = {pack2(acc[i][j][0], acc[i][j][1]), pack2(acc[i][j][2], acc[i][j][3])};
          *(u32x2*)(VCMPT + ((long)grp * 64 + col) * 256 + n) = o2;
        }
      }
  }
}

__device__ __forceinline__ void hgrn_scan(const Params& P) {
  char* ws = P.ws;
  u16* UST = (u16*)(ws + OFF_UST);
  const float* DCY = (const float*)(ws + OFF_DCY);
  for (int idx = bid_() * 256 + tid_(); idx < 131072; idx += gridDim.x * 256) {
    const int bh = idx >> 13, rem = idx & 8191;
    const int dv = rem >> 6, dk2 = (rem & 63) * 2;
    float s0 = 0.f, s1 = 0.f;
#pragma unroll 8
    for (int c = 0; c < 64; ++c) {
      const long uu = (long)bh * 64 + c;
      u16* ptr = UST + (uu * 128 + dv) * 128 + dk2;
      const uint32_t uv = *(const uint32_t*)ptr;
      const float2 d = *(const float2*)(DCY + uu * 128 + dk2);
      *(uint32_t*)ptr = pack2(s0, s1);
      s0 = d.x * s0 + __uint_as_float(uv << 16);
      s1 = d.y * s1 + __uint_as_float(uv & 0xffff0000u);
    }
  }
}

__device__ __forceinline__ void hgrn_out_unit(const Params& P, int half, int uu, char* smem) {
  char* ws = P.ws;
  const int tid = tid_(), lane = tid & 63, wave = tid >> 6;
  const int l15 = lane & 15, G = lane >> 4;
  float* sO = (float*)smem;
  const int bl = uu >> 9, h = (uu >> 6) & 7, c = uu & 63;
  const long r0 = (long)bl * 4096 + c * 64;
  const u16* QF = (const u16*)(ws + OFF_QF);
  const u16* HVT = (const u16*)(ws + OFF_HVT);
  const u16* ABUF = (const u16*)(ws + OFF_ABUF);
  const u16* UST = (const u16*)(ws + OFF_UST);
  u16* SG = (u16*)(ws + OFF_SG) + (long)half * 8192 * 1024;
  f32x4 acc[4][2];
#pragma unroll
  for (int i = 0; i < 4; ++i) { acc[i][0] = (f32x4){0.f, 0.f, 0.f, 0.f}; acc[i][1] = (f32x4){0.f, 0.f, 0.f, 0.f}; }
#pragma unroll
  for (int ks = 0; ks < 4; ++ks) {
    const int dk0 = ks * 32 + G * 8;
    bf16x8 bfr[2];
#pragma unroll
    for (int jt = 0; jt < 2; ++jt) bfr[jt] = ld8(UST + ((long)uu * 128 + 32 * wave + 16 * jt + l15) * 128 + dk0);
#pragma unroll
    for (int i = 0; i < 4; ++i) {
      const bf16x8 af = ld8(QF + (r0 + 16 * i + l15) * 1024 + h * 128 + dk0);
      acc[i][0] = MFMA(af, bfr[0], acc[i][0]);
      acc[i][1] = MFMA(af, bfr[1], acc[i][1]);
    }
  }
#pragma unroll
  for (int ks = 0; ks < 2; ++ks) {
    const int s0 = ks * 32 + G * 8;
    bf16x8 bfr[2];
#pragma unroll
    for (int jt = 0; jt < 2; ++jt) bfr[jt] = ld8(HVT + ((long)uu * 128 + 32 * wave + 16 * jt + l15) * 64 + s0);
#pragma unroll
    for (int i = 0; i < 4; ++i) {
      const bf16x8 af = ld8(ABUF + (long)uu * 4096 + (16 * i + l15) * 64 + s0);
      acc[i][0] = MFMA(af, bfr[0], acc[i][0]);
      acc[i][1] = MFMA(af, bfr[1], acc[i][1]);
    }
  }
  __syncthreads();
#pragma unroll
  for (int i = 0; i < 4; ++i)
#pragma unroll
    for (int jt = 0; jt < 2; ++jt)
#pragma unroll
      for (int e = 0; e < 4; ++e) sO[(16 * i + G * 4 + e) * 132 + 32 * wave + 16 * jt + l15] = acc[i][jt][e];
  __syncthreads();
  {
    const int row = tid >> 2, part = tid & 3;
    float ss = 0.f;
#pragma unroll
    for (int cc = 0; cc < 32; ++cc) { const float v = sO[row * 132 + part * 32 + cc]; ss += v * v; }
    ss += SHX(ss, 1);
    ss += SHX(ss, 2);
    const float r = rsqrtf(ss * (1.f / 128.f) + 1e-6f);
    u16* dst = SG + (r0 + row) * 1024 + h * 128 + part * 32;
#pragma unroll
    for (int q4 = 0; q4 < 4; ++q4) {
      const u32x4 sgv = *(const u32x4*)(dst + q4 * 8);
      uint32_t w[4];
#pragma unroll
      for (int e = 0; e < 4; ++e) {
        const int cc = q4 * 8 + 2 * e;
        const float g0 = __uint_as_float(sgv[e] << 16), g1 = __uint_as_float(sgv[e] & 0xffff0000u);
        const float y0 = sO[row * 132 + part * 32 + cc] * r * P.gnorm[part * 32 + cc] * g0;
        const float y1 = sO[row * 132 + part * 32 + cc + 1] * r * P.gnorm[part * 32 + cc + 1] * g1;
        w[e] = pack2(y0, y1);
      }
      *(u32x4*)(dst + q4 * 8) = (u32x4){w[0], w[1], w[2], w[3]};
    }
  }
}

__device__ __forceinline__ void stage_kv(u16* sK, u16* sV, const u16* kptr, long kstride, const u16* vptr, long vstride) {
  const int tid = tid_();
  __syncthreads();
#pragma unroll
  for (int i = 0; i < 2; ++i) {
    const int id = tid + 256 * i;
    const int row = id >> 3, ch = id & 7;
    *(u32x4*)&sK[row * 72 + ch * 8] = *(const u32x4*)(kptr + row * kstride + ch * 8);
    *(u32x4*)&sV[row * 72 + ch * 8] = *(const u32x4*)(vptr + row * vstride + ch * 8);
  }
  __syncthreads();
}

__device__ __forceinline__ void qk_scores(const u16* sK, const bf16x8 (&q)[2], f32x4 (&s)[4], int l15, int G) {
#pragma unroll
  for (int kt = 0; kt < 4; ++kt) {
    s[kt] = (f32x4){0.f, 0.f, 0.f, 0.f};
#pragma unroll
    for (int ks = 0; ks < 2; ++ks) s[kt] = MFMA(ld8(&sK[(16 * kt + l15) * 72 + ks * 32 + G * 8]), q[ks], s[kt]);
  }
}

__device__ __forceinline__ void pv_accum(const u16* sV, const f32x4 (&p)[4], f32x4 (&o)[4], int l15, int G) {
#pragma unroll
  for (int ks2 = 0; ks2 < 2; ++ks2) {
    const f32x4 pa = p[2 * ks2], pb = p[2 * ks2 + 1];
    const bf16x8 pf = mk8(pack2(pa[0], pa[1]), pack2(pa[2], pa[3]), pack2(pb[0], pb[1]), pack2(pb[2], pb[3]));
#pragma unroll
    for (int dt = 0; dt < 4; ++dt) {
      const u32x2 v0 = *(const u32x2*)&sV[(16 * dt + l15) * 72 + 32 * ks2 + 4 * G];
      const u32x2 v1 = *(const u32x2*)&sV[(16 * dt + l15) * 72 + 32 * ks2 + 16 + 4 * G];
      o[dt] = MFMA(mk8(v0[0], v0[1], v1[0], v1[1]), pf, o[dt]);
    }
  }
}

#define EX2(x) __builtin_amdgcn_exp2f(x)
typedef __attribute__((ext_vector_type(16))) float f32x16;
#define MFMA32(a, b, c) __builtin_amdgcn_mfma_f32_32x32x16_bf16((a), (b), (c), 0, 0, 0)
template <int MODE, bool EDGE>
__device__ __forceinline__ void nsa_block(const u16* sK, const u16* sV, int jb, int qb, int q, bool blk_ok,
                                          const bf16x8 (&qf)[4], f32x16 (&O)[2], float& m, float& l, int r31, int h) {
  const int lane = h * 32 + r31;
  f32x16 s[2];
#pragma unroll
  for (int kt2 = 0; kt2 < 2; ++kt2) {
#pragma unroll
    for (int e = 0; e < 16; ++e) s[kt2][e] = 0.f;
#pragma unroll
    for (int ks = 0; ks < 4; ++ks) s[kt2] = MFMA32(ld8(&sK[(32 * kt2 + r31) * 72 + 16 * ks + 8 * h]), qf[ks], s[kt2]);
  }
  float smax = -1e30f;
  if (EDGE) {
#pragma unroll
    for (int kt2 = 0; kt2 < 2; ++kt2)
#pragma unroll
      for (int e = 0; e < 16; ++e) {
        const int k = 32 * kt2 + (e & 3) + 8 * (e >> 2) + 4 * h;
        const bool a = blk_ok && ((jb == qb) ? (k <= q) : (k > q));
        if (!a) s[kt2][e] = -1e30f;
        smax = fmaxf(smax, s[kt2][e]);
      }
  } else {
#pragma unroll
    for (int kt2 = 0; kt2 < 2; ++kt2)
#pragma unroll
      for (int e = 0; e < 16; ++e) smax = fmaxf(smax, s[kt2][e]);
    if (MODE == 2 && !blk_ok) smax = -1e30f;
  }
  smax = fmaxf(smax, SHX(smax, 32));
  const float mn = fmaxf(m, smax);
  const float alpha = EX2(m - mn);
  m = mn;
  const float mref = (!EDGE && MODE == 2 && !blk_ok) ? 1e30f : mn;
  float ls = 0.f;
#pragma unroll
  for (int kt2 = 0; kt2 < 2; ++kt2)
#pragma unroll
    for (int e = 0; e < 16; ++e) {
      const float sv = s[kt2][e];
      float pv;
      if (EDGE) pv = (sv > -1e29f) ? EX2(sv - mn) : 0.f;
      else pv = EX2(sv - mref);
      s[kt2][e] = pv;
      ls += pv;
    }
  l = l * alpha + ls;
  O[0] *= alpha;
  O[1] *= alpha;
#pragma unroll
  for (int kt2 = 0; kt2 < 2; ++kt2)
#pragma unroll
    for (int st = 0; st < 2; ++st) {
      const bf16x8 pf = mk8(pack2(s[kt2][8 * st + 0], s[kt2][8 * st + 1]), pack2(s[kt2][8 * st + 2], s[kt2][8 * st + 3]),
                            pack2(s[kt2][8 * st + 4], s[kt2][8 * st + 5]), pack2(s[kt2][8 * st + 6], s[kt2][8 * st + 7]));
#pragma unroll
      for (int dt2 = 0; dt2 < 2; ++dt2) {
        const u16* vrow = &sV[(32 * dt2 + r31) * 72 + 32 * kt2 + 16 * st + 4 * h];
        const u32x2 v0 = *(const u32x2*)vrow;
        const u32x2 v1 = *(const u32x2*)(vrow + 8);
        O[dt2] = MFMA32(mk8(v0[0], v0[1], v1[0], v1[1]), pf, O[dt2]);
      }
    }
}

template <int MODE>
__device__ __forceinline__ void nsa_branch(const u16* kbase, const u16* vbase, int jb0, int jb1, int qb, int q,
                                           uint32_t mlo, uint32_t mhi, const bf16x8 (&qf)[4], const float* ngbase, int rowbase, int gidx,
                                           u16* sYl, u16* sm, float pscale = 1.f) {
  const int tid = tid_();
  const int lane = tid & 63;
  const int r31 = lane & 31, h = lane >> 5;
  const int srow = tid >> 3, sch = (tid & 7) * 8;
  f32x16 O[2];
#pragma unroll
  for (int e = 0; e < 16; ++e) { O[0][e] = 0.f; O[1][e] = 0.f; }
  float m = -1e30f, l = 0.f;
  u32x4 kr[2], vr[2];
  const unsigned koff = (unsigned)((srow * 1024 + sch) * 2);
  const unsigned voff = (unsigned)((srow * 4096 + sch) * 2);
  {
    const char* kb = (const char*)kbase + (size_t)jb0 * 131072;
    const char* vb = (const char*)vbase + (size_t)jb0 * 128;
#pragma unroll
    for (int i = 0; i < 2; ++i) {
      kr[i] = *(const u32x4*)(kb + (koff + i * 65536u));
      vr[i] = *(const u32x4*)(vb + (voff + i * 262144u));
    }
  }
  __syncthreads();
#pragma unroll
  for (int i = 0; i < 2; ++i) {
    *(u32x4*)&sm[(srow + 32 * i) * 72 + sch] = kr[i];
    *(u32x4*)&sm[4608 + (srow + 32 * i) * 72 + sch] = vr[i];
  }
  __syncthreads();
  int cur = 0;
  for (int jb = jb0; jb <= jb1; ++jb) {
    const bool more = jb < jb1;
    if (more) {
      const char* kb = (const char*)kbase + (size_t)(jb + 1) * 131072;
      const char* vb = (const char*)vbase + (size_t)(jb + 1) * 128;
#pragma unroll
      for (int i = 0; i < 2; ++i) {
        kr[i] = *(const u32x4*)(kb + (koff + i * 65536u));
        vr[i] = *(const u32x4*)(vb + (voff + i * 262144u));
      }
    }
    const u16* sK = sm + cur * 9216;
    const u16* sV = sK + 4608;
    bool blk_ok = true;
    if (MODE == 2) blk_ok = (jb < 32) ? ((mlo >> jb) & 1u) : ((mhi >> (jb - 32)) & 1u);
    const bool edge = (jb == qb) || (MODE == 3 && jb == qb - 8);
    if (edge) nsa_block<MODE, true>(sK, sV, jb, qb, q, blk_ok, qf, O, m, l, r31, h);
    else nsa_block<MODE, false>(sK, sV, jb, qb, q, blk_ok, qf, O, m, l, r31, h);
    if (more) {
      u16* dK = sm + (cur ^ 1) * 9216;
#pragma unroll
      for (int i = 0; i < 2; ++i) {
        *(u32x4*)&dK[(srow + 32 * i) * 72 + sch] = kr[i];
        *(u32x4*)&dK[4608 + (srow + 32 * i) * 72 + sch] = vr[i];
      }
    }
    __syncthreads();
    cur ^= 1;
  }
  const int tg = tid_();
  const int lg = tg & 63, hh = (lg >> 4) & 1, hg = lg >> 5;
  const float* gatep = (const float*)((const char*)ngbase + (unsigned)(rowbase + 16 * (tg >> 6) + (tg & 15)) * 192u) + gidx + hh;
  float lt = l;
  lt += shx_f(lt, lg ^ 32);
  const float sc = (lt > 0.f) ? (pscale * gatep[0] / lt) : 0.f;
  u16* yrow = sYl + (((tg >> 6) * 2 + hh) * 16 + (tg & 15)) * 64;
#pragma unroll
  for (int dt2 = 0; dt2 < 2; ++dt2)
#pragma unroll
    for (int m4 = 0; m4 < 4; ++m4) {
      u32x2* yp = (u32x2*)(yrow + 32 * dt2 + 8 * m4 + 4 * hg);
      const u32x2 yv = *yp;
      const float y0 = __uint_as_float(yv[0] << 16) + O[dt2][4 * m4 + 0] * sc;
      const float y1 = __uint_as_float(yv[0] & 0xffff0000u) + O[dt2][4 * m4 + 1] * sc;
      const float y2 = __uint_as_float(yv[1] << 16) + O[dt2][4 * m4 + 2] * sc;
      const float y3 = __uint_as_float(yv[1] & 0xffff0000u) + O[dt2][4 * m4 + 3] * sc;
      *yp = (u32x2){pack2(y0, y1), pack2(y2, y3)};
    }
}

__device__ __forceinline__ void pv_cmp(const u16* vc, int jb, const f32x4 (&p)[4], f32x4 (&o)[4], int l15, int G) {
#pragma unroll
  for (int ks2 = 0; ks2 < 2; ++ks2) {
    const f32x4 pa = p[2 * ks2], pb = p[2 * ks2 + 1];
    const bf16x8 pf = mk8(pack2(pa[0], pa[1]), pack2(pa[2], pa[3]), pack2(pb[0], pb[1]), pack2(pb[2], pb[3]));
#pragma unroll
    for (int dt = 0; dt < 4; ++dt) {
      const u16* vp = vc + (long)(16 * dt + l15) * 256 + jb * 64 + 32 * ks2 + 4 * G;
      const u32x2 v0 = *(const u32x2*)vp;
      const u32x2 v1 = *(const u32x2*)(vp + 16);
      o[dt] = MFMA(mk8(v0[0], v0[1], v1[0], v1[1]), pf, o[dt]);
    }
  }
}

__device__ __forceinline__ void nsa_unit(const Params& P, int half, int u, char* smem) {
  char* ws = P.ws;
  const int tid = tid_(), lane = tid & 63, wave = tid >> 6;
  const int l15 = lane & 15, G = lane >> 4;
  const int hp = u >> 9, rest = u & 511;
  const int bl = rest >> 8, g = (rest >> 6) & 3, xq = rest & 63;
  const int qb = hp ? xq : 63 - xq;
  const int q = 16 * wave + l15;
  const int t = qb * 64 + q;
  const int rl = bl * 4096 + t;
  const int rg = half * 8192 + rl;
  const char* NQc = (const char*)(ws + OFF_NQ);
  const unsigned qoff = (unsigned)rg * 2048u;
  u16* sm = (u16*)smem;
  float* sImp = (float*)smem;
  const u16* NQ = (const u16*)(ws + OFF_NQ);
  const u16* NQR = (const u16*)(ws + OFF_NQR);
  const u16* KV = (const u16*)(ws + OFF_KV);
  const u16* VST = (const u16*)(ws + OFF_VST);
  const u16* VWT = (const u16*)(ws + OFF_VWT);
  const u16* KCMP = (const u16*)(ws + OFF_KCMP);
  const u16* VCMPT = (const u16*)(ws + OFF_VCMPT);
  const float* NGATE = (const float*)((const char*)(ws + OFF_NGATE) + (unsigned)rg * 192u);
  u16* YB = (u16*)(ws + (half ? OFF_YB1 : OFF_YB0));

  f32x4 Y[2][4];
#pragma unroll
  for (int rr = 0; rr < 2; ++rr)
#pragma unroll
    for (int dt = 0; dt < 4; ++dt) Y[rr][dt] = (f32x4){0.f, 0.f, 0.f, 0.f};

  uint32_t mlo = 0, mhi = 0;
  u16* sYl = (u16*)(smem + 36864);
  {
    const int nblk = ((4 * qb + 2) >> 6) + 1;
    const u16* kc = KCMP + (long)(bl * 4 + g) * 256 * 64;
    const u16* vc = VCMPT + (long)(bl * 4 + g) * 64 * 256;
    float imp[4][4];
#pragma unroll
    for (int a = 0; a < 4; ++a)
#pragma unroll
      for (int b = 0; b < 4; ++b) imp[a][b] = 0.f;
    __syncthreads();
    for (int id = tid; id < nblk * 512; id += 256) {
      const int row = id >> 3, chn = (id & 7) * 8;
      *(u32x4*)&sm[row * 72 + chn] = *(const u32x4*)(kc + row * 64 + chn);
    }
    __syncthreads();
#pragma unroll 1
    for (int r = 0; r < 4; ++r) {
      bf16x8 qp[2];
#pragma unroll
      for (int ks = 0; ks < 2; ++ks) qp[ks] = *(const bf16x8*)(NQc + (qoff + (unsigned)(((4 * g + r) * 64 + ks * 32 + G * 8) * 2)));
      float m = -1e30f, l = 0.f;
#pragma unroll 1
      for (int jb = 0; jb < nblk; ++jb) {
        f32x4 s[4];
        float smax = -1e30f;
#pragma unroll
        for (int kt = 0; kt < 4; ++kt) {
          f32x4 a4 = {0.f, 0.f, 0.f, 0.f};
#pragma unroll
          for (int ks = 0; ks < 2; ++ks)
            a4 = MFMA(ld8(&sm[(jb * 64 + 16 * kt + l15) * 72 + ks * 32 + G * 8]), qp[ks], a4);
#pragma unroll
          for (int e = 0; e < 4; ++e) {
            const int n = jb * 64 + 16 * kt + 4 * G + e;
            const float sv = (16 * n + 31 <= t) ? a4[e] : -1e30f;
            s[kt][e] = sv;
            smax = fmaxf(smax, sv);
          }
        }
        smax = fmaxf(smax, SHX(smax, 16));
        smax = fmaxf(smax, SHX(smax, 32));
        const float mn = fmaxf(m, smax);
        float ls = 0.f;
#pragma unroll
        for (int kt = 0; kt < 4; ++kt)
#pragma unroll
          for (int e = 0; e < 4; ++e) ls += (s[kt][e] > -1e29f) ? EX2(s[kt][e] - mn) : 0.f;
        l = l * EX2(m - mn) + ls;
        m = mn;
      }
      l += SHX(l, 16);
      l += SHX(l, 32);
      const float invl = (l > 0.f) ? 1.f / l : 0.f;
      float prevup = 0.f;
#pragma unroll 1
      for (int jb = 0; jb < nblk; ++jb) {
        {
          f32x4 p[4];
#pragma unroll
          for (int kt = 0; kt < 4; ++kt) {
            f32x4 a4 = {0.f, 0.f, 0.f, 0.f};
#pragma unroll
            for (int ks = 0; ks < 2; ++ks)
              a4 = MFMA(ld8(&sm[(jb * 64 + 16 * kt + l15) * 72 + ks * 32 + G * 8]), qp[ks], a4);
#pragma unroll
            for (int e = 0; e < 4; ++e) {
              const int n = jb * 64 + 16 * kt + 4 * G + e;
              p[kt][e] = (16 * n + 31 <= t) ? EX2(a4[e] - m) * invl : 0.f;
            }
            const float sum4 = (p[kt][0] + p[kt][1]) + (p[kt][2] + p[kt][3]);
            const float upv = shx_f(p[kt][3], (lane + 48) & 63);
            const float add = (G > 0) ? upv : prevup;
            const float iv = sum4 + add;
#pragma unroll
            for (int j = 0; j < 4; ++j) imp[j][kt] += (jb == j) ? iv : 0.f;
            prevup = upv;
          }
          if (r == 2 * hp) pv_cmp(vc, jb, p, Y[0], l15, G);
          else if (r == 2 * hp + 1) pv_cmp(vc, jb, p, Y[1], l15, G);
        }
      }
    }
    {
      const float g0 = NGATE[0 * 16 + 4 * g + 2 * hp], g1 = NGATE[0 * 16 + 4 * g + 2 * hp + 1];
#pragma unroll
      for (int dt = 0; dt < 4; ++dt) {
        *(u32x2*)(sYl + ((wave * 2 + 0) * 16 + l15) * 64 + 16 * dt + 4 * G) = (u32x2){pack2(Y[0][dt][0] * g0, Y[0][dt][1] * g0), pack2(Y[0][dt][2] * g0, Y[0][dt][3] * g0)};
        *(u32x2*)(sYl + ((wave * 2 + 1) * 16 + l15) * 64 + 16 * dt + 4 * G) = (u32x2){pack2(Y[1][dt][0] * g1, Y[1][dt][1] * g1), pack2(Y[1][dt][2] * g1, Y[1][dt][3] * g1)};
      }
    }
    __syncthreads();
    float* myImp = sImp + wave * 16 * 65;
#pragma unroll
    for (int jb = 0; jb < 4; ++jb)
#pragma unroll
      for (int kt = 0; kt < 4; ++kt) myImp[l15 * 65 + 16 * jb + 4 * kt + G] = imp[jb][kt];
    __syncthreads();
    const int cur = qb;
    uint32_t blo = 0, bhi = 0;
    if (cur + 1 <= 16) {
#pragma unroll
      for (int jb = 0; jb < 4; ++jb)
#pragma unroll
        for (int kt = 0; kt < 4; ++kt) {
          const int s = 16 * jb + 4 * kt + G;
          if (s <= cur) blo |= (1u << s);
        }
    } else {
      int cnt[4][4];
#pragma unroll
      for (int a = 0; a < 4; ++a)
#pragma unroll
        for (int b = 0; b < 4; ++b) cnt[a][b] = 0;
      for (int sp = 1; sp <= cur - 2; ++sp) {
        const float xv = myImp[l15 * 65 + sp];
#pragma unroll
        for (int jb = 0; jb < 4; ++jb)
#pragma unroll
          for (int kt = 0; kt < 4; ++kt) {
            const int s = 16 * jb + 4 * kt + G;
            const float v = imp[jb][kt];
            cnt[jb][kt] += ((xv > v) || (xv == v && sp < s)) ? 1 : 0;
          }
      }
#pragma unroll
      for (int jb = 0; jb < 4; ++jb)
#pragma unroll
        for (int kt = 0; kt < 4; ++kt) {
          const int s = 16 * jb + 4 * kt + G;
          const bool sel = (s == 0) || (s == cur) || (s == cur - 1) || (s >= 1 && s <= cur - 2 && cnt[jb][kt] < 13);
          if (sel) { if (s < 32) blo |= (1u << s); else bhi |= (1u << (s - 32)); }
        }
    }
    blo |= SHXU(blo, 16); blo |= SHXU(blo, 32);
    bhi |= SHXU(bhi, 16); bhi |= SHXU(bhi, 32);
    mlo = blo; mhi = bhi;
  }
  {
    const int hh = (lane >> 4) & 1, h5 = lane >> 5;
    const int head = 4 * g + 2 * hp + hh;
    bf16x8 qf[4];
    qf[0] = *(const bf16x8*)((const char*)NQR + ((unsigned)rl * 512u + (unsigned)((head * 16 + 8 * h5) * 2)));
#pragma unroll
    for (int ks = 1; ks < 4; ++ks) qf[ks] = *(const bf16x8*)(NQc + (qoff + (unsigned)((head * 64 + 16 * ks + 8 * h5) * 2)));
    const int head0 = 4 * g + 2 * hp;
    const u16* kbs = KV + (long)bl * 4096 * 1024 + 512 + g * 64;
    const u16* vbs = VST + (long)(bl * 4 + g) * 64 * 4096;
    nsa_branch<2>(kbs, vbs, 0, qb, qb, q, mlo, mhi, qf, (const float*)(ws + OFF_NGATE), half * 8192 + bl * 4096 + qb * 64, 16 + head0, sYl, sm);
    const u16* kbw = KV + (long)bl * 4096 * 1024 + 768 + g * 64;
    const u16* vbw = VWT + (long)(bl * 4 + g) * 64 * 4096;
    const int jw0 = (qb >= 8) ? qb - 8 : 0;
    nsa_branch<3>(kbw, vbw, jw0, qb, qb, q, mlo, mhi, qf, (const float*)(ws + OFF_NGATE), half * 8192 + bl * 4096 + qb * 64, 32 + head0, sYl, sm);
    const int tid2 = tid_();
    const int l2 = tid2 & 63, hh2 = (l2 >> 4) & 1, hg2 = l2 >> 5;
    const unsigned yoff = (unsigned)(bl * 4096 + qb * 64 + 16 * (tid2 >> 6) + (tid2 & 15)) * 2048u;
    const u16* yrow = sYl + (((tid2 >> 6) * 2 + hh2) * 16 + (tid2 & 15)) * 64;
#pragma unroll
    for (int dt2 = 0; dt2 < 2; ++dt2)
#pragma unroll
      for (int m4 = 0; m4 < 4; ++m4) {
        const int d0 = 32 * dt2 + 8 * m4 + 4 * hg2;
        *(u32x2*)((char*)YB + (yoff + (unsigned)(((head0 + hh2) * 64 + d0) * 2))) = *(const u32x2*)(yrow + d0);
      }
  }
}

__device__ __forceinline__ void phase_branch_merge(const Params& P, char* smem) {
  char* ws = P.ws;
  u16* sA = (u16*)smem;
  const u16* YA = (const u16*)(ws + OFF_SG);
  const u16* GATES = (const u16*)P.out;
  u16* MERGED = (u16*)(ws + OFF_MERGED);
  for (int t = bid_(); t < 512; t += gridDim.x) {
    const int nt = t >> 7, mt = t & 127;
    const int m0 = mt * 128, n0 = nt * 256;
    const u16* YBp = (m0 < 8192) ? (const u16*)(ws + OFF_YB0) : ((const u16*)(ws + OFF_YB1) - (long)8192 * 1024);
    f32x4 acc[4][8];
#pragma unroll
    for (int i = 0; i < 4; ++i)
#pragma unroll
      for (int j = 0; j < 8; ++j) acc[i][j] = (f32x4){0.f, 0.f, 0.f, 0.f};
    gemm_tile_wide(YA, 1024, m0, (const u16*)(ws + OFF_WA_T), 1024, n0, 1024, acc, sA);
    {
      EPI_VARS
#pragma unroll
      for (int i = 0; i < 4; ++i)
#pragma unroll
        for (int j = 0; j < 8; ++j) {
          const int col = n0 + wn * 128 + 16 * j + l15;
#pragma unroll
          for (int e = 0; e < 4; ++e) {
            const unsigned go = ((unsigned)(m0 + wm * 64 + 16 * i + G * 4 + e) * 2048u + (unsigned)col) * 2u;
            acc[i][j][e] *= bf2f(*(const u16*)((const char*)GATES + go)) * __builtin_amdgcn_rcpf(bf2f(*(const u16*)((const char*)GATES + (go + 2048u))));
          }
        }
    }
    gemm_tile_wide(YBp, 1024, m0, (const u16*)(ws + OFF_WB_T), 1024, n0, 1024, acc, sA);
    {
      EPI_VARS
#pragma unroll
      for (int i = 0; i < 4; ++i)
#pragma unroll
        for (int j = 0; j < 8; ++j) {
          const int col = n0 + wn * 128 + 16 * j + l15;
#pragma unroll
          for (int e = 0; e < 4; ++e) {
            const unsigned ro = (unsigned)(m0 + wm * 64 + 16 * i + G * 4 + e);
            const unsigned go = (ro * 2048u + (unsigned)col) * 2u + 2048u;
            *(u16*)((char*)MERGED + (ro * 1024u + (unsigned)col) * 2u) = f2bf(acc[i][j][e] * bf2f(*(const u16*)((const char*)GATES + go)));
          }
        }
    }
  }
}

template <int EPI>
__device__ __forceinline__ void phase_gemm(const u16* A, int K, const u16* Wt, int N, void* outp, char* smem) {
  u16* sA = (u16*)smem;
  u16* sB = sA + 128 * 80;
  EPI_VARS
  const int ntn = N >> 7;
  for (int t = bid_(); t < 128 * ntn; t += gridDim.x) {
    const int nt = t >> 7, mt = t & 127;
    const int m0 = mt * 128, n0 = nt * 128;
    f32x4 acc[4][4];
    zero_acc(acc);
    gemm_tile<0, 2>(A, K, m0, 16384, Wt, K, n0, N, K, 0, acc, sA, sB);
#pragma unroll
    for (int i = 0; i < 4; ++i)
#pragma unroll
      for (int j = 0; j < 4; ++j) {
        const int col = n0 + wn * 64 + 16 * j + l15;
#pragma unroll
        for (int e = 0; e < 4; ++e) {
          const long row = m0 + wm * 64 + 16 * i + G * 4 + e;
          const float v = acc[i][j][e];
          if (EPI == 0) ((float*)outp)[row * N + col] = v;
          else if (EPI == 2) ((u16*)outp)[row * N + col] = f2bf(v);
          else { const float rl = fmaxf(v, 0.f); ((u16*)outp)[row * N + col] = f2bf(rl * rl); }
        }
      }
  }
}


template <int EPI>
__device__ __forceinline__ void phase_gemm_wide(const u16* A, int K, const u16* Wt, int N, u16* outp, char* smem) {
  u16* sA = (u16*)smem;
  EPI_VARS
  const int ntn = N >> 8;
  for (int t = bid_(); t < 128 * ntn; t += gridDim.x) {
    const int nt = t >> 7, mt = t & 127;
    const int m0 = mt * 128, n0 = nt * 256;
    f32x4 acc[4][8];
#pragma unroll
    for (int i = 0; i < 4; ++i)
#pragma unroll
      for (int j = 0; j < 8; ++j) acc[i][j] = (f32x4){0.f, 0.f, 0.f, 0.f};
    gemm_tile_wide(A, K, m0, Wt, K, n0, K, acc, sA);
#pragma unroll
    for (int i = 0; i < 4; ++i)
#pragma unroll
      for (int j = 0; j < 8; ++j) {
        const int col = n0 + wn * 128 + 16 * j + l15;
#pragma unroll
        for (int e = 0; e < 4; ++e) {
          const long row = m0 + wm * 64 + 16 * i + G * 4 + e;
          float v = acc[i][j][e];
          if (EPI == 1) { v = fmaxf(v, 0.f); v = v * v; }
          outp[row * N + col] = f2bf(v);
        }
      }
  }
}

__device__ __forceinline__ void phase_ple(const Params& P, char* smem) {
  char* ws = P.ws;
  u16* sA = (u16*)smem;
  float* Z3 = (float*)(ws + OFF_Z3);
  for (int t = bid_(); t < 512; t += gridDim.x) {
    const int nt = t >> 7, mt = t & 127;
    const int m0 = mt * 128, n0 = nt * 256;
    f32x4 acc[4][8];
#pragma unroll
    for (int i = 0; i < 4; ++i)
#pragma unroll
      for (int j = 0; j < 8; ++j) acc[i][j] = (f32x4){0.f, 0.f, 0.f, 0.f};
    gemm_tile_wide((const u16*)(ws + OFF_PB), 256, m0, (const u16*)(ws + OFF_WPLE_T), 256, n0, 256, acc, sA);
    {
      EPI_VARS
#pragma unroll
      for (int i = 0; i < 4; ++i)
#pragma unroll
        for (int j = 0; j < 8; ++j) {
          const int col = n0 + wn * 128 + 16 * j + l15;
#pragma unroll
          for (int e = 0; e < 4; ++e) {
            const unsigned zo = ((unsigned)(m0 + wm * 64 + 16 * i + G * 4 + e) * 1024u + (unsigned)col) * 4u;
            *(float*)((char*)Z3 + zo) = acc[i][j][e];
            acc[i][j][e] = 0.f;
          }
        }
    }
    gemm_tile_wide((const u16*)(ws + OFF_H2B), 1024, m0, (const u16*)(ws + OFF_WPG_T), 1024, n0, 1024, acc, sA);
    {
      EPI_VARS
#pragma unroll
      for (int i = 0; i < 4; ++i)
#pragma unroll
        for (int j = 0; j < 8; ++j) {
          const int col = n0 + wn * 128 + 16 * j + l15;
#pragma unroll
          for (int e = 0; e < 4; ++e) {
            const unsigned zo = ((unsigned)(m0 + wm * 64 + 16 * i + G * 4 + e) * 1024u + (unsigned)col) * 4u;
            float* zp = (float*)((char*)Z3 + zo);
            *zp = *zp * sigm(acc[i][j][e]);
          }
        }
    }
  }
}

template <int MODE, int ZB>
__device__ __forceinline__ void phase_rownorm(const Params& P, const void* Zv, const float* w, const float* w2, u16* nxt) {
  const int tid = tid_(), lane = tid & 63, wave = tid >> 6;
  float* H = P.out;
  for (int un = bid_(); un < 4096; un += gridDim.x) {
    const long row = (long)un * 4 + wave;
    const float* zr = (const float*)Zv + row * 1024;
    const u16* zh = (const u16*)Zv + row * 1024;
    (void)zr; (void)zh;
    const float* hin = (MODE == 0) ? (P.x + row * 1024) : (H + row * 1024);
    float4 z[4], hv[4];
    float ss = 0.f;
#pragma unroll
    for (int j = 0; j < 4; ++j) {
      if (ZB) {
        const u32x2 zz = *(const u32x2*)(zh + j * 256 + lane * 4);
        z[j] = make_float4(__uint_as_float(zz[0] << 16), __uint_as_float(zz[0] & 0xffff0000u), __uint_as_float(zz[1] << 16), __uint_as_float(zz[1] & 0xffff0000u));
      } else z[j] = *(const float4*)(zr + j * 256 + lane * 4);
      hv[j] = *(const float4*)(hin + j * 256 + lane * 4);
      ss += z[j].x * z[j].x + z[j].y * z[j].y + z[j].z * z[j].z + z[j].w * z[j].w;
    }
#pragma unroll
    for (int o = 32; o >= 1; o >>= 1) ss += SHX(ss, o);
    const float r = rsqrtf(ss * (1.f / 1024.f) + 1e-6f);
    float s2 = 0.f;
#pragma unroll
    for (int j = 0; j < 4; ++j) {
      const float4 wv = *(const float4*)(w + j * 256 + lane * 4);
      hv[j].x += z[j].x * r * wv.x; hv[j].y += z[j].y * r * wv.y;
      hv[j].z += z[j].z * r * wv.z; hv[j].w += z[j].w * r * wv.w;
      s2 += hv[j].x * hv[j].x + hv[j].y * hv[j].y + hv[j].z * hv[j].z + hv[j].w * hv[j].w;
      *(float4*)(H + row * 1024 + j * 256 + lane * 4) = hv[j];
    }
    if (MODE == 0) {
#pragma unroll
      for (int o = 32; o >= 1; o >>= 1) s2 += SHX(s2, o);
      const float r2 = rsqrtf(s2 * (1.f / 1024.f) + 1e-6f);
#pragma unroll
      for (int j = 0; j < 4; ++j) {
        const float4 wv = *(const float4*)(w2 + j * 256 + lane * 4);
        u32x2 o2 = {pack2(hv[j].x * r2 * wv.x, hv[j].y * r2 * wv.y), pack2(hv[j].z * r2 * wv.z, hv[j].w * r2 * wv.w)};
        *(u32x2*)(nxt + row * 1024 + j * 256 + lane * 4) = o2;
      }
    } else if (MODE == 1) {
#pragma unroll
      for (int j = 0; j < 4; ++j) {
        u32x2 o2 = {pack2(hv[j].x, hv[j].y), pack2(hv[j].z, hv[j].w)};
        *(u32x2*)(nxt + row * 1024 + j * 256 + lane * 4) = o2;
      }
      const float4 pv = *(const float4*)(P.p + row * 256 + lane * 4);
      u32x2 o2 = {pack2(pv.x, pv.y), pack2(pv.z, pv.w)};
      *(u32x2*)((u16*)(P.ws + OFF_PB) + row * 256 + lane * 4) = o2;
    }
  }
}

#define XB_TMO      128
#define XB_XCNT(j)  (256  + 64 * (j))
#define XB_XSUB(j)  (1280 + 64 * (j))
#define XB_XGEN(j)  (2304 + 64 * (j))
#define XB_TOP      3328
#define XB_TOPGEN   3392
#define XCD_BAR_WORDS 3456
#define XB_SPIN_CAP (1u << 18)
#define LAS __attribute__((address_space(3)))

__device__ __forceinline__ unsigned xb_ld(unsigned* p)              { return __hip_atomic_load(p, __ATOMIC_RELAXED, __HIP_MEMORY_SCOPE_AGENT); }
__device__ __forceinline__ unsigned xb_add(unsigned* p, unsigned v) { return __hip_atomic_fetch_add(p, v, __ATOMIC_RELAXED, __HIP_MEMORY_SCOPE_AGENT); }
__device__ __forceinline__ unsigned xb_xcc_id() { return (unsigned)__builtin_amdgcn_s_getreg((3 << 11) | 20) & 0xFu; }
#define XB_SPIN(cond, bar) do { unsigned _sp = 0; while (cond) { __builtin_amdgcn_s_sleep(1); \
    if ((++_sp & 255u) == 0u) { if (xb_ld(&(bar)[XB_TMO])) break; if (_sp > XB_SPIN_CAP) { atomicAdd(&(bar)[XB_TMO], 1u); break; } } } } while (0)

struct XcdBarrier {
    unsigned* bar; unsigned x;
    volatile LAS unsigned* st;
};

__device__ __forceinline__ XcdBarrier xcd_barrier_post(unsigned* bar, volatile LAS unsigned* st) {
    XcdBarrier b; b.bar = bar; b.x = xb_xcc_id(); b.st = st;
    if (tid_() == 0) (void)xb_add(&bar[XB_XCNT(b.x)], 1u);
    return b;
}
__device__ __forceinline__ void xcd_barrier_complete(unsigned* bar, unsigned x, unsigned& nloc, unsigned& nx) {
    const unsigned G = gridDim.x * gridDim.y * gridDim.z;
    unsigned sum, cnt, mine, sp = 0u;
    for (;;) {
        sum = 0u; cnt = 0u; mine = 0u;
#pragma unroll
        for (unsigned j = 0; j < 16; ++j) { const unsigned c = xb_ld(&bar[XB_XCNT(j)]); sum += c; cnt += (c > 0u) ? 1u : 0u; mine = (j == x) ? c : mine; }
        if (sum == G) break;
        __builtin_amdgcn_s_sleep(1);
        if ((++sp & 255u) == 0u) { if (xb_ld(&bar[XB_TMO])) break; if (sp > XB_SPIN_CAP) { atomicAdd(&bar[XB_TMO], 1u); break; } }
    }
    nloc = mine > 0u ? mine : 1u; nx = cnt > 0u ? cnt : 1u;
}

__device__ __forceinline__ void xcd_barrier(const XcdBarrier& b) {
    asm volatile("s_waitcnt vmcnt(0)" ::: "memory");
    __syncthreads();
    if (tid_() == 0) {
        unsigned* bar = b.bar;
        __builtin_amdgcn_s_waitcnt(0);
        unsigned nloc = b.st[0], nx = b.st[1];
        if (nloc == 0u) { xcd_barrier_complete(bar, b.x, nloc, nx); b.st[0] = nloc; b.st[1] = nx; }
        const unsigned old = xb_add(&bar[XB_XSUB(b.x)], 1u);
        const unsigned gen = old / nloc;
        if (old + 1u == (gen + 1u) * nloc) {
            __builtin_amdgcn_fence(__ATOMIC_RELEASE, "agent");
            asm volatile("s_waitcnt vmcnt(0)" ::: "memory");
            const unsigned og = xb_add(&bar[XB_TOP], 1u);
            const unsigned tg = og / nx;
            if (og + 1u == (tg + 1u) * nx) xb_add(&bar[XB_TOPGEN], 1u);
            else XB_SPIN(xb_ld(&bar[XB_TOPGEN]) == tg, bar);
            __builtin_amdgcn_fence(__ATOMIC_ACQUIRE, "agent");
            xb_add(&bar[XB_XGEN(b.x)], 1u);
            asm volatile("s_waitcnt vmcnt(0)" ::: "memory");
        } else {
            XB_SPIN(xb_ld(&bar[XB_XGEN(b.x)]) == gen, bar);
            __builtin_amdgcn_fence(__ATOMIC_ACQUIRE, "agent");
            asm volatile("s_waitcnt vmcnt(0)" ::: "memory");
        }
    }
    __syncthreads();
}

#define OFF_BAR (252 * MIB)
#define GSYNC() do { XcdBarrier xb_; xb_.bar = (unsigned*)(P.ws + OFF_BAR); xb_.x = xb_xcc_id(); xb_.st = (volatile LAS unsigned*)&xb_words; xcd_barrier(xb_); } while (0)
__global__ void __launch_bounds__(256, 2) k_mega(Params P) {
  __shared__ __attribute__((aligned(16))) char smem[67584];
  char* ws = P.ws;
  __shared__ uint4 xb_words;
  if (tid_() == 0) xb_words = make_uint4(0u, 0u, 0u, 0u);
  __syncthreads();
  (void)xcd_barrier_post((unsigned*)(ws + OFF_BAR), (volatile LAS unsigned*)&xb_words);
  phase_prep(P, smem);
  GSYNC();
#pragma unroll 1
  for (int half = 0; half < 2; ++half) {
    phase_inproj_wide(P, half, smem);
    phase_inproj_narrow(P, half, smem);
    GSYNC();
#if PROBE_DUP == 1
    phase_inproj_wide(P, half, smem);
    phase_inproj_narrow(P, half, smem);
    GSYNC();
#endif
    if ((int)gridDim.x > 128) {
      const int b2 = bid_();
      if (b2 < 64) cmp_gemm1_tile(P, b2, smem);
      else for (int u = b2 - 64; u < 1024; u += (int)gridDim.x - 64) hgrn_intra_unit(P, u, smem);
    } else {
      for (int t = bid_(); t < 64; t += gridDim.x) cmp_gemm1_tile(P, t, smem);
      for (int u = bid_(); u < 1024; u += gridDim.x) hgrn_intra_unit(P, u, smem);
    }
    GSYNC();
    for (int t = bid_(); t < 32; t += gridDim.x) cmp_gemm2_tile(P, t, smem);
    hgrn_scan(P);
    if (half == 1) phase_late_weights(P, smem);
    GSYNC();
#if PROBE_DUP == 2
    for (int u = bid_(); u < 1024; u += gridDim.x) nsa_unit(P, half, u, smem);
    GSYNC();
#endif
    for (int u = bid_(); u < 1024; u += gridDim.x) nsa_unit(P, half, u, smem);
    for (int u = bid_(); u < 1024; u += gridDim.x) hgrn_out_unit(P, half, u, smem);
    GSYNC();
  }
  phase_branch_merge(P, smem);
  GSYNC();
#if PROBE_DUP == 3
  phase_branch_merge(P, smem);
  GSYNC();
  phase_gemm<2>((const u16*)(ws + OFF_MERGED), 1024, (const u16*)(ws + OFF_WOUT_T), 1024, ws + OFF_Z1, smem);
  GSYNC();
#endif
  phase_gemm_wide<2>((const u16*)(ws + OFF_MERGED), 1024, (const u16*)(ws + OFF_WOUT_T), 1024, (u16*)(ws + OFF_Z1), smem);
  GSYNC();
  phase_rownorm<0, 1>(P, (const void*)(ws + OFF_Z1), P.n_post_mix, P.n_pre_mlp, (u16*)(ws + OFF_V));
  GSYNC();
#if PROBE_DUP == 4
  phase_gemm<1>((const u16*)(ws + OFF_V), 1024, (const u16*)(ws + OFF_WUP_T), 4096, ws + OFF_FFH, smem);
  GSYNC();
#endif
  phase_gemm_wide<1>((const u16*)(ws + OFF_V), 1024, (const u16*)(ws + OFF_WUP_T), 4096, (u16*)(ws + OFF_FFH), smem);
  GSYNC();
#if PROBE_DUP == 4
  phase_gemm<2>((const u16*)(ws + OFF_FFH), 4096, (const u16*)(ws + OFF_WDOWN_T), 1024, ws + OFF_Z2, smem);
  GSYNC();
#endif
  phase_gemm_wide<2>((const u16*)(ws + OFF_FFH), 4096, (const u16*)(ws + OFF_WDOWN_T), 1024, (u16*)(ws + OFF_Z2), smem);
  GSYNC();
  phase_rownorm<1, 1>(P, (const void*)(ws + OFF_Z2), P.n_post_mlp, nullptr, (u16*)(ws + OFF_H2B));
  GSYNC();
  phase_ple(P, smem);
  GSYNC();
#if PROBE_DUP == 5
  for (int i = 0; i < 10; ++i) GSYNC();
#endif
#if PROBE_DUP == 6
  phase_prep(P, smem);
  GSYNC();
#endif
  phase_rownorm<2, 0>(P, (const void*)(P.ws + OFF_Z3), P.n_ple, nullptr, nullptr);
}

extern "C" void kernel_launch(void* const* d_in, const int* in_sizes, int n_in, void* d_out, int out_size, void* d_ws,
                              size_t ws_size, hipStream_t stream) {
  Params P{};
  P.x = (const float*)d_in[0];
  P.p = (const float*)d_in[1];
  P.w_in = (const float*)d_in[2];
  P.w_a = (const float*)d_in[3];
  P.w_b = (const float*)d_in[4];
  P.w_out = (const float*)d_in[5];
  P.n_pre_mix = (const float*)d_in[6];
  P.n_post_mix = (const float*)d_in[7];
  P.n_pre_mlp = (const float*)d_in[8];
  P.n_post_mlp = (const float*)d_in[9];
  P.lb_logits = (const float*)d_in[10];
  P.gnorm = (const float*)d_in[11];
  P.pe_k = (const float*)d_in[12];
  P.pe_v = (const float*)d_in[13];
  P.wk1 = (const float*)d_in[14];
  P.wk2 = (const float*)d_in[15];
  P.wv1 = (const float*)d_in[16];
  P.wv2 = (const float*)d_in[17];
  P.w_up = (const float*)d_in[18];
  P.w_down = (const float*)d_in[19];
  P.w_ple = (const float*)d_in[20];
  P.w_pg = (const float*)d_in[21];
  P.n_ple = (const float*)d_in[22];
  P.out = (float*)d_out;
  P.ws = (char*)d_ws;
#if MEGA
  static int grid_blocks = 0;
  if (!grid_blocks) {
    int dev = 0, cus = 0, per_cu = 0;
    hipGetDevice(&dev);
    hipDeviceGetAttribute(&cus, hipDeviceAttributeMultiprocessorCount, dev);
    hipOccupancyMaxActiveBlocksPerMultiprocessor(&per_cu, k_mega, 256, 0);
    if (per_cu > 2) per_cu = 2;
    if (per_cu < 1) per_cu = 1;
    grid_blocks = cus * per_cu;
  }
  hipMemsetAsync((char*)d_ws + OFF_BAR, 0, XCD_BAR_WORDS * sizeof(unsigned), stream);
  void* args[] = {&P};
  hipError_t e = hipLaunchCooperativeKernel((void*)k_mega, dim3(grid_blocks), dim3(256), args, 0, stream);
  if (e != hipSuccess) fprintf(stderr, "cooperative launch failed: %s (grid %d)\n", hipGetErrorString(e), grid_blocks);
#endif
}
```

```cpp
#include <hip/hip_runtime.h>
#include <hip/hip_cooperative_groups.h>
#include <cstdio>
#include <cstdint>
namespace cg = cooperative_groups;

#ifndef MEGA
#define MEGA 1
#endif
#ifndef PROBE_DUP
#define PROBE_DUP 0
#endif

typedef unsigned short u16;
typedef __attribute__((ext_vector_type(8))) short bf16x8;
typedef __attribute__((ext_vector_type(4))) float f32x4;
typedef __attribute__((ext_vector_type(4))) unsigned u32x4;
typedef __attribute__((ext_vector_type(2))) unsigned u32x2;

#define MFMA(a, b, c) __builtin_amdgcn_mfma_f32_16x16x32_bf16(a, b, c, 0, 0, 0)
#define MIB ((size_t)1 << 20)

#define OFF_U       (0 * MIB)
#define OFF_YB0     (0 * MIB)
#define OFF_WA_T    (16 * MIB)
#define OFF_WB_T    (18 * MIB)
#define OFF_WOUT_T  (20 * MIB)
#define OFF_WPG_T   (22 * MIB)
#define OFF_WPLE_T  (24 * MIB)
#define OFF_WIN_T   (32 * MIB)
#define OFF_WUP_T   (32 * MIB)
#define OFF_WDOWN_T (40 * MIB)
#define OFF_WK1T    (50 * MIB)
#define OFF_WV1T    (51 * MIB)
#define OFF_WK2T    (52 * MIB)
#define OFF_WV2T    (52 * MIB + 32768)
#define OFF_ROPE    (52 * MIB + 65536)
#define OFF_BIAS1   (52 * MIB + 65536 + 262144)
#define OFF_LB      (52 * MIB + 65536 + 262144 + 4096)
#define OFF_BIAS1P  (52 * MIB + 65536 + 262144 + 16384)
#define OFF_NGATE   (53 * MIB)
#define OFF_SG      (56 * MIB)
#define OFF_NQ      (88 * MIB)
#define OFF_QF      (120 * MIB)
#define OFF_LOGF    (136 * MIB)
#define OFF_YB1     (136 * MIB)
#define OFF_HVT     (152 * MIB)
#define OFF_ABUF    (168 * MIB)
#define OFF_UST     (176 * MIB)
#define OFF_KV      (208 * MIB)
#define OFF_NQR     (224 * MIB)
#define OFF_VST     (228 * MIB)
#define OFF_VWT     (232 * MIB)
#define OFF_DCY     (236 * MIB)
#define OFF_HIDK    (236 * MIB + 524288)
#define OFF_HIDV    (237 * MIB + 524288)
#define OFF_KCMP    (238 * MIB + 524288)
#define OFF_VCMPT   (238 * MIB + 524288 + 262144)
#define OFF_MERGED  (88 * MIB)
#define OFF_Z1      (152 * MIB)
#define OFF_V       (56 * MIB)
#define OFF_FFH     (120 * MIB)
#define OFF_Z2      (56 * MIB)
#define OFF_H2B     (120 * MIB)
#define OFF_PB      (152 * MIB)
#define OFF_Z3      (160 * MIB)

struct Params {
  const float *x, *p, *w_in, *w_a, *w_b, *w_out, *n_pre_mix, *n_post_mix, *n_pre_mlp, *n_post_mlp;
  const float *lb_logits, *gnorm, *pe_k, *pe_v, *wk1, *wk2, *wv1, *wv2, *w_up, *w_down, *w_ple, *w_pg, *n_ple;
  float* out;
  char* ws;
};

__device__ __forceinline__ int bid_() { int b = blockIdx.x; asm volatile("" : "+s"(b)); return b; }
__device__ __forceinline__ int tid_() { int t = threadIdx.x; asm volatile("" : "+v"(t)); return t; }
typedef __attribute__((ext_vector_type(2))) float f32x2_t;
typedef __attribute__((ext_vector_type(2))) __bf16 bf16x2_t;
__device__ __forceinline__ uint32_t pack2(float a, float b) {
  f32x2_t v = {a, b};
  return __builtin_bit_cast(uint32_t, __builtin_convertvector(v, bf16x2_t));
}
__device__ __forceinline__ u16 f2bf(float f) { return (u16)(pack2(f, f) & 0xffffu); }
__device__ __forceinline__ float bf2f(u16 h) { return __uint_as_float(((uint32_t)h) << 16); }
__device__ __forceinline__ float shx_f(float v, int src_lane) { return __int_as_float(__builtin_amdgcn_ds_bpermute(src_lane << 2, __float_as_int(v))); }
__device__ __forceinline__ uint32_t shx_u(uint32_t v, int src_lane) { return (uint32_t)__builtin_amdgcn_ds_bpermute(src_lane << 2, (int)v); }
#define SHX(v, m) shx_f((v), lane ^ (m))
#define SHXU(v, m) shx_u((v), lane ^ (m))
__device__ __forceinline__ float sigm(float x) { return __builtin_amdgcn_rcpf(1.f + __expf(-x)); }
__device__ __forceinline__ float siluf(float x) { return x * __builtin_amdgcn_rcpf(1.f + __expf(-x)); }
__device__ __forceinline__ float gelu_tanh(float x) {
  float u = 0.7978845608028654f * (x + 0.044715f * x * x * x);
  float t = 1.f - 2.f * __builtin_amdgcn_rcpf(__expf(2.f * u) + 1.f);
  return 0.5f * x * (1.f + t);
}
__device__ __forceinline__ bf16x8 mk8(uint32_t a, uint32_t b, uint32_t c, uint32_t d) {
  u32x4 v = {a, b, c, d};
  return __builtin_bit_cast(bf16x8, v);
}
__device__ __forceinline__ bf16x8 ld8(const u16* p) { return *(const bf16x8*)p; }

template <int AMODE, int DEEP>
__device__ __forceinline__ void gemm_tile(const u16* __restrict__ A, long lda, int m0, int M,
                                          const u16* __restrict__ Bt, long ldb, int n0, int N, int K,
                                          int coloff, f32x4 (&acc)[4][4], u16* sA, u16* sB) {
  const int tid = tid_(), lane = tid & 63, wave = tid >> 6;
  const int l15 = lane & 15, G = lane >> 4;
  const int wm = wave >> 1, wn = wave & 1;
  const int lr = tid >> 3, ch = tid & 7;
  const char* Ab = (const char*)A;
  const char* Bb = (const char*)Bt;
  unsigned oa[4], ob[4];
  int tok0[4];
#pragma unroll
  for (int i = 0; i < 4; ++i) {
    int r = m0 + lr + 32 * i;
    if (AMODE == 0) {
      if (r > M - 1) r = M - 1;
      oa[i] = (unsigned)(((long)r * lda + ch * 8) * 2);
      tok0[i] = 0;
    } else {
      int grp = r >> 8, n = r & 255;
      int bl = grp >> 2, g = grp & 3;
      tok0[i] = n * 16;
      oa[i] = (unsigned)((bl * 4096 * 1024 + coloff + g * 64 + ch * 8) * 2);
    }
    int rn = n0 + lr + 32 * i;
    if (rn > N - 1) rn = N - 1;
    ob[i] = (unsigned)(((long)rn * ldb + ch * 8) * 2);
  }
#define G_LOAD(RA, RB, KT)                                                                                   \
  {                                                                                                          \
    const char* Ak_ = Ab + (size_t)(KT) * 128;                                                               \
    const char* Bk_ = Bb + (size_t)(KT) * 128;                                                               \
    _Pragma("unroll") for (int i = 0; i < 4; ++i) {                                                          \
      if (AMODE == 0) RA[i] = *(const u32x4*)(Ak_ + oa[i]);                                                  \
      else { int tok = tok0[i] + (KT); if (tok > 4095) tok = 4095; RA[i] = *(const u32x4*)(Ab + (oa[i] + (unsigned)tok * 2048u)); } \
      RB[i] = *(const u32x4*)(Bk_ + ob[i]);                                                                  \
    }                                                                                                        \
  }
#define L_STORE(RA, RB)                                                                                      \
  _Pragma("unroll") for (int i = 0; i < 4; ++i) {                                                            \
    *(u32x4*)&sA[(lr + 32 * i) * 80 + ch * 8] = RA[i];                                                       \
    *(u32x4*)&sB[(lr + 32 * i) * 80 + ch * 8] = RB[i];                                                       \
  }
#define T_COMPUTE()                                                                                          \
  _Pragma("unroll") for (int ks = 0; ks < 2; ++ks) {                                                         \
    bf16x8 af[4], bfr[4];                                                                                    \
    _Pragma("unroll") for (int i = 0; i < 4; ++i) af[i] = ld8(&sA[(wm * 64 + 16 * i + l15) * 80 + ks * 32 + G * 8]);  \
    _Pragma("unroll") for (int j = 0; j < 4; ++j) bfr[j] = ld8(&sB[(wn * 64 + 16 * j + l15) * 80 + ks * 32 + G * 8]); \
    _Pragma("unroll") for (int i = 0; i < 4; ++i)                                                            \
      _Pragma("unroll") for (int j = 0; j < 4; ++j) acc[i][j] = MFMA(af[i], bfr[j], acc[i][j]);              \
  }                                                                                                          \
     \
  __builtin_amdgcn_sched_group_barrier(0x100, 8, 0);                                                         \
  _Pragma("unroll") for (int z = 0; z < 8; ++z) {                                                            \
    __builtin_amdgcn_sched_group_barrier(0x008, 2, 0);                                                       \
    __builtin_amdgcn_sched_group_barrier(0x100, 1, 0);                                                       \
  }                                                                                                          \
  __builtin_amdgcn_sched_group_barrier(0x008, 16, 0);
  const int nk = K >> 6;
  if (DEEP == 2) {
    u32x4 ra0[4], rb0[4], ra1[4], rb1[4];
    const int kl = nk - 1;
    G_LOAD(ra0, rb0, 0);
    G_LOAD(ra1, rb1, 1);
    for (int kt = 0; kt < nk; kt += 2) {
      L_STORE(ra0, rb0);
      __syncthreads();
      G_LOAD(ra0, rb0, (kt + 2 < kl ? kt + 2 : kl));
      T_COMPUTE();
      __syncthreads();
      L_STORE(ra1, rb1);
      __syncthreads();
      G_LOAD(ra1, rb1, (kt + 3 < kl ? kt + 3 : kl));
      T_COMPUTE();
      __syncthreads();
    }
  } else {
    u32x4 ra0[4], rb0[4];
    G_LOAD(ra0, rb0, 0);
    for (int kt = 0; kt < nk; ++kt) {
      L_STORE(ra0, rb0);
      __syncthreads();
      if (kt + 1 < nk) G_LOAD(ra0, rb0, kt + 1);
      T_COMPUTE();
      __syncthreads();
    }
  }
#undef G_LOAD
#undef L_STORE
#undef T_COMPUTE
}

__device__ __forceinline__ void zero_acc(f32x4 (&acc)[4][4]) {
#pragma unroll
  for (int i = 0; i < 4; ++i)
#pragma unroll
    for (int j = 0; j < 4; ++j) acc[i][j] = (f32x4){0.f, 0.f, 0.f, 0.f};
}

#define EPI_VARS                                                         \
  const int tid = tid_(), lane = tid & 63, wave = tid >> 6;         \
  const int l15 = lane & 15, G = lane >> 4;                              \
  const int wm = wave >> 1, wn = wave & 1;                               \
  (void)l15; (void)G; (void)wm; (void)wn;

__device__ __forceinline__ void transpose_tile(const float* __restrict__ W, int ldw, int oc0, int valid, int k0, u16* __restrict__ out,
                               long Kdim, int n0, float* s  ) {
  const int tid = tid_();
  __syncthreads();
  {
    const bool vec = (valid == 64) && (((oc0 | ldw) & 3) == 0);
    if (vec) {
      const int n4 = (tid & 15) * 4;
      float4 v[4];
#pragma unroll
      for (int i = 0; i < 4; ++i) v[i] = *(const float4*)(W + (long)(k0 + (tid >> 4) + 16 * i) * ldw + oc0 + n4);
#pragma unroll
      for (int i = 0; i < 4; ++i) {
        float* d = &s[((tid >> 4) + 16 * i) * 65 + n4];
        d[0] = v[i].x; d[1] = v[i].y; d[2] = v[i].z; d[3] = v[i].w;
      }
    } else {
      const int n = tid & 63;
      for (int kk = tid >> 6; kk < 64; kk += 4) {
        float v = 0.f;
        if (n < valid) v = W[(long)(k0 + kk) * ldw + oc0 + n];
        s[kk * 65 + n] = v;
      }
    }
  }
  __syncthreads();
  {
    const int nn = tid >> 2, kq = (tid & 3) * 16;
    uint32_t w[8];
#pragma unroll
    for (int e = 0; e < 8; ++e) w[e] = pack2(s[(kq + 2 * e) * 65 + nn], s[(kq + 2 * e + 1) * 65 + nn]);
    u16* dst = out + (long)(n0 + nn) * Kdim + k0 + kq;
    *(u32x4*)dst = (u32x4){w[0], w[1], w[2], w[3]};
    *(u32x4*)(dst + 8) = (u32x4){w[4], w[5], w[6], w[7]};
  }
}

__device__ __forceinline__ void transpose_job(const float* W, int N, int K, u16* out, int tile, float* s) {
  const int kt_n = K >> 6;
  const int nt = tile / kt_n, kt = tile % kt_n;
  transpose_tile(W, N, nt * 64, 64, kt * 64, out, K, nt * 64, s);
}

__device__ __forceinline__ void phase_prep(const Params& P, char* smem) {
  const int tid = tid_(), lane = tid & 63, wave = tid >> 6;
  char* ws = P.ws;
  float* sf = (float*)smem;
  {
    u16* U = (u16*)(ws + OFF_U);
    for (int un = bid_(); un < 2048; un += gridDim.x) {
      const int row0 = un * 8 + wave * 2;
      float4 v[2][4];
      float ss[2] = {0.f, 0.f};
#pragma unroll
      for (int rr = 0; rr < 2; ++rr)
#pragma unroll
        for (int j = 0; j < 4; ++j) v[rr][j] = *(const float4*)(P.x + (long)(row0 + rr) * 1024 + j * 256 + lane * 4);
#pragma unroll
      for (int rr = 0; rr < 2; ++rr) {
#pragma unroll
        for (int j = 0; j < 4; ++j)
          ss[rr] += v[rr][j].x * v[rr][j].x + v[rr][j].y * v[rr][j].y + v[rr][j].z * v[rr][j].z + v[rr][j].w * v[rr][j].w;
#pragma unroll
        for (int o = 32; o >= 1; o >>= 1) ss[rr] += SHX(ss[rr], o);
        const float r = rsqrtf(ss[rr] * (1.f / 1024.f) + 1e-6f);
#pragma unroll
        for (int j = 0; j < 4; ++j) {
          const float4 w = *(const float4*)(P.n_pre_mix + j * 256 + lane * 4);
          u32x2 o2 = {pack2(v[rr][j].x * r * w.x, v[rr][j].y * r * w.y), pack2(v[rr][j].z * r * w.z, v[rr][j].w * r * w.w)};
          *(u32x2*)(U + (long)(row0 + rr) * 1024 + j * 256 + lane * 4) = o2;
        }
      }
    }
  }
  {
    u16* WT = (u16*)(ws + OFF_WIN_T);
    for (int t = bid_(); t < 138 * 16; t += gridDim.x) {
      const int nt = t >> 4, kt = t & 15;
      const int nr0 = nt * 64;
      int oc0, valid;
      if (nr0 < 6656) { oc0 = nr0; valid = 64; }
      else if (nr0 < 8704) { oc0 = nr0 + 48; valid = 64; }
      else if (nr0 == 8704) { oc0 = 6656; valid = 48; }
      else { oc0 = 0; valid = 0; }
      transpose_tile(P.w_in, 8752, oc0, valid, kt * 64, WT, 1024, nr0, sf);
    }
    for (int t = bid_(); t < 128; t += gridDim.x) transpose_job(P.wk1, 256, 2048, (u16*)(ws + OFF_WK1T), t, sf);
    for (int t = bid_(); t < 128; t += gridDim.x) transpose_job(P.wv1, 256, 2048, (u16*)(ws + OFF_WV1T), t, sf);
    for (int t = bid_(); t < 4; t += gridDim.x) transpose_job(P.wk2, 64, 256, (u16*)(ws + OFF_WK2T), t, sf);
    for (int t = bid_(); t < 4; t += gridDim.x) transpose_job(P.wv2, 64, 256, (u16*)(ws + OFF_WV2T), t, sf);
  }
  {
    float2* RT = (float2*)(ws + OFF_ROPE);
    for (int un = bid_(); un < 128; un += gridDim.x) {
      const int idx = un * 256 + tid;
      const int t = idx >> 3, j = idx & 7;
      const float inv = (j == 0) ? 1.0f : (j == 1) ? 0.1939227432012558f : (j == 2) ? 0.03760603070259094f
                      : (j == 3) ? 0.007292664609849453f : (j == 4) ? 0.0014142135623842478f
                      : (j == 5) ? 0.00027424818836152554f : (j == 6) ? 5.3182957344688475e-05f : 1.0313385246263351e-05f;
      const float ang = (float)t * inv;
      const double ad = (double)ang;
      const double kq = rint(ad * 0.15915494309189535);
      const float rr = (float)(ad - kq * 6.283185307179586);
      float sn, cs;
      sincosf(rr, &sn, &cs);
      RT[idx] = make_float2(cs, sn);
    }
  }
  {
    float* B1P = (float*)(ws + OFF_BIAS1P);
    for (int un = bid_(); un < 16; un += gridDim.x) {
      const int kvi = un >> 3, part = un & 7;
      const float* pe = kvi ? P.pe_v : P.pe_k;
      const float* w1 = kvi ? P.wv1 : P.wk1;
      float4 a = make_float4(0.f, 0.f, 0.f, 0.f);
      const int k0 = part * 256 + wave * 64;
#pragma unroll 8
      for (int k = k0; k < k0 + 64; ++k) {
        const float pv = pe[k];
        const float4 w = *(const float4*)(w1 + (long)k * 256 + lane * 4);
        a.x += pv * w.x; a.y += pv * w.y; a.z += pv * w.z; a.w += pv * w.w;
      }
      __syncthreads();
      *(float4*)&sf[wave * 256 + lane * 4] = a;
      __syncthreads();
      B1P[un * 256 + tid] = sf[tid] + sf[256 + tid] + sf[512 + tid] + sf[768 + tid];
      __syncthreads();
    }
  }
  {
    float* LB = (float*)(ws + OFF_LB);
    for (int un = bid_(); un < 4; un += gridDim.x) {
      const int c = un * 256 + tid;
      const float l0 = P.lb_logits[c], l1 = P.lb_logits[1024 + c];
      LB[c] = 1.f / (1.f + expf(l1 - l0));
    }
  }
}

__device__ __forceinline__ void phase_late_weights(const Params& P, char* smem) {
  char* ws = P.ws;
  float* sf = (float*)smem;
  for (int t = bid_(); t < 256; t += gridDim.x) transpose_job(P.w_a, 1024, 1024, (u16*)(ws + OFF_WA_T), t, sf);
  for (int t = bid_(); t < 256; t += gridDim.x) transpose_job(P.w_b, 1024, 1024, (u16*)(ws + OFF_WB_T), t, sf);
  for (int t = bid_(); t < 256; t += gridDim.x) transpose_job(P.w_out, 1024, 1024, (u16*)(ws + OFF_WOUT_T), t, sf);
  for (int t = bid_(); t < 256; t += gridDim.x) transpose_job(P.w_pg, 1024, 1024, (u16*)(ws + OFF_WPG_T), t, sf);
  for (int t = bid_(); t < 1024; t += gridDim.x) transpose_job(P.w_up, 4096, 1024, (u16*)(ws + OFF_WUP_T), t, sf);
  for (int t = bid_(); t < 1024; t += gridDim.x) transpose_job(P.w_down, 1024, 4096, (u16*)(ws + OFF_WDOWN_T), t, sf);
  for (int t = bid_(); t < 64; t += gridDim.x) transpose_job(P.w_ple, 1024, 256, (u16*)(ws + OFF_WPLE_T), t, sf);
}

__device__ __forceinline__ void phase_inproj(const Params& P, int half, char* smem) {
  char* ws = P.ws;
  u16* sA = (u16*)smem;
  u16* sB = sA + 128 * 80;
  const u16* U = (const u16*)(ws + OFF_U) + (long)half * 8192 * 1024;
  const u16* WT = (const u16*)(ws + OFF_WIN_T);
  u16* QF = (u16*)(ws + OFF_QF);
  _Float16* LOGF = (_Float16*)(ws + OFF_LOGF);
  u16* HVT = (u16*)(ws + OFF_HVT);
  u16* SG = (u16*)(ws + OFF_SG) + (long)half * 8192 * 1024;
  u16* NQ = (u16*)(ws + OFF_NQ) + (long)half * 8192 * 1024;
  u16* NQR = (u16*)(ws + OFF_NQR);
  u16* KV = (u16*)(ws + OFF_KV);
  u16* VST = (u16*)(ws + OFF_VST);
  u16* VWT = (u16*)(ws + OFF_VWT);
  u16* GATES = (u16*)P.out + (long)half * 8192 * 2048;
  float* NGATE = (float*)(ws + OFF_NGATE) + (long)half * 8192 * 48;
  const float2* RT = (const float2*)(ws + OFF_ROPE);
  const float* LB = (const float*)(ws + OFF_LB);
  EPI_VARS
  for (int t = bid_(); t < 64 * 69; t += gridDim.x) {
    const int nt = t >> 6, mt = t & 63;
    const int m0 = mt * 128, n0 = nt * 128;
    f32x4 acc[4][4];
    zero_acc(acc);
    gemm_tile<0, 2>(U, 1024, m0, 8192, WT, 1024, n0, 8832, 1024, 0, acc, sA, sB);
    u16* sT = sA;
    u16* dbase = nullptr;
    int dstride = 1024, dcol = 0;
    bool staged = true;
    if (nt < 8) { dbase = QF; dcol = n0; }
    else if (nt < 16) { dbase = (u16*)LOGF; dcol = n0 - 1024; }
    else if (nt < 24) staged = false;
    else if (nt < 32) { dbase = SG; dcol = n0 - 3072; }
    else if (nt < 40) { dbase = NQ; dcol = n0 - 4096; }
    else if (nt < 52) {
      const int c0 = n0 - 5120, sub0 = c0 >> 8;
      if (sub0 == 3 || sub0 == 5) staged = false;
      else { dbase = KV; dcol = ((sub0 == 0) ? 0 : (sub0 == 1) ? 256 : (sub0 == 2) ? 512 : 768) + (c0 & 255); }
    } else if (nt < 68) { dbase = GATES; dstride = 2048; dcol = n0 - 6656; }
    else staged = false;
#pragma unroll
    for (int i = 0; i < 4; ++i) {
      const int rbase = m0 + wm * 64 + 16 * i + G * 4;
#pragma unroll
      for (int j = 0; j < 4; ++j) {
        const int col = n0 + wn * 64 + 16 * j + l15;
        const f32x4 a = acc[i][j];
        if (nt < 8) {
#pragma unroll
          for (int e = 0; e < 4; ++e) sT[(wm * 64 + 16 * i + G * 4 + e) * 136 + wn * 64 + 16 * j + l15] = f2bf(siluf(a[e]) * 0.08838834764831845f);
        } else if (nt < 16) {
          const int c = col - 1024;
          const float lbv = LB[c];
#pragma unroll
          for (int e = 0; e < 4; ++e) {
            const float f = lbv + (1.f - lbv) * sigm(a[e]);
            sT[(wm * 64 + 16 * i + G * 4 + e) * 136 + wn * 64 + 16 * j + l15] = __builtin_bit_cast(u16, (_Float16)logf(f));
          }
        } else if (nt < 24) {
          const int c = col - 2048;
          const int h = c >> 7, dv = c & 127;
          const int bl = rbase >> 12, tt = rbase & 4095;
          const int cidx = tt >> 6, s = tt & 63;
          const long uu = (long)(bl * 8 + h) * 64 + cidx;
          u32x2 o2 = {pack2(a[0], a[1]), pack2(a[2], a[3])};
          *(u32x2*)(HVT + (uu * 128 + dv) * 64 + s) = o2;
        } else if (nt < 32) {
          const int c = col - 3072;
#pragma unroll
          for (int e = 0; e < 4; ++e) sT[(wm * 64 + 16 * i + G * 4 + e) * 136 + wn * 64 + 16 * j + l15] = f2bf(siluf(a[e]));
        } else if (nt < 40) {
          const int c = col - 4096;
#pragma unroll
          for (int e = 0; e < 4; ++e) {
            const float v = a[e] * 0.18033688011112042f;
            sT[(wm * 64 + 16 * i + G * 4 + e) * 136 + wn * 64 + 16 * j + l15] = f2bf(v);
            if (j == 0) {
              const float pr = SHX(v, 8);
              const int tt = (rbase + e) & 4095;
              const float2 cs = RT[tt * 8 + (l15 & 7)];
              const float o = (l15 < 8) ? (v * cs.x - pr * cs.y) : (v * cs.x + pr * cs.y);
              NQR[(long)(rbase + e) * 256 + (c >> 6) * 16 + l15] = f2bf(o);
            }
          }
        } else if (nt < 52) {
          const int c = col - 5120;
          const int sub = c >> 8, cc = c & 255;
          if (sub == 0 || sub == 1) {
#pragma unroll
            for (int e = 0; e < 4; ++e) sT[(wm * 64 + 16 * i + G * 4 + e) * 136 + wn * 64 + 16 * j + l15] = f2bf(a[e]);
          } else if (sub == 2 || sub == 4) {
            const int dst = (sub == 2) ? 512 : 768;
#pragma unroll
            for (int e = 0; e < 4; ++e) {
              float v = a[e];
              if (j == 0) {
                const float pr = SHX(v, 8);
                const int tt = (rbase + e) & 4095;
                const float2 cs = RT[tt * 8 + (l15 & 7)];
                v = (l15 < 8) ? (v * cs.x - pr * cs.y) : (v * cs.x + pr * cs.y);
              }
              sT[(wm * 64 + 16 * i + G * 4 + e) * 136 + wn * 64 + 16 * j + l15] = f2bf(v);
            }
          } else {
            u16* VT = (sub == 3) ? VST : VWT;
            const int g = cc >> 6, d = cc & 63;
            const int bl = rbase >> 12, tt = rbase & 4095;
            u32x2 o2 = {pack2(a[0], a[1]), pack2(a[2], a[3])};
            *(u32x2*)(VT + ((long)(bl * 4 + g) * 64 + d) * 4096 + tt) = o2;
          }
        } else if (nt < 68) {
          const int c = col - 6656;
#pragma unroll
          for (int e = 0; e < 4; ++e) sT[(wm * 64 + 16 * i + G * 4 + e) * 136 + wn * 64 + 16 * j + l15] = f2bf(sigm(a[e]));
        } else {
          const int c = col - 8704;
          if (c < 48) {
#pragma unroll
            for (int e = 0; e < 4; ++e) NGATE[(long)(rbase + e) * 48 + c] = sigm(a[e]);
          }
        }
      }
    }
    if (staged) {
      __syncthreads();
      const int tc = tid_();
#pragma unroll
      for (int k8 = 0; k8 < 8; ++k8) {
        const int id = tc + 256 * k8;
        const int row = id >> 4, cch = (id & 15) * 8;
        *(u32x4*)(dbase + (long)(m0 + row) * dstride + dcol + cch) = *(const u32x4*)&sT[row * 136 + cch];
      }
      __syncthreads();
    }
  }
}

__device__ __forceinline__ void hgrn_intra_unit(const Params& P, int uu, char* smem) {
  char* ws = P.ws;
  const int tid = tid_(), lane = tid & 63, wave = tid >> 6;
  const int l15 = lane & 15, G = lane >> 4;
  float* sBc = (float*)smem;
  u16* sQ = (u16*)(smem + 64 * 132 * 4);
  const int bl = uu >> 9, h = (uu >> 6) & 7, c = uu & 63;
  const long r0 = (long)bl * 4096 + c * 64;
  u16* QF = (u16*)(ws + OFF_QF);
  const _Float16* LOGF = (const _Float16*)(ws + OFF_LOGF);
  const u16* HVT = (const u16*)(ws + OFF_HVT);
  u16* ABUF = (u16*)(ws + OFF_ABUF);
  u16* UST = (u16*)(ws + OFF_UST);
  float* DCY = (float*)(ws + OFF_DCY);

  __syncthreads();
#pragma unroll
  for (int i = 0; i < 4; ++i) {
    const int id = tid + 256 * i;
    const int row = id >> 4, cc = (id & 15) * 8;
    const u32x4 lf = *(const u32x4*)(LOGF + (r0 + row) * 1024 + h * 128 + cc);
    const _Float16* hp = (const _Float16*)&lf;
#pragma unroll
    for (int e = 0; e < 8; ++e) sBc[row * 132 + cc + e] = (float)hp[e];
    *(u32x4*)&sQ[row * 136 + cc] = *(const u32x4*)(QF + (r0 + row) * 1024 + h * 128 + cc);
  }
  __syncthreads();
  if (tid < 128) {
    float run = 0.f;
    for (int s = 0; s < 64; ++s) {
      run += sBc[s * 132 + tid];
      sBc[s * 132 + tid] = run;
    }
  }
  __syncthreads();
#pragma unroll
  for (int i = 0; i < 4; ++i) {
    const int id = tid + 256 * i;
    const int row = id >> 4, cc = (id & 15) * 8;
    uint32_t w[4];
#pragma unroll
    for (int e = 0; e < 4; ++e) {
      const float q0 = bf2f(sQ[row * 136 + cc + 2 * e]) * __expf(sBc[row * 132 + cc + 2 * e]);
      const float q1 = bf2f(sQ[row * 136 + cc + 2 * e + 1]) * __expf(sBc[row * 132 + cc + 2 * e + 1]);
      w[e] = pack2(q0, q1);
    }
    *(u32x4*)(QF + (r0 + row) * 1024 + h * 128 + cc) = (u32x4){w[0], w[1], w[2], w[3]};
  }
  if (tid < 128) DCY[(long)uu * 128 + tid] = __expf(sBc[63 * 132 + tid]);
  for (int idx = tid; idx < 4096; idx += 256) {
    const int t = idx >> 6, s = idx & 63;
    if ((s >> 4) > (t >> 4)) ABUF[(long)uu * 4096 + idx] = 0;
  }
  for (int ti = wave; ti < 10; ti += 4) {
    int i, j;
    if (ti == 0) { i = 0; j = 0; }
    else if (ti < 3) { i = 1; j = ti - 1; }
    else if (ti < 6) { i = 2; j = ti - 3; }
    else { i = 3; j = ti - 6; }
    f32x4 a4 = {0.f, 0.f, 0.f, 0.f};
    const int t = 16 * i + l15, s = 16 * j + l15;
#pragma unroll
    for (int ks = 0; ks < 4; ++ks) {
      const int dk0 = ks * 32 + G * 8;
      uint32_t aw[4], bw[4];
#pragma unroll
      for (int e2 = 0; e2 < 4; ++e2) {
        float av[2], bv[2];
#pragma unroll
        for (int z = 0; z < 2; ++z) {
          const int dk = dk0 + 2 * e2 + z;
          const float br = sBc[(16 * i) * 132 + dk];
          const float bt = sBc[t * 132 + dk];
          av[z] = bf2f(sQ[t * 136 + dk]) * __expf(bt - br);
          const float bs = sBc[s * 132 + dk];
          const float bp = (s > 0) ? sBc[(s - 1) * 132 + dk] : 0.f;
          const float kk = 1.f - __expf(bs - bp);
          bv[z] = kk * __expf(br - bs);
        }
        aw[e2] = pack2(av[0], av[1]);
        bw[e2] = pack2(bv[0], bv[1]);
      }
      a4 = MFMA(mk8(aw[0], aw[1], aw[2], aw[3]), mk8(bw[0], bw[1], bw[2], bw[3]), a4);
    }
#pragma unroll
    for (int e = 0; e < 4; ++e) {
      const int tr = 16 * i + G * 4 + e, sc = 16 * j + l15;
      const float v = (sc <= tr) ? a4[e] : 0.f;
      ABUF[(long)uu * 4096 + tr * 64 + sc] = f2bf(v);
    }
  }
  {
    f32x4 ua[8][2];
#pragma unroll
    for (int rt = 0; rt < 8; ++rt) { ua[rt][0] = (f32x4){0.f, 0.f, 0.f, 0.f}; ua[rt][1] = (f32x4){0.f, 0.f, 0.f, 0.f}; }
#pragma unroll
    for (int ks = 0; ks < 2; ++ks) {
      bf16x8 bfr[2];
#pragma unroll
      for (int ct = 0; ct < 2; ++ct) {
        const int dk = (2 * wave + ct) * 16 + l15;
        const float blast = sBc[63 * 132 + dk];
        const int s0 = ks * 32 + G * 8;
        float prev = (s0 > 0) ? sBc[(s0 - 1) * 132 + dk] : 0.f;
        uint32_t bw[4];
#pragma unroll
        for (int e2 = 0; e2 < 4; ++e2) {
          const float b0 = sBc[(s0 + 2 * e2) * 132 + dk];
          const float b1 = sBc[(s0 + 2 * e2 + 1) * 132 + dk];
          const float k0 = (1.f - __expf(b0 - prev)) * __expf(blast - b0);
          const float k1 = (1.f - __expf(b1 - b0)) * __expf(blast - b1);
          prev = b1;
          bw[e2] = pack2(k0, k1);
        }
        bfr[ct] = mk8(bw[0], bw[1], bw[2], bw[3]);
      }
#pragma unroll
      for (int rt = 0; rt < 8; ++rt) {
        const int dv = rt * 16 + l15;
        const bf16x8 af = ld8(HVT + ((long)uu * 128 + dv) * 64 + ks * 32 + G * 8);
        ua[rt][0] = MFMA(af, bfr[0], ua[rt][0]);
        ua[rt][1] = MFMA(af, bfr[1], ua[rt][1]);
      }
    }
#pragma unroll
    for (int rt = 0; rt < 8; ++rt)
#pragma unroll
      for (int ct = 0; ct < 2; ++ct)
#pragma unroll
        for (int e = 0; e < 4; ++e) {
          const int dv = rt * 16 + G * 4 + e, dk = (2 * wave + ct) * 16 + l15;
          UST[((long)uu * 128 + dv) * 128 + dk] = f2bf(ua[rt][ct][e]);
        }
  }
}

__device__ __forceinline__ void cmp_gemm1_tile(const Params& P, int t, char* smem) {
  char* ws = P.ws;
  u16* sA = (u16*)smem;
  u16* sB = sA + 128 * 80;
  EPI_VARS
  const int kv = t >> 5, rem = t & 31;
  const int mt = rem >> 1, nt = rem & 1;
  const int m0 = mt * 128, n0 = nt * 128;
  const u16* KV = (const u16*)(ws + OFF_KV);
  const u16* W1T = (const u16*)(ws + (kv ? OFF_WV1T : OFF_WK1T));
  u16* HID = (u16*)(ws + (kv ? OFF_HIDV : OFF_HIDK));
  const float* B1P = (const float*)(ws + OFF_BIAS1P) + kv * 2048;
  f32x4 acc[4][4];
  zero_acc(acc);
  gemm_tile<1, 2>(KV, 1024, m0, 2048, W1T, 2048, n0, 256, 2048, kv * 256, acc, sA, sB);
#pragma unroll
  for (int i = 0; i < 4; ++i)
#pragma unroll
    for (int j = 0; j < 4; ++j) {
      const int col = n0 + wn * 64 + 16 * j + l15;
      float bias = 0.f;
#pragma unroll
      for (int pp = 0; pp < 8; ++pp) bias += B1P[pp * 256 + col];
#pragma unroll
      for (int e = 0; e < 4; ++e) {
        const int row = m0 + wm * 64 + 16 * i + G * 4 + e;
        HID[(long)row * 256 + col] = f2bf(gelu_tanh(acc[i][j][e] + bias));
      }
    }
}

__device__ __forceinline__ void cmp_gemm2_tile(const Params& P, int t, char* smem) {
  char* ws = P.ws;
  u16* sA = (u16*)smem;
  u16* sB = sA + 128 * 80;
  EPI_VARS
  const int kv = t >> 4, mt = t & 15;
  const int m0 = mt * 128;
  const u16* HID = (const u16*)(ws + (kv ? OFF_HIDV : OFF_HIDK));
  const u16* W2T = (const u16*)(ws + (kv ? OFF_WV2T : OFF_WK2T));
  u16* KCMP = (u16*)(ws + OFF_KCMP);
  u16* VCMPT = (u16*)(ws + OFF_VCMPT);
  f32x4 acc[4][4];
  zero_acc(acc);
  gemm_tile<0, 1>(HID, 256, m0, 2048, W2T, 256, 0, 64, 256, 0, acc, sA, sB);
  if (wn == 0) {
#pragma unroll
    for (int i = 0; i < 4; ++i)
#pragma unroll
      for (int j = 0; j < 4; ++j) {
        const int col = 16 * j + l15;
        const int rbase = m0 + wm * 64 + 16 * i + G * 4;
        if (kv == 0) {
#pragma unroll
          for (int e = 0; e < 4; ++e) KCMP[(long)(rbase + e) * 64 + col] = f2bf(acc[i][j][e]);
        } else {
          const int grp = rbase >> 8, n = rbase & 255;
          u32x2 o2 = {pack2(acc[i][j][0], acc[i][j][1]), pack2(acc[i][j][2], acc[i][j][3])};
          *(u32x2*)(VCMPT + ((long)grp * 64 + col) * 256 + n) = o2;
        }
      }
  }
}

__device__ __forceinline__ void hgrn_scan(const Params& P) {
  char* ws = P.ws;
  u16* UST = (u16*)(ws + OFF_UST);
  const float* DCY = (const float*)(ws + OFF_DCY);
  for (int idx = bid_() * 256 + tid_(); idx < 131072; idx += gridDim.x * 256) {
    const int bh = idx >> 13, rem = idx & 8191;
    const int dv = rem >> 6, dk2 = (rem & 63) * 2;
    float s0 = 0.f, s1 = 0.f;
#pragma unroll 8
    for (int c = 0; c < 64; ++c) {
      const long uu = (long)bh * 64 + c;
      u16* ptr = UST + (uu * 128 + dv) * 128 + dk2;
      const uint32_t uv = *(const uint32_t*)ptr;
      const float2 d = *(const float2*)(DCY + uu * 128 + dk2);
      *(uint32_t*)ptr = pack2(s0, s1);
      s0 = d.x * s0 + __uint_as_float(uv << 16);
      s1 = d.y * s1 + __uint_as_float(uv & 0xffff0000u);
    }
  }
}

__device__ __forceinline__ void hgrn_out_unit(const Params& P, int half, int uu, char* smem) {
  char* ws = P.ws;
  const int tid = tid_(), lane = tid & 63, wave = tid >> 6;
  const int l15 = lane & 15, G = lane >> 4;
  float* sO = (float*)smem;
  const int bl = uu >> 9, h = (uu >> 6) & 7, c = uu & 63;
  const long r0 = (long)bl * 4096 + c * 64;
  const u16* QF = (const u16*)(ws + OFF_QF);
  const u16* HVT = (const u16*)(ws + OFF_HVT);
  const u16* ABUF = (const u16*)(ws + OFF_ABUF);
  const u16* UST = (const u16*)(ws + OFF_UST);
  u16* SG = (u16*)(ws + OFF_SG) + (long)half * 8192 * 1024;
  f32x4 acc[4][2];
#pragma unroll
  for (int i = 0; i < 4; ++i) { acc[i][0] = (f32x4){0.f, 0.f, 0.f, 0.f}; acc[i][1] = (f32x4){0.f, 0.f, 0.f, 0.f}; }
#pragma unroll
  for (int ks = 0; ks < 4; ++ks) {
    const int dk0 = ks * 32 + G * 8;
    bf16x8 bfr[2];
#pragma unroll
    for (int jt = 0; jt < 2; ++jt) bfr[jt] = ld8(UST + ((long)uu * 128 + 32 * wave + 16 * jt + l15) * 128 + dk0);
#pragma unroll
    for (int i = 0; i < 4; ++i) {
      const bf16x8 af = ld8(QF + (r0 + 16 * i + l15) * 1024 + h * 128 + dk0);
      acc[i][0] = MFMA(af, bfr[0], acc[i][0]);
      acc[i][1] = MFMA(af, bfr[1], acc[i][1]);
    }
  }
#pragma unroll
  for (int ks = 0; ks < 2; ++ks) {
    const int s0 = ks * 32 + G * 8;
    bf16x8 bfr[2];
#pragma unroll
    for (int jt = 0; jt < 2; ++jt) bfr[jt] = ld8(HVT + ((long)uu * 128 + 32 * wave + 16 * jt + l15) * 64 + s0);
#pragma unroll
    for (int i = 0; i < 4; ++i) {
      const bf16x8 af = ld8(ABUF + (long)uu * 4096 + (16 * i + l15) * 64 + s0);
      acc[i][0] = MFMA(af, bfr[0], acc[i][0]);
      acc[i][1] = MFMA(af, bfr[1], acc[i][1]);
    }
  }
  __syncthreads();
#pragma unroll
  for (int i = 0; i < 4; ++i)
#pragma unroll
    for (int jt = 0; jt < 2; ++jt)
#pragma unroll
      for (int e = 0; e < 4; ++e) sO[(16 * i + G * 4 + e) * 132 + 32 * wave + 16 * jt + l15] = acc[i][jt][e];
  __syncthreads();
  {
    const int row = tid >> 2, part = tid & 3;
    float ss = 0.f;
#pragma unroll
    for (int cc = 0; cc < 32; ++cc) { const float v = sO[row * 132 + part * 32 + cc]; ss += v * v; }
    ss += SHX(ss, 1);
    ss += SHX(ss, 2);
    const float r = rsqrtf(ss * (1.f / 128.f) + 1e-6f);
    u16* dst = SG + (r0 + row) * 1024 + h * 128 + part * 32;
#pragma unroll
    for (int q4 = 0; q4 < 4; ++q4) {
      const u32x4 sgv = *(const u32x4*)(dst + q4 * 8);
      uint32_t w[4];
#pragma unroll
      for (int e = 0; e < 4; ++e) {
        const int cc = q4 * 8 + 2 * e;
        const float g0 = __uint_as_float(sgv[e] << 16), g1 = __uint_as_float(sgv[e] & 0xffff0000u);
        const float y0 = sO[row * 132 + part * 32 + cc] * r * P.gnorm[part * 32 + cc] * g0;
        const float y1 = sO[row * 132 + part * 32 + cc + 1] * r * P.gnorm[part * 32 + cc + 1] * g1;
        w[e] = pack2(y0, y1);
      }
      *(u32x4*)(dst + q4 * 8) = (u32x4){w[0], w[1], w[2], w[3]};
    }
  }
}

__device__ __forceinline__ void stage_kv(u16* sK, u16* sV, const u16* kptr, long kstride, const u16* vptr, long vstride) {
  const int tid = tid_();
  __syncthreads();
#pragma unroll
  for (int i = 0; i < 2; ++i) {
    const int id = tid + 256 * i;
    const int row = id >> 3, ch = id & 7;
    *(u32x4*)&sK[row * 72 + ch * 8] = *(const u32x4*)(kptr + row * kstride + ch * 8);
    *(u32x4*)&sV[row * 72 + ch * 8] = *(const u32x4*)(vptr + row * vstride + ch * 8);
  }
  __syncthreads();
}

__device__ __forceinline__ void qk_scores(const u16* sK, const bf16x8 (&q)[2], f32x4 (&s)[4], int l15, int G) {
#pragma unroll
  for (int kt = 0; kt < 4; ++kt) {
    s[kt] = (f32x4){0.f, 0.f, 0.f, 0.f};
#pragma unroll
    for (int ks = 0; ks < 2; ++ks) s[kt] = MFMA(ld8(&sK[(16 * kt + l15) * 72 + ks * 32 + G * 8]), q[ks], s[kt]);
  }
}

__device__ __forceinline__ void pv_accum(const u16* sV, const f32x4 (&p)[4], f32x4 (&o)[4], int l15, int G) {
#pragma unroll
  for (int ks2 = 0; ks2 < 2; ++ks2) {
    const f32x4 pa = p[2 * ks2], pb = p[2 * ks2 + 1];
    const bf16x8 pf = mk8(pack2(pa[0], pa[1]), pack2(pa[2], pa[3]), pack2(pb[0], pb[1]), pack2(pb[2], pb[3]));
#pragma unroll
    for (int dt = 0; dt < 4; ++dt) {
      const u32x2 v0 = *(const u32x2*)&sV[(16 * dt + l15) * 72 + 32 * ks2 + 4 * G];
      const u32x2 v1 = *(const u32x2*)&sV[(16 * dt + l15) * 72 + 32 * ks2 + 16 + 4 * G];
      o[dt] = MFMA(mk8(v0[0], v0[1], v1[0], v1[1]), pf, o[dt]);
    }
  }
}

#define EX2(x) __builtin_amdgcn_exp2f(x)
typedef __attribute__((ext_vector_type(16))) float f32x16;
#define MFMA32(a, b, c) __builtin_amdgcn_mfma_f32_32x32x16_bf16((a), (b), (c), 0, 0, 0)
template <int MODE, bool EDGE>
__device__ __forceinline__ void nsa_block(const u16* sK, const u16* sV, int jb, int qb, int q, bool blk_ok,
                                          const bf16x8 (&qf)[4], f32x16 (&O)[2], float& m, float& l, int r31, int h) {
  const int lane = h * 32 + r31;
  f32x16 s[2];
#pragma unroll
  for (int kt2 = 0; kt2 < 2; ++kt2) {
#pragma unroll
    for (int e = 0; e < 16; ++e) s[kt2][e] = 0.f;
#pragma unroll
    for (int ks = 0; ks < 4; ++ks) s[kt2] = MFMA32(ld8(&sK[(32 * kt2 + r31) * 72 + 16 * ks + 8 * h]), qf[ks], s[kt2]);
  }
  float smax = -1e30f;
  if (EDGE) {
#pragma unroll
    for (int kt2 = 0; kt2 < 2; ++kt2)
#pragma unroll
      for (int e = 0; e < 16; ++e) {
        const int k = 32 * kt2 + (e & 3) + 8 * (e >> 2) + 4 * h;
        const bool a = blk_ok && ((jb == qb) ? (k <= q) : (k > q));
        if (!a) s[kt2][e] = -1e30f;
        smax = fmaxf(smax, s[kt2][e]);
      }
  } else {
#pragma unroll
    for (int kt2 = 0; kt2 < 2; ++kt2)
#pragma unroll
      for (int e = 0; e < 16; ++e) smax = fmaxf(smax, s[kt2][e]);
    if (MODE == 2 && !blk_ok) smax = -1e30f;
  }
  smax = fmaxf(smax, SHX(smax, 32));
  const float mn = fmaxf(m, smax);
  const bool need = (mn - m) > 8.f;
  if (__builtin_amdgcn_ballot_w64(need) != 0ull) {
    const float alpha = need ? EX2(m - mn) : 1.f;
    m = need ? mn : m;
    l *= alpha;
    O[0] *= alpha;
    O[1] *= alpha;
  }
  const float mref = (!EDGE && MODE == 2 && !blk_ok) ? 1e30f : m;
  float ls = 0.f;
#pragma unroll
  for (int kt2 = 0; kt2 < 2; ++kt2)
#pragma unroll
    for (int e = 0; e < 16; ++e) {
      const float sv = s[kt2][e];
      float pv;
      if (EDGE) pv = (sv > -1e29f) ? EX2(sv - m) : 0.f;
      else pv = EX2(sv - mref);
      s[kt2][e] = pv;
      ls += pv;
    }
  l += ls;
#pragma unroll
  for (int kt2 = 0; kt2 < 2; ++kt2)
#pragma unroll
    for (int st = 0; st < 2; ++st) {
      const bf16x8 pf = mk8(pack2(s[kt2][8 * st + 0], s[kt2][8 * st + 1]), pack2(s[kt2][8 * st + 2], s[kt2][8 * st + 3]),
                            pack2(s[kt2][8 * st + 4], s[kt2][8 * st + 5]), pack2(s[kt2][8 * st + 6], s[kt2][8 * st + 7]));
#pragma unroll
      for (int dt2 = 0; dt2 < 2; ++dt2) {
        const u16* vrow = &sV[(32 * dt2 + r31) * 72 + 32 * kt2 + 16 * st + 4 * h];
        const u32x2 v0 = *(const u32x2*)vrow;
        const u32x2 v1 = *(const u32x2*)(vrow + 8);
        O[dt2] = MFMA32(mk8(v0[0], v0[1], v1[0], v1[1]), pf, O[dt2]);
      }
    }
}

template <int MODE>
__device__ __forceinline__ void nsa_branch(const u16* kbase, const u16* vbase, int jb0, int jb1, int qb, int q,
                                           uint32_t mlo, uint32_t mhi, const bf16x8 (&qf)[4], const float* ngbase, int rowbase, int gidx,
                                           u16* sYl, u16* sm, float pscale = 1.f) {
  const int tid = tid_();
  const int lane = tid & 63;
  const int r31 = lane & 31, h = lane >> 5;
  const int srow = tid >> 3, sch = (tid & 7) * 8;
  f32x16 O[2];
#pragma unroll
  for (int e = 0; e < 16; ++e) { O[0][e] = 0.f; O[1][e] = 0.f; }
  float m = -1e30f, l = 0.f;
  u32x4 kr[2], vr[2];
  const unsigned koff = (unsigned)((srow * 1024 + sch) * 2);
  const unsigned voff = (unsigned)((srow * 4096 + sch) * 2);
  {
    const char* kb = (const char*)kbase + (size_t)jb0 * 131072;
    const char* vb = (const char*)vbase + (size_t)jb0 * 128;
#pragma unroll
    for (int i = 0; i < 2; ++i) {
      kr[i] = *(const u32x4*)(kb + (koff + i * 65536u));
      vr[i] = *(const u32x4*)(vb + (voff + i * 262144u));
    }
  }
  __syncthreads();
#pragma unroll
  for (int i = 0; i < 2; ++i) {
    *(u32x4*)&sm[(srow + 32 * i) * 72 + sch] = kr[i];
    *(u32x4*)&sm[4608 + (srow + 32 * i) * 72 + sch] = vr[i];
  }
  __syncthreads();
  int cur = 0;
  for (int jb = jb0; jb <= jb1; ++jb) {
    const bool more = jb < jb1;
    if (more) {
      const char* kb = (const char*)kbase + (size_t)(jb + 1) * 131072;
      const char* vb = (const char*)vbase + (size_t)(jb + 1) * 128;
#pragma unroll
      for (int i = 0; i < 2; ++i) {
        kr[i] = *(const u32x4*)(kb + (koff + i * 65536u));
        vr[i] = *(const u32x4*)(vb + (voff + i * 262144u));
      }
    }
    const u16* sK = sm + cur * 9216;
    const u16* sV = sK + 4608;
    bool blk_ok = true;
    if (MODE == 2) blk_ok = (jb < 32) ? ((mlo >> jb) & 1u) : ((mhi >> (jb - 32)) & 1u);
    const bool edge = (jb == qb) || (MODE == 3 && jb == qb - 8);
    if (edge) nsa_block<MODE, true>(sK, sV, jb, qb, q, blk_ok, qf, O, m, l, r31, h);
    else nsa_block<MODE, false>(sK, sV, jb, qb, q, blk_ok, qf, O, m, l, r31, h);
    if (more) {
      u16* dK = sm + (cur ^ 1) * 9216;
#pragma unroll
      for (int i = 0; i < 2; ++i) {
        *(u32x4*)&dK[(srow + 32 * i) * 72 + sch] = kr[i];
        *(u32x4*)&dK[4608 + (srow + 32 * i) * 72 + sch] = vr[i];
      }
    }
    __syncthreads();
    cur ^= 1;
  }
  const int tg = tid_();
  const int lg = tg & 63, hh = (lg >> 4) & 1, hg = lg >> 5;
  const float* gatep = (const float*)((const char*)ngbase + (unsigned)(rowbase + 16 * (tg >> 6) + (tg & 15)) * 192u) + gidx + hh;
  float lt = l;
  lt += shx_f(lt, lg ^ 32);
  const float sc = (lt > 0.f) ? (pscale * gatep[0] / lt) : 0.f;
  u16* yrow = sYl + (((tg >> 6) * 2 + hh) * 16 + (tg & 15)) * 64;
#pragma unroll
  for (int dt2 = 0; dt2 < 2; ++dt2)
#pragma unroll
    for (int m4 = 0; m4 < 4; ++m4) {
      u32x2* yp = (u32x2*)(yrow + 32 * dt2 + 8 * m4 + 4 * hg);
      const u32x2 yv = *yp;
      const float y0 = __uint_as_float(yv[0] << 16) + O[dt2][4 * m4 + 0] * sc;
      const float y1 = __uint_as_float(yv[0] & 0xffff0000u) + O[dt2][4 * m4 + 1] * sc;
      const float y2 = __uint_as_float(yv[1] << 16) + O[dt2][4 * m4 + 2] * sc;
      const float y3 = __uint_as_float(yv[1] & 0xffff0000u) + O[dt2][4 * m4 + 3] * sc;
      *yp = (u32x2){pack2(y0, y1), pack2(y2, y3)};
    }
}

__device__ __forceinline__ void pv_cmp(const u16* vc, int jb, const f32x4 (&p)[4], f32x4 (&o)[4], int l15, int G) {
#pragma unroll
  for (int ks2 = 0; ks2 < 2; ++ks2) {
    const f32x4 pa = p[2 * ks2], pb = p[2 * ks2 + 1];
    const bf16x8 pf = mk8(pack2(pa[0], pa[1]), pack2(pa[2], pa[3]), pack2(pb[0], pb[1]), pack2(pb[2], pb[3]));
#pragma unroll
    for (int dt = 0; dt < 4; ++dt) {
      const u16* vp = vc + (long)(16 * dt + l15) * 256 + jb * 64 + 32 * ks2 + 4 * G;
      const u32x2 v0 = *(const u32x2*)vp;
      const u32x2 v1 = *(const u32x2*)(vp + 16);
      o[dt] = MFMA(mk8(v0[0], v0[1], v1[0], v1[1]), pf, o[dt]);
    }
  }
}

__device__ __forceinline__ void nsa_unit(const Params& P, int half, int u, char* smem) {
  char* ws = P.ws;
  const int tid = tid_(), lane = tid & 63, wave = tid >> 6;
  const int l15 = lane & 15, G = lane >> 4;
  const int hp = u >> 9, rest = u & 511;
  const int bl = rest >> 8, g = (rest >> 6) & 3, xq = rest & 63;
  const int qb = hp ? xq : 63 - xq;
  const int q = 16 * wave + l15;
  const int t = qb * 64 + q;
  const int rl = bl * 4096 + t;
  const int rg = half * 8192 + rl;
  const char* NQc = (const char*)(ws + OFF_NQ);
  const unsigned qoff = (unsigned)rg * 2048u;
  u16* sm = (u16*)smem;
  float* sImp = (float*)smem;
  const u16* NQ = (const u16*)(ws + OFF_NQ);
  const u16* NQR = (const u16*)(ws + OFF_NQR);
  const u16* KV = (const u16*)(ws + OFF_KV);
  const u16* VST = (const u16*)(ws + OFF_VST);
  const u16* VWT = (const u16*)(ws + OFF_VWT);
  const u16* KCMP = (const u16*)(ws + OFF_KCMP);
  const u16* VCMPT = (const u16*)(ws + OFF_VCMPT);
  const float* NGATE = (const float*)((const char*)(ws + OFF_NGATE) + (unsigned)rg * 192u);
  u16* YB = (u16*)(ws + (half ? OFF_YB1 : OFF_YB0));

  f32x4 Y[2][4];
#pragma unroll
  for (int rr = 0; rr < 2; ++rr)
#pragma unroll
    for (int dt = 0; dt < 4; ++dt) Y[rr][dt] = (f32x4){0.f, 0.f, 0.f, 0.f};

  uint32_t mlo = 0, mhi = 0;
  u16* sYl = (u16*)(smem + 36864);
  {
    const int nblk = ((4 * qb + 2) >> 6) + 1;
    const u16* kc = KCMP + (long)(bl * 4 + g) * 256 * 64;
    const u16* vc = VCMPT + (long)(bl * 4 + g) * 64 * 256;
    float imp[4][4];
#pragma unroll
    for (int a = 0; a < 4; ++a)
#pragma unroll
      for (int b = 0; b < 4; ++b) imp[a][b] = 0.f;
    __syncthreads();
    for (int id = tid; id < nblk * 512; id += 256) {
      const int row = id >> 3, chn = (id & 7) * 8;
      *(u32x4*)&sm[row * 72 + chn] = *(const u32x4*)(kc + row * 64 + chn);
    }
    __syncthreads();
#pragma unroll 1
    for (int r = 0; r < 4; ++r) {
      bf16x8 qp[2];
#pragma unroll
      for (int ks = 0; ks < 2; ++ks) qp[ks] = *(const bf16x8*)(NQc + (qoff + (unsigned)(((4 * g + r) * 64 + ks * 32 + G * 8) * 2)));
      float m = -1e30f, l = 0.f;
#pragma unroll 1
      for (int jb = 0; jb < nblk; ++jb) {
        f32x4 s[4];
        float smax = -1e30f;
#pragma unroll
        for (int kt = 0; kt < 4; ++kt) {
          f32x4 a4 = {0.f, 0.f, 0.f, 0.f};
#pragma unroll
          for (int ks = 0; ks < 2; ++ks)
            a4 = MFMA(ld8(&sm[(jb * 64 + 16 * kt + l15) * 72 + ks * 32 + G * 8]), qp[ks], a4);
#pragma unroll
          for (int e = 0; e < 4; ++e) {
            const int n = jb * 64 + 16 * kt + 4 * G + e;
            const float sv = (16 * n + 31 <= t) ? a4[e] : -1e30f;
            s[kt][e] = sv;
            smax = fmaxf(smax, sv);
          }
        }
        smax = fmaxf(smax, SHX(smax, 16));
        smax = fmaxf(smax, SHX(smax, 32));
        const float mn = fmaxf(m, smax);
        float ls = 0.f;
#pragma unroll
        for (int kt = 0; kt < 4; ++kt)
#pragma unroll
          for (int e = 0; e < 4; ++e) ls += (s[kt][e] > -1e29f) ? EX2(s[kt][e] - mn) : 0.f;
        l = l * EX2(m - mn) + ls;
        m = mn;
      }
      l += SHX(l, 16);
      l += SHX(l, 32);
      const float invl = (l > 0.f) ? 1.f / l : 0.f;
      float prevup = 0.f;
#pragma unroll 1
      for (int jb = 0; jb < nblk; ++jb) {
        {
          f32x4 p[4];
#pragma unroll
          for (int kt = 0; kt < 4; ++kt) {
            f32x4 a4 = {0.f, 0.f, 0.f, 0.f};
#pragma unroll
            for (int ks = 0; ks < 2; ++ks)
              a4 = MFMA(ld8(&sm[(jb * 64 + 16 * kt + l15) * 72 + ks * 32 + G * 8]), qp[ks], a4);
#pragma unroll
            for (int e = 0; e < 4; ++e) {
              const int n = jb * 64 + 16 * kt + 4 * G + e;
              p[kt][e] = (16 * n + 31 <= t) ? EX2(a4[e] - m) * invl : 0.f;
            }
            const float sum4 = (p[kt][0] + p[kt][1]) + (p[kt][2] + p[kt][3]);
            const float upv = shx_f(p[kt][3], (lane + 48) & 63);
            const float add = (G > 0) ? upv : prevup;
            const float iv = sum4 + add;
#pragma unroll
            for (int j = 0; j < 4; ++j) imp[j][kt] += (jb == j) ? iv : 0.f;
            prevup = upv;
          }
          if (r == 2 * hp) pv_cmp(vc, jb, p, Y[0], l15, G);
          else if (r == 2 * hp + 1) pv_cmp(vc, jb, p, Y[1], l15, G);
        }
      }
    }
    {
      const float g0 = NGATE[0 * 16 + 4 * g + 2 * hp], g1 = NGATE[0 * 16 + 4 * g + 2 * hp + 1];
#pragma unroll
      for (int dt = 0; dt < 4; ++dt) {
        *(u32x2*)(sYl + ((wave * 2 + 0) * 16 + l15) * 64 + 16 * dt + 4 * G) = (u32x2){pack2(Y[0][dt][0] * g0, Y[0][dt][1] * g0), pack2(Y[0][dt][2] * g0, Y[0][dt][3] * g0)};
        *(u32x2*)(sYl + ((wave * 2 + 1) * 16 + l15) * 64 + 16 * dt + 4 * G) = (u32x2){pack2(Y[1][dt][0] * g1, Y[1][dt][1] * g1), pack2(Y[1][dt][2] * g1, Y[1][dt][3] * g1)};
      }
    }
    __syncthreads();
    float* myImp = sImp + wave * 16 * 65;
#pragma unroll
    for (int jb = 0; jb < 4; ++jb)
#pragma unroll
      for (int kt = 0; kt < 4; ++kt) myImp[l15 * 65 + 16 * jb + 4 * kt + G] = imp[jb][kt];
    __syncthreads();
    const int cur = qb;
    uint32_t blo = 0, bhi = 0;
    if (cur + 1 <= 16) {
#pragma unroll
      for (int jb = 0; jb < 4; ++jb)
#pragma unroll
        for (int kt = 0; kt < 4; ++kt) {
          const int s = 16 * jb + 4 * kt + G;
          if (s <= cur) blo |= (1u << s);
        }
    } else {
      int cnt[4][4];
#pragma unroll
      for (int a = 0; a < 4; ++a)
#pragma unroll
        for (int b = 0; b < 4; ++b) cnt[a][b] = 0;
      for (int sp = 1; sp <= cur - 2; ++sp) {
        const float xv = myImp[l15 * 65 + sp];
#pragma unroll
        for (int jb = 0; jb < 4; ++jb)
#pragma unroll
          for (int kt = 0; kt < 4; ++kt) {
            const int s = 16 * jb + 4 * kt + G;
            const float v = imp[jb][kt];
            cnt[jb][kt] += ((xv > v) || (xv == v && sp < s)) ? 1 : 0;
          }
      }
#pragma unroll
      for (int jb = 0; jb < 4; ++jb)
#pragma unroll
        for (int kt = 0; kt < 4; ++kt) {
          const int s = 16 * jb + 4 * kt + G;
          const bool sel = (s == 0) || (s == cur) || (s == cur - 1) || (s >= 1 && s <= cur - 2 && cnt[jb][kt] < 13);
          if (sel) { if (s < 32) blo |= (1u << s); else bhi |= (1u << (s - 32)); }
        }
    }
    blo |= SHXU(blo, 16); blo |= SHXU(blo, 32);
    bhi |= SHXU(bhi, 16); bhi |= SHXU(bhi, 32);
    mlo = blo; mhi = bhi;
  }
  {
    const int hh = (lane >> 4) & 1, h5 = lane >> 5;
    const int head = 4 * g + 2 * hp + hh;
    bf16x8 qf[4];
    qf[0] = *(const bf16x8*)((const char*)NQR + ((unsigned)rl * 512u + (unsigned)((head * 16 + 8 * h5) * 2)));
#pragma unroll
    for (int ks = 1; ks < 4; ++ks) qf[ks] = *(const bf16x8*)(NQc + (qoff + (unsigned)((head * 64 + 16 * ks + 8 * h5) * 2)));
    const int head0 = 4 * g + 2 * hp;
    const u16* kbs = KV + (long)bl * 4096 * 1024 + 512 + g * 64;
    const u16* vbs = VST + (long)(bl * 4 + g) * 64 * 4096;
    nsa_branch<2>(kbs, vbs, 0, qb, qb, q, mlo, mhi, qf, (const float*)(ws + OFF_NGATE), half * 8192 + bl * 4096 + qb * 64, 16 + head0, sYl, sm);
    const u16* kbw = KV + (long)bl * 4096 * 1024 + 768 + g * 64;
    const u16* vbw = VWT + (long)(bl * 4 + g) * 64 * 4096;
    const int jw0 = (qb >= 8) ? qb - 8 : 0;
    nsa_branch<3>(kbw, vbw, jw0, qb, qb, q, mlo, mhi, qf, (const float*)(ws + OFF_NGATE), half * 8192 + bl * 4096 + qb * 64, 32 + head0, sYl, sm);
    const int tid2 = tid_();
    const int l2 = tid2 & 63, hh2 = (l2 >> 4) & 1, hg2 = l2 >> 5;
    const unsigned yoff = (unsigned)(bl * 4096 + qb * 64 + 16 * (tid2 >> 6) + (tid2 & 15)) * 2048u;
    const u16* yrow = sYl + (((tid2 >> 6) * 2 + hh2) * 16 + (tid2 & 15)) * 64;
#pragma unroll
    for (int dt2 = 0; dt2 < 2; ++dt2)
#pragma unroll
      for (int m4 = 0; m4 < 4; ++m4) {
        const int d0 = 32 * dt2 + 8 * m4 + 4 * hg2;
        *(u32x2*)((char*)YB + (yoff + (unsigned)(((head0 + hh2) * 64 + d0) * 2))) = *(const u32x2*)(yrow + d0);
      }
  }
}

__device__ __forceinline__ void gemm_tile_wide(const u16* __restrict__ A, long lda, int m0, const u16* __restrict__ Bt, long ldb, int n0, int K,
                                               f32x4 (&acc)[4][8], u16* sA) {
  const int tid = tid_(), lane = tid & 63, wave = tid >> 6;
  const int l15 = lane & 15, G = lane >> 4;
  const int wm = wave >> 1, wn = wave & 1;
  const int lr = tid >> 3, ch = tid & 7;
  u16* sB = sA + 128 * 80;
  const char* Ab = (const char*)A;
  const char* Bb = (const char*)Bt;
  unsigned oa[4], ob[8];
#pragma unroll
  for (int i = 0; i < 4; ++i) oa[i] = (unsigned)(((long)(m0 + lr + 32 * i) * lda + ch * 8) * 2);
#pragma unroll
  for (int i = 0; i < 8; ++i) ob[i] = (unsigned)(((long)(n0 + lr + 32 * i) * ldb + ch * 8) * 2);
  u32x4 ra[4], rb[8];
#pragma unroll
  for (int i = 0; i < 4; ++i) ra[i] = *(const u32x4*)(Ab + oa[i]);
#pragma unroll
  for (int i = 0; i < 8; ++i) rb[i] = *(const u32x4*)(Bb + ob[i]);
  const int nk = K >> 6;
  for (int kt = 0; kt < nk; ++kt) {
#pragma unroll
    for (int i = 0; i < 4; ++i) *(u32x4*)&sA[(lr + 32 * i) * 80 + ch * 8] = ra[i];
#pragma unroll
    for (int i = 0; i < 8; ++i) *(u32x4*)&sB[(lr + 32 * i) * 80 + ch * 8] = rb[i];
    __syncthreads();
    {
      const int kn = (kt + 1 < nk) ? kt + 1 : kt;
      const char* Ak = Ab + (size_t)kn * 128;
      const char* Bk = Bb + (size_t)kn * 128;
#pragma unroll
      for (int i = 0; i < 4; ++i) ra[i] = *(const u32x4*)(Ak + oa[i]);
#pragma unroll
      for (int i = 0; i < 8; ++i) rb[i] = *(const u32x4*)(Bk + ob[i]);
    }
#pragma unroll
    for (int ks = 0; ks < 2; ++ks) {
      bf16x8 af[4];
#pragma unroll
      for (int i = 0; i < 4; ++i) af[i] = ld8(&sA[(wm * 64 + 16 * i + l15) * 80 + ks * 32 + G * 8]);
#pragma unroll
      for (int jh = 0; jh < 2; ++jh) {
        bf16x8 bfr[4];
#pragma unroll
        for (int j = 0; j < 4; ++j) bfr[j] = ld8(&sB[(wn * 128 + 64 * jh + 16 * j + l15) * 80 + ks * 32 + G * 8]);
#pragma unroll
        for (int i = 0; i < 4; ++i)
#pragma unroll
          for (int j = 0; j < 4; ++j) acc[i][4 * jh + j] = MFMA(af[i], bfr[j], acc[i][4 * jh + j]);
      }
    }
    __syncthreads();
  }
}


__device__ __forceinline__ void phase_branch_merge(const Params& P, char* smem) {
  char* ws = P.ws;
  u16* sA = (u16*)smem;
  const u16* YA = (const u16*)(ws + OFF_SG);
  const u16* GATES = (const u16*)P.out;
  u16* MERGED = (u16*)(ws + OFF_MERGED);
  for (int t = bid_(); t < 512; t += gridDim.x) {
    const int nt = t >> 7, mt = t & 127;
    const int m0 = mt * 128, n0 = nt * 256;
    const u16* YBp = (m0 < 8192) ? (const u16*)(ws + OFF_YB0) : ((const u16*)(ws + OFF_YB1) - (long)8192 * 1024);
    f32x4 acc[4][8];
#pragma unroll
    for (int i = 0; i < 4; ++i)
#pragma unroll
      for (int j = 0; j < 8; ++j) acc[i][j] = (f32x4){0.f, 0.f, 0.f, 0.f};
    gemm_tile_wide(YA, 1024, m0, (const u16*)(ws + OFF_WA_T), 1024, n0, 1024, acc, sA);
    {
      EPI_VARS
#pragma unroll
      for (int i = 0; i < 4; ++i)
#pragma unroll
        for (int j = 0; j < 8; ++j) {
          const int col = n0 + wn * 128 + 16 * j + l15;
#pragma unroll
          for (int e = 0; e < 4; ++e) {
            const unsigned go = ((unsigned)(m0 + wm * 64 + 16 * i + G * 4 + e) * 2048u + (unsigned)col) * 2u;
            acc[i][j][e] *= bf2f(*(const u16*)((const char*)GATES + go)) * __builtin_amdgcn_rcpf(bf2f(*(const u16*)((const char*)GATES + (go + 2048u))));
          }
        }
    }
    gemm_tile_wide(YBp, 1024, m0, (const u16*)(ws + OFF_WB_T), 1024, n0, 1024, acc, sA);
    {
      EPI_VARS
#pragma unroll
      for (int i = 0; i < 4; ++i)
#pragma unroll
        for (int j = 0; j < 8; ++j) {
          const int col = n0 + wn * 128 + 16 * j + l15;
#pragma unroll
          for (int e = 0; e < 4; ++e) {
            const unsigned ro = (unsigned)(m0 + wm * 64 + 16 * i + G * 4 + e);
            const unsigned go = (ro * 2048u + (unsigned)col) * 2u + 2048u;
            *(u16*)((char*)MERGED + (ro * 1024u + (unsigned)col) * 2u) = f2bf(acc[i][j][e] * bf2f(*(const u16*)((const char*)GATES + go)));
          }
        }
    }
  }
}

template <int EPI>
__device__ __forceinline__ void phase_gemm(const u16* A, int K, const u16* Wt, int N, void* outp, char* smem) {
  u16* sA = (u16*)smem;
  u16* sB = sA + 128 * 80;
  EPI_VARS
  const int ntn = N >> 7;
  for (int t = bid_(); t < 128 * ntn; t += gridDim.x) {
    const int nt = t >> 7, mt = t & 127;
    const int m0 = mt * 128, n0 = nt * 128;
    f32x4 acc[4][4];
    zero_acc(acc);
    gemm_tile<0, 2>(A, K, m0, 16384, Wt, K, n0, N, K, 0, acc, sA, sB);
#pragma unroll
    for (int i = 0; i < 4; ++i)
#pragma unroll
      for (int j = 0; j < 4; ++j) {
        const int col = n0 + wn * 64 + 16 * j + l15;
#pragma unroll
        for (int e = 0; e < 4; ++e) {
          const long row = m0 + wm * 64 + 16 * i + G * 4 + e;
          const float v = acc[i][j][e];
          if (EPI == 0) ((float*)outp)[row * N + col] = v;
          else if (EPI == 2) ((u16*)outp)[row * N + col] = f2bf(v);
          else { const float rl = fmaxf(v, 0.f); ((u16*)outp)[row * N + col] = f2bf(rl * rl); }
        }
      }
  }
}


template <int EPI>
__device__ __forceinline__ void phase_gemm_wide(const u16* A, int K, const u16* Wt, int N, u16* outp, char* smem) {
  u16* sA = (u16*)smem;
  EPI_VARS
  const int ntn = N >> 8;
  for (int t = bid_(); t < 128 * ntn; t += gridDim.x) {
    const int nt = t >> 7, mt = t & 127;
    const int m0 = mt * 128, n0 = nt * 256;
    f32x4 acc[4][8];
#pragma unroll
    for (int i = 0; i < 4; ++i)
#pragma unroll
      for (int j = 0; j < 8; ++j) acc[i][j] = (f32x4){0.f, 0.f, 0.f, 0.f};
    gemm_tile_wide(A, K, m0, Wt, K, n0, K, acc, sA);
#pragma unroll
    for (int i = 0; i < 4; ++i)
#pragma unroll
      for (int j = 0; j < 8; ++j) {
        const int col = n0 + wn * 128 + 16 * j + l15;
#pragma unroll
        for (int e = 0; e < 4; ++e) {
          const long row = m0 + wm * 64 + 16 * i + G * 4 + e;
          float v = acc[i][j][e];
          if (EPI == 1) { v = fmaxf(v, 0.f); v = v * v; }
          outp[row * N + col] = f2bf(v);
        }
      }
  }
}

__device__ __forceinline__ void phase_ple(const Params& P, char* smem) {
  char* ws = P.ws;
  u16* sA = (u16*)smem;
  float* Z3 = (float*)(ws + OFF_Z3);
  for (int t = bid_(); t < 512; t += gridDim.x) {
    const int nt = t >> 7, mt = t & 127;
    const int m0 = mt * 128, n0 = nt * 256;
    f32x4 acc[4][8];
#pragma unroll
    for (int i = 0; i < 4; ++i)
#pragma unroll
      for (int j = 0; j < 8; ++j) acc[i][j] = (f32x4){0.f, 0.f, 0.f, 0.f};
    gemm_tile_wide((const u16*)(ws + OFF_PB), 256, m0, (const u16*)(ws + OFF_WPLE_T), 256, n0, 256, acc, sA);
    {
      EPI_VARS
#pragma unroll
      for (int i = 0; i < 4; ++i)
#pragma unroll
        for (int j = 0; j < 8; ++j) {
          const int col = n0 + wn * 128 + 16 * j + l15;
#pragma unroll
          for (int e = 0; e < 4; ++e) {
            const unsigned zo = ((unsigned)(m0 + wm * 64 + 16 * i + G * 4 + e) * 1024u + (unsigned)col) * 4u;
            *(float*)((char*)Z3 + zo) = acc[i][j][e];
            acc[i][j][e] = 0.f;
          }
        }
    }
    gemm_tile_wide((const u16*)(ws + OFF_H2B), 1024, m0, (const u16*)(ws + OFF_WPG_T), 1024, n0, 1024, acc, sA);
    {
      EPI_VARS
#pragma unroll
      for (int i = 0; i < 4; ++i)
#pragma unroll
        for (int j = 0; j < 8; ++j) {
          const int col = n0 + wn * 128 + 16 * j + l15;
#pragma unroll
          for (int e = 0; e < 4; ++e) {
            const unsigned zo = ((unsigned)(m0 + wm * 64 + 16 * i + G * 4 + e) * 1024u + (unsigned)col) * 4u;
            float* zp = (float*)((char*)Z3 + zo);
            *zp = *zp * sigm(acc[i][j][e]);
          }
        }
    }
  }
}

template <int MODE, int ZB>
__device__ __forceinline__ void phase_rownorm(const Params& P, const void* Zv, const float* w, const float* w2, u16* nxt) {
  const int tid = tid_(), lane = tid & 63, wave = tid >> 6;
  float* H = P.out;
  for (int un = bid_(); un < 4096; un += gridDim.x) {
    const long row = (long)un * 4 + wave;
    const float* zr = (const float*)Zv + row * 1024;
    const u16* zh = (const u16*)Zv + row * 1024;
    (void)zr; (void)zh;
    const float* hin = (MODE == 0) ? (P.x + row * 1024) : (H + row * 1024);
    float4 z[4], hv[4];
    float ss = 0.f;
#pragma unroll
    for (int j = 0; j < 4; ++j) {
      if (ZB) {
        const u32x2 zz = *(const u32x2*)(zh + j * 256 + lane * 4);
        z[j] = make_float4(__uint_as_float(zz[0] << 16), __uint_as_float(zz[0] & 0xffff0000u), __uint_as_float(zz[1] << 16), __uint_as_float(zz[1] & 0xffff0000u));
      } else z[j] = *(const float4*)(zr + j * 256 + lane * 4);
      hv[j] = *(const float4*)(hin + j * 256 + lane * 4);
      ss += z[j].x * z[j].x + z[j].y * z[j].y + z[j].z * z[j].z + z[j].w * z[j].w;
    }
#pragma unroll
    for (int o = 32; o >= 1; o >>= 1) ss += SHX(ss, o);
    const float r = rsqrtf(ss * (1.f / 1024.f) + 1e-6f);
    float s2 = 0.f;
#pragma unroll
    for (int j = 0; j < 4; ++j) {
      const float4 wv = *(const float4*)(w + j * 256 + lane * 4);
      hv[j].x += z[j].x * r * wv.x; hv[j].y += z[j].y * r * wv.y;
      hv[j].z += z[j].z * r * wv.z; hv[j].w += z[j].w * r * wv.w;
      s2 += hv[j].x * hv[j].x + hv[j].y * hv[j].y + hv[j].z * hv[j].z + hv[j].w * hv[j].w;
      *(float4*)(H + row * 1024 + j * 256 + lane * 4) = hv[j];
    }
    if (MODE == 0) {
#pragma unroll
      for (int o = 32; o >= 1; o >>= 1) s2 += SHX(s2, o);
      const float r2 = rsqrtf(s2 * (1.f / 1024.f) + 1e-6f);
#pragma unroll
      for (int j = 0; j < 4; ++j) {
        const float4 wv = *(const float4*)(w2 + j * 256 + lane * 4);
        u32x2 o2 = {pack2(hv[j].x * r2 * wv.x, hv[j].y * r2 * wv.y), pack2(hv[j].z * r2 * wv.z, hv[j].w * r2 * wv.w)};
        *(u32x2*)(nxt + row * 1024 + j * 256 + lane * 4) = o2;
      }
    } else if (MODE == 1) {
#pragma unroll
      for (int j = 0; j < 4; ++j) {
        u32x2 o2 = {pack2(hv[j].x, hv[j].y), pack2(hv[j].z, hv[j].w)};
        *(u32x2*)(nxt + row * 1024 + j * 256 + lane * 4) = o2;
      }
      const float4 pv = *(const float4*)(P.p + row * 256 + lane * 4);
      u32x2 o2 = {pack2(pv.x, pv.y), pack2(pv.z, pv.w)};
      *(u32x2*)((u16*)(P.ws + OFF_PB) + row * 256 + lane * 4) = o2;
    }
  }
}

#define XB_TMO      128
#define XB_XCNT(j)  (256  + 64 * (j))
#define XB_XSUB(j)  (1280 + 64 * (j))
#define XB_XGEN(j)  (2304 + 64 * (j))
#define XB_TOP      3328
#define XB_TOPGEN   3392
#define XCD_BAR_WORDS 3456
#define XB_SPIN_CAP (1u << 18)
#define LAS __attribute__((address_space(3)))

__device__ __forceinline__ unsigned xb_ld(unsigned* p)              { return __hip_atomic_load(p, __ATOMIC_RELAXED, __HIP_MEMORY_SCOPE_AGENT); }
__device__ __forceinline__ unsigned xb_add(unsigned* p, unsigned v) { return __hip_atomic_fetch_add(p, v, __ATOMIC_RELAXED, __HIP_MEMORY_SCOPE_AGENT); }
__device__ __forceinline__ unsigned xb_xcc_id() { return (unsigned)__builtin_amdgcn_s_getreg((3 << 11) | 20) & 0xFu; }
#define XB_SPIN(cond, bar) do { unsigned _sp = 0; while (cond) { __builtin_amdgcn_s_sleep(1); \
    if ((++_sp & 255u) == 0u) { if (xb_ld(&(bar)[XB_TMO])) break; if (_sp > XB_SPIN_CAP) { atomicAdd(&(bar)[XB_TMO], 1u); break; } } } } while (0)

struct XcdBarrier {
    unsigned* bar; unsigned x;
    volatile LAS unsigned* st;
};

__device__ __forceinline__ XcdBarrier xcd_barrier_post(unsigned* bar, volatile LAS unsigned* st) {
    XcdBarrier b; b.bar = bar; b.x = xb_xcc_id(); b.st = st;
    if (tid_() == 0) (void)xb_add(&bar[XB_XCNT(b.x)], 1u);
    return b;
}
__device__ __forceinline__ void xcd_barrier_complete(unsigned* bar, unsigned x, unsigned& nloc, unsigned& nx) {
    const unsigned G = gridDim.x * gridDim.y * gridDim.z;
    unsigned sum, cnt, mine, sp = 0u;
    for (;;) {
        sum = 0u; cnt = 0u; mine = 0u;
#pragma unroll
        for (unsigned j = 0; j < 16; ++j) { const unsigned c = xb_ld(&bar[XB_XCNT(j)]); sum += c; cnt += (c > 0u) ? 1u : 0u; mine = (j == x) ? c : mine; }
        if (sum == G) break;
        __builtin_amdgcn_s_sleep(1);
        if ((++sp & 255u) == 0u) { if (xb_ld(&bar[XB_TMO])) break; if (sp > XB_SPIN_CAP) { atomicAdd(&bar[XB_TMO], 1u); break; } }
    }
    nloc = mine > 0u ? mine : 1u; nx = cnt > 0u ? cnt : 1u;
}

__device__ __forceinline__ void xcd_barrier(const XcdBarrier& b) {
    asm volatile("s_waitcnt vmcnt(0)" ::: "memory");
    __syncthreads();
    if (tid_() == 0) {
        unsigned* bar = b.bar;
        __builtin_amdgcn_s_waitcnt(0);
        unsigned nloc = b.st[0], nx = b.st[1];
        if (nloc == 0u) { xcd_barrier_complete(bar, b.x, nloc, nx); b.st[0] = nloc; b.st[1] = nx; }
        const unsigned old = xb_add(&bar[XB_XSUB(b.x)], 1u);
        const unsigned gen = old / nloc;
        if (old + 1u == (gen + 1u) * nloc) {
            __builtin_amdgcn_fence(__ATOMIC_RELEASE, "agent");
            asm volatile("s_waitcnt vmcnt(0)" ::: "memory");
            const unsigned og = xb_add(&bar[XB_TOP], 1u);
            const unsigned tg = og / nx;
            if (og + 1u == (tg + 1u) * nx) xb_add(&bar[XB_TOPGEN], 1u);
            else XB_SPIN(xb_ld(&bar[XB_TOPGEN]) == tg, bar);
            __builtin_amdgcn_fence(__ATOMIC_ACQUIRE, "agent");
            xb_add(&bar[XB_XGEN(b.x)], 1u);
            asm volatile("s_waitcnt vmcnt(0)" ::: "memory");
        } else {
            XB_SPIN(xb_ld(&bar[XB_XGEN(b.x)]) == gen, bar);
            __builtin_amdgcn_fence(__ATOMIC_ACQUIRE, "agent");
            asm volatile("s_waitcnt vmcnt(0)" ::: "memory");
        }
    }
    __syncthreads();
}

#define OFF_BAR (252 * MIB)
#define GSYNC() do { XcdBarrier xb_; xb_.bar = (unsigned*)(P.ws + OFF_BAR); xb_.x = xb_xcc_id(); xb_.st = (volatile LAS unsigned*)&xb_words; xcd_barrier(xb_); } while (0)
__global__ void __launch_bounds__(256, 2) k_mega(Params P) {
  __shared__ __attribute__((aligned(16))) char smem[61440];
  char* ws = P.ws;
  __shared__ uint4 xb_words;
  if (tid_() == 0) xb_words = make_uint4(0u, 0u, 0u, 0u);
  __syncthreads();
  (void)xcd_barrier_post((unsigned*)(ws + OFF_BAR), (volatile LAS unsigned*)&xb_words);
  phase_prep(P, smem);
  GSYNC();
#pragma unroll 1
  for (int half = 0; half < 2; ++half) {
    phase_inproj(P, half, smem);
    GSYNC();
#if PROBE_DUP == 1
    phase_inproj(P, half, smem);
    GSYNC();
#endif
    if ((int)gridDim.x > 128) {
      const int b2 = bid_();
      if (b2 < 64) cmp_gemm1_tile(P, b2, smem);
      else for (int u = b2 - 64; u < 1024; u += (int)gridDim.x - 64) hgrn_intra_unit(P, u, smem);
    } else {
      for (int t = bid_(); t < 64; t += gridDim.x) cmp_gemm1_tile(P, t, smem);
      for (int u = bid_(); u < 1024; u += gridDim.x) hgrn_intra_unit(P, u, smem);
    }
    GSYNC();
    for (int t = bid_(); t < 32; t += gridDim.x) cmp_gemm2_tile(P, t, smem);
    hgrn_scan(P);
    if (half == 1) phase_late_weights(P, smem);
    GSYNC();
#if PROBE_DUP == 2
    for (int u = bid_(); u < 1024; u += gridDim.x) nsa_unit(P, half, u, smem);
    GSYNC();
#endif
    for (int u = bid_(); u < 1024; u += gridDim.x) nsa_unit(P, half, u, smem);
    for (int u = bid_(); u < 1024; u += gridDim.x) hgrn_out_unit(P, half, u, smem);
    GSYNC();
  }
  phase_branch_merge(P, smem);
  GSYNC();
#if PROBE_DUP == 3
  phase_branch_merge(P, smem);
  GSYNC();
  phase_gemm<2>((const u16*)(ws + OFF_MERGED), 1024, (const u16*)(ws + OFF_WOUT_T), 1024, ws + OFF_Z1, smem);
  GSYNC();
#endif
  phase_gemm_wide<2>((const u16*)(ws + OFF_MERGED), 1024, (const u16*)(ws + OFF_WOUT_T), 1024, (u16*)(ws + OFF_Z1), smem);
  GSYNC();
  phase_rownorm<0, 1>(P, (const void*)(ws + OFF_Z1), P.n_post_mix, P.n_pre_mlp, (u16*)(ws + OFF_V));
  GSYNC();
#if PROBE_DUP == 4
  phase_gemm<1>((const u16*)(ws + OFF_V), 1024, (const u16*)(ws + OFF_WUP_T), 4096, ws + OFF_FFH, smem);
  GSYNC();
#endif
  phase_gemm_wide<1>((const u16*)(ws + OFF_V), 1024, (const u16*)(ws + OFF_WUP_T), 4096, (u16*)(ws + OFF_FFH), smem);
  GSYNC();
#if PROBE_DUP == 4
  phase_gemm<2>((const u16*)(ws + OFF_FFH), 4096, (const u16*)(ws + OFF_WDOWN_T), 1024, ws + OFF_Z2, smem);
  GSYNC();
#endif
  phase_gemm_wide<2>((const u16*)(ws + OFF_FFH), 4096, (const u16*)(ws + OFF_WDOWN_T), 1024, (u16*)(ws + OFF_Z2), smem);
  GSYNC();
  phase_rownorm<1, 1>(P, (const void*)(ws + OFF_Z2), P.n_post_mlp, nullptr, (u16*)(ws + OFF_H2B));
  GSYNC();
  phase_ple(P, smem);
  GSYNC();
#if PROBE_DUP == 5
  for (int i = 0; i < 10; ++i) GSYNC();
#endif
#if PROBE_DUP == 6
  phase_prep(P, smem);
  GSYNC();
#endif
  phase_rownorm<2, 0>(P, (const void*)(P.ws + OFF_Z3), P.n_ple, nullptr, nullptr);
}

extern "C" void kernel_launch(void* const* d_in, const int* in_sizes, int n_in, void* d_out, int out_size, void* d_ws,
                              size_t ws_size, hipStream_t stream) {
  Params P{};
  P.x = (const float*)d_in[0];
  P.p = (const float*)d_in[1];
  P.w_in = (const float*)d_in[2];
  P.w_a = (const float*)d_in[3];
  P.w_b = (const float*)d_in[4];
  P.w_out = (const float*)d_in[5];
  P.n_pre_mix = (const float*)d_in[6];
  P.n_post_mix = (const float*)d_in[7];
  P.n_pre_mlp = (const float*)d_in[8];
  P.n_post_mlp = (const float*)d_in[9];
  P.lb_logits = (const float*)d_in[10];
  P.gnorm = (const float*)d_in[11];
  P.pe_k = (const float*)d_in[12];
  P.pe_v = (const float*)d_in[13];
  P.wk1 = (const float*)d_in[14];
  P.wk2 = (const float*)d_in[15];
  P.wv1 = (const float*)d_in[16];
  P.wv2 = (const float*)d_in[17];
  P.w_up = (const float*)d_in[18];
  P.w_down = (const float*)d_in[19];
  P.w_ple = (const float*)d_in[20];
  P.w_pg = (const float*)d_in[21];
  P.n_ple = (const float*)d_in[22];
  P.out = (float*)d_out;
  P.ws = (char*)d_ws;
#if MEGA
  static int grid_blocks = 0;
  if (!grid_blocks) {
    int dev = 0, cus = 0, per_cu = 0;
    hipGetDevice(&dev);
    hipDeviceGetAttribute(&cus, hipDeviceAttributeMultiprocessorCount, dev);
    hipOccupancyMaxActiveBlocksPerMultiprocessor(&per_cu, k_mega, 256, 0);
    if (per_cu > 2) per_cu = 2;
    if (per_cu < 1) per_cu = 1;
    grid_blocks = cus * per_cu;
  }
  hipMemsetAsync((char*)d_ws + OFF_BAR, 0, XCD_BAR_WORDS * sizeof(unsigned), stream);
  void* args[] = {&P};
  hipError_t e = hipLaunchCooperativeKernel((void*)k_mega, dim3(grid_blocks), dim3(256), args, 0, stream);
  if (e != hipSuccess) fprintf(stderr, "cooperative launch failed: %s (grid %d)\n", hipGetErrorString(e), grid_blocks);
#endif
}
```

```cpp
#include <hip/hip_runtime.h>
#include <hip/hip_cooperative_groups.h>
#include <cstdio>
#include <cstdint>
namespace cg = cooperative_groups;

#ifndef MEGA
#define MEGA 1
#endif
#ifndef PROBE_DUP
#define PROBE_DUP 0
#endif

typedef unsigned short u16;
typedef __attribute__((ext_vector_type(8))) short bf16x8;
typedef __attribute__((ext_vector_type(4))) float f32x4;
typedef __attribute__((ext_vector_type(4))) unsigned u32x4;
typedef __attribute__((ext_vector_type(2))) unsigned u32x2;

#define MFMA(a, b, c) __builtin_amdgcn_mfma_f32_16x16x32_bf16(a, b, c, 0, 0, 0)
#define MIB ((size_t)1 << 20)

#define OFF_U       (0 * MIB)
#define OFF_YB0     (0 * MIB)
#define OFF_WA_T    (16 * MIB)
#define OFF_WB_T    (18 * MIB)
#define OFF_WOUT_T  (20 * MIB)
#define OFF_WPG_T   (22 * MIB)
#define OFF_WPLE_T  (24 * MIB)
#define OFF_WIN_T   (32 * MIB)
#define OFF_WUP_T   (32 * MIB)
#define OFF_WDOWN_T (40 * MIB)
#define OFF_WK1T    (50 * MIB)
#define OFF_WV1T    (51 * MIB)
#define OFF_WK2T    (52 * MIB)
#define OFF_WV2T    (52 * MIB + 32768)
#define OFF_ROPE    (52 * MIB + 65536)
#define OFF_BIAS1   (52 * MIB + 65536 + 262144)
#define OFF_LB      (52 * MIB + 65536 + 262144 + 4096)
#define OFF_BIAS1P  (52 * MIB + 65536 + 262144 + 16384)
#define OFF_NGATE   (53 * MIB)
#define OFF_SG      (56 * MIB)
#define OFF_NQ      (88 * MIB)
#define OFF_QF      (120 * MIB)
#define OFF_LOGF    (136 * MIB)
#define OFF_YB1     (136 * MIB)
#define OFF_HVT     (152 * MIB)
#define OFF_ABUF    (168 * MIB)
#define OFF_UST     (176 * MIB)
#define OFF_KV      (208 * MIB)
#define OFF_NQR     (224 * MIB)
#define OFF_VST     (228 * MIB)
#define OFF_VWT     (232 * MIB)
#define OFF_DCY     (236 * MIB)
#define OFF_HIDK    (236 * MIB + 524288)
#define OFF_HIDV    (237 * MIB + 524288)
#define OFF_KCMP    (238 * MIB + 524288)
#define OFF_VCMPT   (238 * MIB + 524288 + 262144)
#define OFF_MERGED  (88 * MIB)
#define OFF_Z1      (152 * MIB)
#define OFF_V       (56 * MIB)
#define OFF_FFH     (120 * MIB)
#define OFF_Z2      (56 * MIB)
#define OFF_H2B     (120 * MIB)
#define OFF_PB      (152 * MIB)
#define OFF_Z3      (160 * MIB)

struct Params {
  const float *x, *p, *w_in, *w_a, *w_b, *w_out, *n_pre_mix, *n_post_mix, *n_pre_mlp, *n_post_mlp;
  const float *lb_logits, *gnorm, *pe_k, *pe_v, *wk1, *wk2, *wv1, *wv2, *w_up, *w_down, *w_ple, *w_pg, *n_ple;
  float* out;
  char* ws;
};

__device__ __forceinline__ int bid_() { int b = blockIdx.x; asm volatile("" : "+s"(b)); return b; }
__device__ __forceinline__ int tid_() { int t = threadIdx.x; asm volatile("" : "+v"(t)); return t; }
typedef __attribute__((ext_vector_type(2))) float f32x2_t;
typedef __attribute__((ext_vector_type(2))) __bf16 bf16x2_t;
__device__ __forceinline__ uint32_t pack2(float a, float b) {
  f32x2_t v = {a, b};
  return __builtin_bit_cast(uint32_t, __builtin_convertvector(v, bf16x2_t));
}
__device__ __forceinline__ u16 f2bf(float f) { return (u16)(pack2(f, f) & 0xffffu); }
__device__ __forceinline__ float bf2f(u16 h) { return __uint_as_float(((uint32_t)h) << 16); }
__device__ __forceinline__ float shx_f(float v, int src_lane) { return __int_as_float(__builtin_amdgcn_ds_bpermute(src_lane << 2, __float_as_int(v))); }
__device__ __forceinline__ uint32_t shx_u(uint32_t v, int src_lane) { return (uint32_t)__builtin_amdgcn_ds_bpermute(src_lane << 2, (int)v); }
#define SHX(v, m) shx_f((v), lane ^ (m))
#define SHXU(v, m) shx_u((v), lane ^ (m))
__device__ __forceinline__ float sigm(float x) { return __builtin_amdgcn_rcpf(1.f + __expf(-x)); }
__device__ __forceinline__ float siluf(float x) { return x * __builtin_amdgcn_rcpf(1.f + __expf(-x)); }
__device__ __forceinline__ float gelu_tanh(float x) {
  float u = 0.7978845608028654f * (x + 0.044715f * x * x * x);
  float t = 1.f - 2.f * __builtin_amdgcn_rcpf(__expf(2.f * u) + 1.f);
  return 0.5f * x * (1.f + t);
}
__device__ __forceinline__ bf16x8 mk8(uint32_t a, uint32_t b, uint32_t c, uint32_t d) {
  u32x4 v = {a, b, c, d};
  return __builtin_bit_cast(bf16x8, v);
}
__device__ __forceinline__ bf16x8 ld8(const u16* p) { return *(const bf16x8*)p; }

template <int AMODE, int DEEP>
__device__ __forceinline__ void gemm_tile(const u16* __restrict__ A, long lda, int m0, int M,
                                          const u16* __restrict__ Bt, long ldb, int n0, int N, int K,
                                          int coloff, f32x4 (&acc)[4][4], u16* sA, u16* sB) {
  const int tid = tid_(), lane = tid & 63, wave = tid >> 6;
  const int l15 = lane & 15, G = lane >> 4;
  const int wm = wave >> 1, wn = wave & 1;
  const int lr = tid >> 3, ch = tid & 7;
  const char* Ab = (const char*)A;
  const char* Bb = (const char*)Bt;
  unsigned oa[4], ob[4];
  int tok0[4];
#pragma unroll
  for (int i = 0; i < 4; ++i) {
    int r = m0 + lr + 32 * i;
    if (AMODE == 0) {
      if (r > M - 1) r = M - 1;
      oa[i] = (unsigned)(((long)r * lda + ch * 8) * 2);
      tok0[i] = 0;
    } else {
      int grp = r >> 8, n = r & 255;
      int bl = grp >> 2, g = grp & 3;
      tok0[i] = n * 16;
      oa[i] = (unsigned)((bl * 4096 * 1024 + coloff + g * 64 + ch * 8) * 2);
    }
    int rn = n0 + lr + 32 * i;
    if (rn > N - 1) rn = N - 1;
    ob[i] = (unsigned)(((long)rn * ldb + ch * 8) * 2);
  }
#define G_LOAD(RA, RB, KT)                                                                                   \
  {                                                                                                          \
    const char* Ak_ = Ab + (size_t)(KT) * 128;                                                               \
    const char* Bk_ = Bb + (size_t)(KT) * 128;                                                               \
    _Pragma("unroll") for (int i = 0; i < 4; ++i) {                                                          \
      if (AMODE == 0) RA[i] = *(const u32x4*)(Ak_ + oa[i]);                                                  \
      else { int tok = tok0[i] + (KT); if (tok > 4095) tok = 4095; RA[i] = *(const u32x4*)(Ab + (oa[i] + (unsigned)tok * 2048u)); } \
      RB[i] = *(const u32x4*)(Bk_ + ob[i]);                                                                  \
    }                                                                                                        \
  }
#define L_STORE(RA, RB)                                                                                      \
  _Pragma("unroll") for (int i = 0; i < 4; ++i) {                                                            \
    *(u32x4*)&sA[(lr + 32 * i) * 80 + ch * 8] = RA[i];                                                       \
    *(u32x4*)&sB[(lr + 32 * i) * 80 + ch * 8] = RB[i];                                                       \
  }
#define T_COMPUTE()                                                                                          \
  _Pragma("unroll") for (int ks = 0; ks < 2; ++ks) {                                                         \
    bf16x8 af[4], bfr[4];                                                                                    \
    _Pragma("unroll") for (int i = 0; i < 4; ++i) af[i] = ld8(&sA[(wm * 64 + 16 * i + l15) * 80 + ks * 32 + G * 8]);  \
    _Pragma("unroll") for (int j = 0; j < 4; ++j) bfr[j] = ld8(&sB[(wn * 64 + 16 * j + l15) * 80 + ks * 32 + G * 8]); \
    _Pragma("unroll") for (int i = 0; i < 4; ++i)                                                            \
      _Pragma("unroll") for (int j = 0; j < 4; ++j) acc[i][j] = MFMA(af[i], bfr[j], acc[i][j]);              \
  }                                                                                                          \
     \
  __builtin_amdgcn_sched_group_barrier(0x100, 8, 0);                                                         \
  _Pragma("unroll") for (int z = 0; z < 8; ++z) {                                                            \
    __builtin_amdgcn_sched_group_barrier(0x008, 2, 0);                                                       \
    __builtin_amdgcn_sched_group_barrier(0x100, 1, 0);                                                       \
  }                                                                                                          \
  __builtin_amdgcn_sched_group_barrier(0x008, 16, 0);
  const int nk = K >> 6;
  if (DEEP == 2) {
    u32x4 ra0[4], rb0[4], ra1[4], rb1[4];
    const int kl = nk - 1;
    G_LOAD(ra0, rb0, 0);
    G_LOAD(ra1, rb1, 1);
    for (int kt = 0; kt < nk; kt += 2) {
      L_STORE(ra0, rb0);
      __syncthreads();
      G_LOAD(ra0, rb0, (kt + 2 < kl ? kt + 2 : kl));
      T_COMPUTE();
      __syncthreads();
      L_STORE(ra1, rb1);
      __syncthreads();
      G_LOAD(ra1, rb1, (kt + 3 < kl ? kt + 3 : kl));
      T_COMPUTE();
      __syncthreads();
    }
  } else {
    u32x4 ra0[4], rb0[4];
    G_LOAD(ra0, rb0, 0);
    for (int kt = 0; kt < nk; ++kt) {
      L_STORE(ra0, rb0);
      __syncthreads();
      if (kt + 1 < nk) G_LOAD(ra0, rb0, kt + 1);
      T_COMPUTE();
      __syncthreads();
    }
  }
#undef G_LOAD
#undef L_STORE
#undef T_COMPUTE
}

__device__ __forceinline__ void zero_acc(f32x4 (&acc)[4][4]) {
#pragma unroll
  for (int i = 0; i < 4; ++i)
#pragma unroll
    for (int j = 0; j < 4; ++j) acc[i][j] = (f32x4){0.f, 0.f, 0.f, 0.f};
}

#define EPI_VARS                                                         \
  const int tid = tid_(), lane = tid & 63, wave = tid >> 6;         \
  const int l15 = lane & 15, G = lane >> 4;                              \
  const int wm = wave >> 1, wn = wave & 1;                               \
  (void)l15; (void)G; (void)wm; (void)wn;

__device__ __forceinline__ void transpose_tile(const float* __restrict__ W, int ldw, int oc0, int valid, int k0, u16* __restrict__ out,
                               long Kdim, int n0, float* s  ) {
  const int tid = tid_();
  __syncthreads();
  {
    const bool vec = (valid == 64) && (((oc0 | ldw) & 3) == 0);
    if (vec) {
      const int n4 = (tid & 15) * 4;
      float4 v[4];
#pragma unroll
      for (int i = 0; i < 4; ++i) v[i] = *(const float4*)(W + (long)(k0 + (tid >> 4) + 16 * i) * ldw + oc0 + n4);
#pragma unroll
      for (int i = 0; i < 4; ++i) {
        float* d = &s[((tid >> 4) + 16 * i) * 65 + n4];
        d[0] = v[i].x; d[1] = v[i].y; d[2] = v[i].z; d[3] = v[i].w;
      }
    } else {
      const int n = tid & 63;
      for (int kk = tid >> 6; kk < 64; kk += 4) {
        float v = 0.f;
        if (n < valid) v = W[(long)(k0 + kk) * ldw + oc0 + n];
        s[kk * 65 + n] = v;
      }
    }
  }
  __syncthreads();
  {
    const int nn = tid >> 2, kq = (tid & 3) * 16;
    uint32_t w[8];
#pragma unroll
    for (int e = 0; e < 8; ++e) w[e] = pack2(s[(kq + 2 * e) * 65 + nn], s[(kq + 2 * e + 1) * 65 + nn]);
    u16* dst = out + (long)(n0 + nn) * Kdim + k0 + kq;
    *(u32x4*)dst = (u32x4){w[0], w[1], w[2], w[3]};
    *(u32x4*)(dst + 8) = (u32x4){w[4], w[5], w[6], w[7]};
  }
}

__device__ __forceinline__ void transpose_job(const float* W, int N, int K, u16* out, int tile, float* s) {
  const int kt_n = K >> 6;
  const int nt = tile / kt_n, kt = tile % kt_n;
  transpose_tile(W, N, nt * 64, 64, kt * 64, out, K, nt * 64, s);
}

__device__ __forceinline__ void phase_prep(const Params& P, char* smem) {
  const int tid = tid_(), lane = tid & 63, wave = tid >> 6;
  char* ws = P.ws;
  float* sf = (float*)smem;
  {
    u16* U = (u16*)(ws + OFF_U);
    for (int un = bid_(); un < 2048; un += gridDim.x) {
      const int row0 = un * 8 + wave * 2;
      float4 v[2][4];
      float ss[2] = {0.f, 0.f};
#pragma unroll
      for (int rr = 0; rr < 2; ++rr)
#pragma unroll
        for (int j = 0; j < 4; ++j) v[rr][j] = *(const float4*)(P.x + (long)(row0 + rr) * 1024 + j * 256 + lane * 4);
#pragma unroll
      for (int rr = 0; rr < 2; ++rr) {
#pragma unroll
        for (int j = 0; j < 4; ++j)
          ss[rr] += v[rr][j].x * v[rr][j].x + v[rr][j].y * v[rr][j].y + v[rr][j].z * v[rr][j].z + v[rr][j].w * v[rr][j].w;
#pragma unroll
        for (int o = 32; o >= 1; o >>= 1) ss[rr] += SHX(ss[rr], o);
        const float r = rsqrtf(ss[rr] * (1.f / 1024.f) + 1e-6f);
#pragma unroll
        for (int j = 0; j < 4; ++j) {
          const float4 w = *(const float4*)(P.n_pre_mix + j * 256 + lane * 4);
          u32x2 o2 = {pack2(v[rr][j].x * r * w.x, v[rr][j].y * r * w.y), pack2(v[rr][j].z * r * w.z, v[rr][j].w * r * w.w)};
          *(u32x2*)(U + (long)(row0 + rr) * 1024 + j * 256 + lane * 4) = o2;
        }
      }
    }
  }
  {
    u16* WT = (u16*)(ws + OFF_WIN_T);
    for (int t = bid_(); t < 138 * 16; t += gridDim.x) {
      const int nt = t >> 4, kt = t & 15;
      const int nr0 = nt * 64;
      int oc0, valid;
      if (nr0 < 6656) { oc0 = nr0; valid = 64; }
      else if (nr0 < 8704) { oc0 = nr0 + 48; valid = 64; }
      else if (nr0 == 8704) { oc0 = 6656; valid = 48; }
      else { oc0 = 0; valid = 0; }
      transpose_tile(P.w_in, 8752, oc0, valid, kt * 64, WT, 1024, nr0, sf);
    }
    for (int t = bid_(); t < 128; t += gridDim.x) transpose_job(P.wk1, 256, 2048, (u16*)(ws + OFF_WK1T), t, sf);
    for (int t = bid_(); t < 128; t += gridDim.x) transpose_job(P.wv1, 256, 2048, (u16*)(ws + OFF_WV1T), t, sf);
    for (int t = bid_(); t < 4; t += gridDim.x) transpose_job(P.wk2, 64, 256, (u16*)(ws + OFF_WK2T), t, sf);
    for (int t = bid_(); t < 4; t += gridDim.x) transpose_job(P.wv2, 64, 256, (u16*)(ws + OFF_WV2T), t, sf);
  }
  {
    float2* RT = (float2*)(ws + OFF_ROPE);
    for (int un = bid_(); un < 128; un += gridDim.x) {
      const int idx = un * 256 + tid;
      const int t = idx >> 3, j = idx & 7;
      const float inv = (j == 0) ? 1.0f : (j == 1) ? 0.1939227432012558f : (j == 2) ? 0.03760603070259094f
                      : (j == 3) ? 0.007292664609849453f : (j == 4) ? 0.0014142135623842478f
                      : (j == 5) ? 0.00027424818836152554f : (j == 6) ? 5.3182957344688475e-05f : 1.0313385246263351e-05f;
      const float ang = (float)t * inv;
      const double ad = (double)ang;
      const double kq = rint(ad * 0.15915494309189535);
      const float rr = (float)(ad - kq * 6.283185307179586);
      float sn, cs;
      sincosf(rr, &sn, &cs);
      RT[idx] = make_float2(cs, sn);
    }
  }
  {
    float* B1P = (float*)(ws + OFF_BIAS1P);
    for (int un = bid_(); un < 16; un += gridDim.x) {
      const int kvi = un >> 3, part = un & 7;
      const float* pe = kvi ? P.pe_v : P.pe_k;
      const float* w1 = kvi ? P.wv1 : P.wk1;
      float4 a = make_float4(0.f, 0.f, 0.f, 0.f);
      const int k0 = part * 256 + wave * 64;
#pragma unroll 8
      for (int k = k0; k < k0 + 64; ++k) {
        const float pv = pe[k];
        const float4 w = *(const float4*)(w1 + (long)k * 256 + lane * 4);
        a.x += pv * w.x; a.y += pv * w.y; a.z += pv * w.z; a.w += pv * w.w;
      }
      __syncthreads();
      *(float4*)&sf[wave * 256 + lane * 4] = a;
      __syncthreads();
      B1P[un * 256 + tid] = sf[tid] + sf[256 + tid] + sf[512 + tid] + sf[768 + tid];
      __syncthreads();
    }
  }
  {
    float* LB = (float*)(ws + OFF_LB);
    for (int un = bid_(); un < 4; un += gridDim.x) {
      const int c = un * 256 + tid;
      const float l0 = P.lb_logits[c], l1 = P.lb_logits[1024 + c];
      LB[c] = 1.f / (1.f + expf(l1 - l0));
    }
  }
}

__device__ __forceinline__ void phase_late_weights(const Params& P, char* smem) {
  char* ws = P.ws;
  float* sf = (float*)smem;
  for (int t = bid_(); t < 256; t += gridDim.x) transpose_job(P.w_a, 1024, 1024, (u16*)(ws + OFF_WA_T), t, sf);
  for (int t = bid_(); t < 256; t += gridDim.x) transpose_job(P.w_b, 1024, 1024, (u16*)(ws + OFF_WB_T), t, sf);
  for (int t = bid_(); t < 256; t += gridDim.x) transpose_job(P.w_out, 1024, 1024, (u16*)(ws + OFF_WOUT_T), t, sf);
  for (int t = bid_(); t < 256; t += gridDim.x) transpose_job(P.w_pg, 1024, 1024, (u16*)(ws + OFF_WPG_T), t, sf);
  for (int t = bid_(); t < 1024; t += gridDim.x) transpose_job(P.w_up, 4096, 1024, (u16*)(ws + OFF_WUP_T), t, sf);
  for (int t = bid_(); t < 1024; t += gridDim.x) transpose_job(P.w_down, 1024, 4096, (u16*)(ws + OFF_WDOWN_T), t, sf);
  for (int t = bid_(); t < 64; t += gridDim.x) transpose_job(P.w_ple, 1024, 256, (u16*)(ws + OFF_WPLE_T), t, sf);
}

__device__ __forceinline__ void phase_inproj(const Params& P, int half, char* smem) {
  char* ws = P.ws;
  u16* sA = (u16*)smem;
  u16* sB = sA + 128 * 80;
  float* sF = (float*)smem;
  const u16* U = (const u16*)(ws + OFF_U) + (long)half * 8192 * 1024;
  const u16* WT = (const u16*)(ws + OFF_WIN_T);
  u16* QF = (u16*)(ws + OFF_QF);
  u16* LOGF = (u16*)(ws + OFF_LOGF);
  u16* HVT = (u16*)(ws + OFF_HVT);
  u16* SG = (u16*)(ws + OFF_SG) + (long)half * 8192 * 1024;
  u16* NQ = (u16*)(ws + OFF_NQ) + (long)half * 8192 * 1024;
  u16* NQR = (u16*)(ws + OFF_NQR);
  u16* KV = (u16*)(ws + OFF_KV);
  u16* VST = (u16*)(ws + OFF_VST);
  u16* VWT = (u16*)(ws + OFF_VWT);
  u16* GATES = (u16*)P.out + (long)half * 8192 * 2048;
  float* NGATE = (float*)(ws + OFF_NGATE) + (long)half * 8192 * 48;
  const float* RTf = (const float*)(ws + OFF_ROPE);
  const float* LB = (const float*)(ws + OFF_LB);
  for (int t = bid_(); t < 64 * 69; t += gridDim.x) {
    const int nt = t >> 6, mt = t & 63;
    const int m0 = mt * 128, n0 = nt * 128;
    f32x4 acc[4][4];
    zero_acc(acc);
    gemm_tile<0, 2>(U, 1024, m0, 8192, WT, 1024, n0, 8832, 1024, 0, acc, sA, sB);
    {
      EPI_VARS
#pragma unroll
      for (int i = 0; i < 4; ++i)
#pragma unroll
        for (int j = 0; j < 4; ++j)
#pragma unroll
          for (int e = 0; e < 4; ++e) sF[(wm * 64 + 16 * i + G * 4 + e) * 128 + wn * 64 + 16 * j + l15] = acc[i][j][e];
    }
    __syncthreads();
    const int tc = tid_();
    int kind = 0, op = 0, dstride = 1024, dcol = 0;
    u16* dbase = nullptr;
    u16* tbase = nullptr;
    if (nt < 8) { dbase = QF; dcol = n0; op = 0; }
    else if (nt < 16) { dbase = LOGF; dcol = n0 - 1024; op = 1; }
    else if (nt < 24) { kind = 1; tbase = HVT; }
    else if (nt < 32) { dbase = SG; dcol = n0 - 3072; op = 2; }
    else if (nt < 40) { dbase = NQ; dcol = n0 - 4096; op = 3; }
    else if (nt < 52) {
      const int c0 = n0 - 5120, sub0 = c0 >> 8;
      if (sub0 == 3 || sub0 == 5) { kind = 2; tbase = (sub0 == 3) ? VST : VWT; }
      else { dbase = KV; dcol = ((sub0 == 0) ? 0 : (sub0 == 1) ? 256 : (sub0 == 2) ? 512 : 768) + (c0 & 255); op = (sub0 >= 2) ? 5 : 4; }
    } else if (nt < 68) { dbase = GATES; dstride = 2048; dcol = n0 - 6656; op = 6; }
    else kind = 3;

    if (kind == 0) {
#pragma unroll 2
      for (int k8 = 0; k8 < 8; ++k8) {
        const int id = tc + 256 * k8;
        const int row = id >> 4, c8 = (id & 15) * 8;
        const float4 f0 = *(const float4*)&sF[row * 128 + c8];
        const float4 f1 = *(const float4*)&sF[row * 128 + c8 + 4];
        float v[8] = {f0.x, f0.y, f0.z, f0.w, f1.x, f1.y, f1.z, f1.w};
        const int hc = c8 & 63;
        if (op == 0) {
#pragma unroll
          for (int q = 0; q < 8; ++q) v[q] = siluf(v[q]) * 0.08838834764831845f;
        } else if (op == 1) {
          const float4 l0 = *(const float4*)(LB + dcol + c8);
          const float4 l1 = *(const float4*)(LB + dcol + c8 + 4);
          const float lb[8] = {l0.x, l0.y, l0.z, l0.w, l1.x, l1.y, l1.z, l1.w};
#pragma unroll
          for (int q = 0; q < 8; ++q) v[q] = __logf(lb[q] + (1.f - lb[q]) * sigm(v[q]));
        } else if (op == 2) {
#pragma unroll
          for (int q = 0; q < 8; ++q) v[q] = siluf(v[q]);
        } else if (op == 3) {
#pragma unroll
          for (int q = 0; q < 8; ++q) v[q] *= 0.18033688011112042f;
        } else if (op == 6) {
#pragma unroll
          for (int q = 0; q < 8; ++q) v[q] = sigm(v[q]);
        }
        if ((op == 3 || op == 5) && hc < 16) {
          const int pc = (hc == 0) ? c8 + 8 : c8 - 8;
          const float4 g0 = *(const float4*)&sF[row * 128 + pc];
          const float4 g1 = *(const float4*)&sF[row * 128 + pc + 4];
          float pr[8] = {g0.x, g0.y, g0.z, g0.w, g1.x, g1.y, g1.z, g1.w};
          if (op == 3) {
#pragma unroll
            for (int q = 0; q < 8; ++q) pr[q] *= 0.18033688011112042f;
          }
          const int tt = (m0 + row) & 4095;
          const float4 r0 = *(const float4*)(RTf + tt * 16);
          const float4 r1 = *(const float4*)(RTf + tt * 16 + 4);
          const float4 r2 = *(const float4*)(RTf + tt * 16 + 8);
          const float4 r3 = *(const float4*)(RTf + tt * 16 + 12);
          const float cs[8] = {r0.x, r0.z, r1.x, r1.z, r2.x, r2.z, r3.x, r3.z};
          const float sn[8] = {r0.y, r0.w, r1.y, r1.w, r2.y, r2.w, r3.y, r3.w};
          float ro[8];
#pragma unroll
          for (int q = 0; q < 8; ++q) ro[q] = (hc == 0) ? (v[q] * cs[q] - pr[q] * sn[q]) : (v[q] * cs[q] + pr[q] * sn[q]);
          if (op == 3) {
            const int head = (dcol + c8) >> 6;
            *(u32x4*)(NQR + (long)(m0 + row) * 256 + head * 16 + hc) =
                (u32x4){pack2(ro[0], ro[1]), pack2(ro[2], ro[3]), pack2(ro[4], ro[5]), pack2(ro[6], ro[7])};
          } else {
#pragma unroll
            for (int q = 0; q < 8; ++q) v[q] = ro[q];
          }
        }
        u32x4 o4;
        if (op == 1) {
          union { _Float16 h[8]; u32x4 u; } cv;
#pragma unroll
          for (int q = 0; q < 8; ++q) cv.h[q] = (_Float16)v[q];
          o4 = cv.u;
        } else {
          o4 = (u32x4){pack2(v[0], v[1]), pack2(v[2], v[3]), pack2(v[4], v[5]), pack2(v[6], v[7])};
        }
        *(u32x4*)(dbase + (long)(m0 + row) * dstride + dcol + c8) = o4;
      }
    } else if (kind == 1 || kind == 2) {
#pragma unroll 2
      for (int k8 = 0; k8 < 8; ++k8) {
        const int id = tc + 256 * k8;
        const int col = id & 127, r8 = (id >> 7) * 8;
        float v[8];
#pragma unroll
        for (int q = 0; q < 8; ++q) v[q] = sF[(r8 + q) * 128 + col];
        const int r = m0 + r8;
        const int bl = r >> 12, tt = r & 4095;
        unsigned off;
        if (kind == 1) {
          const int c = n0 + col - 2048;
          const int h = c >> 7, dv = c & 127;
          off = ((unsigned)(((bl * 8 + h) * 64 + (tt >> 6)) * 128 + dv) * 64u + (unsigned)(tt & 63)) * 2u;
        } else {
          const int cc = (n0 + col - 5120) & 255;
          const int g = cc >> 6, d = cc & 63;
          off = ((unsigned)((bl * 4 + g) * 64 + d) * 4096u + (unsigned)tt) * 2u;
        }
        *(u32x4*)((char*)tbase + off) = (u32x4){pack2(v[0], v[1]), pack2(v[2], v[3]), pack2(v[4], v[5]), pack2(v[6], v[7])};
      }
    } else {
      for (int id = tc; id < 128 * 48; id += 256) {
        const int row = id / 48, c = id - row * 48;
        NGATE[(long)(m0 + row) * 48 + c] = sigm(sF[row * 128 + c]);
      }
    }
    __syncthreads();
  }
}

__device__ __forceinline__ void hgrn_intra_unit(const Params& P, int uu, char* smem) {
  char* ws = P.ws;
  const int tid = tid_(), lane = tid & 63, wave = tid >> 6;
  const int l15 = lane & 15, G = lane >> 4;
  float* sBc = (float*)smem;
  u16* sQ = (u16*)(smem + 64 * 132 * 4);
  const int bl = uu >> 9, h = (uu >> 6) & 7, c = uu & 63;
  const long r0 = (long)bl * 4096 + c * 64;
  u16* QF = (u16*)(ws + OFF_QF);
  const _Float16* LOGF = (const _Float16*)(ws + OFF_LOGF);
  const u16* HVT = (const u16*)(ws + OFF_HVT);
  u16* ABUF = (u16*)(ws + OFF_ABUF);
  u16* UST = (u16*)(ws + OFF_UST);
  float* DCY = (float*)(ws + OFF_DCY);

  __syncthreads();
#pragma unroll
  for (int i = 0; i < 4; ++i) {
    const int id = tid + 256 * i;
    const int row = id >> 4, cc = (id & 15) * 8;
    const u32x4 lf = *(const u32x4*)(LOGF + (r0 + row) * 1024 + h * 128 + cc);
    const _Float16* hp = (const _Float16*)&lf;
#pragma unroll
    for (int e = 0; e < 8; ++e) sBc[row * 132 + cc + e] = (float)hp[e];
    *(u32x4*)&sQ[row * 136 + cc] = *(const u32x4*)(QF + (r0 + row) * 1024 + h * 128 + cc);
  }
  __syncthreads();
  if (tid < 128) {
    float run = 0.f;
    for (int s = 0; s < 64; ++s) {
      run += sBc[s * 132 + tid];
      sBc[s * 132 + tid] = run;
    }
  }
  __syncthreads();
#pragma unroll
  for (int i = 0; i < 4; ++i) {
    const int id = tid + 256 * i;
    const int row = id >> 4, cc = (id & 15) * 8;
    uint32_t w[4];
#pragma unroll
    for (int e = 0; e < 4; ++e) {
      const float q0 = bf2f(sQ[row * 136 + cc + 2 * e]) * __expf(sBc[row * 132 + cc + 2 * e]);
      const float q1 = bf2f(sQ[row * 136 + cc + 2 * e + 1]) * __expf(sBc[row * 132 + cc + 2 * e + 1]);
      w[e] = pack2(q0, q1);
    }
    *(u32x4*)(QF + (r0 + row) * 1024 + h * 128 + cc) = (u32x4){w[0], w[1], w[2], w[3]};
  }
  if (tid < 128) DCY[(long)uu * 128 + tid] = __expf(sBc[63 * 132 + tid]);
  for (int idx = tid; idx < 4096; idx += 256) {
    const int t = idx >> 6, s = idx & 63;
    if ((s >> 4) > (t >> 4)) ABUF[(long)uu * 4096 + idx] = 0;
  }
  for (int ti = wave; ti < 10; ti += 4) {
    int i, j;
    if (ti == 0) { i = 0; j = 0; }
    else if (ti < 3) { i = 1; j = ti - 1; }
    else if (ti < 6) { i = 2; j = ti - 3; }
    else { i = 3; j = ti - 6; }
    f32x4 a4 = {0.f, 0.f, 0.f, 0.f};
    const int t = 16 * i + l15, s = 16 * j + l15;
#pragma unroll
    for (int ks = 0; ks < 4; ++ks) {
      const int dk0 = ks * 32 + G * 8;
      uint32_t aw[4], bw[4];
#pragma unroll
      for (int e2 = 0; e2 < 4; ++e2) {
        float av[2], bv[2];
#pragma unroll
        for (int z = 0; z < 2; ++z) {
          const int dk = dk0 + 2 * e2 + z;
          const float br = sBc[(16 * i) * 132 + dk];
          const float bt = sBc[t * 132 + dk];
          av[z] = bf2f(sQ[t * 136 + dk]) * __expf(bt - br);
          const float bs = sBc[s * 132 + dk];
          const float bp = (s > 0) ? sBc[(s - 1) * 132 + dk] : 0.f;
          const float kk = 1.f - __expf(bs - bp);
          bv[z] = kk * __expf(br - bs);
        }
        aw[e2] = pack2(av[0], av[1]);
        bw[e2] = pack2(bv[0], bv[1]);
      }
      a4 = MFMA(mk8(aw[0], aw[1], aw[2], aw[3]), mk8(bw[0], bw[1], bw[2], bw[3]), a4);
    }
#pragma unroll
    for (int e = 0; e < 4; ++e) {
      const int tr = 16 * i + G * 4 + e, sc = 16 * j + l15;
      const float v = (sc <= tr) ? a4[e] : 0.f;
      ABUF[(long)uu * 4096 + tr * 64 + sc] = f2bf(v);
    }
  }
  {
    f32x4 ua[8][2];
#pragma unroll
    for (int rt = 0; rt < 8; ++rt) { ua[rt][0] = (f32x4){0.f, 0.f, 0.f, 0.f}; ua[rt][1] = (f32x4){0.f, 0.f, 0.f, 0.f}; }
#pragma unroll
    for (int ks = 0; ks < 2; ++ks) {
      bf16x8 bfr[2];
#pragma unroll
      for (int ct = 0; ct < 2; ++ct) {
        const int dk = (2 * wave + ct) * 16 + l15;
        const float blast = sBc[63 * 132 + dk];
        const int s0 = ks * 32 + G * 8;
        float prev = (s0 > 0) ? sBc[(s0 - 1) * 132 + dk] : 0.f;
        uint32_t bw[4];
#pragma unroll
        for (int e2 = 0; e2 < 4; ++e2) {
          const float b0 = sBc[(s0 + 2 * e2) * 132 + dk];
          const float b1 = sBc[(s0 + 2 * e2 + 1) * 132 + dk];
          const float k0 = (1.f - __expf(b0 - prev)) * __expf(blast - b0);
          const float k1 = (1.f - __expf(b1 - b0)) * __expf(blast - b1);
          prev = b1;
          bw[e2] = pack2(k0, k1);
        }
        bfr[ct] = mk8(bw[0], bw[1], bw[2], bw[3]);
      }
#pragma unroll
      for (int rt = 0; rt < 8; ++rt) {
        const int dv = rt * 16 + l15;
        const bf16x8 af = ld8(HVT + ((long)uu * 128 + dv) * 64 + ks * 32 + G * 8);
        ua[rt][0] = MFMA(af, bfr[0], ua[rt][0]);
        ua[rt][1] = MFMA(af, bfr[1], ua[rt][1]);
      }
    }
#pragma unroll
    for (int rt = 0; rt < 8; ++rt)
#pragma unroll
      for (int ct = 0; ct < 2; ++ct)
#pragma unroll
        for (int e = 0; e < 4; ++e) {
          const int dv = rt * 16 + G * 4 + e, dk = (2 * wave + ct) * 16 + l15;
          UST[((long)uu * 128 + dv) * 128 + dk] = f2bf(ua[rt][ct][e]);
        }
  }
}

__device__ __forceinline__ void cmp_gemm1_tile(const Params& P, int t, char* smem) {
  char* ws = P.ws;
  u16* sA = (u16*)smem;
  u16* sB = sA + 128 * 80;
  EPI_VARS
  const int kv = t >> 5, rem = t & 31;
  const int mt = rem >> 1, nt = rem & 1;
  const int m0 = mt * 128, n0 = nt * 128;
  const u16* KV = (const u16*)(ws + OFF_KV);
  const u16* W1T = (const u16*)(ws + (kv ? OFF_WV1T : OFF_WK1T));
  u16* HID = (u16*)(ws + (kv ? OFF_HIDV : OFF_HIDK));
  const float* B1P = (const float*)(ws + OFF_BIAS1P) + kv * 2048;
  f32x4 acc[4][4];
  zero_acc(acc);
  gemm_tile<1, 2>(KV, 1024, m0, 2048, W1T, 2048, n0, 256, 2048, kv * 256, acc, sA, sB);
#pragma unroll
  for (int i = 0; i < 4; ++i)
#pragma unroll
    for (int j = 0; j < 4; ++j) {
      const int col = n0 + wn * 64 + 16 * j + l15;
      float bias = 0.f;
#pragma unroll
      for (int pp = 0; pp < 8; ++pp) bias += B1P[pp * 256 + col];
#pragma unroll
      for (int e = 0; e < 4; ++e) {
        const int row = m0 + wm * 64 + 16 * i + G * 4 + e;
        HID[(long)row * 256 + col] = f2bf(gelu_tanh(acc[i][j][e] + bias));
      }
    }
}

__device__ __forceinline__ void cmp_gemm2_tile(const Params& P, int t, char* smem) {
  char* ws = P.ws;
  u16* sA = (u16*)smem;
  u16* sB = sA + 128 * 80;
  EPI_VARS
  const int kv = t >> 4, mt = t & 15;
  const int m0 = mt * 128;
  const u16* HID = (const u16*)(ws + (kv ? OFF_HIDV : OFF_HIDK));
  const u16* W2T = (const u16*)(ws + (kv ? OFF_WV2T : OFF_WK2T));
  u16* KCMP = (u16*)(ws + OFF_KCMP);
  u16* VCMPT = (u16*)(ws + OFF_VCMPT);
  f32x4 acc[4][4];
  zero_acc(acc);
  gemm_tile<0, 1>(HID, 256, m0, 2048, W2T, 256, 0, 64, 256, 0, acc, sA, sB);
  if (wn == 0) {
#pragma unroll
    for (int i = 0; i < 4; ++i)
#pragma unroll
      for (int j = 0; j < 4; ++j) {
        const int col = 16 * j + l15;
        const int rbase = m0 + wm * 64 + 16 * i + G * 4;
        if (kv == 0) {
#pragma unroll
          for (int e = 0; e < 4; ++e) KCMP[(long)(rbase + e) * 64 + col] = f2bf(acc[i][j][e]);
        } else {
          const int grp = rbase >> 8, n = rbase & 255;
          u32x2 o2 = {pack2(acc[i][j][0], acc[i][j][1]), pack2(acc[i][j][2], acc[i][j][3])};
          *(u32x2*)(VCMPT + ((long)grp * 64 + col) * 256 + n) = o2;
        }
      }
  }
}

__device__ __forceinline__ void hgrn_scan(const Params& P) {
  char* ws = P.ws;
  u16* UST = (u16*)(ws + OFF_UST);
  const float* DCY = (const float*)(ws + OFF_DCY);
  for (int idx = bid_() * 256 + tid_(); idx < 131072; idx += gridDim.x * 256) {
    const int bh = idx >> 13, rem = idx & 8191;
    const int dv = rem >> 6, dk2 = (rem & 63) * 2;
    float s0 = 0.f, s1 = 0.f;
#pragma unroll 8
    for (int c = 0; c < 64; ++c) {
      const long uu = (long)bh * 64 + c;
      u16* ptr = UST + (uu * 128 + dv) * 128 + dk2;
      const uint32_t uv = *(const uint32_t*)ptr;
      const float2 d = *(const float2*)(DCY + uu * 128 + dk2);
      *(uint32_t*)ptr = pack2(s0, s1);
      s0 = d.x * s0 + __uint_as_float(uv << 16);
      s1 = d.y * s1 + __uint_as_float(uv & 0xffff0000u);
    }
  }
}

__device__ __forceinline__ void hgrn_out_unit(const Params& P, int half, int uu, char* smem) {
  char* ws = P.ws;
  const int tid = tid_(), lane = tid & 63, wave = tid >> 6;
  const int l15 = lane & 15, G = lane >> 4;
  float* sO = (float*)smem;
  const int bl = uu >> 9, h = (uu >> 6) & 7, c = uu & 63;
  const long r0 = (long)bl * 4096 + c * 64;
  const u16* QF = (const u16*)(ws + OFF_QF);
  const u16* HVT = (const u16*)(ws + OFF_HVT);
  const u16* ABUF = (const u16*)(ws + OFF_ABUF);
  const u16* UST = (const u16*)(ws + OFF_UST);
  u16* SG = (u16*)(ws + OFF_SG) + (long)half * 8192 * 1024;
  f32x4 acc[4][2];
#pragma unroll
  for (int i = 0; i < 4; ++i) { acc[i][0] = (f32x4){0.f, 0.f, 0.f, 0.f}; acc[i][1] = (f32x4){0.f, 0.f, 0.f, 0.f}; }
#pragma unroll
  for (int ks = 0; ks < 4; ++ks) {
    const int dk0 = ks * 32 + G * 8;
    bf16x8 bfr[2];
#pragma unroll
    for (int jt = 0; jt < 2; ++jt) bfr[jt] = ld8(UST + ((long)uu * 128 + 32 * wave + 16 * jt + l15) * 128 + dk0);
#pragma unroll
    for (int i = 0; i < 4; ++i) {
      const bf16x8 af = ld8(QF + (r0 + 16 * i + l15) * 1024 + h * 128 + dk0);
      acc[i][0] = MFMA(af, bfr[0], acc[i][0]);
      acc[i][1] = MFMA(af, bfr[1], acc[i][1]);
    }
  }
#pragma unroll
  for (int ks = 0; ks < 2; ++ks) {
    const int s0 = ks * 32 + G * 8;
    bf16x8 bfr[2];
#pragma unroll
    for (int jt = 0; jt < 2; ++jt) bfr[jt] = ld8(HVT + ((long)uu * 128 + 32 * wave + 16 * jt + l15) * 64 + s0);
#pragma unroll
    for (int i = 0; i < 4; ++i) {
      const bf16x8 af = ld8(ABUF + (long)uu * 4096 + (16 * i + l15) * 64 + s0);
      acc[i][0] = MFMA(af, bfr[0], acc[i][0]);
      acc[i][1] = MFMA(af, bfr[1], acc[i][1]);
    }
  }
  __syncthreads();
#pragma unroll
  for (int i = 0; i < 4; ++i)
#pragma unroll
    for (int jt = 0; jt < 2; ++jt)
#pragma unroll
      for (int e = 0; e < 4; ++e) sO[(16 * i + G * 4 + e) * 132 + 32 * wave + 16 * jt + l15] = acc[i][jt][e];
  __syncthreads();
  {
    const int row = tid >> 2, part = tid & 3;
    float ss = 0.f;
#pragma unroll
    for (int cc = 0; cc < 32; ++cc) { const float v = sO[row * 132 + part * 32 + cc]; ss += v * v; }
    ss += SHX(ss, 1);
    ss += SHX(ss, 2);
    const float r = rsqrtf(ss * (1.f / 128.f) + 1e-6f);
    u16* dst = SG + (r0 + row) * 1024 + h * 128 + part * 32;
#pragma unroll
    for (int q4 = 0; q4 < 4; ++q4) {
      const u32x4 sgv = *(const u32x4*)(dst + q4 * 8);
      uint32_t w[4];
#pragma unroll
      for (int e = 0; e < 4; ++e) {
        const int cc = q4 * 8 + 2 * e;
        const float g0 = __uint_as_float(sgv[e] << 16), g1 = __uint_as_float(sgv[e] & 0xffff0000u);
        const float y0 = sO[row * 132 + part * 32 + cc] * r * P.gnorm[part * 32 + cc] * g0;
        const float y1 = sO[row * 132 + part * 32 + cc + 1] * r * P.gnorm[part * 32 + cc + 1] * g1;
        w[e] = pack2(y0, y1);
      }
      *(u32x4*)(dst + q4 * 8) = (u32x4){w[0], w[1], w[2], w[3]};
    }
  }
}

__device__ __forceinline__ void stage_kv(u16* sK, u16* sV, const u16* kptr, long kstride, const u16* vptr, long vstride) {
  const int tid = tid_();
  __syncthreads();
#pragma unroll
  for (int i = 0; i < 2; ++i) {
    const int id = tid + 256 * i;
    const int row = id >> 3, ch = id & 7;
    *(u32x4*)&sK[row * 72 + ch * 8] = *(const u32x4*)(kptr + row * kstride + ch * 8);
    *(u32x4*)&sV[row * 72 + ch * 8] = *(const u32x4*)(vptr + row * vstride + ch * 8);
  }
  __syncthreads();
}

__device__ __forceinline__ void qk_scores(const u16* sK, const bf16x8 (&q)[2], f32x4 (&s)[4], int l15, int G) {
#pragma unroll
  for (int kt = 0; kt < 4; ++kt) {
    s[kt] = (f32x4){0.f, 0.f, 0.f, 0.f};
#pragma unroll
    for (int ks = 0; ks < 2; ++ks) s[kt] = MFMA(ld8(&sK[(16 * kt + l15) * 72 + ks * 32 + G * 8]), q[ks], s[kt]);
  }
}

__device__ __forceinline__ void pv_accum(const u16* sV, const f32x4 (&p)[4], f32x4 (&o)[4], int l15, int G) {
#pragma unroll
  for (int ks2 = 0; ks2 < 2; ++ks2) {
    const f32x4 pa = p[2 * ks2], pb = p[2 * ks2 + 1];
    const bf16x8 pf = mk8(pack2(pa[0], pa[1]), pack2(pa[2], pa[3]), pack2(pb[0], pb[1]), pack2(pb[2], pb[3]));
#pragma unroll
    for (int dt = 0; dt < 4; ++dt) {
      const u32x2 v0 = *(const u32x2*)&sV[(16 * dt + l15) * 72 + 32 * ks2 + 4 * G];
      const u32x2 v1 = *(const u32x2*)&sV[(16 * dt + l15) * 72 + 32 * ks2 + 16 + 4 * G];
      o[dt] = MFMA(mk8(v0[0], v0[1], v1[0], v1[1]), pf, o[dt]);
    }
  }
}

#define EX2(x) __builtin_amdgcn_exp2f(x)
typedef __attribute__((ext_vector_type(16))) float f32x16;
#define MFMA32(a, b, c) __builtin_amdgcn_mfma_f32_32x32x16_bf16((a), (b), (c), 0, 0, 0)
template <int MODE, bool EDGE>
__device__ __forceinline__ void nsa_block(const u16* sK, const u16* sV, int jb, int qb, int q, bool blk_ok,
                                          const bf16x8 (&qf)[4], f32x16 (&O)[2], float& m, float& l, int r31, int h) {
  const int lane = h * 32 + r31;
  f32x16 s[2];
#pragma unroll
  for (int kt2 = 0; kt2 < 2; ++kt2) {
#pragma unroll
    for (int e = 0; e < 16; ++e) s[kt2][e] = 0.f;
#pragma unroll
    for (int ks = 0; ks < 4; ++ks) s[kt2] = MFMA32(ld8(&sK[(32 * kt2 + r31) * 72 + 16 * ks + 8 * h]), qf[ks], s[kt2]);
  }
  float smax = -1e30f;
  if (EDGE) {
#pragma unroll
    for (int kt2 = 0; kt2 < 2; ++kt2)
#pragma unroll
      for (int e = 0; e < 16; ++e) {
        const int k = 32 * kt2 + (e & 3) + 8 * (e >> 2) + 4 * h;
        const bool a = blk_ok && ((jb == qb) ? (k <= q) : (k > q));
        if (!a) s[kt2][e] = -1e30f;
        smax = fmaxf(smax, s[kt2][e]);
      }
  } else {
#pragma unroll
    for (int kt2 = 0; kt2 < 2; ++kt2)
#pragma unroll
      for (int e = 0; e < 16; ++e) smax = fmaxf(smax, s[kt2][e]);
    if (MODE == 2 && !blk_ok) smax = -1e30f;
  }
  smax = fmaxf(smax, SHX(smax, 32));
  const float mn = fmaxf(m, smax);
  const bool need = (mn - m) > 8.f;
  if (__builtin_amdgcn_ballot_w64(need) != 0ull) {
    const float alpha = need ? EX2(m - mn) : 1.f;
    m = need ? mn : m;
    l *= alpha;
    O[0] *= alpha;
    O[1] *= alpha;
  }
  const float mref = (!EDGE && MODE == 2 && !blk_ok) ? 1e30f : m;
  float ls = 0.f;
#pragma unroll
  for (int kt2 = 0; kt2 < 2; ++kt2)
#pragma unroll
    for (int e = 0; e < 16; ++e) {
      const float sv = s[kt2][e];
      float pv;
      if (EDGE) pv = (sv > -1e29f) ? EX2(sv - m) : 0.f;
      else pv = EX2(sv - mref);
      s[kt2][e] = pv;
      ls += pv;
    }
  l += ls;
#pragma unroll
  for (int kt2 = 0; kt2 < 2; ++kt2)
#pragma unroll
    for (int st = 0; st < 2; ++st) {
      const bf16x8 pf = mk8(pack2(s[kt2][8 * st + 0], s[kt2][8 * st + 1]), pack2(s[kt2][8 * st + 2], s[kt2][8 * st + 3]),
                            pack2(s[kt2][8 * st + 4], s[kt2][8 * st + 5]), pack2(s[kt2][8 * st + 6], s[kt2][8 * st + 7]));
#pragma unroll
      for (int dt2 = 0; dt2 < 2; ++dt2) {
        const u16* vrow = &sV[(32 * dt2 + r31) * 72 + 32 * kt2 + 16 * st + 4 * h];
        const u32x2 v0 = *(const u32x2*)vrow;
        const u32x2 v1 = *(const u32x2*)(vrow + 8);
        O[dt2] = MFMA32(mk8(v0[0], v0[1], v1[0], v1[1]), pf, O[dt2]);
      }
    }
}

template <int MODE>
__device__ __forceinline__ void nsa_branch(const u16* kbase, const u16* vbase, int jb0, int jb1, int qb, int q,
                                           uint32_t mlo, uint32_t mhi, const bf16x8 (&qf)[4], const float* ngbase, int rowbase, int gidx,
                                           u16* sYl, u16* sm, float pscale = 1.f) {
  const int tid = tid_();
  const int lane = tid & 63;
  const int r31 = lane & 31, h = lane >> 5;
  const int srow = tid >> 3, sch = (tid & 7) * 8;
  f32x16 O[2];
#pragma unroll
  for (int e = 0; e < 16; ++e) { O[0][e] = 0.f; O[1][e] = 0.f; }
  float m = -1e30f, l = 0.f;
  u32x4 kr[2], vr[2];
  const unsigned koff = (unsigned)((srow * 1024 + sch) * 2);
  const unsigned voff = (unsigned)((srow * 4096 + sch) * 2);
  {
    const char* kb = (const char*)kbase + (size_t)jb0 * 131072;
    const char* vb = (const char*)vbase + (size_t)jb0 * 128;
#pragma unroll
    for (int i = 0; i < 2; ++i) {
      kr[i] = *(const u32x4*)(kb + (koff + i * 65536u));
      vr[i] = *(const u32x4*)(vb + (voff + i * 262144u));
    }
  }
  __syncthreads();
#pragma unroll
  for (int i = 0; i < 2; ++i) {
    *(u32x4*)&sm[(srow + 32 * i) * 72 + sch] = kr[i];
    *(u32x4*)&sm[4608 + (srow + 32 * i) * 72 + sch] = vr[i];
  }
  __syncthreads();
  int cur = 0;
  for (int jb = jb0; jb <= jb1; ++jb) {
    const bool more = jb < jb1;
    if (more) {
      const char* kb = (const char*)kbase + (size_t)(jb + 1) * 131072;
      const char* vb = (const char*)vbase + (size_t)(jb + 1) * 128;
#pragma unroll
      for (int i = 0; i < 2; ++i) {
        kr[i] = *(const u32x4*)(kb + (koff + i * 65536u));
        vr[i] = *(const u32x4*)(vb + (voff + i * 262144u));
      }
    }
    const u16* sK = sm + cur * 9216;
    const u16* sV = sK + 4608;
    bool blk_ok = true;
    if (MODE == 2) blk_ok = (jb < 32) ? ((mlo >> jb) & 1u) : ((mhi >> (jb - 32)) & 1u);
    const bool edge = (jb == qb) || (MODE == 3 && jb == qb - 8);
    if (edge) nsa_block<MODE, true>(sK, sV, jb, qb, q, blk_ok, qf, O, m, l, r31, h);
    else nsa_block<MODE, false>(sK, sV, jb, qb, q, blk_ok, qf, O, m, l, r31, h);
    if (more) {
      u16* dK = sm + (cur ^ 1) * 9216;
#pragma unroll
      for (int i = 0; i < 2; ++i) {
        *(u32x4*)&dK[(srow + 32 * i) * 72 + sch] = kr[i];
        *(u32x4*)&dK[4608 + (srow + 32 * i) * 72 + sch] = vr[i];
      }
    }
    __syncthreads();
    cur ^= 1;
  }
  const int tg = tid_();
  const int lg = tg & 63, hh = (lg >> 4) & 1, hg = lg >> 5;
  const float* gatep = (const float*)((const char*)ngbase + (unsigned)(rowbase + 16 * (tg >> 6) + (tg & 15)) * 192u) + gidx + hh;
  float lt = l;
  lt += shx_f(lt, lg ^ 32);
  const float sc = (lt > 0.f) ? (pscale * gatep[0] / lt) : 0.f;
  u16* yrow = sYl + (((tg >> 6) * 2 + hh) * 16 + (tg & 15)) * 64;
#pragma unroll
  for (int dt2 = 0; dt2 < 2; ++dt2)
#pragma unroll
    for (int m4 = 0; m4 < 4; ++m4) {
      u32x2* yp = (u32x2*)(yrow + 32 * dt2 + 8 * m4 + 4 * hg);
      const u32x2 yv = *yp;
      const float y0 = __uint_as_float(yv[0] << 16) + O[dt2][4 * m4 + 0] * sc;
      const float y1 = __uint_as_float(yv[0] & 0xffff0000u) + O[dt2][4 * m4 + 1] * sc;
      const float y2 = __uint_as_float(yv[1] << 16) + O[dt2][4 * m4 + 2] * sc;
      const float y3 = __uint_as_float(yv[1] & 0xffff0000u) + O[dt2][4 * m4 + 3] * sc;
      *yp = (u32x2){pack2(y0, y1), pack2(y2, y3)};
    }
}

__device__ __forceinline__ void pv_cmp(const u16* vc, int jb, const f32x4 (&p)[4], f32x4 (&o)[4], int l15, int G) {
#pragma unroll
  for (int ks2 = 0; ks2 < 2; ++ks2) {
    const f32x4 pa = p[2 * ks2], pb = p[2 * ks2 + 1];
    const bf16x8 pf = mk8(pack2(pa[0], pa[1]), pack2(pa[2], pa[3]), pack2(pb[0], pb[1]), pack2(pb[2], pb[3]));
#pragma unroll
    for (int dt = 0; dt < 4; ++dt) {
      const u16* vp = vc + (long)(16 * dt + l15) * 256 + jb * 64 + 32 * ks2 + 4 * G;
      const u32x2 v0 = *(const u32x2*)vp;
      const u32x2 v1 = *(const u32x2*)(vp + 16);
      o[dt] = MFMA(mk8(v0[0], v0[1], v1[0], v1[1]), pf, o[dt]);
    }
  }
}

__device__ __forceinline__ void nsa_unit(const Params& P, int half, int u, char* smem) {
  char* ws = P.ws;
  const int tid = tid_(), lane = tid & 63, wave = tid >> 6;
  const int l15 = lane & 15, G = lane >> 4;
  const int hp = u >> 9, rest = u & 511;
  const int bl = rest >> 8, g = (rest >> 6) & 3, xq = rest & 63;
  const int qb = hp ? xq : 63 - xq;
  const int q = 16 * wave + l15;
  const int t = qb * 64 + q;
  const int rl = bl * 4096 + t;
  const int rg = half * 8192 + rl;
  const char* NQc = (const char*)(ws + OFF_NQ);
  const unsigned qoff = (unsigned)rg * 2048u;
  u16* sm = (u16*)smem;
  float* sImp = (float*)smem;
  const u16* NQ = (const u16*)(ws + OFF_NQ);
  const u16* NQR = (const u16*)(ws + OFF_NQR);
  const u16* KV = (const u16*)(ws + OFF_KV);
  const u16* VST = (const u16*)(ws + OFF_VST);
  const u16* VWT = (const u16*)(ws + OFF_VWT);
  const u16* KCMP = (const u16*)(ws + OFF_KCMP);
  const u16* VCMPT = (const u16*)(ws + OFF_VCMPT);
  const float* NGATE = (const float*)((const char*)(ws + OFF_NGATE) + (unsigned)rg * 192u);
  u16* YB = (u16*)(ws + (half ? OFF_YB1 : OFF_YB0));

  f32x4 Y[2][4];
#pragma unroll
  for (int rr = 0; rr < 2; ++rr)
#pragma unroll
    for (int dt = 0; dt < 4; ++dt) Y[rr][dt] = (f32x4){0.f, 0.f, 0.f, 0.f};

  uint32_t mlo = 0, mhi = 0;
  u16* sYl = (u16*)(smem + 36864);
  {
    const int nblk = ((4 * qb + 2) >> 6) + 1;
    const u16* kc = KCMP + (long)(bl * 4 + g) * 256 * 64;
    const u16* vc = VCMPT + (long)(bl * 4 + g) * 64 * 256;
    float imp[4][4];
#pragma unroll
    for (int a = 0; a < 4; ++a)
#pragma unroll
      for (int b = 0; b < 4; ++b) imp[a][b] = 0.f;
    __syncthreads();
    for (int id = tid; id < nblk * 512; id += 256) {
      const int row = id >> 3, chn = (id & 7) * 8;
      *(u32x4*)&sm[row * 72 + chn] = *(const u32x4*)(kc + row * 64 + chn);
    }
    __syncthreads();
#pragma unroll 1
    for (int r = 0; r < 4; ++r) {
      bf16x8 qp[2];
#pragma unroll
      for (int ks = 0; ks < 2; ++ks) qp[ks] = *(const bf16x8*)(NQc + (qoff + (unsigned)(((4 * g + r) * 64 + ks * 32 + G * 8) * 2)));
      float m = -1e30f, l = 0.f;
#pragma unroll 1
      for (int jb = 0; jb < nblk; ++jb) {
        f32x4 s[4];
        float smax = -1e30f;
#pragma unroll
        for (int kt = 0; kt < 4; ++kt) {
          f32x4 a4 = {0.f, 0.f, 0.f, 0.f};
#pragma unroll
          for (int ks = 0; ks < 2; ++ks)
            a4 = MFMA(ld8(&sm[(jb * 64 + 16 * kt + l15) * 72 + ks * 32 + G * 8]), qp[ks], a4);
#pragma unroll
          for (int e = 0; e < 4; ++e) {
            const int n = jb * 64 + 16 * kt + 4 * G + e;
            const float sv = (16 * n + 31 <= t) ? a4[e] : -1e30f;
            s[kt][e] = sv;
            smax = fmaxf(smax, sv);
          }
        }
        smax = fmaxf(smax, SHX(smax, 16));
        smax = fmaxf(smax, SHX(smax, 32));
        const float mn = fmaxf(m, smax);
        float ls = 0.f;
#pragma unroll
        for (int kt = 0; kt < 4; ++kt)
#pragma unroll
          for (int e = 0; e < 4; ++e) ls += (s[kt][e] > -1e29f) ? EX2(s[kt][e] - mn) : 0.f;
        l = l * EX2(m - mn) + ls;
        m = mn;
      }
      l += SHX(l, 16);
      l += SHX(l, 32);
      const float invl = (l > 0.f) ? 1.f / l : 0.f;
      float prevup = 0.f;
#pragma unroll 1
      for (int jb = 0; jb < nblk; ++jb) {
        {
          f32x4 p[4];
#pragma unroll
          for (int kt = 0; kt < 4; ++kt) {
            f32x4 a4 = {0.f, 0.f, 0.f, 0.f};
#pragma unroll
            for (int ks = 0; ks < 2; ++ks)
              a4 = MFMA(ld8(&sm[(jb * 64 + 16 * kt + l15) * 72 + ks * 32 + G * 8]), qp[ks], a4);
#pragma unroll
            for (int e = 0; e < 4; ++e) {
              const int n = jb * 64 + 16 * kt + 4 * G + e;
              p[kt][e] = (16 * n + 31 <= t) ? EX2(a4[e] - m) * invl : 0.f;
            }
            const float sum4 = (p[kt][0] + p[kt][1]) + (p[kt][2] + p[kt][3]);
            const float upv = shx_f(p[kt][3], (lane + 48) & 63);
            const float add = (G > 0) ? upv : prevup;
            const float iv = sum4 + add;
#pragma unroll
            for (int j = 0; j < 4; ++j) imp[j][kt] += (jb == j) ? iv : 0.f;
            prevup = upv;
          }
          if (r == 2 * hp) pv_cmp(vc, jb, p, Y[0], l15, G);
          else if (r == 2 * hp + 1) pv_cmp(vc, jb, p, Y[1], l15, G);
        }
      }
    }
    {
      const float g0 = NGATE[0 * 16 + 4 * g + 2 * hp], g1 = NGATE[0 * 16 + 4 * g + 2 * hp + 1];
#pragma unroll
      for (int dt = 0; dt < 4; ++dt) {
        *(u32x2*)(sYl + ((wave * 2 + 0) * 16 + l15) * 64 + 16 * dt + 4 * G) = (u32x2){pack2(Y[0][dt][0] * g0, Y[0][dt][1] * g0), pack2(Y[0][dt][2] * g0, Y[0][dt][3] * g0)};
        *(u32x2*)(sYl + ((wave * 2 + 1) * 16 + l15) * 64 + 16 * dt + 4 * G) = (u32x2){pack2(Y[1][dt][0] * g1, Y[1][dt][1] * g1), pack2(Y[1][dt][2] * g1, Y[1][dt][3] * g1)};
      }
    }
    __syncthreads();
    float* myImp = sImp + wave * 16 * 65;
#pragma unroll
    for (int jb = 0; jb < 4; ++jb)
#pragma unroll
      for (int kt = 0; kt < 4; ++kt) myImp[l15 * 65 + 16 * jb + 4 * kt + G] = imp[jb][kt];
    __syncthreads();
    const int cur = qb;
    uint32_t blo = 0, bhi = 0;
    if (cur + 1 <= 16) {
#pragma unroll
      for (int jb = 0; jb < 4; ++jb)
#pragma unroll
        for (int kt = 0; kt < 4; ++kt) {
          const int s = 16 * jb + 4 * kt + G;
          if (s <= cur) blo |= (1u << s);
        }
    } else {
      int cnt[4][4];
#pragma unroll
      for (int a = 0; a < 4; ++a)
#pragma unroll
        for (int b = 0; b < 4; ++b) cnt[a][b] = 0;
      for (int sp = 1; sp <= cur - 2; ++sp) {
        const float xv = myImp[l15 * 65 + sp];
#pragma unroll
        for (int jb = 0; jb < 4; ++jb)
#pragma unroll
          for (int kt = 0; kt < 4; ++kt) {
            const int s = 16 * jb + 4 * kt + G;
            const float v = imp[jb][kt];
            cnt[jb][kt] += ((xv > v) || (xv == v && sp < s)) ? 1 : 0;
          }
      }
#pragma unroll
      for (int jb = 0; jb < 4; ++jb)
#pragma unroll
        for (int kt = 0; kt < 4; ++kt) {
          const int s = 16 * jb + 4 * kt + G;
          const bool sel = (s == 0) || (s == cur) || (s == cur - 1) || (s >= 1 && s <= cur - 2 && cnt[jb][kt] < 13);
          if (sel) { if (s < 32) blo |= (1u << s); else bhi |= (1u << (s - 32)); }
        }
    }
    blo |= SHXU(blo, 16); blo |= SHXU(blo, 32);
    bhi |= SHXU(bhi, 16); bhi |= SHXU(bhi, 32);
    mlo = blo; mhi = bhi;
  }
  {
    const int hh = (lane >> 4) & 1, h5 = lane >> 5;
    const int head = 4 * g + 2 * hp + hh;
    bf16x8 qf[4];
    qf[0] = *(const bf16x8*)((const char*)NQR + ((unsigned)rl * 512u + (unsigned)((head * 16 + 8 * h5) * 2)));
#pragma unroll
    for (int ks = 1; ks < 4; ++ks) qf[ks] = *(const bf16x8*)(NQc + (qoff + (unsigned)((head * 64 + 16 * ks + 8 * h5) * 2)));
    const int head0 = 4 * g + 2 * hp;
    const u16* kbs = KV + (long)bl * 4096 * 1024 + 512 + g * 64;
    const u16* vbs = VST + (long)(bl * 4 + g) * 64 * 4096;
    nsa_branch<2>(kbs, vbs, 0, qb, qb, q, mlo, mhi, qf, (const float*)(ws + OFF_NGATE), half * 8192 + bl * 4096 + qb * 64, 16 + head0, sYl, sm);
    const u16* kbw = KV + (long)bl * 4096 * 1024 + 768 + g * 64;
    const u16* vbw = VWT + (long)(bl * 4 + g) * 64 * 4096;
    const int jw0 = (qb >= 8) ? qb - 8 : 0;
    nsa_branch<3>(kbw, vbw, jw0, qb, qb, q, mlo, mhi, qf, (const float*)(ws + OFF_NGATE), half * 8192 + bl * 4096 + qb * 64, 32 + head0, sYl, sm);
    const int tid2 = tid_();
    const int l2 = tid2 & 63, hh2 = (l2 >> 4) & 1, hg2 = l2 >> 5;
    const unsigned yoff = (unsigned)(bl * 4096 + qb * 64 + 16 * (tid2 >> 6) + (tid2 & 15)) * 2048u;
    const u16* yrow = sYl + (((tid2 >> 6) * 2 + hh2) * 16 + (tid2 & 15)) * 64;
#pragma unroll
    for (int dt2 = 0; dt2 < 2; ++dt2)
#pragma unroll
      for (int m4 = 0; m4 < 4; ++m4) {
        const int d0 = 32 * dt2 + 8 * m4 + 4 * hg2;
        *(u32x2*)((char*)YB + (yoff + (unsigned)(((head0 + hh2) * 64 + d0) * 2))) = *(const u32x2*)(yrow + d0);
      }
  }
}

__device__ __forceinline__ void gemm_tile_wide(const u16* __restrict__ A, long lda, int m0, const u16* __restrict__ Bt, long ldb, int n0, int K,
                                               f32x4 (&acc)[4][8], u16* sA) {
  const int tid = tid_(), lane = tid & 63, wave = tid >> 6;
  const int l15 = lane & 15, G = lane >> 4;
  const int wm = wave >> 1, wn = wave & 1;
  const int lr = tid >> 3, ch = tid & 7;
  u16* sB = sA + 128 * 80;
  const char* Ab = (const char*)A;
  const char* Bb = (const char*)Bt;
  unsigned oa[4], ob[8];
#pragma unroll
  for (int i = 0; i < 4; ++i) oa[i] = (unsigned)(((long)(m0 + lr + 32 * i) * lda + ch * 8) * 2);
#pragma unroll
  for (int i = 0; i < 8; ++i) ob[i] = (unsigned)(((long)(n0 + lr + 32 * i) * ldb + ch * 8) * 2);
  u32x4 ra[4], rb[8];
#pragma unroll
  for (int i = 0; i < 4; ++i) ra[i] = *(const u32x4*)(Ab + oa[i]);
#pragma unroll
  for (int i = 0; i < 8; ++i) rb[i] = *(const u32x4*)(Bb + ob[i]);
  const int nk = K >> 6;
  for (int kt = 0; kt < nk; ++kt) {
#pragma unroll
    for (int i = 0; i < 4; ++i) *(u32x4*)&sA[(lr + 32 * i) * 80 + ch * 8] = ra[i];
#pragma unroll
    for (int i = 0; i < 8; ++i) *(u32x4*)&sB[(lr + 32 * i) * 80 + ch * 8] = rb[i];
    __syncthreads();
    {
      const int kn = (kt + 1 < nk) ? kt + 1 : kt;
      const char* Ak = Ab + (size_t)kn * 128;
      const char* Bk = Bb + (size_t)kn * 128;
#pragma unroll
      for (int i = 0; i < 4; ++i) ra[i] = *(const u32x4*)(Ak + oa[i]);
#pragma unroll
      for (int i = 0; i < 8; ++i) rb[i] = *(const u32x4*)(Bk + ob[i]);
    }
#pragma unroll
    for (int ks = 0; ks < 2; ++ks) {
      bf16x8 af[4];
#pragma unroll
      for (int i = 0; i < 4; ++i) af[i] = ld8(&sA[(wm * 64 + 16 * i + l15) * 80 + ks * 32 + G * 8]);
#pragma unroll
      for (int jh = 0; jh < 2; ++jh) {
        bf16x8 bfr[4];
#pragma unroll
        for (int j = 0; j < 4; ++j) bfr[j] = ld8(&sB[(wn * 128 + 64 * jh + 16 * j + l15) * 80 + ks * 32 + G * 8]);
#pragma unroll
        for (int i = 0; i < 4; ++i)
#pragma unroll
          for (int j = 0; j < 4; ++j) acc[i][4 * jh + j] = MFMA(af[i], bfr[j], acc[i][4 * jh + j]);
      }
    }
    __syncthreads();
  }
}


__device__ __forceinline__ void phase_branch_merge(const Params& P, char* smem) {
  char* ws = P.ws;
  u16* sA = (u16*)smem;
  const u16* YA = (const u16*)(ws + OFF_SG);
  const u16* GATES = (const u16*)P.out;
  u16* MERGED = (u16*)(ws + OFF_MERGED);
  for (int t = bid_(); t < 512; t += gridDim.x) {
    const int nt = t >> 7, mt = t & 127;
    const int m0 = mt * 128, n0 = nt * 256;
    const u16* YBp = (m0 < 8192) ? (const u16*)(ws + OFF_YB0) : ((const u16*)(ws + OFF_YB1) - (long)8192 * 1024);
    f32x4 acc[4][8];
#pragma unroll
    for (int i = 0; i < 4; ++i)
#pragma unroll
      for (int j = 0; j < 8; ++j) acc[i][j] = (f32x4){0.f, 0.f, 0.f, 0.f};
    gemm_tile_wide(YA, 1024, m0, (const u16*)(ws + OFF_WA_T), 1024, n0, 1024, acc, sA);
    {
      EPI_VARS
#pragma unroll
      for (int i = 0; i < 4; ++i)
#pragma unroll
        for (int j = 0; j < 8; ++j) {
          const int col = n0 + wn * 128 + 16 * j + l15;
#pragma unroll
          for (int e = 0; e < 4; ++e) {
            const unsigned go = ((unsigned)(m0 + wm * 64 + 16 * i + G * 4 + e) * 2048u + (unsigned)col) * 2u;
            acc[i][j][e] *= bf2f(*(const u16*)((const char*)GATES + go)) * __builtin_amdgcn_rcpf(bf2f(*(const u16*)((const char*)GATES + (go + 2048u))));
          }
        }
    }
    gemm_tile_wide(YBp, 1024, m0, (const u16*)(ws + OFF_WB_T), 1024, n0, 1024, acc, sA);
    {
      EPI_VARS
#pragma unroll
      for (int i = 0; i < 4; ++i)
#pragma unroll
        for (int j = 0; j < 8; ++j) {
          const int col = n0 + wn * 128 + 16 * j + l15;
#pragma unroll
          for (int e = 0; e < 4; ++e) {
            const unsigned ro = (unsigned)(m0 + wm * 64 + 16 * i + G * 4 + e);
            const unsigned go = (ro * 2048u + (unsigned)col) * 2u + 2048u;
            *(u16*)((char*)MERGED + (ro * 1024u + (unsigned)col) * 2u) = f2bf(acc[i][j][e] * bf2f(*(const u16*)((const char*)GATES + go)));
          }
        }
    }
  }
}

template <int EPI>
__device__ __forceinline__ void phase_gemm(const u16* A, int K, const u16* Wt, int N, void* outp, char* smem) {
  u16* sA = (u16*)smem;
  u16* sB = sA + 128 * 80;
  EPI_VARS
  const int ntn = N >> 7;
  for (int t = bid_(); t < 128 * ntn; t += gridDim.x) {
    const int nt = t >> 7, mt = t & 127;
    const int m0 = mt * 128, n0 = nt * 128;
    f32x4 acc[4][4];
    zero_acc(acc);
    gemm_tile<0, 2>(A, K, m0, 16384, Wt, K, n0, N, K, 0, acc, sA, sB);
#pragma unroll
    for (int i = 0; i < 4; ++i)
#pragma unroll
      for (int j = 0; j < 4; ++j) {
        const int col = n0 + wn * 64 + 16 * j + l15;
#pragma unroll
        for (int e = 0; e < 4; ++e) {
          const long row = m0 + wm * 64 + 16 * i + G * 4 + e;
          const float v = acc[i][j][e];
          if (EPI == 0) ((float*)outp)[row * N + col] = v;
          else if (EPI == 2) ((u16*)outp)[row * N + col] = f2bf(v);
          else { const float rl = fmaxf(v, 0.f); ((u16*)outp)[row * N + col] = f2bf(rl * rl); }
        }
      }
  }
}


template <int EPI>
__device__ __forceinline__ void phase_gemm_wide(const u16* A, int K, const u16* Wt, int N, u16* outp, char* smem) {
  u16* sA = (u16*)smem;
  EPI_VARS
  const int ntn = N >> 8;
  for (int t = bid_(); t < 128 * ntn; t += gridDim.x) {
    const int nt = t >> 7, mt = t & 127;
    const int m0 = mt * 128, n0 = nt * 256;
    f32x4 acc[4][8];
#pragma unroll
    for (int i = 0; i < 4; ++i)
#pragma unroll
      for (int j = 0; j < 8; ++j) acc[i][j] = (f32x4){0.f, 0.f, 0.f, 0.f};
    gemm_tile_wide(A, K, m0, Wt, K, n0, K, acc, sA);
#pragma unroll
    for (int i = 0; i < 4; ++i)
#pragma unroll
      for (int j = 0; j < 8; ++j) {
        const int col = n0 + wn * 128 + 16 * j + l15;
#pragma unroll
        for (int e = 0; e < 4; ++e) {
          const long row = m0 + wm * 64 + 16 * i + G * 4 + e;
          float v = acc[i][j][e];
          if (EPI == 1) { v = fmaxf(v, 0.f); v = v * v; }
          outp[row * N + col] = f2bf(v);
        }
      }
  }
}

__device__ __forceinline__ void phase_ple(const Params& P, char* smem) {
  char* ws = P.ws;
  u16* sA = (u16*)smem;
  float* Z3 = (float*)(ws + OFF_Z3);
  for (int t = bid_(); t < 512; t += gridDim.x) {
    const int nt = t >> 7, mt = t & 127;
    const int m0 = mt * 128, n0 = nt * 256;
    f32x4 acc[4][8];
#pragma unroll
    for (int i = 0; i < 4; ++i)
#pragma unroll
      for (int j = 0; j < 8; ++j) acc[i][j] = (f32x4){0.f, 0.f, 0.f, 0.f};
    gemm_tile_wide((const u16*)(ws + OFF_PB), 256, m0, (const u16*)(ws + OFF_WPLE_T), 256, n0, 256, acc, sA);
    {
      EPI_VARS
#pragma unroll
      for (int i = 0; i < 4; ++i)
#pragma unroll
        for (int j = 0; j < 8; ++j) {
          const int col = n0 + wn * 128 + 16 * j + l15;
#pragma unroll
          for (int e = 0; e < 4; ++e) {
            const unsigned zo = ((unsigned)(m0 + wm * 64 + 16 * i + G * 4 + e) * 1024u + (unsigned)col) * 4u;
            *(float*)((char*)Z3 + zo) = acc[i][j][e];
            acc[i][j][e] = 0.f;
          }
        }
    }
    gemm_tile_wide((const u16*)(ws + OFF_H2B), 1024, m0, (const u16*)(ws + OFF_WPG_T), 1024, n0, 1024, acc, sA);
    {
      EPI_VARS
#pragma unroll
      for (int i = 0; i < 4; ++i)
#pragma unroll
        for (int j = 0; j < 8; ++j) {
          const int col = n0 + wn * 128 + 16 * j + l15;
#pragma unroll
          for (int e = 0; e < 4; ++e) {
            const unsigned zo = ((unsigned)(m0 + wm * 64 + 16 * i + G * 4 + e) * 1024u + (unsigned)col) * 4u;
            float* zp = (float*)((char*)Z3 + zo);
            *zp = *zp * sigm(acc[i][j][e]);
          }
        }
    }
  }
}

template <int MODE, int ZB>
__device__ __forceinline__ void phase_rownorm(const Params& P, const void* Zv, const float* w, const float* w2, u16* nxt) {
  const int tid = tid_(), lane = tid & 63, wave = tid >> 6;
  float* H = P.out;
  for (int un = bid_(); un < 4096; un += gridDim.x) {
    const long row = (long)un * 4 + wave;
    const float* zr = (const float*)Zv + row * 1024;
    const u16* zh = (const u16*)Zv + row * 1024;
    (void)zr; (void)zh;
    const float* hin = (MODE == 0) ? (P.x + row * 1024) : (H + row * 1024);
    float4 z[4], hv[4];
    float ss = 0.f;
#pragma unroll
    for (int j = 0; j < 4; ++j) {
      if (ZB) {
        const u32x2 zz = *(const u32x2*)(zh + j * 256 + lane * 4);
        z[j] = make_float4(__uint_as_float(zz[0] << 16), __uint_as_float(zz[0] & 0xffff0000u), __uint_as_float(zz[1] << 16), __uint_as_float(zz[1] & 0xffff0000u));
      } else z[j] = *(const float4*)(zr + j * 256 + lane * 4);
      hv[j] = *(const float4*)(hin + j * 256 + lane * 4);
      ss += z[j].x * z[j].x + z[j].y * z[j].y + z[j].z * z[j].z + z[j].w * z[j].w;
    }
#pragma unroll
    for (int o = 32; o >= 1; o >>= 1) ss += SHX(ss, o);
    const float r = rsqrtf(ss * (1.f / 1024.f) + 1e-6f);
    float s2 = 0.f;
#pragma unroll
    for (int j = 0; j < 4; ++j) {
      const float4 wv = *(const float4*)(w + j * 256 + lane * 4);
      hv[j].x += z[j].x * r * wv.x; hv[j].y += z[j].y * r * wv.y;
      hv[j].z += z[j].z * r * wv.z; hv[j].w += z[j].w * r * wv.w;
      s2 += hv[j].x * hv[j].x + hv[j].y * hv[j].y + hv[j].z * hv[j].z + hv[j].w * hv[j].w;
      *(float4*)(H + row * 1024 + j * 256 + lane * 4) = hv[j];
    }
    if (MODE == 0) {
#pragma unroll
      for (int o = 32; o >= 1; o >>= 1) s2 += SHX(s2, o);
      const float r2 = rsqrtf(s2 * (1.f / 1024.f) + 1e-6f);
#pragma unroll
      for (int j = 0; j < 4; ++j) {
        const float4 wv = *(const float4*)(w2 + j * 256 + lane * 4);
        u32x2 o2 = {pack2(hv[j].x * r2 * wv.x, hv[j].y * r2 * wv.y), pack2(hv[j].z * r2 * wv.z, hv[j].w * r2 * wv.w)};
        *(u32x2*)(nxt + row * 1024 + j * 256 + lane * 4) = o2;
      }
    } else if (MODE == 1) {
#pragma unroll
      for (int j = 0; j < 4; ++j) {
        u32x2 o2 = {pack2(hv[j].x, hv[j].y), pack2(hv[j].z, hv[j].w)};
        *(u32x2*)(nxt + row * 1024 + j * 256 + lane * 4) = o2;
      }
      const float4 pv = *(const float4*)(P.p + row * 256 + lane * 4);
      u32x2 o2 = {pack2(pv.x, pv.y), pack2(pv.z, pv.w)};
      *(u32x2*)((u16*)(P.ws + OFF_PB) + row * 256 + lane * 4) = o2;
    }
  }
}

#define XB_TMO      128
#define XB_XCNT(j)  (256  + 64 * (j))
#define XB_XSUB(j)  (1280 + 64 * (j))
#define XB_XGEN(j)  (2304 + 64 * (j))
#define XB_TOP      3328
#define XB_TOPGEN   3392
#define XCD_BAR_WORDS 3456
#define XB_SPIN_CAP (1u << 18)
#define LAS __attribute__((address_space(3)))

__device__ __forceinline__ unsigned xb_ld(unsigned* p)              { return __hip_atomic_load(p, __ATOMIC_RELAXED, __HIP_MEMORY_SCOPE_AGENT); }
__device__ __forceinline__ unsigned xb_add(unsigned* p, unsigned v) { return __hip_atomic_fetch_add(p, v, __ATOMIC_RELAXED, __HIP_MEMORY_SCOPE_AGENT); }
__device__ __forceinline__ unsigned xb_xcc_id() { return (unsigned)__builtin_amdgcn_s_getreg((3 << 11) | 20) & 0xFu; }
#define XB_SPIN(cond, bar) do { unsigned _sp = 0; while (cond) { __builtin_amdgcn_s_sleep(1); \
    if ((++_sp & 255u) == 0u) { if (xb_ld(&(bar)[XB_TMO])) break; if (_sp > XB_SPIN_CAP) { atomicAdd(&(bar)[XB_TMO], 1u); break; } } } } while (0)

struct XcdBarrier {
    unsigned* bar; unsigned x;
    volatile LAS unsigned* st;
};

__device__ __forceinline__ XcdBarrier xcd_barrier_post(unsigned* bar, volatile LAS unsigned* st) {
    XcdBarrier b; b.bar = bar; b.x = xb_xcc_id(); b.st = st;
    if (tid_() == 0) (void)xb_add(&bar[XB_XCNT(b.x)], 1u);
    return b;
}
__device__ __forceinline__ void xcd_barrier_complete(unsigned* bar, unsigned x, unsigned& nloc, unsigned& nx) {
    const unsigned G = gridDim.x * gridDim.y * gridDim.z;
    unsigned sum, cnt, mine, sp = 0u;
    for (;;) {
        sum = 0u; cnt = 0u; mine = 0u;
#pragma unroll
        for (unsigned j = 0; j < 16; ++j) { const unsigned c = xb_ld(&bar[XB_XCNT(j)]); sum += c; cnt += (c > 0u) ? 1u : 0u; mine = (j == x) ? c : mine; }
        if (sum == G) break;
        __builtin_amdgcn_s_sleep(1);
        if ((++sp & 255u) == 0u) { if (xb_ld(&bar[XB_TMO])) break; if (sp > XB_SPIN_CAP) { atomicAdd(&bar[XB_TMO], 1u); break; } }
    }
    nloc = mine > 0u ? mine : 1u; nx = cnt > 0u ? cnt : 1u;
}

__device__ __forceinline__ void xcd_barrier(const XcdBarrier& b) {
    asm volatile("s_waitcnt vmcnt(0)" ::: "memory");
    __syncthreads();
    if (tid_() == 0) {
        unsigned* bar = b.bar;
        __builtin_amdgcn_s_waitcnt(0);
        unsigned nloc = b.st[0], nx = b.st[1];
        if (nloc == 0u) { xcd_barrier_complete(bar, b.x, nloc, nx); b.st[0] = nloc; b.st[1] = nx; }
        const unsigned old = xb_add(&bar[XB_XSUB(b.x)], 1u);
        const unsigned gen = old / nloc;
        if (old + 1u == (gen + 1u) * nloc) {
            __builtin_amdgcn_fence(__ATOMIC_RELEASE, "agent");
            asm volatile("s_waitcnt vmcnt(0)" ::: "memory");
            const unsigned og = xb_add(&bar[XB_TOP], 1u);
            const unsigned tg = og / nx;
            if (og + 1u == (tg + 1u) * nx) xb_add(&bar[XB_TOPGEN], 1u);
            else XB_SPIN(xb_ld(&bar[XB_TOPGEN]) == tg, bar);
            __builtin_amdgcn_fence(__ATOMIC_ACQUIRE, "agent");
            xb_add(&bar[XB_XGEN(b.x)], 1u);
            asm volatile("s_waitcnt vmcnt(0)" ::: "memory");
        } else {
            XB_SPIN(xb_ld(&bar[XB_XGEN(b.x)]) == gen, bar);
            __builtin_amdgcn_fence(__ATOMIC_ACQUIRE, "agent");
            asm volatile("s_waitcnt vmcnt(0)" ::: "memory");
        }
    }
    __syncthreads();
}

#define OFF_BAR (252 * MIB)
#define GSYNC() do { XcdBarrier xb_; xb_.bar = (unsigned*)(P.ws + OFF_BAR); xb_.x = xb_xcc_id(); xb_.st = (volatile LAS unsigned*)&xb_words; xcd_barrier(xb_); } while (0)
__global__ void __launch_bounds__(256, 2) k_mega(Params P) {
  __shared__ __attribute__((aligned(16))) char smem[67584];
  char* ws = P.ws;
  __shared__ uint4 xb_words;
  if (tid_() == 0) xb_words = make_uint4(0u, 0u, 0u, 0u);
  __syncthreads();
  (void)xcd_barrier_post((unsigned*)(ws + OFF_BAR), (volatile LAS unsigned*)&xb_words);
  phase_prep(P, smem);
  GSYNC();
#pragma unroll 1
  for (int half = 0; half < 2; ++half) {
    phase_inproj(P, half, smem);
    GSYNC();
#if PROBE_DUP == 1
    phase_inproj(P, half, smem);
    GSYNC();
#endif
    if ((int)gridDim.x > 128) {
      const int b2 = bid_();
      if (b2 < 64) cmp_gemm1_tile(P, b2, smem);
      else for (int u = b2 - 64; u < 1024; u += (int)gridDim.x - 64) hgrn_intra_unit(P, u, smem);
    } else {
      for (int t = bid_(); t < 64; t += gridDim.x) cmp_gemm1_tile(P, t, smem);
      for (int u = bid_(); u < 1024; u += gridDim.x) hgrn_intra_unit(P, u, smem);
    }
    GSYNC();
    for (int t = bid_(); t < 32; t += gridDim.x) cmp_gemm2_tile(P, t, smem);
    hgrn_scan(P);
    if (half == 1) phase_late_weights(P, smem);
    GSYNC();
#if PROBE_DUP == 2
    for (int u = bid_(); u < 1024; u += gridDim.x) nsa_unit(P, half, u, smem);
    GSYNC();
#endif
    for (int u = bid_(); u < 1024; u += gridDim.x) nsa_unit(P, half, u, smem);
    for (int u = bid_(); u < 1024; u += gridDim.x) hgrn_out_unit(P, half, u, smem);
    GSYNC();
  }
  phase_branch_merge(P, smem);
  GSYNC();
#if PROBE_DUP == 3
  phase_branch_merge(P, smem);
  GSYNC();
  phase_gemm<2>((const u16*)(ws + OFF_MERGED), 1024, (const u16*)(ws + OFF_WOUT_T), 1024, ws + OFF_Z1, smem);
  GSYNC();
#endif
  phase_gemm_wide<2>((const u16*)(ws + OFF_MERGED), 1024, (const u16*)(ws + OFF_WOUT_T), 1024, (u16*)(ws + OFF_Z1), smem);
  GSYNC();
  phase_rownorm<0, 1>(P, (const void*)(ws + OFF_Z1), P.n_post_mix, P.n_pre_mlp, (u16*)(ws + OFF_V));
  GSYNC();
#if PROBE_DUP == 4
  phase_gemm<1>((const u16*)(ws + OFF_V), 1024, (const u16*)(ws + OFF_WUP_T), 4096, ws + OFF_FFH, smem);
  GSYNC();
#endif
  phase_gemm_wide<1>((const u16*)(ws + OFF_V), 1024, (const u16*)(ws + OFF_WUP_T), 4096, (u16*)(ws + OFF_FFH), smem);
  GSYNC();
#if PROBE_DUP == 4
  phase_gemm<2>((const u16*)(ws + OFF_FFH), 4096, (const u16*)(ws + OFF_WDOWN_T), 1024, ws + OFF_Z2, smem);
  GSYNC();
#endif
  phase_gemm_wide<2>((const u16*)(ws + OFF_FFH), 4096, (const u16*)(ws + OFF_WDOWN_T), 1024, (u16*)(ws + OFF_Z2), smem);
  GSYNC();
  phase_rownorm<1, 1>(P, (const void*)(ws + OFF_Z2), P.n_post_mlp, nullptr, (u16*)(ws + OFF_H2B));
  GSYNC();
  phase_ple(P, smem);
  GSYNC();
#if PROBE_DUP == 5
  for (int i = 0; i < 10; ++i) GSYNC();
#endif
#if PROBE_DUP == 6
  phase_prep(P, smem);
  GSYNC();
#endif
  phase_rownorm<2, 0>(P, (const void*)(P.ws + OFF_Z3), P.n_ple, nullptr, nullptr);
}

extern "C" void kernel_launch(void* const* d_in, const int* in_sizes, int n_in, void* d_out, int out_size, void* d_ws,
                              size_t ws_size, hipStream_t stream) {
  Params P{};
  P.x = (const float*)d_in[0];
  P.p = (const float*)d_in[1];
  P.w_in = (const float*)d_in[2];
  P.w_a = (const float*)d_in[3];
  P.w_b = (const float*)d_in[4];
  P.w_out = (const float*)d_in[5];
  P.n_pre_mix = (const float*)d_in[6];
  P.n_post_mix = (const float*)d_in[7];
  P.n_pre_mlp = (const float*)d_in[8];
  P.n_post_mlp = (const float*)d_in[9];
  P.lb_logits = (const float*)d_in[10];
  P.gnorm = (const float*)d_in[11];
  P.pe_k = (const float*)d_in[12];
  P.pe_v = (const float*)d_in[13];
  P.wk1 = (const float*)d_in[14];
  P.wk2 = (const float*)d_in[15];
  P.wv1 = (const float*)d_in[16];
  P.wv2 = (const float*)d_in[17];
  P.w_up = (const float*)d_in[18];
  P.w_down = (const float*)d_in[19];
  P.w_ple = (const float*)d_in[20];
  P.w_pg = (const float*)d_in[21];
  P.n_ple = (const float*)d_in[22];
  P.out = (float*)d_out;
  P.ws = (char*)d_ws;
#if MEGA
  static int grid_blocks = 0;
  if (!grid_blocks) {
    int dev = 0, cus = 0, per_cu = 0;
    hipGetDevice(&dev);
    hipDeviceGetAttribute(&cus, hipDeviceAttributeMultiprocessorCount, dev);
    hipOccupancyMaxActiveBlocksPerMultiprocessor(&per_cu, k_mega, 256, 0);
    if (per_cu > 2) per_cu = 2;
    if (per_cu < 1) per_cu = 1;
    grid_blocks = cus * per_cu;
  }
  hipMemsetAsync((char*)d_ws + OFF_BAR, 0, XCD_BAR_WORDS * sizeof(unsigned), stream);
  void* args[] = {&P};
  hipError_t e = hipLaunchCooperativeKernel((void*)k_mega, dim3(grid_blocks), dim3(256), args, 0, stream);
  if (e != hipSuccess) fprintf(stderr, "cooperative launch failed: %s (grid %d)\n", hipGetErrorString(e), grid_blocks);
#endif
}
```

```cpp
#include <hip/hip_runtime.h>
#include <hip/hip_cooperative_groups.h>
#include <cstdio>
#include <cstdint>
namespace cg = cooperative_groups;

#ifndef MEGA
#define MEGA 1
#endif
#ifndef PROBE_DUP
#define PROBE_DUP 0
#endif

typedef unsigned short u16;
typedef __attribute__((ext_vector_type(8))) short bf16x8;
typedef __attribute__((ext_vector_type(4))) float f32x4;
typedef __attribute__((ext_vector_type(4))) unsigned u32x4;
typedef __attribute__((ext_vector_type(2))) unsigned u32x2;

#define MFMA(a, b, c) __builtin_amdgcn_mfma_f32_16x16x32_bf16(a, b, c, 0, 0, 0)
#define MIB ((size_t)1 << 20)

#define OFF_U       (0 * MIB)
#define OFF_YB0     (0 * MIB)
#define OFF_WA_T    (16 * MIB)
#define OFF_WB_T    (18 * MIB)
#define OFF_WOUT_T  (20 * MIB)
#define OFF_WPG_T   (22 * MIB)
#define OFF_WPLE_T  (24 * MIB)
#define OFF_WIN_T   (32 * MIB)
#define OFF_WUP_T   (32 * MIB)
#define OFF_WDOWN_T (40 * MIB)
#define OFF_WK1T    (50 * MIB)
#define OFF_WV1T    (51 * MIB)
#define OFF_WK2T    (52 * MIB)
#define OFF_WV2T    (52 * MIB + 32768)
#define OFF_ROPE    (52 * MIB + 65536)
#define OFF_BIAS1   (52 * MIB + 65536 + 262144)
#define OFF_LB      (52 * MIB + 65536 + 262144 + 4096)
#define OFF_BIAS1P  (52 * MIB + 65536 + 262144 + 16384)
#define OFF_NGATE   (53 * MIB)
#define OFF_SG      (56 * MIB)
#define OFF_NQ      (88 * MIB)
#define OFF_QF      (120 * MIB)
#define OFF_LOGF    (136 * MIB)
#define OFF_YB1     (136 * MIB)
#define OFF_HVT     (152 * MIB)
#define OFF_ABUF    (168 * MIB)
#define OFF_UST     (176 * MIB)
#define OFF_KV      (208 * MIB)
#define OFF_NQR     (224 * MIB)
#define OFF_VST     (228 * MIB)
#define OFF_VWT     (232 * MIB)
#define OFF_DCY     (236 * MIB)
#define OFF_HIDK    (236 * MIB + 524288)
#define OFF_HIDV    (237 * MIB + 524288)
#define OFF_KCMP    (238 * MIB + 524288)
#define OFF_VCMPT   (238 * MIB + 524288 + 262144)
#define OFF_MERGED  (88 * MIB)
#define OFF_Z1      (152 * MIB)
#define OFF_V       (56 * MIB)
#define OFF_FFH     (120 * MIB)
#define OFF_Z2      (56 * MIB)
#define OFF_H2B     (120 * MIB)
#define OFF_PB      (152 * MIB)
#define OFF_Z3      (160 * MIB)

struct Params {
  const float *x, *p, *w_in, *w_a, *w_b, *w_out, *n_pre_mix, *n_post_mix, *n_pre_mlp, *n_post_mlp;
  const float *lb_logits, *gnorm, *pe_k, *pe_v, *wk1, *wk2, *wv1, *wv2, *w_up, *w_down, *w_ple, *w_pg, *n_ple;
  float* out;
  char* ws;
};

__device__ __forceinline__ int bid_() { int b = blockIdx.x; asm volatile("" : "+s"(b)); return b; }
__device__ __forceinline__ int tid_() { int t = threadIdx.x; asm volatile("" : "+v"(t)); return t; }
typedef __attribute__((ext_vector_type(2))) float f32x2_t;
typedef __attribute__((ext_vector_type(2))) __bf16 bf16x2_t;
__device__ __forceinline__ uint32_t pack2(float a, float b) {
  f32x2_t v = {a, b};
  return __builtin_bit_cast(uint32_t, __builtin_convertvector(v, bf16x2_t));
}
__device__ __forceinline__ u16 f2bf(float f) { return (u16)(pack2(f, f) & 0xffffu); }
__device__ __forceinline__ float bf2f(u16 h) { return __uint_as_float(((uint32_t)h) << 16); }
__device__ __forceinline__ float shx_f(float v, int src_lane) { return __int_as_float(__builtin_amdgcn_ds_bpermute(src_lane << 2, __float_as_int(v))); }
__device__ __forceinline__ uint32_t shx_u(uint32_t v, int src_lane) { return (uint32_t)__builtin_amdgcn_ds_bpermute(src_lane << 2, (int)v); }
#define SHX(v, m) shx_f((v), lane ^ (m))
#define SHXU(v, m) shx_u((v), lane ^ (m))
__device__ __forceinline__ float sigm(float x) { return __builtin_amdgcn_rcpf(1.f + __expf(-x)); }
__device__ __forceinline__ float siluf(float x) { return x * __builtin_amdgcn_rcpf(1.f + __expf(-x)); }
__device__ __forceinline__ float gelu_tanh(float x) {
  float u = 0.7978845608028654f * (x + 0.044715f * x * x * x);
  float t = 1.f - 2.f * __builtin_amdgcn_rcpf(__expf(2.f * u) + 1.f);
  return 0.5f * x * (1.f + t);
}
__device__ __forceinline__ bf16x8 mk8(uint32_t a, uint32_t b, uint32_t c, uint32_t d) {
  u32x4 v = {a, b, c, d};
  return __builtin_bit_cast(bf16x8, v);
}
__device__ __forceinline__ bf16x8 ld8(const u16* p) { return *(const bf16x8*)p; }

template <int AMODE, int DEEP>
__device__ __forceinline__ void gemm_tile(const u16* __restrict__ A, long lda, int m0, int M,
                                          const u16* __restrict__ Bt, long ldb, int n0, int N, int K,
                                          int coloff, f32x4 (&acc)[4][4], u16* sA, u16* sB) {
  const int tid = tid_(), lane = tid & 63, wave = tid >> 6;
  const int l15 = lane & 15, G = lane >> 4;
  const int wm = wave >> 1, wn = wave & 1;
  const int lr = tid >> 3, ch = tid & 7;
  const char* Ab = (const char*)A;
  const char* Bb = (const char*)Bt;
  unsigned oa[4], ob[4];
  int tok0[4];
#pragma unroll
  for (int i = 0; i < 4; ++i) {
    int r = m0 + lr + 32 * i;
    if (AMODE == 0) {
      if (r > M - 1) r = M - 1;
      oa[i] = (unsigned)(((long)r * lda + ch * 8) * 2);
      tok0[i] = 0;
    } else {
      int grp = r >> 8, n = r & 255;
      int bl = grp >> 2, g = grp & 3;
      tok0[i] = n * 16;
      oa[i] = (unsigned)((bl * 4096 * 1024 + coloff + g * 64 + ch * 8) * 2);
    }
    int rn = n0 + lr + 32 * i;
    if (rn > N - 1) rn = N - 1;
    ob[i] = (unsigned)(((long)rn * ldb + ch * 8) * 2);
  }
#define G_LOAD(RA, RB, KT)                                                                                   \
  {                                                                                                          \
    const char* Ak_ = Ab + (size_t)(KT) * 128;                                                               \
    const char* Bk_ = Bb + (size_t)(KT) * 128;                                                               \
    _Pragma("unroll") for (int i = 0; i < 4; ++i) {                                                          \
      if (AMODE == 0) RA[i] = *(const u32x4*)(Ak_ + oa[i]);                                                  \
      else { int tok = tok0[i] + (KT); if (tok > 4095) tok = 4095; RA[i] = *(const u32x4*)(Ab + (oa[i] + (unsigned)tok * 2048u)); } \
      RB[i] = *(const u32x4*)(Bk_ + ob[i]);                                                                  \
    }                                                                                                        \
  }
#define L_STORE(RA, RB)                                                                                      \
  _Pragma("unroll") for (int i = 0; i < 4; ++i) {                                                            \
    *(u32x4*)&sA[(lr + 32 * i) * 80 + ch * 8] = RA[i];                                                       \
    *(u32x4*)&sB[(lr + 32 * i) * 80 + ch * 8] = RB[i];                                                       \
  }
#define T_COMPUTE()                                                                                          \
  _Pragma("unroll") for (int ks = 0; ks < 2; ++ks) {                                                         \
    bf16x8 af[4], bfr[4];                                                                                    \
    _Pragma("unroll") for (int i = 0; i < 4; ++i) af[i] = ld8(&sA[(wm * 64 + 16 * i + l15) * 80 + ks * 32 + G * 8]);  \
    _Pragma("unroll") for (int j = 0; j < 4; ++j) bfr[j] = ld8(&sB[(wn * 64 + 16 * j + l15) * 80 + ks * 32 + G * 8]); \
    _Pragma("unroll") for (int i = 0; i < 4; ++i)                                                            \
      _Pragma("unroll") for (int j = 0; j < 4; ++j) acc[i][j] = MFMA(af[i], bfr[j], acc[i][j]);              \
  }                                                                                                          \
     \
  __builtin_amdgcn_sched_group_barrier(0x100, 8, 0);                                                         \
  _Pragma("unroll") for (int z = 0; z < 8; ++z) {                                                            \
    __builtin_amdgcn_sched_group_barrier(0x008, 2, 0);                                                       \
    __builtin_amdgcn_sched_group_barrier(0x100, 1, 0);                                                       \
  }                                                                                                          \
  __builtin_amdgcn_sched_group_barrier(0x008, 16, 0);
  const int nk = K >> 6;
  if (DEEP == 2) {
    u32x4 ra0[4], rb0[4], ra1[4], rb1[4];
    const int kl = nk - 1;
    G_LOAD(ra0, rb0, 0);
    G_LOAD(ra1, rb1, 1);
    for (int kt = 0; kt < nk; kt += 2) {
      L_STORE(ra0, rb0);
      __syncthreads();
      G_LOAD(ra0, rb0, (kt + 2 < kl ? kt + 2 : kl));
      T_COMPUTE();
      __syncthreads();
      L_STORE(ra1, rb1);
      __syncthreads();
      G_LOAD(ra1, rb1, (kt + 3 < kl ? kt + 3 : kl));
      T_COMPUTE();
      __syncthreads();
    }
  } else {
    u32x4 ra0[4], rb0[4];
    G_LOAD(ra0, rb0, 0);
    for (int kt = 0; kt < nk; ++kt) {
      L_STORE(ra0, rb0);
      __syncthreads();
      if (kt + 1 < nk) G_LOAD(ra0, rb0, kt + 1);
      T_COMPUTE();
      __syncthreads();
    }
  }
#undef G_LOAD
#undef L_STORE
#undef T_COMPUTE
}

__device__ __forceinline__ void zero_acc(f32x4 (&acc)[4][4]) {
#pragma unroll
  for (int i = 0; i < 4; ++i)
#pragma unroll
    for (int j = 0; j < 4; ++j) acc[i][j] = (f32x4){0.f, 0.f, 0.f, 0.f};
}

#define EPI_VARS                                                         \
  const int tid = tid_(), lane = tid & 63, wave = tid >> 6;         \
  const int l15 = lane & 15, G = lane >> 4;                              \
  const int wm = wave >> 1, wn = wave & 1;                               \
  (void)l15; (void)G; (void)wm; (void)wn;

__device__ __forceinline__ void transpose_tile(const float* __restrict__ W, int ldw, int oc0, int valid, int k0, u16* __restrict__ out,
                               long Kdim, int n0, float* s  ) {
  const int tid = tid_();
  __syncthreads();
  {
    const bool vec = (valid == 64) && (((oc0 | ldw) & 3) == 0);
    if (vec) {
      const int n4 = (tid & 15) * 4;
      float4 v[4];
#pragma unroll
      for (int i = 0; i < 4; ++i) v[i] = *(const float4*)(W + (long)(k0 + (tid >> 4) + 16 * i) * ldw + oc0 + n4);
#pragma unroll
      for (int i = 0; i < 4; ++i) {
        float* d = &s[((tid >> 4) + 16 * i) * 65 + n4];
        d[0] = v[i].x; d[1] = v[i].y; d[2] = v[i].z; d[3] = v[i].w;
      }
    } else {
      const int n = tid & 63;
      for (int kk = tid >> 6; kk < 64; kk += 4) {
        float v = 0.f;
        if (n < valid) v = W[(long)(k0 + kk) * ldw + oc0 + n];
        s[kk * 65 + n] = v;
      }
    }
  }
  __syncthreads();
  {
    const int nn = tid >> 2, kq = (tid & 3) * 16;
    uint32_t w[8];
#pragma unroll
    for (int e = 0; e < 8; ++e) w[e] = pack2(s[(kq + 2 * e) * 65 + nn], s[(kq + 2 * e + 1) * 65 + nn]);
    u16* dst = out + (long)(n0 + nn) * Kdim + k0 + kq;
    *(u32x4*)dst = (u32x4){w[0], w[1], w[2], w[3]};
    *(u32x4*)(dst + 8) = (u32x4){w[4], w[5], w[6], w[7]};
  }
}

__device__ __forceinline__ void transpose_job(const float* W, int N, int K, u16* out, int tile, float* s) {
  const int kt_n = K >> 6;
  const int nt = tile / kt_n, kt = tile % kt_n;
  transpose_tile(W, N, nt * 64, 64, kt * 64, out, K, nt * 64, s);
}

__device__ __forceinline__ void phase_prep(const Params& P, char* smem) {
  const int tid = tid_(), lane = tid & 63, wave = tid >> 6;
  char* ws = P.ws;
  float* sf = (float*)smem;
  {
    u16* U = (u16*)(ws + OFF_U);
    for (int un = bid_(); un < 2048; un += gridDim.x) {
      const int row0 = un * 8 + wave * 2;
      float4 v[2][4];
      float ss[2] = {0.f, 0.f};
#pragma unroll
      for (int rr = 0; rr < 2; ++rr)
#pragma unroll
        for (int j = 0; j < 4; ++j) v[rr][j] = *(const float4*)(P.x + (long)(row0 + rr) * 1024 + j * 256 + lane * 4);
#pragma unroll
      for (int rr = 0; rr < 2; ++rr) {
#pragma unroll
        for (int j = 0; j < 4; ++j)
          ss[rr] += v[rr][j].x * v[rr][j].x + v[rr][j].y * v[rr][j].y + v[rr][j].z * v[rr][j].z + v[rr][j].w * v[rr][j].w;
#pragma unroll
        for (int o = 32; o >= 1; o >>= 1) ss[rr] += SHX(ss[rr], o);
        const float r = rsqrtf(ss[rr] * (1.f / 1024.f) + 1e-6f);
#pragma unroll
        for (int j = 0; j < 4; ++j) {
          const float4 w = *(const float4*)(P.n_pre_mix + j * 256 + lane * 4);
          u32x2 o2 = {pack2(v[rr][j].x * r * w.x, v[rr][j].y * r * w.y), pack2(v[rr][j].z * r * w.z, v[rr][j].w * r * w.w)};
          *(u32x2*)(U + (long)(row0 + rr) * 1024 + j * 256 + lane * 4) = o2;
        }
      }
    }
  }
  {
    u16* WT = (u16*)(ws + OFF_WIN_T);
    for (int t = bid_(); t < 138 * 16; t += gridDim.x) {
      const int nt = t >> 4, kt = t & 15;
      const int nr0 = nt * 64;
      int oc0, valid;
      if (nr0 < 6656) { oc0 = nr0; valid = 64; }
      else if (nr0 < 8704) { oc0 = nr0 + 48; valid = 64; }
      else if (nr0 == 8704) { oc0 = 6656; valid = 48; }
      else { oc0 = 0; valid = 0; }
      transpose_tile(P.w_in, 8752, oc0, valid, kt * 64, WT, 1024, nr0, sf);
    }
    for (int t = bid_(); t < 128; t += gridDim.x) transpose_job(P.wk1, 256, 2048, (u16*)(ws + OFF_WK1T), t, sf);
    for (int t = bid_(); t < 128; t += gridDim.x) transpose_job(P.wv1, 256, 2048, (u16*)(ws + OFF_WV1T), t, sf);
    for (int t = bid_(); t < 4; t += gridDim.x) transpose_job(P.wk2, 64, 256, (u16*)(ws + OFF_WK2T), t, sf);
    for (int t = bid_(); t < 4; t += gridDim.x) transpose_job(P.wv2, 64, 256, (u16*)(ws + OFF_WV2T), t, sf);
  }
  {
    float2* RT = (float2*)(ws + OFF_ROPE);
    for (int un = bid_(); un < 128; un += gridDim.x) {
      const int idx = un * 256 + tid;
      const int t = idx >> 3, j = idx & 7;
      const float inv = (j == 0) ? 1.0f : (j == 1) ? 0.1939227432012558f : (j == 2) ? 0.03760603070259094f
                      : (j == 3) ? 0.007292664609849453f : (j == 4) ? 0.0014142135623842478f
                      : (j == 5) ? 0.00027424818836152554f : (j == 6) ? 5.3182957344688475e-05f : 1.0313385246263351e-05f;
      const float ang = (float)t * inv;
      const double ad = (double)ang;
      const double kq = rint(ad * 0.15915494309189535);
      const float rr = (float)(ad - kq * 6.283185307179586);
      float sn, cs;
      sincosf(rr, &sn, &cs);
      RT[idx] = make_float2(cs, sn);
    }
  }
  {
    float* B1P = (float*)(ws + OFF_BIAS1P);
    for (int un = bid_(); un < 16; un += gridDim.x) {
      const int kvi = un >> 3, part = un & 7;
      const float* pe = kvi ? P.pe_v : P.pe_k;
      const float* w1 = kvi ? P.wv1 : P.wk1;
      float4 a = make_float4(0.f, 0.f, 0.f, 0.f);
      const int k0 = part * 256 + wave * 64;
#pragma unroll 8
      for (int k = k0; k < k0 + 64; ++k) {
        const float pv = pe[k];
        const float4 w = *(const float4*)(w1 + (long)k * 256 + lane * 4);
        a.x += pv * w.x; a.y += pv * w.y; a.z += pv * w.z; a.w += pv * w.w;
      }
      __syncthreads();
      *(float4*)&sf[wave * 256 + lane * 4] = a;
      __syncthreads();
      B1P[un * 256 + tid] = sf[tid] + sf[256 + tid] + sf[512 + tid] + sf[768 + tid];
      __syncthreads();
    }
  }
  {
    float* LB = (float*)(ws + OFF_LB);
    for (int un = bid_(); un < 4; un += gridDim.x) {
      const int c = un * 256 + tid;
      const float l0 = P.lb_logits[c], l1 = P.lb_logits[1024 + c];
      LB[c] = 1.f / (1.f + expf(l1 - l0));
    }
  }
}

__device__ __forceinline__ void phase_late_weights(const Params& P, char* smem) {
  char* ws = P.ws;
  float* sf = (float*)smem;
  for (int t = bid_(); t < 256; t += gridDim.x) transpose_job(P.w_a, 1024, 1024, (u16*)(ws + OFF_WA_T), t, sf);
  for (int t = bid_(); t < 256; t += gridDim.x) transpose_job(P.w_b, 1024, 1024, (u16*)(ws + OFF_WB_T), t, sf);
  for (int t = bid_(); t < 256; t += gridDim.x) transpose_job(P.w_out, 1024, 1024, (u16*)(ws + OFF_WOUT_T), t, sf);
  for (int t = bid_(); t < 256; t += gridDim.x) transpose_job(P.w_pg, 1024, 1024, (u16*)(ws + OFF_WPG_T), t, sf);
  for (int t = bid_(); t < 1024; t += gridDim.x) transpose_job(P.w_up, 4096, 1024, (u16*)(ws + OFF_WUP_T), t, sf);
  for (int t = bid_(); t < 1024; t += gridDim.x) transpose_job(P.w_down, 1024, 4096, (u16*)(ws + OFF_WDOWN_T), t, sf);
  for (int t = bid_(); t < 64; t += gridDim.x) transpose_job(P.w_ple, 1024, 256, (u16*)(ws + OFF_WPLE_T), t, sf);
}

__device__ __forceinline__ void phase_inproj(const Params& P, int half, char* smem) {
  char* ws = P.ws;
  u16* sA = (u16*)smem;
  u16* sB = sA + 128 * 80;
  float* sF = (float*)smem;
  const u16* U = (const u16*)(ws + OFF_U) + (long)half * 8192 * 1024;
  const u16* WT = (const u16*)(ws + OFF_WIN_T);
  u16* QF = (u16*)(ws + OFF_QF);
  u16* LOGF = (u16*)(ws + OFF_LOGF);
  u16* HVT = (u16*)(ws + OFF_HVT);
  u16* SG = (u16*)(ws + OFF_SG) + (long)half * 8192 * 1024;
  u16* NQ = (u16*)(ws + OFF_NQ) + (long)half * 8192 * 1024;
  u16* NQR = (u16*)(ws + OFF_NQR);
  u16* KV = (u16*)(ws + OFF_KV);
  u16* VST = (u16*)(ws + OFF_VST);
  u16* VWT = (u16*)(ws + OFF_VWT);
  u16* GATES = (u16*)P.out + (long)half * 8192 * 2048;
  float* NGATE = (float*)(ws + OFF_NGATE) + (long)half * 8192 * 48;
  const float* RTf = (const float*)(ws + OFF_ROPE);
  const float* LB = (const float*)(ws + OFF_LB);
  for (int t = bid_(); t < 64 * 69; t += gridDim.x) {
    const int nt = t >> 6, mt = t & 63;
    const int m0 = mt * 128, n0 = nt * 128;
    f32x4 acc[4][4];
    zero_acc(acc);
    gemm_tile<0, 2>(U, 1024, m0, 8192, WT, 1024, n0, 8832, 1024, 0, acc, sA, sB);
    {
      EPI_VARS
#pragma unroll
      for (int i = 0; i < 4; ++i)
#pragma unroll
        for (int j = 0; j < 4; ++j)
#pragma unroll
          for (int e = 0; e < 4; ++e) sF[(wm * 64 + 16 * i + G * 4 + e) * 128 + wn * 64 + 16 * j + l15] = acc[i][j][e];
    }
    __syncthreads();
    const int tc = tid_();
    int kind = 0, op = 0, dstride = 1024, dcol = 0;
    u16* dbase = nullptr;
    u16* tbase = nullptr;
    if (nt < 8) { dbase = QF; dcol = n0; op = 0; }
    else if (nt < 16) { dbase = LOGF; dcol = n0 - 1024; op = 1; }
    else if (nt < 24) { kind = 1; tbase = HVT; }
    else if (nt < 32) { dbase = SG; dcol = n0 - 3072; op = 2; }
    else if (nt < 40) { dbase = NQ; dcol = n0 - 4096; op = 3; }
    else if (nt < 52) {
      const int c0 = n0 - 5120, sub0 = c0 >> 8;
      if (sub0 == 3 || sub0 == 5) { kind = 2; tbase = (sub0 == 3) ? VST : VWT; }
      else { dbase = KV; dcol = ((sub0 == 0) ? 0 : (sub0 == 1) ? 256 : (sub0 == 2) ? 512 : 768) + (c0 & 255); op = (sub0 >= 2) ? 5 : 4; }
    } else if (nt < 68) { dbase = GATES; dstride = 2048; dcol = n0 - 6656; op = 6; }
    else kind = 3;

    if (kind == 0) {
#pragma unroll 2
      for (int k8 = 0; k8 < 8; ++k8) {
        const int id = tc + 256 * k8;
        const int row = id >> 4, c8 = (id & 15) * 8;
        const float4 f0 = *(const float4*)&sF[row * 128 + c8];
        const float4 f1 = *(const float4*)&sF[row * 128 + c8 + 4];
        float v[8] = {f0.x, f0.y, f0.z, f0.w, f1.x, f1.y, f1.z, f1.w};
        const int hc = c8 & 63;
        if (op == 0) {
#pragma unroll
          for (int q = 0; q < 8; ++q) v[q] = siluf(v[q]) * 0.08838834764831845f;
        } else if (op == 1) {
          const float4 l0 = *(const float4*)(LB + dcol + c8);
          const float4 l1 = *(const float4*)(LB + dcol + c8 + 4);
          const float lb[8] = {l0.x, l0.y, l0.z, l0.w, l1.x, l1.y, l1.z, l1.w};
#pragma unroll
          for (int q = 0; q < 8; ++q) v[q] = __logf(lb[q] + (1.f - lb[q]) * sigm(v[q]));
        } else if (op == 2) {
#pragma unroll
          for (int q = 0; q < 8; ++q) v[q] = siluf(v[q]);
        } else if (op == 3) {
#pragma unroll
          for (int q = 0; q < 8; ++q) v[q] *= 0.18033688011112042f;
        } else if (op == 6) {
#pragma unroll
          for (int q = 0; q < 8; ++q) v[q] = sigm(v[q]);
        }
        if ((op == 3 || op == 5) && hc < 16) {
          const int pc = (hc == 0) ? c8 + 8 : c8 - 8;
          const float4 g0 = *(const float4*)&sF[row * 128 + pc];
          const float4 g1 = *(const float4*)&sF[row * 128 + pc + 4];
          float pr[8] = {g0.x, g0.y, g0.z, g0.w, g1.x, g1.y, g1.z, g1.w};
          if (op == 3) {
#pragma unroll
            for (int q = 0; q < 8; ++q) pr[q] *= 0.18033688011112042f;
          }
          const int tt = (m0 + row) & 4095;
          const float4 r0 = *(const float4*)(RTf + tt * 16);
          const float4 r1 = *(const float4*)(RTf + tt * 16 + 4);
          const float4 r2 = *(const float4*)(RTf + tt * 16 + 8);
          const float4 r3 = *(const float4*)(RTf + tt * 16 + 12);
          const float cs[8] = {r0.x, r0.z, r1.x, r1.z, r2.x, r2.z, r3.x, r3.z};
          const float sn[8] = {r0.y, r0.w, r1.y, r1.w, r2.y, r2.w, r3.y, r3.w};
          float ro[8];
#pragma unroll
          for (int q = 0; q < 8; ++q) ro[q] = (hc == 0) ? (v[q] * cs[q] - pr[q] * sn[q]) : (v[q] * cs[q] + pr[q] * sn[q]);
          if (op == 3) {
            const int head = (dcol + c8) >> 6;
            *(u32x4*)(NQR + (long)(m0 + row) * 256 + head * 16 + hc) =
                (u32x4){pack2(ro[0], ro[1]), pack2(ro[2], ro[3]), pack2(ro[4], ro[5]), pack2(ro[6], ro[7])};
          } else {
#pragma unroll
            for (int q = 0; q < 8; ++q) v[q] = ro[q];
          }
        }
        u32x4 o4;
        if (op == 1) {
          union { _Float16 h[8]; u32x4 u; } cv;
#pragma unroll
          for (int q = 0; q < 8; ++q) cv.h[q] = (_Float16)v[q];
          o4 = cv.u;
        } else {
          o4 = (u32x4){pack2(v[0], v[1]), pack2(v[2], v[3]), pack2(v[4], v[5]), pack2(v[6], v[7])};
        }
        *(u32x4*)(dbase + (long)(m0 + row) * dstride + dcol + c8) = o4;
      }
    } else if (kind == 1 || kind == 2) {
#pragma unroll 2
      for (int k8 = 0; k8 < 8; ++k8) {
        const int id = tc + 256 * k8;
        const int col = id & 127, r8 = (id >> 7) * 8;
        float v[8];
#pragma unroll
        for (int q = 0; q < 8; ++q) v[q] = sF[(r8 + q) * 128 + col];
        const int r = m0 + r8;
        const int bl = r >> 12, tt = r & 4095;
        unsigned off;
        if (kind == 1) {
          const int c = n0 + col - 2048;
          const int h = c >> 7, dv = c & 127;
          off = ((unsigned)(((bl * 8 + h) * 64 + (tt >> 6)) * 128 + dv) * 64u + (unsigned)(tt & 63)) * 2u;
        } else {
          const int cc = (n0 + col - 5120) & 255;
          const int g = cc >> 6, d = cc & 63;
          off = ((unsigned)((bl * 4 + g) * 64 + d) * 4096u + (unsigned)tt) * 2u;
        }
        *(u32x4*)((char*)tbase + off) = (u32x4){pack2(v[0], v[1]), pack2(v[2], v[3]), pack2(v[4], v[5]), pack2(v[6], v[7])};
      }
    } else {
      for (int id = tc; id < 128 * 48; id += 256) {
        const int row = id / 48, c = id - row * 48;
        NGATE[(long)(m0 + row) * 48 + c] = sigm(sF[row * 128 + c]);
      }
    }
    __syncthreads();
  }
}

__device__ __forceinline__ void hgrn_intra_unit(const Params& P, int uu, char* smem) {
  char* ws = P.ws;
  const int tid = tid_(), lane = tid & 63, wave = tid >> 6;
  const int l15 = lane & 15, G = lane >> 4;
  float* sBc = (float*)smem;
  u16* sQ = (u16*)(smem + 64 * 132 * 4);
  const int bl = uu >> 9, h = (uu >> 6) & 7, c = uu & 63;
  const long r0 = (long)bl * 4096 + c * 64;
  u16* QF = (u16*)(ws + OFF_QF);
  const _Float16* LOGF = (const _Float16*)(ws + OFF_LOGF);
  const u16* HVT = (const u16*)(ws + OFF_HVT);
  u16* ABUF = (u16*)(ws + OFF_ABUF);
  u16* UST = (u16*)(ws + OFF_UST);
  float* DCY = (float*)(ws + OFF_DCY);

  __syncthreads();
#pragma unroll
  for (int i = 0; i < 4; ++i) {
    const int id = tid + 256 * i;
    const int row = id >> 4, cc = (id & 15) * 8;
    const u32x4 lf = *(const u32x4*)(LOGF + (r0 + row) * 1024 + h * 128 + cc);
    const _Float16* hp = (const _Float16*)&lf;
#pragma unroll
    for (int e = 0; e < 8; ++e) sBc[row * 132 + cc + e] = (float)hp[e];
    *(u32x4*)&sQ[row * 136 + cc] = *(const u32x4*)(QF + (r0 + row) * 1024 + h * 128 + cc);
  }
  __syncthreads();
  if (tid < 128) {
    float run = 0.f;
    for (int s = 0; s < 64; ++s) {
      run += sBc[s * 132 + tid];
      sBc[s * 132 + tid] = run;
    }
  }
  __syncthreads();
#pragma unroll
  for (int i = 0; i < 4; ++i) {
    const int id = tid + 256 * i;
    const int row = id >> 4, cc = (id & 15) * 8;
    uint32_t w[4];
#pragma unroll
    for (int e = 0; e < 4; ++e) {
      const float q0 = bf2f(sQ[row * 136 + cc + 2 * e]) * __expf(sBc[row * 132 + cc + 2 * e]);
      const float q1 = bf2f(sQ[row * 136 + cc + 2 * e + 1]) * __expf(sBc[row * 132 + cc + 2 * e + 1]);
      w[e] = pack2(q0, q1);
    }
    *(u32x4*)(QF + (r0 + row) * 1024 + h * 128 + cc) = (u32x4){w[0], w[1], w[2], w[3]};
  }
  if (tid < 128) DCY[(long)uu * 128 + tid] = __expf(sBc[63 * 132 + tid]);
  for (int idx = tid; idx < 4096; idx += 256) {
    const int t = idx >> 6, s = idx & 63;
    if ((s >> 4) > (t >> 4)) ABUF[(long)uu * 4096 + idx] = 0;
  }
  for (int ti = wave; ti < 10; ti += 4) {
    int i, j;
    if (ti == 0) { i = 0; j = 0; }
    else if (ti < 3) { i = 1; j = ti - 1; }
    else if (ti < 6) { i = 2; j = ti - 3; }
    else { i = 3; j = ti - 6; }
    f32x4 a4 = {0.f, 0.f, 0.f, 0.f};
    const int t = 16 * i + l15, s = 16 * j + l15;
#pragma unroll
    for (int ks = 0; ks < 4; ++ks) {
      const int dk0 = ks * 32 + G * 8;
      uint32_t aw[4], bw[4];
#pragma unroll
      for (int e2 = 0; e2 < 4; ++e2) {
        float av[2], bv[2];
#pragma unroll
        for (int z = 0; z < 2; ++z) {
          const int dk = dk0 + 2 * e2 + z;
          const float br = sBc[(16 * i) * 132 + dk];
          const float bt = sBc[t * 132 + dk];
          av[z] = bf2f(sQ[t * 136 + dk]) * __expf(bt - br);
          const float bs = sBc[s * 132 + dk];
          const float bp = (s > 0) ? sBc[(s - 1) * 132 + dk] : 0.f;
          const float kk = 1.f - __expf(bs - bp);
          bv[z] = kk * __expf(br - bs);
        }
        aw[e2] = pack2(av[0], av[1]);
        bw[e2] = pack2(bv[0], bv[1]);
      }
      a4 = MFMA(mk8(aw[0], aw[1], aw[2], aw[3]), mk8(bw[0], bw[1], bw[2], bw[3]), a4);
    }
#pragma unroll
    for (int e = 0; e < 4; ++e) {
      const int tr = 16 * i + G * 4 + e, sc = 16 * j + l15;
      const float v = (sc <= tr) ? a4[e] : 0.f;
      ABUF[(long)uu * 4096 + tr * 64 + sc] = f2bf(v);
    }
  }
  {
    f32x4 ua[8][2];
#pragma unroll
    for (int rt = 0; rt < 8; ++rt) { ua[rt][0] = (f32x4){0.f, 0.f, 0.f, 0.f}; ua[rt][1] = (f32x4){0.f, 0.f, 0.f, 0.f}; }
#pragma unroll
    for (int ks = 0; ks < 2; ++ks) {
      bf16x8 bfr[2];
#pragma unroll
      for (int ct = 0; ct < 2; ++ct) {
        const int dk = (2 * wave + ct) * 16 + l15;
        const float blast = sBc[63 * 132 + dk];
        const int s0 = ks * 32 + G * 8;
        float prev = (s0 > 0) ? sBc[(s0 - 1) * 132 + dk] : 0.f;
        uint32_t bw[4];
#pragma unroll
        for (int e2 = 0; e2 < 4; ++e2) {
          const float b0 = sBc[(s0 + 2 * e2) * 132 + dk];
          const float b1 = sBc[(s0 + 2 * e2 + 1) * 132 + dk];
          const float k0 = (1.f - __expf(b0 - prev)) * __expf(blast - b0);
          const float k1 = (1.f - __expf(b1 - b0)) * __expf(blast - b1);
          prev = b1;
          bw[e2] = pack2(k0, k1);
        }
        bfr[ct] = mk8(bw[0], bw[1], bw[2], bw[3]);
      }
#pragma unroll
      for (int rt = 0; rt < 8; ++rt) {
        const int dv = rt * 16 + l15;
        const bf16x8 af = ld8(HVT + ((long)uu * 128 + dv) * 64 + ks * 32 + G * 8);
        ua[rt][0] = MFMA(af, bfr[0], ua[rt][0]);
        ua[rt][1] = MFMA(af, bfr[1], ua[rt][1]);
      }
    }
#pragma unroll
    for (int rt = 0; rt < 8; ++rt)
#pragma unroll
      for (int ct = 0; ct < 2; ++ct)
#pragma unroll
        for (int e = 0; e < 4; ++e) {
          const int dv = rt * 16 + G * 4 + e, dk = (2 * wave + ct) * 16 + l15;
          UST[((long)uu * 128 + dv) * 128 + dk] = f2bf(ua[rt][ct][e]);
        }
  }
}

__device__ __forceinline__ void cmp_gemm1_tile(const Params& P, int t, char* smem) {
  char* ws = P.ws;
  u16* sA = (u16*)smem;
  u16* sB = sA + 128 * 80;
  EPI_VARS
  const int kv = t >> 5, rem = t & 31;
  const int mt = rem >> 1, nt = rem & 1;
  const int m0 = mt * 128, n0 = nt * 128;
  const u16* KV = (const u16*)(ws + OFF_KV);
  const u16* W1T = (const u16*)(ws + (kv ? OFF_WV1T : OFF_WK1T));
  u16* HID = (u16*)(ws + (kv ? OFF_HIDV : OFF_HIDK));
  const float* B1P = (const float*)(ws + OFF_BIAS1P) + kv * 2048;
  f32x4 acc[4][4];
  zero_acc(acc);
  gemm_tile<1, 2>(KV, 1024, m0, 2048, W1T, 2048, n0, 256, 2048, kv * 256, acc, sA, sB);
#pragma unroll
  for (int i = 0; i < 4; ++i)
#pragma unroll
    for (int j = 0; j < 4; ++j) {
      const int col = n0 + wn * 64 + 16 * j + l15;
      float bias = 0.f;
#pragma unroll
      for (int pp = 0; pp < 8; ++pp) bias += B1P[pp * 256 + col];
#pragma unroll
      for (int e = 0; e < 4; ++e) {
        const int row = m0 + wm * 64 + 16 * i + G * 4 + e;
        HID[(long)row * 256 + col] = f2bf(gelu_tanh(acc[i][j][e] + bias));
      }
    }
}

__device__ __forceinline__ void cmp_gemm2_tile(const Params& P, int t, char* smem) {
  char* ws = P.ws;
  u16* sA = (u16*)smem;
  u16* sB = sA + 128 * 80;
  EPI_VARS
  const int kv = t >> 4, mt = t & 15;
  const int m0 = mt * 128;
  const u16* HID = (const u16*)(ws + (kv ? OFF_HIDV : OFF_HIDK));
  const u16* W2T = (const u16*)(ws + (kv ? OFF_WV2T : OFF_WK2T));
  u16* KCMP = (u16*)(ws + OFF_KCMP);
  u16* VCMPT = (u16*)(ws + OFF_VCMPT);
  f32x4 acc[4][4];
  zero_acc(acc);
  gemm_tile<0, 1>(HID, 256, m0, 2048, W2T, 256, 0, 64, 256, 0, acc, sA, sB);
  if (wn == 0) {
#pragma unroll
    for (int i = 0; i < 4; ++i)
#pragma unroll
      for (int j = 0; j < 4; ++j) {
        const int col = 16 * j + l15;
        const int rbase = m0 + wm * 64 + 16 * i + G * 4;
        if (kv == 0) {
#pragma unroll
          for (int e = 0; e < 4; ++e) KCMP[(long)(rbase + e) * 64 + col] = f2bf(acc[i][j][e]);
        } else {
          const int grp = rbase >> 8, n = rbase & 255;
          u32x2 o2 = {pack2(acc[i][j][0], acc[i][j][1]), pack2(acc[i][j][2], acc[i][j][3])};
          *(u32x2*)(VCMPT + ((long)grp * 64 + col) * 256 + n) = o2;
        }
      }
  }
}

__device__ __forceinline__ void hgrn_scan(const Params& P) {
  char* ws = P.ws;
  u16* UST = (u16*)(ws + OFF_UST);
  const float* DCY = (const float*)(ws + OFF_DCY);
  for (int idx = bid_() * 256 + tid_(); idx < 131072; idx += gridDim.x * 256) {
    const int bh = idx >> 13, rem = idx & 8191;
    const int dv = rem >> 6, dk2 = (rem & 63) * 2;
    float s0 = 0.f, s1 = 0.f;
#pragma unroll 8
    for (int c = 0; c < 64; ++c) {
      const long uu = (long)bh * 64 + c;
      u16* ptr = UST + (uu * 128 + dv) * 128 + dk2;
      const uint32_t uv = *(const uint32_t*)ptr;
      const float2 d = *(const float2*)(DCY + uu * 128 + dk2);
      *(uint32_t*)ptr = pack2(s0, s1);
      s0 = d.x * s0 + __uint_as_float(uv << 16);
      s1 = d.y * s1 + __uint_as_float(uv & 0xffff0000u);
    }
  }
}

__device__ __forceinline__ void hgrn_out_unit(const Params& P, int half, int uu, char* smem) {
  char* ws = P.ws;
  const int tid = tid_(), lane = tid & 63, wave = tid >> 6;
  const int l15 = lane & 15, G = lane >> 4;
  float* sO = (float*)smem;
  const int bl = uu >> 9, h = (uu >> 6) & 7, c = uu & 63;
  const long r0 = (long)bl * 4096 + c * 64;
  const u16* QF = (const u16*)(ws + OFF_QF);
  const u16* HVT = (const u16*)(ws + OFF_HVT);
  const u16* ABUF = (const u16*)(ws + OFF_ABUF);
  const u16* UST = (const u16*)(ws + OFF_UST);
  u16* SG = (u16*)(ws + OFF_SG) + (long)half * 8192 * 1024;
  f32x4 acc[4][2];
#pragma unroll
  for (int i = 0; i < 4; ++i) { acc[i][0] = (f32x4){0.f, 0.f, 0.f, 0.f}; acc[i][1] = (f32x4){0.f, 0.f, 0.f, 0.f}; }
#pragma unroll
  for (int ks = 0; ks < 4; ++ks) {
    const int dk0 = ks * 32 + G * 8;
    bf16x8 bfr[2];
#pragma unroll
    for (int jt = 0; jt < 2; ++jt) bfr[jt] = ld8(UST + ((long)uu * 128 + 32 * wave + 16 * jt + l15) * 128 + dk0);
#pragma unroll
    for (int i = 0; i < 4; ++i) {
      const bf16x8 af = ld8(QF + (r0 + 16 * i + l15) * 1024 + h * 128 + dk0);
      acc[i][0] = MFMA(af, bfr[0], acc[i][0]);
      acc[i][1] = MFMA(af, bfr[1], acc[i][1]);
    }
  }
#pragma unroll
  for (int ks = 0; ks < 2; ++ks) {
    const int s0 = ks * 32 + G * 8;
    bf16x8 bfr[2];
#pragma unroll
    for (int jt = 0; jt < 2; ++jt) bfr[jt] = ld8(HVT + ((long)uu * 128 + 32 * wave + 16 * jt + l15) * 64 + s0);
#pragma unroll
    for (int i = 0; i < 4; ++i) {
      const bf16x8 af = ld8(ABUF + (long)uu * 4096 + (16 * i + l15) * 64 + s0);
      acc[i][0] = MFMA(af, bfr[0], acc[i][0]);
      acc[i][1] = MFMA(af, bfr[1], acc[i][1]);
    }
  }
  __syncthreads();
#pragma unroll
  for (int i = 0; i < 4; ++i)
#pragma unroll
    for (int jt = 0; jt < 2; ++jt)
#pragma unroll
      for (int e = 0; e < 4; ++e) sO[(16 * i + G * 4 + e) * 132 + 32 * wave + 16 * jt + l15] = acc[i][jt][e];
  __syncthreads();
  {
    const int row = tid >> 2, part = tid & 3;
    float ss = 0.f;
#pragma unroll
    for (int cc = 0; cc < 32; ++cc) { const float v = sO[row * 132 + part * 32 + cc]; ss += v * v; }
    ss += SHX(ss, 1);
    ss += SHX(ss, 2);
    const float r = rsqrtf(ss * (1.f / 128.f) + 1e-6f);
    u16* dst = SG + (r0 + row) * 1024 + h * 128 + part * 32;
#pragma unroll
    for (int q4 = 0; q4 < 4; ++q4) {
      const u32x4 sgv = *(const u32x4*)(dst + q4 * 8);
      uint32_t w[4];
#pragma unroll
      for (int e = 0; e < 4; ++e) {
        const int cc = q4 * 8 + 2 * e;
        const float g0 = __uint_as_float(sgv[e] << 16), g1 = __uint_as_float(sgv[e] & 0xffff0000u);
        const float y0 = sO[row * 132 + part * 32 + cc] * r * P.gnorm[part * 32 + cc] * g0;
        const float y1 = sO[row * 132 + part * 32 + cc + 1] * r * P.gnorm[part * 32 + cc + 1] * g1;
        w[e] = pack2(y0, y1);
      }
      *(u32x4*)(dst + q4 * 8) = (u32x4){w[0], w[1], w[2], w[3]};
    }
  }
}

__device__ __forceinline__ void stage_kv(u16* sK, u16* sV, const u16* kptr, long kstride, const u16* vptr, long vstride) {
  const int tid = tid_();
  __syncthreads();
#pragma unroll
  for (int i = 0; i < 2; ++i) {
    const int id = tid + 256 * i;
    const int row = id >> 3, ch = id & 7;
    *(u32x4*)&sK[row * 72 + ch * 8] = *(const u32x4*)(kptr + row * kstride + ch * 8);
    *(u32x4*)&sV[row * 72 + ch * 8] = *(const u32x4*)(vptr + row * vstride + ch * 8);
  }
  __syncthreads();
}

__device__ __forceinline__ void qk_scores(const u16* sK, const bf16x8 (&q)[2], f32x4 (&s)[4], int l15, int G) {
#pragma unroll
  for (int kt = 0; kt < 4; ++kt) {
    s[kt] = (f32x4){0.f, 0.f, 0.f, 0.f};
#pragma unroll
    for (int ks = 0; ks < 2; ++ks) s[kt] = MFMA(ld8(&sK[(16 * kt + l15) * 72 + ks * 32 + G * 8]), q[ks], s[kt]);
  }
}

__device__ __forceinline__ void pv_accum(const u16* sV, const f32x4 (&p)[4], f32x4 (&o)[4], int l15, int G) {
#pragma unroll
  for (int ks2 = 0; ks2 < 2; ++ks2) {
    const f32x4 pa = p[2 * ks2], pb = p[2 * ks2 + 1];
    const bf16x8 pf = mk8(pack2(pa[0], pa[1]), pack2(pa[2], pa[3]), pack2(pb[0], pb[1]), pack2(pb[2], pb[3]));
#pragma unroll
    for (int dt = 0; dt < 4; ++dt) {
      const u32x2 v0 = *(const u32x2*)&sV[(16 * dt + l15) * 72 + 32 * ks2 + 4 * G];
      const u32x2 v1 = *(const u32x2*)&sV[(16 * dt + l15) * 72 + 32 * ks2 + 16 + 4 * G];
      o[dt] = MFMA(mk8(v0[0], v0[1], v1[0], v1[1]), pf, o[dt]);
    }
  }
}

#define EX2(x) __builtin_amdgcn_exp2f(x)
typedef __attribute__((ext_vector_type(16))) float f32x16;
#define MFMA32(a, b, c) __builtin_amdgcn_mfma_f32_32x32x16_bf16((a), (b), (c), 0, 0, 0)
template <int MODE, bool EDGE>
__device__ __forceinline__ void nsa_block(const u16* sK, const u16* sV, int jb, int qb, int q, bool blk_ok,
                                          const bf16x8 (&qf)[4], f32x16 (&O)[2], float& m, float& l, int r31, int h) {
  const int lane = h * 32 + r31;
  f32x16 s[2];
#pragma unroll
  for (int kt2 = 0; kt2 < 2; ++kt2) {
#pragma unroll
    for (int e = 0; e < 16; ++e) s[kt2][e] = 0.f;
#pragma unroll
    for (int ks = 0; ks < 4; ++ks) s[kt2] = MFMA32(ld8(&sK[(32 * kt2 + r31) * 72 + 16 * ks + 8 * h]), qf[ks], s[kt2]);
  }
  float smax = -1e30f;
  if (EDGE) {
#pragma unroll
    for (int kt2 = 0; kt2 < 2; ++kt2)
#pragma unroll
      for (int e = 0; e < 16; ++e) {
        const int k = 32 * kt2 + (e & 3) + 8 * (e >> 2) + 4 * h;
        const bool a = blk_ok && ((jb == qb) ? (k <= q) : (k > q));
        if (!a) s[kt2][e] = -1e30f;
        smax = fmaxf(smax, s[kt2][e]);
      }
  } else {
#pragma unroll
    for (int kt2 = 0; kt2 < 2; ++kt2)
#pragma unroll
      for (int e = 0; e < 16; ++e) smax = fmaxf(smax, s[kt2][e]);
    if (MODE == 2 && !blk_ok) smax = -1e30f;
  }
  smax = fmaxf(smax, SHX(smax, 32));
  const float mn = fmaxf(m, smax);
  const bool need = (mn - m) > 8.f;
  if (__builtin_amdgcn_ballot_w64(need) != 0ull) {
    const float alpha = need ? EX2(m - mn) : 1.f;
    m = need ? mn : m;
    l *= alpha;
    O[0] *= alpha;
    O[1] *= alpha;
  }
  const float mref = (!EDGE && MODE == 2 && !blk_ok) ? 1e30f : m;
  float ls = 0.f;
#pragma unroll
  for (int kt2 = 0; kt2 < 2; ++kt2)
#pragma unroll
    for (int e = 0; e < 16; ++e) {
      const float sv = s[kt2][e];
      float pv;
      if (EDGE) pv = (sv > -1e29f) ? EX2(sv - m) : 0.f;
      else pv = EX2(sv - mref);
      s[kt2][e] = pv;
      ls += pv;
    }
  l += ls;
#pragma unroll
  for (int kt2 = 0; kt2 < 2; ++kt2)
#pragma unroll
    for (int st = 0; st < 2; ++st) {
      const bf16x8 pf = mk8(pack2(s[kt2][8 * st + 0], s[kt2][8 * st + 1]), pack2(s[kt2][8 * st + 2], s[kt2][8 * st + 3]),
                            pack2(s[kt2][8 * st + 4], s[kt2][8 * st + 5]), pack2(s[kt2][8 * st + 6], s[kt2][8 * st + 7]));
#pragma unroll
      for (int dt2 = 0; dt2 < 2; ++dt2) {
        const u16* vrow = &sV[(32 * dt2 + r31) * 72 + 32 * kt2 + 16 * st + 4 * h];
        const u32x2 v0 = *(const u32x2*)vrow;
        const u32x2 v1 = *(const u32x2*)(vrow + 8);
        O[dt2] = MFMA32(mk8(v0[0], v0[1], v1[0], v1[1]), pf, O[dt2]);
      }
    }
}

template <int MODE>
__device__ __forceinline__ void nsa_branch(const u16* kbase, const u16* vbase, int jb0, int jb1, int qb, int q,
                                           uint32_t mlo, uint32_t mhi, const bf16x8 (&qf)[4], const float* ngbase, int rowbase, int gidx,
                                           u16* sYl, u16* sm, float pscale = 1.f) {
  const int tid = tid_();
  const int lane = tid & 63;
  const int r31 = lane & 31, h = lane >> 5;
  const int srow = tid >> 3, sch = (tid & 7) * 8;
  f32x16 O[2];
#pragma unroll
  for (int e = 0; e < 16; ++e) { O[0][e] = 0.f; O[1][e] = 0.f; }
  float m = -1e30f, l = 0.f;
  u32x4 kr[2], vr[2];
  const unsigned koff = (unsigned)((srow * 1024 + sch) * 2);
  const unsigned voff = (unsigned)((srow * 4096 + sch) * 2);
  {
    const char* kb = (const char*)kbase + (size_t)jb0 * 131072;
    const char* vb = (const char*)vbase + (size_t)jb0 * 128;
#pragma unroll
    for (int i = 0; i < 2; ++i) {
      kr[i] = *(const u32x4*)(kb + (koff + i * 65536u));
      vr[i] = *(const u32x4*)(vb + (voff + i * 262144u));
    }
  }
  __syncthreads();
#pragma unroll
  for (int i = 0; i < 2; ++i) {
    *(u32x4*)&sm[(srow + 32 * i) * 72 + sch] = kr[i];
    *(u32x4*)&sm[4608 + (srow + 32 * i) * 72 + sch] = vr[i];
  }
  __syncthreads();
  int cur = 0;
  for (int jb = jb0; jb <= jb1; ++jb) {
    const bool more = jb < jb1;
    if (more) {
      const char* kb = (const char*)kbase + (size_t)(jb + 1) * 131072;
      const char* vb = (const char*)vbase + (size_t)(jb + 1) * 128;
#pragma unroll
      for (int i = 0; i < 2; ++i) {
        kr[i] = *(const u32x4*)(kb + (koff + i * 65536u));
        vr[i] = *(const u32x4*)(vb + (voff + i * 262144u));
      }
    }
    const u16* sK = sm + cur * 9216;
    const u16* sV = sK + 4608;
    bool blk_ok = true;
    if (MODE == 2) blk_ok = (jb < 32) ? ((mlo >> jb) & 1u) : ((mhi >> (jb - 32)) & 1u);
    const bool edge = (jb == qb) || (MODE == 3 && jb == qb - 8);
    if (edge) nsa_block<MODE, true>(sK, sV, jb, qb, q, blk_ok, qf, O, m, l, r31, h);
    else nsa_block<MODE, false>(sK, sV, jb, qb, q, blk_ok, qf, O, m, l, r31, h);
    if (more) {
      u16* dK = sm + (cur ^ 1) * 9216;
#pragma unroll
      for (int i = 0; i < 2; ++i) {
        *(u32x4*)&dK[(srow + 32 * i) * 72 + sch] = kr[i];
        *(u32x4*)&dK[4608 + (srow + 32 * i) * 72 + sch] = vr[i];
      }
    }
    __syncthreads();
    cur ^= 1;
  }
  const int tg = tid_();
  const int lg = tg & 63, hh = (lg >> 4) & 1, hg = lg >> 5;
  const float* gatep = (const float*)((const char*)ngbase + (unsigned)(rowbase + 16 * (tg >> 6) + (tg & 15)) * 192u) + gidx + hh;
  float lt = l;
  lt += shx_f(lt, lg ^ 32);
  const float sc = (lt > 0.f) ? (pscale * gatep[0] / lt) : 0.f;
  u16* yrow = sYl + (((tg >> 6) * 2 + hh) * 16 + (tg & 15)) * 64;
#pragma unroll
  for (int dt2 = 0; dt2 < 2; ++dt2)
#pragma unroll
    for (int m4 = 0; m4 < 4; ++m4) {
      u32x2* yp = (u32x2*)(yrow + 32 * dt2 + 8 * m4 + 4 * hg);
      const u32x2 yv = *yp;
      const float y0 = __uint_as_float(yv[0] << 16) + O[dt2][4 * m4 + 0] * sc;
      const float y1 = __uint_as_float(yv[0] & 0xffff0000u) + O[dt2][4 * m4 + 1] * sc;
      const float y2 = __uint_as_float(yv[1] << 16) + O[dt2][4 * m4 + 2] * sc;
      const float y3 = __uint_as_float(yv[1] & 0xffff0000u) + O[dt2][4 * m4 + 3] * sc;
      *yp = (u32x2){pack2(y0, y1), pack2(y2, y3)};
    }
}

__device__ __forceinline__ void pv_cmp(const u16* vc, int jb, const f32x4 (&p)[4], f32x4 (&o)[4], int l15, int G) {
#pragma unroll
  for (int ks2 = 0; ks2 < 2; ++ks2) {
    const f32x4 pa = p[2 * ks2], pb = p[2 * ks2 + 1];
    const bf16x8 pf = mk8(pack2(pa[0], pa[1]), pack2(pa[2], pa[3]), pack2(pb[0], pb[1]), pack2(pb[2], pb[3]));
#pragma unroll
    for (int dt = 0; dt < 4; ++dt) {
      const u16* vp = vc + (long)(16 * dt + l15) * 256 + jb * 64 + 32 * ks2 + 4 * G;
      const u32x2 v0 = *(const u32x2*)vp;
      const u32x2 v1 = *(const u32x2*)(vp + 16);
      o[dt] = MFMA(mk8(v0[0], v0[1], v1[0], v1[1]), pf, o[dt]);
    }
  }
}

__device__ __forceinline__ void nsa_unit(const Params& P, int half, int u, char* smem) {
  char* ws = P.ws;
  const int tid = tid_(), lane = tid & 63, wave = tid >> 6;
  const int l15 = lane & 15, G = lane >> 4;
  const int hp = u >> 9, rest = u & 511;
  const int bl = rest >> 8, g = (rest >> 6) & 3, xq = rest & 63;
  const int qb = hp ? xq : 63 - xq;
  const int q = 16 * wave + l15;
  const int t = qb * 64 + q;
  const int rl = bl * 4096 + t;
  const int rg = half * 8192 + rl;
  const char* NQc = (const char*)(ws + OFF_NQ);
  const unsigned qoff = (unsigned)rg * 2048u;
  u16* sm = (u16*)smem;
  float* sImp = (float*)smem;
  const u16* NQ = (const u16*)(ws + OFF_NQ);
  const u16* NQR = (const u16*)(ws + OFF_NQR);
  const u16* KV = (const u16*)(ws + OFF_KV);
  const u16* VST = (const u16*)(ws + OFF_VST);
  const u16* VWT = (const u16*)(ws + OFF_VWT);
  const u16* KCMP = (const u16*)(ws + OFF_KCMP);
  const u16* VCMPT = (const u16*)(ws + OFF_VCMPT);
  const float* NGATE = (const float*)((const char*)(ws + OFF_NGATE) + (unsigned)rg * 192u);
  u16* YB = (u16*)(ws + (half ? OFF_YB1 : OFF_YB0));

  f32x4 Y[2][4];
#pragma unroll
  for (int rr = 0; rr < 2; ++rr)
#pragma unroll
    for (int dt = 0; dt < 4; ++dt) Y[rr][dt] = (f32x4){0.f, 0.f, 0.f, 0.f};

  uint32_t mlo = 0, mhi = 0;
  u16* sYl = (u16*)(smem + 36864);
  {
    const int nblk = ((4 * qb + 2) >> 6) + 1;
    const u16* kc = KCMP + (long)(bl * 4 + g) * 256 * 64;
    const u16* vc = VCMPT + (long)(bl * 4 + g) * 64 * 256;
    float imp[4][4];
#pragma unroll
    for (int a = 0; a < 4; ++a)
#pragma unroll
      for (int b = 0; b < 4; ++b) imp[a][b] = 0.f;
    __syncthreads();
    for (int id = tid; id < nblk * 512; id += 256) {
      const int row = id >> 3, chn = (id & 7) * 8;
      *(u32x4*)&sm[row * 72 + chn] = *(const u32x4*)(kc + row * 64 + chn);
    }
    __syncthreads();
#pragma unroll 1
    for (int r = 0; r < 4; ++r) {
      bf16x8 qp[2];
#pragma unroll
      for (int ks = 0; ks < 2; ++ks) qp[ks] = *(const bf16x8*)(NQc + (qoff + (unsigned)(((4 * g + r) * 64 + ks * 32 + G * 8) * 2)));
      float m = -1e30f, l = 0.f;
#pragma unroll 1
      for (int jb = 0; jb < nblk; ++jb) {
        f32x4 s[4];
        float smax = -1e30f;
#pragma unroll
        for (int kt = 0; kt < 4; ++kt) {
          f32x4 a4 = {0.f, 0.f, 0.f, 0.f};
#pragma unroll
          for (int ks = 0; ks < 2; ++ks)
            a4 = MFMA(ld8(&sm[(jb * 64 + 16 * kt + l15) * 72 + ks * 32 + G * 8]), qp[ks], a4);
#pragma unroll
          for (int e = 0; e < 4; ++e) {
            const int n = jb * 64 + 16 * kt + 4 * G + e;
            const float sv = (16 * n + 31 <= t) ? a4[e] : -1e30f;
            s[kt][e] = sv;
            smax = fmaxf(smax, sv);
          }
        }
        smax = fmaxf(smax, SHX(smax, 16));
        smax = fmaxf(smax, SHX(smax, 32));
        const float mn = fmaxf(m, smax);
        float ls = 0.f;
#pragma unroll
        for (int kt = 0; kt < 4; ++kt)
#pragma unroll
          for (int e = 0; e < 4; ++e) ls += (s[kt][e] > -1e29f) ? EX2(s[kt][e] - mn) : 0.f;
        l = l * EX2(m - mn) + ls;
        m = mn;
      }
      l += SHX(l, 16);
      l += SHX(l, 32);
      const float invl = (l > 0.f) ? 1.f / l : 0.f;
      float prevup = 0.f;
#pragma unroll 1
      for (int jb = 0; jb < nblk; ++jb) {
        {
          f32x4 p[4];
#pragma unroll
          for (int kt = 0; kt < 4; ++kt) {
            f32x4 a4 = {0.f, 0.f, 0.f, 0.f};
#pragma unroll
            for (int ks = 0; ks < 2; ++ks)
              a4 = MFMA(ld8(&sm[(jb * 64 + 16 * kt + l15) * 72 + ks * 32 + G * 8]), qp[ks], a4);
#pragma unroll
            for (int e = 0; e < 4; ++e) {
              const int n = jb * 64 + 16 * kt + 4 * G + e;
              p[kt][e] = (16 * n + 31 <= t) ? EX2(a4[e] - m) * invl : 0.f;
            }
            const float sum4 = (p[kt][0] + p[kt][1]) + (p[kt][2] + p[kt][3]);
            const float upv = shx_f(p[kt][3], (lane + 48) & 63);
            const float add = (G > 0) ? upv : prevup;
            const float iv = sum4 + add;
#pragma unroll
            for (int j = 0; j < 4; ++j) imp[j][kt] += (jb == j) ? iv : 0.f;
            prevup = upv;
          }
          if (r == 2 * hp) pv_cmp(vc, jb, p, Y[0], l15, G);
          else if (r == 2 * hp + 1) pv_cmp(vc, jb, p, Y[1], l15, G);
        }
      }
    }
    {
      const float g0 = NGATE[0 * 16 + 4 * g + 2 * hp], g1 = NGATE[0 * 16 + 4 * g + 2 * hp + 1];
#pragma unroll
      for (int dt = 0; dt < 4; ++dt) {
        *(u32x2*)(sYl + ((wave * 2 + 0) * 16 + l15) * 64 + 16 * dt + 4 * G) = (u32x2){pack2(Y[0][dt][0] * g0, Y[0][dt][1] * g0), pack2(Y[0][dt][2] * g0, Y[0][dt][3] * g0)};
        *(u32x2*)(sYl + ((wave * 2 + 1) * 16 + l15) * 64 + 16 * dt + 4 * G) = (u32x2){pack2(Y[1][dt][0] * g1, Y[1][dt][1] * g1), pack2(Y[1][dt][2] * g1, Y[1][dt][3] * g1)};
      }
    }
    __syncthreads();
    float* myImp = sImp + wave * 16 * 65;
#pragma unroll
    for (int jb = 0; jb < 4; ++jb)
#pragma unroll
      for (int kt = 0; kt < 4; ++kt) myImp[l15 * 65 + 16 * jb + 4 * kt + G] = imp[jb][kt];
    __syncthreads();
    const int cur = qb;
    uint32_t blo = 0, bhi = 0;
    if (cur + 1 <= 16) {
#pragma unroll
      for (int jb = 0; jb < 4; ++jb)
#pragma unroll
        for (int kt = 0; kt < 4; ++kt) {
          const int s = 16 * jb + 4 * kt + G;
          if (s <= cur) blo |= (1u << s);
        }
    } else {
      int cnt[4][4];
#pragma unroll
      for (int a = 0; a < 4; ++a)
#pragma unroll
        for (int b = 0; b < 4; ++b) cnt[a][b] = 0;
      for (int sp = 1; sp <= cur - 2; ++sp) {
        const float xv = myImp[l15 * 65 + sp];
#pragma unroll
        for (int jb = 0; jb < 4; ++jb)
#pragma unroll
          for (int kt = 0; kt < 4; ++kt) {
            const int s = 16 * jb + 4 * kt + G;
            const float v = imp[jb][kt];
            cnt[jb][kt] += ((xv > v) || (xv == v && sp < s)) ? 1 : 0;
          }
      }
#pragma unroll
      for (int jb = 0; jb < 4; ++jb)
#pragma unroll
        for (int kt = 0; kt < 4; ++kt) {
          const int s = 16 * jb + 4 * kt + G;
          const bool sel = (s == 0) || (s == cur) || (s == cur - 1) || (s >= 1 && s <= cur - 2 && cnt[jb][kt] < 13);
          if (sel) { if (s < 32) blo |= (1u << s); else bhi |= (1u << (s - 32)); }
        }
    }
    blo |= SHXU(blo, 16); blo |= SHXU(blo, 32);
    bhi |= SHXU(bhi, 16); bhi |= SHXU(bhi, 32);
    mlo = blo; mhi = bhi;
  }
  {
    const int hh = (lane >> 4) & 1, h5 = lane >> 5;
    const int head = 4 * g + 2 * hp + hh;
    bf16x8 qf[4];
    qf[0] = *(const bf16x8*)((const char*)NQR + ((unsigned)rl * 512u + (unsigned)((head * 16 + 8 * h5) * 2)));
#pragma unroll
    for (int ks = 1; ks < 4; ++ks) qf[ks] = *(const bf16x8*)(NQc + (qoff + (unsigned)((head * 64 + 16 * ks + 8 * h5) * 2)));
    const int head0 = 4 * g + 2 * hp;
    const u16* kbs = KV + (long)bl * 4096 * 1024 + 512 + g * 64;
    const u16* vbs = VST + (long)(bl * 4 + g) * 64 * 4096;
    nsa_branch<2>(kbs, vbs, 0, qb, qb, q, mlo, mhi, qf, (const float*)(ws + OFF_NGATE), half * 8192 + bl * 4096 + qb * 64, 16 + head0, sYl, sm);
    const u16* kbw = KV + (long)bl * 4096 * 1024 + 768 + g * 64;
    const u16* vbw = VWT + (long)(bl * 4 + g) * 64 * 4096;
    const int jw0 = (qb >= 8) ? qb - 8 : 0;
    nsa_branch<3>(kbw, vbw, jw0, qb, qb, q, mlo, mhi, qf, (const float*)(ws + OFF_NGATE), half * 8192 + bl * 4096 + qb * 64, 32 + head0, sYl, sm);
    const int tid2 = tid_();
    const int l2 = tid2 & 63, hh2 = (l2 >> 4) & 1, hg2 = l2 >> 5;
    const unsigned yoff = (unsigned)(bl * 4096 + qb * 64 + 16 * (tid2 >> 6) + (tid2 & 15)) * 2048u;
    const u16* yrow = sYl + (((tid2 >> 6) * 2 + hh2) * 16 + (tid2 & 15)) * 64;
#pragma unroll
    for (int dt2 = 0; dt2 < 2; ++dt2)
#pragma unroll
      for (int m4 = 0; m4 < 4; ++m4) {
        const int d0 = 32 * dt2 + 8 * m4 + 4 * hg2;
        *(u32x2*)((char*)YB + (yoff + (unsigned)(((head0 + hh2) * 64 + d0) * 2))) = *(const u32x2*)(yrow + d0);
      }
  }
}

__device__ __forceinline__ void gemm_tile_wide(const u16* __restrict__ A, long lda, int m0, const u16* __restrict__ Bt, long ldb, int n0, int K,
                                               f32x4 (&acc)[4][8], u16* sA) {
  const int tid = tid_(), lane = tid & 63, wave = tid >> 6;
  const int l15 = lane & 15, G = lane >> 4;
  const int wm = wave >> 1, wn = wave & 1;
  const int lr = tid >> 3, ch = tid & 7;
  u16* sB = sA + 128 * 80;
  const char* Ab = (const char*)A;
  const char* Bb = (const char*)Bt;
  unsigned oa[4], ob[8];
#pragma unroll
  for (int i = 0; i < 4; ++i) oa[i] = (unsigned)(((long)(m0 + lr + 32 * i) * lda + ch * 8) * 2);
#pragma unroll
  for (int i = 0; i < 8; ++i) ob[i] = (unsigned)(((long)(n0 + lr + 32 * i) * ldb + ch * 8) * 2);
  u32x4 ra[4], rb[8];
#pragma unroll
  for (int i = 0; i < 4; ++i) ra[i] = *(const u32x4*)(Ab + oa[i]);
#pragma unroll
  for (int i = 0; i < 8; ++i) rb[i] = *(const u32x4*)(Bb + ob[i]);
  const int nk = K >> 6;
  for (int kt = 0; kt < nk; ++kt) {
#pragma unroll
    for (int i = 0; i < 4; ++i) *(u32x4*)&sA[(lr + 32 * i) * 80 + ch * 8] = ra[i];
#pragma unroll
    for (int i = 0; i < 8; ++i) *(u32x4*)&sB[(lr + 32 * i) * 80 + ch * 8] = rb[i];
    __syncthreads();
    {
      const int kn = (kt + 1 < nk) ? kt + 1 : kt;
      const char* Ak = Ab + (size_t)kn * 128;
      const char* Bk = Bb + (size_t)kn * 128;
#pragma unroll
      for (int i = 0; i < 4; ++i) ra[i] = *(const u32x4*)(Ak + oa[i]);
#pragma unroll
      for (int i = 0; i < 8; ++i) rb[i] = *(const u32x4*)(Bk + ob[i]);
    }
#pragma unroll
    for (int ks = 0; ks < 2; ++ks) {
      bf16x8 af[4];
#pragma unroll
      for (int i = 0; i < 4; ++i) af[i] = ld8(&sA[(wm * 64 + 16 * i + l15) * 80 + ks * 32 + G * 8]);
#pragma unroll
      for (int jh = 0; jh < 2; ++jh) {
        bf16x8 bfr[4];
#pragma unroll
        for (int j = 0; j < 4; ++j) bfr[j] = ld8(&sB[(wn * 128 + 64 * jh + 16 * j + l15) * 80 + ks * 32 + G * 8]);
#pragma unroll
        for (int i = 0; i < 4; ++i)
#pragma unroll
          for (int j = 0; j < 4; ++j) acc[i][4 * jh + j] = MFMA(af[i], bfr[j], acc[i][4 * jh + j]);
      }
    }
    __syncthreads();
  }
}


__device__ __forceinline__ void phase_branch_merge(const Params& P, char* smem) {
  char* ws = P.ws;
  u16* sA = (u16*)smem;
  const u16* YA = (const u16*)(ws + OFF_SG);
  const u16* GATES = (const u16*)P.out;
  u16* MERGED = (u16*)(ws + OFF_MERGED);
  for (int t = bid_(); t < 512; t += gridDim.x) {
    const int nt = t >> 7, mt = t & 127;
    const int m0 = mt * 128, n0 = nt * 256;
    const u16* YBp = (m0 < 8192) ? (const u16*)(ws + OFF_YB0) : ((const u16*)(ws + OFF_YB1) - (long)8192 * 1024);
    f32x4 acc[4][8];
#pragma unroll
    for (int i = 0; i < 4; ++i)
#pragma unroll
      for (int j = 0; j < 8; ++j) acc[i][j] = (f32x4){0.f, 0.f, 0.f, 0.f};
    gemm_tile_wide(YA, 1024, m0, (const u16*)(ws + OFF_WA_T), 1024, n0, 1024, acc, sA);
    {
      EPI_VARS
#pragma unroll
      for (int i = 0; i < 4; ++i)
#pragma unroll
        for (int j = 0; j < 8; ++j) {
          const int col = n0 + wn * 128 + 16 * j + l15;
#pragma unroll
          for (int e = 0; e < 4; ++e) {
            const unsigned go = ((unsigned)(m0 + wm * 64 + 16 * i + G * 4 + e) * 2048u + (unsigned)col) * 2u;
            acc[i][j][e] *= bf2f(*(const u16*)((const char*)GATES + go)) * __builtin_amdgcn_rcpf(bf2f(*(const u16*)((const char*)GATES + (go + 2048u))));
          }
        }
    }
    gemm_tile_wide(YBp, 1024, m0, (const u16*)(ws + OFF_WB_T), 1024, n0, 1024, acc, sA);
    {
      EPI_VARS
#pragma unroll
      for (int i = 0; i < 4; ++i)
#pragma unroll
        for (int j = 0; j < 8; ++j) {
          const int col = n0 + wn * 128 + 16 * j + l15;
#pragma unroll
          for (int e = 0; e < 4; ++e) {
            const unsigned ro = (unsigned)(m0 + wm * 64 + 16 * i + G * 4 + e);
            const unsigned go = (ro * 2048u + (unsigned)col) * 2u + 2048u;
            sA[(wm * 64 + 16 * i + G * 4 + e) * 264 + (col - n0)] = f2bf(acc[i][j][e] * bf2f(*(const u16*)((const char*)GATES + go)));
          }
        }
    }
    __syncthreads();
    {
      const int tc = tid_();
#pragma unroll 4
      for (int k16 = 0; k16 < 16; ++k16) {
        const int id = tc + 256 * k16;
        const int row = id >> 5, cch = (id & 31) * 8;
        *(u32x4*)(MERGED + (long)(m0 + row) * 1024 + n0 + cch) = *(const u32x4*)&sA[row * 264 + cch];
      }
    }
    __syncthreads();
  }
}

template <int EPI>
__device__ __forceinline__ void phase_gemm(const u16* A, int K, const u16* Wt, int N, void* outp, char* smem) {
  u16* sA = (u16*)smem;
  u16* sB = sA + 128 * 80;
  EPI_VARS
  const int ntn = N >> 7;
  for (int t = bid_(); t < 128 * ntn; t += gridDim.x) {
    const int nt = t >> 7, mt = t & 127;
    const int m0 = mt * 128, n0 = nt * 128;
    f32x4 acc[4][4];
    zero_acc(acc);
    gemm_tile<0, 2>(A, K, m0, 16384, Wt, K, n0, N, K, 0, acc, sA, sB);
#pragma unroll
    for (int i = 0; i < 4; ++i)
#pragma unroll
      for (int j = 0; j < 4; ++j) {
        const int col = n0 + wn * 64 + 16 * j + l15;
#pragma unroll
        for (int e = 0; e < 4; ++e) {
          const long row = m0 + wm * 64 + 16 * i + G * 4 + e;
          const float v = acc[i][j][e];
          if (EPI == 0) ((float*)outp)[row * N + col] = v;
          else if (EPI == 2) ((u16*)outp)[row * N + col] = f2bf(v);
          else { const float rl = fmaxf(v, 0.f); ((u16*)outp)[row * N + col] = f2bf(rl * rl); }
        }
      }
  }
}


template <int EPI>
__device__ __forceinline__ void phase_gemm_wide(const u16* A, int K, const u16* Wt, int N, u16* outp, char* smem) {
  u16* sA = (u16*)smem;
  EPI_VARS
  const int ntn = N >> 8;
  for (int t = bid_(); t < 128 * ntn; t += gridDim.x) {
    const int nt = t >> 7, mt = t & 127;
    const int m0 = mt * 128, n0 = nt * 256;
    f32x4 acc[4][8];
#pragma unroll
    for (int i = 0; i < 4; ++i)
#pragma unroll
      for (int j = 0; j < 8; ++j) acc[i][j] = (f32x4){0.f, 0.f, 0.f, 0.f};
    gemm_tile_wide(A, K, m0, Wt, K, n0, K, acc, sA);
#pragma unroll
    for (int i = 0; i < 4; ++i)
#pragma unroll
      for (int j = 0; j < 8; ++j) {
        const int col = n0 + wn * 128 + 16 * j + l15;
#pragma unroll
        for (int e = 0; e < 4; ++e) {
          float v = acc[i][j][e];
          if (EPI == 1) { v = fmaxf(v, 0.f); v = v * v; }
          sA[(wm * 64 + 16 * i + G * 4 + e) * 264 + (col - n0)] = f2bf(v);
        }
      }
    __syncthreads();
    {
      const int tc = tid_();
#pragma unroll 4
      for (int k16 = 0; k16 < 16; ++k16) {
        const int id = tc + 256 * k16;
        const int row = id >> 5, cch = (id & 31) * 8;
        *(u32x4*)(outp + (long)(m0 + row) * N + n0 + cch) = *(const u32x4*)&sA[row * 264 + cch];
      }
    }
    __syncthreads();
  }
}

__device__ __forceinline__ void phase_ple(const Params& P, char* smem) {
  char* ws = P.ws;
  u16* sA = (u16*)smem;
  float* Z3 = (float*)(ws + OFF_Z3);
  for (int t = bid_(); t < 512; t += gridDim.x) {
    const int nt = t >> 7, mt = t & 127;
    const int m0 = mt * 128, n0 = nt * 256;
    f32x4 acc[4][8];
#pragma unroll
    for (int i = 0; i < 4; ++i)
#pragma unroll
      for (int j = 0; j < 8; ++j) acc[i][j] = (f32x4){0.f, 0.f, 0.f, 0.f};
    gemm_tile_wide((const u16*)(ws + OFF_PB), 256, m0, (const u16*)(ws + OFF_WPLE_T), 256, n0, 256, acc, sA);
    {
      EPI_VARS
#pragma unroll
      for (int i = 0; i < 4; ++i)
#pragma unroll
        for (int j = 0; j < 8; ++j) {
          const int col = n0 + wn * 128 + 16 * j + l15;
#pragma unroll
          for (int e = 0; e < 4; ++e) {
            const unsigned zo = ((unsigned)(m0 + wm * 64 + 16 * i + G * 4 + e) * 1024u + (unsigned)col) * 4u;
            *(float*)((char*)Z3 + zo) = acc[i][j][e];
            acc[i][j][e] = 0.f;
          }
        }
    }
    gemm_tile_wide((const u16*)(ws + OFF_H2B), 1024, m0, (const u16*)(ws + OFF_WPG_T), 1024, n0, 1024, acc, sA);
    {
      EPI_VARS
#pragma unroll
      for (int i = 0; i < 4; ++i)
#pragma unroll
        for (int j = 0; j < 8; ++j) {
          const int col = n0 + wn * 128 + 16 * j + l15;
#pragma unroll
          for (int e = 0; e < 4; ++e) {
            const unsigned zo = ((unsigned)(m0 + wm * 64 + 16 * i + G * 4 + e) * 1024u + (unsigned)col) * 4u;
            float* zp = (float*)((char*)Z3 + zo);
            *zp = *zp * sigm(acc[i][j][e]);
          }
        }
    }
  }
}

template <int MODE, int ZB>
__device__ __forceinline__ void phase_rownorm(const Params& P, const void* Zv, const float* w, const float* w2, u16* nxt) {
  const int tid = tid_(), lane = tid & 63, wave = tid >> 6;
  float* H = P.out;
  for (int un = bid_(); un < 4096; un += gridDim.x) {
    const long row = (long)un * 4 + wave;
    const float* zr = (const float*)Zv + row * 1024;
    const u16* zh = (const u16*)Zv + row * 1024;
    (void)zr; (void)zh;
    const float* hin = (MODE == 0) ? (P.x + row * 1024) : (H + row * 1024);
    float4 z[4], hv[4];
    float ss = 0.f;
#pragma unroll
    for (int j = 0; j < 4; ++j) {
      if (ZB) {
        const u32x2 zz = *(const u32x2*)(zh + j * 256 + lane * 4);
        z[j] = make_float4(__uint_as_float(zz[0] << 16), __uint_as_float(zz[0] & 0xffff0000u), __uint_as_float(zz[1] << 16), __uint_as_float(zz[1] & 0xffff0000u));
      } else z[j] = *(const float4*)(zr + j * 256 + lane * 4);
      hv[j] = *(const float4*)(hin + j * 256 + lane * 4);
      ss += z[j].x * z[j].x + z[j].y * z[j].y + z[j].z * z[j].z + z[j].w * z[j].w;
    }
#pragma unroll
    for (int o = 32; o >= 1; o >>= 1) ss += SHX(ss, o);
    const float r = rsqrtf(ss * (1.f / 1024.f) + 1e-6f);
    float s2 = 0.f;
#pragma unroll
    for (int j = 0; j < 4; ++j) {
      const float4 wv = *(const float4*)(w + j * 256 + lane * 4);
      hv[j].x += z[j].x * r * wv.x; hv[j].y += z[j].y * r * wv.y;
      hv[j].z += z[j].z * r * wv.z; hv[j].w += z[j].w * r * wv.w;
      s2 += hv[j].x * hv[j].x + hv[j].y * hv[j].y + hv[j].z * hv[j].z + hv[j].w * hv[j].w;
      *(float4*)(H + row * 1024 + j * 256 + lane * 4) = hv[j];
    }
    if (MODE == 0) {
#pragma unroll
      for (int o = 32; o >= 1; o >>= 1) s2 += SHX(s2, o);
      const float r2 = rsqrtf(s2 * (1.f / 1024.f) + 1e-6f);
#pragma unroll
      for (int j = 0; j < 4; ++j) {
        const float4 wv = *(const float4*)(w2 + j * 256 + lane * 4);
        u32x2 o2 = {pack2(hv[j].x * r2 * wv.x, hv[j].y * r2 * wv.y), pack2(hv[j].z * r2 * wv.z, hv[j].w * r2 * wv.w)};
        *(u32x2*)(nxt + row * 1024 + j * 256 + lane * 4) = o2;
      }
    } else if (MODE == 1) {
#pragma unroll
      for (int j = 0; j < 4; ++j) {
        u32x2 o2 = {pack2(hv[j].x, hv[j].y), pack2(hv[j].z, hv[j].w)};
        *(u32x2*)(nxt + row * 1024 + j * 256 + lane * 4) = o2;
      }
      const float4 pv = *(const float4*)(P.p + row * 256 + lane * 4);
      u32x2 o2 = {pack2(pv.x, pv.y), pack2(pv.z, pv.w)};
      *(u32x2*)((u16*)(P.ws + OFF_PB) + row * 256 + lane * 4) = o2;
    }
  }
}

#define XB_TMO      128
#define XB_XCNT(j)  (256  + 64 * (j))
#define XB_XSUB(j)  (1280 + 64 * (j))
#define XB_XGEN(j)  (2304 + 64 * (j))
#define XB_TOP      3328
#define XB_TOPGEN   3392
#define XCD_BAR_WORDS 3456
#define XB_SPIN_CAP (1u << 18)
#define LAS __attribute__((address_space(3)))

__device__ __forceinline__ unsigned xb_ld(unsigned* p)              { return __hip_atomic_load(p, __ATOMIC_RELAXED, __HIP_MEMORY_SCOPE_AGENT); }
__device__ __forceinline__ unsigned xb_add(unsigned* p, unsigned v) { return __hip_atomic_fetch_add(p, v, __ATOMIC_RELAXED, __HIP_MEMORY_SCOPE_AGENT); }
__device__ __forceinline__ unsigned xb_xcc_id() { return (unsigned)__builtin_amdgcn_s_getreg((3 << 11) | 20) & 0xFu; }
#define XB_SPIN(cond, bar) do { unsigned _sp = 0; while (cond) { __builtin_amdgcn_s_sleep(1); \
    if ((++_sp & 255u) == 0u) { if (xb_ld(&(bar)[XB_TMO])) break; if (_sp > XB_SPIN_CAP) { atomicAdd(&(bar)[XB_TMO], 1u); break; } } } } while (0)

struct XcdBarrier {
    unsigned* bar; unsigned x;
    volatile LAS unsigned* st;
};

__device__ __forceinline__ XcdBarrier xcd_barrier_post(unsigned* bar, volatile LAS unsigned* st) {
    XcdBarrier b; b.bar = bar; b.x = xb_xcc_id(); b.st = st;
    if (tid_() == 0) (void)xb_add(&bar[XB_XCNT(b.x)], 1u);
    return b;
}
__device__ __forceinline__ void xcd_barrier_complete(unsigned* bar, unsigned x, unsigned& nloc, unsigned& nx) {
    const unsigned G = gridDim.x * gridDim.y * gridDim.z;
    unsigned sum, cnt, mine, sp = 0u;
    for (;;) {
        sum = 0u; cnt = 0u; mine = 0u;
#pragma unroll
        for (unsigned j = 0; j < 16; ++j) { const unsigned c = xb_ld(&bar[XB_XCNT(j)]); sum += c; cnt += (c > 0u) ? 1u : 0u; mine = (j == x) ? c : mine; }
        if (sum == G) break;
        __builtin_amdgcn_s_sleep(1);
        if ((++sp & 255u) == 0u) { if (xb_ld(&bar[XB_TMO])) break; if (sp > XB_SPIN_CAP) { atomicAdd(&bar[XB_TMO], 1u); break; } }
    }
    nloc = mine > 0u ? mine : 1u; nx = cnt > 0u ? cnt : 1u;
}

__device__ __forceinline__ void xcd_barrier(const XcdBarrier& b) {
    asm volatile("s_waitcnt vmcnt(0)" ::: "memory");
    __syncthreads();
    if (tid_() == 0) {
        unsigned* bar = b.bar;
        __builtin_amdgcn_s_waitcnt(0);
        unsigned nloc = b.st[0], nx = b.st[1];
        if (nloc == 0u) { xcd_barrier_complete(bar, b.x, nloc, nx); b.st[0] = nloc; b.st[1] = nx; }
        const unsigned old = xb_add(&bar[XB_XSUB(b.x)], 1u);
        const unsigned gen = old / nloc;
        if (old + 1u == (gen + 1u) * nloc) {
            __builtin_amdgcn_fence(__ATOMIC_RELEASE, "agent");
            asm volatile("s_waitcnt vmcnt(0)" ::: "memory");
            const unsigned og = xb_add(&bar[XB_TOP], 1u);
            const unsigned tg = og / nx;
            if (og + 1u == (tg + 1u) * nx) xb_add(&bar[XB_TOPGEN], 1u);
            else XB_SPIN(xb_ld(&bar[XB_TOPGEN]) == tg, bar);
            __builtin_amdgcn_fence(__ATOMIC_ACQUIRE, "agent");
            xb_add(&bar[XB_XGEN(b.x)], 1u);
            asm volatile("s_waitcnt vmcnt(0)" ::: "memory");
        } else {
            XB_SPIN(xb_ld(&bar[XB_XGEN(b.x)]) == gen, bar);
            __builtin_amdgcn_fence(__ATOMIC_ACQUIRE, "agent");
            asm volatile("s_waitcnt vmcnt(0)" ::: "memory");
        }
    }
    __syncthreads();
}

#define OFF_BAR (252 * MIB)
#define GSYNC() do { XcdBarrier xb_; xb_.bar = (unsigned*)(P.ws + OFF_BAR); xb_.x = xb_xcc_id(); xb_.st = (volatile LAS unsigned*)&xb_words; xcd_barrier(xb_); } while (0)
__global__ void __launch_bounds__(256, 2) k_mega(Params P) {
  __shared__ __attribute__((aligned(16))) char smem[67584];
  char* ws = P.ws;
  __shared__ uint4 xb_words;
  if (tid_() == 0) xb_words = make_uint4(0u, 0u, 0u, 0u);
  __syncthreads();
  (void)xcd_barrier_post((unsigned*)(ws + OFF_BAR), (volatile LAS unsigned*)&xb_words);
  phase_prep(P, smem);
  GSYNC();
#pragma unroll 1
  for (int half = 0; half < 2; ++half) {
    phase_inproj(P, half, smem);
    GSYNC();
#if PROBE_DUP == 1
    phase_inproj(P, half, smem);
    GSYNC();
#endif
    if ((int)gridDim.x > 128) {
      const int b2 = bid_();
      if (b2 < 64) cmp_gemm1_tile(P, b2, smem);
      else for (int u = b2 - 64; u < 1024; u += (int)gridDim.x - 64) hgrn_intra_unit(P, u, smem);
    } else {
      for (int t = bid_(); t < 64; t += gridDim.x) cmp_gemm1_tile(P, t, smem);
      for (int u = bid_(); u < 1024; u += gridDim.x) hgrn_intra_unit(P, u, smem);
    }
    GSYNC();
    for (int t = bid_(); t < 32; t += gridDim.x) cmp_gemm2_tile(P, t, smem);
    hgrn_scan(P);
    if (half == 1) phase_late_weights(P, smem);
    GSYNC();
#if PROBE_DUP == 2
    for (int u = bid_(); u < 1024; u += gridDim.x) nsa_unit(P, half, u, smem);
    GSYNC();
#endif
    for (int u = bid_(); u < 1024; u += gridDim.x) nsa_unit(P, half, u, smem);
    for (int u = bid_(); u < 1024; u += gridDim.x) hgrn_out_unit(P, half, u, smem);
    GSYNC();
  }
  phase_branch_merge(P, smem);
  GSYNC();
#if PROBE_DUP == 3
  phase_branch_merge(P, smem);
  GSYNC();
  phase_gemm<2>((const u16*)(ws + OFF_MERGED), 1024, (const u16*)(ws + OFF_WOUT_T), 1024, ws + OFF_Z1, smem);
  GSYNC();
#endif
  phase_gemm_wide<2>((const u16*)(ws + OFF_MERGED), 1024, (const u16*)(ws + OFF_WOUT_T), 1024, (u16*)(ws + OFF_Z1), smem);
  GSYNC();
  phase_rownorm<0, 1>(P, (const void*)(ws + OFF_Z1), P.n_post_mix, P.n_pre_mlp, (u16*)(ws + OFF_V));
  GSYNC();
#if PROBE_DUP == 4
  phase_gemm<1>((const u16*)(ws + OFF_V), 1024, (const u16*)(ws + OFF_WUP_T), 4096, ws + OFF_FFH, smem);
  GSYNC();
#endif
  phase_gemm_wide<1>((const u16*)(ws + OFF_V), 1024, (const u16*)(ws + OFF_WUP_T), 4096, (u16*)(ws + OFF_FFH), smem);
  GSYNC();
#if PROBE_DUP == 4
  phase_gemm<2>((const u16*)(ws + OFF_FFH), 4096, (const u16*)(ws + OFF_WDOWN_T), 1024, ws + OFF_Z2, smem);
  GSYNC();
#endif
  phase_gemm_wide<2>((const u16*)(ws + OFF_FFH), 4096, (const u16*)(ws + OFF_WDOWN_T), 1024, (u16*)(ws + OFF_Z2), smem);
  GSYNC();
  phase_rownorm<1, 1>(P, (const void*)(ws + OFF_Z2), P.n_post_mlp, nullptr, (u16*)(ws + OFF_H2B));
  GSYNC();
  phase_ple(P, smem);
  GSYNC();
#if PROBE_DUP == 5
  for (int i = 0; i < 10; ++i) GSYNC();
#endif
#if PROBE_DUP == 6
  phase_prep(P, smem);
  GSYNC();
#endif
  phase_rownorm<2, 0>(P, (const void*)(P.ws + OFF_Z3), P.n_ple, nullptr, nullptr);
}

extern "C" void kernel_launch(void* const* d_in, const int* in_sizes, int n_in, void* d_out, int out_size, void* d_ws,
                              size_t ws_size, hipStream_t stream) {
  Params P{};
  P.x = (const float*)d_in[0];
  P.p = (const float*)d_in[1];
  P.w_in = (const float*)d_in[2];
  P.w_a = (const float*)d_in[3];
  P.w_b = (const float*)d_in[4];
  P.w_out = (const float*)d_in[5];
  P.n_pre_mix = (const float*)d_in[6];
  P.n_post_mix = (const float*)d_in[7];
  P.n_pre_mlp = (const float*)d_in[8];
  P.n_post_mlp = (const float*)d_in[9];
  P.lb_logits = (const float*)d_in[10];
  P.gnorm = (const float*)d_in[11];
  P.pe_k = (const float*)d_in[12];
  P.pe_v = (const float*)d_in[13];
  P.wk1 = (const float*)d_in[14];
  P.wk2 = (const float*)d_in[15];
  P.wv1 = (const float*)d_in[16];
  P.wv2 = (const float*)d_in[17];
  P.w_up = (const float*)d_in[18];
  P.w_down = (const float*)d_in[19];
  P.w_ple = (const float*)d_in[20];
  P.w_pg = (const float*)d_in[21];
  P.n_ple = (const float*)d_in[22];
  P.out = (float*)d_out;
  P.ws = (char*)d_ws;
#if MEGA
  static int grid_blocks = 0;
  if (!grid_blocks) {
    int dev = 0, cus = 0, per_cu = 0;
    hipGetDevice(&dev);
    hipDeviceGetAttribute(&cus, hipDeviceAttributeMultiprocessorCount, dev);
    hipOccupancyMaxActiveBlocksPerMultiprocessor(&per_cu, k_mega, 256, 0);
    if (per_cu > 2) per_cu = 2;
    if (per_cu < 1) per_cu = 1;
    grid_blocks = cus * per_cu;
  }
  hipMemsetAsync((char*)d_ws + OFF_BAR, 0, XCD_BAR_WORDS * sizeof(unsigned), stream);
  void* args[] = {&P};
  hipError_t e = hipLaunchCooperativeKernel((void*)k_mega, dim3(grid_blocks), dim3(256), args, 0, stream);
  if (e != hipSuccess) fprintf(stderr, "cooperative launch failed: %s (grid %d)\n", hipGetErrorString(e), grid_blocks);
#endif
}
```

```cpp
#include <hip/hip_runtime.h>
#include <hip/hip_cooperative_groups.h>
#include <cstdio>
#include <cstdint>
namespace cg = cooperative_groups;

#ifndef MEGA
#define MEGA 1
#endif
#ifndef PROBE_DUP
#define PROBE_DUP 0
#endif

typedef unsigned short u16;
typedef __attribute__((ext_vector_type(8))) short bf16x8;
typedef __attribute__((ext_vector_type(4))) float f32x4;
typedef __attribute__((ext_vector_type(4))) unsigned u32x4;
typedef __attribute__((ext_vector_type(2))) unsigned u32x2;

#define MFMA(a, b, c) __builtin_amdgcn_mfma_f32_16x16x32_bf16(a, b, c, 0, 0, 0)
#define MIB ((size_t)1 << 20)

#define OFF_U       (0 * MIB)
#define OFF_YB0     (0 * MIB)
#define OFF_WA_T    (16 * MIB)
#define OFF_WB_T    (18 * MIB)
#define OFF_WOUT_T  (20 * MIB)
#define OFF_WPG_T   (22 * MIB)
#define OFF_WPLE_T  (24 * MIB)
#define OFF_WIN_T   (32 * MIB)
#define OFF_WUP_T   (32 * MIB)
#define OFF_WDOWN_T (40 * MIB)
#define OFF_WK1T    (50 * MIB)
#define OFF_WV1T    (51 * MIB)
#define OFF_WK2T    (52 * MIB)
#define OFF_WV2T    (52 * MIB + 32768)
#define OFF_ROPE    (52 * MIB + 65536)
#define OFF_BIAS1   (52 * MIB + 65536 + 262144)
#define OFF_LB      (52 * MIB + 65536 + 262144 + 4096)
#define OFF_BIAS1P  (52 * MIB + 65536 + 262144 + 16384)
#define OFF_NGATE   (53 * MIB)
#define OFF_SG      (56 * MIB)
#define OFF_NQ      (88 * MIB)
#define OFF_QF      (120 * MIB)
#define OFF_LOGF    (136 * MIB)
#define OFF_YB1     (136 * MIB)
#define OFF_HVT     (152 * MIB)
#define OFF_ABUF    (168 * MIB)
#define OFF_UST     (176 * MIB)
#define OFF_KV      (208 * MIB)
#define OFF_NQR     (224 * MIB)
#define OFF_VST     (228 * MIB)
#define OFF_VWT     (232 * MIB)
#define OFF_DCY     (236 * MIB)
#define OFF_HIDK    (236 * MIB + 524288)
#define OFF_HIDV    (237 * MIB + 524288)
#define OFF_KCMP    (238 * MIB + 524288)
#define OFF_VCMPT   (238 * MIB + 524288 + 262144)
#define OFF_MERGED  (88 * MIB)
#define OFF_Z1      (152 * MIB)
#define OFF_V       (56 * MIB)
#define OFF_FFH     (120 * MIB)
#define OFF_Z2      (56 * MIB)
#define OFF_H2B     (120 * MIB)
#define OFF_PB      (152 * MIB)
#define OFF_Z3      (160 * MIB)

struct Params {
  const float *x, *p, *w_in, *w_a, *w_b, *w_out, *n_pre_mix, *n_post_mix, *n_pre_mlp, *n_post_mlp;
  const float *lb_logits, *gnorm, *pe_k, *pe_v, *wk1, *wk2, *wv1, *wv2, *w_up, *w_down, *w_ple, *w_pg, *n_ple;
  float* out;
  char* ws;
};

__device__ __forceinline__ int bid_() { int b = blockIdx.x; asm volatile("" : "+s"(b)); return b; }
__device__ __forceinline__ int tid_() { int t = threadIdx.x; asm volatile("" : "+v"(t)); return t; }
typedef __attribute__((ext_vector_type(2))) float f32x2_t;
typedef __attribute__((ext_vector_type(2))) __bf16 bf16x2_t;
__device__ __forceinline__ uint32_t pack2(float a, float b) {
  f32x2_t v = {a, b};
  return __builtin_bit_cast(uint32_t, __builtin_convertvector(v, bf16x2_t));
}
__device__ __forceinline__ u16 f2bf(float f) { return (u16)(pack2(f, f) & 0xffffu); }
__device__ __forceinline__ float bf2f(u16 h) { return __uint_as_float(((uint32_t)h) << 16); }
__device__ __forceinline__ float shx_f(float v, int src_lane) { return __int_as_float(__builtin_amdgcn_ds_bpermute(src_lane << 2, __float_as_int(v))); }
__device__ __forceinline__ uint32_t shx_u(uint32_t v, int src_lane) { return (uint32_t)__builtin_amdgcn_ds_bpermute(src_lane << 2, (int)v); }
#define SHX(v, m) shx_f((v), lane ^ (m))
#define SHXU(v, m) shx_u((v), lane ^ (m))
__device__ __forceinline__ float sigm(float x) { return __builtin_amdgcn_rcpf(1.f + __expf(-x)); }
__device__ __forceinline__ float siluf(float x) { return x * __builtin_amdgcn_rcpf(1.f + __expf(-x)); }
__device__ __forceinline__ float gelu_tanh(float x) {
  float u = 0.7978845608028654f * (x + 0.044715f * x * x * x);
  float t = 1.f - 2.f * __builtin_amdgcn_rcpf(__expf(2.f * u) + 1.f);
  return 0.5f * x * (1.f + t);
}
__device__ __forceinline__ bf16x8 mk8(uint32_t a, uint32_t b, uint32_t c, uint32_t d) {
  u32x4 v = {a, b, c, d};
  return __builtin_bit_cast(bf16x8, v);
}
__device__ __forceinline__ bf16x8 ld8(const u16* p) { return *(const bf16x8*)p; }

template <int AMODE, int DEEP>
__device__ __forceinline__ void gemm_tile(const u16* __restrict__ A, long lda, int m0, int M,
                                          const u16* __restrict__ Bt, long ldb, int n0, int N, int K,
                                          int coloff, f32x4 (&acc)[4][4], u16* sA, u16* sB) {
  const int tid = tid_(), lane = tid & 63, wave = tid >> 6;
  const int l15 = lane & 15, G = lane >> 4;
  const int wm = wave >> 1, wn = wave & 1;
  const int lr = tid >> 3, ch = tid & 7;
  const char* Ab = (const char*)A;
  const char* Bb = (const char*)Bt;
  unsigned oa[4], ob[4];
  int tok0[4];
#pragma unroll
  for (int i = 0; i < 4; ++i) {
    int r = m0 + lr + 32 * i;
    if (AMODE == 0) {
      if (r > M - 1) r = M - 1;
      oa[i] = (unsigned)(((long)r * lda + ch * 8) * 2);
      tok0[i] = 0;
    } else {
      int grp = r >> 8, n = r & 255;
      int bl = grp >> 2, g = grp & 3;
      tok0[i] = n * 16;
      oa[i] = (unsigned)((bl * 4096 * 1024 + coloff + g * 64 + ch * 8) * 2);
    }
    int rn = n0 + lr + 32 * i;
    if (rn > N - 1) rn = N - 1;
    ob[i] = (unsigned)(((long)rn * ldb + ch * 8) * 2);
  }
#define G_LOAD(RA, RB, KT)                                                                                   \
  {                                                                                                          \
    const char* Ak_ = Ab + (size_t)(KT) * 128;                                                               \
    const char* Bk_ = Bb + (size_t)(KT) * 128;                                                               \
    _Pragma("unroll") for (int i = 0; i < 4; ++i) {                                                          \
      if (AMODE == 0) RA[i] = *(const u32x4*)(Ak_ + oa[i]);                                                  \
      else { int tok = tok0[i] + (KT); if (tok > 4095) tok = 4095; RA[i] = *(const u32x4*)(Ab + (oa[i] + (unsigned)tok * 2048u)); } \
      RB[i] = *(const u32x4*)(Bk_ + ob[i]);                                                                  \
    }                                                                                                        \
  }
#define L_STORE(RA, RB)                                                                                      \
  _Pragma("unroll") for (int i = 0; i < 4; ++i) {                                                            \
    *(u32x4*)&sA[(lr + 32 * i) * 80 + ch * 8] = RA[i];                                                       \
    *(u32x4*)&sB[(lr + 32 * i) * 80 + ch * 8] = RB[i];                                                       \
  }
#define T_COMPUTE()                                                                                          \
  _Pragma("unroll") for (int ks = 0; ks < 2; ++ks) {                                                         \
    bf16x8 af[4], bfr[4];                                                                                    \
    _Pragma("unroll") for (int i = 0; i < 4; ++i) af[i] = ld8(&sA[(wm * 64 + 16 * i + l15) * 80 + ks * 32 + G * 8]);  \
    _Pragma("unroll") for (int j = 0; j < 4; ++j) bfr[j] = ld8(&sB[(wn * 64 + 16 * j + l15) * 80 + ks * 32 + G * 8]); \
    _Pragma("unroll") for (int i = 0; i < 4; ++i)                                                            \
      _Pragma("unroll") for (int j = 0; j < 4; ++j) acc[i][j] = MFMA(af[i], bfr[j], acc[i][j]);              \
  }                                                                                                          \
     \
  __builtin_amdgcn_sched_group_barrier(0x100, 8, 0);                                                         \
  _Pragma("unroll") for (int z = 0; z < 8; ++z) {                                                            \
    __builtin_amdgcn_sched_group_barrier(0x008, 2, 0);                                                       \
    __builtin_amdgcn_sched_group_barrier(0x100, 1, 0);                                                       \
  }                                                                                                          \
  __builtin_amdgcn_sched_group_barrier(0x008, 16, 0);
  const int nk = K >> 6;
  if (DEEP == 2) {
    u32x4 ra0[4], rb0[4], ra1[4], rb1[4];
    const int kl = nk - 1;
    G_LOAD(ra0, rb0, 0);
    G_LOAD(ra1, rb1, 1);
    for (int kt = 0; kt < nk; kt += 2) {
      L_STORE(ra0, rb0);
      __syncthreads();
      G_LOAD(ra0, rb0, (kt + 2 < kl ? kt + 2 : kl));
      T_COMPUTE();
      __syncthreads();
      L_STORE(ra1, rb1);
      __syncthreads();
      G_LOAD(ra1, rb1, (kt + 3 < kl ? kt + 3 : kl));
      T_COMPUTE();
      __syncthreads();
    }
  } else {
    u32x4 ra0[4], rb0[4];
    G_LOAD(ra0, rb0, 0);
    for (int kt = 0; kt < nk; ++kt) {
      L_STORE(ra0, rb0);
      __syncthreads();
      if (kt + 1 < nk) G_LOAD(ra0, rb0, kt + 1);
      T_COMPUTE();
      __syncthreads();
    }
  }
#undef G_LOAD
#undef L_STORE
#undef T_COMPUTE
}

__device__ __forceinline__ void zero_acc(f32x4 (&acc)[4][4]) {
#pragma unroll
  for (int i = 0; i < 4; ++i)
#pragma unroll
    for (int j = 0; j < 4; ++j) acc[i][j] = (f32x4){0.f, 0.f, 0.f, 0.f};
}

#define EPI_VARS                                                         \
  const int tid = tid_(), lane = tid & 63, wave = tid >> 6;         \
  const int l15 = lane & 15, G = lane >> 4;                              \
  const int wm = wave >> 1, wn = wave & 1;                               \
  (void)l15; (void)G; (void)wm; (void)wn;

__device__ __forceinline__ void transpose_tile(const float* __restrict__ W, int ldw, int oc0, int valid, int k0, u16* __restrict__ out,
                               long Kdim, int n0, float* s  ) {
  const int tid = tid_();
  __syncthreads();
  {
    const bool vec = (valid == 64) && (((oc0 | ldw) & 3) == 0);
    if (vec) {
      const int n4 = (tid & 15) * 4;
      float4 v[4];
#pragma unroll
      for (int i = 0; i < 4; ++i) v[i] = *(const float4*)(W + (long)(k0 + (tid >> 4) + 16 * i) * ldw + oc0 + n4);
#pragma unroll
      for (int i = 0; i < 4; ++i) {
        float* d = &s[((tid >> 4) + 16 * i) * 65 + n4];
        d[0] = v[i].x; d[1] = v[i].y; d[2] = v[i].z; d[3] = v[i].w;
      }
    } else {
      const int n = tid & 63;
      for (int kk = tid >> 6; kk < 64; kk += 4) {
        float v = 0.f;
        if (n < valid) v = W[(long)(k0 + kk) * ldw + oc0 + n];
        s[kk * 65 + n] = v;
      }
    }
  }
  __syncthreads();
  {
    const int nn = tid >> 2, kq = (tid & 3) * 16;
    uint32_t w[8];
#pragma unroll
    for (int e = 0; e < 8; ++e) w[e] = pack2(s[(kq + 2 * e) * 65 + nn], s[(kq + 2 * e + 1) * 65 + nn]);
    u16* dst = out + (long)(n0 + nn) * Kdim + k0 + kq;
    *(u32x4*)dst = (u32x4){w[0], w[1], w[2], w[3]};
    *(u32x4*)(dst + 8) = (u32x4){w[4], w[5], w[6], w[7]};
  }
}

__device__ __forceinline__ void transpose_job(const float* W, int N, int K, u16* out, int tile, float* s) {
  const int kt_n = K >> 6;
  const int nt = tile / kt_n, kt = tile % kt_n;
  transpose_tile(W, N, nt * 64, 64, kt * 64, out, K, nt * 64, s);
}

__device__ __forceinline__ void phase_prep(const Params& P, char* smem) {
  const int tid = tid_(), lane = tid & 63, wave = tid >> 6;
  char* ws = P.ws;
  float* sf = (float*)smem;
  {
    u16* U = (u16*)(ws + OFF_U);
    for (int un = bid_(); un < 2048; un += gridDim.x) {
      const int row0 = un * 8 + wave * 2;
      float4 v[2][4];
      float ss[2] = {0.f, 0.f};
#pragma unroll
      for (int rr = 0; rr < 2; ++rr)
#pragma unroll
        for (int j = 0; j < 4; ++j) v[rr][j] = *(const float4*)(P.x + (long)(row0 + rr) * 1024 + j * 256 + lane * 4);
#pragma unroll
      for (int rr = 0; rr < 2; ++rr) {
#pragma unroll
        for (int j = 0; j < 4; ++j)
          ss[rr] += v[rr][j].x * v[rr][j].x + v[rr][j].y * v[rr][j].y + v[rr][j].z * v[rr][j].z + v[rr][j].w * v[rr][j].w;
#pragma unroll
        for (int o = 32; o >= 1; o >>= 1) ss[rr] += SHX(ss[rr], o);
        const float r = rsqrtf(ss[rr] * (1.f / 1024.f) + 1e-6f);
#pragma unroll
        for (int j = 0; j < 4; ++j) {
          const float4 w = *(const float4*)(P.n_pre_mix + j * 256 + lane * 4);
          u32x2 o2 = {pack2(v[rr][j].x * r * w.x, v[rr][j].y * r * w.y), pack2(v[rr][j].z * r * w.z, v[rr][j].w * r * w.w)};
          *(u32x2*)(U + (long)(row0 + rr) * 1024 + j * 256 + lane * 4) = o2;
        }
      }
    }
  }
  {
    u16* WT = (u16*)(ws + OFF_WIN_T);
    for (int t = bid_(); t < 138 * 16; t += gridDim.x) {
      const int nt = t >> 4, kt = t & 15;
      const int nr0 = nt * 64;
      int oc0, valid;
      if (nr0 < 6656) { oc0 = nr0; valid = 64; }
      else if (nr0 < 8704) { oc0 = nr0 + 48; valid = 64; }
      else if (nr0 == 8704) { oc0 = 6656; valid = 48; }
      else { oc0 = 0; valid = 0; }
      transpose_tile(P.w_in, 8752, oc0, valid, kt * 64, WT, 1024, nr0, sf);
    }
    for (int t = bid_(); t < 128; t += gridDim.x) transpose_job(P.wk1, 256, 2048, (u16*)(ws + OFF_WK1T), t, sf);
    for (int t = bid_(); t < 128; t += gridDim.x) transpose_job(P.wv1, 256, 2048, (u16*)(ws + OFF_WV1T), t, sf);
    for (int t = bid_(); t < 4; t += gridDim.x) transpose_job(P.wk2, 64, 256, (u16*)(ws + OFF_WK2T), t, sf);
    for (int t = bid_(); t < 4; t += gridDim.x) transpose_job(P.wv2, 64, 256, (u16*)(ws + OFF_WV2T), t, sf);
  }
  {
    float2* RT = (float2*)(ws + OFF_ROPE);
    for (int un = bid_(); un < 128; un += gridDim.x) {
      const int idx = un * 256 + tid;
      const int t = idx >> 3, j = idx & 7;
      const float inv = (j == 0) ? 1.0f : (j == 1) ? 0.1939227432012558f : (j == 2) ? 0.03760603070259094f
                      : (j == 3) ? 0.007292664609849453f : (j == 4) ? 0.0014142135623842478f
                      : (j == 5) ? 0.00027424818836152554f : (j == 6) ? 5.3182957344688475e-05f : 1.0313385246263351e-05f;
      const float ang = (float)t * inv;
      const double ad = (double)ang;
      const double kq = rint(ad * 0.15915494309189535);
      const float rr = (float)(ad - kq * 6.283185307179586);
      float sn, cs;
      sincosf(rr, &sn, &cs);
      RT[idx] = make_float2(cs, sn);
    }
  }
  {
    float* B1P = (float*)(ws + OFF_BIAS1P);
    for (int un = bid_(); un < 16; un += gridDim.x) {
      const int kvi = un >> 3, part = un & 7;
      const float* pe = kvi ? P.pe_v : P.pe_k;
      const float* w1 = kvi ? P.wv1 : P.wk1;
      float4 a = make_float4(0.f, 0.f, 0.f, 0.f);
      const int k0 = part * 256 + wave * 64;
#pragma unroll 8
      for (int k = k0; k < k0 + 64; ++k) {
        const float pv = pe[k];
        const float4 w = *(const float4*)(w1 + (long)k * 256 + lane * 4);
        a.x += pv * w.x; a.y += pv * w.y; a.z += pv * w.z; a.w += pv * w.w;
      }
      __syncthreads();
      *(float4*)&sf[wave * 256 + lane * 4] = a;
      __syncthreads();
      B1P[un * 256 + tid] = sf[tid] + sf[256 + tid] + sf[512 + tid] + sf[768 + tid];
      __syncthreads();
    }
  }
  {
    float* LB = (float*)(ws + OFF_LB);
    for (int un = bid_(); un < 4; un += gridDim.x) {
      const int c = un * 256 + tid;
      const float l0 = P.lb_logits[c], l1 = P.lb_logits[1024 + c];
      LB[c] = 1.f / (1.f + expf(l1 - l0));
    }
  }
}

__device__ __forceinline__ void phase_late_weights(const Params& P, char* smem) {
  char* ws = P.ws;
  float* sf = (float*)smem;
  for (int t = bid_(); t < 256; t += gridDim.x) transpose_job(P.w_a, 1024, 1024, (u16*)(ws + OFF_WA_T), t, sf);
  for (int t = bid_(); t < 256; t += gridDim.x) transpose_job(P.w_b, 1024, 1024, (u16*)(ws + OFF_WB_T), t, sf);
  for (int t = bid_(); t < 256; t += gridDim.x) transpose_job(P.w_out, 1024, 1024, (u16*)(ws + OFF_WOUT_T), t, sf);
  for (int t = bid_(); t < 256; t += gridDim.x) transpose_job(P.w_pg, 1024, 1024, (u16*)(ws + OFF_WPG_T), t, sf);
  for (int t = bid_(); t < 1024; t += gridDim.x) transpose_job(P.w_up, 4096, 1024, (u16*)(ws + OFF_WUP_T), t, sf);
  for (int t = bid_(); t < 1024; t += gridDim.x) transpose_job(P.w_down, 1024, 4096, (u16*)(ws + OFF_WDOWN_T), t, sf);
  for (int t = bid_(); t < 64; t += gridDim.x) transpose_job(P.w_ple, 1024, 256, (u16*)(ws + OFF_WPLE_T), t, sf);
}

__device__ __forceinline__ void phase_inproj(const Params& P, int half, char* smem) {
  char* ws = P.ws;
  u16* sA = (u16*)smem;
  u16* sB = sA + 128 * 80;
  float* sF = (float*)smem;
  const u16* U = (const u16*)(ws + OFF_U) + (long)half * 8192 * 1024;
  const u16* WT = (const u16*)(ws + OFF_WIN_T);
  u16* QF = (u16*)(ws + OFF_QF);
  u16* LOGF = (u16*)(ws + OFF_LOGF);
  u16* HVT = (u16*)(ws + OFF_HVT);
  u16* SG = (u16*)(ws + OFF_SG) + (long)half * 8192 * 1024;
  u16* NQ = (u16*)(ws + OFF_NQ) + (long)half * 8192 * 1024;
  u16* NQR = (u16*)(ws + OFF_NQR);
  u16* KV = (u16*)(ws + OFF_KV);
  u16* VST = (u16*)(ws + OFF_VST);
  u16* VWT = (u16*)(ws + OFF_VWT);
  u16* GATES = (u16*)P.out + (long)half * 8192 * 2048;
  float* NGATE = (float*)(ws + OFF_NGATE) + (long)half * 8192 * 48;
  const float* RTf = (const float*)(ws + OFF_ROPE);
  const float* LB = (const float*)(ws + OFF_LB);
  for (int t = bid_(); t < 64 * 69; t += gridDim.x) {
    const int nt = t >> 6, mt = t & 63;
    const int m0 = mt * 128, n0 = nt * 128;
    f32x4 acc[4][4];
    zero_acc(acc);
    gemm_tile<0, 2>(U, 1024, m0, 8192, WT, 1024, n0, 8832, 1024, 0, acc, sA, sB);
    {
      EPI_VARS
#pragma unroll
      for (int i = 0; i < 4; ++i)
#pragma unroll
        for (int j = 0; j < 4; ++j)
#pragma unroll
          for (int e = 0; e < 4; ++e) sF[(wm * 64 + 16 * i + G * 4 + e) * 128 + wn * 64 + 16 * j + l15] = acc[i][j][e];
    }
    __syncthreads();
    const int tc = tid_();
    int kind = 0, op = 0, dstride = 1024, dcol = 0;
    u16* dbase = nullptr;
    u16* tbase = nullptr;
    if (nt < 8) { dbase = QF; dcol = n0; op = 0; }
    else if (nt < 16) { dbase = LOGF; dcol = n0 - 1024; op = 1; }
    else if (nt < 24) { kind = 1; tbase = HVT; }
    else if (nt < 32) { dbase = SG; dcol = n0 - 3072; op = 2; }
    else if (nt < 40) { dbase = NQ; dcol = n0 - 4096; op = 3; }
    else if (nt < 52) {
      const int c0 = n0 - 5120, sub0 = c0 >> 8;
      if (sub0 == 3 || sub0 == 5) { kind = 2; tbase = (sub0 == 3) ? VST : VWT; }
      else { dbase = KV; dcol = ((sub0 == 0) ? 0 : (sub0 == 1) ? 256 : (sub0 == 2) ? 512 : 768) + (c0 & 255); op = (sub0 >= 2) ? 5 : 4; }
    } else if (nt < 68) { dbase = GATES; dstride = 2048; dcol = n0 - 6656; op = 6; }
    else kind = 3;

    if (kind == 0) {
#pragma unroll 2
      for (int k8 = 0; k8 < 8; ++k8) {
        const int id = tc + 256 * k8;
        const int row = id >> 4, c8 = (id & 15) * 8;
        const float4 f0 = *(const float4*)&sF[row * 128 + c8];
        const float4 f1 = *(const float4*)&sF[row * 128 + c8 + 4];
        float v[8] = {f0.x, f0.y, f0.z, f0.w, f1.x, f1.y, f1.z, f1.w};
        const int hc = c8 & 63;
        if (op == 0) {
#pragma unroll
          for (int q = 0; q < 8; ++q) v[q] = siluf(v[q]) * 0.08838834764831845f;
        } else if (op == 1) {
          const float4 l0 = *(const float4*)(LB + dcol + c8);
          const float4 l1 = *(const float4*)(LB + dcol + c8 + 4);
          const float lb[8] = {l0.x, l0.y, l0.z, l0.w, l1.x, l1.y, l1.z, l1.w};
#pragma unroll
          for (int q = 0; q < 8; ++q) v[q] = __logf(lb[q] + (1.f - lb[q]) * sigm(v[q]));
        } else if (op == 2) {
#pragma unroll
          for (int q = 0; q < 8; ++q) v[q] = siluf(v[q]);
        } else if (op == 3) {
#pragma unroll
          for (int q = 0; q < 8; ++q) v[q] *= 0.18033688011112042f;
        } else if (op == 6) {
#pragma unroll
          for (int q = 0; q < 8; ++q) v[q] = sigm(v[q]);
        }
        if ((op == 3 || op == 5) && hc < 16) {
          const int pc = (hc == 0) ? c8 + 8 : c8 - 8;
          const float4 g0 = *(const float4*)&sF[row * 128 + pc];
          const float4 g1 = *(const float4*)&sF[row * 128 + pc + 4];
          float pr[8] = {g0.x, g0.y, g0.z, g0.w, g1.x, g1.y, g1.z, g1.w};
          if (op == 3) {
#pragma unroll
            for (int q = 0; q < 8; ++q) pr[q] *= 0.18033688011112042f;
          }
          const int tt = (m0 + row) & 4095;
          const float4 r0 = *(const float4*)(RTf + tt * 16);
          const float4 r1 = *(const float4*)(RTf + tt * 16 + 4);
          const float4 r2 = *(const float4*)(RTf + tt * 16 + 8);
          const float4 r3 = *(const float4*)(RTf + tt * 16 + 12);
          const float cs[8] = {r0.x, r0.z, r1.x, r1.z, r2.x, r2.z, r3.x, r3.z};
          const float sn[8] = {r0.y, r0.w, r1.y, r1.w, r2.y, r2.w, r3.y, r3.w};
          float ro[8];
#pragma unroll
          for (int q = 0; q < 8; ++q) ro[q] = (hc == 0) ? (v[q] * cs[q] - pr[q] * sn[q]) : (v[q] * cs[q] + pr[q] * sn[q]);
          if (op == 3) {
            const int head = (dcol + c8) >> 6;
            *(u32x4*)(NQR + (long)(m0 + row) * 256 + head * 16 + hc) =
                (u32x4){pack2(ro[0], ro[1]), pack2(ro[2], ro[3]), pack2(ro[4], ro[5]), pack2(ro[6], ro[7])};
          } else {
#pragma unroll
            for (int q = 0; q < 8; ++q) v[q] = ro[q];
          }
        }
        u32x4 o4;
        if (op == 1) {
          union { _Float16 h[8]; u32x4 u; } cv;
#pragma unroll
          for (int q = 0; q < 8; ++q) cv.h[q] = (_Float16)v[q];
          o4 = cv.u;
        } else {
          o4 = (u32x4){pack2(v[0], v[1]), pack2(v[2], v[3]), pack2(v[4], v[5]), pack2(v[6], v[7])};
        }
        *(u32x4*)(dbase + (long)(m0 + row) * dstride + dcol + c8) = o4;
      }
    } else if (kind == 1 || kind == 2) {
#pragma unroll 2
      for (int k8 = 0; k8 < 8; ++k8) {
        const int id = tc + 256 * k8;
        const int col = id & 127, r8 = (id >> 7) * 8;
        float v[8];
#pragma unroll
        for (int q = 0; q < 8; ++q) v[q] = sF[(r8 + q) * 128 + col];
        const int r = m0 + r8;
        const int bl = r >> 12, tt = r & 4095;
        unsigned off;
        if (kind == 1) {
          const int c = n0 + col - 2048;
          const int h = c >> 7, dv = c & 127;
          off = ((unsigned)(((bl * 8 + h) * 64 + (tt >> 6)) * 128 + dv) * 64u + (unsigned)(tt & 63)) * 2u;
        } else {
          const int cc = (n0 + col - 5120) & 255;
          const int g = cc >> 6, d = cc & 63;
          off = ((unsigned)((bl * 4 + g) * 64 + d) * 4096u + (unsigned)tt) * 2u;
        }
        *(u32x4*)((char*)tbase + off) = (u32x4){pack2(v[0], v[1]), pack2(v[2], v[3]), pack2(v[4], v[5]), pack2(v[6], v[7])};
      }
    } else {
      for (int id = tc; id < 128 * 48; id += 256) {
        const int row = id / 48, c = id - row * 48;
        NGATE[(long)(m0 + row) * 48 + c] = sigm(sF[row * 128 + c]);
      }
    }
    __syncthreads();
  }
}

__device__ __forceinline__ void hgrn_intra_unit(const Params& P, int uu, char* smem) {
  char* ws = P.ws;
  const int tid = tid_(), lane = tid & 63, wave = tid >> 6;
  const int l15 = lane & 15, G = lane >> 4;
  float* sBc = (float*)smem;
  u16* sQ = (u16*)(smem + 64 * 132 * 4);
  const int bl = uu >> 9, h = (uu >> 6) & 7, c = uu & 63;
  const long r0 = (long)bl * 4096 + c * 64;
  u16* QF = (u16*)(ws + OFF_QF);
  const _Float16* LOGF = (const _Float16*)(ws + OFF_LOGF);
  const u16* HVT = (const u16*)(ws + OFF_HVT);
  u16* ABUF = (u16*)(ws + OFF_ABUF);
  u16* UST = (u16*)(ws + OFF_UST);
  float* DCY = (float*)(ws + OFF_DCY);

  __syncthreads();
#pragma unroll
  for (int i = 0; i < 4; ++i) {
    const int id = tid + 256 * i;
    const int row = id >> 4, cc = (id & 15) * 8;
    const u32x4 lf = *(const u32x4*)(LOGF + (r0 + row) * 1024 + h * 128 + cc);
    const _Float16* hp = (const _Float16*)&lf;
#pragma unroll
    for (int e = 0; e < 8; ++e) sBc[row * 132 + cc + e] = (float)hp[e];
    *(u32x4*)&sQ[row * 136 + cc] = *(const u32x4*)(QF + (r0 + row) * 1024 + h * 128 + cc);
  }
  __syncthreads();
  if (tid < 128) {
    float run = 0.f;
    for (int s = 0; s < 64; ++s) {
      run += sBc[s * 132 + tid];
      sBc[s * 132 + tid] = run;
    }
  }
  __syncthreads();
#pragma unroll
  for (int i = 0; i < 4; ++i) {
    const int id = tid + 256 * i;
    const int row = id >> 4, cc = (id & 15) * 8;
    uint32_t w[4];
#pragma unroll
    for (int e = 0; e < 4; ++e) {
      const float q0 = bf2f(sQ[row * 136 + cc + 2 * e]) * __expf(sBc[row * 132 + cc + 2 * e]);
      const float q1 = bf2f(sQ[row * 136 + cc + 2 * e + 1]) * __expf(sBc[row * 132 + cc + 2 * e + 1]);
      w[e] = pack2(q0, q1);
    }
    *(u32x4*)(QF + (r0 + row) * 1024 + h * 128 + cc) = (u32x4){w[0], w[1], w[2], w[3]};
  }
  if (tid < 128) DCY[(long)uu * 128 + tid] = __expf(sBc[63 * 132 + tid]);
  for (int idx = tid; idx < 4096; idx += 256) {
    const int t = idx >> 6, s = idx & 63;
    if ((s >> 4) > (t >> 4)) ABUF[(long)uu * 4096 + idx] = 0;
  }
  for (int ti = wave; ti < 10; ti += 4) {
    int i, j;
    if (ti == 0) { i = 0; j = 0; }
    else if (ti < 3) { i = 1; j = ti - 1; }
    else if (ti < 6) { i = 2; j = ti - 3; }
    else { i = 3; j = ti - 6; }
    f32x4 a4 = {0.f, 0.f, 0.f, 0.f};
    const int t = 16 * i + l15, s = 16 * j + l15;
#pragma unroll
    for (int ks = 0; ks < 4; ++ks) {
      const int dk0 = ks * 32 + G * 8;
      uint32_t aw[4], bw[4];
#pragma unroll
      for (int e2 = 0; e2 < 4; ++e2) {
        float av[2], bv[2];
#pragma unroll
        for (int z = 0; z < 2; ++z) {
          const int dk = dk0 + 2 * e2 + z;
          const float br = sBc[(16 * i) * 132 + dk];
          const float bt = sBc[t * 132 + dk];
          av[z] = bf2f(sQ[t * 136 + dk]) * __expf(bt - br);
          const float bs = sBc[s * 132 + dk];
          const float bp = (s > 0) ? sBc[(s - 1) * 132 + dk] : 0.f;
          const float kk = 1.f - __expf(bs - bp);
          bv[z] = kk * __expf(br - bs);
        }
        aw[e2] = pack2(av[0], av[1]);
        bw[e2] = pack2(bv[0], bv[1]);
      }
      a4 = MFMA(mk8(aw[0], aw[1], aw[2], aw[3]), mk8(bw[0], bw[1], bw[2], bw[3]), a4);
    }
#pragma unroll
    for (int e = 0; e < 4; ++e) {
      const int tr = 16 * i + G * 4 + e, sc = 16 * j + l15;
      const float v = (sc <= tr) ? a4[e] : 0.f;
      ABUF[(long)uu * 4096 + tr * 64 + sc] = f2bf(v);
    }
  }
  {
    f32x4 ua[8][2];
#pragma unroll
    for (int rt = 0; rt < 8; ++rt) { ua[rt][0] = (f32x4){0.f, 0.f, 0.f, 0.f}; ua[rt][1] = (f32x4){0.f, 0.f, 0.f, 0.f}; }
#pragma unroll
    for (int ks = 0; ks < 2; ++ks) {
      bf16x8 bfr[2];
#pragma unroll
      for (int ct = 0; ct < 2; ++ct) {
        const int dk = (2 * wave + ct) * 16 + l15;
        const float blast = sBc[63 * 132 + dk];
        const int s0 = ks * 32 + G * 8;
        float prev = (s0 > 0) ? sBc[(s0 - 1) * 132 + dk] : 0.f;
        uint32_t bw[4];
#pragma unroll
        for (int e2 = 0; e2 < 4; ++e2) {
          const float b0 = sBc[(s0 + 2 * e2) * 132 + dk];
          const float b1 = sBc[(s0 + 2 * e2 + 1) * 132 + dk];
          const float k0 = (1.f - __expf(b0 - prev)) * __expf(blast - b0);
          const float k1 = (1.f - __expf(b1 - b0)) * __expf(blast - b1);
          prev = b1;
          bw[e2] = pack2(k0, k1);
        }
        bfr[ct] = mk8(bw[0], bw[1], bw[2], bw[3]);
      }
#pragma unroll
      for (int rt = 0; rt < 8; ++rt) {
        const int dv = rt * 16 + l15;
        const bf16x8 af = ld8(HVT + ((long)uu * 128 + dv) * 64 + ks * 32 + G * 8);
        ua[rt][0] = MFMA(af, bfr[0], ua[rt][0]);
        ua[rt][1] = MFMA(af, bfr[1], ua[rt][1]);
      }
    }
#pragma unroll
    for (int rt = 0; rt < 8; ++rt)
#pragma unroll
      for (int ct = 0; ct < 2; ++ct)
#pragma unroll
        for (int e = 0; e < 4; ++e) {
          const int dv = rt * 16 + G * 4 + e, dk = (2 * wave + ct) * 16 + l15;
          UST[((long)uu * 128 + dv) * 128 + dk] = f2bf(ua[rt][ct][e]);
        }
  }
}

__device__ __forceinline__ void cmp_gemm1_tile(const Params& P, int t, char* smem) {
  char* ws = P.ws;
  u16* sA = (u16*)smem;
  u16* sB = sA + 128 * 80;
  EPI_VARS
  const int kv = t >> 5, rem = t & 31;
  const int mt = rem >> 1, nt = rem & 1;
  const int m0 = mt * 128, n0 = nt * 128;
  const u16* KV = (const u16*)(ws + OFF_KV);
  const u16* W1T = (const u16*)(ws + (kv ? OFF_WV1T : OFF_WK1T));
  u16* HID = (u16*)(ws + (kv ? OFF_HIDV : OFF_HIDK));
  const float* B1P = (const float*)(ws + OFF_BIAS1P) + kv * 2048;
  f32x4 acc[4][4];
  zero_acc(acc);
  gemm_tile<1, 2>(KV, 1024, m0, 2048, W1T, 2048, n0, 256, 2048, kv * 256, acc, sA, sB);
#pragma unroll
  for (int i = 0; i < 4; ++i)
#pragma unroll
    for (int j = 0; j < 4; ++j) {
      const int col = n0 + wn * 64 + 16 * j + l15;
      float bias = 0.f;
#pragma unroll
      for (int pp = 0; pp < 8; ++pp) bias += B1P[pp * 256 + col];
#pragma unroll
      for (int e = 0; e < 4; ++e) {
        const int row = m0 + wm * 64 + 16 * i + G * 4 + e;
        HID[(long)row * 256 + col] = f2bf(gelu_tanh(acc[i][j][e] + bias));
      }
    }
}

__device__ __forceinline__ void cmp_gemm2_tile(const Params& P, int t, char* smem) {
  char* ws = P.ws;
  u16* sA = (u16*)smem;
  u16* sB = sA + 128 * 80;
  EPI_VARS
  const int kv = t >> 4, mt = t & 15;
  const int m0 = mt * 128;
  const u16* HID = (const u16*)(ws + (kv ? OFF_HIDV : OFF_HIDK));
  const u16* W2T = (const u16*)(ws + (kv ? OFF_WV2T : OFF_WK2T));
  u16* KCMP = (u16*)(ws + OFF_KCMP);
  u16* VCMPT = (u16*)(ws + OFF_VCMPT);
  f32x4 acc[4][4];
  zero_acc(acc);
  gemm_tile<0, 1>(HID, 256, m0, 2048, W2T, 256, 0, 64, 256, 0, acc, sA, sB);
  if (wn == 0) {
#pragma unroll
    for (int i = 0; i < 4; ++i)
#pragma unroll
      for (int j = 0; j < 4; ++j) {
        const int col = 16 * j + l15;
        const int rbase = m0 + wm * 64 + 16 * i + G * 4;
        if (kv == 0) {
#pragma unroll
          for (int e = 0; e < 4; ++e) KCMP[(long)(rbase + e) * 64 + col] = f2bf(acc[i][j][e]);
        } else {
          const int grp = rbase >> 8, n = rbase & 255;
          u32x2 o2 = {pack2(acc[i][j][0], acc[i][j][1]), pack2(acc[i][j][2], acc[i][j][3])};
          *(u32x2*)(VCMPT + ((long)grp * 64 + col) * 256 + n) = o2;
        }
      }
  }
}

__device__ __forceinline__ void hgrn_scan(const Params& P) {
  char* ws = P.ws;
  u16* UST = (u16*)(ws + OFF_UST);
  const float* DCY = (const float*)(ws + OFF_DCY);
  for (int idx = bid_() * 256 + tid_(); idx < 131072; idx += gridDim.x * 256) {
    const int bh = idx >> 13, rem = idx & 8191;
    const int dv = rem >> 6, dk2 = (rem & 63) * 2;
    float s0 = 0.f, s1 = 0.f;
#pragma unroll 8
    for (int c = 0; c < 64; ++c) {
      const long uu = (long)bh * 64 + c;
      u16* ptr = UST + (uu * 128 + dv) * 128 + dk2;
      const uint32_t uv = *(const uint32_t*)ptr;
      const float2 d = *(const float2*)(DCY + uu * 128 + dk2);
      *(uint32_t*)ptr = pack2(s0, s1);
      s0 = d.x * s0 + __uint_as_float(uv << 16);
      s1 = d.y * s1 + __uint_as_float(uv & 0xffff0000u);
    }
  }
}

__device__ __forceinline__ void hgrn_out_unit(const Params& P, int half, int uu, char* smem) {
  char* ws = P.ws;
  const int tid = tid_(), lane = tid & 63, wave = tid >> 6;
  const int l15 = lane & 15, G = lane >> 4;
  float* sO = (float*)smem;
  const int bl = uu >> 9, h = (uu >> 6) & 7, c = uu & 63;
  const long r0 = (long)bl * 4096 + c * 64;
  const u16* QF = (const u16*)(ws + OFF_QF);
  const u16* HVT = (const u16*)(ws + OFF_HVT);
  const u16* ABUF = (const u16*)(ws + OFF_ABUF);
  const u16* UST = (const u16*)(ws + OFF_UST);
  u16* SG = (u16*)(ws + OFF_SG) + (long)half * 8192 * 1024;
  f32x4 acc[4][2];
#pragma unroll
  for (int i = 0; i < 4; ++i) { acc[i][0] = (f32x4){0.f, 0.f, 0.f, 0.f}; acc[i][1] = (f32x4){0.f, 0.f, 0.f, 0.f}; }
#pragma unroll
  for (int ks = 0; ks < 4; ++ks) {
    const int dk0 = ks * 32 + G * 8;
    bf16x8 bfr[2];
#pragma unroll
    for (int jt = 0; jt < 2; ++jt) bfr[jt] = ld8(UST + ((long)uu * 128 + 32 * wave + 16 * jt + l15) * 128 + dk0);
#pragma unroll
    for (int i = 0; i < 4; ++i) {
      const bf16x8 af = ld8(QF + (r0 + 16 * i + l15) * 1024 + h * 128 + dk0);
      acc[i][0] = MFMA(af, bfr[0], acc[i][0]);
      acc[i][1] = MFMA(af, bfr[1], acc[i][1]);
    }
  }
#pragma unroll
  for (int ks = 0; ks < 2; ++ks) {
    const int s0 = ks * 32 + G * 8;
    bf16x8 bfr[2];
#pragma unroll
    for (int jt = 0; jt < 2; ++jt) bfr[jt] = ld8(HVT + ((long)uu * 128 + 32 * wave + 16 * jt + l15) * 64 + s0);
#pragma unroll
    for (int i = 0; i < 4; ++i) {
      const bf16x8 af = ld8(ABUF + (long)uu * 4096 + (16 * i + l15) * 64 + s0);
      acc[i][0] = MFMA(af, bfr[0], acc[i][0]);
      acc[i][1] = MFMA(af, bfr[1], acc[i][1]);
    }
  }
  __syncthreads();
#pragma unroll
  for (int i = 0; i < 4; ++i)
#pragma unroll
    for (int jt = 0; jt < 2; ++jt)
#pragma unroll
      for (int e = 0; e < 4; ++e) sO[(16 * i + G * 4 + e) * 132 + 32 * wave + 16 * jt + l15] = acc[i][jt][e];
  __syncthreads();
  {
    const int row = tid >> 2, part = tid & 3;
    float ss = 0.f;
#pragma unroll
    for (int cc = 0; cc < 32; ++cc) { const float v = sO[row * 132 + part * 32 + cc]; ss += v * v; }
    ss += SHX(ss, 1);
    ss += SHX(ss, 2);
    const float r = rsqrtf(ss * (1.f / 128.f) + 1e-6f);
    u16* dst = SG + (r0 + row) * 1024 + h * 128 + part * 32;
#pragma unroll
    for (int q4 = 0; q4 < 4; ++q4) {
      const u32x4 sgv = *(const u32x4*)(dst + q4 * 8);
      uint32_t w[4];
#pragma unroll
      for (int e = 0; e < 4; ++e) {
        const int cc = q4 * 8 + 2 * e;
        const float g0 = __uint_as_float(sgv[e] << 16), g1 = __uint_as_float(sgv[e] & 0xffff0000u);
        const float y0 = sO[row * 132 + part * 32 + cc] * r * P.gnorm[part * 32 + cc] * g0;
        const float y1 = sO[row * 132 + part * 32 + cc + 1] * r * P.gnorm[part * 32 + cc + 1] * g1;
        w[e] = pack2(y0, y1);
      }
      *(u32x4*)(dst + q4 * 8) = (u32x4){w[0], w[1], w[2], w[3]};
    }
  }
}

__device__ __forceinline__ void stage_kv(u16* sK, u16* sV, const u16* kptr, long kstride, const u16* vptr, long vstride) {
  const int tid = tid_();
  __syncthreads();
#pragma unroll
  for (int i = 0; i < 2; ++i) {
    const int id = tid + 256 * i;
    const int row = id >> 3, ch = id & 7;
    *(u32x4*)&sK[row * 72 + ch * 8] = *(const u32x4*)(kptr + row * kstride + ch * 8);
    *(u32x4*)&sV[row * 72 + ch * 8] = *(const u32x4*)(vptr + row * vstride + ch * 8);
  }
  __syncthreads();
}

__device__ __forceinline__ void qk_scores(const u16* sK, const bf16x8 (&q)[2], f32x4 (&s)[4], int l15, int G) {
#pragma unroll
  for (int kt = 0; kt < 4; ++kt) {
    s[kt] = (f32x4){0.f, 0.f, 0.f, 0.f};
#pragma unroll
    for (int ks = 0; ks < 2; ++ks) s[kt] = MFMA(ld8(&sK[(16 * kt + l15) * 72 + ks * 32 + G * 8]), q[ks], s[kt]);
  }
}

__device__ __forceinline__ void pv_accum(const u16* sV, const f32x4 (&p)[4], f32x4 (&o)[4], int l15, int G) {
#pragma unroll
  for (int ks2 = 0; ks2 < 2; ++ks2) {
    const f32x4 pa = p[2 * ks2], pb = p[2 * ks2 + 1];
    const bf16x8 pf = mk8(pack2(pa[0], pa[1]), pack2(pa[2], pa[3]), pack2(pb[0], pb[1]), pack2(pb[2], pb[3]));
#pragma unroll
    for (int dt = 0; dt < 4; ++dt) {
      const u32x2 v0 = *(const u32x2*)&sV[(16 * dt + l15) * 72 + 32 * ks2 + 4 * G];
      const u32x2 v1 = *(const u32x2*)&sV[(16 * dt + l15) * 72 + 32 * ks2 + 16 + 4 * G];
      o[dt] = MFMA(mk8(v0[0], v0[1], v1[0], v1[1]), pf, o[dt]);
    }
  }
}

#define EX2(x) __builtin_amdgcn_exp2f(x)
typedef __attribute__((ext_vector_type(16))) float f32x16;
#define MFMA32(a, b, c) __builtin_amdgcn_mfma_f32_32x32x16_bf16((a), (b), (c), 0, 0, 0)
template <int MODE, bool EDGE>
__device__ __forceinline__ void nsa_block(const u16* sK, const u16* sV, int jb, int qb, int q, bool blk_ok,
                                          const bf16x8 (&qf)[4], f32x16 (&O)[2], float& m, float& l, int r31, int h) {
  const int lane = h * 32 + r31;
  f32x16 s[2];
#pragma unroll
  for (int kt2 = 0; kt2 < 2; ++kt2) {
#pragma unroll
    for (int e = 0; e < 16; ++e) s[kt2][e] = 0.f;
#pragma unroll
    for (int ks = 0; ks < 4; ++ks) s[kt2] = MFMA32(ld8(&sK[(32 * kt2 + r31) * 72 + 16 * ks + 8 * h]), qf[ks], s[kt2]);
  }
  float smax = -1e30f;
  if (EDGE) {
#pragma unroll
    for (int kt2 = 0; kt2 < 2; ++kt2)
#pragma unroll
      for (int e = 0; e < 16; ++e) {
        const int k = 32 * kt2 + (e & 3) + 8 * (e >> 2) + 4 * h;
        const bool a = blk_ok && ((jb == qb) ? (k <= q) : (k > q));
        if (!a) s[kt2][e] = -1e30f;
        smax = fmaxf(smax, s[kt2][e]);
      }
  } else {
#pragma unroll
    for (int kt2 = 0; kt2 < 2; ++kt2)
#pragma unroll
      for (int e = 0; e < 16; ++e) smax = fmaxf(smax, s[kt2][e]);
    if (MODE == 2 && !blk_ok) smax = -1e30f;
  }
  smax = fmaxf(smax, SHX(smax, 32));
  const float mn = fmaxf(m, smax);
  const bool need = (mn - m) > 8.f;
  if (__builtin_amdgcn_ballot_w64(need) != 0ull) {
    const float alpha = need ? EX2(m - mn) : 1.f;
    m = need ? mn : m;
    l *= alpha;
    O[0] *= alpha;
    O[1] *= alpha;
  }
  const float mref = (!EDGE && MODE == 2 && !blk_ok) ? 1e30f : m;
  float ls = 0.f;
#pragma unroll
  for (int kt2 = 0; kt2 < 2; ++kt2)
#pragma unroll
    for (int e = 0; e < 16; ++e) {
      const float sv = s[kt2][e];
      float pv;
      if (EDGE) pv = (sv > -1e29f) ? EX2(sv - m) : 0.f;
      else pv = EX2(sv - mref);
      s[kt2][e] = pv;
      ls += pv;
    }
  l += ls;
#pragma unroll
  for (int kt2 = 0; kt2 < 2; ++kt2)
#pragma unroll
    for (int st = 0; st < 2; ++st) {
      const bf16x8 pf = mk8(pack2(s[kt2][8 * st + 0], s[kt2][8 * st + 1]), pack2(s[kt2][8 * st + 2], s[kt2][8 * st + 3]),
                            pack2(s[kt2][8 * st + 4], s[kt2][8 * st + 5]), pack2(s[kt2][8 * st + 6], s[kt2][8 * st + 7]));
#pragma unroll
      for (int dt2 = 0; dt2 < 2; ++dt2) {
        const u16* vrow = &sV[(32 * dt2 + r31) * 72 + 32 * kt2 + 16 * st + 4 * h];
        const u32x2 v0 = *(const u32x2*)vrow;
        const u32x2 v1 = *(const u32x2*)(vrow + 8);
        O[dt2] = MFMA32(mk8(v0[0], v0[1], v1[0], v1[1]), pf, O[dt2]);
      }
    }
}

template <int MODE>
__device__ __forceinline__ void nsa_branch(const u16* kbase, const u16* vbase, int jb0, int jb1, int qb, int q,
                                           uint32_t mlo, uint32_t mhi, const bf16x8 (&qf)[4], const float* ngbase, int rowbase, int gidx,
                                           u16* sYl, u16* sm, float pscale = 1.f) {
  const int tid = tid_();
  const int lane = tid & 63;
  const int r31 = lane & 31, h = lane >> 5;
  const int srow = tid >> 3, sch = (tid & 7) * 8;
  f32x16 O[2];
#pragma unroll
  for (int e = 0; e < 16; ++e) { O[0][e] = 0.f; O[1][e] = 0.f; }
  float m = -1e30f, l = 0.f;
  u32x4 kr[2], vr[2];
  const unsigned koff = (unsigned)((srow * 1024 + sch) * 2);
  const unsigned voff = (unsigned)((srow * 4096 + sch) * 2);
  {
    const char* kb = (const char*)kbase + (size_t)jb0 * 131072;
    const char* vb = (const char*)vbase + (size_t)jb0 * 128;
#pragma unroll
    for (int i = 0; i < 2; ++i) {
      kr[i] = *(const u32x4*)(kb + (koff + i * 65536u));
      vr[i] = *(const u32x4*)(vb + (voff + i * 262144u));
    }
  }
  __syncthreads();
#pragma unroll
  for (int i = 0; i < 2; ++i) {
    *(u32x4*)&sm[(srow + 32 * i) * 72 + sch] = kr[i];
    *(u32x4*)&sm[4608 + (srow + 32 * i) * 72 + sch] = vr[i];
  }
  __syncthreads();
  int cur = 0;
  for (int jb = jb0; jb <= jb1; ++jb) {
    const bool more = jb < jb1;
    if (more) {
      const char* kb = (const char*)kbase + (size_t)(jb + 1) * 131072;
      const char* vb = (const char*)vbase + (size_t)(jb + 1) * 128;
#pragma unroll
      for (int i = 0; i < 2; ++i) {
        kr[i] = *(const u32x4*)(kb + (koff + i * 65536u));
        vr[i] = *(const u32x4*)(vb + (voff + i * 262144u));
      }
    }
    const u16* sK = sm + cur * 9216;
    const u16* sV = sK + 4608;
    bool blk_ok = true;
    if (MODE == 2) blk_ok = (jb < 32) ? ((mlo >> jb) & 1u) : ((mhi >> (jb - 32)) & 1u);
    const bool edge = (jb == qb) || (MODE == 3 && jb == qb - 8);
    if (edge) nsa_block<MODE, true>(sK, sV, jb, qb, q, blk_ok, qf, O, m, l, r31, h);
    else nsa_block<MODE, false>(sK, sV, jb, qb, q, blk_ok, qf, O, m, l, r31, h);
    if (more) {
      u16* dK = sm + (cur ^ 1) * 9216;
#pragma unroll
      for (int i = 0; i < 2; ++i) {
        *(u32x4*)&dK[(srow + 32 * i) * 72 + sch] = kr[i];
        *(u32x4*)&dK[4608 + (srow + 32 * i) * 72 + sch] = vr[i];
      }
    }
    __syncthreads();
    cur ^= 1;
  }
  const int tg = tid_();
  const int lg = tg & 63, hh = (lg >> 4) & 1, hg = lg >> 5;
  const float* gatep = (const float*)((const char*)ngbase + (unsigned)(rowbase + 16 * (tg >> 6) + (tg & 15)) * 192u) + gidx + hh;
  float lt = l;
  lt += shx_f(lt, lg ^ 32);
  const float sc = (lt > 0.f) ? (pscale * gatep[0] / lt) : 0.f;
  u16* yrow = sYl + (((tg >> 6) * 2 + hh) * 16 + (tg & 15)) * 64;
#pragma unroll
  for (int dt2 = 0; dt2 < 2; ++dt2)
#pragma unroll
    for (int m4 = 0; m4 < 4; ++m4) {
      u32x2* yp = (u32x2*)(yrow + 32 * dt2 + 8 * m4 + 4 * hg);
      const u32x2 yv = *yp;
      const float y0 = __uint_as_float(yv[0] << 16) + O[dt2][4 * m4 + 0] * sc;
      const float y1 = __uint_as_float(yv[0] & 0xffff0000u) + O[dt2][4 * m4 + 1] * sc;
      const float y2 = __uint_as_float(yv[1] << 16) + O[dt2][4 * m4 + 2] * sc;
      const float y3 = __uint_as_float(yv[1] & 0xffff0000u) + O[dt2][4 * m4 + 3] * sc;
      *yp = (u32x2){pack2(y0, y1), pack2(y2, y3)};
    }
}

__device__ __forceinline__ void pv_cmp(const u16* vc, int jb, const f32x4 (&p)[4], f32x4 (&o)[4], int l15, int G) {
#pragma unroll
  for (int ks2 = 0; ks2 < 2; ++ks2) {
    const f32x4 pa = p[2 * ks2], pb = p[2 * ks2 + 1];
    const bf16x8 pf = mk8(pack2(pa[0], pa[1]), pack2(pa[2], pa[3]), pack2(pb[0], pb[1]), pack2(pb[2], pb[3]));
#pragma unroll
    for (int dt = 0; dt < 4; ++dt) {
      const u16* vp = vc + (long)(16 * dt + l15) * 256 + jb * 64 + 32 * ks2 + 4 * G;
      const u32x2 v0 = *(const u32x2*)vp;
      const u32x2 v1 = *(const u32x2*)(vp + 16);
      o[dt] = MFMA(mk8(v0[0], v0[1], v1[0], v1[1]), pf, o[dt]);
    }
  }
}

__device__ __forceinline__ void nsa_unit(const Params& P, int half, int u, char* smem) {
  char* ws = P.ws;
  const int tid = tid_(), lane = tid & 63, wave = tid >> 6;
  const int l15 = lane & 15, G = lane >> 4;
  const int hp = u >> 9, rest = u & 511;
  const int bl = rest >> 8, g = (rest >> 6) & 3, xq = rest & 63;
  const int qb = hp ? xq : 63 - xq;
  const int q = 16 * wave + l15;
  const int t = qb * 64 + q;
  const int rl = bl * 4096 + t;
  const int rg = half * 8192 + rl;
  const char* NQc = (const char*)(ws + OFF_NQ);
  const unsigned qoff = (unsigned)rg * 2048u;
  u16* sm = (u16*)smem;
  float* sImp = (float*)smem;
  const u16* NQ = (const u16*)(ws + OFF_NQ);
  const u16* NQR = (const u16*)(ws + OFF_NQR);
  const u16* KV = (const u16*)(ws + OFF_KV);
  const u16* VST = (const u16*)(ws + OFF_VST);
  const u16* VWT = (const u16*)(ws + OFF_VWT);
  const u16* KCMP = (const u16*)(ws + OFF_KCMP);
  const u16* VCMPT = (const u16*)(ws + OFF_VCMPT);
  const float* NGATE = (const float*)((const char*)(ws + OFF_NGATE) + (unsigned)rg * 192u);
  u16* YB = (u16*)(ws + (half ? OFF_YB1 : OFF_YB0));

  f32x4 Y[2][4];
#pragma unroll
  for (int rr = 0; rr < 2; ++rr)
#pragma unroll
    for (int dt = 0; dt < 4; ++dt) Y[rr][dt] = (f32x4){0.f, 0.f, 0.f, 0.f};

  uint32_t mlo = 0, mhi = 0;
  u16* sYl = (u16*)(smem + 36864);
  {
    const int nblk = ((4 * qb + 2) >> 6) + 1;
    const u16* kc = KCMP + (long)(bl * 4 + g) * 256 * 64;
    const u16* vc = VCMPT + (long)(bl * 4 + g) * 64 * 256;
    float imp[4][4];
#pragma unroll
    for (int a = 0; a < 4; ++a)
#pragma unroll
      for (int b = 0; b < 4; ++b) imp[a][b] = 0.f;
    __syncthreads();
    for (int id = tid; id < nblk * 512; id += 256) {
      const int row = id >> 3, chn = (id & 7) * 8;
      *(u32x4*)&sm[row * 72 + chn] = *(const u32x4*)(kc + row * 64 + chn);
    }
    __syncthreads();
#pragma unroll 1
    for (int r = 0; r < 4; ++r) {
      bf16x8 qp[2];
#pragma unroll
      for (int ks = 0; ks < 2; ++ks) qp[ks] = *(const bf16x8*)(NQc + (qoff + (unsigned)(((4 * g + r) * 64 + ks * 32 + G * 8) * 2)));
      float m = -1e30f, l = 0.f;
#pragma unroll 1
      for (int jb = 0; jb < nblk; ++jb) {
        f32x4 s[4];
        float smax = -1e30f;
#pragma unroll
        for (int kt = 0; kt < 4; ++kt) {
          f32x4 a4 = {0.f, 0.f, 0.f, 0.f};
#pragma unroll
          for (int ks = 0; ks < 2; ++ks)
            a4 = MFMA(ld8(&sm[(jb * 64 + 16 * kt + l15) * 72 + ks * 32 + G * 8]), qp[ks], a4);
#pragma unroll
          for (int e = 0; e < 4; ++e) {
            const int n = jb * 64 + 16 * kt + 4 * G + e;
            const float sv = (16 * n + 31 <= t) ? a4[e] : -1e30f;
            s[kt][e] = sv;
            smax = fmaxf(smax, sv);
          }
        }
        smax = fmaxf(smax, SHX(smax, 16));
        smax = fmaxf(smax, SHX(smax, 32));
        const float mn = fmaxf(m, smax);
        float ls = 0.f;
#pragma unroll
        for (int kt = 0; kt < 4; ++kt)
#pragma unroll
          for (int e = 0; e < 4; ++e) ls += (s[kt][e] > -1e29f) ? EX2(s[kt][e] - mn) : 0.f;
        l = l * EX2(m - mn) + ls;
        m = mn;
      }
      l += SHX(l, 16);
      l += SHX(l, 32);
      const float invl = (l > 0.f) ? 1.f / l : 0.f;
      float prevup = 0.f;
#pragma unroll 1
      for (int jb = 0; jb < nblk; ++jb) {
        {
          f32x4 p[4];
#pragma unroll
          for (int kt = 0; kt < 4; ++kt) {
            f32x4 a4 = {0.f, 0.f, 0.f, 0.f};
#pragma unroll
            for (int ks = 0; ks < 2; ++ks)
              a4 = MFMA(ld8(&sm[(jb * 64 + 16 * kt + l15) * 72 + ks * 32 + G * 8]), qp[ks], a4);
#pragma unroll
            for (int e = 0; e < 4; ++e) {
              const int n = jb * 64 + 16 * kt + 4 * G + e;
              p[kt][e] = (16 * n + 31 <= t) ? EX2(a4[e] - m) * invl : 0.f;
            }
            const float sum4 = (p[kt][0] + p[kt][1]) + (p[kt][2] + p[kt][3]);
            const float upv = shx_f(p[kt][3], (lane + 48) & 63);
            const float add = (G > 0) ? upv : prevup;
            const float iv = sum4 + add;
#pragma unroll
            for (int j = 0; j < 4; ++j) imp[j][kt] += (jb == j) ? iv : 0.f;
            prevup = upv;
          }
          if (r == 2 * hp) pv_cmp(vc, jb, p, Y[0], l15, G);
          else if (r == 2 * hp + 1) pv_cmp(vc, jb, p, Y[1], l15, G);
        }
      }
    }
    {
      const float g0 = NGATE[0 * 16 + 4 * g + 2 * hp], g1 = NGATE[0 * 16 + 4 * g + 2 * hp + 1];
#pragma unroll
      for (int dt = 0; dt < 4; ++dt) {
        *(u32x2*)(sYl + ((wave * 2 + 0) * 16 + l15) * 64 + 16 * dt + 4 * G) = (u32x2){pack2(Y[0][dt][0] * g0, Y[0][dt][1] * g0), pack2(Y[0][dt][2] * g0, Y[0][dt][3] * g0)};
        *(u32x2*)(sYl + ((wave * 2 + 1) * 16 + l15) * 64 + 16 * dt + 4 * G) = (u32x2){pack2(Y[1][dt][0] * g1, Y[1][dt][1] * g1), pack2(Y[1][dt][2] * g1, Y[1][dt][3] * g1)};
      }
    }
    __syncthreads();
    float* myImp = sImp + wave * 16 * 65;
#pragma unroll
    for (int jb = 0; jb < 4; ++jb)
#pragma unroll
      for (int kt = 0; kt < 4; ++kt) myImp[l15 * 65 + 16 * jb + 4 * kt + G] = imp[jb][kt];
    __syncthreads();
    const int cur = qb;
    uint32_t blo = 0, bhi = 0;
    if (cur + 1 <= 16) {
#pragma unroll
      for (int jb = 0; jb < 4; ++jb)
#pragma unroll
        for (int kt = 0; kt < 4; ++kt) {
          const int s = 16 * jb + 4 * kt + G;
          if (s <= cur) blo |= (1u << s);
        }
    } else {
      int cnt[4][4];
#pragma unroll
      for (int a = 0; a < 4; ++a)
#pragma unroll
        for (int b = 0; b < 4; ++b) cnt[a][b] = 0;
      for (int sp = 1; sp <= cur - 2; ++sp) {
        const float xv = myImp[l15 * 65 + sp];
#pragma unroll
        for (int jb = 0; jb < 4; ++jb)
#pragma unroll
          for (int kt = 0; kt < 4; ++kt) {
            const int s = 16 * jb + 4 * kt + G;
            const float v = imp[jb][kt];
            cnt[jb][kt] += ((xv > v) || (xv == v && sp < s)) ? 1 : 0;
          }
      }
#pragma unroll
      for (int jb = 0; jb < 4; ++jb)
#pragma unroll
        for (int kt = 0; kt < 4; ++kt) {
          const int s = 16 * jb + 4 * kt + G;
          const bool sel = (s == 0) || (s == cur) || (s == cur - 1) || (s >= 1 && s <= cur - 2 && cnt[jb][kt] < 13);
          if (sel) { if (s < 32) blo |= (1u << s); else bhi |= (1u << (s - 32)); }
        }
    }
    blo |= SHXU(blo, 16); blo |= SHXU(blo, 32);
    bhi |= SHXU(bhi, 16); bhi |= SHXU(bhi, 32);
    mlo = blo; mhi = bhi;
  }
  {
    const int hh = (lane >> 4) & 1, h5 = lane >> 5;
    const int head = 4 * g + 2 * hp + hh;
    bf16x8 qf[4];
    qf[0] = *(const bf16x8*)((const char*)NQR + ((unsigned)rl * 512u + (unsigned)((head * 16 + 8 * h5) * 2)));
#pragma unroll
    for (int ks = 1; ks < 4; ++ks) qf[ks] = *(const bf16x8*)(NQc + (qoff + (unsigned)((head * 64 + 16 * ks + 8 * h5) * 2)));
    const int head0 = 4 * g + 2 * hp;
    const u16* kbs = KV + (long)bl * 4096 * 1024 + 512 + g * 64;
    const u16* vbs = VST + (long)(bl * 4 + g) * 64 * 4096;
    nsa_branch<2>(kbs, vbs, 0, qb, qb, q, mlo, mhi, qf, (const float*)(ws + OFF_NGATE), half * 8192 + bl * 4096 + qb * 64, 16 + head0, sYl, sm);
    const u16* kbw = KV + (long)bl * 4096 * 1024 + 768 + g * 64;
    const u16* vbw = VWT + (long)(bl * 4 + g) * 64 * 4096;
    const int jw0 = (qb >= 8) ? qb - 8 : 0;
    nsa_branch<3>(kbw, vbw, jw0, qb, qb, q, mlo, mhi, qf, (const float*)(ws + OFF_NGATE), half * 8192 + bl * 4096 + qb * 64, 32 + head0, sYl, sm);
    const int tid2 = tid_();
    const int l2 = tid2 & 63, hh2 = (l2 >> 4) & 1, hg2 = l2 >> 5;
    const unsigned yoff = (unsigned)(bl * 4096 + qb * 64 + 16 * (tid2 >> 6) + (tid2 & 15)) * 2048u;
    const u16* yrow = sYl + (((tid2 >> 6) * 2 + hh2) * 16 + (tid2 & 15)) * 64;
#pragma unroll
    for (int dt2 = 0; dt2 < 2; ++dt2)
#pragma unroll
      for (int m4 = 0; m4 < 4; ++m4) {
        const int d0 = 32 * dt2 + 8 * m4 + 4 * hg2;
        *(u32x2*)((char*)YB + (yoff + (unsigned)(((head0 + hh2) * 64 + d0) * 2))) = *(const u32x2*)(yrow + d0);
      }
  }
}

__device__ __forceinline__ void gemm_tile_wide(const u16* __restrict__ A, long lda, int m0, const u16* __restrict__ Bt, long ldb, int n0, int K,
                                               f32x4 (&acc)[4][8], u16* sA) {
  const int tid = tid_(), lane = tid & 63, wave = tid >> 6;
  const int l15 = lane & 15, G = lane >> 4;
  const int wm = wave >> 1, wn = wave & 1;
  const int lr = tid >> 3, ch = tid & 7;
  u16* sB = sA + 128 * 80;
  const char* Ab = (const char*)A;
  const char* Bb = (const char*)Bt;
  unsigned oa[4], ob[8];
#pragma unroll
  for (int i = 0; i < 4; ++i) oa[i] = (unsigned)(((long)(m0 + lr + 32 * i) * lda + ch * 8) * 2);
#pragma unroll
  for (int i = 0; i < 8; ++i) ob[i] = (unsigned)(((long)(n0 + lr + 32 * i) * ldb + ch * 8) * 2);
  u32x4 ra[4], rb[8];
#pragma unroll
  for (int i = 0; i < 4; ++i) ra[i] = *(const u32x4*)(Ab + oa[i]);
#pragma unroll
  for (int i = 0; i < 8; ++i) rb[i] = *(const u32x4*)(Bb + ob[i]);
  const int nk = K >> 6;
  for (int kt = 0; kt < nk; ++kt) {
#pragma unroll
    for (int i = 0; i < 4; ++i) *(u32x4*)&sA[(lr + 32 * i) * 80 + ch * 8] = ra[i];
#pragma unroll
    for (int i = 0; i < 8; ++i) *(u32x4*)&sB[(lr + 32 * i) * 80 + ch * 8] = rb[i];
    __syncthreads();
    {
      const int kn = (kt + 1 < nk) ? kt + 1 : kt;
      const char* Ak = Ab + (size_t)kn * 128;
      const char* Bk = Bb + (size_t)kn * 128;
#pragma unroll
      for (int i = 0; i < 4; ++i) ra[i] = *(const u32x4*)(Ak + oa[i]);
#pragma unroll
      for (int i = 0; i < 8; ++i) rb[i] = *(const u32x4*)(Bk + ob[i]);
    }
#pragma unroll
    for (int ks = 0; ks < 2; ++ks) {
      bf16x8 af[4];
#pragma unroll
      for (int i = 0; i < 4; ++i) af[i] = ld8(&sA[(wm * 64 + 16 * i + l15) * 80 + ks * 32 + G * 8]);
#pragma unroll
      for (int jh = 0; jh < 2; ++jh) {
        bf16x8 bfr[4];
#pragma unroll
        for (int j = 0; j < 4; ++j) bfr[j] = ld8(&sB[(wn * 128 + 64 * jh + 16 * j + l15) * 80 + ks * 32 + G * 8]);
#pragma unroll
        for (int i = 0; i < 4; ++i)
#pragma unroll
          for (int j = 0; j < 4; ++j) acc[i][4 * jh + j] = MFMA(af[i], bfr[j], acc[i][4 * jh + j]);
      }
    }
    __syncthreads();
  }
}


__device__ __forceinline__ void phase_branch_merge(const Params& P, char* smem) {
  char* ws = P.ws;
  u16* sA = (u16*)smem;
  const u16* YA = (const u16*)(ws + OFF_SG);
  const u16* GATES = (const u16*)P.out;
  u16* MERGED = (u16*)(ws + OFF_MERGED);
  for (int t = bid_(); t < 512; t += gridDim.x) {
    const int nt = t >> 7, mt = t & 127;
    const int m0 = mt * 128, n0 = nt * 256;
    const u16* YBp = (m0 < 8192) ? (const u16*)(ws + OFF_YB0) : ((const u16*)(ws + OFF_YB1) - (long)8192 * 1024);
    f32x4 acc[4][8];
#pragma unroll
    for (int i = 0; i < 4; ++i)
#pragma unroll
      for (int j = 0; j < 8; ++j) acc[i][j] = (f32x4){0.f, 0.f, 0.f, 0.f};
    gemm_tile_wide(YA, 1024, m0, (const u16*)(ws + OFF_WA_T), 1024, n0, 1024, acc, sA);
    {
      EPI_VARS
#pragma unroll
      for (int i = 0; i < 4; ++i)
#pragma unroll
        for (int j = 0; j < 8; ++j) {
          const int col = n0 + wn * 128 + 16 * j + l15;
#pragma unroll
          for (int e = 0; e < 4; ++e) {
            const unsigned go = ((unsigned)(m0 + wm * 64 + 16 * i + G * 4 + e) * 2048u + (unsigned)col) * 2u;
            acc[i][j][e] *= bf2f(*(const u16*)((const char*)GATES + go)) * __builtin_amdgcn_rcpf(bf2f(*(const u16*)((const char*)GATES + (go + 2048u))));
          }
        }
    }
    gemm_tile_wide(YBp, 1024, m0, (const u16*)(ws + OFF_WB_T), 1024, n0, 1024, acc, sA);
    {
      EPI_VARS
#pragma unroll
      for (int i = 0; i < 4; ++i)
#pragma unroll
        for (int j = 0; j < 8; ++j) {
          const int col = n0 + wn * 128 + 16 * j + l15;
#pragma unroll
          for (int e = 0; e < 4; ++e) {
            const unsigned ro = (unsigned)(m0 + wm * 64 + 16 * i + G * 4 + e);
            const unsigned go = (ro * 2048u + (unsigned)col) * 2u + 2048u;
            sA[(wm * 64 + 16 * i + G * 4 + e) * 264 + (col - n0)] = f2bf(acc[i][j][e] * bf2f(*(const u16*)((const char*)GATES + go)));
          }
        }
    }
    __syncthreads();
    {
      const int tc = tid_();
#pragma unroll 4
      for (int k16 = 0; k16 < 16; ++k16) {
        const int id = tc + 256 * k16;
        const int row = id >> 5, cch = (id & 31) * 8;
        *(u32x4*)(MERGED + (long)(m0 + row) * 1024 + n0 + cch) = *(const u32x4*)&sA[row * 264 + cch];
      }
    }
    __syncthreads();
  }
}

template <int EPI>
__device__ __forceinline__ void phase_gemm(const u16* A, int K, const u16* Wt, int N, void* outp, char* smem) {
  u16* sA = (u16*)smem;
  u16* sB = sA + 128 * 80;
  EPI_VARS
  const int ntn = N >> 7;
  for (int t = bid_(); t < 128 * ntn; t += gridDim.x) {
    const int nt = t >> 7, mt = t & 127;
    const int m0 = mt * 128, n0 = nt * 128;
    f32x4 acc[4][4];
    zero_acc(acc);
    gemm_tile<0, 2>(A, K, m0, 16384, Wt, K, n0, N, K, 0, acc, sA, sB);
#pragma unroll
    for (int i = 0; i < 4; ++i)
#pragma unroll
      for (int j = 0; j < 4; ++j) {
        const int col = n0 + wn * 64 + 16 * j + l15;
#pragma unroll
        for (int e = 0; e < 4; ++e) {
          const long row = m0 + wm * 64 + 16 * i + G * 4 + e;
          const float v = acc[i][j][e];
          if (EPI == 0) ((float*)outp)[row * N + col] = v;
          else if (EPI == 2) ((u16*)outp)[row * N + col] = f2bf(v);
          else { const float rl = fmaxf(v, 0.f); ((u16*)outp)[row * N + col] = f2bf(rl * rl); }
        }
      }
  }
}


template <int EPI>
__device__ __forceinline__ void phase_gemm_wide(const u16* A, int K, const u16* Wt, int N, u16* outp, char* smem) {
  u16* sA = (u16*)smem;
  EPI_VARS
  const int ntn = N >> 8;
  for (int t = bid_(); t < 128 * ntn; t += gridDim.x) {
    const int nt = t >> 7, mt = t & 127;
    const int m0 = mt * 128, n0 = nt * 256;
    f32x4 acc[4][8];
#pragma unroll
    for (int i = 0; i < 4; ++i)
#pragma unroll
      for (int j = 0; j < 8; ++j) acc[i][j] = (f32x4){0.f, 0.f, 0.f, 0.f};
    gemm_tile_wide(A, K, m0, Wt, K, n0, K, acc, sA);
#pragma unroll
    for (int i = 0; i < 4; ++i)
#pragma unroll
      for (int j = 0; j < 8; ++j) {
        const int col = n0 + wn * 128 + 16 * j + l15;
#pragma unroll
        for (int e = 0; e < 4; ++e) {
          float v = acc[i][j][e];
          if (EPI == 1) { v = fmaxf(v, 0.f); v = v * v; }
          sA[(wm * 64 + 16 * i + G * 4 + e) * 264 + (col - n0)] = f2bf(v);
        }
      }
    __syncthreads();
    {
      const int tc = tid_();
#pragma unroll 4
      for (int k16 = 0; k16 < 16; ++k16) {
        const int id = tc + 256 * k16;
        const int row = id >> 5, cch = (id & 31) * 8;
        *(u32x4*)(outp + (long)(m0 + row) * N + n0 + cch) = *(const u32x4*)&sA[row * 264 + cch];
      }
    }
    __syncthreads();
  }
}

__device__ __forceinline__ void phase_ple(const Params& P, char* smem) {
  char* ws = P.ws;
  u16* sA = (u16*)smem;
  u16* Z3b = (u16*)(ws + OFF_Z3);
  for (int t = bid_(); t < 512; t += gridDim.x) {
    const int nt = t >> 7, mt = t & 127;
    const int m0 = mt * 128, n0 = nt * 256;
    f32x4 acc[4][8];
#pragma unroll
    for (int i = 0; i < 4; ++i)
#pragma unroll
      for (int j = 0; j < 8; ++j) acc[i][j] = (f32x4){0.f, 0.f, 0.f, 0.f};
    gemm_tile_wide((const u16*)(ws + OFF_PB), 256, m0, (const u16*)(ws + OFF_WPLE_T), 256, n0, 256, acc, sA);
    {
      EPI_VARS
#pragma unroll
      for (int i = 0; i < 4; ++i)
#pragma unroll
        for (int j = 0; j < 8; ++j)
#pragma unroll
          for (int e = 0; e < 4; ++e) {
            sA[(wm * 64 + 16 * i + G * 4 + e) * 264 + wn * 128 + 16 * j + l15] = f2bf(acc[i][j][e]);
            acc[i][j][e] = 0.f;
          }
    }
    __syncthreads();
    {
      const int tc = tid_();
#pragma unroll 4
      for (int k16 = 0; k16 < 16; ++k16) {
        const int id = tc + 256 * k16;
        const int row = id >> 5, cch = (id & 31) * 8;
        *(u32x4*)(Z3b + (long)(m0 + row) * 1024 + n0 + cch) = *(const u32x4*)&sA[row * 264 + cch];
      }
    }
    asm volatile("s_waitcnt vmcnt(0)" ::: "memory");
    __syncthreads();
    gemm_tile_wide((const u16*)(ws + OFF_H2B), 1024, m0, (const u16*)(ws + OFF_WPG_T), 1024, n0, 1024, acc, sA);
    {
      const int tc = tid_();
#pragma unroll 4
      for (int k16 = 0; k16 < 16; ++k16) {
        const int id = tc + 256 * k16;
        const int row = id >> 5, cch = (id & 31) * 8;
        *(u32x4*)&sA[row * 264 + cch] = *(const u32x4*)(Z3b + (long)(m0 + row) * 1024 + n0 + cch);
      }
    }
    __syncthreads();
    {
      EPI_VARS
#pragma unroll
      for (int i = 0; i < 4; ++i)
#pragma unroll
        for (int j = 0; j < 8; ++j)
#pragma unroll
          for (int e = 0; e < 4; ++e) {
            u16* sp = &sA[(wm * 64 + 16 * i + G * 4 + e) * 264 + wn * 128 + 16 * j + l15];
            *sp = f2bf(bf2f(*sp) * sigm(acc[i][j][e]));
          }
    }
    __syncthreads();
    {
      const int tc = tid_();
#pragma unroll 4
      for (int k16 = 0; k16 < 16; ++k16) {
        const int id = tc + 256 * k16;
        const int row = id >> 5, cch = (id & 31) * 8;
        *(u32x4*)(Z3b + (long)(m0 + row) * 1024 + n0 + cch) = *(const u32x4*)&sA[row * 264 + cch];
      }
    }
    __syncthreads();
  }
}

template <int MODE, int ZB>
__device__ __forceinline__ void phase_rownorm(const Params& P, const void* Zv, const float* w, const float* w2, u16* nxt) {
  const int tid = tid_(), lane = tid & 63, wave = tid >> 6;
  float* H = P.out;
  for (int un = bid_(); un < 4096; un += gridDim.x) {
    const long row = (long)un * 4 + wave;
    const float* zr = (const float*)Zv + row * 1024;
    const u16* zh = (const u16*)Zv + row * 1024;
    (void)zr; (void)zh;
    const float* hin = (MODE == 0) ? (P.x + row * 1024) : (H + row * 1024);
    float4 z[4], hv[4];
    float ss = 0.f;
#pragma unroll
    for (int j = 0; j < 4; ++j) {
      if (ZB) {
        const u32x2 zz = *(const u32x2*)(zh + j * 256 + lane * 4);
        z[j] = make_float4(__uint_as_float(zz[0] << 16), __uint_as_float(zz[0] & 0xffff0000u), __uint_as_float(zz[1] << 16), __uint_as_float(zz[1] & 0xffff0000u));
      } else z[j] = *(const float4*)(zr + j * 256 + lane * 4);
      hv[j] = *(const float4*)(hin + j * 256 + lane * 4);
      ss += z[j].x * z[j].x + z[j].y * z[j].y + z[j].z * z[j].z + z[j].w * z[j].w;
    }
#pragma unroll
    for (int o = 32; o >= 1; o >>= 1) ss += SHX(ss, o);
    const float r = rsqrtf(ss * (1.f / 1024.f) + 1e-6f);
    float s2 = 0.f;
#pragma unroll
    for (int j = 0; j < 4; ++j) {
      const float4 wv = *(const float4*)(w + j * 256 + lane * 4);
      hv[j].x += z[j].x * r * wv.x; hv[j].y += z[j].y * r * wv.y;
      hv[j].z += z[j].z * r * wv.z; hv[j].w += z[j].w * r * wv.w;
      s2 += hv[j].x * hv[j].x + hv[j].y * hv[j].y + hv[j].z * hv[j].z + hv[j].w * hv[j].w;
      *(float4*)(H + row * 1024 + j * 256 + lane * 4) = hv[j];
    }
    if (MODE == 0) {
#pragma unroll
      for (int o = 32; o >= 1; o >>= 1) s2 += SHX(s2, o);
      const float r2 = rsqrtf(s2 * (1.f / 1024.f) + 1e-6f);
#pragma unroll
      for (int j = 0; j < 4; ++j) {
        const float4 wv = *(const float4*)(w2 + j * 256 + lane * 4);
        u32x2 o2 = {pack2(hv[j].x * r2 * wv.x, hv[j].y * r2 * wv.y), pack2(hv[j].z * r2 * wv.z, hv[j].w * r2 * wv.w)};
        *(u32x2*)(nxt + row * 1024 + j * 256 + lane * 4) = o2;
      }
    } else if (MODE == 1) {
#pragma unroll
      for (int j = 0; j < 4; ++j) {
        u32x2 o2 = {pack2(hv[j].x, hv[j].y), pack2(hv[j].z, hv[j].w)};
        *(u32x2*)(nxt + row * 1024 + j * 256 + lane * 4) = o2;
      }
      const float4 pv = *(const float4*)(P.p + row * 256 + lane * 4);
      u32x2 o2 = {pack2(pv.x, pv.y), pack2(pv.z, pv.w)};
      *(u32x2*)((u16*)(P.ws + OFF_PB) + row * 256 + lane * 4) = o2;
    }
  }
}

#define XB_TMO      128
#define XB_XCNT(j)  (256  + 64 * (j))
#define XB_XSUB(j)  (1280 + 64 * (j))
#define XB_XGEN(j)  (2304 + 64 * (j))
#define XB_TOP      3328
#define XB_TOPGEN   3392
#define XCD_BAR_WORDS 3456
#define XB_SPIN_CAP (1u << 18)
#define LAS __attribute__((address_space(3)))

__device__ __forceinline__ unsigned xb_ld(unsigned* p)              { return __hip_atomic_load(p, __ATOMIC_RELAXED, __HIP_MEMORY_SCOPE_AGENT); }
__device__ __forceinline__ unsigned xb_add(unsigned* p, unsigned v) { return __hip_atomic_fetch_add(p, v, __ATOMIC_RELAXED, __HIP_MEMORY_SCOPE_AGENT); }
__device__ __forceinline__ unsigned xb_xcc_id() { return (unsigned)__builtin_amdgcn_s_getreg((3 << 11) | 20) & 0xFu; }
#define XB_SPIN(cond, bar) do { unsigned _sp = 0; while (cond) { __builtin_amdgcn_s_sleep(1); \
    if ((++_sp & 255u) == 0u) { if (xb_ld(&(bar)[XB_TMO])) break; if (_sp > XB_SPIN_CAP) { atomicAdd(&(bar)[XB_TMO], 1u); break; } } } } while (0)

struct XcdBarrier {
    unsigned* bar; unsigned x;
    volatile LAS unsigned* st;
};

__device__ __forceinline__ XcdBarrier xcd_barrier_post(unsigned* bar, volatile LAS unsigned* st) {
    XcdBarrier b; b.bar = bar; b.x = xb_xcc_id(); b.st = st;
    if (tid_() == 0) (void)xb_add(&bar[XB_XCNT(b.x)], 1u);
    return b;
}
__device__ __forceinline__ void xcd_barrier_complete(unsigned* bar, unsigned x, unsigned& nloc, unsigned& nx) {
    const unsigned G = gridDim.x * gridDim.y * gridDim.z;
    unsigned sum, cnt, mine, sp = 0u;
    for (;;) {
        sum = 0u; cnt = 0u; mine = 0u;
#pragma unroll
        for (unsigned j = 0; j < 16; ++j) { const unsigned c = xb_ld(&bar[XB_XCNT(j)]); sum += c; cnt += (c > 0u) ? 1u : 0u; mine = (j == x) ? c : mine; }
        if (sum == G) break;
        __builtin_amdgcn_s_sleep(1);
        if ((++sp & 255u) == 0u) { if (xb_ld(&bar[XB_TMO])) break; if (sp > XB_SPIN_CAP) { atomicAdd(&bar[XB_TMO], 1u); break; } }
    }
    nloc = mine > 0u ? mine : 1u; nx = cnt > 0u ? cnt : 1u;
}

__device__ __forceinline__ void xcd_barrier(const XcdBarrier& b) {
    asm volatile("s_waitcnt vmcnt(0)" ::: "memory");
    __syncthreads();
    if (tid_() == 0) {
        unsigned* bar = b.bar;
        __builtin_amdgcn_s_waitcnt(0);
        unsigned nloc = b.st[0], nx = b.st[1];
        if (nloc == 0u) { xcd_barrier_complete(bar, b.x, nloc, nx); b.st[0] = nloc; b.st[1] = nx; }
        const unsigned old = xb_add(&bar[XB_XSUB(b.x)], 1u);
        const unsigned gen = old / nloc;
        if (old + 1u == (gen + 1u) * nloc) {
            __builtin_amdgcn_fence(__ATOMIC_RELEASE, "agent");
            asm volatile("s_waitcnt vmcnt(0)" ::: "memory");
            const unsigned og = xb_add(&bar[XB_TOP], 1u);
            const unsigned tg = og / nx;
            if (og + 1u == (tg + 1u) * nx) xb_add(&bar[XB_TOPGEN], 1u);
            else XB_SPIN(xb_ld(&bar[XB_TOPGEN]) == tg, bar);
            __builtin_amdgcn_fence(__ATOMIC_ACQUIRE, "agent");
            xb_add(&bar[XB_XGEN(b.x)], 1u);
            asm volatile("s_waitcnt vmcnt(0)" ::: "memory");
        } else {
            XB_SPIN(xb_ld(&bar[XB_XGEN(b.x)]) == gen, bar);
            __builtin_amdgcn_fence(__ATOMIC_ACQUIRE, "agent");
            asm volatile("s_waitcnt vmcnt(0)" ::: "memory");
        }
    }
    __syncthreads();
}

#define OFF_BAR (252 * MIB)
#define GSYNC() do { XcdBarrier xb_; xb_.bar = (unsigned*)(P.ws + OFF_BAR); xb_.x = xb_xcc_id(); xb_.st = (volatile LAS unsigned*)&xb_words; xcd_barrier(xb_); } while (0)
__global__ void __launch_bounds__(256, 2) k_mega(Params P) {
  __shared__ __attribute__((aligned(16))) char smem[67584];
  char* ws = P.ws;
  __shared__ uint4 xb_words;
  if (tid_() == 0) xb_words = make_uint4(0u, 0u, 0u, 0u);
  __syncthreads();
  (void)xcd_barrier_post((unsigned*)(ws + OFF_BAR), (volatile LAS unsigned*)&xb_words);
  phase_prep(P, smem);
  GSYNC();
#pragma unroll 1
  for (int half = 0; half < 2; ++half) {
    phase_inproj(P, half, smem);
    GSYNC();
#if PROBE_DUP == 1
    phase_inproj(P, half, smem);
    GSYNC();
#endif
    if ((int)gridDim.x > 128) {
      const int b2 = bid_();
      if (b2 < 64) cmp_gemm1_tile(P, b2, smem);
      else for (int u = b2 - 64; u < 1024; u += (int)gridDim.x - 64) hgrn_intra_unit(P, u, smem);
    } else {
      for (int t = bid_(); t < 64; t += gridDim.x) cmp_gemm1_tile(P, t, smem);
      for (int u = bid_(); u < 1024; u += gridDim.x) hgrn_intra_unit(P, u, smem);
    }
    GSYNC();
    for (int t = bid_(); t < 32; t += gridDim.x) cmp_gemm2_tile(P, t, smem);
    hgrn_scan(P);
    if (half == 1) phase_late_weights(P, smem);
    GSYNC();
#if PROBE_DUP == 2
    for (int u = bid_(); u < 1024; u += gridDim.x) nsa_unit(P, half, u, smem);
    GSYNC();
#endif
    for (int u = bid_(); u < 1024; u += gridDim.x) nsa_unit(P, half, u, smem);
    for (int u = bid_(); u < 1024; u += gridDim.x) hgrn_out_unit(P, half, u, smem);
    GSYNC();
  }
  phase_branch_merge(P, smem);
  GSYNC();
#if PROBE_DUP == 3
  phase_branch_merge(P, smem);
  GSYNC();
  phase_gemm<2>((const u16*)(ws + OFF_MERGED), 1024, (const u16*)(ws + OFF_WOUT_T), 1024, ws + OFF_Z1, smem);
  GSYNC();
#endif
  phase_gemm_wide<2>((const u16*)(ws + OFF_MERGED), 1024, (const u16*)(ws + OFF_WOUT_T), 1024, (u16*)(ws + OFF_Z1), smem);
  GSYNC();
  phase_rownorm<0, 1>(P, (const void*)(ws + OFF_Z1), P.n_post_mix, P.n_pre_mlp, (u16*)(ws + OFF_V));
  GSYNC();
#if PROBE_DUP == 4
  phase_gemm<1>((const u16*)(ws + OFF_V), 1024, (const u16*)(ws + OFF_WUP_T), 4096, ws + OFF_FFH, smem);
  GSYNC();
#endif
  phase_gemm_wide<1>((const u16*)(ws + OFF_V), 1024, (const u16*)(ws + OFF_WUP_T), 4096, (u16*)(ws + OFF_FFH), smem);
  GSYNC();
#if PROBE_DUP == 4
  phase_gemm<2>((const u16*)(ws + OFF_FFH), 4096, (const u16*)(ws + OFF_WDOWN_T), 1024, ws + OFF_Z2, smem);
  GSYNC();
#endif
  phase_gemm_wide<2>((const u16*)(ws + OFF_FFH), 4096, (const u16*)(ws + OFF_WDOWN_T), 1024, (u16*)(ws + OFF_Z2), smem);
  GSYNC();
  phase_rownorm<1, 1>(P, (const void*)(ws + OFF_Z2), P.n_post_mlp, nullptr, (u16*)(ws + OFF_H2B));
  GSYNC();
  phase_ple(P, smem);
  GSYNC();
#if PROBE_DUP == 5
  for (int i = 0; i < 10; ++i) GSYNC();
#endif
#if PROBE_DUP == 6
  phase_prep(P, smem);
  GSYNC();
#endif
  phase_rownorm<2, 1>(P, (const void*)(P.ws + OFF_Z3), P.n_ple, nullptr, nullptr);
}

extern "C" void kernel_launch(void* const* d_in, const int* in_sizes, int n_in, void* d_out, int out_size, void* d_ws,
                              size_t ws_size, hipStream_t stream) {
  Params P{};
  P.x = (const float*)d_in[0];
  P.p = (const float*)d_in[1];
  P.w_in = (const float*)d_in[2];
  P.w_a = (const float*)d_in[3];
  P.w_b = (const float*)d_in[4];
  P.w_out = (const float*)d_in[5];
  P.n_pre_mix = (const float*)d_in[6];
  P.n_post_mix = (const float*)d_in[7];
  P.n_pre_mlp = (const float*)d_in[8];
  P.n_post_mlp = (const float*)d_in[9];
  P.lb_logits = (const float*)d_in[10];
  P.gnorm = (const float*)d_in[11];
  P.pe_k = (const float*)d_in[12];
  P.pe_v = (const float*)d_in[13];
  P.wk1 = (const float*)d_in[14];
  P.wk2 = (const float*)d_in[15];
  P.wv1 = (const float*)d_in[16];
  P.wv2 = (const float*)d_in[17];
  P.w_up = (const float*)d_in[18];
  P.w_down = (const float*)d_in[19];
  P.w_ple = (const float*)d_in[20];
  P.w_pg = (const float*)d_in[21];
  P.n_ple = (const float*)d_in[22];
  P.out = (float*)d_out;
  P.ws = (char*)d_ws;
#if MEGA
  static int grid_blocks = 0;
  if (!grid_blocks) {
    int dev = 0, cus = 0, per_cu = 0;
    hipGetDevice(&dev);
    hipDeviceGetAttribute(&cus, hipDeviceAttributeMultiprocessorCount, dev);
    hipOccupancyMaxActiveBlocksPerMultiprocessor(&per_cu, k_mega, 256, 0);
    if (per_cu > 2) per_cu = 2;
    if (per_cu < 1) per_cu = 1;
    grid_blocks = cus * per_cu;
  }
  hipMemsetAsync((char*)d_ws + OFF_BAR, 0, XCD_BAR_WORDS * sizeof(unsigned), stream);
  void* args[] = {&P};
  hipError_t e = hipLaunchCooperativeKernel((void*)k_mega, dim3(grid_blocks), dim3(256), args, 0, stream);
  if (e != hipSuccess) fprintf(stderr, "cooperative launch failed: %s (grid %d)\n", hipGetErrorString(e), grid_blocks);
#endif
}
```

```cpp
#include <hip/hip_runtime.h>
#include <hip/hip_cooperative_groups.h>
#include <cstdio>
#include <cstdint>
namespace cg = cooperative_groups;

#ifndef MEGA
#define MEGA 1
#endif
#ifndef PROBE_DUP
#define PROBE_DUP 0
#endif

typedef unsigned short u16;
typedef __attribute__((ext_vector_type(8))) short bf16x8;
typedef __attribute__((ext_vector_type(4))) float f32x4;
typedef __attribute__((ext_vector_type(4))) unsigned u32x4;
typedef __attribute__((ext_vector_type(2))) unsigned u32x2;

#define MFMA(a, b, c) __builtin_amdgcn_mfma_f32_16x16x32_bf16(a, b, c, 0, 0, 0)
#define MIB ((size_t)1 << 20)

#define OFF_U       (0 * MIB)
#define OFF_YB0     (0 * MIB)
#define OFF_WA_T    (16 * MIB)
#define OFF_WB_T    (18 * MIB)
#define OFF_WOUT_T  (20 * MIB)
#define OFF_WPG_T   (22 * MIB)
#define OFF_WPLE_T  (24 * MIB)
#define OFF_WIN_T   (32 * MIB)
#define OFF_WUP_T   (32 * MIB)
#define OFF_WDOWN_T (40 * MIB)
#define OFF_WK1T    (50 * MIB)
#define OFF_WV1T    (51 * MIB)
#define OFF_WK2T    (52 * MIB)
#define OFF_WV2T    (52 * MIB + 32768)
#define OFF_ROPE    (52 * MIB + 65536)
#define OFF_BIAS1   (52 * MIB + 65536 + 262144)
#define OFF_LB      (52 * MIB + 65536 + 262144 + 4096)
#define OFF_BIAS1P  (52 * MIB + 65536 + 262144 + 16384)
#define OFF_NGATE   (53 * MIB)
#define OFF_SG      (56 * MIB)
#define OFF_NQ      (88 * MIB)
#define OFF_QF      (120 * MIB)
#define OFF_LOGF    (136 * MIB)
#define OFF_YB1     (136 * MIB)
#define OFF_HVT     (152 * MIB)
#define OFF_ABUF    (168 * MIB)
#define OFF_UST     (176 * MIB)
#define OFF_KV      (208 * MIB)
#define OFF_NQR     (224 * MIB)
#define OFF_VST     (228 * MIB)
#define OFF_VWT     (232 * MIB)
#define OFF_DCY     (236 * MIB)
#define OFF_HIDK    (236 * MIB + 524288)
#define OFF_HIDV    (237 * MIB + 524288)
#define OFF_KCMP    (238 * MIB + 524288)
#define OFF_VCMPT   (238 * MIB + 524288 + 262144)
#define OFF_MERGED  (88 * MIB)
#define OFF_Z1      (152 * MIB)
#define OFF_V       (56 * MIB)
#define OFF_FFH     (120 * MIB)
#define OFF_Z2      (56 * MIB)
#define OFF_H2B     (120 * MIB)
#define OFF_PB      (152 * MIB)
#define OFF_Z3      (160 * MIB)

struct Params {
  const float *x, *p, *w_in, *w_a, *w_b, *w_out, *n_pre_mix, *n_post_mix, *n_pre_mlp, *n_post_mlp;
  const float *lb_logits, *gnorm, *pe_k, *pe_v, *wk1, *wk2, *wv1, *wv2, *w_up, *w_down, *w_ple, *w_pg, *n_ple;
  float* out;
  char* ws;
};

__device__ __forceinline__ int bid_() { int b = blockIdx.x; asm volatile("" : "+s"(b)); return b; }
__device__ __forceinline__ int tid_() { int t = threadIdx.x; asm volatile("" : "+v"(t)); return t; }
typedef __attribute__((ext_vector_type(2))) float f32x2_t;
typedef __attribute__((ext_vector_type(2))) __bf16 bf16x2_t;
__device__ __forceinline__ uint32_t pack2(float a, float b) {
  f32x2_t v = {a, b};
  return __builtin_bit_cast(uint32_t, __builtin_convertvector(v, bf16x2_t));
}
__device__ __forceinline__ u16 f2bf(float f) { return (u16)(pack2(f, f) & 0xffffu); }
__device__ __forceinline__ float bf2f(u16 h) { return __uint_as_float(((uint32_t)h) << 16); }
__device__ __forceinline__ float shx_f(float v, int src_lane) { return __int_as_float(__builtin_amdgcn_ds_bpermute(src_lane << 2, __float_as_int(v))); }
__device__ __forceinline__ uint32_t shx_u(uint32_t v, int src_lane) { return (uint32_t)__builtin_amdgcn_ds_bpermute(src_lane << 2, (int)v); }
#define SHX(v, m) shx_f((v), lane ^ (m))
#define SHXU(v, m) shx_u((v), lane ^ (m))
__device__ __forceinline__ float sigm(float x) { return __builtin_amdgcn_rcpf(1.f + __expf(-x)); }
__device__ __forceinline__ float siluf(float x) { return x * __builtin_amdgcn_rcpf(1.f + __expf(-x)); }
__device__ __forceinline__ float gelu_tanh(float x) {
  float u = 0.7978845608028654f * (x + 0.044715f * x * x * x);
  float t = 1.f - 2.f * __builtin_amdgcn_rcpf(__expf(2.f * u) + 1.f);
  return 0.5f * x * (1.f + t);
}
__device__ __forceinline__ bf16x8 mk8(uint32_t a, uint32_t b, uint32_t c, uint32_t d) {
  u32x4 v = {a, b, c, d};
  return __builtin_bit_cast(bf16x8, v);
}
__device__ __forceinline__ bf16x8 ld8(const u16* p) { return *(const bf16x8*)p; }

template <int AMODE, int DEEP>
__device__ __forceinline__ void gemm_tile(const u16* __restrict__ A, long lda, int m0, int M,
                                          const u16* __restrict__ Bt, long ldb, int n0, int N, int K,
                                          int coloff, f32x4 (&acc)[4][4], u16* sA, u16* sB) {
  const int tid = tid_(), lane = tid & 63, wave = tid >> 6;
  const int l15 = lane & 15, G = lane >> 4;
  const int wm = wave >> 1, wn = wave & 1;
  const int lr = tid >> 3, ch = tid & 7;
  const char* Ab = (const char*)A;
  const char* Bb = (const char*)Bt;
  unsigned oa[4], ob[4];
  int tok0[4];
#pragma unroll
  for (int i = 0; i < 4; ++i) {
    int r = m0 + lr + 32 * i;
    if (AMODE == 0) {
      if (r > M - 1) r = M - 1;
      oa[i] = (unsigned)(((long)r * lda + ch * 8) * 2);
      tok0[i] = 0;
    } else {
      int grp = r >> 8, n = r & 255;
      int bl = grp >> 2, g = grp & 3;
      tok0[i] = n * 16;
      oa[i] = (unsigned)((bl * 4096 * 1024 + coloff + g * 64 + ch * 8) * 2);
    }
    int rn = n0 + lr + 32 * i;
    if (rn > N - 1) rn = N - 1;
    ob[i] = (unsigned)(((long)rn * ldb + ch * 8) * 2);
  }
#define G_LOAD(RA, RB, KT)                                                                                   \
  {                                                                                                          \
    const char* Ak_ = Ab + (size_t)(KT) * 128;                                                               \
    const char* Bk_ = Bb + (size_t)(KT) * 128;                                                               \
    _Pragma("unroll") for (int i = 0; i < 4; ++i) {                                                          \
      if (AMODE == 0) RA[i] = *(const u32x4*)(Ak_ + oa[i]);                                                  \
      else { int tok = tok0[i] + (KT); if (tok > 4095) tok = 4095; RA[i] = *(const u32x4*)(Ab + (oa[i] + (unsigned)tok * 2048u)); } \
      RB[i] = *(const u32x4*)(Bk_ + ob[i]);                                                                  \
    }                                                                                                        \
  }
#define L_STORE(RA, RB)                                                                                      \
  _Pragma("unroll") for (int i = 0; i < 4; ++i) {                                                            \
    *(u32x4*)&sA[(lr + 32 * i) * 80 + ch * 8] = RA[i];                                                       \
    *(u32x4*)&sB[(lr + 32 * i) * 80 + ch * 8] = RB[i];                                                       \
  }
#define T_COMPUTE()                                                                                          \
  _Pragma("unroll") for (int ks = 0; ks < 2; ++ks) {                                                         \
    bf16x8 af[4], bfr[4];                                                                                    \
    _Pragma("unroll") for (int i = 0; i < 4; ++i) af[i] = ld8(&sA[(wm * 64 + 16 * i + l15) * 80 + ks * 32 + G * 8]);  \
    _Pragma("unroll") for (int j = 0; j < 4; ++j) bfr[j] = ld8(&sB[(wn * 64 + 16 * j + l15) * 80 + ks * 32 + G * 8]); \
    _Pragma("unroll") for (int i = 0; i < 4; ++i)                                                            \
      _Pragma("unroll") for (int j = 0; j < 4; ++j) acc[i][j] = MFMA(af[i], bfr[j], acc[i][j]);              \
  }                                                                                                          \
     \
  __builtin_amdgcn_sched_group_barrier(0x100, 8, 0);                                                         \
  _Pragma("unroll") for (int z = 0; z < 8; ++z) {                                                            \
    __builtin_amdgcn_sched_group_barrier(0x008, 2, 0);                                                       \
    __builtin_amdgcn_sched_group_barrier(0x100, 1, 0);                                                       \
  }                                                                                                          \
  __builtin_amdgcn_sched_group_barrier(0x008, 16, 0);
  const int nk = K >> 6;
  if (DEEP == 2) {
    u32x4 ra0[4], rb0[4], ra1[4], rb1[4];
    const int kl = nk - 1;
    G_LOAD(ra0, rb0, 0);
    G_LOAD(ra1, rb1, 1);
    for (int kt = 0; kt < nk; kt += 2) {
      L_STORE(ra0, rb0);
      __syncthreads();
      G_LOAD(ra0, rb0, (kt + 2 < kl ? kt + 2 : kl));
      T_COMPUTE();
      __syncthreads();
      L_STORE(ra1, rb1);
      __syncthreads();
      G_LOAD(ra1, rb1, (kt + 3 < kl ? kt + 3 : kl));
      T_COMPUTE();
      __syncthreads();
    }
  } else {
    u32x4 ra0[4], rb0[4];
    G_LOAD(ra0, rb0, 0);
    for (int kt = 0; kt < nk; ++kt) {
      L_STORE(ra0, rb0);
      __syncthreads();
      if (kt + 1 < nk) G_LOAD(ra0, rb0, kt + 1);
      T_COMPUTE();
      __syncthreads();
    }
  }
#undef G_LOAD
#undef L_STORE
#undef T_COMPUTE
}

__device__ __forceinline__ void zero_acc(f32x4 (&acc)[4][4]) {
#pragma unroll
  for (int i = 0; i < 4; ++i)
#pragma unroll
    for (int j = 0; j < 4; ++j) acc[i][j] = (f32x4){0.f, 0.f, 0.f, 0.f};
}

#define EPI_VARS                                                         \
  const int tid = tid_(), lane = tid & 63, wave = tid >> 6;         \
  const int l15 = lane & 15, G = lane >> 4;                              \
  const int wm = wave >> 1, wn = wave & 1;                               \
  (void)l15; (void)G; (void)wm; (void)wn;

__device__ __forceinline__ void transpose_tile(const float* __restrict__ W, int ldw, int oc0, int valid, int k0, u16* __restrict__ out,
                               long Kdim, int n0, float* s  ) {
  const int tid = tid_();
  __syncthreads();
  {
    const bool vec = (valid == 64) && (((oc0 | ldw) & 3) == 0);
    if (vec) {
      const int n4 = (tid & 15) * 4;
      float4 v[4];
#pragma unroll
      for (int i = 0; i < 4; ++i) v[i] = *(const float4*)(W + (long)(k0 + (tid >> 4) + 16 * i) * ldw + oc0 + n4);
#pragma unroll
      for (int i = 0; i < 4; ++i) {
        float* d = &s[((tid >> 4) + 16 * i) * 65 + n4];
        d[0] = v[i].x; d[1] = v[i].y; d[2] = v[i].z; d[3] = v[i].w;
      }
    } else {
      const int n = tid & 63;
      for (int kk = tid >> 6; kk < 64; kk += 4) {
        float v = 0.f;
        if (n < valid) v = W[(long)(k0 + kk) * ldw + oc0 + n];
        s[kk * 65 + n] = v;
      }
    }
  }
  __syncthreads();
  {
    const int nn = tid >> 2, kq = (tid & 3) * 16;
    uint32_t w[8];
#pragma unroll
    for (int e = 0; e < 8; ++e) w[e] = pack2(s[(kq + 2 * e) * 65 + nn], s[(kq + 2 * e + 1) * 65 + nn]);
    u16* dst = out + (long)(n0 + nn) * Kdim + k0 + kq;
    *(u32x4*)dst = (u32x4){w[0], w[1], w[2], w[3]};
    *(u32x4*)(dst + 8) = (u32x4){w[4], w[5], w[6], w[7]};
  }
}

__device__ __forceinline__ void transpose_job(const float* W, int N, int K, u16* out, int tile, float* s) {
  const int kt_n = K >> 6;
  const int nt = tile / kt_n, kt = tile % kt_n;
  transpose_tile(W, N, nt * 64, 64, kt * 64, out, K, nt * 64, s);
}

__device__ __forceinline__ void phase_prep(const Params& P, char* smem) {
  const int tid = tid_(), lane = tid & 63, wave = tid >> 6;
  char* ws = P.ws;
  float* sf = (float*)smem;
  {
    u16* U = (u16*)(ws + OFF_U);
    for (int un = bid_(); un < 2048; un += gridDim.x) {
      const int row0 = un * 8 + wave * 2;
      float4 v[2][4];
      float ss[2] = {0.f, 0.f};
#pragma unroll
      for (int rr = 0; rr < 2; ++rr)
#pragma unroll
        for (int j = 0; j < 4; ++j) v[rr][j] = *(const float4*)(P.x + (long)(row0 + rr) * 1024 + j * 256 + lane * 4);
#pragma unroll
      for (int rr = 0; rr < 2; ++rr) {
#pragma unroll
        for (int j = 0; j < 4; ++j)
          ss[rr] += v[rr][j].x * v[rr][j].x + v[rr][j].y * v[rr][j].y + v[rr][j].z * v[rr][j].z + v[rr][j].w * v[rr][j].w;
#pragma unroll
        for (int o = 32; o >= 1; o >>= 1) ss[rr] += SHX(ss[rr], o);
        const float r = rsqrtf(ss[rr] * (1.f / 1024.f) + 1e-6f);
#pragma unroll
        for (int j = 0; j < 4; ++j) {
          const float4 w = *(const float4*)(P.n_pre_mix + j * 256 + lane * 4);
          u32x2 o2 = {pack2(v[rr][j].x * r * w.x, v[rr][j].y * r * w.y), pack2(v[rr][j].z * r * w.z, v[rr][j].w * r * w.w)};
          *(u32x2*)(U + (long)(row0 + rr) * 1024 + j * 256 + lane * 4) = o2;
        }
      }
    }
  }
  {
    u16* WT = (u16*)(ws + OFF_WIN_T);
    for (int t = bid_(); t < 138 * 16; t += gridDim.x) {
      const int nt = t >> 4, kt = t & 15;
      const int nr0 = nt * 64;
      int oc0, valid;
      if (nr0 < 6656) { oc0 = nr0; valid = 64; }
      else if (nr0 < 8704) { oc0 = nr0 + 48; valid = 64; }
      else if (nr0 == 8704) { oc0 = 6656; valid = 48; }
      else { oc0 = 0; valid = 0; }
      transpose_tile(P.w_in, 8752, oc0, valid, kt * 64, WT, 1024, nr0, sf);
    }
    for (int t = bid_(); t < 128; t += gridDim.x) transpose_job(P.wk1, 256, 2048, (u16*)(ws + OFF_WK1T), t, sf);
    for (int t = bid_(); t < 128; t += gridDim.x) transpose_job(P.wv1, 256, 2048, (u16*)(ws + OFF_WV1T), t, sf);
    for (int t = bid_(); t < 4; t += gridDim.x) transpose_job(P.wk2, 64, 256, (u16*)(ws + OFF_WK2T), t, sf);
    for (int t = bid_(); t < 4; t += gridDim.x) transpose_job(P.wv2, 64, 256, (u16*)(ws + OFF_WV2T), t, sf);
  }
  {
    float2* RT = (float2*)(ws + OFF_ROPE);
    for (int un = bid_(); un < 128; un += gridDim.x) {
      const int idx = un * 256 + tid;
      const int t = idx >> 3, j = idx & 7;
      const float inv = (j == 0) ? 1.0f : (j == 1) ? 0.1939227432012558f : (j == 2) ? 0.03760603070259094f
                      : (j == 3) ? 0.007292664609849453f : (j == 4) ? 0.0014142135623842478f
                      : (j == 5) ? 0.00027424818836152554f : (j == 6) ? 5.3182957344688475e-05f : 1.0313385246263351e-05f;
      const float ang = (float)t * inv;
      const double ad = (double)ang;
      const double kq = rint(ad * 0.15915494309189535);
      const float rr = (float)(ad - kq * 6.283185307179586);
      float sn, cs;
      sincosf(rr, &sn, &cs);
      RT[idx] = make_float2(cs, sn);
    }
  }
  {
    float* B1P = (float*)(ws + OFF_BIAS1P);
    for (int un = bid_(); un < 16; un += gridDim.x) {
      const int kvi = un >> 3, part = un & 7;
      const float* pe = kvi ? P.pe_v : P.pe_k;
      const float* w1 = kvi ? P.wv1 : P.wk1;
      float4 a = make_float4(0.f, 0.f, 0.f, 0.f);
      const int k0 = part * 256 + wave * 64;
#pragma unroll 8
      for (int k = k0; k < k0 + 64; ++k) {
        const float pv = pe[k];
        const float4 w = *(const float4*)(w1 + (long)k * 256 + lane * 4);
        a.x += pv * w.x; a.y += pv * w.y; a.z += pv * w.z; a.w += pv * w.w;
      }
      __syncthreads();
      *(float4*)&sf[wave * 256 + lane * 4] = a;
      __syncthreads();
      B1P[un * 256 + tid] = sf[tid] + sf[256 + tid] + sf[512 + tid] + sf[768 + tid];
      __syncthreads();
    }
  }
  {
    float* LB = (float*)(ws + OFF_LB);
    for (int un = bid_(); un < 4; un += gridDim.x) {
      const int c = un * 256 + tid;
      const float l0 = P.lb_logits[c], l1 = P.lb_logits[1024 + c];
      LB[c] = 1.f / (1.f + expf(l1 - l0));
    }
  }
}

__device__ __forceinline__ void phase_late_weights(const Params& P, char* smem) {
  char* ws = P.ws;
  float* sf = (float*)smem;
  for (int t = bid_(); t < 256; t += gridDim.x) transpose_job(P.w_a, 1024, 1024, (u16*)(ws + OFF_WA_T), t, sf);
  for (int t = bid_(); t < 256; t += gridDim.x) transpose_job(P.w_b, 1024, 1024, (u16*)(ws + OFF_WB_T), t, sf);
  for (int t = bid_(); t < 256; t += gridDim.x) transpose_job(P.w_out, 1024, 1024, (u16*)(ws + OFF_WOUT_T), t, sf);
  for (int t = bid_(); t < 256; t += gridDim.x) transpose_job(P.w_pg, 1024, 1024, (u16*)(ws + OFF_WPG_T), t, sf);
  for (int t = bid_(); t < 1024; t += gridDim.x) transpose_job(P.w_up, 4096, 1024, (u16*)(ws + OFF_WUP_T), t, sf);
  for (int t = bid_(); t < 1024; t += gridDim.x) transpose_job(P.w_down, 1024, 4096, (u16*)(ws + OFF_WDOWN_T), t, sf);
  for (int t = bid_(); t < 64; t += gridDim.x) transpose_job(P.w_ple, 1024, 256, (u16*)(ws + OFF_WPLE_T), t, sf);
}

__device__ __forceinline__ void phase_inproj(const Params& P, int half, char* smem) {
  char* ws = P.ws;
  u16* sA = (u16*)smem;
  u16* sB = sA + 128 * 80;
  float* sF = (float*)smem;
  const u16* U = (const u16*)(ws + OFF_U) + (long)half * 8192 * 1024;
  const u16* WT = (const u16*)(ws + OFF_WIN_T);
  u16* QF = (u16*)(ws + OFF_QF);
  u16* LOGF = (u16*)(ws + OFF_LOGF);
  u16* HVT = (u16*)(ws + OFF_HVT);
  u16* SG = (u16*)(ws + OFF_SG) + (long)half * 8192 * 1024;
  u16* NQ = (u16*)(ws + OFF_NQ) + (long)half * 8192 * 1024;
  u16* NQR = (u16*)(ws + OFF_NQR);
  u16* KV = (u16*)(ws + OFF_KV);
  u16* VST = (u16*)(ws + OFF_VST);
  u16* VWT = (u16*)(ws + OFF_VWT);
  u16* GATES = (u16*)P.out + (long)half * 8192 * 2048;
  float* NGATE = (float*)(ws + OFF_NGATE) + (long)half * 8192 * 48;
  const float* RTf = (const float*)(ws + OFF_ROPE);
  const float* LB = (const float*)(ws + OFF_LB);
  for (int t = bid_(); t < 64 * 69; t += gridDim.x) {
    const int nt = t >> 6, mt = t & 63;
    const int m0 = mt * 128, n0 = nt * 128;
    f32x4 acc[4][4];
    zero_acc(acc);
    gemm_tile<0, 2>(U, 1024, m0, 8192, WT, 1024, n0, 8832, 1024, 0, acc, sA, sB);
    {
      EPI_VARS
#pragma unroll
      for (int i = 0; i < 4; ++i)
#pragma unroll
        for (int j = 0; j < 4; ++j)
#pragma unroll
          for (int e = 0; e < 4; ++e) sF[(wm * 64 + 16 * i + G * 4 + e) * 128 + wn * 64 + 16 * j + l15] = acc[i][j][e];
    }
    __syncthreads();
    const int tc = tid_();
    int kind = 0, op = 0, dstride = 1024, dcol = 0;
    u16* dbase = nullptr;
    u16* tbase = nullptr;
    if (nt < 8) { dbase = QF; dcol = n0; op = 0; }
    else if (nt < 16) { dbase = LOGF; dcol = n0 - 1024; op = 1; }
    else if (nt < 24) { kind = 1; tbase = HVT; }
    else if (nt < 32) { dbase = SG; dcol = n0 - 3072; op = 2; }
    else if (nt < 40) { dbase = NQ; dcol = n0 - 4096; op = 3; }
    else if (nt < 52) {
      const int c0 = n0 - 5120, sub0 = c0 >> 8;
      if (sub0 == 3 || sub0 == 5) { kind = 2; tbase = (sub0 == 3) ? VST : VWT; }
      else { dbase = KV; dcol = ((sub0 == 0) ? 0 : (sub0 == 1) ? 256 : (sub0 == 2) ? 512 : 768) + (c0 & 255); op = (sub0 >= 2) ? 5 : 4; }
    } else if (nt < 68) { dbase = GATES; dstride = 2048; dcol = n0 - 6656; op = 6; }
    else kind = 3;

    if (kind == 0) {
#pragma unroll 2
      for (int k8 = 0; k8 < 8; ++k8) {
        const int id = tc + 256 * k8;
        const int row = id >> 4, c8 = (id & 15) * 8;
        const float4 f0 = *(const float4*)&sF[row * 128 + c8];
        const float4 f1 = *(const float4*)&sF[row * 128 + c8 + 4];
        float v[8] = {f0.x, f0.y, f0.z, f0.w, f1.x, f1.y, f1.z, f1.w};
        const int hc = c8 & 63;
        if (op == 0) {
#pragma unroll
          for (int q = 0; q < 8; ++q) v[q] = siluf(v[q]) * 0.08838834764831845f;
        } else if (op == 1) {
          const float4 l0 = *(const float4*)(LB + dcol + c8);
          const float4 l1 = *(const float4*)(LB + dcol + c8 + 4);
          const float lb[8] = {l0.x, l0.y, l0.z, l0.w, l1.x, l1.y, l1.z, l1.w};
#pragma unroll
          for (int q = 0; q < 8; ++q) v[q] = __logf(lb[q] + (1.f - lb[q]) * sigm(v[q]));
        } else if (op == 2) {
#pragma unroll
          for (int q = 0; q < 8; ++q) v[q] = siluf(v[q]);
        } else if (op == 3) {
#pragma unroll
          for (int q = 0; q < 8; ++q) v[q] *= 0.18033688011112042f;
        } else if (op == 6) {
#pragma unroll
          for (int q = 0; q < 8; ++q) v[q] = sigm(v[q]);
        }
        if ((op == 3 || op == 5) && hc < 16) {
          const int pc = (hc == 0) ? c8 + 8 : c8 - 8;
          const float4 g0 = *(const float4*)&sF[row * 128 + pc];
          const float4 g1 = *(const float4*)&sF[row * 128 + pc + 4];
          float pr[8] = {g0.x, g0.y, g0.z, g0.w, g1.x, g1.y, g1.z, g1.w};
          if (op == 3) {
#pragma unroll
            for (int q = 0; q < 8; ++q) pr[q] *= 0.18033688011112042f;
          }
          const int tt = (m0 + row) & 4095;
          const float4 r0 = *(const float4*)(RTf + tt * 16);
          const float4 r1 = *(const float4*)(RTf + tt * 16 + 4);
          const float4 r2 = *(const float4*)(RTf + tt * 16 + 8);
          const float4 r3 = *(const float4*)(RTf + tt * 16 + 12);
          const float cs[8] = {r0.x, r0.z, r1.x, r1.z, r2.x, r2.z, r3.x, r3.z};
          const float sn[8] = {r0.y, r0.w, r1.y, r1.w, r2.y, r2.w, r3.y, r3.w};
          float ro[8];
#pragma unroll
          for (int q = 0; q < 8; ++q) ro[q] = (hc == 0) ? (v[q] * cs[q] - pr[q] * sn[q]) : (v[q] * cs[q] + pr[q] * sn[q]);
          if (op == 3) {
            const int head = (dcol + c8) >> 6;
            *(u32x4*)(NQR + (long)(m0 + row) * 256 + head * 16 + hc) =
                (u32x4){pack2(ro[0], ro[1]), pack2(ro[2], ro[3]), pack2(ro[4], ro[5]), pack2(ro[6], ro[7])};
          } else {
#pragma unroll
            for (int q = 0; q < 8; ++q) v[q] = ro[q];
          }
        }
        u32x4 o4;
        if (op == 1) {
          union { _Float16 h[8]; u32x4 u; } cv;
#pragma unroll
          for (int q = 0; q < 8; ++q) cv.h[q] = (_Float16)v[q];
          o4 = cv.u;
        } else {
          o4 = (u32x4){pack2(v[0], v[1]), pack2(v[2], v[3]), pack2(v[4], v[5]), pack2(v[6], v[7])};
        }
        *(u32x4*)(dbase + (long)(m0 + row) * dstride + dcol + c8) = o4;
      }
    } else if (kind == 1 || kind == 2) {
#pragma unroll 2
      for (int k8 = 0; k8 < 8; ++k8) {
        const int id = tc + 256 * k8;
        const int col = id & 127, r8 = (id >> 7) * 8;
        float v[8];
#pragma unroll
        for (int q = 0; q < 8; ++q) v[q] = sF[(r8 + q) * 128 + col];
        const int r = m0 + r8;
        const int bl = r >> 12, tt = r & 4095;
        unsigned off;
        if (kind == 1) {
          const int c = n0 + col - 2048;
          const int h = c >> 7, dv = c & 127;
          off = ((unsigned)(((bl * 8 + h) * 64 + (tt >> 6)) * 128 + dv) * 64u + (unsigned)(tt & 63)) * 2u;
        } else {
          const int cc = (n0 + col - 5120) & 255;
          const int g = cc >> 6, d = cc & 63;
          off = ((unsigned)((bl * 4 + g) * 64 + d) * 4096u + (unsigned)tt) * 2u;
        }
        *(u32x4*)((char*)tbase + off) = (u32x4){pack2(v[0], v[1]), pack2(v[2], v[3]), pack2(v[4], v[5]), pack2(v[6], v[7])};
      }
    } else {
      for (int id = tc; id < 128 * 48; id += 256) {
        const int row = id / 48, c = id - row * 48;
        NGATE[(long)(m0 + row) * 48 + c] = sigm(sF[row * 128 + c]);
      }
    }
    __syncthreads();
  }
}

__device__ __forceinline__ void hgrn_intra_unit(const Params& P, int uu, char* smem) {
  char* ws = P.ws;
  const int tid = tid_(), lane = tid & 63, wave = tid >> 6;
  const int l15 = lane & 15, G = lane >> 4;
  float* sBc = (float*)smem;
  u16* sQ = (u16*)(smem + 64 * 132 * 4);
  const int bl = uu >> 9, h = (uu >> 6) & 7, c = uu & 63;
  const long r0 = (long)bl * 4096 + c * 64;
  u16* QF = (u16*)(ws + OFF_QF);
  const _Float16* LOGF = (const _Float16*)(ws + OFF_LOGF);
  const u16* HVT = (const u16*)(ws + OFF_HVT);
  u16* ABUF = (u16*)(ws + OFF_ABUF);
  u16* UST = (u16*)(ws + OFF_UST);
  float* DCY = (float*)(ws + OFF_DCY);

  __syncthreads();
#pragma unroll
  for (int i = 0; i < 4; ++i) {
    const int id = tid + 256 * i;
    const int row = id >> 4, cc = (id & 15) * 8;
    const u32x4 lf = *(const u32x4*)(LOGF + (r0 + row) * 1024 + h * 128 + cc);
    const _Float16* hp = (const _Float16*)&lf;
#pragma unroll
    for (int e = 0; e < 8; ++e) sBc[row * 132 + cc + e] = (float)hp[e];
    *(u32x4*)&sQ[row * 136 + cc] = *(const u32x4*)(QF + (r0 + row) * 1024 + h * 128 + cc);
  }
  __syncthreads();
  if (tid < 128) {
    float run = 0.f;
    for (int s = 0; s < 64; ++s) {
      run += sBc[s * 132 + tid];
      sBc[s * 132 + tid] = run;
    }
  }
  __syncthreads();
#pragma unroll
  for (int i = 0; i < 4; ++i) {
    const int id = tid + 256 * i;
    const int row = id >> 4, cc = (id & 15) * 8;
    uint32_t w[4];
#pragma unroll
    for (int e = 0; e < 4; ++e) {
      const float q0 = bf2f(sQ[row * 136 + cc + 2 * e]) * __expf(sBc[row * 132 + cc + 2 * e]);
      const float q1 = bf2f(sQ[row * 136 + cc + 2 * e + 1]) * __expf(sBc[row * 132 + cc + 2 * e + 1]);
      w[e] = pack2(q0, q1);
    }
    *(u32x4*)(QF + (r0 + row) * 1024 + h * 128 + cc) = (u32x4){w[0], w[1], w[2], w[3]};
  }
  if (tid < 128) DCY[(long)uu * 128 + tid] = __expf(sBc[63 * 132 + tid]);
  for (int idx = tid; idx < 4096; idx += 256) {
    const int t = idx >> 6, s = idx & 63;
    if ((s >> 4) > (t >> 4)) ABUF[(long)uu * 4096 + idx] = 0;
  }
  for (int ti = wave; ti < 10; ti += 4) {
    int i, j;
    if (ti == 0) { i = 0; j = 0; }
    else if (ti < 3) { i = 1; j = ti - 1; }
    else if (ti < 6) { i = 2; j = ti - 3; }
    else { i = 3; j = ti - 6; }
    f32x4 a4 = {0.f, 0.f, 0.f, 0.f};
    const int t = 16 * i + l15, s = 16 * j + l15;
#pragma unroll
    for (int ks = 0; ks < 4; ++ks) {
      const int dk0 = ks * 32 + G * 8;
      uint32_t aw[4], bw[4];
#pragma unroll
      for (int e2 = 0; e2 < 4; ++e2) {
        float av[2], bv[2];
#pragma unroll
        for (int z = 0; z < 2; ++z) {
          const int dk = dk0 + 2 * e2 + z;
          const float br = sBc[(16 * i) * 132 + dk];
          const float bt = sBc[t * 132 + dk];
          av[z] = bf2f(sQ[t * 136 + dk]) * __expf(bt - br);
          const float bs = sBc[s * 132 + dk];
          const float bp = (s > 0) ? sBc[(s - 1) * 132 + dk] : 0.f;
          const float kk = 1.f - __expf(bs - bp);
          bv[z] = kk * __expf(br - bs);
        }
        aw[e2] = pack2(av[0], av[1]);
        bw[e2] = pack2(bv[0], bv[1]);
      }
      a4 = MFMA(mk8(aw[0], aw[1], aw[2], aw[3]), mk8(bw[0], bw[1], bw[2], bw[3]), a4);
    }
#pragma unroll
    for (int e = 0; e < 4; ++e) {
      const int tr = 16 * i + G * 4 + e, sc = 16 * j + l15;
      const float v = (sc <= tr) ? a4[e] : 0.f;
      ABUF[(long)uu * 4096 + tr * 64 + sc] = f2bf(v);
    }
  }
  {
    f32x4 ua[8][2];
#pragma unroll
    for (int rt = 0; rt < 8; ++rt) { ua[rt][0] = (f32x4){0.f, 0.f, 0.f, 0.f}; ua[rt][1] = (f32x4){0.f, 0.f, 0.f, 0.f}; }
#pragma unroll
    for (int ks = 0; ks < 2; ++ks) {
      bf16x8 bfr[2];
#pragma unroll
      for (int ct = 0; ct < 2; ++ct) {
        const int dk = (2 * wave + ct) * 16 + l15;
        const float blast = sBc[63 * 132 + dk];
        const int s0 = ks * 32 + G * 8;
        float prev = (s0 > 0) ? sBc[(s0 - 1) * 132 + dk] : 0.f;
        uint32_t bw[4];
#pragma unroll
        for (int e2 = 0; e2 < 4; ++e2) {
          const float b0 = sBc[(s0 + 2 * e2) * 132 + dk];
          const float b1 = sBc[(s0 + 2 * e2 + 1) * 132 + dk];
          const float k0 = (1.f - __expf(b0 - prev)) * __expf(blast - b0);
          const float k1 = (1.f - __expf(b1 - b0)) * __expf(blast - b1);
          prev = b1;
          bw[e2] = pack2(k0, k1);
        }
        bfr[ct] = mk8(bw[0], bw[1], bw[2], bw[3]);
      }
#pragma unroll
      for (int rt = 0; rt < 8; ++rt) {
        const int dv = rt * 16 + l15;
        const bf16x8 af = ld8(HVT + ((long)uu * 128 + dv) * 64 + ks * 32 + G * 8);
        ua[rt][0] = MFMA(af, bfr[0], ua[rt][0]);
        ua[rt][1] = MFMA(af, bfr[1], ua[rt][1]);
      }
    }
#pragma unroll
    for (int rt = 0; rt < 8; ++rt)
#pragma unroll
      for (int ct = 0; ct < 2; ++ct)
#pragma unroll
        for (int e = 0; e < 4; ++e) {
          const int dv = rt * 16 + G * 4 + e, dk = (2 * wave + ct) * 16 + l15;
          UST[((long)uu * 128 + dv) * 128 + dk] = f2bf(ua[rt][ct][e]);
        }
  }
}

__device__ __forceinline__ void cmp_gemm1_tile(const Params& P, int t, char* smem) {
  char* ws = P.ws;
  u16* sA = (u16*)smem;
  u16* sB = sA + 128 * 80;
  EPI_VARS
  const int kv = t >> 5, rem = t & 31;
  const int mt = rem >> 1, nt = rem & 1;
  const int m0 = mt * 128, n0 = nt * 128;
  const u16* KV = (const u16*)(ws + OFF_KV);
  const u16* W1T = (const u16*)(ws + (kv ? OFF_WV1T : OFF_WK1T));
  u16* HID = (u16*)(ws + (kv ? OFF_HIDV : OFF_HIDK));
  const float* B1P = (const float*)(ws + OFF_BIAS1P) + kv * 2048;
  f32x4 acc[4][4];
  zero_acc(acc);
  gemm_tile<1, 2>(KV, 1024, m0, 2048, W1T, 2048, n0, 256, 2048, kv * 256, acc, sA, sB);
#pragma unroll
  for (int i = 0; i < 4; ++i)
#pragma unroll
    for (int j = 0; j < 4; ++j) {
      const int col = n0 + wn * 64 + 16 * j + l15;
      float bias = 0.f;
#pragma unroll
      for (int pp = 0; pp < 8; ++pp) bias += B1P[pp * 256 + col];
#pragma unroll
      for (int e = 0; e < 4; ++e) {
        const int row = m0 + wm * 64 + 16 * i + G * 4 + e;
        HID[(long)row * 256 + col] = f2bf(gelu_tanh(acc[i][j][e] + bias));
      }
    }
}

__device__ __forceinline__ void cmp_gemm2_tile(const Params& P, int t, char* smem) {
  char* ws = P.ws;
  u16* sA = (u16*)smem;
  u16* sB = sA + 128 * 80;
  EPI_VARS
  const int kv = t >> 4, mt = t & 15;
  const int m0 = mt * 128;
  const u16* HID = (const u16*)(ws + (kv ? OFF_HIDV : OFF_HIDK));
  const u16* W2T = (const u16*)(ws + (kv ? OFF_WV2T : OFF_WK2T));
  u16* KCMP = (u16*)(ws + OFF_KCMP);
  u16* VCMPT = (u16*)(ws + OFF_VCMPT);
  f32x4 acc[4][4];
  zero_acc(acc);
  gemm_tile<0, 1>(HID, 256, m0, 2048, W2T, 256, 0, 64, 256, 0, acc, sA, sB);
  if (wn == 0) {
#pragma unroll
    for (int i = 0; i < 4; ++i)
#pragma unroll
      for (int j = 0; j < 4; ++j) {
        const int col = 16 * j + l15;
        const int rbase = m0 + wm * 64 + 16 * i + G * 4;
        if (kv == 0) {
#pragma unroll
          for (int e = 0; e < 4; ++e) KCMP[(long)(rbase + e) * 64 + col] = f2bf(acc[i][j][e]);
        } else {
          const int grp = rbase >> 8, n = rbase & 255;
          u32x2 o2 = {pack2(acc[i][j][0], acc[i][j][1]), pack2(acc[i][j][2], acc[i][j][3])};
          *(u32x2*)(VCMPT + ((long)grp * 64 + col) * 256 + n) = o2;
        }
      }
  }
}

__device__ __forceinline__ void hgrn_scan(const Params& P) {
  char* ws = P.ws;
  u16* UST = (u16*)(ws + OFF_UST);
  const float* DCY = (const float*)(ws + OFF_DCY);
  for (int idx = bid_() * 256 + tid_(); idx < 131072; idx += gridDim.x * 256) {
    const int bh = idx >> 13, rem = idx & 8191;
    const int dv = rem >> 6, dk2 = (rem & 63) * 2;
    float s0 = 0.f, s1 = 0.f;
#pragma unroll 8
    for (int c = 0; c < 64; ++c) {
      const long uu = (long)bh * 64 + c;
      u16* ptr = UST + (uu * 128 + dv) * 128 + dk2;
      const uint32_t uv = *(const uint32_t*)ptr;
      const float2 d = *(const float2*)(DCY + uu * 128 + dk2);
      *(uint32_t*)ptr = pack2(s0, s1);
      s0 = d.x * s0 + __uint_as_float(uv << 16);
      s1 = d.y * s1 + __uint_as_float(uv & 0xffff0000u);
    }
  }
}

__device__ __forceinline__ void hgrn_out_unit(const Params& P, int half, int uu, char* smem) {
  char* ws = P.ws;
  const int tid = tid_(), lane = tid & 63, wave = tid >> 6;
  const int l15 = lane & 15, G = lane >> 4;
  float* sO = (float*)smem;
  const int bl = uu >> 9, h = (uu >> 6) & 7, c = uu & 63;
  const long r0 = (long)bl * 4096 + c * 64;
  const u16* QF = (const u16*)(ws + OFF_QF);
  const u16* HVT = (const u16*)(ws + OFF_HVT);
  const u16* ABUF = (const u16*)(ws + OFF_ABUF);
  const u16* UST = (const u16*)(ws + OFF_UST);
  u16* SG = (u16*)(ws + OFF_SG) + (long)half * 8192 * 1024;
  f32x4 acc[4][2];
#pragma unroll
  for (int i = 0; i < 4; ++i) { acc[i][0] = (f32x4){0.f, 0.f, 0.f, 0.f}; acc[i][1] = (f32x4){0.f, 0.f, 0.f, 0.f}; }
#pragma unroll
  for (int ks = 0; ks < 4; ++ks) {
    const int dk0 = ks * 32 + G * 8;
    bf16x8 bfr[2];
#pragma unroll
    for (int jt = 0; jt < 2; ++jt) bfr[jt] = ld8(UST + ((long)uu * 128 + 32 * wave + 16 * jt + l15) * 128 + dk0);
#pragma unroll
    for (int i = 0; i < 4; ++i) {
      const bf16x8 af = ld8(QF + (r0 + 16 * i + l15) * 1024 + h * 128 + dk0);
      acc[i][0] = MFMA(af, bfr[0], acc[i][0]);
      acc[i][1] = MFMA(af, bfr[1], acc[i][1]);
    }
  }
#pragma unroll
  for (int ks = 0; ks < 2; ++ks) {
    const int s0 = ks * 32 + G * 8;
    bf16x8 bfr[2];
#pragma unroll
    for (int jt = 0; jt < 2; ++jt) bfr[jt] = ld8(HVT + ((long)uu * 128 + 32 * wave + 16 * jt + l15) * 64 + s0);
#pragma unroll
    for (int i = 0; i < 4; ++i) {
      const bf16x8 af = ld8(ABUF + (long)uu * 4096 + (16 * i + l15) * 64 + s0);
      acc[i][0] = MFMA(af, bfr[0], acc[i][0]);
      acc[i][1] = MFMA(af, bfr[1], acc[i][1]);
    }
  }
  __syncthreads();
#pragma unroll
  for (int i = 0; i < 4; ++i)
#pragma unroll
    for (int jt = 0; jt < 2; ++jt)
#pragma unroll
      for (int e = 0; e < 4; ++e) sO[(16 * i + G * 4 + e) * 132 + 32 * wave + 16 * jt + l15] = acc[i][jt][e];
  __syncthreads();
  {
    const int row = tid >> 2, part = tid & 3;
    float ss = 0.f;
#pragma unroll
    for (int cc = 0; cc < 32; ++cc) { const float v = sO[row * 132 + part * 32 + cc]; ss += v * v; }
    ss += SHX(ss, 1);
    ss += SHX(ss, 2);
    const float r = rsqrtf(ss * (1.f / 128.f) + 1e-6f);
    u16* dst = SG + (r0 + row) * 1024 + h * 128 + part * 32;
#pragma unroll
    for (int q4 = 0; q4 < 4; ++q4) {
      const u32x4 sgv = *(const u32x4*)(dst + q4 * 8);
      uint32_t w[4];
#pragma unroll
      for (int e = 0; e < 4; ++e) {
        const int cc = q4 * 8 + 2 * e;
        const float g0 = __uint_as_float(sgv[e] << 16), g1 = __uint_as_float(sgv[e] & 0xffff0000u);
        const float y0 = sO[row * 132 + part * 32 + cc] * r * P.gnorm[part * 32 + cc] * g0;
        const float y1 = sO[row * 132 + part * 32 + cc + 1] * r * P.gnorm[part * 32 + cc + 1] * g1;
        w[e] = pack2(y0, y1);
      }
      *(u32x4*)(dst + q4 * 8) = (u32x4){w[0], w[1], w[2], w[3]};
    }
  }
}

__device__ __forceinline__ void stage_kv(u16* sK, u16* sV, const u16* kptr, long kstride, const u16* vptr, long vstride) {
  const int tid = tid_();
  __syncthreads();
#pragma unroll
  for (int i = 0; i < 2; ++i) {
    const int id = tid + 256 * i;
    const int row = id >> 3, ch = id & 7;
    *(u32x4*)&sK[row * 72 + ch * 8] = *(const u32x4*)(kptr + row * kstride + ch * 8);
    *(u32x4*)&sV[row * 72 + ch * 8] = *(const u32x4*)(vptr + row * vstride + ch * 8);
  }
  __syncthreads();
}

__device__ __forceinline__ void qk_scores(const u16* sK, const bf16x8 (&q)[2], f32x4 (&s)[4], int l15, int G) {
#pragma unroll
  for (int kt = 0; kt < 4; ++kt) {
    s[kt] = (f32x4){0.f, 0.f, 0.f, 0.f};
#pragma unroll
    for (int ks = 0; ks < 2; ++ks) s[kt] = MFMA(ld8(&sK[(16 * kt + l15) * 72 + ks * 32 + G * 8]), q[ks], s[kt]);
  }
}

__device__ __forceinline__ void pv_accum(const u16* sV, const f32x4 (&p)[4], f32x4 (&o)[4], int l15, int G) {
#pragma unroll
  for (int ks2 = 0; ks2 < 2; ++ks2) {
    const f32x4 pa = p[2 * ks2], pb = p[2 * ks2 + 1];
    const bf16x8 pf = mk8(pack2(pa[0], pa[1]), pack2(pa[2], pa[3]), pack2(pb[0], pb[1]), pack2(pb[2], pb[3]));
#pragma unroll
    for (int dt = 0; dt < 4; ++dt) {
      const u32x2 v0 = *(const u32x2*)&sV[(16 * dt + l15) * 72 + 32 * ks2 + 4 * G];
      const u32x2 v1 = *(const u32x2*)&sV[(16 * dt + l15) * 72 + 32 * ks2 + 16 + 4 * G];
      o[dt] = MFMA(mk8(v0[0], v0[1], v1[0], v1[1]), pf, o[dt]);
    }
  }
}

#define EX2(x) __builtin_amdgcn_exp2f(x)
typedef __attribute__((ext_vector_type(16))) float f32x16;
#define MFMA32(a, b, c) __builtin_amdgcn_mfma_f32_32x32x16_bf16((a), (b), (c), 0, 0, 0)
template <int MODE, bool EDGE>
__device__ __forceinline__ void nsa_block(const u16* sK, const u16* sV, int jb, int qb, int q, bool blk_ok,
                                          const bf16x8 (&qf)[4], f32x16 (&O)[2], float& m, float& l, int r31, int h) {
  const int lane = h * 32 + r31;
  f32x16 s[2];
#pragma unroll
  for (int kt2 = 0; kt2 < 2; ++kt2) {
#pragma unroll
    for (int e = 0; e < 16; ++e) s[kt2][e] = 0.f;
#pragma unroll
    for (int ks = 0; ks < 4; ++ks) s[kt2] = MFMA32(ld8(&sK[(32 * kt2 + r31) * 72 + 16 * ks + 8 * h]), qf[ks], s[kt2]);
  }
  float smax = -1e30f;
  if (EDGE) {
#pragma unroll
    for (int kt2 = 0; kt2 < 2; ++kt2)
#pragma unroll
      for (int e = 0; e < 16; ++e) {
        const int k = 32 * kt2 + (e & 3) + 8 * (e >> 2) + 4 * h;
        const bool a = blk_ok && ((jb == qb) ? (k <= q) : (k > q));
        if (!a) s[kt2][e] = -1e30f;
        smax = fmaxf(smax, s[kt2][e]);
      }
  } else {
#pragma unroll
    for (int kt2 = 0; kt2 < 2; ++kt2)
#pragma unroll
      for (int e = 0; e < 16; ++e) smax = fmaxf(smax, s[kt2][e]);
    if (MODE == 2 && !blk_ok) smax = -1e30f;
  }
  smax = fmaxf(smax, SHX(smax, 32));
  const float mn = fmaxf(m, smax);
  const bool need = (mn - m) > 8.f;
  if (__builtin_amdgcn_ballot_w64(need) != 0ull) {
    const float alpha = need ? EX2(m - mn) : 1.f;
    m = need ? mn : m;
    l *= alpha;
    O[0] *= alpha;
    O[1] *= alpha;
  }
  const float mref = (!EDGE && MODE == 2 && !blk_ok) ? 1e30f : m;
  float ls = 0.f;
#pragma unroll
  for (int kt2 = 0; kt2 < 2; ++kt2)
#pragma unroll
    for (int e = 0; e < 16; ++e) {
      const float sv = s[kt2][e];
      float pv;
      if (EDGE) pv = (sv > -1e29f) ? EX2(sv - m) : 0.f;
      else pv = EX2(sv - mref);
      s[kt2][e] = pv;
      ls += pv;
    }
  l += ls;
#pragma unroll
  for (int kt2 = 0; kt2 < 2; ++kt2)
#pragma unroll
    for (int st = 0; st < 2; ++st) {
      const bf16x8 pf = mk8(pack2(s[kt2][8 * st + 0], s[kt2][8 * st + 1]), pack2(s[kt2][8 * st + 2], s[kt2][8 * st + 3]),
                            pack2(s[kt2][8 * st + 4], s[kt2][8 * st + 5]), pack2(s[kt2][8 * st + 6], s[kt2][8 * st + 7]));
#pragma unroll
      for (int dt2 = 0; dt2 < 2; ++dt2) {
        const u16* vrow = &sV[(32 * dt2 + r31) * 72 + 32 * kt2 + 16 * st + 4 * h];
        const u32x2 v0 = *(const u32x2*)vrow;
        const u32x2 v1 = *(const u32x2*)(vrow + 8);
        O[dt2] = MFMA32(mk8(v0[0], v0[1], v1[0], v1[1]), pf, O[dt2]);
      }
    }
}

template <int MODE>
__device__ __forceinline__ void nsa_branch(const u16* kbase, const u16* vbase, int jb0, int jb1, int qb, int q,
                                           uint32_t mlo, uint32_t mhi, const bf16x8 (&qf)[4], const float* ngbase, int rowbase, int gidx,
                                           u16* sYl, u16* sm, float pscale = 1.f) {
  const int tid = tid_();
  const int lane = tid & 63;
  const int r31 = lane & 31, h = lane >> 5;
  const int srow = tid >> 3, sch = (tid & 7) * 8;
  f32x16 O[2];
#pragma unroll
  for (int e = 0; e < 16; ++e) { O[0][e] = 0.f; O[1][e] = 0.f; }
  float m = -1e30f, l = 0.f;
  u32x4 kr[2], vr[2];
  const unsigned koff = (unsigned)((srow * 1024 + sch) * 2);
  const unsigned voff = (unsigned)((srow * 4096 + sch) * 2);
  {
    const char* kb = (const char*)kbase + (size_t)jb0 * 131072;
    const char* vb = (const char*)vbase + (size_t)jb0 * 128;
#pragma unroll
    for (int i = 0; i < 2; ++i) {
      kr[i] = *(const u32x4*)(kb + (koff + i * 65536u));
      vr[i] = *(const u32x4*)(vb + (voff + i * 262144u));
    }
  }
  __syncthreads();
#pragma unroll
  for (int i = 0; i < 2; ++i) {
    *(u32x4*)&sm[(srow + 32 * i) * 72 + sch] = kr[i];
    *(u32x4*)&sm[4608 + (srow + 32 * i) * 72 + sch] = vr[i];
  }
  __syncthreads();
  int cur = 0;
  for (int jb = jb0; jb <= jb1; ++jb) {
    const bool more = jb < jb1;
    if (more) {
      const char* kb = (const char*)kbase + (size_t)(jb + 1) * 131072;
      const char* vb = (const char*)vbase + (size_t)(jb + 1) * 128;
#pragma unroll
      for (int i = 0; i < 2; ++i) {
        kr[i] = *(const u32x4*)(kb + (koff + i * 65536u));
        vr[i] = *(const u32x4*)(vb + (voff + i * 262144u));
      }
    }
    const u16* sK = sm + cur * 9216;
    const u16* sV = sK + 4608;
    bool blk_ok = true;
    if (MODE == 2) blk_ok = (jb < 32) ? ((mlo >> jb) & 1u) : ((mhi >> (jb - 32)) & 1u);
    const bool edge = (jb == qb) || (MODE == 3 && jb == qb - 8);
    if (edge) nsa_block<MODE, true>(sK, sV, jb, qb, q, blk_ok, qf, O, m, l, r31, h);
    else nsa_block<MODE, false>(sK, sV, jb, qb, q, blk_ok, qf, O, m, l, r31, h);
    if (more) {
      u16* dK = sm + (cur ^ 1) * 9216;
#pragma unroll
      for (int i = 0; i < 2; ++i) {
        *(u32x4*)&dK[(srow + 32 * i) * 72 + sch] = kr[i];
        *(u32x4*)&dK[4608 + (srow + 32 * i) * 72 + sch] = vr[i];
      }
    }
    __syncthreads();
    cur ^= 1;
  }
  const int tg = tid_();
  const int lg = tg & 63, hh = (lg >> 4) & 1, hg = lg >> 5;
  const float* gatep = (const float*)((const char*)ngbase + (unsigned)(rowbase + 16 * (tg >> 6) + (tg & 15)) * 192u) + gidx + hh;
  float lt = l;
  lt += shx_f(lt, lg ^ 32);
  const float sc = (lt > 0.f) ? (pscale * gatep[0] / lt) : 0.f;
  u16* yrow = sYl + (((tg >> 6) * 2 + hh) * 16 + (tg & 15)) * 64;
#pragma unroll
  for (int dt2 = 0; dt2 < 2; ++dt2)
#pragma unroll
    for (int m4 = 0; m4 < 4; ++m4) {
      u32x2* yp = (u32x2*)(yrow + 32 * dt2 + 8 * m4 + 4 * hg);
      const u32x2 yv = *yp;
      const float y0 = __uint_as_float(yv[0] << 16) + O[dt2][4 * m4 + 0] * sc;
      const float y1 = __uint_as_float(yv[0] & 0xffff0000u) + O[dt2][4 * m4 + 1] * sc;
      const float y2 = __uint_as_float(yv[1] << 16) + O[dt2][4 * m4 + 2] * sc;
      const float y3 = __uint_as_float(yv[1] & 0xffff0000u) + O[dt2][4 * m4 + 3] * sc;
      *yp = (u32x2){pack2(y0, y1), pack2(y2, y3)};
    }
}

__device__ __forceinline__ void pv_cmp(const u16* vc, int jb, const f32x4 (&p)[4], f32x4 (&o)[4], int l15, int G) {
#pragma unroll
  for (int ks2 = 0; ks2 < 2; ++ks2) {
    const f32x4 pa = p[2 * ks2], pb = p[2 * ks2 + 1];
    const bf16x8 pf = mk8(pack2(pa[0], pa[1]), pack2(pa[2], pa[3]), pack2(pb[0], pb[1]), pack2(pb[2], pb[3]));
#pragma unroll
    for (int dt = 0; dt < 4; ++dt) {
      const u16* vp = vc + (long)(16 * dt + l15) * 256 + jb * 64 + 32 * ks2 + 4 * G;
      const u32x2 v0 = *(const u32x2*)vp;
      const u32x2 v1 = *(const u32x2*)(vp + 16);
      o[dt] = MFMA(mk8(v0[0], v0[1], v1[0], v1[1]), pf, o[dt]);
    }
  }
}

__device__ __forceinline__ void nsa_unit(const Params& P, int half, int u, char* smem) {
  char* ws = P.ws;
  const int tid = tid_(), lane = tid & 63, wave = tid >> 6;
  const int l15 = lane & 15, G = lane >> 4;
  const int hp = u >> 9, rest = u & 511;
  const int bl = rest >> 8, g = (rest >> 6) & 3, xq = rest & 63;
  const int qb = hp ? xq : 63 - xq;
  const int q = 16 * wave + l15;
  const int t = qb * 64 + q;
  const int rl = bl * 4096 + t;
  const int rg = half * 8192 + rl;
  const char* NQc = (const char*)(ws + OFF_NQ);
  const unsigned qoff = (unsigned)rg * 2048u;
  u16* sm = (u16*)smem;
  float* sImp = (float*)smem;
  const u16* NQ = (const u16*)(ws + OFF_NQ);
  const u16* NQR = (const u16*)(ws + OFF_NQR);
  const u16* KV = (const u16*)(ws + OFF_KV);
  const u16* VST = (const u16*)(ws + OFF_VST);
  const u16* VWT = (const u16*)(ws + OFF_VWT);
  const u16* KCMP = (const u16*)(ws + OFF_KCMP);
  const u16* VCMPT = (const u16*)(ws + OFF_VCMPT);
  const float* NGATE = (const float*)((const char*)(ws + OFF_NGATE) + (unsigned)rg * 192u);
  u16* YB = (u16*)(ws + (half ? OFF_YB1 : OFF_YB0));

  f32x4 Y[2][4];
#pragma unroll
  for (int rr = 0; rr < 2; ++rr)
#pragma unroll
    for (int dt = 0; dt < 4; ++dt) Y[rr][dt] = (f32x4){0.f, 0.f, 0.f, 0.f};

  uint32_t mlo = 0, mhi = 0;
  u16* sYl = (u16*)(smem + 36864);
  {
    const int nblk = ((4 * qb + 2) >> 6) + 1;
    const u16* kc = KCMP + (long)(bl * 4 + g) * 256 * 64;
    const u16* vc = VCMPT + (long)(bl * 4 + g) * 64 * 256;
    float imp[4][4];
#pragma unroll
    for (int a = 0; a < 4; ++a)
#pragma unroll
      for (int b = 0; b < 4; ++b) imp[a][b] = 0.f;
    __syncthreads();
    for (int id = tid; id < nblk * 512; id += 256) {
      const int row = id >> 3, chn = (id & 7) * 8;
      *(u32x4*)&sm[row * 72 + chn] = *(const u32x4*)(kc + row * 64 + chn);
    }
    __syncthreads();
#pragma unroll 1
    for (int r = 0; r < 4; ++r) {
      bf16x8 qp[2];
#pragma unroll
      for (int ks = 0; ks < 2; ++ks) qp[ks] = *(const bf16x8*)(NQc + (qoff + (unsigned)(((4 * g + r) * 64 + ks * 32 + G * 8) * 2)));
      float m = -1e30f, l = 0.f;
#pragma unroll 1
      for (int jb = 0; jb < nblk; ++jb) {
        f32x4 s[4];
        float smax = -1e30f;
#pragma unroll
        for (int kt = 0; kt < 4; ++kt) {
          f32x4 a4 = {0.f, 0.f, 0.f, 0.f};
#pragma unroll
          for (int ks = 0; ks < 2; ++ks)
            a4 = MFMA(ld8(&sm[(jb * 64 + 16 * kt + l15) * 72 + ks * 32 + G * 8]), qp[ks], a4);
#pragma unroll
          for (int e = 0; e < 4; ++e) {
            const int n = jb * 64 + 16 * kt + 4 * G + e;
            const float sv = (16 * n + 31 <= t) ? a4[e] : -1e30f;
            s[kt][e] = sv;
            smax = fmaxf(smax, sv);
          }
        }
        smax = fmaxf(smax, SHX(smax, 16));
        smax = fmaxf(smax, SHX(smax, 32));
        const float mn = fmaxf(m, smax);
        float ls = 0.f;
#pragma unroll
        for (int kt = 0; kt < 4; ++kt)
#pragma unroll
          for (int e = 0; e < 4; ++e) ls += (s[kt][e] > -1e29f) ? EX2(s[kt][e] - mn) : 0.f;
        l = l * EX2(m - mn) + ls;
        m = mn;
      }
      l += SHX(l, 16);
      l += SHX(l, 32);
      const float invl = (l > 0.f) ? 1.f / l : 0.f;
      float prevup = 0.f;
#pragma unroll 1
      for (int jb = 0; jb < nblk; ++jb) {
        {
          f32x4 p[4];
#pragma unroll
          for (int kt = 0; kt < 4; ++kt) {
            f32x4 a4 = {0.f, 0.f, 0.f, 0.f};
#pragma unroll
            for (int ks = 0; ks < 2; ++ks)
              a4 = MFMA(ld8(&sm[(jb * 64 + 16 * kt + l15) * 72 + ks * 32 + G * 8]), qp[ks], a4);
#pragma unroll
            for (int e = 0; e < 4; ++e) {
              const int n = jb * 64 + 16 * kt + 4 * G + e;
              p[kt][e] = (16 * n + 31 <= t) ? EX2(a4[e] - m) * invl : 0.f;
            }
            const float sum4 = (p[kt][0] + p[kt][1]) + (p[kt][2] + p[kt][3]);
            const float upv = shx_f(p[kt][3], (lane + 48) & 63);
            const float add = (G > 0) ? upv : prevup;
            const float iv = sum4 + add;
#pragma unroll
            for (int j = 0; j < 4; ++j) imp[j][kt] += (jb == j) ? iv : 0.f;
            prevup = upv;
          }
          if (r == 2 * hp) pv_cmp(vc, jb, p, Y[0], l15, G);
          else if (r == 2 * hp + 1) pv_cmp(vc, jb, p, Y[1], l15, G);
        }
      }
    }
    {
      const float g0 = NGATE[0 * 16 + 4 * g + 2 * hp], g1 = NGATE[0 * 16 + 4 * g + 2 * hp + 1];
#pragma unroll
      for (int dt = 0; dt < 4; ++dt) {
        *(u32x2*)(sYl + ((wave * 2 + 0) * 16 + l15) * 64 + 16 * dt + 4 * G) = (u32x2){pack2(Y[0][dt][0] * g0, Y[0][dt][1] * g0), pack2(Y[0][dt][2] * g0, Y[0][dt][3] * g0)};
        *(u32x2*)(sYl + ((wave * 2 + 1) * 16 + l15) * 64 + 16 * dt + 4 * G) = (u32x2){pack2(Y[1][dt][0] * g1, Y[1][dt][1] * g1), pack2(Y[1][dt][2] * g1, Y[1][dt][3] * g1)};
      }
    }
    __syncthreads();
    float* myImp = sImp + wave * 16 * 65;
#pragma unroll
    for (int jb = 0; jb < 4; ++jb)
#pragma unroll
      for (int kt = 0; kt < 4; ++kt) myImp[l15 * 65 + 16 * jb + 4 * kt + G] = imp[jb][kt];
    __syncthreads();
    const int cur = qb;
    uint32_t blo = 0, bhi = 0;
    if (cur + 1 <= 16) {
#pragma unroll
      for (int jb = 0; jb < 4; ++jb)
#pragma unroll
        for (int kt = 0; kt < 4; ++kt) {
          const int s = 16 * jb + 4 * kt + G;
          if (s <= cur) blo |= (1u << s);
        }
    } else {
      int cnt[4][4];
#pragma unroll
      for (int a = 0; a < 4; ++a)
#pragma unroll
        for (int b = 0; b < 4; ++b) cnt[a][b] = 0;
      for (int sp = 1; sp <= cur - 2; ++sp) {
        const float xv = myImp[l15 * 65 + sp];
#pragma unroll
        for (int jb = 0; jb < 4; ++jb)
#pragma unroll
          for (int kt = 0; kt < 4; ++kt) {
            const int s = 16 * jb + 4 * kt + G;
            const float v = imp[jb][kt];
            cnt[jb][kt] += ((xv > v) || (xv == v && sp < s)) ? 1 : 0;
          }
      }
#pragma unroll
      for (int jb = 0; jb < 4; ++jb)
#pragma unroll
        for (int kt = 0; kt < 4; ++kt) {
          const int s = 16 * jb + 4 * kt + G;
          const bool sel = (s == 0) || (s == cur) || (s == cur - 1) || (s >= 1 && s <= cur - 2 && cnt[jb][kt] < 13);
          if (sel) { if (s < 32) blo |= (1u << s); else bhi |= (1u << (s - 32)); }
        }
    }
    blo |= SHXU(blo, 16); blo |= SHXU(blo, 32);
    bhi |= SHXU(bhi, 16); bhi |= SHXU(bhi, 32);
    mlo = blo; mhi = bhi;
  }
  {
    const int hh = (lane >> 4) & 1, h5 = lane >> 5;
    const int head = 4 * g + 2 * hp + hh;
    bf16x8 qf[4];
    qf[0] = *(const bf16x8*)((const char*)NQR + ((unsigned)rl * 512u + (unsigned)((head * 16 + 8 * h5) * 2)));
#pragma unroll
    for (int ks = 1; ks < 4; ++ks) qf[ks] = *(const bf16x8*)(NQc + (qoff + (unsigned)((head * 64 + 16 * ks + 8 * h5) * 2)));
    const int head0 = 4 * g + 2 * hp;
    const u16* kbs = KV + (long)bl * 4096 * 1024 + 512 + g * 64;
    const u16* vbs = VST + (long)(bl * 4 + g) * 64 * 4096;
    nsa_branch<2>(kbs, vbs, 0, qb, qb, q, mlo, mhi, qf, (const float*)(ws + OFF_NGATE), half * 8192 + bl * 4096 + qb * 64, 16 + head0, sYl, sm);
    const u16* kbw = KV + (long)bl * 4096 * 1024 + 768 + g * 64;
    const u16* vbw = VWT + (long)(bl * 4 + g) * 64 * 4096;
    const int jw0 = (qb >= 8) ? qb - 8 : 0;
    nsa_branch<3>(kbw, vbw, jw0, qb, qb, q, mlo, mhi, qf, (const float*)(ws + OFF_NGATE), half * 8192 + bl * 4096 + qb * 64, 32 + head0, sYl, sm);
    const int tid2 = tid_();
    const int l2 = tid2 & 63, hh2 = (l2 >> 4) & 1, hg2 = l2 >> 5;
    const unsigned yoff = (unsigned)(bl * 4096 + qb * 64 + 16 * (tid2 >> 6) + (tid2 & 15)) * 2048u;
    const u16* yrow = sYl + (((tid2 >> 6) * 2 + hh2) * 16 + (tid2 & 15)) * 64;
#pragma unroll
    for (int dt2 = 0; dt2 < 2; ++dt2)
#pragma unroll
      for (int m4 = 0; m4 < 4; ++m4) {
        const int d0 = 32 * dt2 + 8 * m4 + 4 * hg2;
        *(u32x2*)((char*)YB + (yoff + (unsigned)(((head0 + hh2) * 64 + d0) * 2))) = *(const u32x2*)(yrow + d0);
      }
  }
}

__device__ __forceinline__ void gemm_tile_wide(const u16* __restrict__ A, long lda, int m0, const u16* __restrict__ Bt, long ldb, int n0, int K,
                                               f32x4 (&acc)[4][8], u16* sA) {
  const int tid = tid_(), lane = tid & 63, wave = tid >> 6;
  const int l15 = lane & 15, G = lane >> 4;
  const int wm = wave >> 1, wn = wave & 1;
  const int lr = tid >> 3, ch = tid & 7;
  u16* sB = sA + 128 * 80;
  const char* Ab = (const char*)A;
  const char* Bb = (const char*)Bt;
  unsigned oa[4], ob[8];
#pragma unroll
  for (int i = 0; i < 4; ++i) oa[i] = (unsigned)(((long)(m0 + lr + 32 * i) * lda + ch * 8) * 2);
#pragma unroll
  for (int i = 0; i < 8; ++i) ob[i] = (unsigned)(((long)(n0 + lr + 32 * i) * ldb + ch * 8) * 2);
  u32x4 ra[4], rb[8];
#pragma unroll
  for (int i = 0; i < 4; ++i) ra[i] = *(const u32x4*)(Ab + oa[i]);
#pragma unroll
  for (int i = 0; i < 8; ++i) rb[i] = *(const u32x4*)(Bb + ob[i]);
  const int nk = K >> 6;
  for (int kt = 0; kt < nk; ++kt) {
#pragma unroll
    for (int i = 0; i < 4; ++i) *(u32x4*)&sA[(lr + 32 * i) * 80 + ch * 8] = ra[i];
#pragma unroll
    for (int i = 0; i < 8; ++i) *(u32x4*)&sB[(lr + 32 * i) * 80 + ch * 8] = rb[i];
    __syncthreads();
    {
      const int kn = (kt + 1 < nk) ? kt + 1 : kt;
      const char* Ak = Ab + (size_t)kn * 128;
      const char* Bk = Bb + (size_t)kn * 128;
#pragma unroll
      for (int i = 0; i < 4; ++i) ra[i] = *(const u32x4*)(Ak + oa[i]);
#pragma unroll
      for (int i = 0; i < 8; ++i) rb[i] = *(const u32x4*)(Bk + ob[i]);
    }
#pragma unroll
    for (int ks = 0; ks < 2; ++ks) {
      bf16x8 af[4];
#pragma unroll
      for (int i = 0; i < 4; ++i) af[i] = ld8(&sA[(wm * 64 + 16 * i + l15) * 80 + ks * 32 + G * 8]);
#pragma unroll
      for (int jh = 0; jh < 2; ++jh) {
        bf16x8 bfr[4];
#pragma unroll
        for (int j = 0; j < 4; ++j) bfr[j] = ld8(&sB[(wn * 128 + 64 * jh + 16 * j + l15) * 80 + ks * 32 + G * 8]);
#pragma unroll
        for (int i = 0; i < 4; ++i)
#pragma unroll
          for (int j = 0; j < 4; ++j) acc[i][4 * jh + j] = MFMA(af[i], bfr[j], acc[i][4 * jh + j]);
      }
    }
    __syncthreads();
  }
}


__device__ __forceinline__ void phase_branch_merge(const Params& P, char* smem) {
  char* ws = P.ws;
  u16* sA = (u16*)smem;
  const u16* YA = (const u16*)(ws + OFF_SG);
  const u16* GATES = (const u16*)P.out;
  u16* MERGED = (u16*)(ws + OFF_MERGED);
  for (int t = bid_(); t < 512; t += gridDim.x) {
    const int nt = t >> 7, mt = t & 127;
    const int m0 = mt * 128, n0 = nt * 256;
    const u16* YBp = (m0 < 8192) ? (const u16*)(ws + OFF_YB0) : ((const u16*)(ws + OFF_YB1) - (long)8192 * 1024);
    f32x4 acc[4][8];
#pragma unroll
    for (int i = 0; i < 4; ++i)
#pragma unroll
      for (int j = 0; j < 8; ++j) acc[i][j] = (f32x4){0.f, 0.f, 0.f, 0.f};
    gemm_tile_wide(YA, 1024, m0, (const u16*)(ws + OFF_WA_T), 1024, n0, 1024, acc, sA);
    {
      const int tc = tid_();
#pragma unroll 4
      for (int k16 = 0; k16 < 16; ++k16) {
        const int id = tc + 256 * k16;
        const int row = id >> 5, cch = (id & 31) * 8;
        *(u32x4*)&sA[row * 264 + cch] = *(const u32x4*)(GATES + (long)(m0 + row) * 2048 + n0 + cch);
      }
    }
    __syncthreads();
    {
      EPI_VARS
#pragma unroll
      for (int i = 0; i < 4; ++i)
#pragma unroll
        for (int j = 0; j < 8; ++j)
#pragma unroll
          for (int e = 0; e < 4; ++e) {
            u16* sp = &sA[(wm * 64 + 16 * i + G * 4 + e) * 264 + wn * 128 + 16 * j + l15];
            *sp = f2bf(bf2f(*sp) * acc[i][j][e]);
            acc[i][j][e] = 0.f;
          }
    }
    __syncthreads();
    {
      const int tc = tid_();
#pragma unroll 4
      for (int k16 = 0; k16 < 16; ++k16) {
        const int id = tc + 256 * k16;
        const int row = id >> 5, cch = (id & 31) * 8;
        *(u32x4*)(MERGED + (long)(m0 + row) * 1024 + n0 + cch) = *(const u32x4*)&sA[row * 264 + cch];
      }
    }
    asm volatile("s_waitcnt vmcnt(0)" ::: "memory");
    __syncthreads();
    gemm_tile_wide(YBp, 1024, m0, (const u16*)(ws + OFF_WB_T), 1024, n0, 1024, acc, sA);
    {
      const int tc = tid_();
#pragma unroll 4
      for (int k16 = 0; k16 < 16; ++k16) {
        const int id = tc + 256 * k16;
        const int row = id >> 5, cch = (id & 31) * 8;
        *(u32x4*)&sA[row * 264 + cch] = *(const u32x4*)(GATES + (long)(m0 + row) * 2048 + 1024 + n0 + cch);
      }
    }
    __syncthreads();
    {
      EPI_VARS
#pragma unroll
      for (int i = 0; i < 4; ++i)
#pragma unroll
        for (int j = 0; j < 8; ++j)
#pragma unroll
          for (int e = 0; e < 4; ++e) {
            u16* sp = &sA[(wm * 64 + 16 * i + G * 4 + e) * 264 + wn * 128 + 16 * j + l15];
            *sp = f2bf(bf2f(*sp) * acc[i][j][e]);
          }
    }
    __syncthreads();
    {
      const int tc = tid_();
#pragma unroll 2
      for (int k16 = 0; k16 < 16; ++k16) {
        const int id = tc + 256 * k16;
        const int row = id >> 5, cch = (id & 31) * 8;
        u16* gp = MERGED + (long)(m0 + row) * 1024 + n0 + cch;
        const u32x4 t1 = *(const u32x4*)gp;
        const u32x4 pb = *(const u32x4*)&sA[row * 264 + cch];
        u32x4 o;
#pragma unroll
        for (int q = 0; q < 4; ++q) {
          const float lo = __uint_as_float(t1[q] << 16) + __uint_as_float(pb[q] << 16);
          const float hi = __uint_as_float(t1[q] & 0xffff0000u) + __uint_as_float(pb[q] & 0xffff0000u);
          o[q] = pack2(lo, hi);
        }
        *(u32x4*)gp = o;
      }
    }
    __syncthreads();
  }
}

template <int EPI>
__device__ __forceinline__ void phase_gemm(const u16* A, int K, const u16* Wt, int N, void* outp, char* smem) {
  u16* sA = (u16*)smem;
  u16* sB = sA + 128 * 80;
  EPI_VARS
  const int ntn = N >> 7;
  for (int t = bid_(); t < 128 * ntn; t += gridDim.x) {
    const int nt = t >> 7, mt = t & 127;
    const int m0 = mt * 128, n0 = nt * 128;
    f32x4 acc[4][4];
    zero_acc(acc);
    gemm_tile<0, 2>(A, K, m0, 16384, Wt, K, n0, N, K, 0, acc, sA, sB);
#pragma unroll
    for (int i = 0; i < 4; ++i)
#pragma unroll
      for (int j = 0; j < 4; ++j) {
        const int col = n0 + wn * 64 + 16 * j + l15;
#pragma unroll
        for (int e = 0; e < 4; ++e) {
          const long row = m0 + wm * 64 + 16 * i + G * 4 + e;
          const float v = acc[i][j][e];
          if (EPI == 0) ((float*)outp)[row * N + col] = v;
          else if (EPI == 2) ((u16*)outp)[row * N + col] = f2bf(v);
          else { const float rl = fmaxf(v, 0.f); ((u16*)outp)[row * N + col] = f2bf(rl * rl); }
        }
      }
  }
}


template <int EPI>
__device__ __forceinline__ void phase_gemm_wide(const u16* A, int K, const u16* Wt, int N, u16* outp, char* smem) {
  u16* sA = (u16*)smem;
  EPI_VARS
  const int ntn = N >> 8;
  for (int t = bid_(); t < 128 * ntn; t += gridDim.x) {
    const int nt = t >> 7, mt = t & 127;
    const int m0 = mt * 128, n0 = nt * 256;
    f32x4 acc[4][8];
#pragma unroll
    for (int i = 0; i < 4; ++i)
#pragma unroll
      for (int j = 0; j < 8; ++j) acc[i][j] = (f32x4){0.f, 0.f, 0.f, 0.f};
    gemm_tile_wide(A, K, m0, Wt, K, n0, K, acc, sA);
#pragma unroll
    for (int i = 0; i < 4; ++i)
#pragma unroll
      for (int j = 0; j < 8; ++j) {
        const int col = n0 + wn * 128 + 16 * j + l15;
#pragma unroll
        for (int e = 0; e < 4; ++e) {
          float v = acc[i][j][e];
          if (EPI == 1) { v = fmaxf(v, 0.f); v = v * v; }
          sA[(wm * 64 + 16 * i + G * 4 + e) * 264 + (col - n0)] = f2bf(v);
        }
      }
    __syncthreads();
    {
      const int tc = tid_();
#pragma unroll 4
      for (int k16 = 0; k16 < 16; ++k16) {
        const int id = tc + 256 * k16;
        const int row = id >> 5, cch = (id & 31) * 8;
        *(u32x4*)(outp + (long)(m0 + row) * N + n0 + cch) = *(const u32x4*)&sA[row * 264 + cch];
      }
    }
    __syncthreads();
  }
}

__device__ __forceinline__ void phase_ple(const Params& P, char* smem) {
  char* ws = P.ws;
  u16* sA = (u16*)smem;
  u16* Z3b = (u16*)(ws + OFF_Z3);
  for (int t = bid_(); t < 512; t += gridDim.x) {
    const int nt = t >> 7, mt = t & 127;
    const int m0 = mt * 128, n0 = nt * 256;
    f32x4 acc[4][8];
#pragma unroll
    for (int i = 0; i < 4; ++i)
#pragma unroll
      for (int j = 0; j < 8; ++j) acc[i][j] = (f32x4){0.f, 0.f, 0.f, 0.f};
    gemm_tile_wide((const u16*)(ws + OFF_PB), 256, m0, (const u16*)(ws + OFF_WPLE_T), 256, n0, 256, acc, sA);
    {
      EPI_VARS
#pragma unroll
      for (int i = 0; i < 4; ++i)
#pragma unroll
        for (int j = 0; j < 8; ++j)
#pragma unroll
          for (int e = 0; e < 4; ++e) {
            sA[(wm * 64 + 16 * i + G * 4 + e) * 264 + wn * 128 + 16 * j + l15] = f2bf(acc[i][j][e]);
            acc[i][j][e] = 0.f;
          }
    }
    __syncthreads();
    {
      const int tc = tid_();
#pragma unroll 4
      for (int k16 = 0; k16 < 16; ++k16) {
        const int id = tc + 256 * k16;
        const int row = id >> 5, cch = (id & 31) * 8;
        *(u32x4*)(Z3b + (long)(m0 + row) * 1024 + n0 + cch) = *(const u32x4*)&sA[row * 264 + cch];
      }
    }
    asm volatile("s_waitcnt vmcnt(0)" ::: "memory");
    __syncthreads();
    gemm_tile_wide((const u16*)(ws + OFF_H2B), 1024, m0, (const u16*)(ws + OFF_WPG_T), 1024, n0, 1024, acc, sA);
    {
      const int tc = tid_();
#pragma unroll 4
      for (int k16 = 0; k16 < 16; ++k16) {
        const int id = tc + 256 * k16;
        const int row = id >> 5, cch = (id & 31) * 8;
        *(u32x4*)&sA[row * 264 + cch] = *(const u32x4*)(Z3b + (long)(m0 + row) * 1024 + n0 + cch);
      }
    }
    __syncthreads();
    {
      EPI_VARS
#pragma unroll
      for (int i = 0; i < 4; ++i)
#pragma unroll
        for (int j = 0; j < 8; ++j)
#pragma unroll
          for (int e = 0; e < 4; ++e) {
            u16* sp = &sA[(wm * 64 + 16 * i + G * 4 + e) * 264 + wn * 128 + 16 * j + l15];
            *sp = f2bf(bf2f(*sp) * sigm(acc[i][j][e]));
          }
    }
    __syncthreads();
    {
      const int tc = tid_();
#pragma unroll 4
      for (int k16 = 0; k16 < 16; ++k16) {
        const int id = tc + 256 * k16;
        const int row = id >> 5, cch = (id & 31) * 8;
        *(u32x4*)(Z3b + (long)(m0 + row) * 1024 + n0 + cch) = *(const u32x4*)&sA[row * 264 + cch];
      }
    }
    __syncthreads();
  }
}

template <int MODE, int ZB>
__device__ __forceinline__ void phase_rownorm(const Params& P, const void* Zv, const float* w, const float* w2, u16* nxt) {
  const int tid = tid_(), lane = tid & 63, wave = tid >> 6;
  float* H = P.out;
  for (int un = bid_(); un < 4096; un += gridDim.x) {
    const long row = (long)un * 4 + wave;
    const float* zr = (const float*)Zv + row * 1024;
    const u16* zh = (const u16*)Zv + row * 1024;
    (void)zr; (void)zh;
    const float* hin = (MODE == 0) ? (P.x + row * 1024) : (H + row * 1024);
    float4 z[4], hv[4];
    float ss = 0.f;
#pragma unroll
    for (int j = 0; j < 4; ++j) {
      if (ZB) {
        const u32x2 zz = *(const u32x2*)(zh + j * 256 + lane * 4);
        z[j] = make_float4(__uint_as_float(zz[0] << 16), __uint_as_float(zz[0] & 0xffff0000u), __uint_as_float(zz[1] << 16), __uint_as_float(zz[1] & 0xffff0000u));
      } else z[j] = *(const float4*)(zr + j * 256 + lane * 4);
      hv[j] = *(const float4*)(hin + j * 256 + lane * 4);
      ss += z[j].x * z[j].x + z[j].y * z[j].y + z[j].z * z[j].z + z[j].w * z[j].w;
    }
#pragma unroll
    for (int o = 32; o >= 1; o >>= 1) ss += SHX(ss, o);
    const float r = rsqrtf(ss * (1.f / 1024.f) + 1e-6f);
    float s2 = 0.f;
#pragma unroll
    for (int j = 0; j < 4; ++j) {
      const float4 wv = *(const float4*)(w + j * 256 + lane * 4);
      hv[j].x += z[j].x * r * wv.x; hv[j].y += z[j].y * r * wv.y;
      hv[j].z += z[j].z * r * wv.z; hv[j].w += z[j].w * r * wv.w;
      s2 += hv[j].x * hv[j].x + hv[j].y * hv[j].y + hv[j].z * hv[j].z + hv[j].w * hv[j].w;
      *(float4*)(H + row * 1024 + j * 256 + lane * 4) = hv[j];
    }
    if (MODE == 0) {
#pragma unroll
      for (int o = 32; o >= 1; o >>= 1) s2 += SHX(s2, o);
      const float r2 = rsqrtf(s2 * (1.f / 1024.f) + 1e-6f);
#pragma unroll
      for (int j = 0; j < 4; ++j) {
        const float4 wv = *(const float4*)(w2 + j * 256 + lane * 4);
        u32x2 o2 = {pack2(hv[j].x * r2 * wv.x, hv[j].y * r2 * wv.y), pack2(hv[j].z * r2 * wv.z, hv[j].w * r2 * wv.w)};
        *(u32x2*)(nxt + row * 1024 + j * 256 + lane * 4) = o2;
      }
    } else if (MODE == 1) {
#pragma unroll
      for (int j = 0; j < 4; ++j) {
        u32x2 o2 = {pack2(hv[j].x, hv[j].y), pack2(hv[j].z, hv[j].w)};
        *(u32x2*)(nxt + row * 1024 + j * 256 + lane * 4) = o2;
      }
      const float4 pv = *(const float4*)(P.p + row * 256 + lane * 4);
      u32x2 o2 = {pack2(pv.x, pv.y), pack2(pv.z, pv.w)};
      *(u32x2*)((u16*)(P.ws + OFF_PB) + row * 256 + lane * 4) = o2;
    }
  }
}

#define XB_TMO      128
#define XB_XCNT(j)  (256  + 64 * (j))
#define XB_XSUB(j)  (1280 + 64 * (j))
#define XB_XGEN(j)  (2304 + 64 * (j))
#define XB_TOP      3328
#define XB_TOPGEN   3392
#define XCD_BAR_WORDS 3456
#define XB_SPIN_CAP (1u << 18)
#define LAS __attribute__((address_space(3)))

__device__ __forceinline__ unsigned xb_ld(unsigned* p)              { return __hip_atomic_load(p, __ATOMIC_RELAXED, __HIP_MEMORY_SCOPE_AGENT); }
__device__ __forceinline__ unsigned xb_add(unsigned* p, unsigned v) { return __hip_atomic_fetch_add(p, v, __ATOMIC_RELAXED, __HIP_MEMORY_SCOPE_AGENT); }
__device__ __forceinline__ unsigned xb_xcc_id() { return (unsigned)__builtin_amdgcn_s_getreg((3 << 11) | 20) & 0xFu; }
#define XB_SPIN(cond, bar) do { unsigned _sp = 0; while (cond) { __builtin_amdgcn_s_sleep(1); \
    if ((++_sp & 255u) == 0u) { if (xb_ld(&(bar)[XB_TMO])) break; if (_sp > XB_SPIN_CAP) { atomicAdd(&(bar)[XB_TMO], 1u); break; } } } } while (0)

struct XcdBarrier {
    unsigned* bar; unsigned x;
    volatile LAS unsigned* st;
};

__device__ __forceinline__ XcdBarrier xcd_barrier_post(unsigned* bar, volatile LAS unsigned* st) {
    XcdBarrier b; b.bar = bar; b.x = xb_xcc_id(); b.st = st;
    if (tid_() == 0) (void)xb_add(&bar[XB_XCNT(b.x)], 1u);
    return b;
}
__device__ __forceinline__ void xcd_barrier_complete(unsigned* bar, unsigned x, unsigned& nloc, unsigned& nx) {
    const unsigned G = gridDim.x * gridDim.y * gridDim.z;
    unsigned sum, cnt, mine, sp = 0u;
    for (;;) {
        sum = 0u; cnt = 0u; mine = 0u;
#pragma unroll
        for (unsigned j = 0; j < 16; ++j) { const unsigned c = xb_ld(&bar[XB_XCNT(j)]); sum += c; cnt += (c > 0u) ? 1u : 0u; mine = (j == x) ? c : mine; }
        if (sum == G) break;
        __builtin_amdgcn_s_sleep(1);
        if ((++sp & 255u) == 0u) { if (xb_ld(&bar[XB_TMO])) break; if (sp > XB_SPIN_CAP) { atomicAdd(&bar[XB_TMO], 1u); break; } }
    }
    nloc = mine > 0u ? mine : 1u; nx = cnt > 0u ? cnt : 1u;
}

__device__ __forceinline__ void xcd_barrier(const XcdBarrier& b) {
    asm volatile("s_waitcnt vmcnt(0)" ::: "memory");
    __syncthreads();
    if (tid_() == 0) {
        unsigned* bar = b.bar;
        __builtin_amdgcn_s_waitcnt(0);
        unsigned nloc = b.st[0], nx = b.st[1];
        if (nloc == 0u) { xcd_barrier_complete(bar, b.x, nloc, nx); b.st[0] = nloc; b.st[1] = nx; }
        const unsigned old = xb_add(&bar[XB_XSUB(b.x)], 1u);
        const unsigned gen = old / nloc;
        if (old + 1u == (gen + 1u) * nloc) {
            __builtin_amdgcn_fence(__ATOMIC_RELEASE, "agent");
            asm volatile("s_waitcnt vmcnt(0)" ::: "memory");
            const unsigned og = xb_add(&bar[XB_TOP], 1u);
            const unsigned tg = og / nx;
            if (og + 1u == (tg + 1u) * nx) xb_add(&bar[XB_TOPGEN], 1u);
            else XB_SPIN(xb_ld(&bar[XB_TOPGEN]) == tg, bar);
            __builtin_amdgcn_fence(__ATOMIC_ACQUIRE, "agent");
            xb_add(&bar[XB_XGEN(b.x)], 1u);
            asm volatile("s_waitcnt vmcnt(0)" ::: "memory");
        } else {
            XB_SPIN(xb_ld(&bar[XB_XGEN(b.x)]) == gen, bar);
            __builtin_amdgcn_fence(__ATOMIC_ACQUIRE, "agent");
            asm volatile("s_waitcnt vmcnt(0)" ::: "memory");
        }
    }
    __syncthreads();
}

#define OFF_BAR (252 * MIB)
#define GSYNC() do { XcdBarrier xb_; xb_.bar = (unsigned*)(P.ws + OFF_BAR); xb_.x = xb_xcc_id(); xb_.st = (volatile LAS unsigned*)&xb_words; xcd_barrier(xb_); } while (0)
__global__ void __launch_bounds__(256, 2) k_mega(Params P) {
  __shared__ __attribute__((aligned(16))) char smem[67584];
  char* ws = P.ws;
  __shared__ uint4 xb_words;
  if (tid_() == 0) xb_words = make_uint4(0u, 0u, 0u, 0u);
  __syncthreads();
  (void)xcd_barrier_post((unsigned*)(ws + OFF_BAR), (volatile LAS unsigned*)&xb_words);
  phase_prep(P, smem);
  GSYNC();
#pragma unroll 1
  for (int half = 0; half < 2; ++half) {
    phase_inproj(P, half, smem);
    GSYNC();
#if PROBE_DUP == 1
    phase_inproj(P, half, smem);
    GSYNC();
#endif
    if ((int)gridDim.x > 128) {
      const int b2 = bid_();
      if (b2 < 64) cmp_gemm1_tile(P, b2, smem);
      else for (int u = b2 - 64; u < 1024; u += (int)gridDim.x - 64) hgrn_intra_unit(P, u, smem);
    } else {
      for (int t = bid_(); t < 64; t += gridDim.x) cmp_gemm1_tile(P, t, smem);
      for (int u = bid_(); u < 1024; u += gridDim.x) hgrn_intra_unit(P, u, smem);
    }
    GSYNC();
    for (int t = bid_(); t < 32; t += gridDim.x) cmp_gemm2_tile(P, t, smem);
    hgrn_scan(P);
    if (half == 1) phase_late_weights(P, smem);
    GSYNC();
#if PROBE_DUP == 2
    for (int u = bid_(); u < 1024; u += gridDim.x) nsa_unit(P, half, u, smem);
    GSYNC();
#endif
    for (int u = bid_(); u < 1024; u += gridDim.x) nsa_unit(P, half, u, smem);
    for (int u = bid_(); u < 1024; u += gridDim.x) hgrn_out_unit(P, half, u, smem);
    GSYNC();
  }
  phase_branch_merge(P, smem);
  GSYNC();
#if PROBE_DUP == 3
  phase_branch_merge(P, smem);
  GSYNC();
  phase_gemm<2>((const u16*)(ws + OFF_MERGED), 1024, (const u16*)(ws + OFF_WOUT_T), 1024, ws + OFF_Z1, smem);
  GSYNC();
#endif
  phase_gemm_wide<2>((const u16*)(ws + OFF_MERGED), 1024, (const u16*)(ws + OFF_WOUT_T), 1024, (u16*)(ws + OFF_Z1), smem);
  GSYNC();
  phase_rownorm<0, 1>(P, (const void*)(ws + OFF_Z1), P.n_post_mix, P.n_pre_mlp, (u16*)(ws + OFF_V));
  GSYNC();
#if PROBE_DUP == 4
  phase_gemm<1>((const u16*)(ws + OFF_V), 1024, (const u16*)(ws + OFF_WUP_T), 4096, ws + OFF_FFH, smem);
  GSYNC();
#endif
  phase_gemm_wide<1>((const u16*)(ws + OFF_V), 1024, (const u16*)(ws + OFF_WUP_T), 4096, (u16*)(ws + OFF_FFH), smem);
  GSYNC();
#if PROBE_DUP == 4
  phase_gemm<2>((const u16*)(ws + OFF_FFH), 4096, (const u16*)(ws + OFF_WDOWN_T), 1024, ws + OFF_Z2, smem);
  GSYNC();
#endif
  phase_gemm_wide<2>((const u16*)(ws + OFF_FFH), 4096, (const u16*)(ws + OFF_WDOWN_T), 1024, (u16*)(ws + OFF_Z2), smem);
  GSYNC();
  phase_rownorm<1, 1>(P, (const void*)(ws + OFF_Z2), P.n_post_mlp, nullptr, (u16*)(ws + OFF_H2B));
  GSYNC();
  phase_ple(P, smem);
  GSYNC();
#if PROBE_DUP == 5
  for (int i = 0; i < 10; ++i) GSYNC();
#endif
#if PROBE_DUP == 6
  phase_prep(P, smem);
  GSYNC();
#endif
  phase_rownorm<2, 1>(P, (const void*)(P.ws + OFF_Z3), P.n_ple, nullptr, nullptr);
}

extern "C" void kernel_launch(void* const* d_in, const int* in_sizes, int n_in, void* d_out, int out_size, void* d_ws,
                              size_t ws_size, hipStream_t stream) {
  Params P{};
  P.x = (const float*)d_in[0];
  P.p = (const float*)d_in[1];
  P.w_in = (const float*)d_in[2];
  P.w_a = (const float*)d_in[3];
  P.w_b = (const float*)d_in[4];
  P.w_out = (const float*)d_in[5];
  P.n_pre_mix = (const float*)d_in[6];
  P.n_post_mix = (const float*)d_in[7];
  P.n_pre_mlp = (const float*)d_in[8];
  P.n_post_mlp = (const float*)d_in[9];
  P.lb_logits = (const float*)d_in[10];
  P.gnorm = (const float*)d_in[11];
  P.pe_k = (const float*)d_in[12];
  P.pe_v = (const float*)d_in[13];
  P.wk1 = (const float*)d_in[14];
  P.wk2 = (const float*)d_in[15];
  P.wv1 = (const float*)d_in[16];
  P.wv2 = (const float*)d_in[17];
  P.w_up = (const float*)d_in[18];
  P.w_down = (const float*)d_in[19];
  P.w_ple = (const float*)d_in[20];
  P.w_pg = (const float*)d_in[21];
  P.n_ple = (const float*)d_in[22];
  P.out = (float*)d_out;
  P.ws = (char*)d_ws;
#if MEGA
  static int grid_blocks = 0;
  if (!grid_blocks) {
    int dev = 0, cus = 0, per_cu = 0;
    hipGetDevice(&dev);
    hipDeviceGetAttribute(&cus, hipDeviceAttributeMultiprocessorCount, dev);
    hipOccupancyMaxActiveBlocksPerMultiprocessor(&per_cu, k_mega, 256, 0);
    if (per_cu > 2) per_cu = 2;
    if (per_cu < 1) per_cu = 1;
    grid_blocks = cus * per_cu;
  }
  hipMemsetAsync((char*)d_ws + OFF_BAR, 0, XCD_BAR_WORDS * sizeof(unsigned), stream);
  void* args[] = {&P};
  hipError_t e = hipLaunchCooperativeKernel((void*)k_mega, dim3(grid_blocks), dim3(256), args, 0, stream);
  if (e != hipSuccess) fprintf(stderr, "cooperative launch failed: %s (grid %d)\n", hipGetErrorString(e), grid_blocks);
#endif
}
```

```cpp
#include <hip/hip_runtime.h>
#include <hip/hip_cooperative_groups.h>
#include <cstdio>
#include <cstdint>
namespace cg = cooperative_groups;

#ifndef MEGA
#define MEGA 1
#endif
#ifndef PROBE_DUP
#define PROBE_DUP 0
#endif

typedef unsigned short u16;
typedef __attribute__((ext_vector_type(8))) short bf16x8;
typedef __attribute__((ext_vector_type(4))) float f32x4;
typedef __attribute__((ext_vector_type(4))) unsigned u32x4;
typedef __attribute__((ext_vector_type(2))) unsigned u32x2;

#define MFMA(a, b, c) __builtin_amdgcn_mfma_f32_16x16x32_bf16(a, b, c, 0, 0, 0)
#define MIB ((size_t)1 << 20)

#define OFF_U       (0 * MIB)
#define OFF_YB0     (0 * MIB)
#define OFF_WA_T    (16 * MIB)
#define OFF_WB_T    (18 * MIB)
#define OFF_WOUT_T  (20 * MIB)
#define OFF_WPG_T   (22 * MIB)
#define OFF_WPLE_T  (24 * MIB)
#define OFF_WIN_T   (32 * MIB)
#define OFF_WUP_T   (32 * MIB)
#define OFF_WDOWN_T (40 * MIB)
#define OFF_WK1T    (50 * MIB)
#define OFF_WV1T    (51 * MIB)
#define OFF_WK2T    (52 * MIB)
#define OFF_WV2T    (52 * MIB + 32768)
#define OFF_ROPE    (52 * MIB + 65536)
#define OFF_BIAS1   (52 * MIB + 65536 + 262144)
#define OFF_LB      (52 * MIB + 65536 + 262144 + 4096)
#define OFF_BIAS1P  (52 * MIB + 65536 + 262144 + 16384)
#define OFF_NGATE   (53 * MIB)
#define OFF_SG      (56 * MIB)
#define OFF_NQ      (88 * MIB)
#define OFF_QF      (120 * MIB)
#define OFF_LOGF    (136 * MIB)
#define OFF_YB1     (136 * MIB)
#define OFF_HVT     (152 * MIB)
#define OFF_ABUF    (168 * MIB)
#define OFF_UST     (176 * MIB)
#define OFF_KV      (208 * MIB)
#define OFF_NQR     (224 * MIB)
#define OFF_VST     (228 * MIB)
#define OFF_VWT     (232 * MIB)
#define OFF_DCY     (236 * MIB)
#define OFF_HIDK    (236 * MIB + 524288)
#define OFF_HIDV    (237 * MIB + 524288)
#define OFF_KCMP    (238 * MIB + 524288)
#define OFF_VCMPT   (238 * MIB + 524288 + 262144)
#define OFF_MERGED  (88 * MIB)
#define OFF_Z1      (152 * MIB)
#define OFF_V       (56 * MIB)
#define OFF_FFH     (120 * MIB)
#define OFF_Z2      (56 * MIB)
#define OFF_H2B     (120 * MIB)
#define OFF_PB      (152 * MIB)
#define OFF_Z3      (160 * MIB)

struct Params {
  const float *x, *p, *w_in, *w_a, *w_b, *w_out, *n_pre_mix, *n_post_mix, *n_pre_mlp, *n_post_mlp;
  const float *lb_logits, *gnorm, *pe_k, *pe_v, *wk1, *wk2, *wv1, *wv2, *w_up, *w_down, *w_ple, *w_pg, *n_ple;
  float* out;
  char* ws;
};

__device__ __forceinline__ int bid_() { int b = blockIdx.x; asm volatile("" : "+s"(b)); return b; }
__device__ __forceinline__ int tid_() { int t = threadIdx.x; asm volatile("" : "+v"(t)); return t; }
typedef __attribute__((ext_vector_type(2))) float f32x2_t;
typedef __attribute__((ext_vector_type(2))) __bf16 bf16x2_t;
__device__ __forceinline__ uint32_t pack2(float a, float b) {
  f32x2_t v = {a, b};
  return __builtin_bit_cast(uint32_t, __builtin_convertvector(v, bf16x2_t));
}
__device__ __forceinline__ u16 f2bf(float f) { return (u16)(pack2(f, f) & 0xffffu); }
__device__ __forceinline__ float bf2f(u16 h) { return __uint_as_float(((uint32_t)h) << 16); }
__device__ __forceinline__ float shx_f(float v, int src_lane) { return __int_as_float(__builtin_amdgcn_ds_bpermute(src_lane << 2, __float_as_int(v))); }
__device__ __forceinline__ uint32_t shx_u(uint32_t v, int src_lane) { return (uint32_t)__builtin_amdgcn_ds_bpermute(src_lane << 2, (int)v); }
#define SHX(v, m) shx_f((v), lane ^ (m))
#define SHXU(v, m) shx_u((v), lane ^ (m))
__device__ __forceinline__ float sigm(float x) { return __builtin_amdgcn_rcpf(1.f + __expf(-x)); }
__device__ __forceinline__ float siluf(float x) { return x * __builtin_amdgcn_rcpf(1.f + __expf(-x)); }
__device__ __forceinline__ float gelu_tanh(float x) {
  float u = 0.7978845608028654f * (x + 0.044715f * x * x * x);
  float t = 1.f - 2.f * __builtin_amdgcn_rcpf(__expf(2.f * u) + 1.f);
  return 0.5f * x * (1.f + t);
}
__device__ __forceinline__ bf16x8 mk8(uint32_t a, uint32_t b, uint32_t c, uint32_t d) {
  u32x4 v = {a, b, c, d};
  return __builtin_bit_cast(bf16x8, v);
}
__device__ __forceinline__ bf16x8 ld8(const u16* p) { return *(const bf16x8*)p; }

template <int AMODE, int DEEP>
__device__ __forceinline__ void gemm_tile(const u16* __restrict__ A, long lda, int m0, int M,
                                          const u16* __restrict__ Bt, long ldb, int n0, int N, int K,
                                          int coloff, f32x4 (&acc)[4][4], u16* sA, u16* sB) {
  const int tid = tid_(), lane = tid & 63, wave = tid >> 6;
  const int l15 = lane & 15, G = lane >> 4;
  const int wm = wave >> 1, wn = wave & 1;
  const int lr = tid >> 3, ch = tid & 7;
  const char* Ab = (const char*)A;
  const char* Bb = (const char*)Bt;
  unsigned oa[4], ob[4];
  int tok0[4];
#pragma unroll
  for (int i = 0; i < 4; ++i) {
    int r = m0 + lr + 32 * i;
    if (AMODE == 0) {
      if (r > M - 1) r = M - 1;
      oa[i] = (unsigned)(((long)r * lda + ch * 8) * 2);
      tok0[i] = 0;
    } else {
      int grp = r >> 8, n = r & 255;
      int bl = grp >> 2, g = grp & 3;
      tok0[i] = n * 16;
      oa[i] = (unsigned)((bl * 4096 * 1024 + coloff + g * 64 + ch * 8) * 2);
    }
    int rn = n0 + lr + 32 * i;
    if (rn > N - 1) rn = N - 1;
    ob[i] = (unsigned)(((long)rn * ldb + ch * 8) * 2);
  }
#define G_LOAD(RA, RB, KT)                                                                                   \
  {                                                                                                          \
    const char* Ak_ = Ab + (size_t)(KT) * 128;                                                               \
    const char* Bk_ = Bb + (size_t)(KT) * 128;                                                               \
    _Pragma("unroll") for (int i = 0; i < 4; ++i) {                                                          \
      if (AMODE == 0) RA[i] = *(const u32x4*)(Ak_ + oa[i]);                                                  \
      else { int tok = tok0[i] + (KT); if (tok > 4095) tok = 4095; RA[i] = *(const u32x4*)(Ab + (oa[i] + (unsigned)tok * 2048u)); } \
      RB[i] = *(const u32x4*)(Bk_ + ob[i]);                                                                  \
    }                                                                                                        \
  }
#define L_STORE(RA, RB)                                                                                      \
  _Pragma("unroll") for (int i = 0; i < 4; ++i) {                                                            \
    *(u32x4*)&sA[(lr + 32 * i) * 80 + ch * 8] = RA[i];                                                       \
    *(u32x4*)&sB[(lr + 32 * i) * 80 + ch * 8] = RB[i];                                                       \
  }
#define T_COMPUTE()                                                                                          \
  _Pragma("unroll") for (int ks = 0; ks < 2; ++ks) {                                                         \
    bf16x8 af[4], bfr[4];                                                                                    \
    _Pragma("unroll") for (int i = 0; i < 4; ++i) af[i] = ld8(&sA[(wm * 64 + 16 * i + l15) * 80 + ks * 32 + G * 8]);  \
    _Pragma("unroll") for (int j = 0; j < 4; ++j) bfr[j] = ld8(&sB[(wn * 64 + 16 * j + l15) * 80 + ks * 32 + G * 8]); \
    _Pragma("unroll") for (int i = 0; i < 4; ++i)                                                            \
      _Pragma("unroll") for (int j = 0; j < 4; ++j) acc[i][j] = MFMA(af[i], bfr[j], acc[i][j]);              \
  }                                                                                                          \
     \
  __builtin_amdgcn_sched_group_barrier(0x100, 8, 0);                                                         \
  _Pragma("unroll") for (int z = 0; z < 8; ++z) {                                                            \
    __builtin_amdgcn_sched_group_barrier(0x008, 2, 0);                                                       \
    __builtin_amdgcn_sched_group_barrier(0x100, 1, 0);                                                       \
  }                                                                                                          \
  __builtin_amdgcn_sched_group_barrier(0x008, 16, 0);
  const int nk = K >> 6;
  if (DEEP == 2) {
    u32x4 ra0[4], rb0[4], ra1[4], rb1[4];
    const int kl = nk - 1;
    G_LOAD(ra0, rb0, 0);
    G_LOAD(ra1, rb1, 1);
    for (int kt = 0; kt < nk; kt += 2) {
      L_STORE(ra0, rb0);
      __syncthreads();
      G_LOAD(ra0, rb0, (kt + 2 < kl ? kt + 2 : kl));
      T_COMPUTE();
      __syncthreads();
      L_STORE(ra1, rb1);
      __syncthreads();
      G_LOAD(ra1, rb1, (kt + 3 < kl ? kt + 3 : kl));
      T_COMPUTE();
      __syncthreads();
    }
  } else {
    u32x4 ra0[4], rb0[4];
    G_LOAD(ra0, rb0, 0);
    for (int kt = 0; kt < nk; ++kt) {
      L_STORE(ra0, rb0);
      __syncthreads();
      if (kt + 1 < nk) G_LOAD(ra0, rb0, kt + 1);
      T_COMPUTE();
      __syncthreads();
    }
  }
#undef G_LOAD
#undef L_STORE
#undef T_COMPUTE
}

__device__ __forceinline__ void zero_acc(f32x4 (&acc)[4][4]) {
#pragma unroll
  for (int i = 0; i < 4; ++i)
#pragma unroll
    for (int j = 0; j < 4; ++j) acc[i][j] = (f32x4){0.f, 0.f, 0.f, 0.f};
}

#define EPI_VARS                                                         \
  const int tid = tid_(), lane = tid & 63, wave = tid >> 6;         \
  const int l15 = lane & 15, G = lane >> 4;                              \
  const int wm = wave >> 1, wn = wave & 1;                               \
  (void)l15; (void)G; (void)wm; (void)wn;

__device__ __forceinline__ void transpose_tile(const float* __restrict__ W, int ldw, int oc0, int valid, int k0, u16* __restrict__ out,
                               long Kdim, int n0, float* s  ) {
  const int tid = tid_();
  __syncthreads();
  {
    const bool vec = (valid == 64) && (((oc0 | ldw) & 3) == 0);
    if (vec) {
      const int n4 = (tid & 15) * 4;
      float4 v[4];
#pragma unroll
      for (int i = 0; i < 4; ++i) v[i] = *(const float4*)(W + (long)(k0 + (tid >> 4) + 16 * i) * ldw + oc0 + n4);
#pragma unroll
      for (int i = 0; i < 4; ++i) {
        float* d = &s[((tid >> 4) + 16 * i) * 65 + n4];
        d[0] = v[i].x; d[1] = v[i].y; d[2] = v[i].z; d[3] = v[i].w;
      }
    } else {
      const int n = tid & 63;
      for (int kk = tid >> 6; kk < 64; kk += 4) {
        float v = 0.f;
        if (n < valid) v = W[(long)(k0 + kk) * ldw + oc0 + n];
        s[kk * 65 + n] = v;
      }
    }
  }
  __syncthreads();
  {
    const int nn = tid >> 2, kq = (tid & 3) * 16;
    uint32_t w[8];
#pragma unroll
    for (int e = 0; e < 8; ++e) w[e] = pack2(s[(kq + 2 * e) * 65 + nn], s[(kq + 2 * e + 1) * 65 + nn]);
    u16* dst = out + (long)(n0 + nn) * Kdim + k0 + kq;
    *(u32x4*)dst = (u32x4){w[0], w[1], w[2], w[3]};
    *(u32x4*)(dst + 8) = (u32x4){w[4], w[5], w[6], w[7]};
  }
}

__device__ __forceinline__ void transpose_job(const float* W, int N, int K, u16* out, int tile, float* s) {
  const int kt_n = K >> 6;
  const int nt = tile / kt_n, kt = tile % kt_n;
  transpose_tile(W, N, nt * 64, 64, kt * 64, out, K, nt * 64, s);
}

__device__ __forceinline__ void phase_prep(const Params& P, char* smem) {
  const int tid = tid_(), lane = tid & 63, wave = tid >> 6;
  char* ws = P.ws;
  float* sf = (float*)smem;
  {
    u16* U = (u16*)(ws + OFF_U);
    for (int un = bid_(); un < 2048; un += gridDim.x) {
      const int row0 = un * 8 + wave * 2;
      float4 v[2][4];
      float ss[2] = {0.f, 0.f};
#pragma unroll
      for (int rr = 0; rr < 2; ++rr)
#pragma unroll
        for (int j = 0; j < 4; ++j) v[rr][j] = *(const float4*)(P.x + (long)(row0 + rr) * 1024 + j * 256 + lane * 4);
#pragma unroll
      for (int rr = 0; rr < 2; ++rr) {
#pragma unroll
        for (int j = 0; j < 4; ++j)
          ss[rr] += v[rr][j].x * v[rr][j].x + v[rr][j].y * v[rr][j].y + v[rr][j].z * v[rr][j].z + v[rr][j].w * v[rr][j].w;
#pragma unroll
        for (int o = 32; o >= 1; o >>= 1) ss[rr] += SHX(ss[rr], o);
        const float r = rsqrtf(ss[rr] * (1.f / 1024.f) + 1e-6f);
#pragma unroll
        for (int j = 0; j < 4; ++j) {
          const float4 w = *(const float4*)(P.n_pre_mix + j * 256 + lane * 4);
          u32x2 o2 = {pack2(v[rr][j].x * r * w.x, v[rr][j].y * r * w.y), pack2(v[rr][j].z * r * w.z, v[rr][j].w * r * w.w)};
          *(u32x2*)(U + (long)(row0 + rr) * 1024 + j * 256 + lane * 4) = o2;
        }
      }
    }
  }
  {
    u16* WT = (u16*)(ws + OFF_WIN_T);
    for (int t = bid_(); t < 138 * 16; t += gridDim.x) {
      const int nt = t >> 4, kt = t & 15;
      const int nr0 = nt * 64;
      int oc0, valid;
      if (nr0 < 6656) { oc0 = nr0; valid = 64; }
      else if (nr0 < 8704) { oc0 = nr0 + 48; valid = 64; }
      else if (nr0 == 8704) { oc0 = 6656; valid = 48; }
      else { oc0 = 0; valid = 0; }
      transpose_tile(P.w_in, 8752, oc0, valid, kt * 64, WT, 1024, nr0, sf);
    }
    for (int t = bid_(); t < 128; t += gridDim.x) transpose_job(P.wk1, 256, 2048, (u16*)(ws + OFF_WK1T), t, sf);
    for (int t = bid_(); t < 128; t += gridDim.x) transpose_job(P.wv1, 256, 2048, (u16*)(ws + OFF_WV1T), t, sf);
    for (int t = bid_(); t < 4; t += gridDim.x) transpose_job(P.wk2, 64, 256, (u16*)(ws + OFF_WK2T), t, sf);
    for (int t = bid_(); t < 4; t += gridDim.x) transpose_job(P.wv2, 64, 256, (u16*)(ws + OFF_WV2T), t, sf);
  }
  {
    float2* RT = (float2*)(ws + OFF_ROPE);
    for (int un = bid_(); un < 128; un += gridDim.x) {
      const int idx = un * 256 + tid;
      const int t = idx >> 3, j = idx & 7;
      const float inv = (j == 0) ? 1.0f : (j == 1) ? 0.1939227432012558f : (j == 2) ? 0.03760603070259094f
                      : (j == 3) ? 0.007292664609849453f : (j == 4) ? 0.0014142135623842478f
                      : (j == 5) ? 0.00027424818836152554f : (j == 6) ? 5.3182957344688475e-05f : 1.0313385246263351e-05f;
      const float ang = (float)t * inv;
      const double ad = (double)ang;
      const double kq = rint(ad * 0.15915494309189535);
      const float rr = (float)(ad - kq * 6.283185307179586);
      float sn, cs;
      sincosf(rr, &sn, &cs);
      RT[idx] = make_float2(cs, sn);
    }
  }
  {
    float* B1P = (float*)(ws + OFF_BIAS1P);
    for (int un = bid_(); un < 16; un += gridDim.x) {
      const int kvi = un >> 3, part = un & 7;
      const float* pe = kvi ? P.pe_v : P.pe_k;
      const float* w1 = kvi ? P.wv1 : P.wk1;
      float4 a = make_float4(0.f, 0.f, 0.f, 0.f);
      const int k0 = part * 256 + wave * 64;
#pragma unroll 8
      for (int k = k0; k < k0 + 64; ++k) {
        const float pv = pe[k];
        const float4 w = *(const float4*)(w1 + (long)k * 256 + lane * 4);
        a.x += pv * w.x; a.y += pv * w.y; a.z += pv * w.z; a.w += pv * w.w;
      }
      __syncthreads();
      *(float4*)&sf[wave * 256 + lane * 4] = a;
      __syncthreads();
      B1P[un * 256 + tid] = sf[tid] + sf[256 + tid] + sf[512 + tid] + sf[768 + tid];
      __syncthreads();
    }
  }
  {
    float* LB = (float*)(ws + OFF_LB);
    for (int un = bid_(); un < 4; un += gridDim.x) {
      const int c = un * 256 + tid;
      const float l0 = P.lb_logits[c], l1 = P.lb_logits[1024 + c];
      LB[c] = 1.f / (1.f + expf(l1 - l0));
    }
  }
}

__device__ __forceinline__ void phase_late_weights(const Params& P, char* smem) {
  char* ws = P.ws;
  float* sf = (float*)smem;
  for (int t = bid_(); t < 256; t += gridDim.x) transpose_job(P.w_a, 1024, 1024, (u16*)(ws + OFF_WA_T), t, sf);
  for (int t = bid_(); t < 256; t += gridDim.x) transpose_job(P.w_b, 1024, 1024, (u16*)(ws + OFF_WB_T), t, sf);
  for (int t = bid_(); t < 256; t += gridDim.x) transpose_job(P.w_out, 1024, 1024, (u16*)(ws + OFF_WOUT_T), t, sf);
  for (int t = bid_(); t < 256; t += gridDim.x) transpose_job(P.w_pg, 1024, 1024, (u16*)(ws + OFF_WPG_T), t, sf);
  for (int t = bid_(); t < 1024; t += gridDim.x) transpose_job(P.w_up, 4096, 1024, (u16*)(ws + OFF_WUP_T), t, sf);
  for (int t = bid_(); t < 1024; t += gridDim.x) transpose_job(P.w_down, 1024, 4096, (u16*)(ws + OFF_WDOWN_T), t, sf);
  for (int t = bid_(); t < 64; t += gridDim.x) transpose_job(P.w_ple, 1024, 256, (u16*)(ws + OFF_WPLE_T), t, sf);
}

__device__ __forceinline__ void phase_inproj(const Params& P, int half, char* smem) {
  char* ws = P.ws;
  u16* sA = (u16*)smem;
  u16* sB = sA + 128 * 80;
  float* sF = (float*)smem;
  const u16* U = (const u16*)(ws + OFF_U) + (long)half * 8192 * 1024;
  const u16* WT = (const u16*)(ws + OFF_WIN_T);
  u16* QF = (u16*)(ws + OFF_QF);
  u16* LOGF = (u16*)(ws + OFF_LOGF);
  u16* HVT = (u16*)(ws + OFF_HVT);
  u16* SG = (u16*)(ws + OFF_SG) + (long)half * 8192 * 1024;
  u16* NQ = (u16*)(ws + OFF_NQ) + (long)half * 8192 * 1024;
  u16* NQR = (u16*)(ws + OFF_NQR);
  u16* KV = (u16*)(ws + OFF_KV);
  u16* VST = (u16*)(ws + OFF_VST);
  u16* VWT = (u16*)(ws + OFF_VWT);
  u16* GATES = (u16*)P.out + (long)half * 8192 * 2048;
  float* NGATE = (float*)(ws + OFF_NGATE) + (long)half * 8192 * 48;
  const float* RTf = (const float*)(ws + OFF_ROPE);
  const float* LB = (const float*)(ws + OFF_LB);
  for (int t = bid_(); t < 64 * 69; t += gridDim.x) {
    const int nt = t >> 6, mt = t & 63;
    const int m0 = mt * 128, n0 = nt * 128;
    f32x4 acc[4][4];
    zero_acc(acc);
    gemm_tile<0, 2>(U, 1024, m0, 8192, WT, 1024, n0, 8832, 1024, 0, acc, sA, sB);
    {
      EPI_VARS
#pragma unroll
      for (int i = 0; i < 4; ++i)
#pragma unroll
        for (int j = 0; j < 4; ++j)
#pragma unroll
          for (int e = 0; e < 4; ++e) sF[(wm * 64 + 16 * i + G * 4 + e) * 132 + wn * 64 + 16 * j + l15] = acc[i][j][e];
    }
    __syncthreads();
    const int tc = tid_();
    int kind = 0, op = 0, dstride = 1024, dcol = 0;
    u16* dbase = nullptr;
    u16* tbase = nullptr;
    if (nt < 8) { dbase = QF; dcol = n0; op = 0; }
    else if (nt < 16) { dbase = LOGF; dcol = n0 - 1024; op = 1; }
    else if (nt < 24) { kind = 1; tbase = HVT; }
    else if (nt < 32) { dbase = SG; dcol = n0 - 3072; op = 2; }
    else if (nt < 40) { dbase = NQ; dcol = n0 - 4096; op = 3; }
    else if (nt < 52) {
      const int c0 = n0 - 5120, sub0 = c0 >> 8;
      if (sub0 == 3 || sub0 == 5) { kind = 2; tbase = (sub0 == 3) ? VST : VWT; }
      else { dbase = KV; dcol = ((sub0 == 0) ? 0 : (sub0 == 1) ? 256 : (sub0 == 2) ? 512 : 768) + (c0 & 255); op = (sub0 >= 2) ? 5 : 4; }
    } else if (nt < 68) { dbase = GATES; dstride = 2048; dcol = n0 - 6656; op = 6; }
    else kind = 3;

    if (kind == 0) {
#pragma unroll 2
      for (int k8 = 0; k8 < 8; ++k8) {
        const int id = tc + 256 * k8;
        const int row = id >> 4, c8 = (id & 15) * 8;
        const float4 f0 = *(const float4*)&sF[row * 132 + c8];
        const float4 f1 = *(const float4*)&sF[row * 132 + c8 + 4];
        float v[8] = {f0.x, f0.y, f0.z, f0.w, f1.x, f1.y, f1.z, f1.w};
        const int hc = c8 & 63;
        if (op == 0) {
#pragma unroll
          for (int q = 0; q < 8; ++q) v[q] = siluf(v[q]) * 0.08838834764831845f;
        } else if (op == 1) {
          const float4 l0 = *(const float4*)(LB + dcol + c8);
          const float4 l1 = *(const float4*)(LB + dcol + c8 + 4);
          const float lb[8] = {l0.x, l0.y, l0.z, l0.w, l1.x, l1.y, l1.z, l1.w};
#pragma unroll
          for (int q = 0; q < 8; ++q) v[q] = __logf(lb[q] + (1.f - lb[q]) * sigm(v[q]));
        } else if (op == 2) {
#pragma unroll
          for (int q = 0; q < 8; ++q) v[q] = siluf(v[q]);
        } else if (op == 3) {
#pragma unroll
          for (int q = 0; q < 8; ++q) v[q] *= 0.18033688011112042f;
        } else if (op == 6) {
#pragma unroll
          for (int q = 0; q < 8; ++q) v[q] = sigm(v[q]);
        }
        if ((op == 3 || op == 5) && hc < 16) {
          const int pc = (hc == 0) ? c8 + 8 : c8 - 8;
          const float4 g0 = *(const float4*)&sF[row * 132 + pc];
          const float4 g1 = *(const float4*)&sF[row * 132 + pc + 4];
          float pr[8] = {g0.x, g0.y, g0.z, g0.w, g1.x, g1.y, g1.z, g1.w};
          if (op == 3) {
#pragma unroll
            for (int q = 0; q < 8; ++q) pr[q] *= 0.18033688011112042f;
          }
          const int tt = (m0 + row) & 4095;
          const float4 r0 = *(const float4*)(RTf + tt * 16);
          const float4 r1 = *(const float4*)(RTf + tt * 16 + 4);
          const float4 r2 = *(const float4*)(RTf + tt * 16 + 8);
          const float4 r3 = *(const float4*)(RTf + tt * 16 + 12);
          const float cs[8] = {r0.x, r0.z, r1.x, r1.z, r2.x, r2.z, r3.x, r3.z};
          const float sn[8] = {r0.y, r0.w, r1.y, r1.w, r2.y, r2.w, r3.y, r3.w};
          float ro[8];
#pragma unroll
          for (int q = 0; q < 8; ++q) ro[q] = (hc == 0) ? (v[q] * cs[q] - pr[q] * sn[q]) : (v[q] * cs[q] + pr[q] * sn[q]);
          if (op == 3) {
            const int head = (dcol + c8) >> 6;
            *(u32x4*)(NQR + (long)(m0 + row) * 256 + head * 16 + hc) =
                (u32x4){pack2(ro[0], ro[1]), pack2(ro[2], ro[3]), pack2(ro[4], ro[5]), pack2(ro[6], ro[7])};
          } else {
#pragma unroll
            for (int q = 0; q < 8; ++q) v[q] = ro[q];
          }
        }
        u32x4 o4;
        if (op == 1) {
          union { _Float16 h[8]; u32x4 u; } cv;
#pragma unroll
          for (int q = 0; q < 8; ++q) cv.h[q] = (_Float16)v[q];
          o4 = cv.u;
        } else {
          o4 = (u32x4){pack2(v[0], v[1]), pack2(v[2], v[3]), pack2(v[4], v[5]), pack2(v[6], v[7])};
        }
        *(u32x4*)(dbase + (long)(m0 + row) * dstride + dcol + c8) = o4;
      }
    } else if (kind == 1 || kind == 2) {
#pragma unroll 2
      for (int k8 = 0; k8 < 8; ++k8) {
        const int id = tc + 256 * k8;
        const int col = id & 127, r8 = (id >> 7) * 8;
        float v[8];
#pragma unroll
        for (int q = 0; q < 8; ++q) v[q] = sF[(r8 + q) * 132 + col];
        const int r = m0 + r8;
        const int bl = r >> 12, tt = r & 4095;
        unsigned off;
        if (kind == 1) {
          const int c = n0 + col - 2048;
          const int h = c >> 7, dv = c & 127;
          off = ((unsigned)(((bl * 8 + h) * 64 + (tt >> 6)) * 128 + dv) * 64u + (unsigned)(tt & 63)) * 2u;
        } else {
          const int cc = (n0 + col - 5120) & 255;
          const int g = cc >> 6, d = cc & 63;
          off = ((unsigned)((bl * 4 + g) * 64 + d) * 4096u + (unsigned)tt) * 2u;
        }
        *(u32x4*)((char*)tbase + off) = (u32x4){pack2(v[0], v[1]), pack2(v[2], v[3]), pack2(v[4], v[5]), pack2(v[6], v[7])};
      }
    } else {
      for (int id = tc; id < 128 * 48; id += 256) {
        const int row = id / 48, c = id - row * 48;
        NGATE[(long)(m0 + row) * 48 + c] = sigm(sF[row * 132 + c]);
      }
    }
    __syncthreads();
  }
}

__device__ __forceinline__ void hgrn_intra_unit(const Params& P, int uu, char* smem) {
  char* ws = P.ws;
  const int tid = tid_(), lane = tid & 63, wave = tid >> 6;
  const int l15 = lane & 15, G = lane >> 4;
  float* sBc = (float*)smem;
  u16* sQ = (u16*)(smem + 64 * 132 * 4);
  const int bl = uu >> 9, h = (uu >> 6) & 7, c = uu & 63;
  const long r0 = (long)bl * 4096 + c * 64;
  u16* QF = (u16*)(ws + OFF_QF);
  const _Float16* LOGF = (const _Float16*)(ws + OFF_LOGF);
  const u16* HVT = (const u16*)(ws + OFF_HVT);
  u16* ABUF = (u16*)(ws + OFF_ABUF);
  u16* UST = (u16*)(ws + OFF_UST);
  float* DCY = (float*)(ws + OFF_DCY);

  __syncthreads();
#pragma unroll
  for (int i = 0; i < 4; ++i) {
    const int id = tid + 256 * i;
    const int row = id >> 4, cc = (id & 15) * 8;
    const u32x4 lf = *(const u32x4*)(LOGF + (r0 + row) * 1024 + h * 128 + cc);
    const _Float16* hp = (const _Float16*)&lf;
#pragma unroll
    for (int e = 0; e < 8; ++e) sBc[row * 132 + cc + e] = (float)hp[e];
    *(u32x4*)&sQ[row * 136 + cc] = *(const u32x4*)(QF + (r0 + row) * 1024 + h * 128 + cc);
  }
  __syncthreads();
  {
    float* sTot = (float*)(smem + 51200);
    const int col = tid & 127, hh = tid >> 7;
    float v[32];
#pragma unroll
    for (int q = 0; q < 32; ++q) v[q] = sBc[(32 * hh + q) * 132 + col];
    float run = 0.f;
#pragma unroll
    for (int q = 0; q < 32; ++q) { run += v[q]; v[q] = run; }
    if (hh == 0) sTot[col] = run;
    __syncthreads();
    const float off = hh ? sTot[col] : 0.f;
#pragma unroll
    for (int q = 0; q < 32; ++q) sBc[(32 * hh + q) * 132 + col] = v[q] + off;
  }
  __syncthreads();
#pragma unroll
  for (int i = 0; i < 4; ++i) {
    const int id = tid + 256 * i;
    const int row = id >> 4, cc = (id & 15) * 8;
    uint32_t w[4];
#pragma unroll
    for (int e = 0; e < 4; ++e) {
      const float q0 = bf2f(sQ[row * 136 + cc + 2 * e]) * __expf(sBc[row * 132 + cc + 2 * e]);
      const float q1 = bf2f(sQ[row * 136 + cc + 2 * e + 1]) * __expf(sBc[row * 132 + cc + 2 * e + 1]);
      w[e] = pack2(q0, q1);
    }
    *(u32x4*)(QF + (r0 + row) * 1024 + h * 128 + cc) = (u32x4){w[0], w[1], w[2], w[3]};
  }
  if (tid < 128) DCY[(long)uu * 128 + tid] = __expf(sBc[63 * 132 + tid]);
  for (int idx = tid; idx < 4096; idx += 256) {
    const int t = idx >> 6, s = idx & 63;
    if ((s >> 4) > (t >> 4)) ABUF[(long)uu * 4096 + idx] = 0;
  }
  for (int ti = wave; ti < 10; ti += 4) {
    int i, j;
    if (ti == 0) { i = 0; j = 0; }
    else if (ti < 3) { i = 1; j = ti - 1; }
    else if (ti < 6) { i = 2; j = ti - 3; }
    else { i = 3; j = ti - 6; }
    f32x4 a4 = {0.f, 0.f, 0.f, 0.f};
    const int t = 16 * i + l15, s = 16 * j + l15;
#pragma unroll
    for (int ks = 0; ks < 4; ++ks) {
      const int dk0 = ks * 32 + G * 8;
      uint32_t aw[4], bw[4];
#pragma unroll
      for (int e2 = 0; e2 < 4; ++e2) {
        float av[2], bv[2];
#pragma unroll
        for (int z = 0; z < 2; ++z) {
          const int dk = dk0 + 2 * e2 + z;
          const float br = sBc[(16 * i) * 132 + dk];
          const float bt = sBc[t * 132 + dk];
          av[z] = bf2f(sQ[t * 136 + dk]) * __expf(bt - br);
          const float bs = sBc[s * 132 + dk];
          const float bp = (s > 0) ? sBc[(s - 1) * 132 + dk] : 0.f;
          const float kk = 1.f - __expf(bs - bp);
          bv[z] = kk * __expf(br - bs);
        }
        aw[e2] = pack2(av[0], av[1]);
        bw[e2] = pack2(bv[0], bv[1]);
      }
      a4 = MFMA(mk8(aw[0], aw[1], aw[2], aw[3]), mk8(bw[0], bw[1], bw[2], bw[3]), a4);
    }
#pragma unroll
    for (int e = 0; e < 4; ++e) {
      const int tr = 16 * i + G * 4 + e, sc = 16 * j + l15;
      const float v = (sc <= tr) ? a4[e] : 0.f;
      ABUF[(long)uu * 4096 + tr * 64 + sc] = f2bf(v);
    }
  }
  {
    f32x4 ua[8][2];
#pragma unroll
    for (int rt = 0; rt < 8; ++rt) { ua[rt][0] = (f32x4){0.f, 0.f, 0.f, 0.f}; ua[rt][1] = (f32x4){0.f, 0.f, 0.f, 0.f}; }
#pragma unroll
    for (int ks = 0; ks < 2; ++ks) {
      bf16x8 bfr[2];
#pragma unroll
      for (int ct = 0; ct < 2; ++ct) {
        const int dk = (2 * wave + ct) * 16 + l15;
        const float blast = sBc[63 * 132 + dk];
        const int s0 = ks * 32 + G * 8;
        float prev = (s0 > 0) ? sBc[(s0 - 1) * 132 + dk] : 0.f;
        uint32_t bw[4];
#pragma unroll
        for (int e2 = 0; e2 < 4; ++e2) {
          const float b0 = sBc[(s0 + 2 * e2) * 132 + dk];
          const float b1 = sBc[(s0 + 2 * e2 + 1) * 132 + dk];
          const float k0 = (1.f - __expf(b0 - prev)) * __expf(blast - b0);
          const float k1 = (1.f - __expf(b1 - b0)) * __expf(blast - b1);
          prev = b1;
          bw[e2] = pack2(k0, k1);
        }
        bfr[ct] = mk8(bw[0], bw[1], bw[2], bw[3]);
      }
#pragma unroll
      for (int rt = 0; rt < 8; ++rt) {
        const int dv = rt * 16 + l15;
        const bf16x8 af = ld8(HVT + ((long)uu * 128 + dv) * 64 + ks * 32 + G * 8);
        ua[rt][0] = MFMA(af, bfr[0], ua[rt][0]);
        ua[rt][1] = MFMA(af, bfr[1], ua[rt][1]);
      }
    }
#pragma unroll
    for (int rt = 0; rt < 8; ++rt)
#pragma unroll
      for (int ct = 0; ct < 2; ++ct)
#pragma unroll
        for (int e = 0; e < 4; ++e) {
          const int dv = rt * 16 + G * 4 + e, dk = (2 * wave + ct) * 16 + l15;
          UST[((long)uu * 128 + dv) * 128 + dk] = f2bf(ua[rt][ct][e]);
        }
  }
}

__device__ __forceinline__ void cmp_gemm1_tile(const Params& P, int t, char* smem) {
  char* ws = P.ws;
  u16* sA = (u16*)smem;
  u16* sB = sA + 128 * 80;
  EPI_VARS
  const int kv = t >> 5, rem = t & 31;
  const int mt = rem >> 1, nt = rem & 1;
  const int m0 = mt * 128, n0 = nt * 128;
  const u16* KV = (const u16*)(ws + OFF_KV);
  const u16* W1T = (const u16*)(ws + (kv ? OFF_WV1T : OFF_WK1T));
  u16* HID = (u16*)(ws + (kv ? OFF_HIDV : OFF_HIDK));
  const float* B1P = (const float*)(ws + OFF_BIAS1P) + kv * 2048;
  f32x4 acc[4][4];
  zero_acc(acc);
  gemm_tile<1, 2>(KV, 1024, m0, 2048, W1T, 2048, n0, 256, 2048, kv * 256, acc, sA, sB);
#pragma unroll
  for (int i = 0; i < 4; ++i)
#pragma unroll
    for (int j = 0; j < 4; ++j) {
      const int col = n0 + wn * 64 + 16 * j + l15;
      float bias = 0.f;
#pragma unroll
      for (int pp = 0; pp < 8; ++pp) bias += B1P[pp * 256 + col];
#pragma unroll
      for (int e = 0; e < 4; ++e) {
        const int row = m0 + wm * 64 + 16 * i + G * 4 + e;
        HID[(long)row * 256 + col] = f2bf(gelu_tanh(acc[i][j][e] + bias));
      }
    }
}

__device__ __forceinline__ void cmp_gemm2_tile(const Params& P, int t, char* smem) {
  char* ws = P.ws;
  u16* sA = (u16*)smem;
  u16* sB = sA + 128 * 80;
  EPI_VARS
  const int kv = t >> 4, mt = t & 15;
  const int m0 = mt * 128;
  const u16* HID = (const u16*)(ws + (kv ? OFF_HIDV : OFF_HIDK));
  const u16* W2T = (const u16*)(ws + (kv ? OFF_WV2T : OFF_WK2T));
  u16* KCMP = (u16*)(ws + OFF_KCMP);
  u16* VCMPT = (u16*)(ws + OFF_VCMPT);
  f32x4 acc[4][4];
  zero_acc(acc);
  gemm_tile<0, 1>(HID, 256, m0, 2048, W2T, 256, 0, 64, 256, 0, acc, sA, sB);
  if (wn == 0) {
#pragma unroll
    for (int i = 0; i < 4; ++i)
#pragma unroll
      for (int j = 0; j < 4; ++j) {
        const int col = 16 * j + l15;
        const int rbase = m0 + wm * 64 + 16 * i + G * 4;
        if (kv == 0) {
#pragma unroll
          for (int e = 0; e < 4; ++e) KCMP[(long)(rbase + e) * 64 + col] = f2bf(acc[i][j][e]);
        } else {
          const int grp = rbase >> 8, n = rbase & 255;
          u32x2 o2 = {pack2(acc[i][j][0], acc[i][j][1]), pack2(acc[i][j][2], acc[i][j][3])};
          *(u32x2*)(VCMPT + ((long)grp * 64 + col) * 256 + n) = o2;
        }
      }
  }
}

__device__ __forceinline__ void hgrn_scan(const Params& P) {
  char* ws = P.ws;
  u16* UST = (u16*)(ws + OFF_UST);
  const float* DCY = (const float*)(ws + OFF_DCY);
  for (int idx = bid_() * 256 + tid_(); idx < 131072; idx += gridDim.x * 256) {
    const int bh = idx >> 13, rem = idx & 8191;
    const int dv = rem >> 6, dk2 = (rem & 63) * 2;
    float s0 = 0.f, s1 = 0.f;
#pragma unroll 8
    for (int c = 0; c < 64; ++c) {
      const long uu = (long)bh * 64 + c;
      u16* ptr = UST + (uu * 128 + dv) * 128 + dk2;
      const uint32_t uv = *(const uint32_t*)ptr;
      const float2 d = *(const float2*)(DCY + uu * 128 + dk2);
      *(uint32_t*)ptr = pack2(s0, s1);
      s0 = d.x * s0 + __uint_as_float(uv << 16);
      s1 = d.y * s1 + __uint_as_float(uv & 0xffff0000u);
    }
  }
}

__device__ __forceinline__ void hgrn_out_unit(const Params& P, int half, int uu, char* smem) {
  char* ws = P.ws;
  const int tid = tid_(), lane = tid & 63, wave = tid >> 6;
  const int l15 = lane & 15, G = lane >> 4;
  float* sO = (float*)smem;
  const int bl = uu >> 9, h = (uu >> 6) & 7, c = uu & 63;
  const long r0 = (long)bl * 4096 + c * 64;
  const u16* QF = (const u16*)(ws + OFF_QF);
  const u16* HVT = (const u16*)(ws + OFF_HVT);
  const u16* ABUF = (const u16*)(ws + OFF_ABUF);
  const u16* UST = (const u16*)(ws + OFF_UST);
  u16* SG = (u16*)(ws + OFF_SG) + (long)half * 8192 * 1024;
  f32x4 acc[4][2];
#pragma unroll
  for (int i = 0; i < 4; ++i) { acc[i][0] = (f32x4){0.f, 0.f, 0.f, 0.f}; acc[i][1] = (f32x4){0.f, 0.f, 0.f, 0.f}; }
#pragma unroll
  for (int ks = 0; ks < 4; ++ks) {
    const int dk0 = ks * 32 + G * 8;
    bf16x8 bfr[2];
#pragma unroll
    for (int jt = 0; jt < 2; ++jt) bfr[jt] = ld8(UST + ((long)uu * 128 + 32 * wave + 16 * jt + l15) * 128 + dk0);
#pragma unroll
    for (int i = 0; i < 4; ++i) {
      const bf16x8 af = ld8(QF + (r0 + 16 * i + l15) * 1024 + h * 128 + dk0);
      acc[i][0] = MFMA(af, bfr[0], acc[i][0]);
      acc[i][1] = MFMA(af, bfr[1], acc[i][1]);
    }
  }
#pragma unroll
  for (int ks = 0; ks < 2; ++ks) {
    const int s0 = ks * 32 + G * 8;
    bf16x8 bfr[2];
#pragma unroll
    for (int jt = 0; jt < 2; ++jt) bfr[jt] = ld8(HVT + ((long)uu * 128 + 32 * wave + 16 * jt + l15) * 64 + s0);
#pragma unroll
    for (int i = 0; i < 4; ++i) {
      const bf16x8 af = ld8(ABUF + (long)uu * 4096 + (16 * i + l15) * 64 + s0);
      acc[i][0] = MFMA(af, bfr[0], acc[i][0]);
      acc[i][1] = MFMA(af, bfr[1], acc[i][1]);
    }
  }
  __syncthreads();
#pragma unroll
  for (int i = 0; i < 4; ++i)
#pragma unroll
    for (int jt = 0; jt < 2; ++jt)
#pragma unroll
      for (int e = 0; e < 4; ++e) sO[(16 * i + G * 4 + e) * 132 + 32 * wave + 16 * jt + l15] = acc[i][jt][e];
  __syncthreads();
  {
    const int row = tid >> 2, part = tid & 3;
    float ss = 0.f;
#pragma unroll
    for (int cc = 0; cc < 32; ++cc) { const float v = sO[row * 132 + part * 32 + cc]; ss += v * v; }
    ss += SHX(ss, 1);
    ss += SHX(ss, 2);
    const float r = rsqrtf(ss * (1.f / 128.f) + 1e-6f);
    u16* dst = SG + (r0 + row) * 1024 + h * 128 + part * 32;
#pragma unroll
    for (int q4 = 0; q4 < 4; ++q4) {
      const u32x4 sgv = *(const u32x4*)(dst + q4 * 8);
      uint32_t w[4];
#pragma unroll
      for (int e = 0; e < 4; ++e) {
        const int cc = q4 * 8 + 2 * e;
        const float g0 = __uint_as_float(sgv[e] << 16), g1 = __uint_as_float(sgv[e] & 0xffff0000u);
        const float y0 = sO[row * 132 + part * 32 + cc] * r * P.gnorm[part * 32 + cc] * g0;
        const float y1 = sO[row * 132 + part * 32 + cc + 1] * r * P.gnorm[part * 32 + cc + 1] * g1;
        w[e] = pack2(y0, y1);
      }
      *(u32x4*)(dst + q4 * 8) = (u32x4){w[0], w[1], w[2], w[3]};
    }
  }
}

__device__ __forceinline__ void stage_kv(u16* sK, u16* sV, const u16* kptr, long kstride, const u16* vptr, long vstride) {
  const int tid = tid_();
  __syncthreads();
#pragma unroll
  for (int i = 0; i < 2; ++i) {
    const int id = tid + 256 * i;
    const int row = id >> 3, ch = id & 7;
    *(u32x4*)&sK[row * 72 + ch * 8] = *(const u32x4*)(kptr + row * kstride + ch * 8);
    *(u32x4*)&sV[row * 72 + ch * 8] = *(const u32x4*)(vptr + row * vstride + ch * 8);
  }
  __syncthreads();
}

__device__ __forceinline__ void qk_scores(const u16* sK, const bf16x8 (&q)[2], f32x4 (&s)[4], int l15, int G) {
#pragma unroll
  for (int kt = 0; kt < 4; ++kt) {
    s[kt] = (f32x4){0.f, 0.f, 0.f, 0.f};
#pragma unroll
    for (int ks = 0; ks < 2; ++ks) s[kt] = MFMA(ld8(&sK[(16 * kt + l15) * 72 + ks * 32 + G * 8]), q[ks], s[kt]);
  }
}

__device__ __forceinline__ void pv_accum(const u16* sV, const f32x4 (&p)[4], f32x4 (&o)[4], int l15, int G) {
#pragma unroll
  for (int ks2 = 0; ks2 < 2; ++ks2) {
    const f32x4 pa = p[2 * ks2], pb = p[2 * ks2 + 1];
    const bf16x8 pf = mk8(pack2(pa[0], pa[1]), pack2(pa[2], pa[3]), pack2(pb[0], pb[1]), pack2(pb[2], pb[3]));
#pragma unroll
    for (int dt = 0; dt < 4; ++dt) {
      const u32x2 v0 = *(const u32x2*)&sV[(16 * dt + l15) * 72 + 32 * ks2 + 4 * G];
      const u32x2 v1 = *(const u32x2*)&sV[(16 * dt + l15) * 72 + 32 * ks2 + 16 + 4 * G];
      o[dt] = MFMA(mk8(v0[0], v0[1], v1[0], v1[1]), pf, o[dt]);
    }
  }
}

#define EX2(x) __builtin_amdgcn_exp2f(x)
typedef __attribute__((ext_vector_type(16))) float f32x16;
#define MFMA32(a, b, c) __builtin_amdgcn_mfma_f32_32x32x16_bf16((a), (b), (c), 0, 0, 0)
template <int MODE, bool EDGE>
__device__ __forceinline__ void nsa_block(const u16* sK, const u16* sV, int jb, int qb, int q, bool blk_ok,
                                          const bf16x8 (&qf)[4], f32x16 (&O)[2], float& m, float& l, int r31, int h) {
  const int lane = h * 32 + r31;
  f32x16 s[2];
#pragma unroll
  for (int kt2 = 0; kt2 < 2; ++kt2) {
#pragma unroll
    for (int e = 0; e < 16; ++e) s[kt2][e] = 0.f;
#pragma unroll
    for (int ks = 0; ks < 4; ++ks) s[kt2] = MFMA32(ld8(&sK[(32 * kt2 + r31) * 72 + 16 * ks + 8 * h]), qf[ks], s[kt2]);
  }
  float smax = -1e30f;
  if (EDGE) {
#pragma unroll
    for (int kt2 = 0; kt2 < 2; ++kt2)
#pragma unroll
      for (int e = 0; e < 16; ++e) {
        const int k = 32 * kt2 + (e & 3) + 8 * (e >> 2) + 4 * h;
        const bool a = blk_ok && ((jb == qb) ? (k <= q) : (k > q));
        if (!a) s[kt2][e] = -1e30f;
        smax = fmaxf(smax, s[kt2][e]);
      }
  } else {
#pragma unroll
    for (int kt2 = 0; kt2 < 2; ++kt2)
#pragma unroll
      for (int e = 0; e < 16; ++e) smax = fmaxf(smax, s[kt2][e]);
    if (MODE == 2 && !blk_ok) smax = -1e30f;
  }
  smax = fmaxf(smax, SHX(smax, 32));
  const float mn = fmaxf(m, smax);
  const bool need = (mn - m) > 8.f;
  if (__builtin_amdgcn_ballot_w64(need) != 0ull) {
    const float alpha = need ? EX2(m - mn) : 1.f;
    m = need ? mn : m;
    l *= alpha;
    O[0] *= alpha;
    O[1] *= alpha;
  }
  const float mref = (!EDGE && MODE == 2 && !blk_ok) ? 1e30f : m;
  float ls = 0.f;
#pragma unroll
  for (int kt2 = 0; kt2 < 2; ++kt2)
#pragma unroll
    for (int e = 0; e < 16; ++e) {
      const float sv = s[kt2][e];
      float pv;
      if (EDGE) pv = (sv > -1e29f) ? EX2(sv - m) : 0.f;
      else pv = EX2(sv - mref);
      s[kt2][e] = pv;
      ls += pv;
    }
  l += ls;
#pragma unroll
  for (int kt2 = 0; kt2 < 2; ++kt2)
#pragma unroll
    for (int st = 0; st < 2; ++st) {
      const bf16x8 pf = mk8(pack2(s[kt2][8 * st + 0], s[kt2][8 * st + 1]), pack2(s[kt2][8 * st + 2], s[kt2][8 * st + 3]),
                            pack2(s[kt2][8 * st + 4], s[kt2][8 * st + 5]), pack2(s[kt2][8 * st + 6], s[kt2][8 * st + 7]));
#pragma unroll
      for (int dt2 = 0; dt2 < 2; ++dt2) {
        const u16* vrow = &sV[(32 * dt2 + r31) * 72 + 32 * kt2 + 16 * st + 4 * h];
        const u32x2 v0 = *(const u32x2*)vrow;
        const u32x2 v1 = *(const u32x2*)(vrow + 8);
        O[dt2] = MFMA32(mk8(v0[0], v0[1], v1[0], v1[1]), pf, O[dt2]);
      }
    }
}

template <int MODE>
__device__ __forceinline__ void nsa_branch(const u16* kbase, const u16* vbase, int jb0, int jb1, int qb, int q,
                                           uint32_t mlo, uint32_t mhi, const bf16x8 (&qf)[4], const float* ngbase, int rowbase, int gidx,
                                           u16* sYl, u16* sm, float pscale = 1.f) {
  const int tid = tid_();
  const int lane = tid & 63;
  const int r31 = lane & 31, h = lane >> 5;
  const int srow = tid >> 3, sch = (tid & 7) * 8;
  f32x16 O[2];
#pragma unroll
  for (int e = 0; e < 16; ++e) { O[0][e] = 0.f; O[1][e] = 0.f; }
  float m = -1e30f, l = 0.f;
  u32x4 kr[2], vr[2];
  const unsigned koff = (unsigned)((srow * 1024 + sch) * 2);
  const unsigned voff = (unsigned)((srow * 4096 + sch) * 2);
  {
    const char* kb = (const char*)kbase + (size_t)jb0 * 131072;
    const char* vb = (const char*)vbase + (size_t)jb0 * 128;
#pragma unroll
    for (int i = 0; i < 2; ++i) {
      kr[i] = *(const u32x4*)(kb + (koff + i * 65536u));
      vr[i] = *(const u32x4*)(vb + (voff + i * 262144u));
    }
  }
  __syncthreads();
#pragma unroll
  for (int i = 0; i < 2; ++i) {
    *(u32x4*)&sm[(srow + 32 * i) * 72 + sch] = kr[i];
    *(u32x4*)&sm[4608 + (srow + 32 * i) * 72 + sch] = vr[i];
  }
  __syncthreads();
  int cur = 0;
  for (int jb = jb0; jb <= jb1; ++jb) {
    const bool more = jb < jb1;
    if (more) {
      const char* kb = (const char*)kbase + (size_t)(jb + 1) * 131072;
      const char* vb = (const char*)vbase + (size_t)(jb + 1) * 128;
#pragma unroll
      for (int i = 0; i < 2; ++i) {
        kr[i] = *(const u32x4*)(kb + (koff + i * 65536u));
        vr[i] = *(const u32x4*)(vb + (voff + i * 262144u));
      }
    }
    const u16* sK = sm + cur * 9216;
    const u16* sV = sK + 4608;
    bool blk_ok = true;
    if (MODE == 2) blk_ok = (jb < 32) ? ((mlo >> jb) & 1u) : ((mhi >> (jb - 32)) & 1u);
    const bool edge = (jb == qb) || (MODE == 3 && jb == qb - 8);
    if (edge) nsa_block<MODE, true>(sK, sV, jb, qb, q, blk_ok, qf, O, m, l, r31, h);
    else nsa_block<MODE, false>(sK, sV, jb, qb, q, blk_ok, qf, O, m, l, r31, h);
    if (more) {
      u16* dK = sm + (cur ^ 1) * 9216;
#pragma unroll
      for (int i = 0; i < 2; ++i) {
        *(u32x4*)&dK[(srow + 32 * i) * 72 + sch] = kr[i];
        *(u32x4*)&dK[4608 + (srow + 32 * i) * 72 + sch] = vr[i];
      }
    }
    __syncthreads();
    cur ^= 1;
  }
  const int tg = tid_();
  const int lg = tg & 63, hh = (lg >> 4) & 1, hg = lg >> 5;
  const float* gatep = (const float*)((const char*)ngbase + (unsigned)(rowbase + 16 * (tg >> 6) + (tg & 15)) * 192u) + gidx + hh;
  float lt = l;
  lt += shx_f(lt, lg ^ 32);
  const float sc = (lt > 0.f) ? (pscale * gatep[0] / lt) : 0.f;
  u16* yrow = sYl + (((tg >> 6) * 2 + hh) * 16 + (tg & 15)) * 64;
#pragma unroll
  for (int dt2 = 0; dt2 < 2; ++dt2)
#pragma unroll
    for (int m4 = 0; m4 < 4; ++m4) {
      u32x2* yp = (u32x2*)(yrow + 32 * dt2 + 8 * m4 + 4 * hg);
      const u32x2 yv = *yp;
      const float y0 = __uint_as_float(yv[0] << 16) + O[dt2][4 * m4 + 0] * sc;
      const float y1 = __uint_as_float(yv[0] & 0xffff0000u) + O[dt2][4 * m4 + 1] * sc;
      const float y2 = __uint_as_float(yv[1] << 16) + O[dt2][4 * m4 + 2] * sc;
      const float y3 = __uint_as_float(yv[1] & 0xffff0000u) + O[dt2][4 * m4 + 3] * sc;
      *yp = (u32x2){pack2(y0, y1), pack2(y2, y3)};
    }
}

__device__ __forceinline__ void pv_cmp(const u16* vc, int jb, const f32x4 (&p)[4], f32x4 (&o)[4], int l15, int G) {
#pragma unroll
  for (int ks2 = 0; ks2 < 2; ++ks2) {
    const f32x4 pa = p[2 * ks2], pb = p[2 * ks2 + 1];
    const bf16x8 pf = mk8(pack2(pa[0], pa[1]), pack2(pa[2], pa[3]), pack2(pb[0], pb[1]), pack2(pb[2], pb[3]));
#pragma unroll
    for (int dt = 0; dt < 4; ++dt) {
      const u16* vp = vc + (long)(16 * dt + l15) * 256 + jb * 64 + 32 * ks2 + 4 * G;
      const u32x2 v0 = *(const u32x2*)vp;
      const u32x2 v1 = *(const u32x2*)(vp + 16);
      o[dt] = MFMA(mk8(v0[0], v0[1], v1[0], v1[1]), pf, o[dt]);
    }
  }
}

__device__ __forceinline__ void nsa_unit(const Params& P, int half, int u, char* smem) {
  char* ws = P.ws;
  const int tid = tid_(), lane = tid & 63, wave = tid >> 6;
  const int l15 = lane & 15, G = lane >> 4;
  const int hp = u >> 9, rest = u & 511;
  const int bl = rest >> 8, g = (rest >> 6) & 3, xq = rest & 63;
  const int qb = hp ? xq : 63 - xq;
  const int q = 16 * wave + l15;
  const int t = qb * 64 + q;
  const int rl = bl * 4096 + t;
  const int rg = half * 8192 + rl;
  const char* NQc = (const char*)(ws + OFF_NQ);
  const unsigned qoff = (unsigned)rg * 2048u;
  u16* sm = (u16*)smem;
  float* sImp = (float*)smem;
  const u16* NQ = (const u16*)(ws + OFF_NQ);
  const u16* NQR = (const u16*)(ws + OFF_NQR);
  const u16* KV = (const u16*)(ws + OFF_KV);
  const u16* VST = (const u16*)(ws + OFF_VST);
  const u16* VWT = (const u16*)(ws + OFF_VWT);
  const u16* KCMP = (const u16*)(ws + OFF_KCMP);
  const u16* VCMPT = (const u16*)(ws + OFF_VCMPT);
  const float* NGATE = (const float*)((const char*)(ws + OFF_NGATE) + (unsigned)rg * 192u);
  u16* YB = (u16*)(ws + (half ? OFF_YB1 : OFF_YB0));

  f32x4 Y[2][4];
#pragma unroll
  for (int rr = 0; rr < 2; ++rr)
#pragma unroll
    for (int dt = 0; dt < 4; ++dt) Y[rr][dt] = (f32x4){0.f, 0.f, 0.f, 0.f};

  uint32_t mlo = 0, mhi = 0;
  u16* sYl = (u16*)(smem + 36864);
  {
    const int nblk = ((4 * qb + 2) >> 6) + 1;
    const u16* kc = KCMP + (long)(bl * 4 + g) * 256 * 64;
    const u16* vc = VCMPT + (long)(bl * 4 + g) * 64 * 256;
    float imp[4][4];
#pragma unroll
    for (int a = 0; a < 4; ++a)
#pragma unroll
      for (int b = 0; b < 4; ++b) imp[a][b] = 0.f;
    __syncthreads();
    for (int id = tid; id < nblk * 512; id += 256) {
      const int row = id >> 3, chn = (id & 7) * 8;
      *(u32x4*)&sm[row * 72 + chn] = *(const u32x4*)(kc + row * 64 + chn);
    }
    __syncthreads();
#pragma unroll 1
    for (int r = 0; r < 4; ++r) {
      bf16x8 qp[2];
#pragma unroll
      for (int ks = 0; ks < 2; ++ks) qp[ks] = *(const bf16x8*)(NQc + (qoff + (unsigned)(((4 * g + r) * 64 + ks * 32 + G * 8) * 2)));
      float m = -1e30f, l = 0.f;
#pragma unroll 1
      for (int jb = 0; jb < nblk; ++jb) {
        f32x4 s[4];
        float smax = -1e30f;
#pragma unroll
        for (int kt = 0; kt < 4; ++kt) {
          f32x4 a4 = {0.f, 0.f, 0.f, 0.f};
#pragma unroll
          for (int ks = 0; ks < 2; ++ks)
            a4 = MFMA(ld8(&sm[(jb * 64 + 16 * kt + l15) * 72 + ks * 32 + G * 8]), qp[ks], a4);
#pragma unroll
          for (int e = 0; e < 4; ++e) {
            const int n = jb * 64 + 16 * kt + 4 * G + e;
            const float sv = (16 * n + 31 <= t) ? a4[e] : -1e30f;
            s[kt][e] = sv;
            smax = fmaxf(smax, sv);
          }
        }
        smax = fmaxf(smax, SHX(smax, 16));
        smax = fmaxf(smax, SHX(smax, 32));
        const float mn = fmaxf(m, smax);
        float ls = 0.f;
#pragma unroll
        for (int kt = 0; kt < 4; ++kt)
#pragma unroll
          for (int e = 0; e < 4; ++e) ls += (s[kt][e] > -1e29f) ? EX2(s[kt][e] - mn) : 0.f;
        l = l * EX2(m - mn) + ls;
        m = mn;
      }
      l += SHX(l, 16);
      l += SHX(l, 32);
      const float invl = (l > 0.f) ? 1.f / l : 0.f;
      float prevup = 0.f;
#pragma unroll 1
      for (int jb = 0; jb < nblk; ++jb) {
        {
          f32x4 p[4];
#pragma unroll
          for (int kt = 0; kt < 4; ++kt) {
            f32x4 a4 = {0.f, 0.f, 0.f, 0.f};
#pragma unroll
            for (int ks = 0; ks < 2; ++ks)
              a4 = MFMA(ld8(&sm[(jb * 64 + 16 * kt + l15) * 72 + ks * 32 + G * 8]), qp[ks], a4);
#pragma unroll
            for (int e = 0; e < 4; ++e) {
              const int n = jb * 64 + 16 * kt + 4 * G + e;
              p[kt][e] = (16 * n + 31 <= t) ? EX2(a4[e] - m) * invl : 0.f;
            }
            const float sum4 = (p[kt][0] + p[kt][1]) + (p[kt][2] + p[kt][3]);
            const float upv = shx_f(p[kt][3], (lane + 48) & 63);
            const float add = (G > 0) ? upv : prevup;
            const float iv = sum4 + add;
#pragma unroll
            for (int j = 0; j < 4; ++j) imp[j][kt] += (jb == j) ? iv : 0.f;
            prevup = upv;
          }
          if (r == 2 * hp) pv_cmp(vc, jb, p, Y[0], l15, G);
          else if (r == 2 * hp + 1) pv_cmp(vc, jb, p, Y[1], l15, G);
        }
      }
    }
    {
      const float g0 = NGATE[0 * 16 + 4 * g + 2 * hp], g1 = NGATE[0 * 16 + 4 * g + 2 * hp + 1];
#pragma unroll
      for (int dt = 0; dt < 4; ++dt) {
        *(u32x2*)(sYl + ((wave * 2 + 0) * 16 + l15) * 64 + 16 * dt + 4 * G) = (u32x2){pack2(Y[0][dt][0] * g0, Y[0][dt][1] * g0), pack2(Y[0][dt][2] * g0, Y[0][dt][3] * g0)};
        *(u32x2*)(sYl + ((wave * 2 + 1) * 16 + l15) * 64 + 16 * dt + 4 * G) = (u32x2){pack2(Y[1][dt][0] * g1, Y[1][dt][1] * g1), pack2(Y[1][dt][2] * g1, Y[1][dt][3] * g1)};
      }
    }
    __syncthreads();
    float* myImp = sImp + wave * 16 * 65;
#pragma unroll
    for (int jb = 0; jb < 4; ++jb)
#pragma unroll
      for (int kt = 0; kt < 4; ++kt) myImp[l15 * 65 + 16 * jb + 4 * kt + G] = imp[jb][kt];
    __syncthreads();
    const int cur = qb;
    uint32_t blo = 0, bhi = 0;
    if (cur + 1 <= 16) {
#pragma unroll
      for (int jb = 0; jb < 4; ++jb)
#pragma unroll
        for (int kt = 0; kt < 4; ++kt) {
          const int s = 16 * jb + 4 * kt + G;
          if (s <= cur) blo |= (1u << s);
        }
    } else {
      int cnt[4][4];
#pragma unroll
      for (int a = 0; a < 4; ++a)
#pragma unroll
        for (int b = 0; b < 4; ++b) cnt[a][b] = 0;
      for (int sp = 1; sp <= cur - 2; ++sp) {
        const float xv = myImp[l15 * 65 + sp];
#pragma unroll
        for (int jb = 0; jb < 4; ++jb)
#pragma unroll
          for (int kt = 0; kt < 4; ++kt) {
            const int s = 16 * jb + 4 * kt + G;
            const float v = imp[jb][kt];
            cnt[jb][kt] += ((xv > v) || (xv == v && sp < s)) ? 1 : 0;
          }
      }
#pragma unroll
      for (int jb = 0; jb < 4; ++jb)
#pragma unroll
        for (int kt = 0; kt < 4; ++kt) {
          const int s = 16 * jb + 4 * kt + G;
          const bool sel = (s == 0) || (s == cur) || (s == cur - 1) || (s >= 1 && s <= cur - 2 && cnt[jb][kt] < 13);
          if (sel) { if (s < 32) blo |= (1u << s); else bhi |= (1u << (s - 32)); }
        }
    }
    blo |= SHXU(blo, 16); blo |= SHXU(blo, 32);
    bhi |= SHXU(bhi, 16); bhi |= SHXU(bhi, 32);
    mlo = blo; mhi = bhi;
  }
  {
    const int hh = (lane >> 4) & 1, h5 = lane >> 5;
    const int head = 4 * g + 2 * hp + hh;
    bf16x8 qf[4];
    qf[0] = *(const bf16x8*)((const char*)NQR + ((unsigned)rl * 512u + (unsigned)((head * 16 + 8 * h5) * 2)));
#pragma unroll
    for (int ks = 1; ks < 4; ++ks) qf[ks] = *(const bf16x8*)(NQc + (qoff + (unsigned)((head * 64 + 16 * ks + 8 * h5) * 2)));
    const int head0 = 4 * g + 2 * hp;
    const u16* kbs = KV + (long)bl * 4096 * 1024 + 512 + g * 64;
    const u16* vbs = VST + (long)(bl * 4 + g) * 64 * 4096;
    nsa_branch<2>(kbs, vbs, 0, qb, qb, q, mlo, mhi, qf, (const float*)(ws + OFF_NGATE), half * 8192 + bl * 4096 + qb * 64, 16 + head0, sYl, sm);
    const u16* kbw = KV + (long)bl * 4096 * 1024 + 768 + g * 64;
    const u16* vbw = VWT + (long)(bl * 4 + g) * 64 * 4096;
    const int jw0 = (qb >= 8) ? qb - 8 : 0;
    nsa_branch<3>(kbw, vbw, jw0, qb, qb, q, mlo, mhi, qf, (const float*)(ws + OFF_NGATE), half * 8192 + bl * 4096 + qb * 64, 32 + head0, sYl, sm);
    const int tid2 = tid_();
    const int l2 = tid2 & 63, hh2 = (l2 >> 4) & 1, hg2 = l2 >> 5;
    const unsigned yoff = (unsigned)(bl * 4096 + qb * 64 + 16 * (tid2 >> 6) + (tid2 & 15)) * 2048u;
    const u16* yrow = sYl + (((tid2 >> 6) * 2 + hh2) * 16 + (tid2 & 15)) * 64;
#pragma unroll
    for (int dt2 = 0; dt2 < 2; ++dt2)
#pragma unroll
      for (int m4 = 0; m4 < 4; ++m4) {
        const int d0 = 32 * dt2 + 8 * m4 + 4 * hg2;
        *(u32x2*)((char*)YB + (yoff + (unsigned)(((head0 + hh2) * 64 + d0) * 2))) = *(const u32x2*)(yrow + d0);
      }
  }
}

__device__ __forceinline__ void gemm_tile_wide(const u16* __restrict__ A, long lda, int m0, const u16* __restrict__ Bt, long ldb, int n0, int K,
                                               f32x4 (&acc)[4][8], u16* sA) {
  const int tid = tid_(), lane = tid & 63, wave = tid >> 6;
  const int l15 = lane & 15, G = lane >> 4;
  const int wm = wave >> 1, wn = wave & 1;
  const int lr = tid >> 3, ch = tid & 7;
  u16* sB = sA + 128 * 80;
  const char* Ab = (const char*)A;
  const char* Bb = (const char*)Bt;
  unsigned oa[4], ob[8];
#pragma unroll
  for (int i = 0; i < 4; ++i) oa[i] = (unsigned)(((long)(m0 + lr + 32 * i) * lda + ch * 8) * 2);
#pragma unroll
  for (int i = 0; i < 8; ++i) ob[i] = (unsigned)(((long)(n0 + lr + 32 * i) * ldb + ch * 8) * 2);
  u32x4 ra[4], rb[8];
#pragma unroll
  for (int i = 0; i < 4; ++i) ra[i] = *(const u32x4*)(Ab + oa[i]);
#pragma unroll
  for (int i = 0; i < 8; ++i) rb[i] = *(const u32x4*)(Bb + ob[i]);
  const int nk = K >> 6;
  for (int kt = 0; kt < nk; ++kt) {
#pragma unroll
    for (int i = 0; i < 4; ++i) *(u32x4*)&sA[(lr + 32 * i) * 80 + ch * 8] = ra[i];
#pragma unroll
    for (int i = 0; i < 8; ++i) *(u32x4*)&sB[(lr + 32 * i) * 80 + ch * 8] = rb[i];
    __syncthreads();
    {
      const int kn = (kt + 1 < nk) ? kt + 1 : kt;
      const char* Ak = Ab + (size_t)kn * 128;
      const char* Bk = Bb + (size_t)kn * 128;
#pragma unroll
      for (int i = 0; i < 4; ++i) ra[i] = *(const u32x4*)(Ak + oa[i]);
#pragma unroll
      for (int i = 0; i < 8; ++i) rb[i] = *(const u32x4*)(Bk + ob[i]);
    }
#pragma unroll
    for (int ks = 0; ks < 2; ++ks) {
      bf16x8 af[4];
#pragma unroll
      for (int i = 0; i < 4; ++i) af[i] = ld8(&sA[(wm * 64 + 16 * i + l15) * 80 + ks * 32 + G * 8]);
#pragma unroll
      for (int jh = 0; jh < 2; ++jh) {
        bf16x8 bfr[4];
#pragma unroll
        for (int j = 0; j < 4; ++j) bfr[j] = ld8(&sB[(wn * 128 + 64 * jh + 16 * j + l15) * 80 + ks * 32 + G * 8]);
#pragma unroll
        for (int i = 0; i < 4; ++i)
#pragma unroll
          for (int j = 0; j < 4; ++j) acc[i][4 * jh + j] = MFMA(af[i], bfr[j], acc[i][4 * jh + j]);
      }
    }
    __syncthreads();
  }
}


__device__ __forceinline__ void phase_branch_merge(const Params& P, char* smem) {
  char* ws = P.ws;
  u16* sA = (u16*)smem;
  const u16* YA = (const u16*)(ws + OFF_SG);
  const u16* GATES = (const u16*)P.out;
  u16* MERGED = (u16*)(ws + OFF_MERGED);
  for (int t = bid_(); t < 512; t += gridDim.x) {
    const int nt = t >> 7, mt = t & 127;
    const int m0 = mt * 128, n0 = nt * 256;
    const u16* YBp = (m0 < 8192) ? (const u16*)(ws + OFF_YB0) : ((const u16*)(ws + OFF_YB1) - (long)8192 * 1024);
    f32x4 acc[4][8];
#pragma unroll
    for (int i = 0; i < 4; ++i)
#pragma unroll
      for (int j = 0; j < 8; ++j) acc[i][j] = (f32x4){0.f, 0.f, 0.f, 0.f};
    gemm_tile_wide(YA, 1024, m0, (const u16*)(ws + OFF_WA_T), 1024, n0, 1024, acc, sA);
    {
      const int tc = tid_();
#pragma unroll 4
      for (int k16 = 0; k16 < 16; ++k16) {
        const int id = tc + 256 * k16;
        const int row = id >> 5, cch = (id & 31) * 8;
        *(u32x4*)&sA[row * 264 + cch] = *(const u32x4*)(GATES + (long)(m0 + row) * 2048 + n0 + cch);
      }
    }
    __syncthreads();
    {
      EPI_VARS
#pragma unroll
      for (int i = 0; i < 4; ++i)
#pragma unroll
        for (int j = 0; j < 8; ++j)
#pragma unroll
          for (int e = 0; e < 4; ++e) {
            u16* sp = &sA[(wm * 64 + 16 * i + G * 4 + e) * 264 + wn * 128 + 16 * j + l15];
            *sp = f2bf(bf2f(*sp) * acc[i][j][e]);
            acc[i][j][e] = 0.f;
          }
    }
    __syncthreads();
    {
      const int tc = tid_();
#pragma unroll 4
      for (int k16 = 0; k16 < 16; ++k16) {
        const int id = tc + 256 * k16;
        const int row = id >> 5, cch = (id & 31) * 8;
        *(u32x4*)(MERGED + (long)(m0 + row) * 1024 + n0 + cch) = *(const u32x4*)&sA[row * 264 + cch];
      }
    }
    asm volatile("s_waitcnt vmcnt(0)" ::: "memory");
    __syncthreads();
    gemm_tile_wide(YBp, 1024, m0, (const u16*)(ws + OFF_WB_T), 1024, n0, 1024, acc, sA);
    {
      const int tc = tid_();
#pragma unroll 4
      for (int k16 = 0; k16 < 16; ++k16) {
        const int id = tc + 256 * k16;
        const int row = id >> 5, cch = (id & 31) * 8;
        *(u32x4*)&sA[row * 264 + cch] = *(const u32x4*)(GATES + (long)(m0 + row) * 2048 + 1024 + n0 + cch);
      }
    }
    __syncthreads();
    {
      EPI_VARS
#pragma unroll
      for (int i = 0; i < 4; ++i)
#pragma unroll
        for (int j = 0; j < 8; ++j)
#pragma unroll
          for (int e = 0; e < 4; ++e) {
            u16* sp = &sA[(wm * 64 + 16 * i + G * 4 + e) * 264 + wn * 128 + 16 * j + l15];
            *sp = f2bf(bf2f(*sp) * acc[i][j][e]);
          }
    }
    __syncthreads();
    {
      const int tc = tid_();
#pragma unroll 2
      for (int k16 = 0; k16 < 16; ++k16) {
        const int id = tc + 256 * k16;
        const int row = id >> 5, cch = (id & 31) * 8;
        u16* gp = MERGED + (long)(m0 + row) * 1024 + n0 + cch;
        const u32x4 t1 = *(const u32x4*)gp;
        const u32x4 pb = *(const u32x4*)&sA[row * 264 + cch];
        u32x4 o;
#pragma unroll
        for (int q = 0; q < 4; ++q) {
          const float lo = __uint_as_float(t1[q] << 16) + __uint_as_float(pb[q] << 16);
          const float hi = __uint_as_float(t1[q] & 0xffff0000u) + __uint_as_float(pb[q] & 0xffff0000u);
          o[q] = pack2(lo, hi);
        }
        *(u32x4*)gp = o;
      }
    }
    __syncthreads();
  }
}

template <int EPI>
__device__ __forceinline__ void phase_gemm(const u16* A, int K, const u16* Wt, int N, void* outp, char* smem) {
  u16* sA = (u16*)smem;
  u16* sB = sA + 128 * 80;
  EPI_VARS
  const int ntn = N >> 7;
  for (int t = bid_(); t < 128 * ntn; t += gridDim.x) {
    const int nt = t >> 7, mt = t & 127;
    const int m0 = mt * 128, n0 = nt * 128;
    f32x4 acc[4][4];
    zero_acc(acc);
    gemm_tile<0, 2>(A, K, m0, 16384, Wt, K, n0, N, K, 0, acc, sA, sB);
#pragma unroll
    for (int i = 0; i < 4; ++i)
#pragma unroll
      for (int j = 0; j < 4; ++j) {
        const int col = n0 + wn * 64 + 16 * j + l15;
#pragma unroll
        for (int e = 0; e < 4; ++e) {
          const long row = m0 + wm * 64 + 16 * i + G * 4 + e;
          const float v = acc[i][j][e];
          if (EPI == 0) ((float*)outp)[row * N + col] = v;
          else if (EPI == 2) ((u16*)outp)[row * N + col] = f2bf(v);
          else { const float rl = fmaxf(v, 0.f); ((u16*)outp)[row * N + col] = f2bf(rl * rl); }
        }
      }
  }
}


template <int EPI>
__device__ __forceinline__ void phase_gemm_wide(const u16* A, int K, const u16* Wt, int N, u16* outp, char* smem) {
  u16* sA = (u16*)smem;
  EPI_VARS
  const int ntn = N >> 8;
  for (int t = bid_(); t < 128 * ntn; t += gridDim.x) {
    const int nt = t >> 7, mt = t & 127;
    const int m0 = mt * 128, n0 = nt * 256;
    f32x4 acc[4][8];
#pragma unroll
    for (int i = 0; i < 4; ++i)
#pragma unroll
      for (int j = 0; j < 8; ++j) acc[i][j] = (f32x4){0.f, 0.f, 0.f, 0.f};
    gemm_tile_wide(A, K, m0, Wt, K, n0, K, acc, sA);
#pragma unroll
    for (int i = 0; i < 4; ++i)
#pragma unroll
      for (int j = 0; j < 8; ++j) {
        const int col = n0 + wn * 128 + 16 * j + l15;
#pragma unroll
        for (int e = 0; e < 4; ++e) {
          float v = acc[i][j][e];
          if (EPI == 1) { v = fmaxf(v, 0.f); v = v * v; }
          sA[(wm * 64 + 16 * i + G * 4 + e) * 264 + (col - n0)] = f2bf(v);
        }
      }
    __syncthreads();
    {
      const int tc = tid_();
#pragma unroll 4
      for (int k16 = 0; k16 < 16; ++k16) {
        const int id = tc + 256 * k16;
        const int row = id >> 5, cch = (id & 31) * 8;
        *(u32x4*)(outp + (long)(m0 + row) * N + n0 + cch) = *(const u32x4*)&sA[row * 264 + cch];
      }
    }
    __syncthreads();
  }
}

__device__ __forceinline__ void phase_ple(const Params& P, char* smem) {
  char* ws = P.ws;
  u16* sA = (u16*)smem;
  u16* Z3b = (u16*)(ws + OFF_Z3);
  for (int t = bid_(); t < 512; t += gridDim.x) {
    const int nt = t >> 7, mt = t & 127;
    const int m0 = mt * 128, n0 = nt * 256;
    f32x4 acc[4][8];
#pragma unroll
    for (int i = 0; i < 4; ++i)
#pragma unroll
      for (int j = 0; j < 8; ++j) acc[i][j] = (f32x4){0.f, 0.f, 0.f, 0.f};
    gemm_tile_wide((const u16*)(ws + OFF_PB), 256, m0, (const u16*)(ws + OFF_WPLE_T), 256, n0, 256, acc, sA);
    {
      EPI_VARS
#pragma unroll
      for (int i = 0; i < 4; ++i)
#pragma unroll
        for (int j = 0; j < 8; ++j)
#pragma unroll
          for (int e = 0; e < 4; ++e) {
            sA[(wm * 64 + 16 * i + G * 4 + e) * 264 + wn * 128 + 16 * j + l15] = f2bf(acc[i][j][e]);
            acc[i][j][e] = 0.f;
          }
    }
    __syncthreads();
    {
      const int tc = tid_();
#pragma unroll 4
      for (int k16 = 0; k16 < 16; ++k16) {
        const int id = tc + 256 * k16;
        const int row = id >> 5, cch = (id & 31) * 8;
        *(u32x4*)(Z3b + (long)(m0 + row) * 1024 + n0 + cch) = *(const u32x4*)&sA[row * 264 + cch];
      }
    }
    asm volatile("s_waitcnt vmcnt(0)" ::: "memory");
    __syncthreads();
    gemm_tile_wide((const u16*)(ws + OFF_H2B), 1024, m0, (const u16*)(ws + OFF_WPG_T), 1024, n0, 1024, acc, sA);
    {
      const int tc = tid_();
#pragma unroll 4
      for (int k16 = 0; k16 < 16; ++k16) {
        const int id = tc + 256 * k16;
        const int row = id >> 5, cch = (id & 31) * 8;
        *(u32x4*)&sA[row * 264 + cch] = *(const u32x4*)(Z3b + (long)(m0 + row) * 1024 + n0 + cch);
      }
    }
    __syncthreads();
    {
      EPI_VARS
#pragma unroll
      for (int i = 0; i < 4; ++i)
#pragma unroll
        for (int j = 0; j < 8; ++j)
#pragma unroll
          for (int e = 0; e < 4; ++e) {
            u16* sp = &sA[(wm * 64 + 16 * i + G * 4 + e) * 264 + wn * 128 + 16 * j + l15];
            *sp = f2bf(bf2f(*sp) * sigm(acc[i][j][e]));
          }
    }
    __syncthreads();
    {
      const int tc = tid_();
#pragma unroll 4
      for (int k16 = 0; k16 < 16; ++k16) {
        const int id = tc + 256 * k16;
        const int row = id >> 5, cch = (id & 31) * 8;
        *(u32x4*)(Z3b + (long)(m0 + row) * 1024 + n0 + cch) = *(const u32x4*)&sA[row * 264 + cch];
      }
    }
    __syncthreads();
  }
}

template <int MODE, int ZB>
__device__ __forceinline__ void phase_rownorm(const Params& P, const void* Zv, const float* w, const float* w2, u16* nxt) {
  const int tid = tid_(), lane = tid & 63, wave = tid >> 6;
  float* H = P.out;
  for (int un = bid_(); un < 4096; un += gridDim.x) {
    const long row = (long)un * 4 + wave;
    const float* zr = (const float*)Zv + row * 1024;
    const u16* zh = (const u16*)Zv + row * 1024;
    (void)zr; (void)zh;
    const float* hin = (MODE == 0) ? (P.x + row * 1024) : (H + row * 1024);
    float4 z[4], hv[4];
    float ss = 0.f;
#pragma unroll
    for (int j = 0; j < 4; ++j) {
      if (ZB) {
        const u32x2 zz = *(const u32x2*)(zh + j * 256 + lane * 4);
        z[j] = make_float4(__uint_as_float(zz[0] << 16), __uint_as_float(zz[0] & 0xffff0000u), __uint_as_float(zz[1] << 16), __uint_as_float(zz[1] & 0xffff0000u));
      } else z[j] = *(const float4*)(zr + j * 256 + lane * 4);
      hv[j] = *(const float4*)(hin + j * 256 + lane * 4);
      ss += z[j].x * z[j].x + z[j].y * z[j].y + z[j].z * z[j].z + z[j].w * z[j].w;
    }
#pragma unroll
    for (int o = 32; o >= 1; o >>= 1) ss += SHX(ss, o);
    const float r = rsqrtf(ss * (1.f / 1024.f) + 1e-6f);
    float s2 = 0.f;
#pragma unroll
    for (int j = 0; j < 4; ++j) {
      const float4 wv = *(const float4*)(w + j * 256 + lane * 4);
      hv[j].x += z[j].x * r * wv.x; hv[j].y += z[j].y * r * wv.y;
      hv[j].z += z[j].z * r * wv.z; hv[j].w += z[j].w * r * wv.w;
      s2 += hv[j].x * hv[j].x + hv[j].y * hv[j].y + hv[j].z * hv[j].z + hv[j].w * hv[j].w;
      *(float4*)(H + row * 1024 + j * 256 + lane * 4) = hv[j];
    }
    if (MODE == 0) {
#pragma unroll
      for (int o = 32; o >= 1; o >>= 1) s2 += SHX(s2, o);
      const float r2 = rsqrtf(s2 * (1.f / 1024.f) + 1e-6f);
#pragma unroll
      for (int j = 0; j < 4; ++j) {
        const float4 wv = *(const float4*)(w2 + j * 256 + lane * 4);
        u32x2 o2 = {pack2(hv[j].x * r2 * wv.x, hv[j].y * r2 * wv.y), pack2(hv[j].z * r2 * wv.z, hv[j].w * r2 * wv.w)};
        *(u32x2*)(nxt + row * 1024 + j * 256 + lane * 4) = o2;
      }
    } else if (MODE == 1) {
#pragma unroll
      for (int j = 0; j < 4; ++j) {
        u32x2 o2 = {pack2(hv[j].x, hv[j].y), pack2(hv[j].z, hv[j].w)};
        *(u32x2*)(nxt + row * 1024 + j * 256 + lane * 4) = o2;
      }
      const float4 pv = *(const float4*)(P.p + row * 256 + lane * 4);
      u32x2 o2 = {pack2(pv.x, pv.y), pack2(pv.z, pv.w)};
      *(u32x2*)((u16*)(P.ws + OFF_PB) + row * 256 + lane * 4) = o2;
    }
  }
}

#define XB_TMO      128
#define XB_XCNT(j)  (256  + 64 * (j))
#define XB_XSUB(j)  (1280 + 64 * (j))
#define XB_XGEN(j)  (2304 + 64 * (j))
#define XB_TOP      3328
#define XB_TOPGEN   3392
#define XCD_BAR_WORDS 3456
#define XB_SPIN_CAP (1u << 18)
#define LAS __attribute__((address_space(3)))

__device__ __forceinline__ unsigned xb_ld(unsigned* p)              { return __hip_atomic_load(p, __ATOMIC_RELAXED, __HIP_MEMORY_SCOPE_AGENT); }
__device__ __forceinline__ unsigned xb_add(unsigned* p, unsigned v) { return __hip_atomic_fetch_add(p, v, __ATOMIC_RELAXED, __HIP_MEMORY_SCOPE_AGENT); }
__device__ __forceinline__ unsigned xb_xcc_id() { return (unsigned)__builtin_amdgcn_s_getreg((3 << 11) | 20) & 0xFu; }
#define XB_SPIN(cond, bar) do { unsigned _sp = 0; while (cond) { __builtin_amdgcn_s_sleep(1); \
    if ((++_sp & 255u) == 0u) { if (xb_ld(&(bar)[XB_TMO])) break; if (_sp > XB_SPIN_CAP) { atomicAdd(&(bar)[XB_TMO], 1u); break; } } } } while (0)

struct XcdBarrier {
    unsigned* bar; unsigned x;
    volatile LAS unsigned* st;
};

__device__ __forceinline__ XcdBarrier xcd_barrier_post(unsigned* bar, volatile LAS unsigned* st) {
    XcdBarrier b; b.bar = bar; b.x = xb_xcc_id(); b.st = st;
    if (tid_() == 0) (void)xb_add(&bar[XB_XCNT(b.x)], 1u);
    return b;
}
__device__ __forceinline__ void xcd_barrier_complete(unsigned* bar, unsigned x, unsigned& nloc, unsigned& nx) {
    const unsigned G = gridDim.x * gridDim.y * gridDim.z;
    unsigned sum, cnt, mine, sp = 0u;
    for (;;) {
        sum = 0u; cnt = 0u; mine = 0u;
#pragma unroll
        for (unsigned j = 0; j < 16; ++j) { const unsigned c = xb_ld(&bar[XB_XCNT(j)]); sum += c; cnt += (c > 0u) ? 1u : 0u; mine = (j == x) ? c : mine; }
        if (sum == G) break;
        __builtin_amdgcn_s_sleep(1);
        if ((++sp & 255u) == 0u) { if (xb_ld(&bar[XB_TMO])) break; if (sp > XB_SPIN_CAP) { atomicAdd(&bar[XB_TMO], 1u); break; } }
    }
    nloc = mine > 0u ? mine : 1u; nx = cnt > 0u ? cnt : 1u;
}

__device__ __forceinline__ void xcd_barrier(const XcdBarrier& b) {
    asm volatile("s_waitcnt vmcnt(0)" ::: "memory");
    __syncthreads();
    if (tid_() == 0) {
        unsigned* bar = b.bar;
        __builtin_amdgcn_s_waitcnt(0);
        unsigned nloc = b.st[0], nx = b.st[1];
        if (nloc == 0u) { xcd_barrier_complete(bar, b.x, nloc, nx); b.st[0] = nloc; b.st[1] = nx; }
        const unsigned old = xb_add(&bar[XB_XSUB(b.x)], 1u);
        const unsigned gen = old / nloc;
        if (old + 1u == (gen + 1u) * nloc) {
            __builtin_amdgcn_fence(__ATOMIC_RELEASE, "agent");
            asm volatile("s_waitcnt vmcnt(0)" ::: "memory");
            const unsigned og = xb_add(&bar[XB_TOP], 1u);
            const unsigned tg = og / nx;
            if (og + 1u == (tg + 1u) * nx) xb_add(&bar[XB_TOPGEN], 1u);
            else XB_SPIN(xb_ld(&bar[XB_TOPGEN]) == tg, bar);
            __builtin_amdgcn_fence(__ATOMIC_ACQUIRE, "agent");
            xb_add(&bar[XB_XGEN(b.x)], 1u);
            asm volatile("s_waitcnt vmcnt(0)" ::: "memory");
        } else {
            XB_SPIN(xb_ld(&bar[XB_XGEN(b.x)]) == gen, bar);
            __builtin_amdgcn_fence(__ATOMIC_ACQUIRE, "agent");
            asm volatile("s_waitcnt vmcnt(0)" ::: "memory");
        }
    }
    __syncthreads();
}

#define OFF_BAR (252 * MIB)
#define GSYNC() do { XcdBarrier xb_; xb_.bar = (unsigned*)(P.ws + OFF_BAR); xb_.x = xb_xcc_id(); xb_.st = (volatile LAS unsigned*)&xb_words; xcd_barrier(xb_); } while (0)
__global__ void __launch_bounds__(256, 2) k_mega(Params P) {
  __shared__ __attribute__((aligned(16))) char smem[67584];
  char* ws = P.ws;
  __shared__ uint4 xb_words;
  if (tid_() == 0) xb_words = make_uint4(0u, 0u, 0u, 0u);
  __syncthreads();
  (void)xcd_barrier_post((unsigned*)(ws + OFF_BAR), (volatile LAS unsigned*)&xb_words);
  phase_prep(P, smem);
  GSYNC();
#pragma unroll 1
  for (int half = 0; half < 2; ++half) {
    phase_inproj(P, half, smem);
    GSYNC();
#if PROBE_DUP == 1
    phase_inproj(P, half, smem);
    GSYNC();
#endif
    if ((int)gridDim.x > 128) {
      const int b2 = bid_();
      if (b2 < 64) cmp_gemm1_tile(P, b2, smem);
      else for (int u = b2 - 64; u < 1024; u += (int)gridDim.x - 64) hgrn_intra_unit(P, u, smem);
    } else {
      for (int t = bid_(); t < 64; t += gridDim.x) cmp_gemm1_tile(P, t, smem);
      for (int u = bid_(); u < 1024; u += gridDim.x) hgrn_intra_unit(P, u, smem);
    }
    GSYNC();
    for (int t = bid_(); t < 32; t += gridDim.x) cmp_gemm2_tile(P, t, smem);
    hgrn_scan(P);
    if (half == 1) phase_late_weights(P, smem);
    GSYNC();
#if PROBE_DUP == 2
    for (int u = bid_(); u < 1024; u += gridDim.x) nsa_unit(P, half, u, smem);
    GSYNC();
#endif
    for (int u = bid_(); u < 1024; u += gridDim.x) nsa_unit(P, half, u, smem);
    for (int u = bid_(); u < 1024; u += gridDim.x) hgrn_out_unit(P, half, u, smem);
    GSYNC();
  }
  phase_branch_merge(P, smem);
  GSYNC();
#if PROBE_DUP == 3
  phase_branch_merge(P, smem);
  GSYNC();
  phase_gemm<2>((const u16*)(ws + OFF_MERGED), 1024, (const u16*)(ws + OFF_WOUT_T), 1024, ws + OFF_Z1, smem);
  GSYNC();
#endif
  phase_gemm_wide<2>((const u16*)(ws + OFF_MERGED), 1024, (const u16*)(ws + OFF_WOUT_T), 1024, (u16*)(ws + OFF_Z1), smem);
  GSYNC();
  phase_rownorm<0, 1>(P, (const void*)(ws + OFF_Z1), P.n_post_mix, P.n_pre_mlp, (u16*)(ws + OFF_V));
  GSYNC();
#if PROBE_DUP == 4
  phase_gemm<1>((const u16*)(ws + OFF_V), 1024, (const u16*)(ws + OFF_WUP_T), 4096, ws + OFF_FFH, smem);
  GSYNC();
#endif
  phase_gemm_wide<1>((const u16*)(ws + OFF_V), 1024, (const u16*)(ws + OFF_WUP_T), 4096, (u16*)(ws + OFF_FFH), smem);
  GSYNC();
#if PROBE_DUP == 4
  phase_gemm<2>((const u16*)(ws + OFF_FFH), 4096, (const u16*)(ws + OFF_WDOWN_T), 1024, ws + OFF_Z2, smem);
  GSYNC();
#endif
  phase_gemm_wide<2>((const u16*)(ws + OFF_FFH), 4096, (const u16*)(ws + OFF_WDOWN_T), 1024, (u16*)(ws + OFF_Z2), smem);
  GSYNC();
  phase_rownorm<1, 1>(P, (const void*)(ws + OFF_Z2), P.n_post_mlp, nullptr, (u16*)(ws + OFF_H2B));
  GSYNC();
  phase_ple(P, smem);
  GSYNC();
#if PROBE_DUP == 5
  for (int i = 0; i < 10; ++i) GSYNC();
#endif
#if PROBE_DUP == 6
  phase_prep(P, smem);
  GSYNC();
#endif
  phase_rownorm<2, 1>(P, (const void*)(P.ws + OFF_Z3), P.n_ple, nullptr, nullptr);
}

extern "C" void kernel_launch(void* const* d_in, const int* in_sizes, int n_in, void* d_out, int out_size, void* d_ws,
                              size_t ws_size, hipStream_t stream) {
  Params P{};
  P.x = (const float*)d_in[0];
  P.p = (const float*)d_in[1];
  P.w_in = (const float*)d_in[2];
  P.w_a = (const float*)d_in[3];
  P.w_b = (const float*)d_in[4];
  P.w_out = (const float*)d_in[5];
  P.n_pre_mix = (const float*)d_in[6];
  P.n_post_mix = (const float*)d_in[7];
  P.n_pre_mlp = (const float*)d_in[8];
  P.n_post_mlp = (const float*)d_in[9];
  P.lb_logits = (const float*)d_in[10];
  P.gnorm = (const float*)d_in[11];
  P.pe_k = (const float*)d_in[12];
  P.pe_v = (const float*)d_in[13];
  P.wk1 = (const float*)d_in[14];
  P.wk2 = (const float*)d_in[15];
  P.wv1 = (const float*)d_in[16];
  P.wv2 = (const float*)d_in[17];
  P.w_up = (const float*)d_in[18];
  P.w_down = (const float*)d_in[19];
  P.w_ple = (const float*)d_in[20];
  P.w_pg = (const float*)d_in[21];
  P.n_ple = (const float*)d_in[22];
  P.out = (float*)d_out;
  P.ws = (char*)d_ws;
#if MEGA
  static int grid_blocks = 0;
  if (!grid_blocks) {
    int dev = 0, cus = 0, per_cu = 0;
    hipGetDevice(&dev);
    hipDeviceGetAttribute(&cus, hipDeviceAttributeMultiprocessorCount, dev);
    hipOccupancyMaxActiveBlocksPerMultiprocessor(&per_cu, k_mega, 256, 0);
    if (per_cu > 2) per_cu = 2;
    if (per_cu < 1) per_cu = 1;
    grid_blocks = cus * per_cu;
  }
  hipMemsetAsync((char*)d_ws + OFF_BAR, 0, XCD_BAR_WORDS * sizeof(unsigned), stream);
  void* args[] = {&P};
  hipError_t e = hipLaunchCooperativeKernel((void*)k_mega, dim3(grid_blocks), dim3(256), args, 0, stream);
  if (e != hipSuccess) fprintf(stderr, "cooperative launch failed: %s (grid %d)\n", hipGetErrorString(e), grid_blocks);
#endif
}
```

```cpp
#include <hip/hip_runtime.h>
#include <hip/hip_cooperative_groups.h>
#include <cstdio>
#include <cstdint>
namespace cg = cooperative_groups;

#ifndef MEGA
#define MEGA 1
#endif
#ifndef PROBE_DUP
#define PROBE_DUP 0
#endif

typedef unsigned short u16;
typedef __attribute__((ext_vector_type(8))) short bf16x8;
typedef __attribute__((ext_vector_type(4))) float f32x4;
typedef __attribute__((ext_vector_type(4))) unsigned u32x4;
typedef __attribute__((ext_vector_type(2))) unsigned u32x2;

#define MFMA(a, b, c) __builtin_amdgcn_mfma_f32_16x16x32_bf16(a, b, c, 0, 0, 0)
#define MIB ((size_t)1 << 20)

#define OFF_U       (0 * MIB)
#define OFF_YB0     (0 * MIB)
#define OFF_WA_T    (16 * MIB)
#define OFF_WB_T    (18 * MIB)
#define OFF_WOUT_T  (20 * MIB)
#define OFF_WPG_T   (22 * MIB)
#define OFF_WPLE_T  (24 * MIB)
#define OFF_WIN_T   (32 * MIB)
#define OFF_WUP_T   (32 * MIB)
#define OFF_WDOWN_T (40 * MIB)
#define OFF_WK1T    (50 * MIB)
#define OFF_WV1T    (51 * MIB)
#define OFF_WK2T    (52 * MIB)
#define OFF_WV2T    (52 * MIB + 32768)
#define OFF_ROPE    (52 * MIB + 65536)
#define OFF_BIAS1   (52 * MIB + 65536 + 262144)
#define OFF_LB      (52 * MIB + 65536 + 262144 + 4096)
#define OFF_BIAS1P  (52 * MIB + 65536 + 262144 + 16384)
#define OFF_NGATE   (53 * MIB)
#define OFF_SG      (56 * MIB)
#define OFF_NQ      (88 * MIB)
#define OFF_QF      (120 * MIB)
#define OFF_LOGF    (136 * MIB)
#define OFF_YB1     (136 * MIB)
#define OFF_HVT     (152 * MIB)
#define OFF_ABUF    (168 * MIB)
#define OFF_UST     (176 * MIB)
#define OFF_KV      (208 * MIB)
#define OFF_NQR     (224 * MIB)
#define OFF_VST     (228 * MIB)
#define OFF_VWT     (232 * MIB)
#define OFF_DCY     (236 * MIB)
#define OFF_HIDK    (236 * MIB + 524288)
#define OFF_HIDV    (237 * MIB + 524288)
#define OFF_KCMP    (238 * MIB + 524288)
#define OFF_VCMPT   (238 * MIB + 524288 + 262144)
#define OFF_MERGED  (88 * MIB)
#define OFF_Z1      (152 * MIB)
#define OFF_V       (56 * MIB)
#define OFF_FFH     (120 * MIB)
#define OFF_Z2      (56 * MIB)
#define OFF_H2B     (120 * MIB)
#define OFF_PB      (152 * MIB)
#define OFF_Z3      (160 * MIB)

struct Params {
  const float *x, *p, *w_in, *w_a, *w_b, *w_out, *n_pre_mix, *n_post_mix, *n_pre_mlp, *n_post_mlp;
  const float *lb_logits, *gnorm, *pe_k, *pe_v, *wk1, *wk2, *wv1, *wv2, *w_up, *w_down, *w_ple, *w_pg, *n_ple;
  float* out;
  char* ws;
};

__device__ __forceinline__ int bid_() { int b = blockIdx.x; asm volatile("" : "+s"(b)); return b; }
__device__ __forceinline__ int tid_() { int t = threadIdx.x; asm volatile("" : "+v"(t)); return t; }
typedef __attribute__((ext_vector_type(2))) float f32x2_t;
typedef __attribute__((ext_vector_type(2))) __bf16 bf16x2_t;
__device__ __forceinline__ uint32_t pack2(float a, float b) {
  f32x2_t v = {a, b};
  return __builtin_bit_cast(uint32_t, __builtin_convertvector(v, bf16x2_t));
}
__device__ __forceinline__ u16 f2bf(float f) { return (u16)(pack2(f, f) & 0xffffu); }
__device__ __forceinline__ float bf2f(u16 h) { return __uint_as_float(((uint32_t)h) << 16); }
__device__ __forceinline__ float shx_f(float v, int src_lane) { return __int_as_float(__builtin_amdgcn_ds_bpermute(src_lane << 2, __float_as_int(v))); }
__device__ __forceinline__ uint32_t shx_u(uint32_t v, int src_lane) { return (uint32_t)__builtin_amdgcn_ds_bpermute(src_lane << 2, (int)v); }
#define SHX(v, m) shx_f((v), lane ^ (m))
#define SHXU(v, m) shx_u((v), lane ^ (m))
__device__ __forceinline__ float sigm(float x) { return __builtin_amdgcn_rcpf(1.f + __expf(-x)); }
__device__ __forceinline__ float siluf(float x) { return x * __builtin_amdgcn_rcpf(1.f + __expf(-x)); }
__device__ __forceinline__ float gelu_tanh(float x) {
  float u = 0.7978845608028654f * (x + 0.044715f * x * x * x);
  float t = 1.f - 2.f * __builtin_amdgcn_rcpf(__expf(2.f * u) + 1.f);
  return 0.5f * x * (1.f + t);
}
__device__ __forceinline__ bf16x8 mk8(uint32_t a, uint32_t b, uint32_t c, uint32_t d) {
  u32x4 v = {a, b, c, d};
  return __builtin_bit_cast(bf16x8, v);
}
__device__ __forceinline__ bf16x8 ld8(const u16* p) { return *(const bf16x8*)p; }

template <int AMODE, int DEEP>
__device__ __forceinline__ void gemm_tile(const u16* __restrict__ A, long lda, int m0, int M,
                                          const u16* __restrict__ Bt, long ldb, int n0, int N, int K,
                                          int coloff, f32x4 (&acc)[4][4], u16* sA, u16* sB) {
  const int tid = tid_(), lane = tid & 63, wave = tid >> 6;
  const int l15 = lane & 15, G = lane >> 4;
  const int wm = wave >> 1, wn = wave & 1;
  const int lr = tid >> 3, ch = tid & 7;
  const char* Ab = (const char*)A;
  const char* Bb = (const char*)Bt;
  unsigned oa[4], ob[4];
  int tok0[4];
#pragma unroll
  for (int i = 0; i < 4; ++i) {
    int r = m0 + lr + 32 * i;
    if (AMODE == 0) {
      if (r > M - 1) r = M - 1;
      oa[i] = (unsigned)(((long)r * lda + ch * 8) * 2);
      tok0[i] = 0;
    } else {
      int grp = r >> 8, n = r & 255;
      int bl = grp >> 2, g = grp & 3;
      tok0[i] = n * 16;
      oa[i] = (unsigned)((bl * 4096 * 1024 + coloff + g * 64 + ch * 8) * 2);
    }
    int rn = n0 + lr + 32 * i;
    if (rn > N - 1) rn = N - 1;
    ob[i] = (unsigned)(((long)rn * ldb + ch * 8) * 2);
  }
#define G_LOAD(RA, RB, KT)                                                                                   \
  {                                                                                                          \
    const char* Ak_ = Ab + (size_t)(KT) * 128;                                                               \
    const char* Bk_ = Bb + (size_t)(KT) * 128;                                                               \
    _Pragma("unroll") for (int i = 0; i < 4; ++i) {                                                          \
      if (AMODE == 0) RA[i] = *(const u32x4*)(Ak_ + oa[i]);                                                  \
      else { int tok = tok0[i] + (KT); if (tok > 4095) tok = 4095; RA[i] = *(const u32x4*)(Ab + (oa[i] + (unsigned)tok * 2048u)); } \
      RB[i] = *(const u32x4*)(Bk_ + ob[i]);                                                                  \
    }                                                                                                        \
  }
#define L_STORE(RA, RB)                                                                                      \
  _Pragma("unroll") for (int i = 0; i < 4; ++i) {                                                            \
    *(u32x4*)&sA[(lr + 32 * i) * 80 + ch * 8] = RA[i];                                                       \
    *(u32x4*)&sB[(lr + 32 * i) * 80 + ch * 8] = RB[i];                                                       \
  }
#define T_COMPUTE()                                                                                          \
  _Pragma("unroll") for (int ks = 0; ks < 2; ++ks) {                                                         \
    bf16x8 af[4], bfr[4];                                                                                    \
    _Pragma("unroll") for (int i = 0; i < 4; ++i) af[i] = ld8(&sA[(wm * 64 + 16 * i + l15) * 80 + ks * 32 + G * 8]);  \
    _Pragma("unroll") for (int j = 0; j < 4; ++j) bfr[j] = ld8(&sB[(wn * 64 + 16 * j + l15) * 80 + ks * 32 + G * 8]); \
    _Pragma("unroll") for (int i = 0; i < 4; ++i)                                                            \
      _Pragma("unroll") for (int j = 0; j < 4; ++j) acc[i][j] = MFMA(af[i], bfr[j], acc[i][j]);              \
  }                                                                                                          \
     \
  __builtin_amdgcn_sched_group_barrier(0x100, 8, 0);                                                         \
  _Pragma("unroll") for (int z = 0; z < 8; ++z) {                                                            \
    __builtin_amdgcn_sched_group_barrier(0x008, 2, 0);                                                       \
    __builtin_amdgcn_sched_group_barrier(0x100, 1, 0);                                                       \
  }                                                                                                          \
  __builtin_amdgcn_sched_group_barrier(0x008, 16, 0);
  const int nk = K >> 6;
  if (DEEP == 2) {
    u32x4 ra0[4], rb0[4], ra1[4], rb1[4];
    const int kl = nk - 1;
    G_LOAD(ra0, rb0, 0);
    G_LOAD(ra1, rb1, 1);
    for (int kt = 0; kt < nk; kt += 2) {
      L_STORE(ra0, rb0);
      __syncthreads();
      G_LOAD(ra0, rb0, (kt + 2 < kl ? kt + 2 : kl));
      T_COMPUTE();
      __syncthreads();
      L_STORE(ra1, rb1);
      __syncthreads();
      G_LOAD(ra1, rb1, (kt + 3 < kl ? kt + 3 : kl));
      T_COMPUTE();
      __syncthreads();
    }
  } else {
    u32x4 ra0[4], rb0[4];
    G_LOAD(ra0, rb0, 0);
    for (int kt = 0; kt < nk; ++kt) {
      L_STORE(ra0, rb0);
      __syncthreads();
      if (kt + 1 < nk) G_LOAD(ra0, rb0, kt + 1);
      T_COMPUTE();
      __syncthreads();
    }
  }
#undef G_LOAD
#undef L_STORE
#undef T_COMPUTE
}

__device__ __forceinline__ void zero_acc(f32x4 (&acc)[4][4]) {
#pragma unroll
  for (int i = 0; i < 4; ++i)
#pragma unroll
    for (int j = 0; j < 4; ++j) acc[i][j] = (f32x4){0.f, 0.f, 0.f, 0.f};
}

#define EPI_VARS                                                         \
  const int tid = tid_(), lane = tid & 63, wave = tid >> 6;         \
  const int l15 = lane & 15, G = lane >> 4;                              \
  const int wm = wave >> 1, wn = wave & 1;                               \
  (void)l15; (void)G; (void)wm; (void)wn;

__device__ __forceinline__ void transpose_tile(const float* __restrict__ W, int ldw, int oc0, int valid, int k0, u16* __restrict__ out,
                               long Kdim, int n0, float* s  ) {
  const int tid = tid_();
  __syncthreads();
  {
    const bool vec = (valid == 64) && (((oc0 | ldw) & 3) == 0);
    if (vec) {
      const int n4 = (tid & 15) * 4;
      float4 v[4];
#pragma unroll
      for (int i = 0; i < 4; ++i) v[i] = *(const float4*)(W + (long)(k0 + (tid >> 4) + 16 * i) * ldw + oc0 + n4);
#pragma unroll
      for (int i = 0; i < 4; ++i) {
        float* d = &s[((tid >> 4) + 16 * i) * 65 + n4];
        d[0] = v[i].x; d[1] = v[i].y; d[2] = v[i].z; d[3] = v[i].w;
      }
    } else {
      const int n = tid & 63;
      for (int kk = tid >> 6; kk < 64; kk += 4) {
        float v = 0.f;
        if (n < valid) v = W[(long)(k0 + kk) * ldw + oc0 + n];
        s[kk * 65 + n] = v;
      }
    }
  }
  __syncthreads();
  {
    const int nn = tid >> 2, kq = (tid & 3) * 16;
    uint32_t w[8];
#pragma unroll
    for (int e = 0; e < 8; ++e) w[e] = pack2(s[(kq + 2 * e) * 65 + nn], s[(kq + 2 * e + 1) * 65 + nn]);
    u16* dst = out + (long)(n0 + nn) * Kdim + k0 + kq;
    *(u32x4*)dst = (u32x4){w[0], w[1], w[2], w[3]};
    *(u32x4*)(dst + 8) = (u32x4){w[4], w[5], w[6], w[7]};
  }
}

__device__ __forceinline__ void transpose_job(const float* W, int N, int K, u16* out, int tile, float* s) {
  const int kt_n = K >> 6;
  const int nt = tile / kt_n, kt = tile % kt_n;
  transpose_tile(W, N, nt * 64, 64, kt * 64, out, K, nt * 64, s);
}

__device__ __forceinline__ void phase_prep(const Params& P, char* smem) {
  const int tid = tid_(), lane = tid & 63, wave = tid >> 6;
  char* ws = P.ws;
  float* sf = (float*)smem;
  {
    u16* U = (u16*)(ws + OFF_U);
    for (int un = bid_(); un < 2048; un += gridDim.x) {
      const int row0 = un * 8 + wave * 2;
      float4 v[2][4];
      float ss[2] = {0.f, 0.f};
#pragma unroll
      for (int rr = 0; rr < 2; ++rr)
#pragma unroll
        for (int j = 0; j < 4; ++j) v[rr][j] = *(const float4*)(P.x + (long)(row0 + rr) * 1024 + j * 256 + lane * 4);
#pragma unroll
      for (int rr = 0; rr < 2; ++rr) {
#pragma unroll
        for (int j = 0; j < 4; ++j)
          ss[rr] += v[rr][j].x * v[rr][j].x + v[rr][j].y * v[rr][j].y + v[rr][j].z * v[rr][j].z + v[rr][j].w * v[rr][j].w;
#pragma unroll
        for (int o = 32; o >= 1; o >>= 1) ss[rr] += SHX(ss[rr], o);
        const float r = rsqrtf(ss[rr] * (1.f / 1024.f) + 1e-6f);
#pragma unroll
        for (int j = 0; j < 4; ++j) {
          const float4 w = *(const float4*)(P.n_pre_mix + j * 256 + lane * 4);
          u32x2 o2 = {pack2(v[rr][j].x * r * w.x, v[rr][j].y * r * w.y), pack2(v[rr][j].z * r * w.z, v[rr][j].w * r * w.w)};
          *(u32x2*)(U + (long)(row0 + rr) * 1024 + j * 256 + lane * 4) = o2;
        }
      }
    }
  }
  {
    u16* WT = (u16*)(ws + OFF_WIN_T);
    for (int t = bid_(); t < 138 * 16; t += gridDim.x) {
      const int nt = t >> 4, kt = t & 15;
      const int nr0 = nt * 64;
      int oc0, valid;
      if (nr0 < 6656) { oc0 = nr0; valid = 64; }
      else if (nr0 < 8704) { oc0 = nr0 + 48; valid = 64; }
      else if (nr0 == 8704) { oc0 = 6656; valid = 48; }
      else { oc0 = 0; valid = 0; }
      transpose_tile(P.w_in, 8752, oc0, valid, kt * 64, WT, 1024, nr0, sf);
    }
    for (int t = bid_(); t < 128; t += gridDim.x) transpose_job(P.wk1, 256, 2048, (u16*)(ws + OFF_WK1T), t, sf);
    for (int t = bid_(); t < 128; t += gridDim.x) transpose_job(P.wv1, 256, 2048, (u16*)(ws + OFF_WV1T), t, sf);
    for (int t = bid_(); t < 4; t += gridDim.x) transpose_job(P.wk2, 64, 256, (u16*)(ws + OFF_WK2T), t, sf);
    for (int t = bid_(); t < 4; t += gridDim.x) transpose_job(P.wv2, 64, 256, (u16*)(ws + OFF_WV2T), t, sf);
  }
  {
    float2* RT = (float2*)(ws + OFF_ROPE);
    for (int un = bid_(); un < 128; un += gridDim.x) {
      const int idx = un * 256 + tid;
      const int t = idx >> 3, j = idx & 7;
      const float inv = (j == 0) ? 1.0f : (j == 1) ? 0.1939227432012558f : (j == 2) ? 0.03760603070259094f
                      : (j == 3) ? 0.007292664609849453f : (j == 4) ? 0.0014142135623842478f
                      : (j == 5) ? 0.00027424818836152554f : (j == 6) ? 5.3182957344688475e-05f : 1.0313385246263351e-05f;
      const float ang = (float)t * inv;
      const double ad = (double)ang;
      const double kq = rint(ad * 0.15915494309189535);
      const float rr = (float)(ad - kq * 6.283185307179586);
      float sn, cs;
      sincosf(rr, &sn, &cs);
      RT[idx] = make_float2(cs, sn);
    }
  }
  {
    float* B1P = (float*)(ws + OFF_BIAS1P);
    for (int un = bid_(); un < 16; un += gridDim.x) {
      const int kvi = un >> 3, part = un & 7;
      const float* pe = kvi ? P.pe_v : P.pe_k;
      const float* w1 = kvi ? P.wv1 : P.wk1;
      float4 a = make_float4(0.f, 0.f, 0.f, 0.f);
      const int k0 = part * 256 + wave * 64;
#pragma unroll 8
      for (int k = k0; k < k0 + 64; ++k) {
        const float pv = pe[k];
        const float4 w = *(const float4*)(w1 + (long)k * 256 + lane * 4);
        a.x += pv * w.x; a.y += pv * w.y; a.z += pv * w.z; a.w += pv * w.w;
      }
      __syncthreads();
      *(float4*)&sf[wave * 256 + lane * 4] = a;
      __syncthreads();
      B1P[un * 256 + tid] = sf[tid] + sf[256 + tid] + sf[512 + tid] + sf[768 + tid];
      __syncthreads();
    }
  }
  {
    float* LB = (float*)(ws + OFF_LB);
    for (int un = bid_(); un < 4; un += gridDim.x) {
      const int c = un * 256 + tid;
      const float l0 = P.lb_logits[c], l1 = P.lb_logits[1024 + c];
      LB[c] = 1.f / (1.f + expf(l1 - l0));
    }
  }
}

__device__ __forceinline__ void phase_late_weights(const Params& P, char* smem) {
  char* ws = P.ws;
  float* sf = (float*)smem;
  for (int t = bid_(); t < 256; t += gridDim.x) transpose_job(P.w_a, 1024, 1024, (u16*)(ws + OFF_WA_T), t, sf);
  for (int t = bid_(); t < 256; t += gridDim.x) transpose_job(P.w_b, 1024, 1024, (u16*)(ws + OFF_WB_T), t, sf);
  for (int t = bid_(); t < 256; t += gridDim.x) transpose_job(P.w_out, 1024, 1024, (u16*)(ws + OFF_WOUT_T), t, sf);
  for (int t = bid_(); t < 256; t += gridDim.x) transpose_job(P.w_pg, 1024, 1024, (u16*)(ws + OFF_WPG_T), t, sf);
  for (int t = bid_(); t < 1024; t += gridDim.x) transpose_job(P.w_up, 4096, 1024, (u16*)(ws + OFF_WUP_T), t, sf);
  for (int t = bid_(); t < 1024; t += gridDim.x) transpose_job(P.w_down, 1024, 4096, (u16*)(ws + OFF_WDOWN_T), t, sf);
  for (int t = bid_(); t < 64; t += gridDim.x) transpose_job(P.w_ple, 1024, 256, (u16*)(ws + OFF_WPLE_T), t, sf);
}

__device__ __forceinline__ void phase_inproj(const Params& P, int half, char* smem) {
  char* ws = P.ws;
  u16* sA = (u16*)smem;
  u16* sB = sA + 128 * 80;
  float* sF = (float*)smem;
  const u16* U = (const u16*)(ws + OFF_U) + (long)half * 8192 * 1024;
  const u16* WT = (const u16*)(ws + OFF_WIN_T);
  u16* QF = (u16*)(ws + OFF_QF);
  u16* LOGF = (u16*)(ws + OFF_LOGF);
  u16* HVT = (u16*)(ws + OFF_HVT);
  u16* SG = (u16*)(ws + OFF_SG) + (long)half * 8192 * 1024;
  u16* NQ = (u16*)(ws + OFF_NQ) + (long)half * 8192 * 1024;
  u16* NQR = (u16*)(ws + OFF_NQR);
  u16* KV = (u16*)(ws + OFF_KV);
  u16* VST = (u16*)(ws + OFF_VST);
  u16* VWT = (u16*)(ws + OFF_VWT);
  u16* GATES = (u16*)P.out + (long)half * 8192 * 2048;
  float* NGATE = (float*)(ws + OFF_NGATE) + (long)half * 8192 * 48;
  const float* RTf = (const float*)(ws + OFF_ROPE);
  const float* LB = (const float*)(ws + OFF_LB);
  for (int t = bid_(); t < 64 * 69; t += gridDim.x) {
    const int nt = t >> 6, mt = t & 63;
    const int m0 = mt * 128, n0 = nt * 128;
    f32x4 acc[4][4];
    zero_acc(acc);
    gemm_tile<0, 2>(U, 1024, m0, 8192, WT, 1024, n0, 8832, 1024, 0, acc, sA, sB);
    {
      EPI_VARS
#pragma unroll
      for (int i = 0; i < 4; ++i)
#pragma unroll
        for (int j = 0; j < 4; ++j)
#pragma unroll
          for (int e = 0; e < 4; ++e) sF[(wm * 64 + 16 * i + G * 4 + e) * 132 + wn * 64 + 16 * j + l15] = acc[i][j][e];
    }
    __syncthreads();
    const int tc = tid_();
    int kind = 0, op = 0, dstride = 1024, dcol = 0;
    u16* dbase = nullptr;
    u16* tbase = nullptr;
    if (nt < 8) { dbase = QF; dcol = n0; op = 0; }
    else if (nt < 16) { dbase = LOGF; dcol = n0 - 1024; op = 1; }
    else if (nt < 24) { kind = 1; tbase = HVT; }
    else if (nt < 32) { dbase = SG; dcol = n0 - 3072; op = 2; }
    else if (nt < 40) { dbase = NQ; dcol = n0 - 4096; op = 3; }
    else if (nt < 52) {
      const int c0 = n0 - 5120, sub0 = c0 >> 8;
      if (sub0 == 3 || sub0 == 5) { kind = 2; tbase = (sub0 == 3) ? VST : VWT; }
      else { dbase = KV; dcol = ((sub0 == 0) ? 0 : (sub0 == 1) ? 256 : (sub0 == 2) ? 512 : 768) + (c0 & 255); op = (sub0 >= 2) ? 5 : 4; }
    } else if (nt < 68) { dbase = GATES; dstride = 2048; dcol = n0 - 6656; op = 6; }
    else kind = 3;

    if (kind == 0) {
#pragma unroll 2
      for (int k8 = 0; k8 < 8; ++k8) {
        const int id = tc + 256 * k8;
        const int row = id >> 4, c8 = (id & 15) * 8;
        const float4 f0 = *(const float4*)&sF[row * 132 + c8];
        const float4 f1 = *(const float4*)&sF[row * 132 + c8 + 4];
        float v[8] = {f0.x, f0.y, f0.z, f0.w, f1.x, f1.y, f1.z, f1.w};
        const int hc = c8 & 63;
        if (op == 0) {
#pragma unroll
          for (int q = 0; q < 8; ++q) v[q] = siluf(v[q]) * 0.08838834764831845f;
        } else if (op == 1) {
          const float4 l0 = *(const float4*)(LB + dcol + c8);
          const float4 l1 = *(const float4*)(LB + dcol + c8 + 4);
          const float lb[8] = {l0.x, l0.y, l0.z, l0.w, l1.x, l1.y, l1.z, l1.w};
#pragma unroll
          for (int q = 0; q < 8; ++q) v[q] = __logf(lb[q] + (1.f - lb[q]) * sigm(v[q]));
        } else if (op == 2) {
#pragma unroll
          for (int q = 0; q < 8; ++q) v[q] = siluf(v[q]);
        } else if (op == 3) {
#pragma unroll
          for (int q = 0; q < 8; ++q) v[q] *= 0.18033688011112042f;
        } else if (op == 6) {
#pragma unroll
          for (int q = 0; q < 8; ++q) v[q] = sigm(v[q]);
        }
        if ((op == 3 || op == 5) && hc < 16) {
          const int pc = (hc == 0) ? c8 + 8 : c8 - 8;
          const float4 g0 = *(const float4*)&sF[row * 132 + pc];
          const float4 g1 = *(const float4*)&sF[row * 132 + pc + 4];
          float pr[8] = {g0.x, g0.y, g0.z, g0.w, g1.x, g1.y, g1.z, g1.w};
          if (op == 3) {
#pragma unroll
            for (int q = 0; q < 8; ++q) pr[q] *= 0.18033688011112042f;
          }
          const int tt = (m0 + row) & 4095;
          const float4 r0 = *(const float4*)(RTf + tt * 16);
          const float4 r1 = *(const float4*)(RTf + tt * 16 + 4);
          const float4 r2 = *(const float4*)(RTf + tt * 16 + 8);
          const float4 r3 = *(const float4*)(RTf + tt * 16 + 12);
          const float cs[8] = {r0.x, r0.z, r1.x, r1.z, r2.x, r2.z, r3.x, r3.z};
          const float sn[8] = {r0.y, r0.w, r1.y, r1.w, r2.y, r2.w, r3.y, r3.w};
          float ro[8];
#pragma unroll
          for (int q = 0; q < 8; ++q) ro[q] = (hc == 0) ? (v[q] * cs[q] - pr[q] * sn[q]) : (v[q] * cs[q] + pr[q] * sn[q]);
          if (op == 3) {
            const int head = (dcol + c8) >> 6;
            *(u32x4*)(NQR + (long)(m0 + row) * 256 + head * 16 + hc) =
                (u32x4){pack2(ro[0], ro[1]), pack2(ro[2], ro[3]), pack2(ro[4], ro[5]), pack2(ro[6], ro[7])};
          } else {
#pragma unroll
            for (int q = 0; q < 8; ++q) v[q] = ro[q];
          }
        }
        u32x4 o4;
        if (op == 1) {
          union { _Float16 h[8]; u32x4 u; } cv;
#pragma unroll
          for (int q = 0; q < 8; ++q) cv.h[q] = (_Float16)v[q];
          o4 = cv.u;
        } else {
          o4 = (u32x4){pack2(v[0], v[1]), pack2(v[2], v[3]), pack2(v[4], v[5]), pack2(v[6], v[7])};
        }
        *(u32x4*)(dbase + (long)(m0 + row) * dstride + dcol + c8) = o4;
      }
    } else if (kind == 1 || kind == 2) {
#pragma unroll 2
      for (int k8 = 0; k8 < 8; ++k8) {
        const int id = tc + 256 * k8;
        const int col = id & 127, r8 = (id >> 7) * 8;
        float v[8];
#pragma unroll
        for (int q = 0; q < 8; ++q) v[q] = sF[(r8 + q) * 132 + col];
        const int r = m0 + r8;
        const int bl = r >> 12, tt = r & 4095;
        unsigned off;
        if (kind == 1) {
          const int c = n0 + col - 2048;
          const int h = c >> 7, dv = c & 127;
          off = ((unsigned)(((bl * 8 + h) * 64 + (tt >> 6)) * 128 + dv) * 64u + (unsigned)(tt & 63)) * 2u;
        } else {
          const int cc = (n0 + col - 5120) & 255;
          const int g = cc >> 6, d = cc & 63;
          off = ((unsigned)((bl * 4 + g) * 64 + d) * 4096u + (unsigned)tt) * 2u;
        }
        *(u32x4*)((char*)tbase + off) = (u32x4){pack2(v[0], v[1]), pack2(v[2], v[3]), pack2(v[4], v[5]), pack2(v[6], v[7])};
      }
    } else {
      for (int id = tc; id < 128 * 48; id += 256) {
        const int row = id / 48, c = id - row * 48;
        NGATE[(long)(m0 + row) * 48 + c] = sigm(sF[row * 132 + c]);
      }
    }
    __syncthreads();
  }
}

__device__ __forceinline__ void hgrn_intra_unit(const Params& P, int uu, char* smem) {
  char* ws = P.ws;
  const int tid = tid_(), lane = tid & 63, wave = tid >> 6;
  const int l15 = lane & 15, G = lane >> 4;
  float* sBc = (float*)smem;
  u16* sQ = (u16*)(smem + 64 * 132 * 4);
  const int bl = uu >> 9, h = (uu >> 6) & 7, c = uu & 63;
  const long r0 = (long)bl * 4096 + c * 64;
  u16* QF = (u16*)(ws + OFF_QF);
  const _Float16* LOGF = (const _Float16*)(ws + OFF_LOGF);
  const u16* HVT = (const u16*)(ws + OFF_HVT);
  u16* ABUF = (u16*)(ws + OFF_ABUF);
  u16* UST = (u16*)(ws + OFF_UST);
  float* DCY = (float*)(ws + OFF_DCY);

  __syncthreads();
#pragma unroll
  for (int i = 0; i < 4; ++i) {
    const int id = tid + 256 * i;
    const int row = id >> 4, cc = (id & 15) * 8;
    const u32x4 lf = *(const u32x4*)(LOGF + (r0 + row) * 1024 + h * 128 + cc);
    const _Float16* hp = (const _Float16*)&lf;
#pragma unroll
    for (int e = 0; e < 8; ++e) sBc[row * 132 + cc + e] = (float)hp[e];
    *(u32x4*)&sQ[row * 136 + cc] = *(const u32x4*)(QF + (r0 + row) * 1024 + h * 128 + cc);
  }
  __syncthreads();
  {
    float* sTot = (float*)(smem + 51200);
    const int col = tid & 127, hh = tid >> 7;
    float v[32];
#pragma unroll
    for (int q = 0; q < 32; ++q) v[q] = sBc[(32 * hh + q) * 132 + col];
    float run = 0.f;
#pragma unroll
    for (int q = 0; q < 32; ++q) { run += v[q]; v[q] = run; }
    if (hh == 0) sTot[col] = run;
    __syncthreads();
    const float off = hh ? sTot[col] : 0.f;
#pragma unroll
    for (int q = 0; q < 32; ++q) sBc[(32 * hh + q) * 132 + col] = v[q] + off;
  }
  __syncthreads();
#pragma unroll
  for (int i = 0; i < 4; ++i) {
    const int id = tid + 256 * i;
    const int row = id >> 4, cc = (id & 15) * 8;
    uint32_t w[4];
#pragma unroll
    for (int e = 0; e < 4; ++e) {
      const float q0 = bf2f(sQ[row * 136 + cc + 2 * e]) * __expf(sBc[row * 132 + cc + 2 * e]);
      const float q1 = bf2f(sQ[row * 136 + cc + 2 * e + 1]) * __expf(sBc[row * 132 + cc + 2 * e + 1]);
      w[e] = pack2(q0, q1);
    }
    *(u32x4*)(QF + (r0 + row) * 1024 + h * 128 + cc) = (u32x4){w[0], w[1], w[2], w[3]};
  }
  if (tid < 128) DCY[(long)uu * 128 + tid] = __expf(sBc[63 * 132 + tid]);
  for (int idx = tid; idx < 4096; idx += 256) {
    const int t = idx >> 6, s = idx & 63;
    if ((s >> 4) > (t >> 4)) ABUF[(long)uu * 4096 + idx] = 0;
  }
  for (int ti = wave; ti < 10; ti += 4) {
    int i, j;
    if (ti == 0) { i = 0; j = 0; }
    else if (ti < 3) { i = 1; j = ti - 1; }
    else if (ti < 6) { i = 2; j = ti - 3; }
    else { i = 3; j = ti - 6; }
    f32x4 a4 = {0.f, 0.f, 0.f, 0.f};
    const int t = 16 * i + l15, s = 16 * j + l15;
#pragma unroll
    for (int ks = 0; ks < 4; ++ks) {
      const int dk0 = ks * 32 + G * 8;
      uint32_t aw[4], bw[4];
#pragma unroll
      for (int e2 = 0; e2 < 4; ++e2) {
        float av[2], bv[2];
#pragma unroll
        for (int z = 0; z < 2; ++z) {
          const int dk = dk0 + 2 * e2 + z;
          const float br = sBc[(16 * i) * 132 + dk];
          const float bt = sBc[t * 132 + dk];
          av[z] = bf2f(sQ[t * 136 + dk]) * __expf(bt - br);
          const float bs = sBc[s * 132 + dk];
          const float bp = (s > 0) ? sBc[(s - 1) * 132 + dk] : 0.f;
          const float kk = 1.f - __expf(bs - bp);
          bv[z] = kk * __expf(br - bs);
        }
        aw[e2] = pack2(av[0], av[1]);
        bw[e2] = pack2(bv[0], bv[1]);
      }
      a4 = MFMA(mk8(aw[0], aw[1], aw[2], aw[3]), mk8(bw[0], bw[1], bw[2], bw[3]), a4);
    }
#pragma unroll
    for (int e = 0; e < 4; ++e) {
      const int tr = 16 * i + G * 4 + e, sc = 16 * j + l15;
      const float v = (sc <= tr) ? a4[e] : 0.f;
      ABUF[(long)uu * 4096 + tr * 64 + sc] = f2bf(v);
    }
  }
  {
    f32x4 ua[8][2];
#pragma unroll
    for (int rt = 0; rt < 8; ++rt) { ua[rt][0] = (f32x4){0.f, 0.f, 0.f, 0.f}; ua[rt][1] = (f32x4){0.f, 0.f, 0.f, 0.f}; }
#pragma unroll
    for (int ks = 0; ks < 2; ++ks) {
      bf16x8 bfr[2];
#pragma unroll
      for (int ct = 0; ct < 2; ++ct) {
        const int dk = (2 * wave + ct) * 16 + l15;
        const float blast = sBc[63 * 132 + dk];
        const int s0 = ks * 32 + G * 8;
        float prev = (s0 > 0) ? sBc[(s0 - 1) * 132 + dk] : 0.f;
        uint32_t bw[4];
#pragma unroll
        for (int e2 = 0; e2 < 4; ++e2) {
          const float b0 = sBc[(s0 + 2 * e2) * 132 + dk];
          const float b1 = sBc[(s0 + 2 * e2 + 1) * 132 + dk];
          const float k0 = (1.f - __expf(b0 - prev)) * __expf(blast - b0);
          const float k1 = (1.f - __expf(b1 - b0)) * __expf(blast - b1);
          prev = b1;
          bw[e2] = pack2(k0, k1);
        }
        bfr[ct] = mk8(bw[0], bw[1], bw[2], bw[3]);
      }
#pragma unroll
      for (int rt = 0; rt < 8; ++rt) {
        const int dv = rt * 16 + l15;
        const bf16x8 af = ld8(HVT + ((long)uu * 128 + dv) * 64 + ks * 32 + G * 8);
        ua[rt][0] = MFMA(af, bfr[0], ua[rt][0]);
        ua[rt][1] = MFMA(af, bfr[1], ua[rt][1]);
      }
    }
    u16* sU = (u16*)smem;
    __syncthreads();
#pragma unroll
    for (int rt = 0; rt < 8; ++rt)
#pragma unroll
      for (int ct = 0; ct < 2; ++ct)
#pragma unroll
        for (int e = 0; e < 4; ++e) {
          const int dv = rt * 16 + G * 4 + e, dk = (2 * wave + ct) * 16 + l15;
          sU[dv * 136 + dk] = f2bf(ua[rt][ct][e]);
        }
    __syncthreads();
#pragma unroll 4
    for (int k8 = 0; k8 < 8; ++k8) {
      const int id = tid + 256 * k8;
      const int row = id >> 4, cch = (id & 15) * 8;
      *(u32x4*)(UST + ((long)uu * 128 + row) * 128 + cch) = *(const u32x4*)&sU[row * 136 + cch];
    }
  }
}

__device__ __forceinline__ void cmp_gemm1_tile(const Params& P, int t, char* smem) {
  char* ws = P.ws;
  u16* sA = (u16*)smem;
  u16* sB = sA + 128 * 80;
  EPI_VARS
  const int kv = t >> 5, rem = t & 31;
  const int mt = rem >> 1, nt = rem & 1;
  const int m0 = mt * 128, n0 = nt * 128;
  const u16* KV = (const u16*)(ws + OFF_KV);
  const u16* W1T = (const u16*)(ws + (kv ? OFF_WV1T : OFF_WK1T));
  u16* HID = (u16*)(ws + (kv ? OFF_HIDV : OFF_HIDK));
  const float* B1P = (const float*)(ws + OFF_BIAS1P) + kv * 2048;
  f32x4 acc[4][4];
  zero_acc(acc);
  gemm_tile<1, 2>(KV, 1024, m0, 2048, W1T, 2048, n0, 256, 2048, kv * 256, acc, sA, sB);
#pragma unroll
  for (int i = 0; i < 4; ++i)
#pragma unroll
    for (int j = 0; j < 4; ++j) {
      const int col = n0 + wn * 64 + 16 * j + l15;
      float bias = 0.f;
#pragma unroll
      for (int pp = 0; pp < 8; ++pp) bias += B1P[pp * 256 + col];
#pragma unroll
      for (int e = 0; e < 4; ++e) {
        const int row = m0 + wm * 64 + 16 * i + G * 4 + e;
        HID[(long)row * 256 + col] = f2bf(gelu_tanh(acc[i][j][e] + bias));
      }
    }
}

__device__ __forceinline__ void cmp_gemm2_tile(const Params& P, int t, char* smem) {
  char* ws = P.ws;
  u16* sA = (u16*)smem;
  u16* sB = sA + 128 * 80;
  EPI_VARS
  const int kv = t >> 4, mt = t & 15;
  const int m0 = mt * 128;
  const u16* HID = (const u16*)(ws + (kv ? OFF_HIDV : OFF_HIDK));
  const u16* W2T = (const u16*)(ws + (kv ? OFF_WV2T : OFF_WK2T));
  u16* KCMP = (u16*)(ws + OFF_KCMP);
  u16* VCMPT = (u16*)(ws + OFF_VCMPT);
  f32x4 acc[4][4];
  zero_acc(acc);
  gemm_tile<0, 1>(HID, 256, m0, 2048, W2T, 256, 0, 64, 256, 0, acc, sA, sB);
  if (wn == 0) {
#pragma unroll
    for (int i = 0; i < 4; ++i)
#pragma unroll
      for (int j = 0; j < 4; ++j) {
        const int col = 16 * j + l15;
        const int rbase = m0 + wm * 64 + 16 * i + G * 4;
        if (kv == 0) {
#pragma unroll
          for (int e = 0; e < 4; ++e) KCMP[(long)(rbase + e) * 64 + col] = f2bf(acc[i][j][e]);
        } else {
          const int grp = rbase >> 8, n = rbase & 255;
          u32x2 o2 = {pack2(acc[i][j][0], acc[i][j][1]), pack2(acc[i][j][2], acc[i][j][3])};
          *(u32x2*)(VCMPT + ((long)grp * 64 + col) * 256 + n) = o2;
        }
      }
  }
}

__device__ __forceinline__ void hgrn_scan(const Params& P) {
  char* ws = P.ws;
  u16* UST = (u16*)(ws + OFF_UST);
  const float* DCY = (const float*)(ws + OFF_DCY);
  for (int idx = bid_() * 256 + tid_(); idx < 131072; idx += gridDim.x * 256) {
    const int bh = idx >> 13, rem = idx & 8191;
    const int dv = rem >> 6, dk2 = (rem & 63) * 2;
    float s0 = 0.f, s1 = 0.f;
#pragma unroll 8
    for (int c = 0; c < 64; ++c) {
      const long uu = (long)bh * 64 + c;
      u16* ptr = UST + (uu * 128 + dv) * 128 + dk2;
      const uint32_t uv = *(const uint32_t*)ptr;
      const float2 d = *(const float2*)(DCY + uu * 128 + dk2);
      *(uint32_t*)ptr = pack2(s0, s1);
      s0 = d.x * s0 + __uint_as_float(uv << 16);
      s1 = d.y * s1 + __uint_as_float(uv & 0xffff0000u);
    }
  }
}

__device__ __forceinline__ void hgrn_out_unit(const Params& P, int half, int uu, char* smem) {
  char* ws = P.ws;
  const int tid = tid_(), lane = tid & 63, wave = tid >> 6;
  const int l15 = lane & 15, G = lane >> 4;
  float* sO = (float*)smem;
  const int bl = uu >> 9, h = (uu >> 6) & 7, c = uu & 63;
  const long r0 = (long)bl * 4096 + c * 64;
  const u16* QF = (const u16*)(ws + OFF_QF);
  const u16* HVT = (const u16*)(ws + OFF_HVT);
  const u16* ABUF = (const u16*)(ws + OFF_ABUF);
  const u16* UST = (const u16*)(ws + OFF_UST);
  u16* SG = (u16*)(ws + OFF_SG) + (long)half * 8192 * 1024;
  f32x4 acc[4][2];
#pragma unroll
  for (int i = 0; i < 4; ++i) { acc[i][0] = (f32x4){0.f, 0.f, 0.f, 0.f}; acc[i][1] = (f32x4){0.f, 0.f, 0.f, 0.f}; }
#pragma unroll
  for (int ks = 0; ks < 4; ++ks) {
    const int dk0 = ks * 32 + G * 8;
    bf16x8 bfr[2];
#pragma unroll
    for (int jt = 0; jt < 2; ++jt) bfr[jt] = ld8(UST + ((long)uu * 128 + 32 * wave + 16 * jt + l15) * 128 + dk0);
#pragma unroll
    for (int i = 0; i < 4; ++i) {
      const bf16x8 af = ld8(QF + (r0 + 16 * i + l15) * 1024 + h * 128 + dk0);
      acc[i][0] = MFMA(af, bfr[0], acc[i][0]);
      acc[i][1] = MFMA(af, bfr[1], acc[i][1]);
    }
  }
#pragma unroll
  for (int ks = 0; ks < 2; ++ks) {
    const int s0 = ks * 32 + G * 8;
    bf16x8 bfr[2];
#pragma unroll
    for (int jt = 0; jt < 2; ++jt) bfr[jt] = ld8(HVT + ((long)uu * 128 + 32 * wave + 16 * jt + l15) * 64 + s0);
#pragma unroll
    for (int i = 0; i < 4; ++i) {
      const bf16x8 af = ld8(ABUF + (long)uu * 4096 + (16 * i + l15) * 64 + s0);
      acc[i][0] = MFMA(af, bfr[0], acc[i][0]);
      acc[i][1] = MFMA(af, bfr[1], acc[i][1]);
    }
  }
  __syncthreads();
#pragma unroll
  for (int i = 0; i < 4; ++i)
#pragma unroll
    for (int jt = 0; jt < 2; ++jt)
#pragma unroll
      for (int e = 0; e < 4; ++e) sO[(16 * i + G * 4 + e) * 132 + 32 * wave + 16 * jt + l15] = acc[i][jt][e];
  __syncthreads();
  {
    const int row = tid >> 2, part = tid & 3;
    float ss = 0.f;
#pragma unroll
    for (int cc = 0; cc < 32; ++cc) { const float v = sO[row * 132 + part * 32 + cc]; ss += v * v; }
    ss += SHX(ss, 1);
    ss += SHX(ss, 2);
    const float r = rsqrtf(ss * (1.f / 128.f) + 1e-6f);
    u16* dst = SG + (r0 + row) * 1024 + h * 128 + part * 32;
#pragma unroll
    for (int q4 = 0; q4 < 4; ++q4) {
      const u32x4 sgv = *(const u32x4*)(dst + q4 * 8);
      uint32_t w[4];
#pragma unroll
      for (int e = 0; e < 4; ++e) {
        const int cc = q4 * 8 + 2 * e;
        const float g0 = __uint_as_float(sgv[e] << 16), g1 = __uint_as_float(sgv[e] & 0xffff0000u);
        const float y0 = sO[row * 132 + part * 32 + cc] * r * P.gnorm[part * 32 + cc] * g0;
        const float y1 = sO[row * 132 + part * 32 + cc + 1] * r * P.gnorm[part * 32 + cc + 1] * g1;
        w[e] = pack2(y0, y1);
      }
      *(u32x4*)(dst + q4 * 8) = (u32x4){w[0], w[1], w[2], w[3]};
    }
  }
}

__device__ __forceinline__ void stage_kv(u16* sK, u16* sV, const u16* kptr, long kstride, const u16* vptr, long vstride) {
  const int tid = tid_();
  __syncthreads();
#pragma unroll
  for (int i = 0; i < 2; ++i) {
    const int id = tid + 256 * i;
    const int row = id >> 3, ch = id & 7;
    *(u32x4*)&sK[row * 72 + ch * 8] = *(const u32x4*)(kptr + row * kstride + ch * 8);
    *(u32x4*)&sV[row * 72 + ch * 8] = *(const u32x4*)(vptr + row * vstride + ch * 8);
  }
  __syncthreads();
}

__device__ __forceinline__ void qk_scores(const u16* sK, const bf16x8 (&q)[2], f32x4 (&s)[4], int l15, int G) {
#pragma unroll
  for (int kt = 0; kt < 4; ++kt) {
    s[kt] = (f32x4){0.f, 0.f, 0.f, 0.f};
#pragma unroll
    for (int ks = 0; ks < 2; ++ks) s[kt] = MFMA(ld8(&sK[(16 * kt + l15) * 72 + ks * 32 + G * 8]), q[ks], s[kt]);
  }
}

__device__ __forceinline__ void pv_accum(const u16* sV, const f32x4 (&p)[4], f32x4 (&o)[4], int l15, int G) {
#pragma unroll
  for (int ks2 = 0; ks2 < 2; ++ks2) {
    const f32x4 pa = p[2 * ks2], pb = p[2 * ks2 + 1];
    const bf16x8 pf = mk8(pack2(pa[0], pa[1]), pack2(pa[2], pa[3]), pack2(pb[0], pb[1]), pack2(pb[2], pb[3]));
#pragma unroll
    for (int dt = 0; dt < 4; ++dt) {
      const u32x2 v0 = *(const u32x2*)&sV[(16 * dt + l15) * 72 + 32 * ks2 + 4 * G];
      const u32x2 v1 = *(const u32x2*)&sV[(16 * dt + l15) * 72 + 32 * ks2 + 16 + 4 * G];
      o[dt] = MFMA(mk8(v0[0], v0[1], v1[0], v1[1]), pf, o[dt]);
    }
  }
}

#define EX2(x) __builtin_amdgcn_exp2f(x)
typedef __attribute__((ext_vector_type(16))) float f32x16;
#define MFMA32(a, b, c) __builtin_amdgcn_mfma_f32_32x32x16_bf16((a), (b), (c), 0, 0, 0)
template <int MODE, bool EDGE>
__device__ __forceinline__ void nsa_block(const u16* sK, const u16* sV, int jb, int qb, int q, bool blk_ok,
                                          const bf16x8 (&qf)[4], f32x16 (&O)[2], float& m, float& l, int r31, int h) {
  const int lane = h * 32 + r31;
  f32x16 s[2];
#pragma unroll
  for (int kt2 = 0; kt2 < 2; ++kt2) {
#pragma unroll
    for (int e = 0; e < 16; ++e) s[kt2][e] = 0.f;
#pragma unroll
    for (int ks = 0; ks < 4; ++ks) s[kt2] = MFMA32(ld8(&sK[(32 * kt2 + r31) * 72 + 16 * ks + 8 * h]), qf[ks], s[kt2]);
  }
  float smax = -1e30f;
  if (EDGE) {
#pragma unroll
    for (int kt2 = 0; kt2 < 2; ++kt2)
#pragma unroll
      for (int e = 0; e < 16; ++e) {
        const int k = 32 * kt2 + (e & 3) + 8 * (e >> 2) + 4 * h;
        const bool a = blk_ok && ((jb == qb) ? (k <= q) : (k > q));
        if (!a) s[kt2][e] = -1e30f;
        smax = fmaxf(smax, s[kt2][e]);
      }
  } else {
#pragma unroll
    for (int kt2 = 0; kt2 < 2; ++kt2)
#pragma unroll
      for (int e = 0; e < 16; ++e) smax = fmaxf(smax, s[kt2][e]);
    if (MODE == 2 && !blk_ok) smax = -1e30f;
  }
  smax = fmaxf(smax, SHX(smax, 32));
  const float mn = fmaxf(m, smax);
  const bool need = (mn - m) > 8.f;
  if (__builtin_amdgcn_ballot_w64(need) != 0ull) {
    const float alpha = need ? EX2(m - mn) : 1.f;
    m = need ? mn : m;
    l *= alpha;
    O[0] *= alpha;
    O[1] *= alpha;
  }
  const float mref = (!EDGE && MODE == 2 && !blk_ok) ? 1e30f : m;
  float ls = 0.f;
#pragma unroll
  for (int kt2 = 0; kt2 < 2; ++kt2)
#pragma unroll
    for (int e = 0; e < 16; ++e) {
      const float sv = s[kt2][e];
      float pv;
      if (EDGE) pv = (sv > -1e29f) ? EX2(sv - m) : 0.f;
      else pv = EX2(sv - mref);
      s[kt2][e] = pv;
      ls += pv;
    }
  l += ls;
#pragma unroll
  for (int kt2 = 0; kt2 < 2; ++kt2)
#pragma unroll
    for (int st = 0; st < 2; ++st) {
      const bf16x8 pf = mk8(pack2(s[kt2][8 * st + 0], s[kt2][8 * st + 1]), pack2(s[kt2][8 * st + 2], s[kt2][8 * st + 3]),
                            pack2(s[kt2][8 * st + 4], s[kt2][8 * st + 5]), pack2(s[kt2][8 * st + 6], s[kt2][8 * st + 7]));
#pragma unroll
      for (int dt2 = 0; dt2 < 2; ++dt2) {
        const u16* vrow = &sV[(32 * dt2 + r31) * 72 + 32 * kt2 + 16 * st + 4 * h];
        const u32x2 v0 = *(const u32x2*)vrow;
        const u32x2 v1 = *(const u32x2*)(vrow + 8);
        O[dt2] = MFMA32(mk8(v0[0], v0[1], v1[0], v1[1]), pf, O[dt2]);
      }
    }
}

template <int MODE>
__device__ __forceinline__ void nsa_branch(const u16* kbase, const u16* vbase, int jb0, int jb1, int qb, int q,
                                           uint32_t mlo, uint32_t mhi, const bf16x8 (&qf)[4], const float* ngbase, int rowbase, int gidx,
                                           u16* sYl, u16* sm, float pscale = 1.f) {
  const int tid = tid_();
  const int lane = tid & 63;
  const int r31 = lane & 31, h = lane >> 5;
  const int srow = tid >> 3, sch = (tid & 7) * 8;
  f32x16 O[2];
#pragma unroll
  for (int e = 0; e < 16; ++e) { O[0][e] = 0.f; O[1][e] = 0.f; }
  float m = -1e30f, l = 0.f;
  u32x4 kr[2], vr[2];
  const unsigned koff = (unsigned)((srow * 1024 + sch) * 2);
  const unsigned voff = (unsigned)((srow * 4096 + sch) * 2);
  {
    const char* kb = (const char*)kbase + (size_t)jb0 * 131072;
    const char* vb = (const char*)vbase + (size_t)jb0 * 128;
#pragma unroll
    for (int i = 0; i < 2; ++i) {
      kr[i] = *(const u32x4*)(kb + (koff + i * 65536u));
      vr[i] = *(const u32x4*)(vb + (voff + i * 262144u));
    }
  }
  __syncthreads();
#pragma unroll
  for (int i = 0; i < 2; ++i) {
    *(u32x4*)&sm[(srow + 32 * i) * 72 + sch] = kr[i];
    *(u32x4*)&sm[4608 + (srow + 32 * i) * 72 + sch] = vr[i];
  }
  __syncthreads();
  int cur = 0;
  for (int jb = jb0; jb <= jb1; ++jb) {
    const bool more = jb < jb1;
    if (more) {
      const char* kb = (const char*)kbase + (size_t)(jb + 1) * 131072;
      const char* vb = (const char*)vbase + (size_t)(jb + 1) * 128;
#pragma unroll
      for (int i = 0; i < 2; ++i) {
        kr[i] = *(const u32x4*)(kb + (koff + i * 65536u));
        vr[i] = *(const u32x4*)(vb + (voff + i * 262144u));
      }
    }
    const u16* sK = sm + cur * 9216;
    const u16* sV = sK + 4608;
    bool blk_ok = true;
    if (MODE == 2) blk_ok = (jb < 32) ? ((mlo >> jb) & 1u) : ((mhi >> (jb - 32)) & 1u);
    const bool edge = (jb == qb) || (MODE == 3 && jb == qb - 8);
    if (edge) nsa_block<MODE, true>(sK, sV, jb, qb, q, blk_ok, qf, O, m, l, r31, h);
    else nsa_block<MODE, false>(sK, sV, jb, qb, q, blk_ok, qf, O, m, l, r31, h);
    if (more) {
      u16* dK = sm + (cur ^ 1) * 9216;
#pragma unroll
      for (int i = 0; i < 2; ++i) {
        *(u32x4*)&dK[(srow + 32 * i) * 72 + sch] = kr[i];
        *(u32x4*)&dK[4608 + (srow + 32 * i) * 72 + sch] = vr[i];
      }
    }
    __syncthreads();
    cur ^= 1;
  }
  const int tg = tid_();
  const int lg = tg & 63, hh = (lg >> 4) & 1, hg = lg >> 5;
  const float* gatep = (const float*)((const char*)ngbase + (unsigned)(rowbase + 16 * (tg >> 6) + (tg & 15)) * 192u) + gidx + hh;
  float lt = l;
  lt += shx_f(lt, lg ^ 32);
  const float sc = (lt > 0.f) ? (pscale * gatep[0] / lt) : 0.f;
  u16* yrow = sYl + (((tg >> 6) * 2 + hh) * 16 + (tg & 15)) * 64;
#pragma unroll
  for (int dt2 = 0; dt2 < 2; ++dt2)
#pragma unroll
    for (int m4 = 0; m4 < 4; ++m4) {
      u32x2* yp = (u32x2*)(yrow + 32 * dt2 + 8 * m4 + 4 * hg);
      const u32x2 yv = *yp;
      const float y0 = __uint_as_float(yv[0] << 16) + O[dt2][4 * m4 + 0] * sc;
      const float y1 = __uint_as_float(yv[0] & 0xffff0000u) + O[dt2][4 * m4 + 1] * sc;
      const float y2 = __uint_as_float(yv[1] << 16) + O[dt2][4 * m4 + 2] * sc;
      const float y3 = __uint_as_float(yv[1] & 0xffff0000u) + O[dt2][4 * m4 + 3] * sc;
      *yp = (u32x2){pack2(y0, y1), pack2(y2, y3)};
    }
}

__device__ __forceinline__ void pv_cmp(const u16* vc, int jb, const f32x4 (&p)[4], f32x4 (&o)[4], int l15, int G) {
#pragma unroll
  for (int ks2 = 0; ks2 < 2; ++ks2) {
    const f32x4 pa = p[2 * ks2], pb = p[2 * ks2 + 1];
    const bf16x8 pf = mk8(pack2(pa[0], pa[1]), pack2(pa[2], pa[3]), pack2(pb[0], pb[1]), pack2(pb[2], pb[3]));
#pragma unroll
    for (int dt = 0; dt < 4; ++dt) {
      const u16* vp = vc + (long)(16 * dt + l15) * 256 + jb * 64 + 32 * ks2 + 4 * G;
      const u32x2 v0 = *(const u32x2*)vp;
      const u32x2 v1 = *(const u32x2*)(vp + 16);
      o[dt] = MFMA(mk8(v0[0], v0[1], v1[0], v1[1]), pf, o[dt]);
    }
  }
}

__device__ __forceinline__ void nsa_unit(const Params& P, int half, int u, char* smem) {
  char* ws = P.ws;
  const int tid = tid_(), lane = tid & 63, wave = tid >> 6;
  const int l15 = lane & 15, G = lane >> 4;
  const int hp = u >> 9, rest = u & 511;
  const int bl = rest >> 8, g = (rest >> 6) & 3, xq = rest & 63;
  const int qb = hp ? xq : 63 - xq;
  const int q = 16 * wave + l15;
  const int t = qb * 64 + q;
  const int rl = bl * 4096 + t;
  const int rg = half * 8192 + rl;
  const char* NQc = (const char*)(ws + OFF_NQ);
  const unsigned qoff = (unsigned)rg * 2048u;
  u16* sm = (u16*)smem;
  float* sImp = (float*)smem;
  const u16* NQ = (const u16*)(ws + OFF_NQ);
  const u16* NQR = (const u16*)(ws + OFF_NQR);
  const u16* KV = (const u16*)(ws + OFF_KV);
  const u16* VST = (const u16*)(ws + OFF_VST);
  const u16* VWT = (const u16*)(ws + OFF_VWT);
  const u16* KCMP = (const u16*)(ws + OFF_KCMP);
  const u16* VCMPT = (const u16*)(ws + OFF_VCMPT);
  const float* NGATE = (const float*)((const char*)(ws + OFF_NGATE) + (unsigned)rg * 192u);
  u16* YB = (u16*)(ws + (half ? OFF_YB1 : OFF_YB0));

  f32x4 Y[2][4];
#pragma unroll
  for (int rr = 0; rr < 2; ++rr)
#pragma unroll
    for (int dt = 0; dt < 4; ++dt) Y[rr][dt] = (f32x4){0.f, 0.f, 0.f, 0.f};

  uint32_t mlo = 0, mhi = 0;
  u16* sYl = (u16*)(smem + 36864);
  {
    const int nblk = ((4 * qb + 2) >> 6) + 1;
    const u16* kc = KCMP + (long)(bl * 4 + g) * 256 * 64;
    const u16* vc = VCMPT + (long)(bl * 4 + g) * 64 * 256;
    float imp[4][4];
#pragma unroll
    for (int a = 0; a < 4; ++a)
#pragma unroll
      for (int b = 0; b < 4; ++b) imp[a][b] = 0.f;
    __syncthreads();
    for (int id = tid; id < nblk * 512; id += 256) {
      const int row = id >> 3, chn = (id & 7) * 8;
      *(u32x4*)&sm[row * 72 + chn] = *(const u32x4*)(kc + row * 64 + chn);
    }
    __syncthreads();
#pragma unroll 1
    for (int r = 0; r < 4; ++r) {
      bf16x8 qp[2];
#pragma unroll
      for (int ks = 0; ks < 2; ++ks) qp[ks] = *(const bf16x8*)(NQc + (qoff + (unsigned)(((4 * g + r) * 64 + ks * 32 + G * 8) * 2)));
      float m = -1e30f, l = 0.f;
#pragma unroll 1
      for (int jb = 0; jb < nblk; ++jb) {
        f32x4 s[4];
        float smax = -1e30f;
#pragma unroll
        for (int kt = 0; kt < 4; ++kt) {
          f32x4 a4 = {0.f, 0.f, 0.f, 0.f};
#pragma unroll
          for (int ks = 0; ks < 2; ++ks)
            a4 = MFMA(ld8(&sm[(jb * 64 + 16 * kt + l15) * 72 + ks * 32 + G * 8]), qp[ks], a4);
#pragma unroll
          for (int e = 0; e < 4; ++e) {
            const int n = jb * 64 + 16 * kt + 4 * G + e;
            const float sv = (16 * n + 31 <= t) ? a4[e] : -1e30f;
            s[kt][e] = sv;
            smax = fmaxf(smax, sv);
          }
        }
        smax = fmaxf(smax, SHX(smax, 16));
        smax = fmaxf(smax, SHX(smax, 32));
        const float mn = fmaxf(m, smax);
        float ls = 0.f;
#pragma unroll
        for (int kt = 0; kt < 4; ++kt)
#pragma unroll
          for (int e = 0; e < 4; ++e) ls += (s[kt][e] > -1e29f) ? EX2(s[kt][e] - mn) : 0.f;
        l = l * EX2(m - mn) + ls;
        m = mn;
      }
      l += SHX(l, 16);
      l += SHX(l, 32);
      const float invl = (l > 0.f) ? 1.f / l : 0.f;
      float prevup = 0.f;
#pragma unroll 1
      for (int jb = 0; jb < nblk; ++jb) {
        {
          f32x4 p[4];
#pragma unroll
          for (int kt = 0; kt < 4; ++kt) {
            f32x4 a4 = {0.f, 0.f, 0.f, 0.f};
#pragma unroll
            for (int ks = 0; ks < 2; ++ks)
              a4 = MFMA(ld8(&sm[(jb * 64 + 16 * kt + l15) * 72 + ks * 32 + G * 8]), qp[ks], a4);
#pragma unroll
            for (int e = 0; e < 4; ++e) {
              const int n = jb * 64 + 16 * kt + 4 * G + e;
              p[kt][e] = (16 * n + 31 <= t) ? EX2(a4[e] - m) * invl : 0.f;
            }
            const float sum4 = (p[kt][0] + p[kt][1]) + (p[kt][2] + p[kt][3]);
            const float upv = shx_f(p[kt][3], (lane + 48) & 63);
            const float add = (G > 0) ? upv : prevup;
            const float iv = sum4 + add;
#pragma unroll
            for (int j = 0; j < 4; ++j) imp[j][kt] += (jb == j) ? iv : 0.f;
            prevup = upv;
          }
          if (r == 2 * hp) pv_cmp(vc, jb, p, Y[0], l15, G);
          else if (r == 2 * hp + 1) pv_cmp(vc, jb, p, Y[1], l15, G);
        }
      }
    }
    {
      const float g0 = NGATE[0 * 16 + 4 * g + 2 * hp], g1 = NGATE[0 * 16 + 4 * g + 2 * hp + 1];
#pragma unroll
      for (int dt = 0; dt < 4; ++dt) {
        *(u32x2*)(sYl + ((wave * 2 + 0) * 16 + l15) * 64 + 16 * dt + 4 * G) = (u32x2){pack2(Y[0][dt][0] * g0, Y[0][dt][1] * g0), pack2(Y[0][dt][2] * g0, Y[0][dt][3] * g0)};
        *(u32x2*)(sYl + ((wave * 2 + 1) * 16 + l15) * 64 + 16 * dt + 4 * G) = (u32x2){pack2(Y[1][dt][0] * g1, Y[1][dt][1] * g1), pack2(Y[1][dt][2] * g1, Y[1][dt][3] * g1)};
      }
    }
    __syncthreads();
    float* myImp = sImp + wave * 16 * 65;
#pragma unroll
    for (int jb = 0; jb < 4; ++jb)
#pragma unroll
      for (int kt = 0; kt < 4; ++kt) myImp[l15 * 65 + 16 * jb + 4 * kt + G] = imp[jb][kt];
    __syncthreads();
    const int cur = qb;
    uint32_t blo = 0, bhi = 0;
    if (cur + 1 <= 16) {
#pragma unroll
      for (int jb = 0; jb < 4; ++jb)
#pragma unroll
        for (int kt = 0; kt < 4; ++kt) {
          const int s = 16 * jb + 4 * kt + G;
          if (s <= cur) blo |= (1u << s);
        }
    } else {
      int cnt[4][4];
#pragma unroll
      for (int a = 0; a < 4; ++a)
#pragma unroll
        for (int b = 0; b < 4; ++b) cnt[a][b] = 0;
      for (int sp = 1; sp <= cur - 2; ++sp) {
        const float xv = myImp[l15 * 65 + sp];
#pragma unroll
        for (int jb = 0; jb < 4; ++jb)
#pragma unroll
          for (int kt = 0; kt < 4; ++kt) {
            const int s = 16 * jb + 4 * kt + G;
            const float v = imp[jb][kt];
            cnt[jb][kt] += ((xv > v) || (xv == v && sp < s)) ? 1 : 0;
          }
      }
#pragma unroll
      for (int jb = 0; jb < 4; ++jb)
#pragma unroll
        for (int kt = 0; kt < 4; ++kt) {
          const int s = 16 * jb + 4 * kt + G;
          const bool sel = (s == 0) || (s == cur) || (s == cur - 1) || (s >= 1 && s <= cur - 2 && cnt[jb][kt] < 13);
          if (sel) { if (s < 32) blo |= (1u << s); else bhi |= (1u << (s - 32)); }
        }
    }
    blo |= SHXU(blo, 16); blo |= SHXU(blo, 32);
    bhi |= SHXU(bhi, 16); bhi |= SHXU(bhi, 32);
    mlo = blo; mhi = bhi;
  }
  {
    const int hh = (lane >> 4) & 1, h5 = lane >> 5;
    const int head = 4 * g + 2 * hp + hh;
    bf16x8 qf[4];
    qf[0] = *(const bf16x8*)((const char*)NQR + ((unsigned)rl * 512u + (unsigned)((head * 16 + 8 * h5) * 2)));
#pragma unroll
    for (int ks = 1; ks < 4; ++ks) qf[ks] = *(const bf16x8*)(NQc + (qoff + (unsigned)((head * 64 + 16 * ks + 8 * h5) * 2)));
    const int head0 = 4 * g + 2 * hp;
    const u16* kbs = KV + (long)bl * 4096 * 1024 + 512 + g * 64;
    const u16* vbs = VST + (long)(bl * 4 + g) * 64 * 4096;
    nsa_branch<2>(kbs, vbs, 0, qb, qb, q, mlo, mhi, qf, (const float*)(ws + OFF_NGATE), half * 8192 + bl * 4096 + qb * 64, 16 + head0, sYl, sm);
    const u16* kbw = KV + (long)bl * 4096 * 1024 + 768 + g * 64;
    const u16* vbw = VWT + (long)(bl * 4 + g) * 64 * 4096;
    const int jw0 = (qb >= 8) ? qb - 8 : 0;
    nsa_branch<3>(kbw, vbw, jw0, qb, qb, q, mlo, mhi, qf, (const float*)(ws + OFF_NGATE), half * 8192 + bl * 4096 + qb * 64, 32 + head0, sYl, sm);
    const int tid2 = tid_();
    const int l2 = tid2 & 63, hh2 = (l2 >> 4) & 1, hg2 = l2 >> 5;
    const unsigned yoff = (unsigned)(bl * 4096 + qb * 64 + 16 * (tid2 >> 6) + (tid2 & 15)) * 2048u;
    const u16* yrow = sYl + (((tid2 >> 6) * 2 + hh2) * 16 + (tid2 & 15)) * 64;
#pragma unroll
    for (int dt2 = 0; dt2 < 2; ++dt2)
#pragma unroll
      for (int m4 = 0; m4 < 4; ++m4) {
        const int d0 = 32 * dt2 + 8 * m4 + 4 * hg2;
        *(u32x2*)((char*)YB + (yoff + (unsigned)(((head0 + hh2) * 64 + d0) * 2))) = *(const u32x2*)(yrow + d0);
      }
  }
}

__device__ __forceinline__ void gemm_tile_wide(const u16* __restrict__ A, long lda, int m0, const u16* __restrict__ Bt, long ldb, int n0, int K,
                                               f32x4 (&acc)[4][8], u16* sA) {
  const int tid = tid_(), lane = tid & 63, wave = tid >> 6;
  const int l15 = lane & 15, G = lane >> 4;
  const int wm = wave >> 1, wn = wave & 1;
  const int lr = tid >> 3, ch = tid & 7;
  u16* sB = sA + 128 * 80;
  const char* Ab = (const char*)A;
  const char* Bb = (const char*)Bt;
  unsigned oa[4], ob[8];
#pragma unroll
  for (int i = 0; i < 4; ++i) oa[i] = (unsigned)(((long)(m0 + lr + 32 * i) * lda + ch * 8) * 2);
#pragma unroll
  for (int i = 0; i < 8; ++i) ob[i] = (unsigned)(((long)(n0 + lr + 32 * i) * ldb + ch * 8) * 2);
  u32x4 ra[4], rb[8];
#pragma unroll
  for (int i = 0; i < 4; ++i) ra[i] = *(const u32x4*)(Ab + oa[i]);
#pragma unroll
  for (int i = 0; i < 8; ++i) rb[i] = *(const u32x4*)(Bb + ob[i]);
  const int nk = K >> 6;
  for (int kt = 0; kt < nk; ++kt) {
#pragma unroll
    for (int i = 0; i < 4; ++i) *(u32x4*)&sA[(lr + 32 * i) * 80 + ch * 8] = ra[i];
#pragma unroll
    for (int i = 0; i < 8; ++i) *(u32x4*)&sB[(lr + 32 * i) * 80 + ch * 8] = rb[i];
    __syncthreads();
    {
      const int kn = (kt + 1 < nk) ? kt + 1 : kt;
      const char* Ak = Ab + (size_t)kn * 128;
      const char* Bk = Bb + (size_t)kn * 128;
#pragma unroll
      for (int i = 0; i < 4; ++i) ra[i] = *(const u32x4*)(Ak + oa[i]);
#pragma unroll
      for (int i = 0; i < 8; ++i) rb[i] = *(const u32x4*)(Bk + ob[i]);
    }
#pragma unroll
    for (int ks = 0; ks < 2; ++ks) {
      bf16x8 af[4];
#pragma unroll
      for (int i = 0; i < 4; ++i) af[i] = ld8(&sA[(wm * 64 + 16 * i + l15) * 80 + ks * 32 + G * 8]);
#pragma unroll
      for (int jh = 0; jh < 2; ++jh) {
        bf16x8 bfr[4];
#pragma unroll
        for (int j = 0; j < 4; ++j) bfr[j] = ld8(&sB[(wn * 128 + 64 * jh + 16 * j + l15) * 80 + ks * 32 + G * 8]);
#pragma unroll
        for (int i = 0; i < 4; ++i)
#pragma unroll
          for (int j = 0; j < 4; ++j) acc[i][4 * jh + j] = MFMA(af[i], bfr[j], acc[i][4 * jh + j]);
      }
    }
    __syncthreads();
  }
}


__device__ __forceinline__ void phase_branch_merge(const Params& P, char* smem) {
  char* ws = P.ws;
  u16* sA = (u16*)smem;
  const u16* YA = (const u16*)(ws + OFF_SG);
  const u16* GATES = (const u16*)P.out;
  u16* MERGED = (u16*)(ws + OFF_MERGED);
  for (int t = bid_(); t < 512; t += gridDim.x) {
    const int nt = t >> 7, mt = t & 127;
    const int m0 = mt * 128, n0 = nt * 256;
    const u16* YBp = (m0 < 8192) ? (const u16*)(ws + OFF_YB0) : ((const u16*)(ws + OFF_YB1) - (long)8192 * 1024);
    f32x4 acc[4][8];
#pragma unroll
    for (int i = 0; i < 4; ++i)
#pragma unroll
      for (int j = 0; j < 8; ++j) acc[i][j] = (f32x4){0.f, 0.f, 0.f, 0.f};
    gemm_tile_wide(YA, 1024, m0, (const u16*)(ws + OFF_WA_T), 1024, n0, 1024, acc, sA);
    {
      const int tc = tid_();
#pragma unroll 4
      for (int k16 = 0; k16 < 16; ++k16) {
        const int id = tc + 256 * k16;
        const int row = id >> 5, cch = (id & 31) * 8;
        *(u32x4*)&sA[row * 264 + cch] = *(const u32x4*)(GATES + (long)(m0 + row) * 2048 + n0 + cch);
      }
    }
    __syncthreads();
    {
      EPI_VARS
#pragma unroll
      for (int i = 0; i < 4; ++i)
#pragma unroll
        for (int j = 0; j < 8; ++j)
#pragma unroll
          for (int e = 0; e < 4; ++e) {
            u16* sp = &sA[(wm * 64 + 16 * i + G * 4 + e) * 264 + wn * 128 + 16 * j + l15];
            *sp = f2bf(bf2f(*sp) * acc[i][j][e]);
            acc[i][j][e] = 0.f;
          }
    }
    __syncthreads();
    {
      const int tc = tid_();
#pragma unroll 4
      for (int k16 = 0; k16 < 16; ++k16) {
        const int id = tc + 256 * k16;
        const int row = id >> 5, cch = (id & 31) * 8;
        *(u32x4*)(MERGED + (long)(m0 + row) * 1024 + n0 + cch) = *(const u32x4*)&sA[row * 264 + cch];
      }
    }
    asm volatile("s_waitcnt vmcnt(0)" ::: "memory");
    __syncthreads();
    gemm_tile_wide(YBp, 1024, m0, (const u16*)(ws + OFF_WB_T), 1024, n0, 1024, acc, sA);
    {
      const int tc = tid_();
#pragma unroll 4
      for (int k16 = 0; k16 < 16; ++k16) {
        const int id = tc + 256 * k16;
        const int row = id >> 5, cch = (id & 31) * 8;
        *(u32x4*)&sA[row * 264 + cch] = *(const u32x4*)(GATES + (long)(m0 + row) * 2048 + 1024 + n0 + cch);
      }
    }
    __syncthreads();
    {
      EPI_VARS
#pragma unroll
      for (int i = 0; i < 4; ++i)
#pragma unroll
        for (int j = 0; j < 8; ++j)
#pragma unroll
          for (int e = 0; e < 4; ++e) {
            u16* sp = &sA[(wm * 64 + 16 * i + G * 4 + e) * 264 + wn * 128 + 16 * j + l15];
            *sp = f2bf(bf2f(*sp) * acc[i][j][e]);
          }
    }
    __syncthreads();
    {
      const int tc = tid_();
#pragma unroll 2
      for (int k16 = 0; k16 < 16; ++k16) {
        const int id = tc + 256 * k16;
        const int row = id >> 5, cch = (id & 31) * 8;
        u16* gp = MERGED + (long)(m0 + row) * 1024 + n0 + cch;
        const u32x4 t1 = *(const u32x4*)gp;
        const u32x4 pb = *(const u32x4*)&sA[row * 264 + cch];
        u32x4 o;
#pragma unroll
        for (int q = 0; q < 4; ++q) {
          const float lo = __uint_as_float(t1[q] << 16) + __uint_as_float(pb[q] << 16);
          const float hi = __uint_as_float(t1[q] & 0xffff0000u) + __uint_as_float(pb[q] & 0xffff0000u);
          o[q] = pack2(lo, hi);
        }
        *(u32x4*)gp = o;
      }
    }
    __syncthreads();
  }
}

template <int EPI>
__device__ __forceinline__ void phase_gemm(const u16* A, int K, const u16* Wt, int N, void* outp, char* smem) {
  u16* sA = (u16*)smem;
  u16* sB = sA + 128 * 80;
  EPI_VARS
  const int ntn = N >> 7;
  for (int t = bid_(); t < 128 * ntn; t += gridDim.x) {
    const int nt = t >> 7, mt = t & 127;
    const int m0 = mt * 128, n0 = nt * 128;
    f32x4 acc[4][4];
    zero_acc(acc);
    gemm_tile<0, 2>(A, K, m0, 16384, Wt, K, n0, N, K, 0, acc, sA, sB);
#pragma unroll
    for (int i = 0; i < 4; ++i)
#pragma unroll
      for (int j = 0; j < 4; ++j) {
        const int col = n0 + wn * 64 + 16 * j + l15;
#pragma unroll
        for (int e = 0; e < 4; ++e) {
          const long row = m0 + wm * 64 + 16 * i + G * 4 + e;
          const float v = acc[i][j][e];
          if (EPI == 0) ((float*)outp)[row * N + col] = v;
          else if (EPI == 2) ((u16*)outp)[row * N + col] = f2bf(v);
          else { const float rl = fmaxf(v, 0.f); ((u16*)outp)[row * N + col] = f2bf(rl * rl); }
        }
      }
  }
}


template <int EPI>
__device__ __forceinline__ void phase_gemm_wide(const u16* A, int K, const u16* Wt, int N, u16* outp, char* smem) {
  u16* sA = (u16*)smem;
  EPI_VARS
  const int ntn = N >> 8;
  for (int t = bid_(); t < 128 * ntn; t += gridDim.x) {
    const int nt = t >> 7, mt = t & 127;
    const int m0 = mt * 128, n0 = nt * 256;
    f32x4 acc[4][8];
#pragma unroll
    for (int i = 0; i < 4; ++i)
#pragma unroll
      for (int j = 0; j < 8; ++j) acc[i][j] = (f32x4){0.f, 0.f, 0.f, 0.f};
    gemm_tile_wide(A, K, m0, Wt, K, n0, K, acc, sA);
#pragma unroll
    for (int i = 0; i < 4; ++i)
#pragma unroll
      for (int j = 0; j < 8; ++j) {
        const int col = n0 + wn * 128 + 16 * j + l15;
#pragma unroll
        for (int e = 0; e < 4; ++e) {
          float v = acc[i][j][e];
          if (EPI == 1) { v = fmaxf(v, 0.f); v = v * v; }
          sA[(wm * 64 + 16 * i + G * 4 + e) * 264 + (col - n0)] = f2bf(v);
        }
      }
    __syncthreads();
    {
      const int tc = tid_();
#pragma unroll 4
      for (int k16 = 0; k16 < 16; ++k16) {
        const int id = tc + 256 * k16;
        const int row = id >> 5, cch = (id & 31) * 8;
        *(u32x4*)(outp + (long)(m0 + row) * N + n0 + cch) = *(const u32x4*)&sA[row * 264 + cch];
      }
    }
    __syncthreads();
  }
}

__device__ __forceinline__ void phase_ple(const Params& P, char* smem) {
  char* ws = P.ws;
  u16* sA = (u16*)smem;
  u16* Z3b = (u16*)(ws + OFF_Z3);
  for (int t = bid_(); t < 512; t += gridDim.x) {
    const int nt = t >> 7, mt = t & 127;
    const int m0 = mt * 128, n0 = nt * 256;
    f32x4 acc[4][8];
#pragma unroll
    for (int i = 0; i < 4; ++i)
#pragma unroll
      for (int j = 0; j < 8; ++j) acc[i][j] = (f32x4){0.f, 0.f, 0.f, 0.f};
    gemm_tile_wide((const u16*)(ws + OFF_PB), 256, m0, (const u16*)(ws + OFF_WPLE_T), 256, n0, 256, acc, sA);
    {
      EPI_VARS
#pragma unroll
      for (int i = 0; i < 4; ++i)
#pragma unroll
        for (int j = 0; j < 8; ++j)
#pragma unroll
          for (int e = 0; e < 4; ++e) {
            sA[(wm * 64 + 16 * i + G * 4 + e) * 264 + wn * 128 + 16 * j + l15] = f2bf(acc[i][j][e]);
            acc[i][j][e] = 0.f;
          }
    }
    __syncthreads();
    {
      const int tc = tid_();
#pragma unroll 4
      for (int k16 = 0; k16 < 16; ++k16) {
        const int id = tc + 256 * k16;
        const int row = id >> 5, cch = (id & 31) * 8;
        *(u32x4*)(Z3b + (long)(m0 + row) * 1024 + n0 + cch) = *(const u32x4*)&sA[row * 264 + cch];
      }
    }
    asm volatile("s_waitcnt vmcnt(0)" ::: "memory");
    __syncthreads();
    gemm_tile_wide((const u16*)(ws + OFF_H2B), 1024, m0, (const u16*)(ws + OFF_WPG_T), 1024, n0, 1024, acc, sA);
    {
      const int tc = tid_();
#pragma unroll 4
      for (int k16 = 0; k16 < 16; ++k16) {
        const int id = tc + 256 * k16;
        const int row = id >> 5, cch = (id & 31) * 8;
        *(u32x4*)&sA[row * 264 + cch] = *(const u32x4*)(Z3b + (long)(m0 + row) * 1024 + n0 + cch);
      }
    }
    __syncthreads();
    {
      EPI_VARS
#pragma unroll
      for (int i = 0; i < 4; ++i)
#pragma unroll
        for (int j = 0; j < 8; ++j)
#pragma unroll
          for (int e = 0; e < 4; ++e) {
            u16* sp = &sA[(wm * 64 + 16 * i + G * 4 + e) * 264 + wn * 128 + 16 * j + l15];
            *sp = f2bf(bf2f(*sp) * sigm(acc[i][j][e]));
          }
    }
    __syncthreads();
    {
      const int tc = tid_();
#pragma unroll 4
      for (int k16 = 0; k16 < 16; ++k16) {
        const int id = tc + 256 * k16;
        const int row = id >> 5, cch = (id & 31) * 8;
        *(u32x4*)(Z3b + (long)(m0 + row) * 1024 + n0 + cch) = *(const u32x4*)&sA[row * 264 + cch];
      }
    }
    __syncthreads();
  }
}

template <int MODE, int ZB>
__device__ __forceinline__ void phase_rownorm(const Params& P, const void* Zv, const float* w, const float* w2, u16* nxt) {
  const int tid = tid_(), lane = tid & 63, wave = tid >> 6;
  float* H = P.out;
  for (int un = bid_(); un < 4096; un += gridDim.x) {
    const long row = (long)un * 4 + wave;
    const float* zr = (const float*)Zv + row * 1024;
    const u16* zh = (const u16*)Zv + row * 1024;
    (void)zr; (void)zh;
    const float* hin = (MODE == 0) ? (P.x + row * 1024) : (H + row * 1024);
    float4 z[4], hv[4];
    float ss = 0.f;
#pragma unroll
    for (int j = 0; j < 4; ++j) {
      if (ZB) {
        const u32x2 zz = *(const u32x2*)(zh + j * 256 + lane * 4);
        z[j] = make_float4(__uint_as_float(zz[0] << 16), __uint_as_float(zz[0] & 0xffff0000u), __uint_as_float(zz[1] << 16), __uint_as_float(zz[1] & 0xffff0000u));
      } else z[j] = *(const float4*)(zr + j * 256 + lane * 4);
      hv[j] = *(const float4*)(hin + j * 256 + lane * 4);
      ss += z[j].x * z[j].x + z[j].y * z[j].y + z[j].z * z[j].z + z[j].w * z[j].w;
    }
#pragma unroll
    for (int o = 32; o >= 1; o >>= 1) ss += SHX(ss, o);
    const float r = rsqrtf(ss * (1.f / 1024.f) + 1e-6f);
    float s2 = 0.f;
#pragma unroll
    for (int j = 0; j < 4; ++j) {
      const float4 wv = *(const float4*)(w + j * 256 + lane * 4);
      hv[j].x += z[j].x * r * wv.x; hv[j].y += z[j].y * r * wv.y;
      hv[j].z += z[j].z * r * wv.z; hv[j].w += z[j].w * r * wv.w;
      s2 += hv[j].x * hv[j].x + hv[j].y * hv[j].y + hv[j].z * hv[j].z + hv[j].w * hv[j].w;
      *(float4*)(H + row * 1024 + j * 256 + lane * 4) = hv[j];
    }
    if (MODE == 0) {
#pragma unroll
      for (int o = 32; o >= 1; o >>= 1) s2 += SHX(s2, o);
      const float r2 = rsqrtf(s2 * (1.f / 1024.f) + 1e-6f);
#pragma unroll
      for (int j = 0; j < 4; ++j) {
        const float4 wv = *(const float4*)(w2 + j * 256 + lane * 4);
        u32x2 o2 = {pack2(hv[j].x * r2 * wv.x, hv[j].y * r2 * wv.y), pack2(hv[j].z * r2 * wv.z, hv[j].w * r2 * wv.w)};
        *(u32x2*)(nxt + row * 1024 + j * 256 + lane * 4) = o2;
      }
    } else if (MODE == 1) {
#pragma unroll
      for (int j = 0; j < 4; ++j) {
        u32x2 o2 = {pack2(hv[j].x, hv[j].y), pack2(hv[j].z, hv[j].w)};
        *(u32x2*)(nxt + row * 1024 + j * 256 + lane * 4) = o2;
      }
      const float4 pv = *(const float4*)(P.p + row * 256 + lane * 4);
      u32x2 o2 = {pack2(pv.x, pv.y), pack2(pv.z, pv.w)};
      *(u32x2*)((u16*)(P.ws + OFF_PB) + row * 256 + lane * 4) = o2;
    }
  }
}

#define XB_TMO      128
#define XB_XCNT(j)  (256  + 64 * (j))
#define XB_XSUB(j)  (1280 + 64 * (j))
#define XB_XGEN(j)  (2304 + 64 * (j))
#define XB_TOP      3328
#define XB_TOPGEN   3392
#define XCD_BAR_WORDS 3456
#define XB_SPIN_CAP (1u << 18)
#define LAS __attribute__((address_space(3)))

__device__ __forceinline__ unsigned xb_ld(unsigned* p)              { return __hip_atomic_load(p, __ATOMIC_RELAXED, __HIP_MEMORY_SCOPE_AGENT); }
__device__ __forceinline__ unsigned xb_add(unsigned* p, unsigned v) { return __hip_atomic_fetch_add(p, v, __ATOMIC_RELAXED, __HIP_MEMORY_SCOPE_AGENT); }
__device__ __forceinline__ unsigned xb_xcc_id() { return (unsigned)__builtin_amdgcn_s_getreg((3 << 11) | 20) & 0xFu; }
#define XB_SPIN(cond, bar) do { unsigned _sp = 0; while (cond) { __builtin_amdgcn_s_sleep(1); \
    if ((++_sp & 255u) == 0u) { if (xb_ld(&(bar)[XB_TMO])) break; if (_sp > XB_SPIN_CAP) { atomicAdd(&(bar)[XB_TMO], 1u); break; } } } } while (0)

struct XcdBarrier {
    unsigned* bar; unsigned x;
    volatile LAS unsigned* st;
};

__device__ __forceinline__ XcdBarrier xcd_barrier_post(unsigned* bar, volatile LAS unsigned* st) {
    XcdBarrier b; b.bar = bar; b.x = xb_xcc_id(); b.st = st;
    if (tid_() == 0) (void)xb_add(&bar[XB_XCNT(b.x)], 1u);
    return b;
}
__device__ __forceinline__ void xcd_barrier_complete(unsigned* bar, unsigned x, unsigned& nloc, unsigned& nx) {
    const unsigned G = gridDim.x * gridDim.y * gridDim.z;
    unsigned sum, cnt, mine, sp = 0u;
    for (;;) {
        sum = 0u; cnt = 0u; mine = 0u;
#pragma unroll
        for (unsigned j = 0; j < 16; ++j) { const unsigned c = xb_ld(&bar[XB_XCNT(j)]); sum += c; cnt += (c > 0u) ? 1u : 0u; mine = (j == x) ? c : mine; }
        if (sum == G) break;
        __builtin_amdgcn_s_sleep(1);
        if ((++sp & 255u) == 0u) { if (xb_ld(&bar[XB_TMO])) break; if (sp > XB_SPIN_CAP) { atomicAdd(&bar[XB_TMO], 1u); break; } }
    }
    nloc = mine > 0u ? mine : 1u; nx = cnt > 0u ? cnt : 1u;
}

__device__ __forceinline__ void xcd_barrier(const XcdBarrier& b) {
    asm volatile("s_waitcnt vmcnt(0)" ::: "memory");
    __syncthreads();
    if (tid_() == 0) {
        unsigned* bar = b.bar;
        __builtin_amdgcn_s_waitcnt(0);
        unsigned nloc = b.st[0], nx = b.st[1];
        if (nloc == 0u) { xcd_barrier_complete(bar, b.x, nloc, nx); b.st[0] = nloc; b.st[1] = nx; }
        const unsigned old = xb_add(&bar[XB_XSUB(b.x)], 1u);
        const unsigned gen = old / nloc;
        if (old + 1u == (gen + 1u) * nloc) {
            __builtin_amdgcn_fence(__ATOMIC_RELEASE, "agent");
            asm volatile("s_waitcnt vmcnt(0)" ::: "memory");
            const unsigned og = xb_add(&bar[XB_TOP], 1u);
            const unsigned tg = og / nx;
            if (og + 1u == (tg + 1u) * nx) xb_add(&bar[XB_TOPGEN], 1u);
            else XB_SPIN(xb_ld(&bar[XB_TOPGEN]) == tg, bar);
            __builtin_amdgcn_fence(__ATOMIC_ACQUIRE, "agent");
            xb_add(&bar[XB_XGEN(b.x)], 1u);
            asm volatile("s_waitcnt vmcnt(0)" ::: "memory");
        } else {
            XB_SPIN(xb_ld(&bar[XB_XGEN(b.x)]) == gen, bar);
            __builtin_amdgcn_fence(__ATOMIC_ACQUIRE, "agent");
            asm volatile("s_waitcnt vmcnt(0)" ::: "memory");
        }
    }
    __syncthreads();
}

#define OFF_BAR (252 * MIB)
#define GSYNC() do { XcdBarrier xb_; xb_.bar = (unsigned*)(P.ws + OFF_BAR); xb_.x = xb_xcc_id(); xb_.st = (volatile LAS unsigned*)&xb_words; xcd_barrier(xb_); } while (0)
__global__ void __launch_bounds__(256, 2) k_mega(Params P) {
  __shared__ __attribute__((aligned(16))) char smem[67584];
  char* ws = P.ws;
  __shared__ uint4 xb_words;
  if (tid_() == 0) xb_words = make_uint4(0u, 0u, 0u, 0u);
  __syncthreads();
  (void)xcd_barrier_post((unsigned*)(ws + OFF_BAR), (volatile LAS unsigned*)&xb_words);
  phase_prep(P, smem);
  GSYNC();
#pragma unroll 1
  for (int half = 0; half < 2; ++half) {
    phase_inproj(P, half, smem);
    GSYNC();
#if PROBE_DUP == 1
    phase_inproj(P, half, smem);
    GSYNC();
#endif
    if ((int)gridDim.x > 128) {
      const int b2 = bid_();
      if (b2 < 64) cmp_gemm1_tile(P, b2, smem);
      else for (int u = b2 - 64; u < 1024; u += (int)gridDim.x - 64) hgrn_intra_unit(P, u, smem);
    } else {
      for (int t = bid_(); t < 64; t += gridDim.x) cmp_gemm1_tile(P, t, smem);
      for (int u = bid_(); u < 1024; u += gridDim.x) hgrn_intra_unit(P, u, smem);
    }
    GSYNC();
    for (int t = bid_(); t < 32; t += gridDim.x) cmp_gemm2_tile(P, t, smem);
    hgrn_scan(P);
    if (half == 1) phase_late_weights(P, smem);
    GSYNC();
#if PROBE_DUP == 2
    for (int u = bid_(); u < 1024; u += gridDim.x) nsa_unit(P, half, u, smem);
    GSYNC();
#endif
    for (int u = bid_(); u < 1024; u += gridDim.x) nsa_unit(P, half, u, smem);
    for (int u = bid_(); u < 1024; u += gridDim.x) hgrn_out_unit(P, half, u, smem);
    GSYNC();
  }
  phase_branch_merge(P, smem);
  GSYNC();
#if PROBE_DUP == 3
  phase_branch_merge(P, smem);
  GSYNC();
  phase_gemm<2>((const u16*)(ws + OFF_MERGED), 1024, (const u16*)(ws + OFF_WOUT_T), 1024, ws + OFF_Z1, smem);
  GSYNC();
#endif
  phase_gemm_wide<2>((const u16*)(ws + OFF_MERGED), 1024, (const u16*)(ws + OFF_WOUT_T), 1024, (u16*)(ws + OFF_Z1), smem);
  GSYNC();
  phase_rownorm<0, 1>(P, (const void*)(ws + OFF_Z1), P.n_post_mix, P.n_pre_mlp, (u16*)(ws + OFF_V));
  GSYNC();
#if PROBE_DUP == 4
  phase_gemm<1>((const u16*)(ws + OFF_V), 1024, (const u16*)(ws + OFF_WUP_T), 4096, ws + OFF_FFH, smem);
  GSYNC();
#endif
  phase_gemm_wide<1>((const u16*)(ws + OFF_V), 1024, (const u16*)(ws + OFF_WUP_T), 4096, (u16*)(ws + OFF_FFH), smem);
  GSYNC();
#if PROBE_DUP == 4
  phase_gemm<2>((const u16*)(ws + OFF_FFH), 4096, (const u16*)(ws + OFF_WDOWN_T), 1024, ws + OFF_Z2, smem);
  GSYNC();
#endif
  phase_gemm_wide<2>((const u16*)(ws + OFF_FFH), 4096, (const u16*)(ws + OFF_WDOWN_T), 1024, (u16*)(ws + OFF_Z2), smem);
  GSYNC();
  phase_rownorm<1, 1>(P, (const void*)(ws + OFF_Z2), P.n_post_mlp, nullptr, (u16*)(ws + OFF_H2B));
  GSYNC();
  phase_ple(P, smem);
  GSYNC();
#if PROBE_DUP == 5
  for (int i = 0; i < 10; ++i) GSYNC();
#endif
#if PROBE_DUP == 6
  phase_prep(P, smem);
  GSYNC();
#endif
  phase_rownorm<2, 1>(P, (const void*)(P.ws + OFF_Z3), P.n_ple, nullptr, nullptr);
}

extern "C" void kernel_launch(void* const* d_in, const int* in_sizes, int n_in, void* d_out, int out_size, void* d_ws,
                              size_t ws_size, hipStream_t stream) {
  Params P{};
  P.x = (const float*)d_in[0];
  P.p = (const float*)d_in[1];
  P.w_in = (const float*)d_in[2];
  P.w_a = (const float*)d_in[3];
  P.w_b = (const float*)d_in[4];
  P.w_out = (const float*)d_in[5];
  P.n_pre_mix = (const float*)d_in[6];
  P.n_post_mix = (const float*)d_in[7];
  P.n_pre_mlp = (const float*)d_in[8];
  P.n_post_mlp = (const float*)d_in[9];
  P.lb_logits = (const float*)d_in[10];
  P.gnorm = (const float*)d_in[11];
  P.pe_k = (const float*)d_in[12];
  P.pe_v = (const float*)d_in[13];
  P.wk1 = (const float*)d_in[14];
  P.wk2 = (const float*)d_in[15];
  P.wv1 = (const float*)d_in[16];
  P.wv2 = (const float*)d_in[17];
  P.w_up = (const float*)d_in[18];
  P.w_down = (const float*)d_in[19];
  P.w_ple = (const float*)d_in[20];
  P.w_pg = (const float*)d_in[21];
  P.n_ple = (const float*)d_in[22];
  P.out = (float*)d_out;
  P.ws = (char*)d_ws;
#if MEGA
  static int grid_blocks = 0;
  if (!grid_blocks) {
    int dev = 0, cus = 0, per_cu = 0;
    hipGetDevice(&dev);
    hipDeviceGetAttribute(&cus, hipDeviceAttributeMultiprocessorCount, dev);
    hipOccupancyMaxActiveBlocksPerMultiprocessor(&per_cu, k_mega, 256, 0);
    if (per_cu > 2) per_cu = 2;
    if (per_cu < 1) per_cu = 1;
    grid_blocks = cus * per_cu;
  }
  hipMemsetAsync((char*)d_ws + OFF_BAR, 0, XCD_BAR_WORDS * sizeof(unsigned), stream);
  void* args[] = {&P};
  hipError_t e = hipLaunchCooperativeKernel((void*)k_mega, dim3(grid_blocks), dim3(256), args, 0, stream);
  if (e != hipSuccess) fprintf(stderr, "cooperative launch failed: %s (grid %d)\n", hipGetErrorString(e), grid_blocks);
#endif
}
```

```cpp
#include <hip/hip_runtime.h>
#include <hip/hip_cooperative_groups.h>
#include <cstdio>
#include <cstdint>
namespace cg = cooperative_groups;

#ifndef MEGA
#define MEGA 1
#endif
#ifndef PROBE_DUP
#define PROBE_DUP 0
#endif

typedef unsigned short u16;
typedef __attribute__((ext_vector_type(8))) short bf16x8;
typedef __attribute__((ext_vector_type(4))) float f32x4;
typedef __attribute__((ext_vector_type(4))) unsigned u32x4;
typedef __attribute__((ext_vector_type(2))) unsigned u32x2;

#define MFMA(a, b, c) __builtin_amdgcn_mfma_f32_16x16x32_bf16(a, b, c, 0, 0, 0)
#define MIB ((size_t)1 << 20)

#define OFF_U       (0 * MIB)
#define OFF_YB0     (0 * MIB)
#define OFF_WA_T    (16 * MIB)
#define OFF_WB_T    (18 * MIB)
#define OFF_WOUT_T  (20 * MIB)
#define OFF_WPG_T   (22 * MIB)
#define OFF_WPLE_T  (24 * MIB)
#define OFF_WIN_T   (32 * MIB)
#define OFF_WUP_T   (32 * MIB)
#define OFF_WDOWN_T (40 * MIB)
#define OFF_WK1T    (50 * MIB)
#define OFF_WV1T    (51 * MIB)
#define OFF_WK2T    (52 * MIB)
#define OFF_WV2T    (52 * MIB + 32768)
#define OFF_ROPE    (52 * MIB + 65536)
#define OFF_BIAS1   (52 * MIB + 65536 + 262144)
#define OFF_LB      (52 * MIB + 65536 + 262144 + 4096)
#define OFF_BIAS1P  (52 * MIB + 65536 + 262144 + 16384)
#define OFF_NGATE   (53 * MIB)
#define OFF_SG      (56 * MIB)
#define OFF_NQ      (88 * MIB)
#define OFF_QF      (120 * MIB)
#define OFF_LOGF    (136 * MIB)
#define OFF_YB1     (136 * MIB)
#define OFF_HVT     (152 * MIB)
#define OFF_ABUF    (168 * MIB)
#define OFF_UST     (176 * MIB)
#define OFF_KV      (208 * MIB)
#define OFF_NQR     (224 * MIB)
#define OFF_VST     (228 * MIB)
#define OFF_VWT     (232 * MIB)
#define OFF_DCY     (236 * MIB)
#define OFF_HIDK    (236 * MIB + 524288)
#define OFF_HIDV    (237 * MIB + 524288)
#define OFF_KCMP    (238 * MIB + 524288)
#define OFF_VCMPT   (238 * MIB + 524288 + 262144)
#define OFF_MERGED  (88 * MIB)
#define OFF_Z1      (152 * MIB)
#define OFF_V       (56 * MIB)
#define OFF_FFH     (120 * MIB)
#define OFF_Z2      (56 * MIB)
#define OFF_H2B     (120 * MIB)
#define OFF_PB      (152 * MIB)
#define OFF_Z3      (160 * MIB)

struct Params {
  const float *x, *p, *w_in, *w_a, *w_b, *w_out, *n_pre_mix, *n_post_mix, *n_pre_mlp, *n_post_mlp;
  const float *lb_logits, *gnorm, *pe_k, *pe_v, *wk1, *wk2, *wv1, *wv2, *w_up, *w_down, *w_ple, *w_pg, *n_ple;
  float* out;
  char* ws;
};

__device__ __forceinline__ int bid_() { int b = blockIdx.x; asm volatile("" : "+s"(b)); return b; }
__device__ __forceinline__ int tid_() { int t = threadIdx.x; asm volatile("" : "+v"(t)); return t; }
typedef __attribute__((ext_vector_type(2))) float f32x2_t;
typedef __attribute__((ext_vector_type(2))) __bf16 bf16x2_t;
__device__ __forceinline__ uint32_t pack2(float a, float b) {
  f32x2_t v = {a, b};
  return __builtin_bit_cast(uint32_t, __builtin_convertvector(v, bf16x2_t));
}
__device__ __forceinline__ u16 f2bf(float f) { return (u16)(pack2(f, f) & 0xffffu); }
__device__ __forceinline__ float bf2f(u16 h) { return __uint_as_float(((uint32_t)h) << 16); }
__device__ __forceinline__ float shx_f(float v, int src_lane) { return __int_as_float(__builtin_amdgcn_ds_bpermute(src_lane << 2, __float_as_int(v))); }
__device__ __forceinline__ uint32_t shx_u(uint32_t v, int src_lane) { return (uint32_t)__builtin_amdgcn_ds_bpermute(src_lane << 2, (int)v); }
#define SHX(v, m) shx_f((v), lane ^ (m))
#define SHXU(v, m) shx_u((v), lane ^ (m))
__device__ __forceinline__ float sigm(float x) { return __builtin_amdgcn_rcpf(1.f + __expf(-x)); }
__device__ __forceinline__ float siluf(float x) { return x * __builtin_amdgcn_rcpf(1.f + __expf(-x)); }
__device__ __forceinline__ float gelu_tanh(float x) {
  float u = 0.7978845608028654f * (x + 0.044715f * x * x * x);
  float t = 1.f - 2.f * __builtin_amdgcn_rcpf(__expf(2.f * u) + 1.f);
  return 0.5f * x * (1.f + t);
}
__device__ __forceinline__ bf16x8 mk8(uint32_t a, uint32_t b, uint32_t c, uint32_t d) {
  u32x4 v = {a, b, c, d};
  return __builtin_bit_cast(bf16x8, v);
}
__device__ __forceinline__ bf16x8 ld8(const u16* p) { return *(const bf16x8*)p; }

template <int AMODE, int DEEP>
__device__ __forceinline__ void gemm_tile(const u16* __restrict__ A, long lda, int m0, int M,
                                          const u16* __restrict__ Bt, long ldb, int n0, int N, int K,
                                          int coloff, f32x4 (&acc)[4][4], u16* sA, u16* sB) {
  const int tid = tid_(), lane = tid & 63, wave = tid >> 6;
  const int l15 = lane & 15, G = lane >> 4;
  const int wm = wave >> 1, wn = wave & 1;
  const int lr = tid >> 3, ch = tid & 7;
  const char* Ab = (const char*)A;
  const char* Bb = (const char*)Bt;
  unsigned oa[4], ob[4];
  int tok0[4];
#pragma unroll
  for (int i = 0; i < 4; ++i) {
    int r = m0 + lr + 32 * i;
    if (AMODE == 0) {
      if (r > M - 1) r = M - 1;
      oa[i] = (unsigned)(((long)r * lda + ch * 8) * 2);
      tok0[i] = 0;
    } else {
      int grp = r >> 8, n = r & 255;
      int bl = grp >> 2, g = grp & 3;
      tok0[i] = n * 16;
      oa[i] = (unsigned)((bl * 4096 * 1024 + coloff + g * 64 + ch * 8) * 2);
    }
    int rn = n0 + lr + 32 * i;
    if (rn > N - 1) rn = N - 1;
    ob[i] = (unsigned)(((long)rn * ldb + ch * 8) * 2);
  }
#define G_LOAD(RA, RB, KT)                                                                                   \
  {                                                                                                          \
    const char* Ak_ = Ab + (size_t)(KT) * 128;                                                               \
    const char* Bk_ = Bb + (size_t)(KT) * 128;                                                               \
    _Pragma("unroll") for (int i = 0; i < 4; ++i) {                                                          \
      if (AMODE == 0) RA[i] = *(const u32x4*)(Ak_ + oa[i]);                                                  \
      else { int tok = tok0[i] + (KT); if (tok > 4095) tok = 4095; RA[i] = *(const u32x4*)(Ab + (oa[i] + (unsigned)tok * 2048u)); } \
      RB[i] = *(const u32x4*)(Bk_ + ob[i]);                                                                  \
    }                                                                                                        \
  }
#define L_STORE(RA, RB)                                                                                      \
  _Pragma("unroll") for (int i = 0; i < 4; ++i) {                                                            \
    *(u32x4*)&sA[(lr + 32 * i) * 80 + ch * 8] = RA[i];                                                       \
    *(u32x4*)&sB[(lr + 32 * i) * 80 + ch * 8] = RB[i];                                                       \
  }
#define T_COMPUTE()                                                                                          \
  _Pragma("unroll") for (int ks = 0; ks < 2; ++ks) {                                                         \
    bf16x8 af[4], bfr[4];                                                                                    \
    _Pragma("unroll") for (int i = 0; i < 4; ++i) af[i] = ld8(&sA[(wm * 64 + 16 * i + l15) * 80 + ks * 32 + G * 8]);  \
    _Pragma("unroll") for (int j = 0; j < 4; ++j) bfr[j] = ld8(&sB[(wn * 64 + 16 * j + l15) * 80 + ks * 32 + G * 8]); \
    _Pragma("unroll") for (int i = 0; i < 4; ++i)                                                            \
      _Pragma("unroll") for (int j = 0; j < 4; ++j) acc[i][j] = MFMA(af[i], bfr[j], acc[i][j]);              \
  }                                                                                                          \
     \
  __builtin_amdgcn_sched_group_barrier(0x100, 8, 0);                                                         \
  _Pragma("unroll") for (int z = 0; z < 8; ++z) {                                                            \
    __builtin_amdgcn_sched_group_barrier(0x008, 2, 0);                                                       \
    __builtin_amdgcn_sched_group_barrier(0x100, 1, 0);                                                       \
  }                                                                                                          \
  __builtin_amdgcn_sched_group_barrier(0x008, 16, 0);
  const int nk = K >> 6;
  if (DEEP == 2) {
    u32x4 ra0[4], rb0[4], ra1[4], rb1[4];
    const int kl = nk - 1;
    G_LOAD(ra0, rb0, 0);
    G_LOAD(ra1, rb1, 1);
    for (int kt = 0; kt < nk; kt += 2) {
      L_STORE(ra0, rb0);
      __syncthreads();
      G_LOAD(ra0, rb0, (kt + 2 < kl ? kt + 2 : kl));
      T_COMPUTE();
      __syncthreads();
      L_STORE(ra1, rb1);
      __syncthreads();
      G_LOAD(ra1, rb1, (kt + 3 < kl ? kt + 3 : kl));
      T_COMPUTE();
      __syncthreads();
    }
  } else {
    u32x4 ra0[4], rb0[4];
    G_LOAD(ra0, rb0, 0);
    for (int kt = 0; kt < nk; ++kt) {
      L_STORE(ra0, rb0);
      __syncthreads();
      if (kt + 1 < nk) G_LOAD(ra0, rb0, kt + 1);
      T_COMPUTE();
      __syncthreads();
    }
  }
#undef G_LOAD
#undef L_STORE
#undef T_COMPUTE
}

__device__ __forceinline__ void zero_acc(f32x4 (&acc)[4][4]) {
#pragma unroll
  for (int i = 0; i < 4; ++i)
#pragma unroll
    for (int j = 0; j < 4; ++j) acc[i][j] = (f32x4){0.f, 0.f, 0.f, 0.f};
}

#define EPI_VARS                                                         \
  const int tid = tid_(), lane = tid & 63, wave = tid >> 6;         \
  const int l15 = lane & 15, G = lane >> 4;                              \
  const int wm = wave >> 1, wn = wave & 1;                               \
  (void)l15; (void)G; (void)wm; (void)wn;

__device__ __forceinline__ void transpose_tile(const float* __restrict__ W, int ldw, int oc0, int valid, int k0, u16* __restrict__ out,
                               long Kdim, int n0, float* s  ) {
  const int tid = tid_();
  __syncthreads();
  {
    const bool vec = (valid == 64) && (((oc0 | ldw) & 3) == 0);
    if (vec) {
      const int n4 = (tid & 15) * 4;
      float4 v[4];
#pragma unroll
      for (int i = 0; i < 4; ++i) v[i] = *(const float4*)(W + (long)(k0 + (tid >> 4) + 16 * i) * ldw + oc0 + n4);
#pragma unroll
      for (int i = 0; i < 4; ++i) {
        float* d = &s[((tid >> 4) + 16 * i) * 65 + n4];
        d[0] = v[i].x; d[1] = v[i].y; d[2] = v[i].z; d[3] = v[i].w;
      }
    } else {
      const int n = tid & 63;
      for (int kk = tid >> 6; kk < 64; kk += 4) {
        float v = 0.f;
        if (n < valid) v = W[(long)(k0 + kk) * ldw + oc0 + n];
        s[kk * 65 + n] = v;
      }
    }
  }
  __syncthreads();
  {
    const int nn = tid >> 2, kq = (tid & 3) * 16;
    uint32_t w[8];
#pragma unroll
    for (int e = 0; e < 8; ++e) w[e] = pack2(s[(kq + 2 * e) * 65 + nn], s[(kq + 2 * e + 1) * 65 + nn]);
    u16* dst = out + (long)(n0 + nn) * Kdim + k0 + kq;
    *(u32x4*)dst = (u32x4){w[0], w[1], w[2], w[3]};
    *(u32x4*)(dst + 8) = (u32x4){w[4], w[5], w[6], w[7]};
  }
}

__device__ __forceinline__ void transpose_job(const float* W, int N, int K, u16* out, int tile, float* s) {
  const int kt_n = K >> 6;
  const int nt = tile / kt_n, kt = tile % kt_n;
  transpose_tile(W, N, nt * 64, 64, kt * 64, out, K, nt * 64, s);
}

__device__ __forceinline__ void phase_prep(const Params& P, char* smem) {
  const int tid = tid_(), lane = tid & 63, wave = tid >> 6;
  char* ws = P.ws;
  float* sf = (float*)smem;
  {
    u16* U = (u16*)(ws + OFF_U);
    for (int un = bid_(); un < 2048; un += gridDim.x) {
      const int row0 = un * 8 + wave * 2;
      float4 v[2][4];
      float ss[2] = {0.f, 0.f};
#pragma unroll
      for (int rr = 0; rr < 2; ++rr)
#pragma unroll
        for (int j = 0; j < 4; ++j) v[rr][j] = *(const float4*)(P.x + (long)(row0 + rr) * 1024 + j * 256 + lane * 4);
#pragma unroll
      for (int rr = 0; rr < 2; ++rr) {
#pragma unroll
        for (int j = 0; j < 4; ++j)
          ss[rr] += v[rr][j].x * v[rr][j].x + v[rr][j].y * v[rr][j].y + v[rr][j].z * v[rr][j].z + v[rr][j].w * v[rr][j].w;
#pragma unroll
        for (int o = 32; o >= 1; o >>= 1) ss[rr] += SHX(ss[rr], o);
        const float r = rsqrtf(ss[rr] * (1.f / 1024.f) + 1e-6f);
#pragma unroll
        for (int j = 0; j < 4; ++j) {
          const float4 w = *(const float4*)(P.n_pre_mix + j * 256 + lane * 4);
          u32x2 o2 = {pack2(v[rr][j].x * r * w.x, v[rr][j].y * r * w.y), pack2(v[rr][j].z * r * w.z, v[rr][j].w * r * w.w)};
          *(u32x2*)(U + (long)(row0 + rr) * 1024 + j * 256 + lane * 4) = o2;
        }
      }
    }
  }
  {
    u16* WT = (u16*)(ws + OFF_WIN_T);
    for (int t = bid_(); t < 138 * 16; t += gridDim.x) {
      const int nt = t >> 4, kt = t & 15;
      const int nr0 = nt * 64;
      int oc0, valid;
      if (nr0 < 6656) { oc0 = nr0; valid = 64; }
      else if (nr0 < 8704) { oc0 = nr0 + 48; valid = 64; }
      else if (nr0 == 8704) { oc0 = 6656; valid = 48; }
      else { oc0 = 0; valid = 0; }
      transpose_tile(P.w_in, 8752, oc0, valid, kt * 64, WT, 1024, nr0, sf);
    }
    for (int t = bid_(); t < 128; t += gridDim.x) transpose_job(P.wk1, 256, 2048, (u16*)(ws + OFF_WK1T), t, sf);
    for (int t = bid_(); t < 128; t += gridDim.x) transpose_job(P.wv1, 256, 2048, (u16*)(ws + OFF_WV1T), t, sf);
    for (int t = bid_(); t < 4; t += gridDim.x) transpose_job(P.wk2, 64, 256, (u16*)(ws + OFF_WK2T), t, sf);
    for (int t = bid_(); t < 4; t += gridDim.x) transpose_job(P.wv2, 64, 256, (u16*)(ws + OFF_WV2T), t, sf);
  }
  {
    float2* RT = (float2*)(ws + OFF_ROPE);
    for (int un = bid_(); un < 128; un += gridDim.x) {
      const int idx = un * 256 + tid;
      const int t = idx >> 3, j = idx & 7;
      const float inv = (j == 0) ? 1.0f : (j == 1) ? 0.1939227432012558f : (j == 2) ? 0.03760603070259094f
                      : (j == 3) ? 0.007292664609849453f : (j == 4) ? 0.0014142135623842478f
                      : (j == 5) ? 0.00027424818836152554f : (j == 6) ? 5.3182957344688475e-05f : 1.0313385246263351e-05f;
      const float ang = (float)t * inv;
      const double ad = (double)ang;
      const double kq = rint(ad * 0.15915494309189535);
      const float rr = (float)(ad - kq * 6.283185307179586);
      float sn, cs;
      sincosf(rr, &sn, &cs);
      RT[idx] = make_float2(cs, sn);
    }
  }
  {
    float* B1P = (float*)(ws + OFF_BIAS1P);
    for (int un = bid_(); un < 16; un += gridDim.x) {
      const int kvi = un >> 3, part = un & 7;
      const float* pe = kvi ? P.pe_v : P.pe_k;
      const float* w1 = kvi ? P.wv1 : P.wk1;
      float4 a = make_float4(0.f, 0.f, 0.f, 0.f);
      const int k0 = part * 256 + wave * 64;
#pragma unroll 8
      for (int k = k0; k < k0 + 64; ++k) {
        const float pv = pe[k];
        const float4 w = *(const float4*)(w1 + (long)k * 256 + lane * 4);
        a.x += pv * w.x; a.y += pv * w.y; a.z += pv * w.z; a.w += pv * w.w;
      }
      __syncthreads();
      *(float4*)&sf[wave * 256 + lane * 4] = a;
      __syncthreads();
      B1P[un * 256 + tid] = sf[tid] + sf[256 + tid] + sf[512 + tid] + sf[768 + tid];
      __syncthreads();
    }
  }
  {
    float* LB = (float*)(ws + OFF_LB);
    for (int un = bid_(); un < 4; un += gridDim.x) {
      const int c = un * 256 + tid;
      const float l0 = P.lb_logits[c], l1 = P.lb_logits[1024 + c];
      LB[c] = 1.f / (1.f + expf(l1 - l0));
    }
  }
}

__device__ __forceinline__ void phase_late_weights(const Params& P, char* smem) {
  char* ws = P.ws;
  float* sf = (float*)smem;
  for (int t = bid_(); t < 256; t += gridDim.x) transpose_job(P.w_a, 1024, 1024, (u16*)(ws + OFF_WA_T), t, sf);
  for (int t = bid_(); t < 256; t += gridDim.x) transpose_job(P.w_b, 1024, 1024, (u16*)(ws + OFF_WB_T), t, sf);
  for (int t = bid_(); t < 256; t += gridDim.x) transpose_job(P.w_out, 1024, 1024, (u16*)(ws + OFF_WOUT_T), t, sf);
  for (int t = bid_(); t < 256; t += gridDim.x) transpose_job(P.w_pg, 1024, 1024, (u16*)(ws + OFF_WPG_T), t, sf);
  for (int t = bid_(); t < 1024; t += gridDim.x) transpose_job(P.w_up, 4096, 1024, (u16*)(ws + OFF_WUP_T), t, sf);
  for (int t = bid_(); t < 1024; t += gridDim.x) transpose_job(P.w_down, 1024, 4096, (u16*)(ws + OFF_WDOWN_T), t, sf);
  for (int t = bid_(); t < 64; t += gridDim.x) transpose_job(P.w_ple, 1024, 256, (u16*)(ws + OFF_WPLE_T), t, sf);
}

__device__ __forceinline__ void phase_inproj(const Params& P, int half, char* smem) {
  char* ws = P.ws;
  u16* sA = (u16*)smem;
  u16* sB = sA + 128 * 80;
  float* sF = (float*)smem;
  const u16* U = (const u16*)(ws + OFF_U) + (long)half * 8192 * 1024;
  const u16* WT = (const u16*)(ws + OFF_WIN_T);
  u16* QF = (u16*)(ws + OFF_QF);
  u16* LOGF = (u16*)(ws + OFF_LOGF);
  u16* HVT = (u16*)(ws + OFF_HVT);
  u16* SG = (u16*)(ws + OFF_SG) + (long)half * 8192 * 1024;
  u16* NQ = (u16*)(ws + OFF_NQ) + (long)half * 8192 * 1024;
  u16* NQR = (u16*)(ws + OFF_NQR);
  u16* KV = (u16*)(ws + OFF_KV);
  u16* VST = (u16*)(ws + OFF_VST);
  u16* VWT = (u16*)(ws + OFF_VWT);
  u16* GATES = (u16*)P.out + (long)half * 8192 * 2048;
  float* NGATE = (float*)(ws + OFF_NGATE) + (long)half * 8192 * 48;
  const float* RTf = (const float*)(ws + OFF_ROPE);
  const float* LB = (const float*)(ws + OFF_LB);
  for (int t = bid_(); t < 64 * 69; t += gridDim.x) {
    const int nt = t >> 6, mt = t & 63;
    const int m0 = mt * 128, n0 = nt * 128;
    f32x4 acc[4][4];
    zero_acc(acc);
    gemm_tile<0, 2>(U, 1024, m0, 8192, WT, 1024, n0, 8832, 1024, 0, acc, sA, sB);
    {
      EPI_VARS
#pragma unroll
      for (int i = 0; i < 4; ++i)
#pragma unroll
        for (int j = 0; j < 4; ++j)
#pragma unroll
          for (int e = 0; e < 4; ++e) sF[(wm * 64 + 16 * i + G * 4 + e) * 132 + wn * 64 + 16 * j + l15] = acc[i][j][e];
    }
    __syncthreads();
    const int tc = tid_();
    int kind = 0, op = 0, dstride = 1024, dcol = 0;
    u16* dbase = nullptr;
    u16* tbase = nullptr;
    if (nt < 8) { dbase = QF; dcol = n0; op = 0; }
    else if (nt < 16) { dbase = LOGF; dcol = n0 - 1024; op = 1; }
    else if (nt < 24) { kind = 1; tbase = HVT; }
    else if (nt < 32) { dbase = SG; dcol = n0 - 3072; op = 2; }
    else if (nt < 40) { dbase = NQ; dcol = n0 - 4096; op = 3; }
    else if (nt < 52) {
      const int c0 = n0 - 5120, sub0 = c0 >> 8;
      if (sub0 == 3 || sub0 == 5) { kind = 2; tbase = (sub0 == 3) ? VST : VWT; }
      else { dbase = KV; dcol = ((sub0 == 0) ? 0 : (sub0 == 1) ? 256 : (sub0 == 2) ? 512 : 768) + (c0 & 255); op = (sub0 >= 2) ? 5 : 4; }
    } else if (nt < 68) { dbase = GATES; dstride = 2048; dcol = n0 - 6656; op = 6; }
    else kind = 3;

    if (kind == 0) {
#pragma unroll 2
      for (int k8 = 0; k8 < 8; ++k8) {
        const int id = tc + 256 * k8;
        const int row = id >> 4, c8 = (id & 15) * 8;
        const float4 f0 = *(const float4*)&sF[row * 132 + c8];
        const float4 f1 = *(const float4*)&sF[row * 132 + c8 + 4];
        float v[8] = {f0.x, f0.y, f0.z, f0.w, f1.x, f1.y, f1.z, f1.w};
        const int hc = c8 & 63;
        if (op == 0) {
#pragma unroll
          for (int q = 0; q < 8; ++q) v[q] = siluf(v[q]) * 0.08838834764831845f;
        } else if (op == 1) {
          const float4 l0 = *(const float4*)(LB + dcol + c8);
          const float4 l1 = *(const float4*)(LB + dcol + c8 + 4);
          const float lb[8] = {l0.x, l0.y, l0.z, l0.w, l1.x, l1.y, l1.z, l1.w};
#pragma unroll
          for (int q = 0; q < 8; ++q) v[q] = __logf(lb[q] + (1.f - lb[q]) * sigm(v[q]));
        } else if (op == 2) {
#pragma unroll
          for (int q = 0; q < 8; ++q) v[q] = siluf(v[q]);
        } else if (op == 3) {
#pragma unroll
          for (int q = 0; q < 8; ++q) v[q] *= 0.18033688011112042f;
        } else if (op == 6) {
#pragma unroll
          for (int q = 0; q < 8; ++q) v[q] = sigm(v[q]);
        }
        if ((op == 3 || op == 5) && hc < 16) {
          const int pc = (hc == 0) ? c8 + 8 : c8 - 8;
          const float4 g0 = *(const float4*)&sF[row * 132 + pc];
          const float4 g1 = *(const float4*)&sF[row * 132 + pc + 4];
          float pr[8] = {g0.x, g0.y, g0.z, g0.w, g1.x, g1.y, g1.z, g1.w};
          if (op == 3) {
#pragma unroll
            for (int q = 0; q < 8; ++q) pr[q] *= 0.18033688011112042f;
          }
          const int tt = (m0 + row) & 4095;
          const float4 r0 = *(const float4*)(RTf + tt * 16);
          const float4 r1 = *(const float4*)(RTf + tt * 16 + 4);
          const float4 r2 = *(const float4*)(RTf + tt * 16 + 8);
          const float4 r3 = *(const float4*)(RTf + tt * 16 + 12);
          const float cs[8] = {r0.x, r0.z, r1.x, r1.z, r2.x, r2.z, r3.x, r3.z};
          const float sn[8] = {r0.y, r0.w, r1.y, r1.w, r2.y, r2.w, r3.y, r3.w};
          float ro[8];
#pragma unroll
          for (int q = 0; q < 8; ++q) ro[q] = (hc == 0) ? (v[q] * cs[q] - pr[q] * sn[q]) : (v[q] * cs[q] + pr[q] * sn[q]);
          if (op == 3) {
            const int head = (dcol + c8) >> 6;
            *(u32x4*)(NQR + (long)(m0 + row) * 256 + head * 16 + hc) =
                (u32x4){pack2(ro[0], ro[1]), pack2(ro[2], ro[3]), pack2(ro[4], ro[5]), pack2(ro[6], ro[7])};
          } else {
#pragma unroll
            for (int q = 0; q < 8; ++q) v[q] = ro[q];
          }
        }
        u32x4 o4;
        if (op == 1) {
          union { _Float16 h[8]; u32x4 u; } cv;
#pragma unroll
          for (int q = 0; q < 8; ++q) cv.h[q] = (_Float16)v[q];
          o4 = cv.u;
        } else {
          o4 = (u32x4){pack2(v[0], v[1]), pack2(v[2], v[3]), pack2(v[4], v[5]), pack2(v[6], v[7])};
        }
        *(u32x4*)(dbase + (long)(m0 + row) * dstride + dcol + c8) = o4;
      }
    } else if (kind == 1 || kind == 2) {
#pragma unroll 2
      for (int k8 = 0; k8 < 8; ++k8) {
        const int id = tc + 256 * k8;
        const int col = id & 127, r8 = (id >> 7) * 8;
        float v[8];
#pragma unroll
        for (int q = 0; q < 8; ++q) v[q] = sF[(r8 + q) * 132 + col];
        const int r = m0 + r8;
        const int bl = r >> 12, tt = r & 4095;
        unsigned off;
        if (kind == 1) {
          const int c = n0 + col - 2048;
          const int h = c >> 7, dv = c & 127;
          off = ((unsigned)(((bl * 8 + h) * 64 + (tt >> 6)) * 128 + dv) * 64u + (unsigned)(tt & 63)) * 2u;
        } else {
          const int cc = (n0 + col - 5120) & 255;
          const int g = cc >> 6, d = cc & 63;
          off = ((unsigned)((bl * 4 + g) * 64 + d) * 4096u + (unsigned)tt) * 2u;
        }
        *(u32x4*)((char*)tbase + off) = (u32x4){pack2(v[0], v[1]), pack2(v[2], v[3]), pack2(v[4], v[5]), pack2(v[6], v[7])};
      }
    } else {
      for (int id = tc; id < 128 * 48; id += 256) {
        const int row = id / 48, c = id - row * 48;
        NGATE[(long)(m0 + row) * 48 + c] = sigm(sF[row * 132 + c]);
      }
    }
    __syncthreads();
  }
}

__device__ __forceinline__ void hgrn_intra_unit(const Params& P, int uu, char* smem) {
  char* ws = P.ws;
  const int tid = tid_(), lane = tid & 63, wave = tid >> 6;
  const int l15 = lane & 15, G = lane >> 4;
  float* sBc = (float*)smem;
  u16* sQ = (u16*)(smem + 64 * 132 * 4);
  const int bl = uu >> 9, h = (uu >> 6) & 7, c = uu & 63;
  const long r0 = (long)bl * 4096 + c * 64;
  u16* QF = (u16*)(ws + OFF_QF);
  const _Float16* LOGF = (const _Float16*)(ws + OFF_LOGF);
  const u16* HVT = (const u16*)(ws + OFF_HVT);
  u16* ABUF = (u16*)(ws + OFF_ABUF);
  u16* UST = (u16*)(ws + OFF_UST);
  float* DCY = (float*)(ws + OFF_DCY);

  __syncthreads();
#pragma unroll
  for (int i = 0; i < 4; ++i) {
    const int id = tid + 256 * i;
    const int row = id >> 4, cc = (id & 15) * 8;
    const u32x4 lf = *(const u32x4*)(LOGF + (r0 + row) * 1024 + h * 128 + cc);
    const _Float16* hp = (const _Float16*)&lf;
#pragma unroll
    for (int e = 0; e < 8; ++e) sBc[row * 132 + cc + e] = (float)hp[e];
    *(u32x4*)&sQ[row * 136 + cc] = *(const u32x4*)(QF + (r0 + row) * 1024 + h * 128 + cc);
  }
  __syncthreads();
  {
    float* sTot = (float*)(smem + 51200);
    const int col = tid & 127, hh = tid >> 7;
    float v[32];
#pragma unroll
    for (int q = 0; q < 32; ++q) v[q] = sBc[(32 * hh + q) * 132 + col];
    float run = 0.f;
#pragma unroll
    for (int q = 0; q < 32; ++q) { run += v[q]; v[q] = run; }
    if (hh == 0) sTot[col] = run;
    __syncthreads();
    const float off = hh ? sTot[col] : 0.f;
#pragma unroll
    for (int q = 0; q < 32; ++q) sBc[(32 * hh + q) * 132 + col] = v[q] + off;
  }
  __syncthreads();
#pragma unroll
  for (int i = 0; i < 4; ++i) {
    const int id = tid + 256 * i;
    const int row = id >> 4, cc = (id & 15) * 8;
    uint32_t w[4];
#pragma unroll
    for (int e = 0; e < 4; ++e) {
      const float q0 = bf2f(sQ[row * 136 + cc + 2 * e]) * __expf(sBc[row * 132 + cc + 2 * e]);
      const float q1 = bf2f(sQ[row * 136 + cc + 2 * e + 1]) * __expf(sBc[row * 132 + cc + 2 * e + 1]);
      w[e] = pack2(q0, q1);
    }
    *(u32x4*)(QF + (r0 + row) * 1024 + h * 128 + cc) = (u32x4){w[0], w[1], w[2], w[3]};
  }
  if (tid < 128) DCY[(long)uu * 128 + tid] = __expf(sBc[63 * 132 + tid]);
  for (int idx = tid; idx < 4096; idx += 256) {
    const int t = idx >> 6, s = idx & 63;
    if ((s >> 4) > (t >> 4)) ABUF[(long)uu * 4096 + idx] = 0;
  }
  for (int ti = wave; ti < 10; ti += 4) {
    int i, j;
    if (ti == 0) { i = 0; j = 0; }
    else if (ti < 3) { i = 1; j = ti - 1; }
    else if (ti < 6) { i = 2; j = ti - 3; }
    else { i = 3; j = ti - 6; }
    f32x4 a4 = {0.f, 0.f, 0.f, 0.f};
    const int t = 16 * i + l15, s = 16 * j + l15;
#pragma unroll
    for (int ks = 0; ks < 4; ++ks) {
      const int dk0 = ks * 32 + G * 8;
      uint32_t aw[4], bw[4];
#pragma unroll
      for (int e2 = 0; e2 < 4; ++e2) {
        float av[2], bv[2];
#pragma unroll
        for (int z = 0; z < 2; ++z) {
          const int dk = dk0 + 2 * e2 + z;
          const float br = sBc[(16 * i) * 132 + dk];
          const float bt = sBc[t * 132 + dk];
          av[z] = bf2f(sQ[t * 136 + dk]) * __expf(bt - br);
          const float bs = sBc[s * 132 + dk];
          const float bp = (s > 0) ? sBc[(s - 1) * 132 + dk] : 0.f;
          const float kk = 1.f - __expf(bs - bp);
          bv[z] = kk * __expf(br - bs);
        }
        aw[e2] = pack2(av[0], av[1]);
        bw[e2] = pack2(bv[0], bv[1]);
      }
      a4 = MFMA(mk8(aw[0], aw[1], aw[2], aw[3]), mk8(bw[0], bw[1], bw[2], bw[3]), a4);
    }
#pragma unroll
    for (int e = 0; e < 4; ++e) {
      const int tr = 16 * i + G * 4 + e, sc = 16 * j + l15;
      const float v = (sc <= tr) ? a4[e] : 0.f;
      ABUF[(long)uu * 4096 + tr * 64 + sc] = f2bf(v);
    }
  }
  {
    f32x4 ua[8][2];
#pragma unroll
    for (int rt = 0; rt < 8; ++rt) { ua[rt][0] = (f32x4){0.f, 0.f, 0.f, 0.f}; ua[rt][1] = (f32x4){0.f, 0.f, 0.f, 0.f}; }
#pragma unroll
    for (int ks = 0; ks < 2; ++ks) {
      bf16x8 bfr[2];
#pragma unroll
      for (int ct = 0; ct < 2; ++ct) {
        const int dk = (2 * wave + ct) * 16 + l15;
        const float blast = sBc[63 * 132 + dk];
        const int s0 = ks * 32 + G * 8;
        float prev = (s0 > 0) ? sBc[(s0 - 1) * 132 + dk] : 0.f;
        uint32_t bw[4];
#pragma unroll
        for (int e2 = 0; e2 < 4; ++e2) {
          const float b0 = sBc[(s0 + 2 * e2) * 132 + dk];
          const float b1 = sBc[(s0 + 2 * e2 + 1) * 132 + dk];
          const float k0 = (1.f - __expf(b0 - prev)) * __expf(blast - b0);
          const float k1 = (1.f - __expf(b1 - b0)) * __expf(blast - b1);
          prev = b1;
          bw[e2] = pack2(k0, k1);
        }
        bfr[ct] = mk8(bw[0], bw[1], bw[2], bw[3]);
      }
#pragma unroll
      for (int rt = 0; rt < 8; ++rt) {
        const int dv = rt * 16 + l15;
        const bf16x8 af = ld8(HVT + ((long)uu * 128 + dv) * 64 + ks * 32 + G * 8);
        ua[rt][0] = MFMA(af, bfr[0], ua[rt][0]);
        ua[rt][1] = MFMA(af, bfr[1], ua[rt][1]);
      }
    }
    u16* sU = (u16*)smem;
    __syncthreads();
#pragma unroll
    for (int rt = 0; rt < 8; ++rt)
#pragma unroll
      for (int ct = 0; ct < 2; ++ct)
#pragma unroll
        for (int e = 0; e < 4; ++e) {
          const int dv = rt * 16 + G * 4 + e, dk = (2 * wave + ct) * 16 + l15;
          sU[dv * 136 + dk] = f2bf(ua[rt][ct][e]);
        }
    __syncthreads();
#pragma unroll 4
    for (int k8 = 0; k8 < 8; ++k8) {
      const int id = tid + 256 * k8;
      const int row = id >> 4, cch = (id & 15) * 8;
      *(u32x4*)(UST + ((long)uu * 128 + row) * 128 + cch) = *(const u32x4*)&sU[row * 136 + cch];
    }
  }
}

__device__ __forceinline__ void cmp_gemm1_tile(const Params& P, int t, char* smem) {
  char* ws = P.ws;
  u16* sA = (u16*)smem;
  u16* sB = sA + 128 * 80;
  EPI_VARS
  const int kv = t >> 5, rem = t & 31;
  const int mt = rem >> 1, nt = rem & 1;
  const int m0 = mt * 128, n0 = nt * 128;
  const u16* KV = (const u16*)(ws + OFF_KV);
  const u16* W1T = (const u16*)(ws + (kv ? OFF_WV1T : OFF_WK1T));
  u16* HID = (u16*)(ws + (kv ? OFF_HIDV : OFF_HIDK));
  const float* B1P = (const float*)(ws + OFF_BIAS1P) + kv * 2048;
  f32x4 acc[4][4];
  zero_acc(acc);
  gemm_tile<1, 2>(KV, 1024, m0, 2048, W1T, 2048, n0, 256, 2048, kv * 256, acc, sA, sB);
#pragma unroll
  for (int i = 0; i < 4; ++i)
#pragma unroll
    for (int j = 0; j < 4; ++j) {
      const int col = n0 + wn * 64 + 16 * j + l15;
      float bias = 0.f;
#pragma unroll
      for (int pp = 0; pp < 8; ++pp) bias += B1P[pp * 256 + col];
#pragma unroll
      for (int e = 0; e < 4; ++e) {
        const int row = m0 + wm * 64 + 16 * i + G * 4 + e;
        HID[(long)row * 256 + col] = f2bf(gelu_tanh(acc[i][j][e] + bias));
      }
    }
}

__device__ __forceinline__ void cmp_gemm2_tile(const Params& P, int t, char* smem) {
  char* ws = P.ws;
  u16* sA = (u16*)smem;
  u16* sB = sA + 128 * 80;
  EPI_VARS
  const int kv = t >> 4, mt = t & 15;
  const int m0 = mt * 128;
  const u16* HID = (const u16*)(ws + (kv ? OFF_HIDV : OFF_HIDK));
  const u16* W2T = (const u16*)(ws + (kv ? OFF_WV2T : OFF_WK2T));
  u16* KCMP = (u16*)(ws + OFF_KCMP);
  u16* VCMPT = (u16*)(ws + OFF_VCMPT);
  f32x4 acc[4][4];
  zero_acc(acc);
  gemm_tile<0, 1>(HID, 256, m0, 2048, W2T, 256, 0, 64, 256, 0, acc, sA, sB);
  if (wn == 0) {
#pragma unroll
    for (int i = 0; i < 4; ++i)
#pragma unroll
      for (int j = 0; j < 4; ++j) {
        const int col = 16 * j + l15;
        const int rbase = m0 + wm * 64 + 16 * i + G * 4;
        if (kv == 0) {
#pragma unroll
          for (int e = 0; e < 4; ++e) KCMP[(long)(rbase + e) * 64 + col] = f2bf(acc[i][j][e]);
        } else {
          const int grp = rbase >> 8, n = rbase & 255;
          u32x2 o2 = {pack2(acc[i][j][0], acc[i][j][1]), pack2(acc[i][j][2], acc[i][j][3])};
          *(u32x2*)(VCMPT + ((long)grp * 64 + col) * 256 + n) = o2;
        }
      }
  }
}

__device__ __forceinline__ void hgrn_scan(const Params& P) {
  char* ws = P.ws;
  u16* UST = (u16*)(ws + OFF_UST);
  const float* DCY = (const float*)(ws + OFF_DCY);
  for (int idx = bid_() * 256 + tid_(); idx < 131072; idx += gridDim.x * 256) {
    const int bh = idx >> 13, rem = idx & 8191;
    const int dv = rem >> 6, dk2 = (rem & 63) * 2;
    float s0 = 0.f, s1 = 0.f;
#pragma unroll 8
    for (int c = 0; c < 64; ++c) {
      const long uu = (long)bh * 64 + c;
      u16* ptr = UST + (uu * 128 + dv) * 128 + dk2;
      const uint32_t uv = *(const uint32_t*)ptr;
      const float2 d = *(const float2*)(DCY + uu * 128 + dk2);
      *(uint32_t*)ptr = pack2(s0, s1);
      s0 = d.x * s0 + __uint_as_float(uv << 16);
      s1 = d.y * s1 + __uint_as_float(uv & 0xffff0000u);
    }
  }
}

__device__ __forceinline__ void hgrn_out_unit(const Params& P, int half, int uu, char* smem) {
  char* ws = P.ws;
  const int tid = tid_(), lane = tid & 63, wave = tid >> 6;
  const int l15 = lane & 15, G = lane >> 4;
  float* sO = (float*)smem;
  const int bl = uu >> 9, h = (uu >> 6) & 7, c = uu & 63;
  const long r0 = (long)bl * 4096 + c * 64;
  const u16* QF = (const u16*)(ws + OFF_QF);
  const u16* HVT = (const u16*)(ws + OFF_HVT);
  const u16* ABUF = (const u16*)(ws + OFF_ABUF);
  const u16* UST = (const u16*)(ws + OFF_UST);
  u16* SG = (u16*)(ws + OFF_SG) + (long)half * 8192 * 1024;
  f32x4 acc[4][2];
#pragma unroll
  for (int i = 0; i < 4; ++i) { acc[i][0] = (f32x4){0.f, 0.f, 0.f, 0.f}; acc[i][1] = (f32x4){0.f, 0.f, 0.f, 0.f}; }
#pragma unroll
  for (int ks = 0; ks < 4; ++ks) {
    const int dk0 = ks * 32 + G * 8;
    bf16x8 bfr[2];
#pragma unroll
    for (int jt = 0; jt < 2; ++jt) bfr[jt] = ld8(UST + ((long)uu * 128 + 32 * wave + 16 * jt + l15) * 128 + dk0);
#pragma unroll
    for (int i = 0; i < 4; ++i) {
      const bf16x8 af = ld8(QF + (r0 + 16 * i + l15) * 1024 + h * 128 + dk0);
      acc[i][0] = MFMA(af, bfr[0], acc[i][0]);
      acc[i][1] = MFMA(af, bfr[1], acc[i][1]);
    }
  }
#pragma unroll
  for (int ks = 0; ks < 2; ++ks) {
    const int s0 = ks * 32 + G * 8;
    bf16x8 bfr[2];
#pragma unroll
    for (int jt = 0; jt < 2; ++jt) bfr[jt] = ld8(HVT + ((long)uu * 128 + 32 * wave + 16 * jt + l15) * 64 + s0);
#pragma unroll
    for (int i = 0; i < 4; ++i) {
      const bf16x8 af = ld8(ABUF + (long)uu * 4096 + (16 * i + l15) * 64 + s0);
      acc[i][0] = MFMA(af, bfr[0], acc[i][0]);
      acc[i][1] = MFMA(af, bfr[1], acc[i][1]);
    }
  }
  __syncthreads();
#pragma unroll
  for (int i = 0; i < 4; ++i)
#pragma unroll
    for (int jt = 0; jt < 2; ++jt)
#pragma unroll
      for (int e = 0; e < 4; ++e) sO[(16 * i + G * 4 + e) * 132 + 32 * wave + 16 * jt + l15] = acc[i][jt][e];
  __syncthreads();
  {
    const int row = tid >> 2, part = tid & 3;
    float ss = 0.f;
#pragma unroll
    for (int cc = 0; cc < 32; ++cc) { const float v = sO[row * 132 + part * 32 + cc]; ss += v * v; }
    ss += SHX(ss, 1);
    ss += SHX(ss, 2);
    const float r = rsqrtf(ss * (1.f / 128.f) + 1e-6f);
    u16* dst = SG + (r0 + row) * 1024 + h * 128 + part * 32;
#pragma unroll
    for (int q4 = 0; q4 < 4; ++q4) {
      const u32x4 sgv = *(const u32x4*)(dst + q4 * 8);
      uint32_t w[4];
#pragma unroll
      for (int e = 0; e < 4; ++e) {
        const int cc = q4 * 8 + 2 * e;
        const float g0 = __uint_as_float(sgv[e] << 16), g1 = __uint_as_float(sgv[e] & 0xffff0000u);
        const float y0 = sO[row * 132 + part * 32 + cc] * r * P.gnorm[part * 32 + cc] * g0;
        const float y1 = sO[row * 132 + part * 32 + cc + 1] * r * P.gnorm[part * 32 + cc + 1] * g1;
        w[e] = pack2(y0, y1);
      }
      *(u32x4*)(dst + q4 * 8) = (u32x4){w[0], w[1], w[2], w[3]};
    }
  }
}

__device__ __forceinline__ void stage_kv(u16* sK, u16* sV, const u16* kptr, long kstride, const u16* vptr, long vstride) {
  const int tid = tid_();
  __syncthreads();
#pragma unroll
  for (int i = 0; i < 2; ++i) {
    const int id = tid + 256 * i;
    const int row = id >> 3, ch = id & 7;
    *(u32x4*)&sK[row * 72 + ch * 8] = *(const u32x4*)(kptr + row * kstride + ch * 8);
    *(u32x4*)&sV[row * 72 + ch * 8] = *(const u32x4*)(vptr + row * vstride + ch * 8);
  }
  __syncthreads();
}

__device__ __forceinline__ void qk_scores(const u16* sK, const bf16x8 (&q)[2], f32x4 (&s)[4], int l15, int G) {
#pragma unroll
  for (int kt = 0; kt < 4; ++kt) {
    s[kt] = (f32x4){0.f, 0.f, 0.f, 0.f};
#pragma unroll
    for (int ks = 0; ks < 2; ++ks) s[kt] = MFMA(ld8(&sK[(16 * kt + l15) * 72 + ks * 32 + G * 8]), q[ks], s[kt]);
  }
}

__device__ __forceinline__ void pv_accum(const u16* sV, const f32x4 (&p)[4], f32x4 (&o)[4], int l15, int G) {
#pragma unroll
  for (int ks2 = 0; ks2 < 2; ++ks2) {
    const f32x4 pa = p[2 * ks2], pb = p[2 * ks2 + 1];
    const bf16x8 pf = mk8(pack2(pa[0], pa[1]), pack2(pa[2], pa[3]), pack2(pb[0], pb[1]), pack2(pb[2], pb[3]));
#pragma unroll
    for (int dt = 0; dt < 4; ++dt) {
      const u32x2 v0 = *(const u32x2*)&sV[(16 * dt + l15) * 72 + 32 * ks2 + 4 * G];
      const u32x2 v1 = *(const u32x2*)&sV[(16 * dt + l15) * 72 + 32 * ks2 + 16 + 4 * G];
      o[dt] = MFMA(mk8(v0[0], v0[1], v1[0], v1[1]), pf, o[dt]);
    }
  }
}

#define EX2(x) __builtin_amdgcn_exp2f(x)
typedef __attribute__((ext_vector_type(16))) float f32x16;
#define MFMA32(a, b, c) __builtin_amdgcn_mfma_f32_32x32x16_bf16((a), (b), (c), 0, 0, 0)
template <int MODE, bool EDGE>
__device__ __forceinline__ void nsa_block(const u16* sK, const u16* sV, int jb, int qb, int q, bool blk_ok,
                                          const bf16x8 (&qf)[4], f32x16 (&O)[2], float& m, float& l, int r31, int h) {
  const int lane = h * 32 + r31;
  f32x16 s[2];
#pragma unroll
  for (int kt2 = 0; kt2 < 2; ++kt2) {
#pragma unroll
    for (int e = 0; e < 16; ++e) s[kt2][e] = 0.f;
#pragma unroll
    for (int ks = 0; ks < 4; ++ks) s[kt2] = MFMA32(ld8(&sK[(32 * kt2 + r31) * 72 + 16 * ks + 8 * h]), qf[ks], s[kt2]);
  }
  float smax = -1e30f;
  if (EDGE) {
#pragma unroll
    for (int kt2 = 0; kt2 < 2; ++kt2)
#pragma unroll
      for (int e = 0; e < 16; ++e) {
        const int k = 32 * kt2 + (e & 3) + 8 * (e >> 2) + 4 * h;
        const bool a = blk_ok && ((jb == qb) ? (k <= q) : (k > q));
        if (!a) s[kt2][e] = -1e30f;
        smax = fmaxf(smax, s[kt2][e]);
      }
  } else {
#pragma unroll
    for (int kt2 = 0; kt2 < 2; ++kt2)
#pragma unroll
      for (int e = 0; e < 16; ++e) smax = fmaxf(smax, s[kt2][e]);
    if (MODE == 2 && !blk_ok) smax = -1e30f;
  }
  smax = fmaxf(smax, SHX(smax, 32));
  const float mn = fmaxf(m, smax);
  const bool need = (mn - m) > 8.f;
  if (__builtin_amdgcn_ballot_w64(need) != 0ull) {
    const float alpha = need ? EX2(m - mn) : 1.f;
    m = need ? mn : m;
    l *= alpha;
    O[0] *= alpha;
    O[1] *= alpha;
  }
  const float mref = (!EDGE && MODE == 2 && !blk_ok) ? 1e30f : m;
  float ls = 0.f;
#pragma unroll
  for (int kt2 = 0; kt2 < 2; ++kt2)
#pragma unroll
    for (int e = 0; e < 16; ++e) {
      const float sv = s[kt2][e];
      float pv;
      if (EDGE) pv = (sv > -1e29f) ? EX2(sv - m) : 0.f;
      else pv = EX2(sv - mref);
      s[kt2][e] = pv;
      ls += pv;
    }
  l += ls;
#pragma unroll
  for (int kt2 = 0; kt2 < 2; ++kt2)
#pragma unroll
    for (int st = 0; st < 2; ++st) {
      const bf16x8 pf = mk8(pack2(s[kt2][8 * st + 0], s[kt2][8 * st + 1]), pack2(s[kt2][8 * st + 2], s[kt2][8 * st + 3]),
                            pack2(s[kt2][8 * st + 4], s[kt2][8 * st + 5]), pack2(s[kt2][8 * st + 6], s[kt2][8 * st + 7]));
#pragma unroll
      for (int dt2 = 0; dt2 < 2; ++dt2) {
        const u16* vrow = &sV[(32 * dt2 + r31) * 72 + 32 * kt2 + 16 * st + 4 * h];
        const u32x2 v0 = *(const u32x2*)vrow;
        const u32x2 v1 = *(const u32x2*)(vrow + 8);
        O[dt2] = MFMA32(mk8(v0[0], v0[1], v1[0], v1[1]), pf, O[dt2]);
      }
    }
}

template <int MODE>
__device__ __forceinline__ void nsa_branch(const u16* kbase, const u16* vbase, int jb0, int jb1, int qb, int q,
                                           uint32_t mlo, uint32_t mhi, const bf16x8 (&qf)[4], const float* ngbase, int rowbase, int gidx,
                                           u16* sYl, u16* sm, float pscale = 1.f) {
  const int tid = tid_();
  const int lane = tid & 63;
  const int r31 = lane & 31, h = lane >> 5;
  const int srow = tid >> 3, sch = (tid & 7) * 8;
  f32x16 O[2];
#pragma unroll
  for (int e = 0; e < 16; ++e) { O[0][e] = 0.f; O[1][e] = 0.f; }
  float m = -1e30f, l = 0.f;
  u32x4 kr[2], vr[2];
  const unsigned koff = (unsigned)((srow * 1024 + sch) * 2);
  const unsigned voff = (unsigned)((srow * 4096 + sch) * 2);
  {
    const char* kb = (const char*)kbase + (size_t)jb0 * 131072;
    const char* vb = (const char*)vbase + (size_t)jb0 * 128;
#pragma unroll
    for (int i = 0; i < 2; ++i) {
      kr[i] = *(const u32x4*)(kb + (koff + i * 65536u));
      vr[i] = *(const u32x4*)(vb + (voff + i * 262144u));
    }
  }
  __syncthreads();
#pragma unroll
  for (int i = 0; i < 2; ++i) {
    *(u32x4*)&sm[(srow + 32 * i) * 72 + sch] = kr[i];
    *(u32x4*)&sm[4608 + (srow + 32 * i) * 72 + sch] = vr[i];
  }
  __syncthreads();
  int cur = 0;
  for (int jb = jb0; jb <= jb1; ++jb) {
    const bool more = jb < jb1;
    if (more) {
      const char* kb = (const char*)kbase + (size_t)(jb + 1) * 131072;
      const char* vb = (const char*)vbase + (size_t)(jb + 1) * 128;
#pragma unroll
      for (int i = 0; i < 2; ++i) {
        kr[i] = *(const u32x4*)(kb + (koff + i * 65536u));
        vr[i] = *(const u32x4*)(vb + (voff + i * 262144u));
      }
    }
    const u16* sK = sm + cur * 9216;
    const u16* sV = sK + 4608;
    bool blk_ok = true;
    if (MODE == 2) blk_ok = (jb < 32) ? ((mlo >> jb) & 1u) : ((mhi >> (jb - 32)) & 1u);
    const bool edge = (jb == qb) || (MODE == 3 && jb == qb - 8);
    if (edge) nsa_block<MODE, true>(sK, sV, jb, qb, q, blk_ok, qf, O, m, l, r31, h);
    else nsa_block<MODE, false>(sK, sV, jb, qb, q, blk_ok, qf, O, m, l, r31, h);
    if (more) {
      u16* dK = sm + (cur ^ 1) * 9216;
#pragma unroll
      for (int i = 0; i < 2; ++i) {
        *(u32x4*)&dK[(srow + 32 * i) * 72 + sch] = kr[i];
        *(u32x4*)&dK[4608 + (srow + 32 * i) * 72 + sch] = vr[i];
      }
    }
    __syncthreads();
    cur ^= 1;
  }
  const int tg = tid_();
  const int lg = tg & 63, hh = (lg >> 4) & 1, hg = lg >> 5;
  const float* gatep = (const float*)((const char*)ngbase + (unsigned)(rowbase + 16 * (tg >> 6) + (tg & 15)) * 192u) + gidx + hh;
  float lt = l;
  lt += shx_f(lt, lg ^ 32);
  const float sc = (lt > 0.f) ? (pscale * gatep[0] / lt) : 0.f;
  u16* yrow = sYl + (((tg >> 6) * 2 + hh) * 16 + (tg & 15)) * 64;
#pragma unroll
  for (int dt2 = 0; dt2 < 2; ++dt2)
#pragma unroll
    for (int m4 = 0; m4 < 4; ++m4) {
      u32x2* yp = (u32x2*)(yrow + 32 * dt2 + 8 * m4 + 4 * hg);
      const u32x2 yv = *yp;
      const float y0 = __uint_as_float(yv[0] << 16) + O[dt2][4 * m4 + 0] * sc;
      const float y1 = __uint_as_float(yv[0] & 0xffff0000u) + O[dt2][4 * m4 + 1] * sc;
      const float y2 = __uint_as_float(yv[1] << 16) + O[dt2][4 * m4 + 2] * sc;
      const float y3 = __uint_as_float(yv[1] & 0xffff0000u) + O[dt2][4 * m4 + 3] * sc;
      *yp = (u32x2){pack2(y0, y1), pack2(y2, y3)};
    }
}

__device__ __forceinline__ void pv_cmp(const u16* vc, int jb, const f32x4 (&p)[4], f32x4 (&o)[4], int l15, int G) {
#pragma unroll
  for (int ks2 = 0; ks2 < 2; ++ks2) {
    const f32x4 pa = p[2 * ks2], pb = p[2 * ks2 + 1];
    const bf16x8 pf = mk8(pack2(pa[0], pa[1]), pack2(pa[2], pa[3]), pack2(pb[0], pb[1]), pack2(pb[2], pb[3]));
#pragma unroll
    for (int dt = 0; dt < 4; ++dt) {
      const u16* vp = vc + (long)(16 * dt + l15) * 256 + jb * 64 + 32 * ks2 + 4 * G;
      const u32x2 v0 = *(const u32x2*)vp;
      const u32x2 v1 = *(const u32x2*)(vp + 16);
      o[dt] = MFMA(mk8(v0[0], v0[1], v1[0], v1[1]), pf, o[dt]);
    }
  }
}

__device__ __forceinline__ void nsa_unit(const Params& P, int half, int u, char* smem) {
  char* ws = P.ws;
  const int tid = tid_(), lane = tid & 63, wave = tid >> 6;
  const int l15 = lane & 15, G = lane >> 4;
  const int hp = u >> 9, rest = u & 511;
  const int bl = rest >> 8, g = (rest >> 6) & 3, xq = rest & 63;
  const int qb = hp ? xq : 63 - xq;
  const int q = 16 * wave + l15;
  const int t = qb * 64 + q;
  const int rl = bl * 4096 + t;
  const int rg = half * 8192 + rl;
  const char* NQc = (const char*)(ws + OFF_NQ);
  const unsigned qoff = (unsigned)rg * 2048u;
  u16* sm = (u16*)smem;
  float* sImp = (float*)smem;
  const u16* NQ = (const u16*)(ws + OFF_NQ);
  const u16* NQR = (const u16*)(ws + OFF_NQR);
  const u16* KV = (const u16*)(ws + OFF_KV);
  const u16* VST = (const u16*)(ws + OFF_VST);
  const u16* VWT = (const u16*)(ws + OFF_VWT);
  const u16* KCMP = (const u16*)(ws + OFF_KCMP);
  const u16* VCMPT = (const u16*)(ws + OFF_VCMPT);
  const float* NGATE = (const float*)((const char*)(ws + OFF_NGATE) + (unsigned)rg * 192u);
  u16* YB = (u16*)(ws + (half ? OFF_YB1 : OFF_YB0));

  f32x4 Y[2][4];
#pragma unroll
  for (int rr = 0; rr < 2; ++rr)
#pragma unroll
    for (int dt = 0; dt < 4; ++dt) Y[rr][dt] = (f32x4){0.f, 0.f, 0.f, 0.f};

  uint32_t mlo = 0, mhi = 0;
  u16* sYl = (u16*)(smem + 36864);
  {
    const int nblk = ((4 * qb + 2) >> 6) + 1;
    const u16* kc = KCMP + (long)(bl * 4 + g) * 256 * 64;
    const u16* vc = VCMPT + (long)(bl * 4 + g) * 64 * 256;
    float imp[4][4];
#pragma unroll
    for (int a = 0; a < 4; ++a)
#pragma unroll
      for (int b = 0; b < 4; ++b) imp[a][b] = 0.f;
    __syncthreads();
    for (int id = tid; id < nblk * 512; id += 256) {
      const int row = id >> 3, chn = (id & 7) * 8;
      *(u32x4*)&sm[row * 72 + chn] = *(const u32x4*)(kc + row * 64 + chn);
    }
    __syncthreads();
#pragma unroll 1
    for (int r = 0; r < 4; ++r) {
      bf16x8 qp[2];
#pragma unroll
      for (int ks = 0; ks < 2; ++ks) qp[ks] = *(const bf16x8*)(NQc + (qoff + (unsigned)(((4 * g + r) * 64 + ks * 32 + G * 8) * 2)));
      float m = -1e30f, l = 0.f;
#pragma unroll 1
      for (int jb = 0; jb < nblk; ++jb) {
        f32x4 s[4];
        float smax = -1e30f;
#pragma unroll
        for (int kt = 0; kt < 4; ++kt) {
          f32x4 a4 = {0.f, 0.f, 0.f, 0.f};
#pragma unroll
          for (int ks = 0; ks < 2; ++ks)
            a4 = MFMA(ld8(&sm[(jb * 64 + 16 * kt + l15) * 72 + ks * 32 + G * 8]), qp[ks], a4);
#pragma unroll
          for (int e = 0; e < 4; ++e) {
            const int n = jb * 64 + 16 * kt + 4 * G + e;
            const float sv = (16 * n + 31 <= t) ? a4[e] : -1e30f;
            s[kt][e] = sv;
            smax = fmaxf(smax, sv);
          }
        }
        smax = fmaxf(smax, SHX(smax, 16));
        smax = fmaxf(smax, SHX(smax, 32));
        const float mn = fmaxf(m, smax);
        float ls = 0.f;
#pragma unroll
        for (int kt = 0; kt < 4; ++kt)
#pragma unroll
          for (int e = 0; e < 4; ++e) ls += (s[kt][e] > -1e29f) ? EX2(s[kt][e] - mn) : 0.f;
        l = l * EX2(m - mn) + ls;
        m = mn;
      }
      l += SHX(l, 16);
      l += SHX(l, 32);
      const float invl = (l > 0.f) ? 1.f / l : 0.f;
      float prevup = 0.f;
#pragma unroll 1
      for (int jb = 0; jb < nblk; ++jb) {
        {
          f32x4 p[4];
#pragma unroll
          for (int kt = 0; kt < 4; ++kt) {
            f32x4 a4 = {0.f, 0.f, 0.f, 0.f};
#pragma unroll
            for (int ks = 0; ks < 2; ++ks)
              a4 = MFMA(ld8(&sm[(jb * 64 + 16 * kt + l15) * 72 + ks * 32 + G * 8]), qp[ks], a4);
#pragma unroll
            for (int e = 0; e < 4; ++e) {
              const int n = jb * 64 + 16 * kt + 4 * G + e;
              p[kt][e] = (16 * n + 31 <= t) ? EX2(a4[e] - m) * invl : 0.f;
            }
            const float sum4 = (p[kt][0] + p[kt][1]) + (p[kt][2] + p[kt][3]);
            const float upv = shx_f(p[kt][3], (lane + 48) & 63);
            const float add = (G > 0) ? upv : prevup;
            const float iv = sum4 + add;
#pragma unroll
            for (int j = 0; j < 4; ++j) imp[j][kt] += (jb == j) ? iv : 0.f;
            prevup = upv;
          }
          if (r == 2 * hp) pv_cmp(vc, jb, p, Y[0], l15, G);
          else if (r == 2 * hp + 1) pv_cmp(vc, jb, p, Y[1], l15, G);
        }
      }
    }
    {
      const float g0 = NGATE[0 * 16 + 4 * g + 2 * hp], g1 = NGATE[0 * 16 + 4 * g + 2 * hp + 1];
#pragma unroll
      for (int dt = 0; dt < 4; ++dt) {
        *(u32x2*)(sYl + ((wave * 2 + 0) * 16 + l15) * 64 + 16 * dt + 4 * G) = (u32x2){pack2(Y[0][dt][0] * g0, Y[0][dt][1] * g0), pack2(Y[0][dt][2] * g0, Y[0][dt][3] * g0)};
        *(u32x2*)(sYl + ((wave * 2 + 1) * 16 + l15) * 64 + 16 * dt + 4 * G) = (u32x2){pack2(Y[1][dt][0] * g1, Y[1][dt][1] * g1), pack2(Y[1][dt][2] * g1, Y[1][dt][3] * g1)};
      }
    }
    __syncthreads();
    unsigned long long* myKey = (unsigned long long*)sImp + wave * 16 * 65;
    unsigned long long vk[4][4];
#pragma unroll
    for (int jb = 0; jb < 4; ++jb)
#pragma unroll
      for (int kt = 0; kt < 4; ++kt) {
        const int s = 16 * jb + 4 * kt + G;
        vk[jb][kt] = ((unsigned long long)__float_as_uint(imp[jb][kt]) << 6) | (unsigned long long)(63 - s);
        myKey[l15 * 65 + s] = vk[jb][kt];
      }
    __syncthreads();
    const int cur = qb;
    uint32_t blo = 0, bhi = 0;
    if (cur + 1 <= 16) {
#pragma unroll
      for (int jb = 0; jb < 4; ++jb)
#pragma unroll
        for (int kt = 0; kt < 4; ++kt) {
          const int s = 16 * jb + 4 * kt + G;
          if (s <= cur) blo |= (1u << s);
        }
    } else {
      int cnt[4][4];
#pragma unroll
      for (int a = 0; a < 4; ++a)
#pragma unroll
        for (int b = 0; b < 4; ++b) cnt[a][b] = 0;
      for (int sp = 1; sp <= cur - 2; ++sp) {
        const unsigned long long xk = myKey[l15 * 65 + sp];
#pragma unroll
        for (int jb = 0; jb < 4; ++jb)
#pragma unroll
          for (int kt = 0; kt < 4; ++kt) cnt[jb][kt] += (xk > vk[jb][kt]) ? 1 : 0;
      }
#pragma unroll
      for (int jb = 0; jb < 4; ++jb)
#pragma unroll
        for (int kt = 0; kt < 4; ++kt) {
          const int s = 16 * jb + 4 * kt + G;
          const bool sel = (s == 0) || (s == cur) || (s == cur - 1) || (s >= 1 && s <= cur - 2 && cnt[jb][kt] < 13);
          if (sel) { if (s < 32) blo |= (1u << s); else bhi |= (1u << (s - 32)); }
        }
    }
    blo |= SHXU(blo, 16); blo |= SHXU(blo, 32);
    bhi |= SHXU(bhi, 16); bhi |= SHXU(bhi, 32);
    mlo = blo; mhi = bhi;
  }
  {
    const int hh = (lane >> 4) & 1, h5 = lane >> 5;
    const int head = 4 * g + 2 * hp + hh;
    bf16x8 qf[4];
    qf[0] = *(const bf16x8*)((const char*)NQR + ((unsigned)rl * 512u + (unsigned)((head * 16 + 8 * h5) * 2)));
#pragma unroll
    for (int ks = 1; ks < 4; ++ks) qf[ks] = *(const bf16x8*)(NQc + (qoff + (unsigned)((head * 64 + 16 * ks + 8 * h5) * 2)));
    const int head0 = 4 * g + 2 * hp;
    const u16* kbs = KV + (long)bl * 4096 * 1024 + 512 + g * 64;
    const u16* vbs = VST + (long)(bl * 4 + g) * 64 * 4096;
    nsa_branch<2>(kbs, vbs, 0, qb, qb, q, mlo, mhi, qf, (const float*)(ws + OFF_NGATE), half * 8192 + bl * 4096 + qb * 64, 16 + head0, sYl, sm);
    const u16* kbw = KV + (long)bl * 4096 * 1024 + 768 + g * 64;
    const u16* vbw = VWT + (long)(bl * 4 + g) * 64 * 4096;
    const int jw0 = (qb >= 8) ? qb - 8 : 0;
    nsa_branch<3>(kbw, vbw, jw0, qb, qb, q, mlo, mhi, qf, (const float*)(ws + OFF_NGATE), half * 8192 + bl * 4096 + qb * 64, 32 + head0, sYl, sm);
    const int tid2 = tid_();
    const int l2 = tid2 & 63, hh2 = (l2 >> 4) & 1, hg2 = l2 >> 5;
    const unsigned yoff = (unsigned)(bl * 4096 + qb * 64 + 16 * (tid2 >> 6) + (tid2 & 15)) * 2048u;
    const u16* yrow = sYl + (((tid2 >> 6) * 2 + hh2) * 16 + (tid2 & 15)) * 64;
#pragma unroll
    for (int dt2 = 0; dt2 < 2; ++dt2)
#pragma unroll
      for (int m4 = 0; m4 < 4; ++m4) {
        const int d0 = 32 * dt2 + 8 * m4 + 4 * hg2;
        *(u32x2*)((char*)YB + (yoff + (unsigned)(((head0 + hh2) * 64 + d0) * 2))) = *(const u32x2*)(yrow + d0);
      }
  }
}

__device__ __forceinline__ void gemm_tile_wide(const u16* __restrict__ A, long lda, int m0, const u16* __restrict__ Bt, long ldb, int n0, int K,
                                               f32x4 (&acc)[4][8], u16* sA) {
  const int tid = tid_(), lane = tid & 63, wave = tid >> 6;
  const int l15 = lane & 15, G = lane >> 4;
  const int wm = wave >> 1, wn = wave & 1;
  const int lr = tid >> 3, ch = tid & 7;
  u16* sB = sA + 128 * 80;
  const char* Ab = (const char*)A;
  const char* Bb = (const char*)Bt;
  unsigned oa[4], ob[8];
#pragma unroll
  for (int i = 0; i < 4; ++i) oa[i] = (unsigned)(((long)(m0 + lr + 32 * i) * lda + ch * 8) * 2);
#pragma unroll
  for (int i = 0; i < 8; ++i) ob[i] = (unsigned)(((long)(n0 + lr + 32 * i) * ldb + ch * 8) * 2);
  u32x4 ra[4], rb[8];
#pragma unroll
  for (int i = 0; i < 4; ++i) ra[i] = *(const u32x4*)(Ab + oa[i]);
#pragma unroll
  for (int i = 0; i < 8; ++i) rb[i] = *(const u32x4*)(Bb + ob[i]);
  const int nk = K >> 6;
  for (int kt = 0; kt < nk; ++kt) {
#pragma unroll
    for (int i = 0; i < 4; ++i) *(u32x4*)&sA[(lr + 32 * i) * 80 + ch * 8] = ra[i];
#pragma unroll
    for (int i = 0; i < 8; ++i) *(u32x4*)&sB[(lr + 32 * i) * 80 + ch * 8] = rb[i];
    __syncthreads();
    {
      const int kn = (kt + 1 < nk) ? kt + 1 : kt;
      const char* Ak = Ab + (size_t)kn * 128;
      const char* Bk = Bb + (size_t)kn * 128;
#pragma unroll
      for (int i = 0; i < 4; ++i) ra[i] = *(const u32x4*)(Ak + oa[i]);
#pragma unroll
      for (int i = 0; i < 8; ++i) rb[i] = *(const u32x4*)(Bk + ob[i]);
    }
#pragma unroll
    for (int ks = 0; ks < 2; ++ks) {
      bf16x8 af[4];
#pragma unroll
      for (int i = 0; i < 4; ++i) af[i] = ld8(&sA[(wm * 64 + 16 * i + l15) * 80 + ks * 32 + G * 8]);
#pragma unroll
      for (int jh = 0; jh < 2; ++jh) {
        bf16x8 bfr[4];
#pragma unroll
        for (int j = 0; j < 4; ++j) bfr[j] = ld8(&sB[(wn * 128 + 64 * jh + 16 * j + l15) * 80 + ks * 32 + G * 8]);
#pragma unroll
        for (int i = 0; i < 4; ++i)
#pragma unroll
          for (int j = 0; j < 4; ++j) acc[i][4 * jh + j] = MFMA(af[i], bfr[j], acc[i][4 * jh + j]);
      }
    }
    __syncthreads();
  }
}


__device__ __forceinline__ void phase_branch_merge(const Params& P, char* smem) {
  char* ws = P.ws;
  u16* sA = (u16*)smem;
  const u16* YA = (const u16*)(ws + OFF_SG);
  const u16* GATES = (const u16*)P.out;
  u16* MERGED = (u16*)(ws + OFF_MERGED);
  for (int t = bid_(); t < 512; t += gridDim.x) {
    const int nt = t >> 7, mt = t & 127;
    const int m0 = mt * 128, n0 = nt * 256;
    const u16* YBp = (m0 < 8192) ? (const u16*)(ws + OFF_YB0) : ((const u16*)(ws + OFF_YB1) - (long)8192 * 1024);
    f32x4 acc[4][8];
#pragma unroll
    for (int i = 0; i < 4; ++i)
#pragma unroll
      for (int j = 0; j < 8; ++j) acc[i][j] = (f32x4){0.f, 0.f, 0.f, 0.f};
    gemm_tile_wide(YA, 1024, m0, (const u16*)(ws + OFF_WA_T), 1024, n0, 1024, acc, sA);
    {
      const int tc = tid_();
#pragma unroll 4
      for (int k16 = 0; k16 < 16; ++k16) {
        const int id = tc + 256 * k16;
        const int row = id >> 5, cch = (id & 31) * 8;
        *(u32x4*)&sA[row * 264 + cch] = *(const u32x4*)(GATES + (long)(m0 + row) * 2048 + n0 + cch);
      }
    }
    __syncthreads();
    {
      EPI_VARS
#pragma unroll
      for (int i = 0; i < 4; ++i)
#pragma unroll
        for (int j = 0; j < 8; ++j)
#pragma unroll
          for (int e = 0; e < 4; ++e) {
            u16* sp = &sA[(wm * 64 + 16 * i + G * 4 + e) * 264 + wn * 128 + 16 * j + l15];
            *sp = f2bf(bf2f(*sp) * acc[i][j][e]);
            acc[i][j][e] = 0.f;
          }
    }
    __syncthreads();
    {
      const int tc = tid_();
#pragma unroll 4
      for (int k16 = 0; k16 < 16; ++k16) {
        const int id = tc + 256 * k16;
        const int row = id >> 5, cch = (id & 31) * 8;
        *(u32x4*)(MERGED + (long)(m0 + row) * 1024 + n0 + cch) = *(const u32x4*)&sA[row * 264 + cch];
      }
    }
    asm volatile("s_waitcnt vmcnt(0)" ::: "memory");
    __syncthreads();
    gemm_tile_wide(YBp, 1024, m0, (const u16*)(ws + OFF_WB_T), 1024, n0, 1024, acc, sA);
    {
      const int tc = tid_();
#pragma unroll 4
      for (int k16 = 0; k16 < 16; ++k16) {
        const int id = tc + 256 * k16;
        const int row = id >> 5, cch = (id & 31) * 8;
        *(u32x4*)&sA[row * 264 + cch] = *(const u32x4*)(GATES + (long)(m0 + row) * 2048 + 1024 + n0 + cch);
      }
    }
    __syncthreads();
    {
      EPI_VARS
#pragma unroll
      for (int i = 0; i < 4; ++i)
#pragma unroll
        for (int j = 0; j < 8; ++j)
#pragma unroll
          for (int e = 0; e < 4; ++e) {
            u16* sp = &sA[(wm * 64 + 16 * i + G * 4 + e) * 264 + wn * 128 + 16 * j + l15];
            *sp = f2bf(bf2f(*sp) * acc[i][j][e]);
          }
    }
    __syncthreads();
    {
      const int tc = tid_();
#pragma unroll 2
      for (int k16 = 0; k16 < 16; ++k16) {
        const int id = tc + 256 * k16;
        const int row = id >> 5, cch = (id & 31) * 8;
        u16* gp = MERGED + (long)(m0 + row) * 1024 + n0 + cch;
        const u32x4 t1 = *(const u32x4*)gp;
        const u32x4 pb = *(const u32x4*)&sA[row * 264 + cch];
        u32x4 o;
#pragma unroll
        for (int q = 0; q < 4; ++q) {
          const float lo = __uint_as_float(t1[q] << 16) + __uint_as_float(pb[q] << 16);
          const float hi = __uint_as_float(t1[q] & 0xffff0000u) + __uint_as_float(pb[q] & 0xffff0000u);
          o[q] = pack2(lo, hi);
        }
        *(u32x4*)gp = o;
      }
    }
    __syncthreads();
  }
}

template <int EPI>
__device__ __forceinline__ void phase_gemm(const u16* A, int K, const u16* Wt, int N, void* outp, char* smem) {
  u16* sA = (u16*)smem;
  u16* sB = sA + 128 * 80;
  EPI_VARS
  const int ntn = N >> 7;
  for (int t = bid_(); t < 128 * ntn; t += gridDim.x) {
    const int nt = t >> 7, mt = t & 127;
    const int m0 = mt * 128, n0 = nt * 128;
    f32x4 acc[4][4];
    zero_acc(acc);
    gemm_tile<0, 2>(A, K, m0, 16384, Wt, K, n0, N, K, 0, acc, sA, sB);
#pragma unroll
    for (int i = 0; i < 4; ++i)
#pragma unroll
      for (int j = 0; j < 4; ++j) {
        const int col = n0 + wn * 64 + 16 * j + l15;
#pragma unroll
        for (int e = 0; e < 4; ++e) {
          const long row = m0 + wm * 64 + 16 * i + G * 4 + e;
          const float v = acc[i][j][e];
          if (EPI == 0) ((float*)outp)[row * N + col] = v;
          else if (EPI == 2) ((u16*)outp)[row * N + col] = f2bf(v);
          else { const float rl = fmaxf(v, 0.f); ((u16*)outp)[row * N + col] = f2bf(rl * rl); }
        }
      }
  }
}


template <int EPI>
__device__ __forceinline__ void phase_gemm_wide(const u16* A, int K, const u16* Wt, int N, u16* outp, char* smem) {
  u16* sA = (u16*)smem;
  EPI_VARS
  const int ntn = N >> 8;
  for (int t = bid_(); t < 128 * ntn; t += gridDim.x) {
    const int nt = t >> 7, mt = t & 127;
    const int m0 = mt * 128, n0 = nt * 256;
    f32x4 acc[4][8];
#pragma unroll
    for (int i = 0; i < 4; ++i)
#pragma unroll
      for (int j = 0; j < 8; ++j) acc[i][j] = (f32x4){0.f, 0.f, 0.f, 0.f};
    gemm_tile_wide(A, K, m0, Wt, K, n0, K, acc, sA);
#pragma unroll
    for (int i = 0; i < 4; ++i)
#pragma unroll
      for (int j = 0; j < 8; ++j) {
        const int col = n0 + wn * 128 + 16 * j + l15;
#pragma unroll
        for (int e = 0; e < 4; ++e) {
          float v = acc[i][j][e];
          if (EPI == 1) { v = fmaxf(v, 0.f); v = v * v; }
          sA[(wm * 64 + 16 * i + G * 4 + e) * 264 + (col - n0)] = f2bf(v);
        }
      }
    __syncthreads();
    {
      const int tc = tid_();
#pragma unroll 4
      for (int k16 = 0; k16 < 16; ++k16) {
        const int id = tc + 256 * k16;
        const int row = id >> 5, cch = (id & 31) * 8;
        *(u32x4*)(outp + (long)(m0 + row) * N + n0 + cch) = *(const u32x4*)&sA[row * 264 + cch];
      }
    }
    __syncthreads();
  }
}

__device__ __forceinline__ void phase_ple(const Params& P, char* smem) {
  char* ws = P.ws;
  u16* sA = (u16*)smem;
  u16* Z3b = (u16*)(ws + OFF_Z3);
  for (int t = bid_(); t < 512; t += gridDim.x) {
    const int nt = t >> 7, mt = t & 127;
    const int m0 = mt * 128, n0 = nt * 256;
    f32x4 acc[4][8];
#pragma unroll
    for (int i = 0; i < 4; ++i)
#pragma unroll
      for (int j = 0; j < 8; ++j) acc[i][j] = (f32x4){0.f, 0.f, 0.f, 0.f};
    gemm_tile_wide((const u16*)(ws + OFF_PB), 256, m0, (const u16*)(ws + OFF_WPLE_T), 256, n0, 256, acc, sA);
    {
      EPI_VARS
#pragma unroll
      for (int i = 0; i < 4; ++i)
#pragma unroll
        for (int j = 0; j < 8; ++j)
#pragma unroll
          for (int e = 0; e < 4; ++e) {
            sA[(wm * 64 + 16 * i + G * 4 + e) * 264 + wn * 128 + 16 * j + l15] = f2bf(acc[i][j][e]);
            acc[i][j][e] = 0.f;
          }
    }
    __syncthreads();
    {
      const int tc = tid_();
#pragma unroll 4
      for (int k16 = 0; k16 < 16; ++k16) {
        const int id = tc + 256 * k16;
        const int row = id >> 5, cch = (id & 31) * 8;
        *(u32x4*)(Z3b + (long)(m0 + row) * 1024 + n0 + cch) = *(const u32x4*)&sA[row * 264 + cch];
      }
    }
    asm volatile("s_waitcnt vmcnt(0)" ::: "memory");
    __syncthreads();
    gemm_tile_wide((const u16*)(ws + OFF_H2B), 1024, m0, (const u16*)(ws + OFF_WPG_T), 1024, n0, 1024, acc, sA);
    {
      const int tc = tid_();
#pragma unroll 4
      for (int k16 = 0; k16 < 16; ++k16) {
        const int id = tc + 256 * k16;
        const int row = id >> 5, cch = (id & 31) * 8;
        *(u32x4*)&sA[row * 264 + cch] = *(const u32x4*)(Z3b + (long)(m0 + row) * 1024 + n0 + cch);
      }
    }
    __syncthreads();
    {
      EPI_VARS
#pragma unroll
      for (int i = 0; i < 4; ++i)
#pragma unroll
        for (int j = 0; j < 8; ++j)
#pragma unroll
          for (int e = 0; e < 4; ++e) {
            u16* sp = &sA[(wm * 64 + 16 * i + G * 4 + e) * 264 + wn * 128 + 16 * j + l15];
            *sp = f2bf(bf2f(*sp) * sigm(acc[i][j][e]));
          }
    }
    __syncthreads();
    {
      const int tc = tid_();
#pragma unroll 4
      for (int k16 = 0; k16 < 16; ++k16) {
        const int id = tc + 256 * k16;
        const int row = id >> 5, cch = (id & 31) * 8;
        *(u32x4*)(Z3b + (long)(m0 + row) * 1024 + n0 + cch) = *(const u32x4*)&sA[row * 264 + cch];
      }
    }
    __syncthreads();
  }
}

template <int MODE, int ZB>
__device__ __forceinline__ void phase_rownorm(const Params& P, const void* Zv, const float* w, const float* w2, u16* nxt) {
  const int tid = tid_(), lane = tid & 63, wave = tid >> 6;
  float* H = P.out;
  for (int un = bid_(); un < 4096; un += gridDim.x) {
    const long row = (long)un * 4 + wave;
    const float* zr = (const float*)Zv + row * 1024;
    const u16* zh = (const u16*)Zv + row * 1024;
    (void)zr; (void)zh;
    const float* hin = (MODE == 0) ? (P.x + row * 1024) : (H + row * 1024);
    float4 z[4], hv[4];
    float ss = 0.f;
#pragma unroll
    for (int j = 0; j < 4; ++j) {
      if (ZB) {
        const u32x2 zz = *(const u32x2*)(zh + j * 256 + lane * 4);
        z[j] = make_float4(__uint_as_float(zz[0] << 16), __uint_as_float(zz[0] & 0xffff0000u), __uint_as_float(zz[1] << 16), __uint_as_float(zz[1] & 0xffff0000u));
      } else z[j] = *(const float4*)(zr + j * 256 + lane * 4);
      hv[j] = *(const float4*)(hin + j * 256 + lane * 4);
      ss += z[j].x * z[j].x + z[j].y * z[j].y + z[j].z * z[j].z + z[j].w * z[j].w;
    }
#pragma unroll
    for (int o = 32; o >= 1; o >>= 1) ss += SHX(ss, o);
    const float r = rsqrtf(ss * (1.f / 1024.f) + 1e-6f);
    float s2 = 0.f;
#pragma unroll
    for (int j = 0; j < 4; ++j) {
      const float4 wv = *(const float4*)(w + j * 256 + lane * 4);
      hv[j].x += z[j].x * r * wv.x; hv[j].y += z[j].y * r * wv.y;
      hv[j].z += z[j].z * r * wv.z; hv[j].w += z[j].w * r * wv.w;
      s2 += hv[j].x * hv[j].x + hv[j].y * hv[j].y + hv[j].z * hv[j].z + hv[j].w * hv[j].w;
      *(float4*)(H + row * 1024 + j * 256 + lane * 4) = hv[j];
    }
    if (MODE == 0) {
#pragma unroll
      for (int o = 32; o >= 1; o >>= 1) s2 += SHX(s2, o);
      const float r2 = rsqrtf(s2 * (1.f / 1024.f) + 1e-6f);
#pragma unroll
      for (int j = 0; j < 4; ++j) {
        const float4 wv = *(const float4*)(w2 + j * 256 + lane * 4);
        u32x2 o2 = {pack2(hv[j].x * r2 * wv.x, hv[j].y * r2 * wv.y), pack2(hv[j].z * r2 * wv.z, hv[j].w * r2 * wv.w)};
        *(u32x2*)(nxt + row * 1024 + j * 256 + lane * 4) = o2;
      }
    } else if (MODE == 1) {
#pragma unroll
      for (int j = 0; j < 4; ++j) {
        u32x2 o2 = {pack2(hv[j].x, hv[j].y), pack2(hv[j].z, hv[j].w)};
        *(u32x2*)(nxt + row * 1024 + j * 256 + lane * 4) = o2;
      }
      const float4 pv = *(const float4*)(P.p + row * 256 + lane * 4);
      u32x2 o2 = {pack2(pv.x, pv.y), pack2(pv.z, pv.w)};
      *(u32x2*)((u16*)(P.ws + OFF_PB) + row * 256 + lane * 4) = o2;
    }
  }
}

#define XB_TMO      128
#define XB_XCNT(j)  (256  + 64 * (j))
#define XB_XSUB(j)  (1280 + 64 * (j))
#define XB_XGEN(j)  (2304 + 64 * (j))
#define XB_TOP      3328
#define XB_TOPGEN   3392
#define XCD_BAR_WORDS 3456
#define XB_SPIN_CAP (1u << 18)
#define LAS __attribute__((address_space(3)))

__device__ __forceinline__ unsigned xb_ld(unsigned* p)              { return __hip_atomic_load(p, __ATOMIC_RELAXED, __HIP_MEMORY_SCOPE_AGENT); }
__device__ __forceinline__ unsigned xb_add(unsigned* p, unsigned v) { return __hip_atomic_fetch_add(p, v, __ATOMIC_RELAXED, __HIP_MEMORY_SCOPE_AGENT); }
__device__ __forceinline__ unsigned xb_xcc_id() { return (unsigned)__builtin_amdgcn_s_getreg((3 << 11) | 20) & 0xFu; }
#define XB_SPIN(cond, bar) do { unsigned _sp = 0; while (cond) { __builtin_amdgcn_s_sleep(1); \
    if ((++_sp & 255u) == 0u) { if (xb_ld(&(bar)[XB_TMO])) break; if (_sp > XB_SPIN_CAP) { atomicAdd(&(bar)[XB_TMO], 1u); break; } } } } while (0)

struct XcdBarrier {
    unsigned* bar; unsigned x;
    volatile LAS unsigned* st;
};

__device__ __forceinline__ XcdBarrier xcd_barrier_post(unsigned* bar, volatile LAS unsigned* st) {
    XcdBarrier b; b.bar = bar; b.x = xb_xcc_id(); b.st = st;
    if (tid_() == 0) (void)xb_add(&bar[XB_XCNT(b.x)], 1u);
    return b;
}
__device__ __forceinline__ void xcd_barrier_complete(unsigned* bar, unsigned x, unsigned& nloc, unsigned& nx) {
    const unsigned G = gridDim.x * gridDim.y * gridDim.z;
    unsigned sum, cnt, mine, sp = 0u;
    for (;;) {
        sum = 0u; cnt = 0u; mine = 0u;
#pragma unroll
        for (unsigned j = 0; j < 16; ++j) { const unsigned c = xb_ld(&bar[XB_XCNT(j)]); sum += c; cnt += (c > 0u) ? 1u : 0u; mine = (j == x) ? c : mine; }
        if (sum == G) break;
        __builtin_amdgcn_s_sleep(1);
        if ((++sp & 255u) == 0u) { if (xb_ld(&bar[XB_TMO])) break; if (sp > XB_SPIN_CAP) { atomicAdd(&bar[XB_TMO], 1u); break; } }
    }
    nloc = mine > 0u ? mine : 1u; nx = cnt > 0u ? cnt : 1u;
}

__device__ __forceinline__ void xcd_barrier(const XcdBarrier& b) {
    asm volatile("s_waitcnt vmcnt(0)" ::: "memory");
    __syncthreads();
    if (tid_() == 0) {
        unsigned* bar = b.bar;
        __builtin_amdgcn_s_waitcnt(0);
        unsigned nloc = b.st[0], nx = b.st[1];
        if (nloc == 0u) { xcd_barrier_complete(bar, b.x, nloc, nx); b.st[0] = nloc; b.st[1] = nx; }
        const unsigned old = xb_add(&bar[XB_XSUB(b.x)], 1u);
        const unsigned gen = old / nloc;
        if (old + 1u == (gen + 1u) * nloc) {
            __builtin_amdgcn_fence(__ATOMIC_RELEASE, "agent");
            asm volatile("s_waitcnt vmcnt(0)" ::: "memory");
            const unsigned og = xb_add(&bar[XB_TOP], 1u);
            const unsigned tg = og / nx;
            if (og + 1u == (tg + 1u) * nx) xb_add(&bar[XB_TOPGEN], 1u);
            else XB_SPIN(xb_ld(&bar[XB_TOPGEN]) == tg, bar);
            __builtin_amdgcn_fence(__ATOMIC_ACQUIRE, "agent");
            xb_add(&bar[XB_XGEN(b.x)], 1u);
            asm volatile("s_waitcnt vmcnt(0)" ::: "memory");
        } else {
            XB_SPIN(xb_ld(&bar[XB_XGEN(b.x)]) == gen, bar);
            __builtin_amdgcn_fence(__ATOMIC_ACQUIRE, "agent");
            asm volatile("s_waitcnt vmcnt(0)" ::: "memory");
        }
    }
    __syncthreads();
}

#define OFF_BAR (252 * MIB)
#define GSYNC() do { XcdBarrier xb_; xb_.bar = (unsigned*)(P.ws + OFF_BAR); xb_.x = xb_xcc_id(); xb_.st = (volatile LAS unsigned*)&xb_words; xcd_barrier(xb_); } while (0)
__global__ void __launch_bounds__(256, 2) k_mega(Params P) {
  __shared__ __attribute__((aligned(16))) char smem[67584];
  char* ws = P.ws;
  __shared__ uint4 xb_words;
  if (tid_() == 0) xb_words = make_uint4(0u, 0u, 0u, 0u);
  __syncthreads();
  (void)xcd_barrier_post((unsigned*)(ws + OFF_BAR), (volatile LAS unsigned*)&xb_words);
  phase_prep(P, smem);
  GSYNC();
#pragma unroll 1
  for (int half = 0; half < 2; ++half) {
    phase_inproj(P, half, smem);
    GSYNC();
#if PROBE_DUP == 1
    phase_inproj(P, half, smem);
    GSYNC();
#endif
    if ((int)gridDim.x > 128) {
      const int b2 = bid_();
      if (b2 < 64) cmp_gemm1_tile(P, b2, smem);
      else for (int u = b2 - 64; u < 1024; u += (int)gridDim.x - 64) hgrn_intra_unit(P, u, smem);
    } else {
      for (int t = bid_(); t < 64; t += gridDim.x) cmp_gemm1_tile(P, t, smem);
      for (int u = bid_(); u < 1024; u += gridDim.x) hgrn_intra_unit(P, u, smem);
    }
    GSYNC();
    for (int t = bid_(); t < 32; t += gridDim.x) cmp_gemm2_tile(P, t, smem);
    hgrn_scan(P);
    if (half == 1) phase_late_weights(P, smem);
    GSYNC();
#if PROBE_DUP == 2
    for (int u = bid_(); u < 1024; u += gridDim.x) nsa_unit(P, half, u, smem);
    GSYNC();
#endif
    for (int u = bid_(); u < 1024; u += gridDim.x) nsa_unit(P, half, u, smem);
    for (int u = bid_(); u < 1024; u += gridDim.x) hgrn_out_unit(P, half, u, smem);
    GSYNC();
  }
  phase_branch_merge(P, smem);
  GSYNC();
#if PROBE_DUP == 3
  phase_branch_merge(P, smem);
  GSYNC();
  phase_gemm<2>((const u16*)(ws + OFF_MERGED), 1024, (const u16*)(ws + OFF_WOUT_T), 1024, ws + OFF_Z1, smem);
  GSYNC();
#endif
  phase_gemm_wide<2>((const u16*)(ws + OFF_MERGED), 1024, (const u16*)(ws + OFF_WOUT_T), 1024, (u16*)(ws + OFF_Z1), smem);
  GSYNC();
  phase_rownorm<0, 1>(P, (const void*)(ws + OFF_Z1), P.n_post_mix, P.n_pre_mlp, (u16*)(ws + OFF_V));
  GSYNC();
#if PROBE_DUP == 4
  phase_gemm<1>((const u16*)(ws + OFF_V), 1024, (const u16*)(ws + OFF_WUP_T), 4096, ws + OFF_FFH, smem);
  GSYNC();
#endif
  phase_gemm_wide<1>((const u16*)(ws + OFF_V), 1024, (const u16*)(ws + OFF_WUP_T), 4096, (u16*)(ws + OFF_FFH), smem);
  GSYNC();
#if PROBE_DUP == 4
  phase_gemm<2>((const u16*)(ws + OFF_FFH), 4096, (const u16*)(ws + OFF_WDOWN_T), 1024, ws + OFF_Z2, smem);
  GSYNC();
#endif
  phase_gemm_wide<2>((const u16*)(ws + OFF_FFH), 4096, (const u16*)(ws + OFF_WDOWN_T), 1024, (u16*)(ws + OFF_Z2), smem);
  GSYNC();
  phase_rownorm<1, 1>(P, (const void*)(ws + OFF_Z2), P.n_post_mlp, nullptr, (u16*)(ws + OFF_H2B));
  GSYNC();
  phase_ple(P, smem);
  GSYNC();
#if PROBE_DUP == 5
  for (int i = 0; i < 10; ++i) GSYNC();
#endif
#if PROBE_DUP == 6
  phase_prep(P, smem);
  GSYNC();
#endif
  phase_rownorm<2, 1>(P, (const void*)(P.ws + OFF_Z3), P.n_ple, nullptr, nullptr);
}

extern "C" void kernel_launch(void* const* d_in, const int* in_sizes, int n_in, void* d_out, int out_size, void* d_ws,
                              size_t ws_size, hipStream_t stream) {
  Params P{};
  P.x = (const float*)d_in[0];
  P.p = (const float*)d_in[1];
  P.w_in = (const float*)d_in[2];
  P.w_a = (const float*)d_in[3];
  P.w_b = (const float*)d_in[4];
  P.w_out = (const float*)d_in[5];
  P.n_pre_mix = (const float*)d_in[6];
  P.n_post_mix = (const float*)d_in[7];
  P.n_pre_mlp = (const float*)d_in[8];
  P.n_post_mlp = (const float*)d_in[9];
  P.lb_logits = (const float*)d_in[10];
  P.gnorm = (const float*)d_in[11];
  P.pe_k = (const float*)d_in[12];
  P.pe_v = (const float*)d_in[13];
  P.wk1 = (const float*)d_in[14];
  P.wk2 = (const float*)d_in[15];
  P.wv1 = (const float*)d_in[16];
  P.wv2 = (const float*)d_in[17];
  P.w_up = (const float*)d_in[18];
  P.w_down = (const float*)d_in[19];
  P.w_ple = (const float*)d_in[20];
  P.w_pg = (const float*)d_in[21];
  P.n_ple = (const float*)d_in[22];
  P.out = (float*)d_out;
  P.ws = (char*)d_ws;
#if MEGA
  static int grid_blocks = 0;
  if (!grid_blocks) {
    int dev = 0, cus = 0, per_cu = 0;
    hipGetDevice(&dev);
    hipDeviceGetAttribute(&cus, hipDeviceAttributeMultiprocessorCount, dev);
    hipOccupancyMaxActiveBlocksPerMultiprocessor(&per_cu, k_mega, 256, 0);
    if (per_cu > 2) per_cu = 2;
    if (per_cu < 1) per_cu = 1;
    grid_blocks = cus * per_cu;
  }
  hipMemsetAsync((char*)d_ws + OFF_BAR, 0, XCD_BAR_WORDS * sizeof(unsigned), stream);
  void* args[] = {&P};
  hipError_t e = hipLaunchCooperativeKernel((void*)k_mega, dim3(grid_blocks), dim3(256), args, 0, stream);
  if (e != hipSuccess) fprintf(stderr, "cooperative launch failed: %s (grid %d)\n", hipGetErrorString(e), grid_blocks);
#endif
}
```

```cpp
#include <hip/hip_runtime.h>
#include <hip/hip_cooperative_groups.h>
#include <cstdio>
#include <cstdint>
namespace cg = cooperative_groups;

#ifndef MEGA
#define MEGA 1
#endif
#ifndef PROBE_DUP
#define PROBE_DUP 0
#endif

typedef unsigned short u16;
typedef __attribute__((ext_vector_type(8))) short bf16x8;
typedef __attribute__((ext_vector_type(4))) float f32x4;
typedef __attribute__((ext_vector_type(4))) unsigned u32x4;
typedef __attribute__((ext_vector_type(2))) unsigned u32x2;

#define MFMA(a, b, c) __builtin_amdgcn_mfma_f32_16x16x32_bf16(a, b, c, 0, 0, 0)
#define MIB ((size_t)1 << 20)

#define OFF_U       (0 * MIB)
#define OFF_YB0     (0 * MIB)
#define OFF_WA_T    (16 * MIB)
#define OFF_WB_T    (18 * MIB)
#define OFF_WOUT_T  (20 * MIB)
#define OFF_WPG_T   (22 * MIB)
#define OFF_WPLE_T  (24 * MIB)
#define OFF_WIN_T   (32 * MIB)
#define OFF_WUP_T   (32 * MIB)
#define OFF_WDOWN_T (40 * MIB)
#define OFF_WK1T    (50 * MIB)
#define OFF_WV1T    (51 * MIB)
#define OFF_WK2T    (52 * MIB)
#define OFF_WV2T    (52 * MIB + 32768)
#define OFF_ROPE    (52 * MIB + 65536)
#define OFF_BIAS1   (52 * MIB + 65536 + 262144)
#define OFF_LB      (52 * MIB + 65536 + 262144 + 4096)
#define OFF_BIAS1P  (52 * MIB + 65536 + 262144 + 16384)
#define OFF_NGATE   (53 * MIB)
#define OFF_SG      (56 * MIB)
#define OFF_NQ      (88 * MIB)
#define OFF_QF      (120 * MIB)
#define OFF_LOGF    (136 * MIB)
#define OFF_YB1     (136 * MIB)
#define OFF_HVT     (152 * MIB)
#define OFF_ABUF    (168 * MIB)
#define OFF_UST     (176 * MIB)
#define OFF_KV      (208 * MIB)
#define OFF_NQR     (224 * MIB)
#define OFF_VST     (228 * MIB)
#define OFF_VWT     (232 * MIB)
#define OFF_DCY     (236 * MIB)
#define OFF_HIDK    (236 * MIB + 524288)
#define OFF_HIDV    (237 * MIB + 524288)
#define OFF_KCMP    (238 * MIB + 524288)
#define OFF_VCMPT   (238 * MIB + 524288 + 262144)
#define OFF_MERGED  (88 * MIB)
#define OFF_Z1      (152 * MIB)
#define OFF_V       (56 * MIB)
#define OFF_FFH     (120 * MIB)
#define OFF_Z2      (56 * MIB)
#define OFF_H2B     (120 * MIB)
#define OFF_PB      (152 * MIB)
#define OFF_Z3      (160 * MIB)

struct Params {
  const float *x, *p, *w_in, *w_a, *w_b, *w_out, *n_pre_mix, *n_post_mix, *n_pre_mlp, *n_post_mlp;
  const float *lb_logits, *gnorm, *pe_k, *pe_v, *wk1, *wk2, *wv1, *wv2, *w_up, *w_down, *w_ple, *w_pg, *n_ple;
  float* out;
  char* ws;
};

__device__ __forceinline__ int bid_() { int b = blockIdx.x; asm volatile("" : "+s"(b)); return b; }
__device__ __forceinline__ int tid_() { int t = threadIdx.x; asm volatile("" : "+v"(t)); return t; }
typedef __attribute__((ext_vector_type(2))) float f32x2_t;
typedef __attribute__((ext_vector_type(2))) __bf16 bf16x2_t;
__device__ __forceinline__ uint32_t pack2(float a, float b) {
  f32x2_t v = {a, b};
  return __builtin_bit_cast(uint32_t, __builtin_convertvector(v, bf16x2_t));
}
__device__ __forceinline__ u16 f2bf(float f) { return (u16)(pack2(f, f) & 0xffffu); }
__device__ __forceinline__ float bf2f(u16 h) { return __uint_as_float(((uint32_t)h) << 16); }
__device__ __forceinline__ float shx_f(float v, int src_lane) { return __int_as_float(__builtin_amdgcn_ds_bpermute(src_lane << 2, __float_as_int(v))); }
__device__ __forceinline__ uint32_t shx_u(uint32_t v, int src_lane) { return (uint32_t)__builtin_amdgcn_ds_bpermute(src_lane << 2, (int)v); }
#define SHX(v, m) shx_f((v), lane ^ (m))
#define SHXU(v, m) shx_u((v), lane ^ (m))
__device__ __forceinline__ float sigm(float x) { return __builtin_amdgcn_rcpf(1.f + __expf(-x)); }
__device__ __forceinline__ float siluf(float x) { return x * __builtin_amdgcn_rcpf(1.f + __expf(-x)); }
__device__ __forceinline__ float gelu_tanh(float x) {
  float u = 0.7978845608028654f * (x + 0.044715f * x * x * x);
  float t = 1.f - 2.f * __builtin_amdgcn_rcpf(__expf(2.f * u) + 1.f);
  return 0.5f * x * (1.f + t);
}
__device__ __forceinline__ bf16x8 mk8(uint32_t a, uint32_t b, uint32_t c, uint32_t d) {
  u32x4 v = {a, b, c, d};
  return __builtin_bit_cast(bf16x8, v);
}
__device__ __forceinline__ bf16x8 ld8(const u16* p) { return *(const bf16x8*)p; }

template <int AMODE, int DEEP>
__device__ __forceinline__ void gemm_tile(const u16* __restrict__ A, long lda, int m0, int M,
                                          const u16* __restrict__ Bt, long ldb, int n0, int N, int K,
                                          int coloff, f32x4 (&acc)[4][4], u16* sA, u16* sB) {
  const int tid = tid_(), lane = tid & 63, wave = tid >> 6;
  const int l15 = lane & 15, G = lane >> 4;
  const int wm = wave >> 1, wn = wave & 1;
  const int lr = tid >> 3, ch = tid & 7;
  const char* Ab = (const char*)A;
  const char* Bb = (const char*)Bt;
  unsigned oa[4], ob[4];
  int tok0[4];
#pragma unroll
  for (int i = 0; i < 4; ++i) {
    int r = m0 + lr + 32 * i;
    if (AMODE == 0) {
      if (r > M - 1) r = M - 1;
      oa[i] = (unsigned)(((long)r * lda + ch * 8) * 2);
      tok0[i] = 0;
    } else {
      int grp = r >> 8, n = r & 255;
      int bl = grp >> 2, g = grp & 3;
      tok0[i] = n * 16;
      oa[i] = (unsigned)((bl * 4096 * 1024 + coloff + g * 64 + ch * 8) * 2);
    }
    int rn = n0 + lr + 32 * i;
    if (rn > N - 1) rn = N - 1;
    ob[i] = (unsigned)(((long)rn * ldb + ch * 8) * 2);
  }
#define G_LOAD(RA, RB, KT)                                                                                   \
  {                                                                                                          \
    const char* Ak_ = Ab + (size_t)(KT) * 128;                                                               \
    const char* Bk_ = Bb + (size_t)(KT) * 128;                                                               \
    _Pragma("unroll") for (int i = 0; i < 4; ++i) {                                                          \
      if (AMODE == 0) RA[i] = *(const u32x4*)(Ak_ + oa[i]);                                                  \
      else { int tok = tok0[i] + (KT); if (tok > 4095) tok = 4095; RA[i] = *(const u32x4*)(Ab + (oa[i] + (unsigned)tok * 2048u)); } \
      RB[i] = *(const u32x4*)(Bk_ + ob[i]);                                                                  \
    }                                                                                                        \
  }
#define L_STORE(RA, RB)                                                                                      \
  _Pragma("unroll") for (int i = 0; i < 4; ++i) {                                                            \
    *(u32x4*)&sA[(lr + 32 * i) * 80 + ch * 8] = RA[i];                                                       \
    *(u32x4*)&sB[(lr + 32 * i) * 80 + ch * 8] = RB[i];                                                       \
  }
#define T_COMPUTE()                                                                                          \
  _Pragma("unroll") for (int ks = 0; ks < 2; ++ks) {                                                         \
    bf16x8 af[4], bfr[4];                                                                                    \
    _Pragma("unroll") for (int i = 0; i < 4; ++i) af[i] = ld8(&sA[(wm * 64 + 16 * i + l15) * 80 + ks * 32 + G * 8]);  \
    _Pragma("unroll") for (int j = 0; j < 4; ++j) bfr[j] = ld8(&sB[(wn * 64 + 16 * j + l15) * 80 + ks * 32 + G * 8]); \
    _Pragma("unroll") for (int i = 0; i < 4; ++i)                                                            \
      _Pragma("unroll") for (int j = 0; j < 4; ++j) acc[i][j] = MFMA(af[i], bfr[j], acc[i][j]);              \
  }                                                                                                          \
     \
  __builtin_amdgcn_sched_group_barrier(0x100, 8, 0);                                                         \
  _Pragma("unroll") for (int z = 0; z < 8; ++z) {                                                            \
    __builtin_amdgcn_sched_group_barrier(0x008, 2, 0);                                                       \
    __builtin_amdgcn_sched_group_barrier(0x100, 1, 0);                                                       \
  }                                                                                                          \
  __builtin_amdgcn_sched_group_barrier(0x008, 16, 0);
  const int nk = K >> 6;
  if (DEEP == 2) {
    u32x4 ra0[4], rb0[4], ra1[4], rb1[4];
    const int kl = nk - 1;
    G_LOAD(ra0, rb0, 0);
    G_LOAD(ra1, rb1, 1);
    for (int kt = 0; kt < nk; kt += 2) {
      L_STORE(ra0, rb0);
      __syncthreads();
      G_LOAD(ra0, rb0, (kt + 2 < kl ? kt + 2 : kl));
      T_COMPUTE();
      __syncthreads();
      L_STORE(ra1, rb1);
      __syncthreads();
      G_LOAD(ra1, rb1, (kt + 3 < kl ? kt + 3 : kl));
      T_COMPUTE();
      __syncthreads();
    }
  } else {
    u32x4 ra0[4], rb0[4];
    G_LOAD(ra0, rb0, 0);
    for (int kt = 0; kt < nk; ++kt) {
      L_STORE(ra0, rb0);
      __syncthreads();
      if (kt + 1 < nk) G_LOAD(ra0, rb0, kt + 1);
      T_COMPUTE();
      __syncthreads();
    }
  }
#undef G_LOAD
#undef L_STORE
#undef T_COMPUTE
}

__device__ __forceinline__ void zero_acc(f32x4 (&acc)[4][4]) {
#pragma unroll
  for (int i = 0; i < 4; ++i)
#pragma unroll
    for (int j = 0; j < 4; ++j) acc[i][j] = (f32x4){0.f, 0.f, 0.f, 0.f};
}

#define EPI_VARS                                                         \
  const int tid = tid_(), lane = tid & 63, wave = tid >> 6;         \
  const int l15 = lane & 15, G = lane >> 4;                              \
  const int wm = wave >> 1, wn = wave & 1;                               \
  (void)l15; (void)G; (void)wm; (void)wn;

__device__ __forceinline__ void transpose_tile(const float* __restrict__ W, int ldw, int oc0, int valid, int k0, u16* __restrict__ out,
                               long Kdim, int n0, float* s  ) {
  const int tid = tid_();
  __syncthreads();
  {
    const bool vec = (valid == 64) && (((oc0 | ldw) & 3) == 0);
    if (vec) {
      const int n4 = (tid & 15) * 4;
      float4 v[4];
#pragma unroll
      for (int i = 0; i < 4; ++i) v[i] = *(const float4*)(W + (long)(k0 + (tid >> 4) + 16 * i) * ldw + oc0 + n4);
#pragma unroll
      for (int i = 0; i < 4; ++i) {
        float* d = &s[((tid >> 4) + 16 * i) * 65 + n4];
        d[0] = v[i].x; d[1] = v[i].y; d[2] = v[i].z; d[3] = v[i].w;
      }
    } else {
      const int n = tid & 63;
      for (int kk = tid >> 6; kk < 64; kk += 4) {
        float v = 0.f;
        if (n < valid) v = W[(long)(k0 + kk) * ldw + oc0 + n];
        s[kk * 65 + n] = v;
      }
    }
  }
  __syncthreads();
  {
    const int nn = tid >> 2, kq = (tid & 3) * 16;
    uint32_t w[8];
#pragma unroll
    for (int e = 0; e < 8; ++e) w[e] = pack2(s[(kq + 2 * e) * 65 + nn], s[(kq + 2 * e + 1) * 65 + nn]);
    u16* dst = out + (long)(n0 + nn) * Kdim + k0 + kq;
    *(u32x4*)dst = (u32x4){w[0], w[1], w[2], w[3]};
    *(u32x4*)(dst + 8) = (u32x4){w[4], w[5], w[6], w[7]};
  }
}

__device__ __forceinline__ void transpose_job(const float* W, int N, int K, u16* out, int tile, float* s) {
  const int kt_n = K >> 6;
  const int nt = tile / kt_n, kt = tile % kt_n;
  transpose_tile(W, N, nt * 64, 64, kt * 64, out, K, nt * 64, s);
}

__device__ __forceinline__ void phase_prep(const Params& P, char* smem) {
  const int tid = tid_(), lane = tid & 63, wave = tid >> 6;
  char* ws = P.ws;
  float* sf = (float*)smem;
  {
    u16* U = (u16*)(ws + OFF_U);
    for (int un = bid_(); un < 2048; un += gridDim.x) {
      const int row0 = un * 8 + wave * 2;
      float4 v[2][4];
      float ss[2] = {0.f, 0.f};
#pragma unroll
      for (int rr = 0; rr < 2; ++rr)
#pragma unroll
        for (int j = 0; j < 4; ++j) v[rr][j] = *(const float4*)(P.x + (long)(row0 + rr) * 1024 + j * 256 + lane * 4);
#pragma unroll
      for (int rr = 0; rr < 2; ++rr) {
#pragma unroll
        for (int j = 0; j < 4; ++j)
          ss[rr] += v[rr][j].x * v[rr][j].x + v[rr][j].y * v[rr][j].y + v[rr][j].z * v[rr][j].z + v[rr][j].w * v[rr][j].w;
#pragma unroll
        for (int o = 32; o >= 1; o >>= 1) ss[rr] += SHX(ss[rr], o);
        const float r = rsqrtf(ss[rr] * (1.f / 1024.f) + 1e-6f);
#pragma unroll
        for (int j = 0; j < 4; ++j) {
          const float4 w = *(const float4*)(P.n_pre_mix + j * 256 + lane * 4);
          u32x2 o2 = {pack2(v[rr][j].x * r * w.x, v[rr][j].y * r * w.y), pack2(v[rr][j].z * r * w.z, v[rr][j].w * r * w.w)};
          *(u32x2*)(U + (long)(row0 + rr) * 1024 + j * 256 + lane * 4) = o2;
        }
      }
    }
  }
  {
    u16* WT = (u16*)(ws + OFF_WIN_T);
    for (int t = bid_(); t < 138 * 16; t += gridDim.x) {
      const int nt = t >> 4, kt = t & 15;
      const int nr0 = nt * 64;
      int oc0, valid;
      if (nr0 < 6656) { oc0 = nr0; valid = 64; }
      else if (nr0 < 8704) { oc0 = nr0 + 48; valid = 64; }
      else if (nr0 == 8704) { oc0 = 6656; valid = 48; }
      else { oc0 = 0; valid = 0; }
      transpose_tile(P.w_in, 8752, oc0, valid, kt * 64, WT, 1024, nr0, sf);
    }
    for (int t = bid_(); t < 128; t += gridDim.x) transpose_job(P.wk1, 256, 2048, (u16*)(ws + OFF_WK1T), t, sf);
    for (int t = bid_(); t < 128; t += gridDim.x) transpose_job(P.wv1, 256, 2048, (u16*)(ws + OFF_WV1T), t, sf);
    for (int t = bid_(); t < 4; t += gridDim.x) transpose_job(P.wk2, 64, 256, (u16*)(ws + OFF_WK2T), t, sf);
    for (int t = bid_(); t < 4; t += gridDim.x) transpose_job(P.wv2, 64, 256, (u16*)(ws + OFF_WV2T), t, sf);
  }
  {
    float2* RT = (float2*)(ws + OFF_ROPE);
    for (int un = bid_(); un < 128; un += gridDim.x) {
      const int idx = un * 256 + tid;
      const int t = idx >> 3, j = idx & 7;
      const float inv = (j == 0) ? 1.0f : (j == 1) ? 0.1939227432012558f : (j == 2) ? 0.03760603070259094f
                      : (j == 3) ? 0.007292664609849453f : (j == 4) ? 0.0014142135623842478f
                      : (j == 5) ? 0.00027424818836152554f : (j == 6) ? 5.3182957344688475e-05f : 1.0313385246263351e-05f;
      const float ang = (float)t * inv;
      const double ad = (double)ang;
      const double kq = rint(ad * 0.15915494309189535);
      const float rr = (float)(ad - kq * 6.283185307179586);
      float sn, cs;
      sincosf(rr, &sn, &cs);
      RT[idx] = make_float2(cs, sn);
    }
  }
  {
    float* B1P = (float*)(ws + OFF_BIAS1P);
    for (int un = bid_(); un < 16; un += gridDim.x) {
      const int kvi = un >> 3, part = un & 7;
      const float* pe = kvi ? P.pe_v : P.pe_k;
      const float* w1 = kvi ? P.wv1 : P.wk1;
      float4 a = make_float4(0.f, 0.f, 0.f, 0.f);
      const int k0 = part * 256 + wave * 64;
#pragma unroll 8
      for (int k = k0; k < k0 + 64; ++k) {
        const float pv = pe[k];
        const float4 w = *(const float4*)(w1 + (long)k * 256 + lane * 4);
        a.x += pv * w.x; a.y += pv * w.y; a.z += pv * w.z; a.w += pv * w.w;
      }
      __syncthreads();
      *(float4*)&sf[wave * 256 + lane * 4] = a;
      __syncthreads();
      B1P[un * 256 + tid] = sf[tid] + sf[256 + tid] + sf[512 + tid] + sf[768 + tid];
      __syncthreads();
    }
  }
  {
    float* LB = (float*)(ws + OFF_LB);
    for (int un = bid_(); un < 4; un += gridDim.x) {
      const int c = un * 256 + tid;
      const float l0 = P.lb_logits[c], l1 = P.lb_logits[1024 + c];
      LB[c] = 1.f / (1.f + expf(l1 - l0));
    }
  }
}

__device__ __forceinline__ void phase_late_weights(const Params& P, char* smem) {
  char* ws = P.ws;
  float* sf = (float*)smem;
  for (int t = bid_(); t < 256; t += gridDim.x) transpose_job(P.w_a, 1024, 1024, (u16*)(ws + OFF_WA_T), t, sf);
  for (int t = bid_(); t < 256; t += gridDim.x) transpose_job(P.w_b, 1024, 1024, (u16*)(ws + OFF_WB_T), t, sf);
  for (int t = bid_(); t < 256; t += gridDim.x) transpose_job(P.w_out, 1024, 1024, (u16*)(ws + OFF_WOUT_T), t, sf);
  for (int t = bid_(); t < 256; t += gridDim.x) transpose_job(P.w_pg, 1024, 1024, (u16*)(ws + OFF_WPG_T), t, sf);
  for (int t = bid_(); t < 1024; t += gridDim.x) transpose_job(P.w_up, 4096, 1024, (u16*)(ws + OFF_WUP_T), t, sf);
  for (int t = bid_(); t < 1024; t += gridDim.x) transpose_job(P.w_down, 1024, 4096, (u16*)(ws + OFF_WDOWN_T), t, sf);
  for (int t = bid_(); t < 64; t += gridDim.x) transpose_job(P.w_ple, 1024, 256, (u16*)(ws + OFF_WPLE_T), t, sf);
}

__device__ __forceinline__ void phase_inproj(const Params& P, int half, char* smem) {
  char* ws = P.ws;
  u16* sA = (u16*)smem;
  u16* sB = sA + 128 * 80;
  float* sF = (float*)smem;
  const u16* U = (const u16*)(ws + OFF_U) + (long)half * 8192 * 1024;
  const u16* WT = (const u16*)(ws + OFF_WIN_T);
  u16* QF = (u16*)(ws + OFF_QF);
  u16* LOGF = (u16*)(ws + OFF_LOGF);
  u16* HVT = (u16*)(ws + OFF_HVT);
  u16* SG = (u16*)(ws + OFF_SG) + (long)half * 8192 * 1024;
  u16* NQ = (u16*)(ws + OFF_NQ) + (long)half * 8192 * 1024;
  u16* NQR = (u16*)(ws + OFF_NQR);
  u16* KV = (u16*)(ws + OFF_KV);
  u16* VST = (u16*)(ws + OFF_VST);
  u16* VWT = (u16*)(ws + OFF_VWT);
  u16* GATES = (u16*)P.out + (long)half * 8192 * 2048;
  float* NGATE = (float*)(ws + OFF_NGATE) + (long)half * 8192 * 48;
  const float* RTf = (const float*)(ws + OFF_ROPE);
  const float* LB = (const float*)(ws + OFF_LB);
  for (int t = bid_(); t < 64 * 69; t += gridDim.x) {
    const int nt = t >> 6, mt = t & 63;
    const int m0 = mt * 128, n0 = nt * 128;
    f32x4 acc[4][4];
    zero_acc(acc);
    gemm_tile<0, 2>(U, 1024, m0, 8192, WT, 1024, n0, 8832, 1024, 0, acc, sA, sB);
    {
      EPI_VARS
#pragma unroll
      for (int i = 0; i < 4; ++i)
#pragma unroll
        for (int j = 0; j < 4; ++j)
#pragma unroll
          for (int e = 0; e < 4; ++e) sF[(wm * 64 + 16 * i + G * 4 + e) * 132 + wn * 64 + 16 * j + l15] = acc[i][j][e];
    }
    __syncthreads();
    const int tc = tid_();
    int kind = 0, op = 0, dstride = 1024, dcol = 0;
    u16* dbase = nullptr;
    u16* tbase = nullptr;
    if (nt < 8) { dbase = QF; dcol = n0; op = 0; }
    else if (nt < 16) { dbase = LOGF; dcol = n0 - 1024; op = 1; }
    else if (nt < 24) { kind = 1; tbase = HVT; }
    else if (nt < 32) { dbase = SG; dcol = n0 - 3072; op = 2; }
    else if (nt < 40) { dbase = NQ; dcol = n0 - 4096; op = 3; }
    else if (nt < 52) {
      const int c0 = n0 - 5120, sub0 = c0 >> 8;
      if (sub0 == 3 || sub0 == 5) { kind = 2; tbase = (sub0 == 3) ? VST : VWT; }
      else { dbase = KV; dcol = ((sub0 == 0) ? 0 : (sub0 == 1) ? 256 : (sub0 == 2) ? 512 : 768) + (c0 & 255); op = (sub0 >= 2) ? 5 : 4; }
    } else if (nt < 68) { dbase = GATES; dstride = 2048; dcol = n0 - 6656; op = 6; }
    else kind = 3;

    if (kind == 0) {
#pragma unroll 2
      for (int k8 = 0; k8 < 8; ++k8) {
        const int id = tc + 256 * k8;
        const int row = id >> 4, c8 = (id & 15) * 8;
        const float4 f0 = *(const float4*)&sF[row * 132 + c8];
        const float4 f1 = *(const float4*)&sF[row * 132 + c8 + 4];
        float v[8] = {f0.x, f0.y, f0.z, f0.w, f1.x, f1.y, f1.z, f1.w};
        const int hc = c8 & 63;
        if (op == 0) {
#pragma unroll
          for (int q = 0; q < 8; ++q) v[q] = siluf(v[q]) * 0.08838834764831845f;
        } else if (op == 1) {
          const float4 l0 = *(const float4*)(LB + dcol + c8);
          const float4 l1 = *(const float4*)(LB + dcol + c8 + 4);
          const float lb[8] = {l0.x, l0.y, l0.z, l0.w, l1.x, l1.y, l1.z, l1.w};
#pragma unroll
          for (int q = 0; q < 8; ++q) v[q] = __logf(lb[q] + (1.f - lb[q]) * sigm(v[q]));
        } else if (op == 2) {
#pragma unroll
          for (int q = 0; q < 8; ++q) v[q] = siluf(v[q]);
        } else if (op == 3) {
#pragma unroll
          for (int q = 0; q < 8; ++q) v[q] *= 0.18033688011112042f;
        } else if (op == 6) {
#pragma unroll
          for (int q = 0; q < 8; ++q) v[q] = sigm(v[q]);
        }
        if ((op == 3 || op == 5) && hc < 16) {
          const int pc = (hc == 0) ? c8 + 8 : c8 - 8;
          const float4 g0 = *(const float4*)&sF[row * 132 + pc];
          const float4 g1 = *(const float4*)&sF[row * 132 + pc + 4];
          float pr[8] = {g0.x, g0.y, g0.z, g0.w, g1.x, g1.y, g1.z, g1.w};
          if (op == 3) {
#pragma unroll
            for (int q = 0; q < 8; ++q) pr[q] *= 0.18033688011112042f;
          }
          const int tt = (m0 + row) & 4095;
          const float4 r0 = *(const float4*)(RTf + tt * 16);
          const float4 r1 = *(const float4*)(RTf + tt * 16 + 4);
          const float4 r2 = *(const float4*)(RTf + tt * 16 + 8);
          const float4 r3 = *(const float4*)(RTf + tt * 16 + 12);
          const float cs[8] = {r0.x, r0.z, r1.x, r1.z, r2.x, r2.z, r3.x, r3.z};
          const float sn[8] = {r0.y, r0.w, r1.y, r1.w, r2.y, r2.w, r3.y, r3.w};
          float ro[8];
#pragma unroll
          for (int q = 0; q < 8; ++q) ro[q] = (hc == 0) ? (v[q] * cs[q] - pr[q] * sn[q]) : (v[q] * cs[q] + pr[q] * sn[q]);
          if (op == 3) {
            const int head = (dcol + c8) >> 6;
            *(u32x4*)(NQR + (long)(m0 + row) * 256 + head * 16 + hc) =
                (u32x4){pack2(ro[0], ro[1]), pack2(ro[2], ro[3]), pack2(ro[4], ro[5]), pack2(ro[6], ro[7])};
          } else {
#pragma unroll
            for (int q = 0; q < 8; ++q) v[q] = ro[q];
          }
        }
        u32x4 o4;
        if (op == 1) {
          union { _Float16 h[8]; u32x4 u; } cv;
#pragma unroll
          for (int q = 0; q < 8; ++q) cv.h[q] = (_Float16)v[q];
          o4 = cv.u;
        } else {
          o4 = (u32x4){pack2(v[0], v[1]), pack2(v[2], v[3]), pack2(v[4], v[5]), pack2(v[6], v[7])};
        }
        *(u32x4*)(dbase + (long)(m0 + row) * dstride + dcol + c8) = o4;
      }
    } else if (kind == 1 || kind == 2) {
#pragma unroll 2
      for (int k8 = 0; k8 < 8; ++k8) {
        const int id = tc + 256 * k8;
        const int col = id & 127, r8 = (id >> 7) * 8;
        float v[8];
#pragma unroll
        for (int q = 0; q < 8; ++q) v[q] = sF[(r8 + q) * 132 + col];
        const int r = m0 + r8;
        const int bl = r >> 12, tt = r & 4095;
        unsigned off;
        if (kind == 1) {
          const int c = n0 + col - 2048;
          const int h = c >> 7, dv = c & 127;
          off = ((unsigned)(((bl * 8 + h) * 64 + (tt >> 6)) * 128 + dv) * 64u + (unsigned)(tt & 63)) * 2u;
        } else {
          const int cc = (n0 + col - 5120) & 255;
          const int g = cc >> 6, d = cc & 63;
          off = ((unsigned)((bl * 4 + g) * 64 + d) * 4096u + (unsigned)tt) * 2u;
        }
        *(u32x4*)((char*)tbase + off) = (u32x4){pack2(v[0], v[1]), pack2(v[2], v[3]), pack2(v[4], v[5]), pack2(v[6], v[7])};
      }
    } else {
      for (int id = tc; id < 128 * 48; id += 256) {
        const int row = id / 48, c = id - row * 48;
        NGATE[(long)(m0 + row) * 48 + c] = sigm(sF[row * 132 + c]);
      }
    }
    __syncthreads();
  }
}

__device__ __forceinline__ void hgrn_intra_unit(const Params& P, int uu, char* smem) {
  char* ws = P.ws;
  const int tid = tid_(), lane = tid & 63, wave = tid >> 6;
  const int l15 = lane & 15, G = lane >> 4;
  float* sBc = (float*)smem;
  u16* sQ = (u16*)(smem + 64 * 132 * 4);
  const int bl = uu >> 9, h = (uu >> 6) & 7, c = uu & 63;
  const long r0 = (long)bl * 4096 + c * 64;
  u16* QF = (u16*)(ws + OFF_QF);
  const _Float16* LOGF = (const _Float16*)(ws + OFF_LOGF);
  const u16* HVT = (const u16*)(ws + OFF_HVT);
  u16* ABUF = (u16*)(ws + OFF_ABUF);
  u16* UST = (u16*)(ws + OFF_UST);
  float* DCY = (float*)(ws + OFF_DCY);

  __syncthreads();
#pragma unroll
  for (int i = 0; i < 4; ++i) {
    const int id = tid + 256 * i;
    const int row = id >> 4, cc = (id & 15) * 8;
    const u32x4 lf = *(const u32x4*)(LOGF + (r0 + row) * 1024 + h * 128 + cc);
    const _Float16* hp = (const _Float16*)&lf;
#pragma unroll
    for (int e = 0; e < 8; ++e) sBc[row * 132 + cc + e] = (float)hp[e];
    *(u32x4*)&sQ[row * 136 + cc] = *(const u32x4*)(QF + (r0 + row) * 1024 + h * 128 + cc);
  }
  __syncthreads();
  {
    float* sTot = (float*)(smem + 51200);
    const int col = tid & 127, hh = tid >> 7;
    float v[32];
#pragma unroll
    for (int q = 0; q < 32; ++q) v[q] = sBc[(32 * hh + q) * 132 + col];
    float run = 0.f;
#pragma unroll
    for (int q = 0; q < 32; ++q) { run += v[q]; v[q] = run; }
    if (hh == 0) sTot[col] = run;
    __syncthreads();
    const float off = hh ? sTot[col] : 0.f;
#pragma unroll
    for (int q = 0; q < 32; ++q) sBc[(32 * hh + q) * 132 + col] = v[q] + off;
  }
  __syncthreads();
#pragma unroll
  for (int i = 0; i < 4; ++i) {
    const int id = tid + 256 * i;
    const int row = id >> 4, cc = (id & 15) * 8;
    uint32_t w[4];
#pragma unroll
    for (int e = 0; e < 4; ++e) {
      const float q0 = bf2f(sQ[row * 136 + cc + 2 * e]) * __expf(sBc[row * 132 + cc + 2 * e]);
      const float q1 = bf2f(sQ[row * 136 + cc + 2 * e + 1]) * __expf(sBc[row * 132 + cc + 2 * e + 1]);
      w[e] = pack2(q0, q1);
    }
    *(u32x4*)(QF + (r0 + row) * 1024 + h * 128 + cc) = (u32x4){w[0], w[1], w[2], w[3]};
  }
  if (tid < 128) DCY[(long)uu * 128 + tid] = __expf(sBc[63 * 132 + tid]);
  for (int idx = tid; idx < 4096; idx += 256) {
    const int t = idx >> 6, s = idx & 63;
    if ((s >> 4) > (t >> 4)) ABUF[(long)uu * 4096 + idx] = 0;
  }
  for (int ti = wave; ti < 10; ti += 4) {
    int i, j;
    if (ti == 0) { i = 0; j = 0; }
    else if (ti < 3) { i = 1; j = ti - 1; }
    else if (ti < 6) { i = 2; j = ti - 3; }
    else { i = 3; j = ti - 6; }
    f32x4 a4 = {0.f, 0.f, 0.f, 0.f};
    const int t = 16 * i + l15, s = 16 * j + l15;
#pragma unroll
    for (int ks = 0; ks < 4; ++ks) {
      const int dk0 = ks * 32 + G * 8;
      uint32_t aw[4], bw[4];
#pragma unroll
      for (int e2 = 0; e2 < 4; ++e2) {
        float av[2], bv[2];
#pragma unroll
        for (int z = 0; z < 2; ++z) {
          const int dk = dk0 + 2 * e2 + z;
          const float br = sBc[(16 * i) * 132 + dk];
          const float bt = sBc[t * 132 + dk];
          av[z] = bf2f(sQ[t * 136 + dk]) * __expf(bt - br);
          const float bs = sBc[s * 132 + dk];
          const float bp = (s > 0) ? sBc[(s - 1) * 132 + dk] : 0.f;
          const float kk = 1.f - __expf(bs - bp);
          bv[z] = kk * __expf(br - bs);
        }
        aw[e2] = pack2(av[0], av[1]);
        bw[e2] = pack2(bv[0], bv[1]);
      }
      a4 = MFMA(mk8(aw[0], aw[1], aw[2], aw[3]), mk8(bw[0], bw[1], bw[2], bw[3]), a4);
    }
#pragma unroll
    for (int e = 0; e < 4; ++e) {
      const int tr = 16 * i + G * 4 + e, sc = 16 * j + l15;
      const float v = (sc <= tr) ? a4[e] : 0.f;
      ABUF[(long)uu * 4096 + tr * 64 + sc] = f2bf(v);
    }
  }
  {
    f32x4 ua[8][2];
#pragma unroll
    for (int rt = 0; rt < 8; ++rt) { ua[rt][0] = (f32x4){0.f, 0.f, 0.f, 0.f}; ua[rt][1] = (f32x4){0.f, 0.f, 0.f, 0.f}; }
#pragma unroll
    for (int ks = 0; ks < 2; ++ks) {
      bf16x8 bfr[2];
#pragma unroll
      for (int ct = 0; ct < 2; ++ct) {
        const int dk = (2 * wave + ct) * 16 + l15;
        const float blast = sBc[63 * 132 + dk];
        const int s0 = ks * 32 + G * 8;
        float prev = (s0 > 0) ? sBc[(s0 - 1) * 132 + dk] : 0.f;
        uint32_t bw[4];
#pragma unroll
        for (int e2 = 0; e2 < 4; ++e2) {
          const float b0 = sBc[(s0 + 2 * e2) * 132 + dk];
          const float b1 = sBc[(s0 + 2 * e2 + 1) * 132 + dk];
          const float k0 = (1.f - __expf(b0 - prev)) * __expf(blast - b0);
          const float k1 = (1.f - __expf(b1 - b0)) * __expf(blast - b1);
          prev = b1;
          bw[e2] = pack2(k0, k1);
        }
        bfr[ct] = mk8(bw[0], bw[1], bw[2], bw[3]);
      }
#pragma unroll
      for (int rt = 0; rt < 8; ++rt) {
        const int dv = rt * 16 + l15;
        const bf16x8 af = ld8(HVT + ((long)uu * 128 + dv) * 64 + ks * 32 + G * 8);
        ua[rt][0] = MFMA(af, bfr[0], ua[rt][0]);
        ua[rt][1] = MFMA(af, bfr[1], ua[rt][1]);
      }
    }
    u16* sU = (u16*)smem;
    __syncthreads();
#pragma unroll
    for (int rt = 0; rt < 8; ++rt)
#pragma unroll
      for (int ct = 0; ct < 2; ++ct)
#pragma unroll
        for (int e = 0; e < 4; ++e) {
          const int dv = rt * 16 + G * 4 + e, dk = (2 * wave + ct) * 16 + l15;
          sU[dv * 136 + dk] = f2bf(ua[rt][ct][e]);
        }
    __syncthreads();
#pragma unroll 4
    for (int k8 = 0; k8 < 8; ++k8) {
      const int id = tid + 256 * k8;
      const int row = id >> 4, cch = (id & 15) * 8;
      *(u32x4*)(UST + ((long)uu * 128 + row) * 128 + cch) = *(const u32x4*)&sU[row * 136 + cch];
    }
  }
}

__device__ __forceinline__ void cmp_gemm1_tile(const Params& P, int t, char* smem) {
  char* ws = P.ws;
  u16* sA = (u16*)smem;
  u16* sB = sA + 128 * 80;
  EPI_VARS
  const int kv = t >> 5, rem = t & 31;
  const int mt = rem >> 1, nt = rem & 1;
  const int m0 = mt * 128, n0 = nt * 128;
  const u16* KV = (const u16*)(ws + OFF_KV);
  const u16* W1T = (const u16*)(ws + (kv ? OFF_WV1T : OFF_WK1T));
  u16* HID = (u16*)(ws + (kv ? OFF_HIDV : OFF_HIDK));
  const float* B1P = (const float*)(ws + OFF_BIAS1P) + kv * 2048;
  f32x4 acc[4][4];
  zero_acc(acc);
  gemm_tile<1, 2>(KV, 1024, m0, 2048, W1T, 2048, n0, 256, 2048, kv * 256, acc, sA, sB);
#pragma unroll
  for (int i = 0; i < 4; ++i)
#pragma unroll
    for (int j = 0; j < 4; ++j) {
      const int col = n0 + wn * 64 + 16 * j + l15;
      float bias = 0.f;
#pragma unroll
      for (int pp = 0; pp < 8; ++pp) bias += B1P[pp * 256 + col];
#pragma unroll
      for (int e = 0; e < 4; ++e) {
        const int row = m0 + wm * 64 + 16 * i + G * 4 + e;
        HID[(long)row * 256 + col] = f2bf(gelu_tanh(acc[i][j][e] + bias));
      }
    }
}

__device__ __forceinline__ void cmp_gemm2_tile(const Params& P, int t, char* smem) {
  char* ws = P.ws;
  u16* sA = (u16*)smem;
  u16* sB = sA + 128 * 80;
  EPI_VARS
  const int kv = t >> 4, mt = t & 15;
  const int m0 = mt * 128;
  const u16* HID = (const u16*)(ws + (kv ? OFF_HIDV : OFF_HIDK));
  const u16* W2T = (const u16*)(ws + (kv ? OFF_WV2T : OFF_WK2T));
  u16* KCMP = (u16*)(ws + OFF_KCMP);
  u16* VCMPT = (u16*)(ws + OFF_VCMPT);
  f32x4 acc[4][4];
  zero_acc(acc);
  gemm_tile<0, 1>(HID, 256, m0, 2048, W2T, 256, 0, 64, 256, 0, acc, sA, sB);
  if (wn == 0) {
#pragma unroll
    for (int i = 0; i < 4; ++i)
#pragma unroll
      for (int j = 0; j < 4; ++j) {
        const int col = 16 * j + l15;
        const int rbase = m0 + wm * 64 + 16 * i + G * 4;
        if (kv == 0) {
#pragma unroll
          for (int e = 0; e < 4; ++e) KCMP[(long)(rbase + e) * 64 + col] = f2bf(acc[i][j][e]);
        } else {
          const int grp = rbase >> 8, n = rbase & 255;
          u32x2 o2 = {pack2(acc[i][j][0], acc[i][j][1]), pack2(acc[i][j][2], acc[i][j][3])};
          *(u32x2*)(VCMPT + ((long)grp * 64 + col) * 256 + n) = o2;
        }
      }
  }
}

__device__ __forceinline__ void hgrn_scan(const Params& P) {
  char* ws = P.ws;
  u16* UST = (u16*)(ws + OFF_UST);
  const float* DCY = (const float*)(ws + OFF_DCY);
  for (int idx = bid_() * 256 + tid_(); idx < 131072; idx += gridDim.x * 256) {
    const int bh = idx >> 13, rem = idx & 8191;
    const int dv = rem >> 6, dk2 = (rem & 63) * 2;
    float s0 = 0.f, s1 = 0.f;
#pragma unroll 8
    for (int c = 0; c < 64; ++c) {
      const long uu = (long)bh * 64 + c;
      u16* ptr = UST + (uu * 128 + dv) * 128 + dk2;
      const uint32_t uv = *(const uint32_t*)ptr;
      const float2 d = *(const float2*)(DCY + uu * 128 + dk2);
      *(uint32_t*)ptr = pack2(s0, s1);
      s0 = d.x * s0 + __uint_as_float(uv << 16);
      s1 = d.y * s1 + __uint_as_float(uv & 0xffff0000u);
    }
  }
}

__device__ __forceinline__ void hgrn_out_unit(const Params& P, int half, int uu, char* smem) {
  char* ws = P.ws;
  const int tid = tid_(), lane = tid & 63, wave = tid >> 6;
  const int l15 = lane & 15, G = lane >> 4;
  float* sO = (float*)smem;
  const int bl = uu >> 9, h = (uu >> 6) & 7, c = uu & 63;
  const long r0 = (long)bl * 4096 + c * 64;
  const u16* QF = (const u16*)(ws + OFF_QF);
  const u16* HVT = (const u16*)(ws + OFF_HVT);
  const u16* ABUF = (const u16*)(ws + OFF_ABUF);
  const u16* UST = (const u16*)(ws + OFF_UST);
  u16* SG = (u16*)(ws + OFF_SG) + (long)half * 8192 * 1024;
  f32x4 acc[4][2];
#pragma unroll
  for (int i = 0; i < 4; ++i) { acc[i][0] = (f32x4){0.f, 0.f, 0.f, 0.f}; acc[i][1] = (f32x4){0.f, 0.f, 0.f, 0.f}; }
#pragma unroll
  for (int ks = 0; ks < 4; ++ks) {
    const int dk0 = ks * 32 + G * 8;
    bf16x8 bfr[2];
#pragma unroll
    for (int jt = 0; jt < 2; ++jt) bfr[jt] = ld8(UST + ((long)uu * 128 + 32 * wave + 16 * jt + l15) * 128 + dk0);
#pragma unroll
    for (int i = 0; i < 4; ++i) {
      const bf16x8 af = ld8(QF + (r0 + 16 * i + l15) * 1024 + h * 128 + dk0);
      acc[i][0] = MFMA(af, bfr[0], acc[i][0]);
      acc[i][1] = MFMA(af, bfr[1], acc[i][1]);
    }
  }
#pragma unroll
  for (int ks = 0; ks < 2; ++ks) {
    const int s0 = ks * 32 + G * 8;
    bf16x8 bfr[2];
#pragma unroll
    for (int jt = 0; jt < 2; ++jt) bfr[jt] = ld8(HVT + ((long)uu * 128 + 32 * wave + 16 * jt + l15) * 64 + s0);
#pragma unroll
    for (int i = 0; i < 4; ++i) {
      const bf16x8 af = ld8(ABUF + (long)uu * 4096 + (16 * i + l15) * 64 + s0);
      acc[i][0] = MFMA(af, bfr[0], acc[i][0]);
      acc[i][1] = MFMA(af, bfr[1], acc[i][1]);
    }
  }
  __syncthreads();
#pragma unroll
  for (int i = 0; i < 4; ++i)
#pragma unroll
    for (int jt = 0; jt < 2; ++jt)
#pragma unroll
      for (int e = 0; e < 4; ++e) sO[(16 * i + G * 4 + e) * 132 + 32 * wave + 16 * jt + l15] = acc[i][jt][e];
  __syncthreads();
  {
    const int row = tid >> 2, part = tid & 3;
    float ss = 0.f;
#pragma unroll
    for (int cc = 0; cc < 32; ++cc) { const float v = sO[row * 132 + part * 32 + cc]; ss += v * v; }
    ss += SHX(ss, 1);
    ss += SHX(ss, 2);
    const float r = rsqrtf(ss * (1.f / 128.f) + 1e-6f);
    u16* dst = SG + (r0 + row) * 1024 + h * 128 + part * 32;
#pragma unroll
    for (int q4 = 0; q4 < 4; ++q4) {
      const u32x4 sgv = *(const u32x4*)(dst + q4 * 8);
      uint32_t w[4];
#pragma unroll
      for (int e = 0; e < 4; ++e) {
        const int cc = q4 * 8 + 2 * e;
        const float g0 = __uint_as_float(sgv[e] << 16), g1 = __uint_as_float(sgv[e] & 0xffff0000u);
        const float y0 = sO[row * 132 + part * 32 + cc] * r * P.gnorm[part * 32 + cc] * g0;
        const float y1 = sO[row * 132 + part * 32 + cc + 1] * r * P.gnorm[part * 32 + cc + 1] * g1;
        w[e] = pack2(y0, y1);
      }
      *(u32x4*)(dst + q4 * 8) = (u32x4){w[0], w[1], w[2], w[3]};
    }
  }
}

__device__ __forceinline__ void stage_kv(u16* sK, u16* sV, const u16* kptr, long kstride, const u16* vptr, long vstride) {
  const int tid = tid_();
  __syncthreads();
#pragma unroll
  for (int i = 0; i < 2; ++i) {
    const int id = tid + 256 * i;
    const int row = id >> 3, ch = id & 7;
    *(u32x4*)&sK[row * 72 + ch * 8] = *(const u32x4*)(kptr + row * kstride + ch * 8);
    *(u32x4*)&sV[row * 72 + ch * 8] = *(const u32x4*)(vptr + row * vstride + ch * 8);
  }
  __syncthreads();
}

__device__ __forceinline__ void qk_scores(const u16* sK, const bf16x8 (&q)[2], f32x4 (&s)[4], int l15, int G) {
#pragma unroll
  for (int kt = 0; kt < 4; ++kt) {
    s[kt] = (f32x4){0.f, 0.f, 0.f, 0.f};
#pragma unroll
    for (int ks = 0; ks < 2; ++ks) s[kt] = MFMA(ld8(&sK[(16 * kt + l15) * 72 + ks * 32 + G * 8]), q[ks], s[kt]);
  }
}

__device__ __forceinline__ void pv_accum(const u16* sV, const f32x4 (&p)[4], f32x4 (&o)[4], int l15, int G) {
#pragma unroll
  for (int ks2 = 0; ks2 < 2; ++ks2) {
    const f32x4 pa = p[2 * ks2], pb = p[2 * ks2 + 1];
    const bf16x8 pf = mk8(pack2(pa[0], pa[1]), pack2(pa[2], pa[3]), pack2(pb[0], pb[1]), pack2(pb[2], pb[3]));
#pragma unroll
    for (int dt = 0; dt < 4; ++dt) {
      const u32x2 v0 = *(const u32x2*)&sV[(16 * dt + l15) * 72 + 32 * ks2 + 4 * G];
      const u32x2 v1 = *(const u32x2*)&sV[(16 * dt + l15) * 72 + 32 * ks2 + 16 + 4 * G];
      o[dt] = MFMA(mk8(v0[0], v0[1], v1[0], v1[1]), pf, o[dt]);
    }
  }
}

#define EX2(x) __builtin_amdgcn_exp2f(x)
typedef __attribute__((ext_vector_type(16))) float f32x16;
#define MFMA32(a, b, c) __builtin_amdgcn_mfma_f32_32x32x16_bf16((a), (b), (c), 0, 0, 0)
template <int MODE, bool EDGE>
__device__ __forceinline__ void nsa_block(const u16* sK, const u16* sV, int jb, int qb, int q, bool blk_ok,
                                          const bf16x8 (&qf)[4], f32x16 (&O)[2], float& m, float& l, int r31, int h) {
  const int lane = h * 32 + r31;
  f32x16 s[2];
#pragma unroll
  for (int kt2 = 0; kt2 < 2; ++kt2) {
#pragma unroll
    for (int e = 0; e < 16; ++e) s[kt2][e] = 0.f;
#pragma unroll
    for (int ks = 0; ks < 4; ++ks) s[kt2] = MFMA32(ld8(&sK[(32 * kt2 + r31) * 72 + 16 * ks + 8 * h]), qf[ks], s[kt2]);
  }
  float smax = -1e30f;
  if (EDGE) {
#pragma unroll
    for (int kt2 = 0; kt2 < 2; ++kt2)
#pragma unroll
      for (int e = 0; e < 16; ++e) {
        const int k = 32 * kt2 + (e & 3) + 8 * (e >> 2) + 4 * h;
        const bool a = blk_ok && ((jb == qb) ? (k <= q) : (k > q));
        if (!a) s[kt2][e] = -1e30f;
        smax = fmaxf(smax, s[kt2][e]);
      }
  } else {
#pragma unroll
    for (int kt2 = 0; kt2 < 2; ++kt2)
#pragma unroll
      for (int e = 0; e < 16; ++e) smax = fmaxf(smax, s[kt2][e]);
    if (MODE == 2 && !blk_ok) smax = -1e30f;
  }
  smax = fmaxf(smax, SHX(smax, 32));
  const float mn = fmaxf(m, smax);
  const bool need = (mn - m) > 8.f;
  if (__builtin_amdgcn_ballot_w64(need) != 0ull) {
    const float alpha = need ? EX2(m - mn) : 1.f;
    m = need ? mn : m;
    l *= alpha;
    O[0] *= alpha;
    O[1] *= alpha;
  }
  const float mref = (!EDGE && MODE == 2 && !blk_ok) ? 1e30f : m;
  float ls = 0.f;
#pragma unroll
  for (int kt2 = 0; kt2 < 2; ++kt2)
#pragma unroll
    for (int e = 0; e < 16; ++e) {
      const float sv = s[kt2][e];
      float pv;
      if (EDGE) pv = (sv > -1e29f) ? EX2(sv - m) : 0.f;
      else pv = EX2(sv - mref);
      s[kt2][e] = pv;
      ls += pv;
    }
  l += ls;
#pragma unroll
  for (int kt2 = 0; kt2 < 2; ++kt2)
#pragma unroll
    for (int st = 0; st < 2; ++st) {
      const bf16x8 pf = mk8(pack2(s[kt2][8 * st + 0], s[kt2][8 * st + 1]), pack2(s[kt2][8 * st + 2], s[kt2][8 * st + 3]),
                            pack2(s[kt2][8 * st + 4], s[kt2][8 * st + 5]), pack2(s[kt2][8 * st + 6], s[kt2][8 * st + 7]));
#pragma unroll
      for (int dt2 = 0; dt2 < 2; ++dt2) {
        const u16* vrow = &sV[(32 * dt2 + r31) * 72 + 32 * kt2 + 16 * st + 4 * h];
        const u32x2 v0 = *(const u32x2*)vrow;
        const u32x2 v1 = *(const u32x2*)(vrow + 8);
        O[dt2] = MFMA32(mk8(v0[0], v0[1], v1[0], v1[1]), pf, O[dt2]);
      }
    }
}

template <int MODE>
__device__ __forceinline__ void nsa_branch(const u16* kbase, const u16* vbase, int jb0, int jb1, int qb, int q,
                                           uint32_t mlo, uint32_t mhi, const bf16x8 (&qf)[4], const float* ngbase, int rowbase, int gidx,
                                           u16* sYl, u16* sm, float pscale = 1.f) {
  const int tid = tid_();
  const int lane = tid & 63;
  const int r31 = lane & 31, h = lane >> 5;
  const int srow = tid >> 3, sch = (tid & 7) * 8;
  f32x16 O[2];
#pragma unroll
  for (int e = 0; e < 16; ++e) { O[0][e] = 0.f; O[1][e] = 0.f; }
  float m = -1e30f, l = 0.f;
  u32x4 kr[2], vr[2];
  const unsigned koff = (unsigned)((srow * 1024 + sch) * 2);
  const unsigned voff = (unsigned)((srow * 4096 + sch) * 2);
  {
    const char* kb = (const char*)kbase + (size_t)jb0 * 131072;
    const char* vb = (const char*)vbase + (size_t)jb0 * 128;
#pragma unroll
    for (int i = 0; i < 2; ++i) {
      kr[i] = *(const u32x4*)(kb + (koff + i * 65536u));
      vr[i] = *(const u32x4*)(vb + (voff + i * 262144u));
    }
  }
  __syncthreads();
#pragma unroll
  for (int i = 0; i < 2; ++i) {
    *(u32x4*)&sm[(srow + 32 * i) * 72 + sch] = kr[i];
    *(u32x4*)&sm[4608 + (srow + 32 * i) * 72 + sch] = vr[i];
  }
  __syncthreads();
  int cur = 0;
  for (int jb = jb0; jb <= jb1; ++jb) {
    const bool more = jb < jb1;
    if (more) {
      const char* kb = (const char*)kbase + (size_t)(jb + 1) * 131072;
      const char* vb = (const char*)vbase + (size_t)(jb + 1) * 128;
#pragma unroll
      for (int i = 0; i < 2; ++i) {
        kr[i] = *(const u32x4*)(kb + (koff + i * 65536u));
        vr[i] = *(const u32x4*)(vb + (voff + i * 262144u));
      }
    }
    const u16* sK = sm + cur * 9216;
    const u16* sV = sK + 4608;
    bool blk_ok = true;
    if (MODE == 2) blk_ok = (jb < 32) ? ((mlo >> jb) & 1u) : ((mhi >> (jb - 32)) & 1u);
    const bool edge = (jb == qb) || (MODE == 3 && jb == qb - 8);
    if (edge) nsa_block<MODE, true>(sK, sV, jb, qb, q, blk_ok, qf, O, m, l, r31, h);
    else nsa_block<MODE, false>(sK, sV, jb, qb, q, blk_ok, qf, O, m, l, r31, h);
    if (more) {
      u16* dK = sm + (cur ^ 1) * 9216;
#pragma unroll
      for (int i = 0; i < 2; ++i) {
        *(u32x4*)&dK[(srow + 32 * i) * 72 + sch] = kr[i];
        *(u32x4*)&dK[4608 + (srow + 32 * i) * 72 + sch] = vr[i];
      }
    }
    __syncthreads();
    cur ^= 1;
  }
  const int tg = tid_();
  const int lg = tg & 63, hh = (lg >> 4) & 1, hg = lg >> 5;
  const float* gatep = (const float*)((const char*)ngbase + (unsigned)(rowbase + 16 * (tg >> 6) + (tg & 15)) * 192u) + gidx + hh;
  float lt = l;
  lt += shx_f(lt, lg ^ 32);
  const float sc = (lt > 0.f) ? (pscale * gatep[0] / lt) : 0.f;
  u16* yrow = sYl + (((tg >> 6) * 2 + hh) * 16 + (tg & 15)) * 64;
#pragma unroll
  for (int dt2 = 0; dt2 < 2; ++dt2)
#pragma unroll
    for (int m4 = 0; m4 < 4; ++m4) {
      u32x2* yp = (u32x2*)(yrow + 32 * dt2 + 8 * m4 + 4 * hg);
      const u32x2 yv = *yp;
      const float y0 = __uint_as_float(yv[0] << 16) + O[dt2][4 * m4 + 0] * sc;
      const float y1 = __uint_as_float(yv[0] & 0xffff0000u) + O[dt2][4 * m4 + 1] * sc;
      const float y2 = __uint_as_float(yv[1] << 16) + O[dt2][4 * m4 + 2] * sc;
      const float y3 = __uint_as_float(yv[1] & 0xffff0000u) + O[dt2][4 * m4 + 3] * sc;
      *yp = (u32x2){pack2(y0, y1), pack2(y2, y3)};
    }
}

__device__ __forceinline__ void pv_cmp(const u16* vc, int jb, const f32x4 (&p)[4], f32x4 (&o)[4], int l15, int G) {
#pragma unroll
  for (int ks2 = 0; ks2 < 2; ++ks2) {
    const f32x4 pa = p[2 * ks2], pb = p[2 * ks2 + 1];
    const bf16x8 pf = mk8(pack2(pa[0], pa[1]), pack2(pa[2], pa[3]), pack2(pb[0], pb[1]), pack2(pb[2], pb[3]));
#pragma unroll
    for (int dt = 0; dt < 4; ++dt) {
      const u16* vp = vc + (long)(16 * dt + l15) * 256 + jb * 64 + 32 * ks2 + 4 * G;
      const u32x2 v0 = *(const u32x2*)vp;
      const u32x2 v1 = *(const u32x2*)(vp + 16);
      o[dt] = MFMA(mk8(v0[0], v0[1], v1[0], v1[1]), pf, o[dt]);
    }
  }
}

__device__ __forceinline__ void nsa_unit(const Params& P, int half, int u, char* smem) {
  char* ws = P.ws;
  const int tid = tid_(), lane = tid & 63, wave = tid >> 6;
  const int l15 = lane & 15, G = lane >> 4;
  const int hp = u >> 9, rest = u & 511;
  const int bl = rest >> 8, g = (rest >> 6) & 3, xq = rest & 63;
  const int qb = hp ? xq : 63 - xq;
  const int q = 16 * wave + l15;
  const int t = qb * 64 + q;
  const int rl = bl * 4096 + t;
  const int rg = half * 8192 + rl;
  const char* NQc = (const char*)(ws + OFF_NQ);
  const unsigned qoff = (unsigned)rg * 2048u;
  u16* sm = (u16*)smem;
  float* sImp = (float*)smem;
  const u16* NQ = (const u16*)(ws + OFF_NQ);
  const u16* NQR = (const u16*)(ws + OFF_NQR);
  const u16* KV = (const u16*)(ws + OFF_KV);
  const u16* VST = (const u16*)(ws + OFF_VST);
  const u16* VWT = (const u16*)(ws + OFF_VWT);
  const u16* KCMP = (const u16*)(ws + OFF_KCMP);
  const u16* VCMPT = (const u16*)(ws + OFF_VCMPT);
  const float* NGATE = (const float*)((const char*)(ws + OFF_NGATE) + (unsigned)rg * 192u);
  u16* YB = (u16*)(ws + (half ? OFF_YB1 : OFF_YB0));

  f32x4 Y[2][4];
#pragma unroll
  for (int rr = 0; rr < 2; ++rr)
#pragma unroll
    for (int dt = 0; dt < 4; ++dt) Y[rr][dt] = (f32x4){0.f, 0.f, 0.f, 0.f};

  uint32_t mlo = 0, mhi = 0;
  u16* sYl = (u16*)(smem + 36864);
  {
    const int nblk = ((4 * qb + 2) >> 6) + 1;
    const u16* kc = KCMP + (long)(bl * 4 + g) * 256 * 64;
    const u16* vc = VCMPT + (long)(bl * 4 + g) * 64 * 256;
    float imp[4][4];
#pragma unroll
    for (int a = 0; a < 4; ++a)
#pragma unroll
      for (int b = 0; b < 4; ++b) imp[a][b] = 0.f;
    __syncthreads();
    for (int id = tid; id < nblk * 512; id += 256) {
      const int row = id >> 3, chn = (id & 7) * 8;
      *(u32x4*)&sm[row * 72 + chn] = *(const u32x4*)(kc + row * 64 + chn);
    }
    __syncthreads();
#pragma unroll 1
    for (int r = 0; r < 4; ++r) {
      bf16x8 qp[2];
#pragma unroll
      for (int ks = 0; ks < 2; ++ks) qp[ks] = *(const bf16x8*)(NQc + (qoff + (unsigned)(((4 * g + r) * 64 + ks * 32 + G * 8) * 2)));
      f32x4 s[4][4];
      float smax = -1e30f;
#pragma unroll
      for (int jb = 0; jb < 4; ++jb) {
#pragma unroll
        for (int kt = 0; kt < 4; ++kt) s[jb][kt] = (f32x4){-1e30f, -1e30f, -1e30f, -1e30f};
        if (jb < nblk) {
#pragma unroll
          for (int kt = 0; kt < 4; ++kt) {
            f32x4 a4 = {0.f, 0.f, 0.f, 0.f};
#pragma unroll
            for (int ks = 0; ks < 2; ++ks)
              a4 = MFMA(ld8(&sm[(jb * 64 + 16 * kt + l15) * 72 + ks * 32 + G * 8]), qp[ks], a4);
#pragma unroll
            for (int e = 0; e < 4; ++e) {
              const int n = jb * 64 + 16 * kt + 4 * G + e;
              const float sv = (16 * n + 31 <= t) ? a4[e] : -1e30f;
              s[jb][kt][e] = sv;
              smax = fmaxf(smax, sv);
            }
          }
        }
      }
      smax = fmaxf(smax, SHX(smax, 16));
      smax = fmaxf(smax, SHX(smax, 32));
      float l = 0.f;
#pragma unroll
      for (int jb = 0; jb < 4; ++jb) {
        if (jb < nblk) {
#pragma unroll
          for (int kt = 0; kt < 4; ++kt)
#pragma unroll
            for (int e = 0; e < 4; ++e) {
              const float sv = s[jb][kt][e];
              const float pv = (sv > -1e29f) ? EX2(sv - smax) : 0.f;
              s[jb][kt][e] = pv;
              l += pv;
            }
        }
      }
      l += SHX(l, 16);
      l += SHX(l, 32);
      const float invl = (l > 0.f) ? 1.f / l : 0.f;
      float prevup = 0.f;
#pragma unroll
      for (int jb = 0; jb < 4; ++jb) {
        if (jb < nblk) {
#pragma unroll
          for (int kt = 0; kt < 4; ++kt) {
            s[jb][kt] *= invl;
            const float sum4 = (s[jb][kt][0] + s[jb][kt][1]) + (s[jb][kt][2] + s[jb][kt][3]);
            const float upv = shx_f(s[jb][kt][3], (lane + 48) & 63);
            const float add = (G > 0) ? upv : prevup;
            imp[jb][kt] += sum4 + add;
            prevup = upv;
          }
          if (r == 2 * hp) pv_cmp(vc, jb, s[jb], Y[0], l15, G);
          else if (r == 2 * hp + 1) pv_cmp(vc, jb, s[jb], Y[1], l15, G);
        }
      }
    }
    {
      const float g0 = NGATE[0 * 16 + 4 * g + 2 * hp], g1 = NGATE[0 * 16 + 4 * g + 2 * hp + 1];
#pragma unroll
      for (int dt = 0; dt < 4; ++dt) {
        *(u32x2*)(sYl + ((wave * 2 + 0) * 16 + l15) * 64 + 16 * dt + 4 * G) = (u32x2){pack2(Y[0][dt][0] * g0, Y[0][dt][1] * g0), pack2(Y[0][dt][2] * g0, Y[0][dt][3] * g0)};
        *(u32x2*)(sYl + ((wave * 2 + 1) * 16 + l15) * 64 + 16 * dt + 4 * G) = (u32x2){pack2(Y[1][dt][0] * g1, Y[1][dt][1] * g1), pack2(Y[1][dt][2] * g1, Y[1][dt][3] * g1)};
      }
    }
    __syncthreads();
    unsigned long long* myKey = (unsigned long long*)sImp + wave * 16 * 65;
    unsigned long long vk[4][4];
#pragma unroll
    for (int jb = 0; jb < 4; ++jb)
#pragma unroll
      for (int kt = 0; kt < 4; ++kt) {
        const int s = 16 * jb + 4 * kt + G;
        vk[jb][kt] = ((unsigned long long)__float_as_uint(imp[jb][kt]) << 6) | (unsigned long long)(63 - s);
        myKey[l15 * 65 + s] = vk[jb][kt];
      }
    __syncthreads();
    const int cur = qb;
    uint32_t blo = 0, bhi = 0;
    if (cur + 1 <= 16) {
#pragma unroll
      for (int jb = 0; jb < 4; ++jb)
#pragma unroll
        for (int kt = 0; kt < 4; ++kt) {
          const int s = 16 * jb + 4 * kt + G;
          if (s <= cur) blo |= (1u << s);
        }
    } else {
      int cnt[4][4];
#pragma unroll
      for (int a = 0; a < 4; ++a)
#pragma unroll
        for (int b = 0; b < 4; ++b) cnt[a][b] = 0;
      for (int sp = 1; sp <= cur - 2; ++sp) {
        const unsigned long long xk = myKey[l15 * 65 + sp];
#pragma unroll
        for (int jb = 0; jb < 4; ++jb)
#pragma unroll
          for (int kt = 0; kt < 4; ++kt) cnt[jb][kt] += (xk > vk[jb][kt]) ? 1 : 0;
      }
#pragma unroll
      for (int jb = 0; jb < 4; ++jb)
#pragma unroll
        for (int kt = 0; kt < 4; ++kt) {
          const int s = 16 * jb + 4 * kt + G;
          const bool sel = (s == 0) || (s == cur) || (s == cur - 1) || (s >= 1 && s <= cur - 2 && cnt[jb][kt] < 13);
          if (sel) { if (s < 32) blo |= (1u << s); else bhi |= (1u << (s - 32)); }
        }
    }
    blo |= SHXU(blo, 16); blo |= SHXU(blo, 32);
    bhi |= SHXU(bhi, 16); bhi |= SHXU(bhi, 32);
    mlo = blo; mhi = bhi;
  }
  {
    const int hh = (lane >> 4) & 1, h5 = lane >> 5;
    const int head = 4 * g + 2 * hp + hh;
    bf16x8 qf[4];
    qf[0] = *(const bf16x8*)((const char*)NQR + ((unsigned)rl * 512u + (unsigned)((head * 16 + 8 * h5) * 2)));
#pragma unroll
    for (int ks = 1; ks < 4; ++ks) qf[ks] = *(const bf16x8*)(NQc + (qoff + (unsigned)((head * 64 + 16 * ks + 8 * h5) * 2)));
    const int head0 = 4 * g + 2 * hp;
    const u16* kbs = KV + (long)bl * 4096 * 1024 + 512 + g * 64;
    const u16* vbs = VST + (long)(bl * 4 + g) * 64 * 4096;
    nsa_branch<2>(kbs, vbs, 0, qb, qb, q, mlo, mhi, qf, (const float*)(ws + OFF_NGATE), half * 8192 + bl * 4096 + qb * 64, 16 + head0, sYl, sm);
    const u16* kbw = KV + (long)bl * 4096 * 1024 + 768 + g * 64;
    const u16* vbw = VWT + (long)(bl * 4 + g) * 64 * 4096;
    const int jw0 = (qb >= 8) ? qb - 8 : 0;
    nsa_branch<3>(kbw, vbw, jw0, qb, qb, q, mlo, mhi, qf, (const float*)(ws + OFF_NGATE), half * 8192 + bl * 4096 + qb * 64, 32 + head0, sYl, sm);
    const int tid2 = tid_();
    const int l2 = tid2 & 63, hh2 = (l2 >> 4) & 1, hg2 = l2 >> 5;
    const unsigned yoff = (unsigned)(bl * 4096 + qb * 64 + 16 * (tid2 >> 6) + (tid2 & 15)) * 2048u;
    const u16* yrow = sYl + (((tid2 >> 6) * 2 + hh2) * 16 + (tid2 & 15)) * 64;
#pragma unroll
    for (int dt2 = 0; dt2 < 2; ++dt2)
#pragma unroll
      for (int m4 = 0; m4 < 4; ++m4) {
        const int d0 = 32 * dt2 + 8 * m4 + 4 * hg2;
        *(u32x2*)((char*)YB + (yoff + (unsigned)(((head0 + hh2) * 64 + d0) * 2))) = *(const u32x2*)(yrow + d0);
      }
  }
}

__device__ __forceinline__ void gemm_tile_wide(const u16* __restrict__ A, long lda, int m0, const u16* __restrict__ Bt, long ldb, int n0, int K,
                                               f32x4 (&acc)[4][8], u16* sA) {
  const int tid = tid_(), lane = tid & 63, wave = tid >> 6;
  const int l15 = lane & 15, G = lane >> 4;
  const int wm = wave >> 1, wn = wave & 1;
  const int lr = tid >> 3, ch = tid & 7;
  u16* sB = sA + 128 * 80;
  const char* Ab = (const char*)A;
  const char* Bb = (const char*)Bt;
  unsigned oa[4], ob[8];
#pragma unroll
  for (int i = 0; i < 4; ++i) oa[i] = (unsigned)(((long)(m0 + lr + 32 * i) * lda + ch * 8) * 2);
#pragma unroll
  for (int i = 0; i < 8; ++i) ob[i] = (unsigned)(((long)(n0 + lr + 32 * i) * ldb + ch * 8) * 2);
  u32x4 ra[4], rb[8];
#pragma unroll
  for (int i = 0; i < 4; ++i) ra[i] = *(const u32x4*)(Ab + oa[i]);
#pragma unroll
  for (int i = 0; i < 8; ++i) rb[i] = *(const u32x4*)(Bb + ob[i]);
  const int nk = K >> 6;
  for (int kt = 0; kt < nk; ++kt) {
#pragma unroll
    for (int i = 0; i < 4; ++i) *(u32x4*)&sA[(lr + 32 * i) * 80 + ch * 8] = ra[i];
#pragma unroll
    for (int i = 0; i < 8; ++i) *(u32x4*)&sB[(lr + 32 * i) * 80 + ch * 8] = rb[i];
    __syncthreads();
    {
      const int kn = (kt + 1 < nk) ? kt + 1 : kt;
      const char* Ak = Ab + (size_t)kn * 128;
      const char* Bk = Bb + (size_t)kn * 128;
#pragma unroll
      for (int i = 0; i < 4; ++i) ra[i] = *(const u32x4*)(Ak + oa[i]);
#pragma unroll
      for (int i = 0; i < 8; ++i) rb[i] = *(const u32x4*)(Bk + ob[i]);
    }
#pragma unroll
    for (int ks = 0; ks < 2; ++ks) {
      bf16x8 af[4];
#pragma unroll
      for (int i = 0; i < 4; ++i) af[i] = ld8(&sA[(wm * 64 + 16 * i + l15) * 80 + ks * 32 + G * 8]);
#pragma unroll
      for (int jh = 0; jh < 2; ++jh) {
        bf16x8 bfr[4];
#pragma unroll
        for (int j = 0; j < 4; ++j) bfr[j] = ld8(&sB[(wn * 128 + 64 * jh + 16 * j + l15) * 80 + ks * 32 + G * 8]);
#pragma unroll
        for (int i = 0; i < 4; ++i)
#pragma unroll
          for (int j = 0; j < 4; ++j) acc[i][4 * jh + j] = MFMA(af[i], bfr[j], acc[i][4 * jh + j]);
      }
    }
    __syncthreads();
  }
}


__device__ __forceinline__ void phase_branch_merge(const Params& P, char* smem) {
  char* ws = P.ws;
  u16* sA = (u16*)smem;
  const u16* YA = (const u16*)(ws + OFF_SG);
  const u16* GATES = (const u16*)P.out;
  u16* MERGED = (u16*)(ws + OFF_MERGED);
  for (int t = bid_(); t < 512; t += gridDim.x) {
    const int nt = t >> 7, mt = t & 127;
    const int m0 = mt * 128, n0 = nt * 256;
    const u16* YBp = (m0 < 8192) ? (const u16*)(ws + OFF_YB0) : ((const u16*)(ws + OFF_YB1) - (long)8192 * 1024);
    f32x4 acc[4][8];
#pragma unroll
    for (int i = 0; i < 4; ++i)
#pragma unroll
      for (int j = 0; j < 8; ++j) acc[i][j] = (f32x4){0.f, 0.f, 0.f, 0.f};
    gemm_tile_wide(YA, 1024, m0, (const u16*)(ws + OFF_WA_T), 1024, n0, 1024, acc, sA);
    {
      const int tc = tid_();
#pragma unroll 4
      for (int k16 = 0; k16 < 16; ++k16) {
        const int id = tc + 256 * k16;
        const int row = id >> 5, cch = (id & 31) * 8;
        *(u32x4*)&sA[row * 264 + cch] = *(const u32x4*)(GATES + (long)(m0 + row) * 2048 + n0 + cch);
      }
    }
    __syncthreads();
    {
      EPI_VARS
#pragma unroll
      for (int i = 0; i < 4; ++i)
#pragma unroll
        for (int j = 0; j < 8; ++j)
#pragma unroll
          for (int e = 0; e < 4; ++e) {
            u16* sp = &sA[(wm * 64 + 16 * i + G * 4 + e) * 264 + wn * 128 + 16 * j + l15];
            *sp = f2bf(bf2f(*sp) * acc[i][j][e]);
            acc[i][j][e] = 0.f;
          }
    }
    __syncthreads();
    {
      const int tc = tid_();
#pragma unroll 4
      for (int k16 = 0; k16 < 16; ++k16) {
        const int id = tc + 256 * k16;
        const int row = id >> 5, cch = (id & 31) * 8;
        *(u32x4*)(MERGED + (long)(m0 + row) * 1024 + n0 + cch) = *(const u32x4*)&sA[row * 264 + cch];
      }
    }
    asm volatile("s_waitcnt vmcnt(0)" ::: "memory");
    __syncthreads();
    gemm_tile_wide(YBp, 1024, m0, (const u16*)(ws + OFF_WB_T), 1024, n0, 1024, acc, sA);
    {
      const int tc = tid_();
#pragma unroll 4
      for (int k16 = 0; k16 < 16; ++k16) {
        const int id = tc + 256 * k16;
        const int row = id >> 5, cch = (id & 31) * 8;
        *(u32x4*)&sA[row * 264 + cch] = *(const u32x4*)(GATES + (long)(m0 + row) * 2048 + 1024 + n0 + cch);
      }
    }
    __syncthreads();
    {
      EPI_VARS
#pragma unroll
      for (int i = 0; i < 4; ++i)
#pragma unroll
        for (int j = 0; j < 8; ++j)
#pragma unroll
          for (int e = 0; e < 4; ++e) {
            u16* sp = &sA[(wm * 64 + 16 * i + G * 4 + e) * 264 + wn * 128 + 16 * j + l15];
            *sp = f2bf(bf2f(*sp) * acc[i][j][e]);
          }
    }
    __syncthreads();
    {
      const int tc = tid_();
#pragma unroll 2
      for (int k16 = 0; k16 < 16; ++k16) {
        const int id = tc + 256 * k16;
        const int row = id >> 5, cch = (id & 31) * 8;
        u16* gp = MERGED + (long)(m0 + row) * 1024 + n0 + cch;
        const u32x4 t1 = *(const u32x4*)gp;
        const u32x4 pb = *(const u32x4*)&sA[row * 264 + cch];
        u32x4 o;
#pragma unroll
        for (int q = 0; q < 4; ++q) {
          const float lo = __uint_as_float(t1[q] << 16) + __uint_as_float(pb[q] << 16);
          const float hi = __uint_as_float(t1[q] & 0xffff0000u) + __uint_as_float(pb[q] & 0xffff0000u);
          o[q] = pack2(lo, hi);
        }
        *(u32x4*)gp = o;
      }
    }
    __syncthreads();
  }
}

template <int EPI>
__device__ __forceinline__ void phase_gemm(const u16* A, int K, const u16* Wt, int N, void* outp, char* smem) {
  u16* sA = (u16*)smem;
  u16* sB = sA + 128 * 80;
  EPI_VARS
  const int ntn = N >> 7;
  for (int t = bid_(); t < 128 * ntn; t += gridDim.x) {
    const int nt = t >> 7, mt = t & 127;
    const int m0 = mt * 128, n0 = nt * 128;
    f32x4 acc[4][4];
    zero_acc(acc);
    gemm_tile<0, 2>(A, K, m0, 16384, Wt, K, n0, N, K, 0, acc, sA, sB);
#pragma unroll
    for (int i = 0; i < 4; ++i)
#pragma unroll
      for (int j = 0; j < 4; ++j) {
        const int col = n0 + wn * 64 + 16 * j + l15;
#pragma unroll
        for (int e = 0; e < 4; ++e) {
          const long row = m0 + wm * 64 + 16 * i + G * 4 + e;
          const float v = acc[i][j][e];
          if (EPI == 0) ((float*)outp)[row * N + col] = v;
          else if (EPI == 2) ((u16*)outp)[row * N + col] = f2bf(v);
          else { const float rl = fmaxf(v, 0.f); ((u16*)outp)[row * N + col] = f2bf(rl * rl); }
        }
      }
  }
}


template <int EPI>
__device__ __forceinline__ void phase_gemm_wide(const u16* A, int K, const u16* Wt, int N, u16* outp, char* smem) {
  u16* sA = (u16*)smem;
  EPI_VARS
  const int ntn = N >> 8;
  for (int t = bid_(); t < 128 * ntn; t += gridDim.x) {
    const int nt = t >> 7, mt = t & 127;
    const int m0 = mt * 128, n0 = nt * 256;
    f32x4 acc[4][8];
#pragma unroll
    for (int i = 0; i < 4; ++i)
#pragma unroll
      for (int j = 0; j < 8; ++j) acc[i][j] = (f32x4){0.f, 0.f, 0.f, 0.f};
    gemm_tile_wide(A, K, m0, Wt, K, n0, K, acc, sA);
#pragma unroll
    for (int i = 0; i < 4; ++i)
#pragma unroll
      for (int j = 0; j < 8; ++j) {
        const int col = n0 + wn * 128 + 16 * j + l15;
#pragma unroll
        for (int e = 0; e < 4; ++e) {
          float v = acc[i][j][e];
          if (EPI == 1) { v = fmaxf(v, 0.f); v = v * v; }
          sA[(wm * 64 + 16 * i + G * 4 + e) * 264 + (col - n0)] = f2bf(v);
        }
      }
    __syncthreads();
    {
      const int tc = tid_();
#pragma unroll 4
      for (int k16 = 0; k16 < 16; ++k16) {
        const int id = tc + 256 * k16;
        const int row = id >> 5, cch = (id & 31) * 8;
        *(u32x4*)(outp + (long)(m0 + row) * N + n0 + cch) = *(const u32x4*)&sA[row * 264 + cch];
      }
    }
    __syncthreads();
  }
}

__device__ __forceinline__ void phase_ple(const Params& P, char* smem) {
  char* ws = P.ws;
  u16* sA = (u16*)smem;
  u16* Z3b = (u16*)(ws + OFF_Z3);
  for (int t = bid_(); t < 512; t += gridDim.x) {
    const int nt = t >> 7, mt = t & 127;
    const int m0 = mt * 128, n0 = nt * 256;
    f32x4 acc[4][8];
#pragma unroll
    for (int i = 0; i < 4; ++i)
#pragma unroll
      for (int j = 0; j < 8; ++j) acc[i][j] = (f32x4){0.f, 0.f, 0.f, 0.f};
    gemm_tile_wide((const u16*)(ws + OFF_PB), 256, m0, (const u16*)(ws + OFF_WPLE_T), 256, n0, 256, acc, sA);
    {
      EPI_VARS
#pragma unroll
      for (int i = 0; i < 4; ++i)
#pragma unroll
        for (int j = 0; j < 8; ++j)
#pragma unroll
          for (int e = 0; e < 4; ++e) {
            sA[(wm * 64 + 16 * i + G * 4 + e) * 264 + wn * 128 + 16 * j + l15] = f2bf(acc[i][j][e]);
            acc[i][j][e] = 0.f;
          }
    }
    __syncthreads();
    {
      const int tc = tid_();
#pragma unroll 4
      for (int k16 = 0; k16 < 16; ++k16) {
        const int id = tc + 256 * k16;
        const int row = id >> 5, cch = (id & 31) * 8;
        *(u32x4*)(Z3b + (long)(m0 + row) * 1024 + n0 + cch) = *(const u32x4*)&sA[row * 264 + cch];
      }
    }
    asm volatile("s_waitcnt vmcnt(0)" ::: "memory");
    __syncthreads();
    gemm_tile_wide((const u16*)(ws + OFF_H2B), 1024, m0, (const u16*)(ws + OFF_WPG_T), 1024, n0, 1024, acc, sA);
    {
      const int tc = tid_();
#pragma unroll 4
      for (int k16 = 0; k16 < 16; ++k16) {
        const int id = tc + 256 * k16;
        const int row = id >> 5, cch = (id & 31) * 8;
        *(u32x4*)&sA[row * 264 + cch] = *(const u32x4*)(Z3b + (long)(m0 + row) * 1024 + n0 + cch);
      }
    }
    __syncthreads();
    {
      EPI_VARS
#pragma unroll
      for (int i = 0; i < 4; ++i)
#pragma unroll
        for (int j = 0; j < 8; ++j)
#pragma unroll
          for (int e = 0; e < 4; ++e) {
            u16* sp = &sA[(wm * 64 + 16 * i + G * 4 + e) * 264 + wn * 128 + 16 * j + l15];
            *sp = f2bf(bf2f(*sp) * sigm(acc[i][j][e]));
          }
    }
    __syncthreads();
    {
      const int tc = tid_();
#pragma unroll 4
      for (int k16 = 0; k16 < 16; ++k16) {
        const int id = tc + 256 * k16;
        const int row = id >> 5, cch = (id & 31) * 8;
        *(u32x4*)(Z3b + (long)(m0 + row) * 1024 + n0 + cch) = *(const u32x4*)&sA[row * 264 + cch];
      }
    }
    __syncthreads();
  }
}

template <int MODE, int ZB>
__device__ __forceinline__ void phase_rownorm(const Params& P, const void* Zv, const float* w, const float* w2, u16* nxt) {
  const int tid = tid_(), lane = tid & 63, wave = tid >> 6;
  float* H = P.out;
  for (int un = bid_(); un < 4096; un += gridDim.x) {
    const long row = (long)un * 4 + wave;
    const float* zr = (const float*)Zv + row * 1024;
    const u16* zh = (const u16*)Zv + row * 1024;
    (void)zr; (void)zh;
    const float* hin = (MODE == 0) ? (P.x + row * 1024) : (H + row * 1024);
    float4 z[4], hv[4];
    float ss = 0.f;
#pragma unroll
    for (int j = 0; j < 4; ++j) {
      if (ZB) {
        const u32x2 zz = *(const u32x2*)(zh + j * 256 + lane * 4);
        z[j] = make_float4(__uint_as_float(zz[0] << 16), __uint_as_float(zz[0] & 0xffff0000u), __uint_as_float(zz[1] << 16), __uint_as_float(zz[1] & 0xffff0000u));
      } else z[j] = *(const float4*)(zr + j * 256 + lane * 4);
      hv[j] = *(const float4*)(hin + j * 256 + lane * 4);
      ss += z[j].x * z[j].x + z[j].y * z[j].y + z[j].z * z[j].z + z[j].w * z[j].w;
    }
#pragma unroll
    for (int o = 32; o >= 1; o >>= 1) ss += SHX(ss, o);
    const float r = rsqrtf(ss * (1.f / 1024.f) + 1e-6f);
    float s2 = 0.f;
#pragma unroll
    for (int j = 0; j < 4; ++j) {
      const float4 wv = *(const float4*)(w + j * 256 + lane * 4);
      hv[j].x += z[j].x * r * wv.x; hv[j].y += z[j].y * r * wv.y;
      hv[j].z += z[j].z * r * wv.z; hv[j].w += z[j].w * r * wv.w;
      s2 += hv[j].x * hv[j].x + hv[j].y * hv[j].y + hv[j].z * hv[j].z + hv[j].w * hv[j].w;
      *(float4*)(H + row * 1024 + j * 256 + lane * 4) = hv[j];
    }
    if (MODE == 0) {
#pragma unroll
      for (int o = 32; o >= 1; o >>= 1) s2 += SHX(s2, o);
      const float r2 = rsqrtf(s2 * (1.f / 1024.f) + 1e-6f);
#pragma unroll
      for (int j = 0; j < 4; ++j) {
        const float4 wv = *(const float4*)(w2 + j * 256 + lane * 4);
        u32x2 o2 = {pack2(hv[j].x * r2 * wv.x, hv[j].y * r2 * wv.y), pack2(hv[j].z * r2 * wv.z, hv[j].w * r2 * wv.w)};
        *(u32x2*)(nxt + row * 1024 + j * 256 + lane * 4) = o2;
      }
    } else if (MODE == 1) {
#pragma unroll
      for (int j = 0; j < 4; ++j) {
        u32x2 o2 = {pack2(hv[j].x, hv[j].y), pack2(hv[j].z, hv[j].w)};
        *(u32x2*)(nxt + row * 1024 + j * 256 + lane * 4) = o2;
      }
      const float4 pv = *(const float4*)(P.p + row * 256 + lane * 4);
      u32x2 o2 = {pack2(pv.x, pv.y), pack2(pv.z, pv.w)};
      *(u32x2*)((u16*)(P.ws + OFF_PB) + row * 256 + lane * 4) = o2;
    }
  }
}

#define XB_TMO      128
#define XB_XCNT(j)  (256  + 64 * (j))
#define XB_XSUB(j)  (1280 + 64 * (j))
#define XB_XGEN(j)  (2304 + 64 * (j))
#define XB_TOP      3328
#define XB_TOPGEN   3392
#define XCD_BAR_WORDS 3456
#define XB_SPIN_CAP (1u << 18)
#define LAS __attribute__((address_space(3)))

__device__ __forceinline__ unsigned xb_ld(unsigned* p)              { return __hip_atomic_load(p, __ATOMIC_RELAXED, __HIP_MEMORY_SCOPE_AGENT); }
__device__ __forceinline__ unsigned xb_add(unsigned* p, unsigned v) { return __hip_atomic_fetch_add(p, v, __ATOMIC_RELAXED, __HIP_MEMORY_SCOPE_AGENT); }
__device__ __forceinline__ unsigned xb_xcc_id() { return (unsigned)__builtin_amdgcn_s_getreg((3 << 11) | 20) & 0xFu; }
#define XB_SPIN(cond, bar) do { unsigned _sp = 0; while (cond) { __builtin_amdgcn_s_sleep(1); \
    if ((++_sp & 255u) == 0u) { if (xb_ld(&(bar)[XB_TMO])) break; if (_sp > XB_SPIN_CAP) { atomicAdd(&(bar)[XB_TMO], 1u); break; } } } } while (0)

struct XcdBarrier {
    unsigned* bar; unsigned x;
    volatile LAS unsigned* st;
};

__device__ __forceinline__ XcdBarrier xcd_barrier_post(unsigned* bar, volatile LAS unsigned* st) {
    XcdBarrier b; b.bar = bar; b.x = xb_xcc_id(); b.st = st;
    if (tid_() == 0) (void)xb_add(&bar[XB_XCNT(b.x)], 1u);
    return b;
}
__device__ __forceinline__ void xcd_barrier_complete(unsigned* bar, unsigned x, unsigned& nloc, unsigned& nx) {
    const unsigned G = gridDim.x * gridDim.y * gridDim.z;
    unsigned sum, cnt, mine, sp = 0u;
    for (;;) {
        sum = 0u; cnt = 0u; mine = 0u;
#pragma unroll
        for (unsigned j = 0; j < 16; ++j) { const unsigned c = xb_ld(&bar[XB_XCNT(j)]); sum += c; cnt += (c > 0u) ? 1u : 0u; mine = (j == x) ? c : mine; }
        if (sum == G) break;
        __builtin_amdgcn_s_sleep(1);
        if ((++sp & 255u) == 0u) { if (xb_ld(&bar[XB_TMO])) break; if (sp > XB_SPIN_CAP) { atomicAdd(&bar[XB_TMO], 1u); break; } }
    }
    nloc = mine > 0u ? mine : 1u; nx = cnt > 0u ? cnt : 1u;
}

__device__ __forceinline__ void xcd_barrier(const XcdBarrier& b) {
    asm volatile("s_waitcnt vmcnt(0)" ::: "memory");
    __syncthreads();
    if (tid_() == 0) {
        unsigned* bar = b.bar;
        __builtin_amdgcn_s_waitcnt(0);
        unsigned nloc = b.st[0], nx = b.st[1];
        if (nloc == 0u) { xcd_barrier_complete(bar, b.x, nloc, nx); b.st[0] = nloc; b.st[1] = nx; }
        const unsigned old = xb_add(&bar[XB_XSUB(b.x)], 1u);
        const unsigned gen = old / nloc;
        if (old + 1u == (gen + 1u) * nloc) {
            __builtin_amdgcn_fence(__ATOMIC_RELEASE, "agent");
            asm volatile("s_waitcnt vmcnt(0)" ::: "memory");
            const unsigned og = xb_add(&bar[XB_TOP], 1u);
            const unsigned tg = og / nx;
            if (og + 1u == (tg + 1u) * nx) xb_add(&bar[XB_TOPGEN], 1u);
            else XB_SPIN(xb_ld(&bar[XB_TOPGEN]) == tg, bar);
            __builtin_amdgcn_fence(__ATOMIC_ACQUIRE, "agent");
            xb_add(&bar[XB_XGEN(b.x)], 1u);
            asm volatile("s_waitcnt vmcnt(0)" ::: "memory");
        } else {
            XB_SPIN(xb_ld(&bar[XB_XGEN(b.x)]) == gen, bar);
            __builtin_amdgcn_fence(__ATOMIC_ACQUIRE, "agent");
            asm volatile("s_waitcnt vmcnt(0)" ::: "memory");
        }
    }
    __syncthreads();
}

#define OFF_BAR (252 * MIB)
#define GSYNC() do { XcdBarrier xb_; xb_.bar = (unsigned*)(P.ws + OFF_BAR); xb_.x = xb_xcc_id(); xb_.st = (volatile LAS unsigned*)&xb_words; xcd_barrier(xb_); } while (0)
__global__ void __launch_bounds__(256, 2) k_mega(Params P) {
  __shared__ __attribute__((aligned(16))) char smem[67584];
  char* ws = P.ws;
  __shared__ uint4 xb_words;
  if (tid_() == 0) xb_words = make_uint4(0u, 0u, 0u, 0u);
  __syncthreads();
  (void)xcd_barrier_post((unsigned*)(ws + OFF_BAR), (volatile LAS unsigned*)&xb_words);
  phase_prep(P, smem);
  GSYNC();
#pragma unroll 1
  for (int half = 0; half < 2; ++half) {
    phase_inproj(P, half, smem);
    GSYNC();
#if PROBE_DUP == 1
    phase_inproj(P, half, smem);
    GSYNC();
#endif
    if ((int)gridDim.x > 128) {
      const int b2 = bid_();
      if (b2 < 64) cmp_gemm1_tile(P, b2, smem);
      else for (int u = b2 - 64; u < 1024; u += (int)gridDim.x - 64) hgrn_intra_unit(P, u, smem);
    } else {
      for (int t = bid_(); t < 64; t += gridDim.x) cmp_gemm1_tile(P, t, smem);
      for (int u = bid_(); u < 1024; u += gridDim.x) hgrn_intra_unit(P, u, smem);
    }
    GSYNC();
    for (int t = bid_(); t < 32; t += gridDim.x) cmp_gemm2_tile(P, t, smem);
    hgrn_scan(P);
    if (half == 1) phase_late_weights(P, smem);
    GSYNC();
#if PROBE_DUP == 2
    for (int u = bid_(); u < 1024; u += gridDim.x) nsa_unit(P, half, u, smem);
    GSYNC();
#endif
    for (int u = bid_(); u < 1024; u += gridDim.x) nsa_unit(P, half, u, smem);
    for (int u = bid_(); u < 1024; u += gridDim.x) hgrn_out_unit(P, half, u, smem);
    GSYNC();
  }
  phase_branch_merge(P, smem);
  GSYNC();
#if PROBE_DUP == 3
  phase_branch_merge(P, smem);
  GSYNC();
  phase_gemm<2>((const u16*)(ws + OFF_MERGED), 1024, (const u16*)(ws + OFF_WOUT_T), 1024, ws + OFF_Z1, smem);
  GSYNC();
#endif
  phase_gemm_wide<2>((const u16*)(ws + OFF_MERGED), 1024, (const u16*)(ws + OFF_WOUT_T), 1024, (u16*)(ws + OFF_Z1), smem);
  GSYNC();
  phase_rownorm<0, 1>(P, (const void*)(ws + OFF_Z1), P.n_post_mix, P.n_pre_mlp, (u16*)(ws + OFF_V));
  GSYNC();
#if PROBE_DUP == 4
  phase_gemm<1>((const u16*)(ws + OFF_V), 1024, (const u16*)(ws + OFF_WUP_T), 4096, ws + OFF_FFH, smem);
  GSYNC();
#endif
  phase_gemm_wide<1>((const u16*)(ws + OFF_V), 1024, (const u16*)(ws + OFF_WUP_T), 4096, (u16*)(ws + OFF_FFH), smem);
  GSYNC();
#if PROBE_DUP == 4
  phase_gemm<2>((const u16*)(ws + OFF_FFH), 4096, (const u16*)(ws + OFF_WDOWN_T), 1024, ws + OFF_Z2, smem);
  GSYNC();
#endif
  phase_gemm_wide<2>((const u16*)(ws + OFF_FFH), 4096, (const u16*)(ws + OFF_WDOWN_T), 1024, (u16*)(ws + OFF_Z2), smem);
  GSYNC();
  phase_rownorm<1, 1>(P, (const void*)(ws + OFF_Z2), P.n_post_mlp, nullptr, (u16*)(ws + OFF_H2B));
  GSYNC();
  phase_ple(P, smem);
  GSYNC();
#if PROBE_DUP == 5
  for (int i = 0; i < 10; ++i) GSYNC();
#endif
#if PROBE_DUP == 6
  phase_prep(P, smem);
  GSYNC();
#endif
  phase_rownorm<2, 1>(P, (const void*)(P.ws + OFF_Z3), P.n_ple, nullptr, nullptr);
}

extern "C" void kernel_launch(void* const* d_in, const int* in_sizes, int n_in, void* d_out, int out_size, void* d_ws,
                              size_t ws_size, hipStream_t stream) {
  Params P{};
  P.x = (const float*)d_in[0];
  P.p = (const float*)d_in[1];
  P.w_in = (const float*)d_in[2];
  P.w_a = (const float*)d_in[3];
  P.w_b = (const float*)d_in[4];
  P.w_out = (const float*)d_in[5];
  P.n_pre_mix = (const float*)d_in[6];
  P.n_post_mix = (const float*)d_in[7];
  P.n_pre_mlp = (const float*)d_in[8];
  P.n_post_mlp = (const float*)d_in[9];
  P.lb_logits = (const float*)d_in[10];
  P.gnorm = (const float*)d_in[11];
  P.pe_k = (const float*)d_in[12];
  P.pe_v = (const float*)d_in[13];
  P.wk1 = (const float*)d_in[14];
  P.wk2 = (const float*)d_in[15];
  P.wv1 = (const float*)d_in[16];
  P.wv2 = (const float*)d_in[17];
  P.w_up = (const float*)d_in[18];
  P.w_down = (const float*)d_in[19];
  P.w_ple = (const float*)d_in[20];
  P.w_pg = (const float*)d_in[21];
  P.n_ple = (const float*)d_in[22];
  P.out = (float*)d_out;
  P.ws = (char*)d_ws;
#if MEGA
  static int grid_blocks = 0;
  if (!grid_blocks) {
    int dev = 0, cus = 0, per_cu = 0;
    hipGetDevice(&dev);
    hipDeviceGetAttribute(&cus, hipDeviceAttributeMultiprocessorCount, dev);
    hipOccupancyMaxActiveBlocksPerMultiprocessor(&per_cu, k_mega, 256, 0);
    if (per_cu > 2) per_cu = 2;
    if (per_cu < 1) per_cu = 1;
    grid_blocks = cus * per_cu;
  }
  hipMemsetAsync((char*)d_ws + OFF_BAR, 0, XCD_BAR_WORDS * sizeof(unsigned), stream);
  void* args[] = {&P};
  hipError_t e = hipLaunchCooperativeKernel((void*)k_mega, dim3(grid_blocks), dim3(256), args, 0, stream);
  if (e != hipSuccess) fprintf(stderr, "cooperative launch failed: %s (grid %d)\n", hipGetErrorString(e), grid_blocks);
#endif
}
```

```cpp
#include <hip/hip_runtime.h>
#include <hip/hip_cooperative_groups.h>
#include <cstdio>
#include <cstdint>
namespace cg = cooperative_groups;

#ifndef MEGA
#define MEGA 1
#endif
#ifndef PROBE_DUP
#define PROBE_DUP 0
#endif

typedef unsigned short u16;
typedef __attribute__((ext_vector_type(8))) short bf16x8;
typedef __attribute__((ext_vector_type(4))) float f32x4;
typedef __attribute__((ext_vector_type(4))) unsigned u32x4;
typedef __attribute__((ext_vector_type(2))) unsigned u32x2;

#define MFMA(a, b, c) __builtin_amdgcn_mfma_f32_16x16x32_bf16(a, b, c, 0, 0, 0)
#define MIB ((size_t)1 << 20)

#define OFF_U       (0 * MIB)
#define OFF_YB0     (0 * MIB)
#define OFF_WA_T    (16 * MIB)
#define OFF_WB_T    (18 * MIB)
#define OFF_WOUT_T  (20 * MIB)
#define OFF_WPG_T   (22 * MIB)
#define OFF_WPLE_T  (24 * MIB)
#define OFF_WIN_T   (32 * MIB)
#define OFF_WUP_T   (32 * MIB)
#define OFF_WDOWN_T (40 * MIB)
#define OFF_WK1T    (50 * MIB)
#define OFF_WV1T    (51 * MIB)
#define OFF_WK2T    (52 * MIB)
#define OFF_WV2T    (52 * MIB + 32768)
#define OFF_ROPE    (52 * MIB + 65536)
#define OFF_BIAS1   (52 * MIB + 65536 + 262144)
#define OFF_LB      (52 * MIB + 65536 + 262144 + 4096)
#define OFF_BIAS1P  (52 * MIB + 65536 + 262144 + 16384)
#define OFF_NGATE   (53 * MIB)
#define OFF_SG      (56 * MIB)
#define OFF_NQ      (88 * MIB)
#define OFF_QF      (120 * MIB)
#define OFF_LOGF    (136 * MIB)
#define OFF_YB1     (136 * MIB)
#define OFF_HVT     (152 * MIB)
#define OFF_ABUF    (168 * MIB)
#define OFF_UST     (176 * MIB)
#define OFF_KV      (208 * MIB)
#define OFF_NQR     (224 * MIB)
#define OFF_VST     (228 * MIB)
#define OFF_VWT     (232 * MIB)
#define OFF_DCY     (236 * MIB)
#define OFF_HIDK    (236 * MIB + 524288)
#define OFF_HIDV    (237 * MIB + 524288)
#define OFF_KCMP    (238 * MIB + 524288)
#define OFF_VCMPT   (238 * MIB + 524288 + 262144)
#define OFF_MERGED  (88 * MIB)
#define OFF_Z1      (152 * MIB)
#define OFF_V       (56 * MIB)
#define OFF_FFH     (120 * MIB)
#define OFF_Z2      (56 * MIB)
#define OFF_H2B     (120 * MIB)
#define OFF_PB      (152 * MIB)
#define OFF_Z3      (160 * MIB)

struct Params {
  const float *x, *p, *w_in, *w_a, *w_b, *w_out, *n_pre_mix, *n_post_mix, *n_pre_mlp, *n_post_mlp;
  const float *lb_logits, *gnorm, *pe_k, *pe_v, *wk1, *wk2, *wv1, *wv2, *w_up, *w_down, *w_ple, *w_pg, *n_ple;
  float* out;
  char* ws;
};

__device__ __forceinline__ int bid_() { int b = blockIdx.x; asm volatile("" : "+s"(b)); return b; }
__device__ __forceinline__ int tid_() { int t = threadIdx.x; asm volatile("" : "+v"(t)); return t; }
typedef __attribute__((ext_vector_type(2))) float f32x2_t;
typedef __attribute__((ext_vector_type(2))) __bf16 bf16x2_t;
__device__ __forceinline__ uint32_t pack2(float a, float b) {
  f32x2_t v = {a, b};
  return __builtin_bit_cast(uint32_t, __builtin_convertvector(v, bf16x2_t));
}
__device__ __forceinline__ u16 f2bf(float f) { return (u16)(pack2(f, f) & 0xffffu); }
__device__ __forceinline__ float bf2f(u16 h) { return __uint_as_float(((uint32_t)h) << 16); }
__device__ __forceinline__ float shx_f(float v, int src_lane) { return __int_as_float(__builtin_amdgcn_ds_bpermute(src_lane << 2, __float_as_int(v))); }
__device__ __forceinline__ uint32_t shx_u(uint32_t v, int src_lane) { return (uint32_t)__builtin_amdgcn_ds_bpermute(src_lane << 2, (int)v); }
#define SHX(v, m) shx_f((v), lane ^ (m))
#define SHXU(v, m) shx_u((v), lane ^ (m))
__device__ __forceinline__ float sigm(float x) { return __builtin_amdgcn_rcpf(1.f + __expf(-x)); }
__device__ __forceinline__ float siluf(float x) { return x * __builtin_amdgcn_rcpf(1.f + __expf(-x)); }
__device__ __forceinline__ float gelu_tanh(float x) {
  float u = 0.7978845608028654f * (x + 0.044715f * x * x * x);
  float t = 1.f - 2.f * __builtin_amdgcn_rcpf(__expf(2.f * u) + 1.f);
  return 0.5f * x * (1.f + t);
}
__device__ __forceinline__ bf16x8 mk8(uint32_t a, uint32_t b, uint32_t c, uint32_t d) {
  u32x4 v = {a, b, c, d};
  return __builtin_bit_cast(bf16x8, v);
}
__device__ __forceinline__ bf16x8 ld8(const u16* p) { return *(const bf16x8*)p; }

template <int AMODE, int DEEP>
__device__ __forceinline__ void gemm_tile(const u16* __restrict__ A, long lda, int m0, int M,
                                          const u16* __restrict__ Bt, long ldb, int n0, int N, int K,
                                          int coloff, f32x4 (&acc)[4][4], u16* sA, u16* sB) {
  const int tid = tid_(), lane = tid & 63, wave = tid >> 6;
  const int l15 = lane & 15, G = lane >> 4;
  const int wm = wave >> 1, wn = wave & 1;
  const int lr = tid >> 3, ch = tid & 7;
  const char* Ab = (const char*)A;
  const char* Bb = (const char*)Bt;
  unsigned oa[4], ob[4];
  int tok0[4];
#pragma unroll
  for (int i = 0; i < 4; ++i) {
    int r = m0 + lr + 32 * i;
    if (AMODE == 0) {
      if (r > M - 1) r = M - 1;
      oa[i] = (unsigned)(((long)r * lda + ch * 8) * 2);
      tok0[i] = 0;
    } else {
      int grp = r >> 8, n = r & 255;
      int bl = grp >> 2, g = grp & 3;
      tok0[i] = n * 16;
      oa[i] = (unsigned)((bl * 4096 * 1024 + coloff + g * 64 + ch * 8) * 2);
    }
    int rn = n0 + lr + 32 * i;
    if (rn > N - 1) rn = N - 1;
    ob[i] = (unsigned)(((long)rn * ldb + ch * 8) * 2);
  }
#define G_LOAD(RA, RB, KT)                                                                                   \
  {                                                                                                          \
    const char* Ak_ = Ab + (size_t)(KT) * 128;                                                               \
    const char* Bk_ = Bb + (size_t)(KT) * 128;                                                               \
    _Pragma("unroll") for (int i = 0; i < 4; ++i) {                                                          \
      if (AMODE == 0) RA[i] = *(const u32x4*)(Ak_ + oa[i]);                                                  \
      else { int tok = tok0[i] + (KT); if (tok > 4095) tok = 4095; RA[i] = *(const u32x4*)(Ab + (oa[i] + (unsigned)tok * 2048u)); } \
      RB[i] = *(const u32x4*)(Bk_ + ob[i]);                                                                  \
    }                                                                                                        \
  }
#define L_STORE(RA, RB)                                                                                      \
  _Pragma("unroll") for (int i = 0; i < 4; ++i) {                                                            \
    *(u32x4*)&sA[(lr + 32 * i) * 80 + ch * 8] = RA[i];                                                       \
    *(u32x4*)&sB[(lr + 32 * i) * 80 + ch * 8] = RB[i];                                                       \
  }
#define T_COMPUTE()                                                                                          \
  _Pragma("unroll") for (int ks = 0; ks < 2; ++ks) {                                                         \
    bf16x8 af[4], bfr[4];                                                                                    \
    _Pragma("unroll") for (int i = 0; i < 4; ++i) af[i] = ld8(&sA[(wm * 64 + 16 * i + l15) * 80 + ks * 32 + G * 8]);  \
    _Pragma("unroll") for (int j = 0; j < 4; ++j) bfr[j] = ld8(&sB[(wn * 64 + 16 * j + l15) * 80 + ks * 32 + G * 8]); \
    _Pragma("unroll") for (int i = 0; i < 4; ++i)                                                            \
      _Pragma("unroll") for (int j = 0; j < 4; ++j) acc[i][j] = MFMA(af[i], bfr[j], acc[i][j]);              \
  }                                                                                                          \
     \
  __builtin_amdgcn_sched_group_barrier(0x100, 8, 0);                                                         \
  _Pragma("unroll") for (int z = 0; z < 8; ++z) {                                                            \
    __builtin_amdgcn_sched_group_barrier(0x008, 2, 0);                                                       \
    __builtin_amdgcn_sched_group_barrier(0x100, 1, 0);                                                       \
  }                                                                                                          \
  __builtin_amdgcn_sched_group_barrier(0x008, 16, 0);
  const int nk = K >> 6;
  if (DEEP == 2) {
    u32x4 ra0[4], rb0[4], ra1[4], rb1[4];
    const int kl = nk - 1;
    G_LOAD(ra0, rb0, 0);
    G_LOAD(ra1, rb1, 1);
    for (int kt = 0; kt < nk; kt += 2) {
      L_STORE(ra0, rb0);
      __syncthreads();
      G_LOAD(ra0, rb0, (kt + 2 < kl ? kt + 2 : kl));
      T_COMPUTE();
      __syncthreads();
      L_STORE(ra1, rb1);
      __syncthreads();
      G_LOAD(ra1, rb1, (kt + 3 < kl ? kt + 3 : kl));
      T_COMPUTE();
      __syncthreads();
    }
  } else {
    u32x4 ra0[4], rb0[4];
    G_LOAD(ra0, rb0, 0);
    for (int kt = 0; kt < nk; ++kt) {
      L_STORE(ra0, rb0);
      __syncthreads();
      if (kt + 1 < nk) G_LOAD(ra0, rb0, kt + 1);
      T_COMPUTE();
      __syncthreads();
    }
  }
#undef G_LOAD
#undef L_STORE
#undef T_COMPUTE
}

__device__ __forceinline__ void zero_acc(f32x4 (&acc)[4][4]) {
#pragma unroll
  for (int i = 0; i < 4; ++i)
#pragma unroll
    for (int j = 0; j < 4; ++j) acc[i][j] = (f32x4){0.f, 0.f, 0.f, 0.f};
}

#define EPI_VARS                                                         \
  const int tid = tid_(), lane = tid & 63, wave = tid >> 6;         \
  const int l15 = lane & 15, G = lane >> 4;                              \
  const int wm = wave >> 1, wn = wave & 1;                               \
  (void)l15; (void)G; (void)wm; (void)wn;

__device__ __forceinline__ void transpose_tile(const float* __restrict__ W, int ldw, int oc0, int valid, int k0, u16* __restrict__ out,
                               long Kdim, int n0, float* s  ) {
  const int tid = tid_();
  __syncthreads();
  {
    const bool vec = (valid == 64) && (((oc0 | ldw) & 3) == 0);
    if (vec) {
      const int n4 = (tid & 15) * 4;
      float4 v[4];
#pragma unroll
      for (int i = 0; i < 4; ++i) v[i] = *(const float4*)(W + (long)(k0 + (tid >> 4) + 16 * i) * ldw + oc0 + n4);
#pragma unroll
      for (int i = 0; i < 4; ++i) {
        float* d = &s[((tid >> 4) + 16 * i) * 65 + n4];
        d[0] = v[i].x; d[1] = v[i].y; d[2] = v[i].z; d[3] = v[i].w;
      }
    } else {
      const int n = tid & 63;
      for (int kk = tid >> 6; kk < 64; kk += 4) {
        float v = 0.f;
        if (n < valid) v = W[(long)(k0 + kk) * ldw + oc0 + n];
        s[kk * 65 + n] = v;
      }
    }
  }
  __syncthreads();
  {
    const int nn = tid >> 2, kq = (tid & 3) * 16;
    uint32_t w[8];
#pragma unroll
    for (int e = 0; e < 8; ++e) w[e] = pack2(s[(kq + 2 * e) * 65 + nn], s[(kq + 2 * e + 1) * 65 + nn]);
    u16* dst = out + (long)(n0 + nn) * Kdim + k0 + kq;
    *(u32x4*)dst = (u32x4){w[0], w[1], w[2], w[3]};
    *(u32x4*)(dst + 8) = (u32x4){w[4], w[5], w[6], w[7]};
  }
}

__device__ __forceinline__ void transpose_job(const float* W, int N, int K, u16* out, int tile, float* s) {
  const int kt_n = K >> 6;
  const int nt = tile / kt_n, kt = tile % kt_n;
  transpose_tile(W, N, nt * 64, 64, kt * 64, out, K, nt * 64, s);
}

__device__ __forceinline__ void phase_prep(const Params& P, char* smem) {
  const int tid = tid_(), lane = tid & 63, wave = tid >> 6;
  char* ws = P.ws;
  float* sf = (float*)smem;
  {
    u16* U = (u16*)(ws + OFF_U);
    for (int un = bid_(); un < 1024; un += gridDim.x) {
      const int row0 = un * 16 + wave * 4;
      float4 v[4][4];
      float ss[4] = {0.f, 0.f, 0.f, 0.f};
#pragma unroll
      for (int rr = 0; rr < 4; ++rr)
#pragma unroll
        for (int j = 0; j < 4; ++j) v[rr][j] = *(const float4*)(P.x + (long)(row0 + rr) * 1024 + j * 256 + lane * 4);
#pragma unroll
      for (int rr = 0; rr < 4; ++rr) {
#pragma unroll
        for (int j = 0; j < 4; ++j)
          ss[rr] += v[rr][j].x * v[rr][j].x + v[rr][j].y * v[rr][j].y + v[rr][j].z * v[rr][j].z + v[rr][j].w * v[rr][j].w;
#pragma unroll
        for (int o = 32; o >= 1; o >>= 1) ss[rr] += SHX(ss[rr], o);
        const float r = rsqrtf(ss[rr] * (1.f / 1024.f) + 1e-6f);
#pragma unroll
        for (int j = 0; j < 4; ++j) {
          const float4 w = *(const float4*)(P.n_pre_mix + j * 256 + lane * 4);
          u32x2 o2 = {pack2(v[rr][j].x * r * w.x, v[rr][j].y * r * w.y), pack2(v[rr][j].z * r * w.z, v[rr][j].w * r * w.w)};
          *(u32x2*)(U + (long)(row0 + rr) * 1024 + j * 256 + lane * 4) = o2;
        }
      }
    }
  }
  {
    u16* WT = (u16*)(ws + OFF_WIN_T);
    for (int t = bid_(); t < 138 * 16; t += gridDim.x) {
      const int nt = t >> 4, kt = t & 15;
      const int nr0 = nt * 64;
      int oc0, valid;
      if (nr0 < 6656) { oc0 = nr0; valid = 64; }
      else if (nr0 < 8704) { oc0 = nr0 + 48; valid = 64; }
      else if (nr0 == 8704) { oc0 = 6656; valid = 48; }
      else { oc0 = 0; valid = 0; }
      transpose_tile(P.w_in, 8752, oc0, valid, kt * 64, WT, 1024, nr0, sf);
    }
    for (int t = bid_(); t < 128; t += gridDim.x) transpose_job(P.wk1, 256, 2048, (u16*)(ws + OFF_WK1T), t, sf);
    for (int t = bid_(); t < 128; t += gridDim.x) transpose_job(P.wv1, 256, 2048, (u16*)(ws + OFF_WV1T), t, sf);
    for (int t = bid_(); t < 4; t += gridDim.x) transpose_job(P.wk2, 64, 256, (u16*)(ws + OFF_WK2T), t, sf);
    for (int t = bid_(); t < 4; t += gridDim.x) transpose_job(P.wv2, 64, 256, (u16*)(ws + OFF_WV2T), t, sf);
  }
  {
    float2* RT = (float2*)(ws + OFF_ROPE);
    for (int un = bid_(); un < 128; un += gridDim.x) {
      const int idx = un * 256 + tid;
      const int t = idx >> 3, j = idx & 7;
      const float inv = (j == 0) ? 1.0f : (j == 1) ? 0.1939227432012558f : (j == 2) ? 0.03760603070259094f
                      : (j == 3) ? 0.007292664609849453f : (j == 4) ? 0.0014142135623842478f
                      : (j == 5) ? 0.00027424818836152554f : (j == 6) ? 5.3182957344688475e-05f : 1.0313385246263351e-05f;
      const float ang = (float)t * inv;
      const double ad = (double)ang;
      const double kq = rint(ad * 0.15915494309189535);
      const float rr = (float)(ad - kq * 6.283185307179586);
      float sn, cs;
      sincosf(rr, &sn, &cs);
      RT[idx] = make_float2(cs, sn);
    }
  }
  {
    float* B1P = (float*)(ws + OFF_BIAS1P);
    for (int un = bid_(); un < 16; un += gridDim.x) {
      const int kvi = un >> 3, part = un & 7;
      const float* pe = kvi ? P.pe_v : P.pe_k;
      const float* w1 = kvi ? P.wv1 : P.wk1;
      float4 a = make_float4(0.f, 0.f, 0.f, 0.f);
      const int k0 = part * 256 + wave * 64;
#pragma unroll 8
      for (int k = k0; k < k0 + 64; ++k) {
        const float pv = pe[k];
        const float4 w = *(const float4*)(w1 + (long)k * 256 + lane * 4);
        a.x += pv * w.x; a.y += pv * w.y; a.z += pv * w.z; a.w += pv * w.w;
      }
      __syncthreads();
      *(float4*)&sf[wave * 256 + lane * 4] = a;
      __syncthreads();
      B1P[un * 256 + tid] = sf[tid] + sf[256 + tid] + sf[512 + tid] + sf[768 + tid];
      __syncthreads();
    }
  }
  {
    float* LB = (float*)(ws + OFF_LB);
    for (int un = bid_(); un < 4; un += gridDim.x) {
      const int c = un * 256 + tid;
      const float l0 = P.lb_logits[c], l1 = P.lb_logits[1024 + c];
      LB[c] = 1.f / (1.f + expf(l1 - l0));
    }
  }
}

__device__ __forceinline__ void phase_late_weights(const Params& P, char* smem) {
  char* ws = P.ws;
  float* sf = (float*)smem;
  for (int t = bid_(); t < 256; t += gridDim.x) transpose_job(P.w_a, 1024, 1024, (u16*)(ws + OFF_WA_T), t, sf);
  for (int t = bid_(); t < 256; t += gridDim.x) transpose_job(P.w_b, 1024, 1024, (u16*)(ws + OFF_WB_T), t, sf);
  for (int t = bid_(); t < 256; t += gridDim.x) transpose_job(P.w_out, 1024, 1024, (u16*)(ws + OFF_WOUT_T), t, sf);
  for (int t = bid_(); t < 256; t += gridDim.x) transpose_job(P.w_pg, 1024, 1024, (u16*)(ws + OFF_WPG_T), t, sf);
  for (int t = bid_(); t < 1024; t += gridDim.x) transpose_job(P.w_up, 4096, 1024, (u16*)(ws + OFF_WUP_T), t, sf);
  for (int t = bid_(); t < 1024; t += gridDim.x) transpose_job(P.w_down, 1024, 4096, (u16*)(ws + OFF_WDOWN_T), t, sf);
  for (int t = bid_(); t < 64; t += gridDim.x) transpose_job(P.w_ple, 1024, 256, (u16*)(ws + OFF_WPLE_T), t, sf);
}

__device__ __forceinline__ void phase_inproj(const Params& P, int half, char* smem) {
  char* ws = P.ws;
  u16* sA = (u16*)smem;
  u16* sB = sA + 128 * 80;
  float* sF = (float*)smem;
  const u16* U = (const u16*)(ws + OFF_U) + (long)half * 8192 * 1024;
  const u16* WT = (const u16*)(ws + OFF_WIN_T);
  u16* QF = (u16*)(ws + OFF_QF);
  u16* LOGF = (u16*)(ws + OFF_LOGF);
  u16* HVT = (u16*)(ws + OFF_HVT);
  u16* SG = (u16*)(ws + OFF_SG) + (long)half * 8192 * 1024;
  u16* NQ = (u16*)(ws + OFF_NQ) + (long)half * 8192 * 1024;
  u16* NQR = (u16*)(ws + OFF_NQR);
  u16* KV = (u16*)(ws + OFF_KV);
  u16* VST = (u16*)(ws + OFF_VST);
  u16* VWT = (u16*)(ws + OFF_VWT);
  u16* GATES = (u16*)P.out + (long)half * 8192 * 2048;
  float* NGATE = (float*)(ws + OFF_NGATE) + (long)half * 8192 * 48;
  const float* RTf = (const float*)(ws + OFF_ROPE);
  const float* LB = (const float*)(ws + OFF_LB);
  for (int t = bid_(); t < 64 * 69; t += gridDim.x) {
    const int nt = t >> 6, mt = t & 63;
    const int m0 = mt * 128, n0 = nt * 128;
    f32x4 acc[4][4];
    zero_acc(acc);
    gemm_tile<0, 2>(U, 1024, m0, 8192, WT, 1024, n0, 8832, 1024, 0, acc, sA, sB);
    {
      EPI_VARS
#pragma unroll
      for (int i = 0; i < 4; ++i)
#pragma unroll
        for (int j = 0; j < 4; ++j)
#pragma unroll
          for (int e = 0; e < 4; ++e) sF[(wm * 64 + 16 * i + G * 4 + e) * 132 + wn * 64 + 16 * j + l15] = acc[i][j][e];
    }
    __syncthreads();
    const int tc = tid_();
    int kind = 0, op = 0, dstride = 1024, dcol = 0;
    u16* dbase = nullptr;
    u16* tbase = nullptr;
    if (nt < 8) { dbase = QF; dcol = n0; op = 0; }
    else if (nt < 16) { dbase = LOGF; dcol = n0 - 1024; op = 1; }
    else if (nt < 24) { kind = 1; tbase = HVT; }
    else if (nt < 32) { dbase = SG; dcol = n0 - 3072; op = 2; }
    else if (nt < 40) { dbase = NQ; dcol = n0 - 4096; op = 3; }
    else if (nt < 52) {
      const int c0 = n0 - 5120, sub0 = c0 >> 8;
      if (sub0 == 3 || sub0 == 5) { kind = 2; tbase = (sub0 == 3) ? VST : VWT; }
      else { dbase = KV; dcol = ((sub0 == 0) ? 0 : (sub0 == 1) ? 256 : (sub0 == 2) ? 512 : 768) + (c0 & 255); op = (sub0 >= 2) ? 5 : 4; }
    } else if (nt < 68) { dbase = GATES; dstride = 2048; dcol = n0 - 6656; op = 6; }
    else kind = 3;

    if (kind == 0) {
#pragma unroll 2
      for (int k8 = 0; k8 < 8; ++k8) {
        const int id = tc + 256 * k8;
        const int row = id >> 4, c8 = (id & 15) * 8;
        const float4 f0 = *(const float4*)&sF[row * 132 + c8];
        const float4 f1 = *(const float4*)&sF[row * 132 + c8 + 4];
        float v[8] = {f0.x, f0.y, f0.z, f0.w, f1.x, f1.y, f1.z, f1.w};
        const int hc = c8 & 63;
        if (op == 0) {
#pragma unroll
          for (int q = 0; q < 8; ++q) v[q] = siluf(v[q]) * 0.08838834764831845f;
        } else if (op == 1) {
          const float4 l0 = *(const float4*)(LB + dcol + c8);
          const float4 l1 = *(const float4*)(LB + dcol + c8 + 4);
          const float lb[8] = {l0.x, l0.y, l0.z, l0.w, l1.x, l1.y, l1.z, l1.w};
#pragma unroll
          for (int q = 0; q < 8; ++q) v[q] = __logf(lb[q] + (1.f - lb[q]) * sigm(v[q]));
        } else if (op == 2) {
#pragma unroll
          for (int q = 0; q < 8; ++q) v[q] = siluf(v[q]);
        } else if (op == 3) {
#pragma unroll
          for (int q = 0; q < 8; ++q) v[q] *= 0.18033688011112042f;
        } else if (op == 6) {
#pragma unroll
          for (int q = 0; q < 8; ++q) v[q] = sigm(v[q]);
        }
        if ((op == 3 || op == 5) && hc < 16) {
          const int pc = (hc == 0) ? c8 + 8 : c8 - 8;
          const float4 g0 = *(const float4*)&sF[row * 132 + pc];
          const float4 g1 = *(const float4*)&sF[row * 132 + pc + 4];
          float pr[8] = {g0.x, g0.y, g0.z, g0.w, g1.x, g1.y, g1.z, g1.w};
          if (op == 3) {
#pragma unroll
            for (int q = 0; q < 8; ++q) pr[q] *= 0.18033688011112042f;
          }
          const int tt = (m0 + row) & 4095;
          const float4 r0 = *(const float4*)(RTf + tt * 16);
          const float4 r1 = *(const float4*)(RTf + tt * 16 + 4);
          const float4 r2 = *(const float4*)(RTf + tt * 16 + 8);
          const float4 r3 = *(const float4*)(RTf + tt * 16 + 12);
          const float cs[8] = {r0.x, r0.z, r1.x, r1.z, r2.x, r2.z, r3.x, r3.z};
          const float sn[8] = {r0.y, r0.w, r1.y, r1.w, r2.y, r2.w, r3.y, r3.w};
          float ro[8];
#pragma unroll
          for (int q = 0; q < 8; ++q) ro[q] = (hc == 0) ? (v[q] * cs[q] - pr[q] * sn[q]) : (v[q] * cs[q] + pr[q] * sn[q]);
          if (op == 3) {
            const int head = (dcol + c8) >> 6;
            *(u32x4*)(NQR + (long)(m0 + row) * 256 + head * 16 + hc) =
                (u32x4){pack2(ro[0], ro[1]), pack2(ro[2], ro[3]), pack2(ro[4], ro[5]), pack2(ro[6], ro[7])};
          } else {
#pragma unroll
            for (int q = 0; q < 8; ++q) v[q] = ro[q];
          }
        }
        u32x4 o4;
        if (op == 1) {
          union { _Float16 h[8]; u32x4 u; } cv;
#pragma unroll
          for (int q = 0; q < 8; ++q) cv.h[q] = (_Float16)v[q];
          o4 = cv.u;
        } else {
          o4 = (u32x4){pack2(v[0], v[1]), pack2(v[2], v[3]), pack2(v[4], v[5]), pack2(v[6], v[7])};
        }
        *(u32x4*)(dbase + (long)(m0 + row) * dstride + dcol + c8) = o4;
      }
    } else if (kind == 1 || kind == 2) {
#pragma unroll 2
      for (int k8 = 0; k8 < 8; ++k8) {
        const int id = tc + 256 * k8;
        const int col = id & 127, r8 = (id >> 7) * 8;
        float v[8];
#pragma unroll
        for (int q = 0; q < 8; ++q) v[q] = sF[(r8 + q) * 132 + col];
        const int r = m0 + r8;
        const int bl = r >> 12, tt = r & 4095;
        unsigned off;
        if (kind == 1) {
          const int c = n0 + col - 2048;
          const int h = c >> 7, dv = c & 127;
          off = ((unsigned)(((bl * 8 + h) * 64 + (tt >> 6)) * 128 + dv) * 64u + (unsigned)(tt & 63)) * 2u;
        } else {
          const int cc = (n0 + col - 5120) & 255;
          const int g = cc >> 6, d = cc & 63;
          off = ((unsigned)((bl * 4 + g) * 64 + d) * 4096u + (unsigned)tt) * 2u;
        }
        *(u32x4*)((char*)tbase + off) = (u32x4){pack2(v[0], v[1]), pack2(v[2], v[3]), pack2(v[4], v[5]), pack2(v[6], v[7])};
      }
    } else {
      for (int id = tc; id < 128 * 48; id += 256) {
        const int row = id / 48, c = id - row * 48;
        NGATE[(long)(m0 + row) * 48 + c] = sigm(sF[row * 132 + c]);
      }
    }
    __syncthreads();
  }
}

__device__ __forceinline__ void hgrn_intra_unit(const Params& P, int uu, char* smem) {
  char* ws = P.ws;
  const int tid = tid_(), lane = tid & 63, wave = tid >> 6;
  const int l15 = lane & 15, G = lane >> 4;
  float* sBc = (float*)smem;
  u16* sQ = (u16*)(smem + 64 * 132 * 4);
  const int bl = uu >> 9, h = (uu >> 6) & 7, c = uu & 63;
  const long r0 = (long)bl * 4096 + c * 64;
  u16* QF = (u16*)(ws + OFF_QF);
  const _Float16* LOGF = (const _Float16*)(ws + OFF_LOGF);
  const u16* HVT = (const u16*)(ws + OFF_HVT);
  u16* ABUF = (u16*)(ws + OFF_ABUF);
  u16* UST = (u16*)(ws + OFF_UST);
  float* DCY = (float*)(ws + OFF_DCY);

  __syncthreads();
#pragma unroll
  for (int i = 0; i < 4; ++i) {
    const int id = tid + 256 * i;
    const int row = id >> 4, cc = (id & 15) * 8;
    const u32x4 lf = *(const u32x4*)(LOGF + (r0 + row) * 1024 + h * 128 + cc);
    const _Float16* hp = (const _Float16*)&lf;
#pragma unroll
    for (int e = 0; e < 8; ++e) sBc[row * 132 + cc + e] = (float)hp[e];
    *(u32x4*)&sQ[row * 136 + cc] = *(const u32x4*)(QF + (r0 + row) * 1024 + h * 128 + cc);
  }
  __syncthreads();
  {
    float* sTot = (float*)(smem + 51200);
    const int col = tid & 127, hh = tid >> 7;
    float v[32];
#pragma unroll
    for (int q = 0; q < 32; ++q) v[q] = sBc[(32 * hh + q) * 132 + col];
    float run = 0.f;
#pragma unroll
    for (int q = 0; q < 32; ++q) { run += v[q]; v[q] = run; }
    if (hh == 0) sTot[col] = run;
    __syncthreads();
    const float off = hh ? sTot[col] : 0.f;
#pragma unroll
    for (int q = 0; q < 32; ++q) sBc[(32 * hh + q) * 132 + col] = v[q] + off;
  }
  __syncthreads();
#pragma unroll
  for (int i = 0; i < 4; ++i) {
    const int id = tid + 256 * i;
    const int row = id >> 4, cc = (id & 15) * 8;
    uint32_t w[4];
#pragma unroll
    for (int e = 0; e < 4; ++e) {
      const float q0 = bf2f(sQ[row * 136 + cc + 2 * e]) * __expf(sBc[row * 132 + cc + 2 * e]);
      const float q1 = bf2f(sQ[row * 136 + cc + 2 * e + 1]) * __expf(sBc[row * 132 + cc + 2 * e + 1]);
      w[e] = pack2(q0, q1);
    }
    *(u32x4*)(QF + (r0 + row) * 1024 + h * 128 + cc) = (u32x4){w[0], w[1], w[2], w[3]};
  }
  if (tid < 128) DCY[(long)uu * 128 + tid] = __expf(sBc[63 * 132 + tid]);
  for (int idx = tid; idx < 4096; idx += 256) {
    const int t = idx >> 6, s = idx & 63;
    if ((s >> 4) > (t >> 4)) ABUF[(long)uu * 4096 + idx] = 0;
  }
  for (int ti = wave; ti < 10; ti += 4) {
    int i, j;
    if (ti == 0) { i = 0; j = 0; }
    else if (ti < 3) { i = 1; j = ti - 1; }
    else if (ti < 6) { i = 2; j = ti - 3; }
    else { i = 3; j = ti - 6; }
    f32x4 a4 = {0.f, 0.f, 0.f, 0.f};
    const int t = 16 * i + l15, s = 16 * j + l15;
#pragma unroll
    for (int ks = 0; ks < 4; ++ks) {
      const int dk0 = ks * 32 + G * 8;
      uint32_t aw[4], bw[4];
#pragma unroll
      for (int e2 = 0; e2 < 4; ++e2) {
        float av[2], bv[2];
#pragma unroll
        for (int z = 0; z < 2; ++z) {
          const int dk = dk0 + 2 * e2 + z;
          const float br = sBc[(16 * i) * 132 + dk];
          const float bt = sBc[t * 132 + dk];
          av[z] = bf2f(sQ[t * 136 + dk]) * __expf(bt - br);
          const float bs = sBc[s * 132 + dk];
          const float bp = (s > 0) ? sBc[(s - 1) * 132 + dk] : 0.f;
          const float kk = 1.f - __expf(bs - bp);
          bv[z] = kk * __expf(br - bs);
        }
        aw[e2] = pack2(av[0], av[1]);
        bw[e2] = pack2(bv[0], bv[1]);
      }
      a4 = MFMA(mk8(aw[0], aw[1], aw[2], aw[3]), mk8(bw[0], bw[1], bw[2], bw[3]), a4);
    }
#pragma unroll
    for (int e = 0; e < 4; ++e) {
      const int tr = 16 * i + G * 4 + e, sc = 16 * j + l15;
      const float v = (sc <= tr) ? a4[e] : 0.f;
      ABUF[(long)uu * 4096 + tr * 64 + sc] = f2bf(v);
    }
  }
  {
    f32x4 ua[8][2];
#pragma unroll
    for (int rt = 0; rt < 8; ++rt) { ua[rt][0] = (f32x4){0.f, 0.f, 0.f, 0.f}; ua[rt][1] = (f32x4){0.f, 0.f, 0.f, 0.f}; }
#pragma unroll
    for (int ks = 0; ks < 2; ++ks) {
      bf16x8 bfr[2];
#pragma unroll
      for (int ct = 0; ct < 2; ++ct) {
        const int dk = (2 * wave + ct) * 16 + l15;
        const float blast = sBc[63 * 132 + dk];
        const int s0 = ks * 32 + G * 8;
        float prev = (s0 > 0) ? sBc[(s0 - 1) * 132 + dk] : 0.f;
        uint32_t bw[4];
#pragma unroll
        for (int e2 = 0; e2 < 4; ++e2) {
          const float b0 = sBc[(s0 + 2 * e2) * 132 + dk];
          const float b1 = sBc[(s0 + 2 * e2 + 1) * 132 + dk];
          const float k0 = (1.f - __expf(b0 - prev)) * __expf(blast - b0);
          const float k1 = (1.f - __expf(b1 - b0)) * __expf(blast - b1);
          prev = b1;
          bw[e2] = pack2(k0, k1);
        }
        bfr[ct] = mk8(bw[0], bw[1], bw[2], bw[3]);
      }
#pragma unroll
      for (int rt = 0; rt < 8; ++rt) {
        const int dv = rt * 16 + l15;
        const bf16x8 af = ld8(HVT + ((long)uu * 128 + dv) * 64 + ks * 32 + G * 8);
        ua[rt][0] = MFMA(af, bfr[0], ua[rt][0]);
        ua[rt][1] = MFMA(af, bfr[1], ua[rt][1]);
      }
    }
    u16* sU = (u16*)smem;
    __syncthreads();
#pragma unroll
    for (int rt = 0; rt < 8; ++rt)
#pragma unroll
      for (int ct = 0; ct < 2; ++ct)
#pragma unroll
        for (int e = 0; e < 4; ++e) {
          const int dv = rt * 16 + G * 4 + e, dk = (2 * wave + ct) * 16 + l15;
          sU[dv * 136 + dk] = f2bf(ua[rt][ct][e]);
        }
    __syncthreads();
#pragma unroll 4
    for (int k8 = 0; k8 < 8; ++k8) {
      const int id = tid + 256 * k8;
      const int row = id >> 4, cch = (id & 15) * 8;
      *(u32x4*)(UST + ((long)uu * 128 + row) * 128 + cch) = *(const u32x4*)&sU[row * 136 + cch];
    }
  }
}

__device__ __forceinline__ void cmp_gemm1_tile(const Params& P, int t, char* smem) {
  char* ws = P.ws;
  u16* sA = (u16*)smem;
  u16* sB = sA + 128 * 80;
  EPI_VARS
  const int kv = t >> 5, rem = t & 31;
  const int mt = rem >> 1, nt = rem & 1;
  const int m0 = mt * 128, n0 = nt * 128;
  const u16* KV = (const u16*)(ws + OFF_KV);
  const u16* W1T = (const u16*)(ws + (kv ? OFF_WV1T : OFF_WK1T));
  u16* HID = (u16*)(ws + (kv ? OFF_HIDV : OFF_HIDK));
  const float* B1P = (const float*)(ws + OFF_BIAS1P) + kv * 2048;
  f32x4 acc[4][4];
  zero_acc(acc);
  gemm_tile<1, 2>(KV, 1024, m0, 2048, W1T, 2048, n0, 256, 2048, kv * 256, acc, sA, sB);
#pragma unroll
  for (int i = 0; i < 4; ++i)
#pragma unroll
    for (int j = 0; j < 4; ++j) {
      const int col = n0 + wn * 64 + 16 * j + l15;
      float bias = 0.f;
#pragma unroll
      for (int pp = 0; pp < 8; ++pp) bias += B1P[pp * 256 + col];
#pragma unroll
      for (int e = 0; e < 4; ++e) {
        const int row = m0 + wm * 64 + 16 * i + G * 4 + e;
        HID[(long)row * 256 + col] = f2bf(gelu_tanh(acc[i][j][e] + bias));
      }
    }
}

__device__ __forceinline__ void cmp_gemm2_tile(const Params& P, int t, char* smem) {
  char* ws = P.ws;
  u16* sA = (u16*)smem;
  u16* sB = sA + 128 * 80;
  EPI_VARS
  const int kv = t >> 4, mt = t & 15;
  const int m0 = mt * 128;
  const u16* HID = (const u16*)(ws + (kv ? OFF_HIDV : OFF_HIDK));
  const u16* W2T = (const u16*)(ws + (kv ? OFF_WV2T : OFF_WK2T));
  u16* KCMP = (u16*)(ws + OFF_KCMP);
  u16* VCMPT = (u16*)(ws + OFF_VCMPT);
  f32x4 acc[4][4];
  zero_acc(acc);
  gemm_tile<0, 1>(HID, 256, m0, 2048, W2T, 256, 0, 64, 256, 0, acc, sA, sB);
  if (wn == 0) {
#pragma unroll
    for (int i = 0; i < 4; ++i)
#pragma unroll
      for (int j = 0; j < 4; ++j) {
        const int col = 16 * j + l15;
        const int rbase = m0 + wm * 64 + 16 * i + G * 4;
        if (kv == 0) {
#pragma unroll
          for (int e = 0; e < 4; ++e) KCMP[(long)(rbase + e) * 64 + col] = f2bf(acc[i][j][e]);
        } else {
          const int grp = rbase >> 8, n = rbase & 255;
          u32x2 o2 = {pack2(acc[i][j][0], acc[i][j][1]), pack2(acc[i][j][2], acc[i][j][3])};
          *(u32x2*)(VCMPT + ((long)grp * 64 + col) * 256 + n) = o2;
        }
      }
  }
}

__device__ __forceinline__ void hgrn_scan(const Params& P) {
  char* ws = P.ws;
  u16* UST = (u16*)(ws + OFF_UST);
  const float* DCY = (const float*)(ws + OFF_DCY);
  for (int idx = bid_() * 256 + tid_(); idx < 131072; idx += gridDim.x * 256) {
    const int bh = idx >> 13, rem = idx & 8191;
    const int dv = rem >> 6, dk2 = (rem & 63) * 2;
    float s0 = 0.f, s1 = 0.f;
#pragma unroll 8
    for (int c = 0; c < 64; ++c) {
      const long uu = (long)bh * 64 + c;
      u16* ptr = UST + (uu * 128 + dv) * 128 + dk2;
      const uint32_t uv = *(const uint32_t*)ptr;
      const float2 d = *(const float2*)(DCY + uu * 128 + dk2);
      *(uint32_t*)ptr = pack2(s0, s1);
      s0 = d.x * s0 + __uint_as_float(uv << 16);
      s1 = d.y * s1 + __uint_as_float(uv & 0xffff0000u);
    }
  }
}

__device__ __forceinline__ void hgrn_out_unit(const Params& P, int half, int uu, char* smem) {
  char* ws = P.ws;
  const int tid = tid_(), lane = tid & 63, wave = tid >> 6;
  const int l15 = lane & 15, G = lane >> 4;
  float* sO = (float*)smem;
  const int bl = uu >> 9, h = (uu >> 6) & 7, c = uu & 63;
  const long r0 = (long)bl * 4096 + c * 64;
  const u16* QF = (const u16*)(ws + OFF_QF);
  const u16* HVT = (const u16*)(ws + OFF_HVT);
  const u16* ABUF = (const u16*)(ws + OFF_ABUF);
  const u16* UST = (const u16*)(ws + OFF_UST);
  u16* SG = (u16*)(ws + OFF_SG) + (long)half * 8192 * 1024;
  f32x4 acc[4][2];
#pragma unroll
  for (int i = 0; i < 4; ++i) { acc[i][0] = (f32x4){0.f, 0.f, 0.f, 0.f}; acc[i][1] = (f32x4){0.f, 0.f, 0.f, 0.f}; }
#pragma unroll
  for (int ks = 0; ks < 4; ++ks) {
    const int dk0 = ks * 32 + G * 8;
    bf16x8 bfr[2];
#pragma unroll
    for (int jt = 0; jt < 2; ++jt) bfr[jt] = ld8(UST + ((long)uu * 128 + 32 * wave + 16 * jt + l15) * 128 + dk0);
#pragma unroll
    for (int i = 0; i < 4; ++i) {
      const bf16x8 af = ld8(QF + (r0 + 16 * i + l15) * 1024 + h * 128 + dk0);
      acc[i][0] = MFMA(af, bfr[0], acc[i][0]);
      acc[i][1] = MFMA(af, bfr[1], acc[i][1]);
    }
  }
#pragma unroll
  for (int ks = 0; ks < 2; ++ks) {
    const int s0 = ks * 32 + G * 8;
    bf16x8 bfr[2];
#pragma unroll
    for (int jt = 0; jt < 2; ++jt) bfr[jt] = ld8(HVT + ((long)uu * 128 + 32 * wave + 16 * jt + l15) * 64 + s0);
#pragma unroll
    for (int i = 0; i < 4; ++i) {
      const bf16x8 af = ld8(ABUF + (long)uu * 4096 + (16 * i + l15) * 64 + s0);
      acc[i][0] = MFMA(af, bfr[0], acc[i][0]);
      acc[i][1] = MFMA(af, bfr[1], acc[i][1]);
    }
  }
  __syncthreads();
#pragma unroll
  for (int i = 0; i < 4; ++i)
#pragma unroll
    for (int jt = 0; jt < 2; ++jt)
#pragma unroll
      for (int e = 0; e < 4; ++e) sO[(16 * i + G * 4 + e) * 132 + 32 * wave + 16 * jt + l15] = acc[i][jt][e];
  __syncthreads();
  {
    const int row = tid >> 2, part = tid & 3;
    float ss = 0.f;
#pragma unroll
    for (int cc = 0; cc < 32; ++cc) { const float v = sO[row * 132 + part * 32 + cc]; ss += v * v; }
    ss += SHX(ss, 1);
    ss += SHX(ss, 2);
    const float r = rsqrtf(ss * (1.f / 128.f) + 1e-6f);
    u16* dst = SG + (r0 + row) * 1024 + h * 128 + part * 32;
#pragma unroll
    for (int q4 = 0; q4 < 4; ++q4) {
      const u32x4 sgv = *(const u32x4*)(dst + q4 * 8);
      uint32_t w[4];
#pragma unroll
      for (int e = 0; e < 4; ++e) {
        const int cc = q4 * 8 + 2 * e;
        const float g0 = __uint_as_float(sgv[e] << 16), g1 = __uint_as_float(sgv[e] & 0xffff0000u);
        const float y0 = sO[row * 132 + part * 32 + cc] * r * P.gnorm[part * 32 + cc] * g0;
        const float y1 = sO[row * 132 + part * 32 + cc + 1] * r * P.gnorm[part * 32 + cc + 1] * g1;
        w[e] = pack2(y0, y1);
      }
      *(u32x4*)(dst + q4 * 8) = (u32x4){w[0], w[1], w[2], w[3]};
    }
  }
}

__device__ __forceinline__ void stage_kv(u16* sK, u16* sV, const u16* kptr, long kstride, const u16* vptr, long vstride) {
  const int tid = tid_();
  __syncthreads();
#pragma unroll
  for (int i = 0; i < 2; ++i) {
    const int id = tid + 256 * i;
    const int row = id >> 3, ch = id & 7;
    *(u32x4*)&sK[row * 72 + ch * 8] = *(const u32x4*)(kptr + row * kstride + ch * 8);
    *(u32x4*)&sV[row * 72 + ch * 8] = *(const u32x4*)(vptr + row * vstride + ch * 8);
  }
  __syncthreads();
}

__device__ __forceinline__ void qk_scores(const u16* sK, const bf16x8 (&q)[2], f32x4 (&s)[4], int l15, int G) {
#pragma unroll
  for (int kt = 0; kt < 4; ++kt) {
    s[kt] = (f32x4){0.f, 0.f, 0.f, 0.f};
#pragma unroll
    for (int ks = 0; ks < 2; ++ks) s[kt] = MFMA(ld8(&sK[(16 * kt + l15) * 72 + ks * 32 + G * 8]), q[ks], s[kt]);
  }
}

__device__ __forceinline__ void pv_accum(const u16* sV, const f32x4 (&p)[4], f32x4 (&o)[4], int l15, int G) {
#pragma unroll
  for (int ks2 = 0; ks2 < 2; ++ks2) {
    const f32x4 pa = p[2 * ks2], pb = p[2 * ks2 + 1];
    const bf16x8 pf = mk8(pack2(pa[0], pa[1]), pack2(pa[2], pa[3]), pack2(pb[0], pb[1]), pack2(pb[2], pb[3]));
#pragma unroll
    for (int dt = 0; dt < 4; ++dt) {
      const u32x2 v0 = *(const u32x2*)&sV[(16 * dt + l15) * 72 + 32 * ks2 + 4 * G];
      const u32x2 v1 = *(const u32x2*)&sV[(16 * dt + l15) * 72 + 32 * ks2 + 16 + 4 * G];
      o[dt] = MFMA(mk8(v0[0], v0[1], v1[0], v1[1]), pf, o[dt]);
    }
  }
}

#define EX2(x) __builtin_amdgcn_exp2f(x)
typedef __attribute__((ext_vector_type(16))) float f32x16;
#define MFMA32(a, b, c) __builtin_amdgcn_mfma_f32_32x32x16_bf16((a), (b), (c), 0, 0, 0)
template <int MODE, bool EDGE>
__device__ __forceinline__ void nsa_block(const u16* sK, const u16* sV, int jb, int qb, int q, bool blk_ok,
                                          const bf16x8 (&qf)[4], f32x16 (&O)[2], float& m, float& l, int r31, int h) {
  const int lane = h * 32 + r31;
  f32x16 s[2];
#pragma unroll
  for (int kt2 = 0; kt2 < 2; ++kt2) {
#pragma unroll
    for (int e = 0; e < 16; ++e) s[kt2][e] = 0.f;
#pragma unroll
    for (int ks = 0; ks < 4; ++ks) s[kt2] = MFMA32(ld8(&sK[(32 * kt2 + r31) * 72 + 16 * ks + 8 * h]), qf[ks], s[kt2]);
  }
  float smax = -1e30f;
  if (EDGE) {
#pragma unroll
    for (int kt2 = 0; kt2 < 2; ++kt2)
#pragma unroll
      for (int e = 0; e < 16; ++e) {
        const int k = 32 * kt2 + (e & 3) + 8 * (e >> 2) + 4 * h;
        const bool a = blk_ok && ((jb == qb) ? (k <= q) : (k > q));
        if (!a) s[kt2][e] = -1e30f;
        smax = fmaxf(smax, s[kt2][e]);
      }
  } else {
#pragma unroll
    for (int kt2 = 0; kt2 < 2; ++kt2)
#pragma unroll
      for (int e = 0; e < 16; ++e) smax = fmaxf(smax, s[kt2][e]);
    if (MODE == 2 && !blk_ok) smax = -1e30f;
  }
  smax = fmaxf(smax, SHX(smax, 32));
  const float mn = fmaxf(m, smax);
  const bool need = (mn - m) > 8.f;
  if (__builtin_amdgcn_ballot_w64(need) != 0ull) {
    const float alpha = need ? EX2(m - mn) : 1.f;
    m = need ? mn : m;
    l *= alpha;
    O[0] *= alpha;
    O[1] *= alpha;
  }
  const float mref = (!EDGE && MODE == 2 && !blk_ok) ? 1e30f : m;
  float ls = 0.f;
#pragma unroll
  for (int kt2 = 0; kt2 < 2; ++kt2)
#pragma unroll
    for (int e = 0; e < 16; ++e) {
      const float sv = s[kt2][e];
      float pv;
      if (EDGE) pv = (sv > -1e29f) ? EX2(sv - m) : 0.f;
      else pv = EX2(sv - mref);
      s[kt2][e] = pv;
      ls += pv;
    }
  l += ls;
#pragma unroll
  for (int kt2 = 0; kt2 < 2; ++kt2)
#pragma unroll
    for (int st = 0; st < 2; ++st) {
      const bf16x8 pf = mk8(pack2(s[kt2][8 * st + 0], s[kt2][8 * st + 1]), pack2(s[kt2][8 * st + 2], s[kt2][8 * st + 3]),
                            pack2(s[kt2][8 * st + 4], s[kt2][8 * st + 5]), pack2(s[kt2][8 * st + 6], s[kt2][8 * st + 7]));
#pragma unroll
      for (int dt2 = 0; dt2 < 2; ++dt2) {
        const u16* vrow = &sV[(32 * dt2 + r31) * 72 + 32 * kt2 + 16 * st + 4 * h];
        const u32x2 v0 = *(const u32x2*)vrow;
        const u32x2 v1 = *(const u32x2*)(vrow + 8);
        O[dt2] = MFMA32(mk8(v0[0], v0[1], v1[0], v1[1]), pf, O[dt2]);
      }
    }
}

template <int MODE>
__device__ __forceinline__ void nsa_branch(const u16* kbase, const u16* vbase, int jb0, int jb1, int qb, int q,
                                           uint32_t mlo, uint32_t mhi, const bf16x8 (&qf)[4], const float* ngbase, int rowbase, int gidx,
                                           u16* sYl, u16* sm, float pscale = 1.f) {
  const int tid = tid_();
  const int lane = tid & 63;
  const int r31 = lane & 31, h = lane >> 5;
  const int srow = tid >> 3, sch = (tid & 7) * 8;
  f32x16 O[2];
#pragma unroll
  for (int e = 0; e < 16; ++e) { O[0][e] = 0.f; O[1][e] = 0.f; }
  float m = -1e30f, l = 0.f;
  u32x4 kr[2], vr[2];
  const unsigned koff = (unsigned)((srow * 1024 + sch) * 2);
  const unsigned voff = (unsigned)((srow * 4096 + sch) * 2);
  {
    const char* kb = (const char*)kbase + (size_t)jb0 * 131072;
    const char* vb = (const char*)vbase + (size_t)jb0 * 128;
#pragma unroll
    for (int i = 0; i < 2; ++i) {
      kr[i] = *(const u32x4*)(kb + (koff + i * 65536u));
      vr[i] = *(const u32x4*)(vb + (voff + i * 262144u));
    }
  }
  __syncthreads();
#pragma unroll
  for (int i = 0; i < 2; ++i) {
    *(u32x4*)&sm[(srow + 32 * i) * 72 + sch] = kr[i];
    *(u32x4*)&sm[4608 + (srow + 32 * i) * 72 + sch] = vr[i];
  }
  __syncthreads();
  int cur = 0;
  for (int jb = jb0; jb <= jb1; ++jb) {
    const bool more = jb < jb1;
    if (more) {
      const char* kb = (const char*)kbase + (size_t)(jb + 1) * 131072;
      const char* vb = (const char*)vbase + (size_t)(jb + 1) * 128;
#pragma unroll
      for (int i = 0; i < 2; ++i) {
        kr[i] = *(const u32x4*)(kb + (koff + i * 65536u));
        vr[i] = *(const u32x4*)(vb + (voff + i * 262144u));
      }
    }
    const u16* sK = sm + cur * 9216;
    const u16* sV = sK + 4608;
    bool blk_ok = true;
    if (MODE == 2) blk_ok = (jb < 32) ? ((mlo >> jb) & 1u) : ((mhi >> (jb - 32)) & 1u);
    const bool edge = (jb == qb) || (MODE == 3 && jb == qb - 8);
    if (edge) nsa_block<MODE, true>(sK, sV, jb, qb, q, blk_ok, qf, O, m, l, r31, h);
    else nsa_block<MODE, false>(sK, sV, jb, qb, q, blk_ok, qf, O, m, l, r31, h);
    if (more) {
      u16* dK = sm + (cur ^ 1) * 9216;
#pragma unroll
      for (int i = 0; i < 2; ++i) {
        *(u32x4*)&dK[(srow + 32 * i) * 72 + sch] = kr[i];
        *(u32x4*)&dK[4608 + (srow + 32 * i) * 72 + sch] = vr[i];
      }
    }
    __syncthreads();
    cur ^= 1;
  }
  const int tg = tid_();
  const int lg = tg & 63, hh = (lg >> 4) & 1, hg = lg >> 5;
  const float* gatep = (const float*)((const char*)ngbase + (unsigned)(rowbase + 16 * (tg >> 6) + (tg & 15)) * 192u) + gidx + hh;
  float lt = l;
  lt += shx_f(lt, lg ^ 32);
  const float sc = (lt > 0.f) ? (pscale * gatep[0] / lt) : 0.f;
  u16* yrow = sYl + (((tg >> 6) * 2 + hh) * 16 + (tg & 15)) * 64;
#pragma unroll
  for (int dt2 = 0; dt2 < 2; ++dt2)
#pragma unroll
    for (int m4 = 0; m4 < 4; ++m4) {
      u32x2* yp = (u32x2*)(yrow + 32 * dt2 + 8 * m4 + 4 * hg);
      const u32x2 yv = *yp;
      const float y0 = __uint_as_float(yv[0] << 16) + O[dt2][4 * m4 + 0] * sc;
      const float y1 = __uint_as_float(yv[0] & 0xffff0000u) + O[dt2][4 * m4 + 1] * sc;
      const float y2 = __uint_as_float(yv[1] << 16) + O[dt2][4 * m4 + 2] * sc;
      const float y3 = __uint_as_float(yv[1] & 0xffff0000u) + O[dt2][4 * m4 + 3] * sc;
      *yp = (u32x2){pack2(y0, y1), pack2(y2, y3)};
    }
}

__device__ __forceinline__ void pv_cmp(const u16* vc, int jb, const f32x4 (&p)[4], f32x4 (&o)[4], int l15, int G) {
#pragma unroll
  for (int ks2 = 0; ks2 < 2; ++ks2) {
    const f32x4 pa = p[2 * ks2], pb = p[2 * ks2 + 1];
    const bf16x8 pf = mk8(pack2(pa[0], pa[1]), pack2(pa[2], pa[3]), pack2(pb[0], pb[1]), pack2(pb[2], pb[3]));
#pragma unroll
    for (int dt = 0; dt < 4; ++dt) {
      const u16* vp = vc + (long)(16 * dt + l15) * 256 + jb * 64 + 32 * ks2 + 4 * G;
      const u32x2 v0 = *(const u32x2*)vp;
      const u32x2 v1 = *(const u32x2*)(vp + 16);
      o[dt] = MFMA(mk8(v0[0], v0[1], v1[0], v1[1]), pf, o[dt]);
    }
  }
}

__device__ __forceinline__ void nsa_unit(const Params& P, int half, int u, char* smem) {
  char* ws = P.ws;
  const int tid = tid_(), lane = tid & 63, wave = tid >> 6;
  const int l15 = lane & 15, G = lane >> 4;
  const int hp = u >> 9, rest = u & 511;
  const int bl = rest >> 8, g = (rest >> 6) & 3, xq = rest & 63;
  const int qb = hp ? xq : 63 - xq;
  const int q = 16 * wave + l15;
  const int t = qb * 64 + q;
  const int rl = bl * 4096 + t;
  const int rg = half * 8192 + rl;
  const char* NQc = (const char*)(ws + OFF_NQ);
  const unsigned qoff = (unsigned)rg * 2048u;
  u16* sm = (u16*)smem;
  float* sImp = (float*)smem;
  const u16* NQ = (const u16*)(ws + OFF_NQ);
  const u16* NQR = (const u16*)(ws + OFF_NQR);
  const u16* KV = (const u16*)(ws + OFF_KV);
  const u16* VST = (const u16*)(ws + OFF_VST);
  const u16* VWT = (const u16*)(ws + OFF_VWT);
  const u16* KCMP = (const u16*)(ws + OFF_KCMP);
  const u16* VCMPT = (const u16*)(ws + OFF_VCMPT);
  const float* NGATE = (const float*)((const char*)(ws + OFF_NGATE) + (unsigned)rg * 192u);
  u16* YB = (u16*)(ws + (half ? OFF_YB1 : OFF_YB0));

  f32x4 Y[2][4];
#pragma unroll
  for (int rr = 0; rr < 2; ++rr)
#pragma unroll
    for (int dt = 0; dt < 4; ++dt) Y[rr][dt] = (f32x4){0.f, 0.f, 0.f, 0.f};

  uint32_t mlo = 0, mhi = 0;
  u16* sYl = (u16*)(smem + 36864);
  {
    const int nblk = ((4 * qb + 2) >> 6) + 1;
    const u16* kc = KCMP + (long)(bl * 4 + g) * 256 * 64;
    const u16* vc = VCMPT + (long)(bl * 4 + g) * 64 * 256;
    float imp[4][4];
#pragma unroll
    for (int a = 0; a < 4; ++a)
#pragma unroll
      for (int b = 0; b < 4; ++b) imp[a][b] = 0.f;
    __syncthreads();
    for (int id = tid; id < nblk * 512; id += 256) {
      const int row = id >> 3, chn = (id & 7) * 8;
      *(u32x4*)&sm[row * 72 + chn] = *(const u32x4*)(kc + row * 64 + chn);
    }
    __syncthreads();
#pragma unroll 1
    for (int r = 0; r < 4; ++r) {
      bf16x8 qp[2];
#pragma unroll
      for (int ks = 0; ks < 2; ++ks) qp[ks] = *(const bf16x8*)(NQc + (qoff + (unsigned)(((4 * g + r) * 64 + ks * 32 + G * 8) * 2)));
      f32x4 s[4][4];
      float smax = -1e30f;
#pragma unroll
      for (int jb = 0; jb < 4; ++jb) {
#pragma unroll
        for (int kt = 0; kt < 4; ++kt) s[jb][kt] = (f32x4){-1e30f, -1e30f, -1e30f, -1e30f};
        if (jb < nblk) {
#pragma unroll
          for (int kt = 0; kt < 4; ++kt) {
            f32x4 a4 = {0.f, 0.f, 0.f, 0.f};
#pragma unroll
            for (int ks = 0; ks < 2; ++ks)
              a4 = MFMA(ld8(&sm[(jb * 64 + 16 * kt + l15) * 72 + ks * 32 + G * 8]), qp[ks], a4);
#pragma unroll
            for (int e = 0; e < 4; ++e) {
              const int n = jb * 64 + 16 * kt + 4 * G + e;
              const float sv = (16 * n + 31 <= t) ? a4[e] : -1e30f;
              s[jb][kt][e] = sv;
              smax = fmaxf(smax, sv);
            }
          }
        }
      }
      smax = fmaxf(smax, SHX(smax, 16));
      smax = fmaxf(smax, SHX(smax, 32));
      float l = 0.f;
#pragma unroll
      for (int jb = 0; jb < 4; ++jb) {
        if (jb < nblk) {
#pragma unroll
          for (int kt = 0; kt < 4; ++kt)
#pragma unroll
            for (int e = 0; e < 4; ++e) {
              const float sv = s[jb][kt][e];
              const float pv = (sv > -1e29f) ? EX2(sv - smax) : 0.f;
              s[jb][kt][e] = pv;
              l += pv;
            }
        }
      }
      l += SHX(l, 16);
      l += SHX(l, 32);
      const float invl = (l > 0.f) ? 1.f / l : 0.f;
      float prevup = 0.f;
#pragma unroll
      for (int jb = 0; jb < 4; ++jb) {
        if (jb < nblk) {
#pragma unroll
          for (int kt = 0; kt < 4; ++kt) {
            s[jb][kt] *= invl;
            const float sum4 = (s[jb][kt][0] + s[jb][kt][1]) + (s[jb][kt][2] + s[jb][kt][3]);
            const float upv = shx_f(s[jb][kt][3], (lane + 48) & 63);
            const float add = (G > 0) ? upv : prevup;
            imp[jb][kt] += sum4 + add;
            prevup = upv;
          }
          if (r == 2 * hp) pv_cmp(vc, jb, s[jb], Y[0], l15, G);
          else if (r == 2 * hp + 1) pv_cmp(vc, jb, s[jb], Y[1], l15, G);
        }
      }
    }
    {
      const float g0 = NGATE[0 * 16 + 4 * g + 2 * hp], g1 = NGATE[0 * 16 + 4 * g + 2 * hp + 1];
#pragma unroll
      for (int dt = 0; dt < 4; ++dt) {
        *(u32x2*)(sYl + ((wave * 2 + 0) * 16 + l15) * 64 + 16 * dt + 4 * G) = (u32x2){pack2(Y[0][dt][0] * g0, Y[0][dt][1] * g0), pack2(Y[0][dt][2] * g0, Y[0][dt][3] * g0)};
        *(u32x2*)(sYl + ((wave * 2 + 1) * 16 + l15) * 64 + 16 * dt + 4 * G) = (u32x2){pack2(Y[1][dt][0] * g1, Y[1][dt][1] * g1), pack2(Y[1][dt][2] * g1, Y[1][dt][3] * g1)};
      }
    }
    __syncthreads();
    unsigned long long* myKey = (unsigned long long*)sImp + wave * 16 * 65;
    unsigned long long vk[4][4];
#pragma unroll
    for (int jb = 0; jb < 4; ++jb)
#pragma unroll
      for (int kt = 0; kt < 4; ++kt) {
        const int s = 16 * jb + 4 * kt + G;
        vk[jb][kt] = ((unsigned long long)__float_as_uint(imp[jb][kt]) << 6) | (unsigned long long)(63 - s);
        myKey[l15 * 65 + s] = vk[jb][kt];
      }
    __syncthreads();
    const int cur = qb;
    uint32_t blo = 0, bhi = 0;
    if (cur + 1 <= 16) {
#pragma unroll
      for (int jb = 0; jb < 4; ++jb)
#pragma unroll
        for (int kt = 0; kt < 4; ++kt) {
          const int s = 16 * jb + 4 * kt + G;
          if (s <= cur) blo |= (1u << s);
        }
    } else {
      int cnt[4][4];
#pragma unroll
      for (int a = 0; a < 4; ++a)
#pragma unroll
        for (int b = 0; b < 4; ++b) cnt[a][b] = 0;
      for (int sp = 1; sp <= cur - 2; ++sp) {
        const unsigned long long xk = myKey[l15 * 65 + sp];
#pragma unroll
        for (int jb = 0; jb < 4; ++jb)
#pragma unroll
          for (int kt = 0; kt < 4; ++kt) cnt[jb][kt] += (xk > vk[jb][kt]) ? 1 : 0;
      }
#pragma unroll
      for (int jb = 0; jb < 4; ++jb)
#pragma unroll
        for (int kt = 0; kt < 4; ++kt) {
          const int s = 16 * jb + 4 * kt + G;
          const bool sel = (s == 0) || (s == cur) || (s == cur - 1) || (s >= 1 && s <= cur - 2 && cnt[jb][kt] < 13);
          if (sel) { if (s < 32) blo |= (1u << s); else bhi |= (1u << (s - 32)); }
        }
    }
    blo |= SHXU(blo, 16); blo |= SHXU(blo, 32);
    bhi |= SHXU(bhi, 16); bhi |= SHXU(bhi, 32);
    mlo = blo; mhi = bhi;
  }
  {
    const int hh = (lane >> 4) & 1, h5 = lane >> 5;
    const int head = 4 * g + 2 * hp + hh;
    bf16x8 qf[4];
    qf[0] = *(const bf16x8*)((const char*)NQR + ((unsigned)rl * 512u + (unsigned)((head * 16 + 8 * h5) * 2)));
#pragma unroll
    for (int ks = 1; ks < 4; ++ks) qf[ks] = *(const bf16x8*)(NQc + (qoff + (unsigned)((head * 64 + 16 * ks + 8 * h5) * 2)));
    const int head0 = 4 * g + 2 * hp;
    const u16* kbs = KV + (long)bl * 4096 * 1024 + 512 + g * 64;
    const u16* vbs = VST + (long)(bl * 4 + g) * 64 * 4096;
    nsa_branch<2>(kbs, vbs, 0, qb, qb, q, mlo, mhi, qf, (const float*)(ws + OFF_NGATE), half * 8192 + bl * 4096 + qb * 64, 16 + head0, sYl, sm);
    const u16* kbw = KV + (long)bl * 4096 * 1024 + 768 + g * 64;
    const u16* vbw = VWT + (long)(bl * 4 + g) * 64 * 4096;
    const int jw0 = (qb >= 8) ? qb - 8 : 0;
    nsa_branch<3>(kbw, vbw, jw0, qb, qb, q, mlo, mhi, qf, (const float*)(ws + OFF_NGATE), half * 8192 + bl * 4096 + qb * 64, 32 + head0, sYl, sm);
    const int tid2 = tid_();
    const int l2 = tid2 & 63, hh2 = (l2 >> 4) & 1, hg2 = l2 >> 5;
    const unsigned yoff = (unsigned)(bl * 4096 + qb * 64 + 16 * (tid2 >> 6) + (tid2 & 15)) * 2048u;
    const u16* yrow = sYl + (((tid2 >> 6) * 2 + hh2) * 16 + (tid2 & 15)) * 64;
#pragma unroll
    for (int dt2 = 0; dt2 < 2; ++dt2)
#pragma unroll
      for (int m4 = 0; m4 < 4; ++m4) {
        const int d0 = 32 * dt2 + 8 * m4 + 4 * hg2;
        *(u32x2*)((char*)YB + (yoff + (unsigned)(((head0 + hh2) * 64 + d0) * 2))) = *(const u32x2*)(yrow + d0);
      }
  }
}

__device__ __forceinline__ void gemm_tile_wide(const u16* __restrict__ A, long lda, int m0, const u16* __restrict__ Bt, long ldb, int n0, int K,
                                               f32x4 (&acc)[4][8], u16* sA) {
  const int tid = tid_(), lane = tid & 63, wave = tid >> 6;
  const int l15 = lane & 15, G = lane >> 4;
  const int wm = wave >> 1, wn = wave & 1;
  const int lr = tid >> 3, ch = tid & 7;
  u16* sB = sA + 128 * 80;
  const char* Ab = (const char*)A;
  const char* Bb = (const char*)Bt;
  unsigned oa[4], ob[8];
#pragma unroll
  for (int i = 0; i < 4; ++i) oa[i] = (unsigned)(((long)(m0 + lr + 32 * i) * lda + ch * 8) * 2);
#pragma unroll
  for (int i = 0; i < 8; ++i) ob[i] = (unsigned)(((long)(n0 + lr + 32 * i) * ldb + ch * 8) * 2);
  u32x4 ra[4], rb[8];
#pragma unroll
  for (int i = 0; i < 4; ++i) ra[i] = *(const u32x4*)(Ab + oa[i]);
#pragma unroll
  for (int i = 0; i < 8; ++i) rb[i] = *(const u32x4*)(Bb + ob[i]);
  const int nk = K >> 6;
  for (int kt = 0; kt < nk; ++kt) {
#pragma unroll
    for (int i = 0; i < 4; ++i) *(u32x4*)&sA[(lr + 32 * i) * 80 + ch * 8] = ra[i];
#pragma unroll
    for (int i = 0; i < 8; ++i) *(u32x4*)&sB[(lr + 32 * i) * 80 + ch * 8] = rb[i];
    __syncthreads();
    {
      const int kn = (kt + 1 < nk) ? kt + 1 : kt;
      const char* Ak = Ab + (size_t)kn * 128;
      const char* Bk = Bb + (size_t)kn * 128;
#pragma unroll
      for (int i = 0; i < 4; ++i) ra[i] = *(const u32x4*)(Ak + oa[i]);
#pragma unroll
      for (int i = 0; i < 8; ++i) rb[i] = *(const u32x4*)(Bk + ob[i]);
    }
#pragma unroll
    for (int ks = 0; ks < 2; ++ks) {
      bf16x8 af[4];
#pragma unroll
      for (int i = 0; i < 4; ++i) af[i] = ld8(&sA[(wm * 64 + 16 * i + l15) * 80 + ks * 32 + G * 8]);
#pragma unroll
      for (int jh = 0; jh < 2; ++jh) {
        bf16x8 bfr[4];
#pragma unroll
        for (int j = 0; j < 4; ++j) bfr[j] = ld8(&sB[(wn * 128 + 64 * jh + 16 * j + l15) * 80 + ks * 32 + G * 8]);
#pragma unroll
        for (int i = 0; i < 4; ++i)
#pragma unroll
          for (int j = 0; j < 4; ++j) acc[i][4 * jh + j] = MFMA(af[i], bfr[j], acc[i][4 * jh + j]);
      }
    }
    __syncthreads();
  }
}


__device__ __forceinline__ void phase_branch_merge(const Params& P, char* smem) {
  char* ws = P.ws;
  u16* sA = (u16*)smem;
  const u16* YA = (const u16*)(ws + OFF_SG);
  const u16* GATES = (const u16*)P.out;
  u16* MERGED = (u16*)(ws + OFF_MERGED);
  for (int t = bid_(); t < 512; t += gridDim.x) {
    const int nt = t >> 7, mt = t & 127;
    const int m0 = mt * 128, n0 = nt * 256;
    const u16* YBp = (m0 < 8192) ? (const u16*)(ws + OFF_YB0) : ((const u16*)(ws + OFF_YB1) - (long)8192 * 1024);
    f32x4 acc[4][8];
#pragma unroll
    for (int i = 0; i < 4; ++i)
#pragma unroll
      for (int j = 0; j < 8; ++j) acc[i][j] = (f32x4){0.f, 0.f, 0.f, 0.f};
    gemm_tile_wide(YA, 1024, m0, (const u16*)(ws + OFF_WA_T), 1024, n0, 1024, acc, sA);
    {
      const int tc = tid_();
#pragma unroll 4
      for (int k16 = 0; k16 < 16; ++k16) {
        const int id = tc + 256 * k16;
        const int row = id >> 5, cch = (id & 31) * 8;
        *(u32x4*)&sA[row * 264 + cch] = *(const u32x4*)(GATES + (long)(m0 + row) * 2048 + n0 + cch);
      }
    }
    __syncthreads();
    {
      EPI_VARS
#pragma unroll
      for (int i = 0; i < 4; ++i)
#pragma unroll
        for (int j = 0; j < 8; ++j)
#pragma unroll
          for (int e = 0; e < 4; ++e) {
            u16* sp = &sA[(wm * 64 + 16 * i + G * 4 + e) * 264 + wn * 128 + 16 * j + l15];
            *sp = f2bf(bf2f(*sp) * acc[i][j][e]);
            acc[i][j][e] = 0.f;
          }
    }
    __syncthreads();
    {
      const int tc = tid_();
#pragma unroll 4
      for (int k16 = 0; k16 < 16; ++k16) {
        const int id = tc + 256 * k16;
        const int row = id >> 5, cch = (id & 31) * 8;
        *(u32x4*)(MERGED + (long)(m0 + row) * 1024 + n0 + cch) = *(const u32x4*)&sA[row * 264 + cch];
      }
    }
    asm volatile("s_waitcnt vmcnt(0)" ::: "memory");
    __syncthreads();
    gemm_tile_wide(YBp, 1024, m0, (const u16*)(ws + OFF_WB_T), 1024, n0, 1024, acc, sA);
    {
      const int tc = tid_();
#pragma unroll 4
      for (int k16 = 0; k16 < 16; ++k16) {
        const int id = tc + 256 * k16;
        const int row = id >> 5, cch = (id & 31) * 8;
        *(u32x4*)&sA[row * 264 + cch] = *(const u32x4*)(GATES + (long)(m0 + row) * 2048 + 1024 + n0 + cch);
      }
    }
    __syncthreads();
    {
      EPI_VARS
#pragma unroll
      for (int i = 0; i < 4; ++i)
#pragma unroll
        for (int j = 0; j < 8; ++j)
#pragma unroll
          for (int e = 0; e < 4; ++e) {
            u16* sp = &sA[(wm * 64 + 16 * i + G * 4 + e) * 264 + wn * 128 + 16 * j + l15];
            *sp = f2bf(bf2f(*sp) * acc[i][j][e]);
          }
    }
    __syncthreads();
    {
      const int tc = tid_();
#pragma unroll 2
      for (int k16 = 0; k16 < 16; ++k16) {
        const int id = tc + 256 * k16;
        const int row = id >> 5, cch = (id & 31) * 8;
        u16* gp = MERGED + (long)(m0 + row) * 1024 + n0 + cch;
        const u32x4 t1 = *(const u32x4*)gp;
        const u32x4 pb = *(const u32x4*)&sA[row * 264 + cch];
        u32x4 o;
#pragma unroll
        for (int q = 0; q < 4; ++q) {
          const float lo = __uint_as_float(t1[q] << 16) + __uint_as_float(pb[q] << 16);
          const float hi = __uint_as_float(t1[q] & 0xffff0000u) + __uint_as_float(pb[q] & 0xffff0000u);
          o[q] = pack2(lo, hi);
        }
        *(u32x4*)gp = o;
      }
    }
    __syncthreads();
  }
}

template <int EPI>
__device__ __forceinline__ void phase_gemm(const u16* A, int K, const u16* Wt, int N, void* outp, char* smem) {
  u16* sA = (u16*)smem;
  u16* sB = sA + 128 * 80;
  EPI_VARS
  const int ntn = N >> 7;
  for (int t = bid_(); t < 128 * ntn; t += gridDim.x) {
    const int nt = t >> 7, mt = t & 127;
    const int m0 = mt * 128, n0 = nt * 128;
    f32x4 acc[4][4];
    zero_acc(acc);
    gemm_tile<0, 2>(A, K, m0, 16384, Wt, K, n0, N, K, 0, acc, sA, sB);
#pragma unroll
    for (int i = 0; i < 4; ++i)
#pragma unroll
      for (int j = 0; j < 4; ++j) {
        const int col = n0 + wn * 64 + 16 * j + l15;
#pragma unroll
        for (int e = 0; e < 4; ++e) {
          const long row = m0 + wm * 64 + 16 * i + G * 4 + e;
          const float v = acc[i][j][e];
          if (EPI == 0) ((float*)outp)[row * N + col] = v;
          else if (EPI == 2) ((u16*)outp)[row * N + col] = f2bf(v);
          else { const float rl = fmaxf(v, 0.f); ((u16*)outp)[row * N + col] = f2bf(rl * rl); }
        }
      }
  }
}


template <int EPI>
__device__ __forceinline__ void phase_gemm_wide(const u16* A, int K, const u16* Wt, int N, u16* outp, char* smem) {
  u16* sA = (u16*)smem;
  EPI_VARS
  const int ntn = N >> 8;
  for (int t = bid_(); t < 128 * ntn; t += gridDim.x) {
    const int nt = t >> 7, mt = t & 127;
    const int m0 = mt * 128, n0 = nt * 256;
    f32x4 acc[4][8];
#pragma unroll
    for (int i = 0; i < 4; ++i)
#pragma unroll
      for (int j = 0; j < 8; ++j) acc[i][j] = (f32x4){0.f, 0.f, 0.f, 0.f};
    gemm_tile_wide(A, K, m0, Wt, K, n0, K, acc, sA);
#pragma unroll
    for (int i = 0; i < 4; ++i)
#pragma unroll
      for (int j = 0; j < 8; ++j) {
        const int col = n0 + wn * 128 + 16 * j + l15;
#pragma unroll
        for (int e = 0; e < 4; ++e) {
          float v = acc[i][j][e];
          if (EPI == 1) { v = fmaxf(v, 0.f); v = v * v; }
          sA[(wm * 64 + 16 * i + G * 4 + e) * 264 + (col - n0)] = f2bf(v);
        }
      }
    __syncthreads();
    {
      const int tc = tid_();
#pragma unroll 4
      for (int k16 = 0; k16 < 16; ++k16) {
        const int id = tc + 256 * k16;
        const int row = id >> 5, cch = (id & 31) * 8;
        *(u32x4*)(outp + (long)(m0 + row) * N + n0 + cch) = *(const u32x4*)&sA[row * 264 + cch];
      }
    }
    __syncthreads();
  }
}

__device__ __forceinline__ void phase_ple(const Params& P, char* smem) {
  char* ws = P.ws;
  u16* sA = (u16*)smem;
  u16* Z3b = (u16*)(ws + OFF_Z3);
  for (int t = bid_(); t < 512; t += gridDim.x) {
    const int nt = t >> 7, mt = t & 127;
    const int m0 = mt * 128, n0 = nt * 256;
    f32x4 acc[4][8];
#pragma unroll
    for (int i = 0; i < 4; ++i)
#pragma unroll
      for (int j = 0; j < 8; ++j) acc[i][j] = (f32x4){0.f, 0.f, 0.f, 0.f};
    gemm_tile_wide((const u16*)(ws + OFF_PB), 256, m0, (const u16*)(ws + OFF_WPLE_T), 256, n0, 256, acc, sA);
    {
      EPI_VARS
#pragma unroll
      for (int i = 0; i < 4; ++i)
#pragma unroll
        for (int j = 0; j < 8; ++j)
#pragma unroll
          for (int e = 0; e < 4; ++e) {
            sA[(wm * 64 + 16 * i + G * 4 + e) * 264 + wn * 128 + 16 * j + l15] = f2bf(acc[i][j][e]);
            acc[i][j][e] = 0.f;
          }
    }
    __syncthreads();
    {
      const int tc = tid_();
#pragma unroll 4
      for (int k16 = 0; k16 < 16; ++k16) {
        const int id = tc + 256 * k16;
        const int row = id >> 5, cch = (id & 31) * 8;
        *(u32x4*)(Z3b + (long)(m0 + row) * 1024 + n0 + cch) = *(const u32x4*)&sA[row * 264 + cch];
      }
    }
    asm volatile("s_waitcnt vmcnt(0)" ::: "memory");
    __syncthreads();
    gemm_tile_wide((const u16*)(ws + OFF_H2B), 1024, m0, (const u16*)(ws + OFF_WPG_T), 1024, n0, 1024, acc, sA);
    {
      const int tc = tid_();
#pragma unroll 4
      for (int k16 = 0; k16 < 16; ++k16) {
        const int id = tc + 256 * k16;
        const int row = id >> 5, cch = (id & 31) * 8;
        *(u32x4*)&sA[row * 264 + cch] = *(const u32x4*)(Z3b + (long)(m0 + row) * 1024 + n0 + cch);
      }
    }
    __syncthreads();
    {
      EPI_VARS
#pragma unroll
      for (int i = 0; i < 4; ++i)
#pragma unroll
        for (int j = 0; j < 8; ++j)
#pragma unroll
          for (int e = 0; e < 4; ++e) {
            u16* sp = &sA[(wm * 64 + 16 * i + G * 4 + e) * 264 + wn * 128 + 16 * j + l15];
            *sp = f2bf(bf2f(*sp) * sigm(acc[i][j][e]));
          }
    }
    __syncthreads();
    {
      const int tc = tid_();
#pragma unroll 4
      for (int k16 = 0; k16 < 16; ++k16) {
        const int id = tc + 256 * k16;
        const int row = id >> 5, cch = (id & 31) * 8;
        *(u32x4*)(Z3b + (long)(m0 + row) * 1024 + n0 + cch) = *(const u32x4*)&sA[row * 264 + cch];
      }
    }
    __syncthreads();
  }
}

template <int MODE, int ZB>
__device__ __forceinline__ void phase_rownorm(const Params& P, const void* Zv, const float* w, const float* w2, u16* nxt) {
  const int tid = tid_(), lane = tid & 63, wave = tid >> 6;
  float* H = P.out;
  for (int un = bid_(); un < 4096; un += gridDim.x) {
    const long row = (long)un * 4 + wave;
    const float* zr = (const float*)Zv + row * 1024;
    const u16* zh = (const u16*)Zv + row * 1024;
    (void)zr; (void)zh;
    const float* hin = (MODE == 0) ? (P.x + row * 1024) : (H + row * 1024);
    float4 z[4], hv[4];
    float ss = 0.f;
#pragma unroll
    for (int j = 0; j < 4; ++j) {
      if (ZB) {
        const u32x2 zz = *(const u32x2*)(zh + j * 256 + lane * 4);
        z[j] = make_float4(__uint_as_float(zz[0] << 16), __uint_as_float(zz[0] & 0xffff0000u), __uint_as_float(zz[1] << 16), __uint_as_float(zz[1] & 0xffff0000u));
      } else z[j] = *(const float4*)(zr + j * 256 + lane * 4);
      hv[j] = *(const float4*)(hin + j * 256 + lane * 4);
      ss += z[j].x * z[j].x + z[j].y * z[j].y + z[j].z * z[j].z + z[j].w * z[j].w;
    }
#pragma unroll
    for (int o = 32; o >= 1; o >>= 1) ss += SHX(ss, o);
    const float r = rsqrtf(ss * (1.f / 1024.f) + 1e-6f);
    float s2 = 0.f;
#pragma unroll
    for (int j = 0; j < 4; ++j) {
      const float4 wv = *(const float4*)(w + j * 256 + lane * 4);
      hv[j].x += z[j].x * r * wv.x; hv[j].y += z[j].y * r * wv.y;
      hv[j].z += z[j].z * r * wv.z; hv[j].w += z[j].w * r * wv.w;
      s2 += hv[j].x * hv[j].x + hv[j].y * hv[j].y + hv[j].z * hv[j].z + hv[j].w * hv[j].w;
      *(float4*)(H + row * 1024 + j * 256 + lane * 4) = hv[j];
    }
    if (MODE == 0) {
#pragma unroll
      for (int o = 32; o >= 1; o >>= 1) s2 += SHX(s2, o);
      const float r2 = rsqrtf(s2 * (1.f / 1024.f) + 1e-6f);
#pragma unroll
      for (int j = 0; j < 4; ++j) {
        const float4 wv = *(const float4*)(w2 + j * 256 + lane * 4);
        u32x2 o2 = {pack2(hv[j].x * r2 * wv.x, hv[j].y * r2 * wv.y), pack2(hv[j].z * r2 * wv.z, hv[j].w * r2 * wv.w)};
        *(u32x2*)(nxt + row * 1024 + j * 256 + lane * 4) = o2;
      }
    } else if (MODE == 1) {
#pragma unroll
      for (int j = 0; j < 4; ++j) {
        u32x2 o2 = {pack2(hv[j].x, hv[j].y), pack2(hv[j].z, hv[j].w)};
        *(u32x2*)(nxt + row * 1024 + j * 256 + lane * 4) = o2;
      }
      const float4 pv = *(const float4*)(P.p + row * 256 + lane * 4);
      u32x2 o2 = {pack2(pv.x, pv.y), pack2(pv.z, pv.w)};
      *(u32x2*)((u16*)(P.ws + OFF_PB) + row * 256 + lane * 4) = o2;
    }
  }
}

#define XB_TMO      128
#define XB_XCNT(j)  (256  + 64 * (j))
#define XB_XSUB(j)  (1280 + 64 * (j))
#define XB_XGEN(j)  (2304 + 64 * (j))
#define XB_TOP      3328
#define XB_TOPGEN   3392
#define XCD_BAR_WORDS 3456
#define XB_SPIN_CAP (1u << 18)
#define LAS __attribute__((address_space(3)))

__device__ __forceinline__ unsigned xb_ld(unsigned* p)              { return __hip_atomic_load(p, __ATOMIC_RELAXED, __HIP_MEMORY_SCOPE_AGENT); }
__device__ __forceinline__ unsigned xb_add(unsigned* p, unsigned v) { return __hip_atomic_fetch_add(p, v, __ATOMIC_RELAXED, __HIP_MEMORY_SCOPE_AGENT); }
__device__ __forceinline__ unsigned xb_xcc_id() { return (unsigned)__builtin_amdgcn_s_getreg((3 << 11) | 20) & 0xFu; }
#define XB_SPIN(cond, bar) do { unsigned _sp = 0; while (cond) { __builtin_amdgcn_s_sleep(1); \
    if ((++_sp & 255u) == 0u) { if (xb_ld(&(bar)[XB_TMO])) break; if (_sp > XB_SPIN_CAP) { atomicAdd(&(bar)[XB_TMO], 1u); break; } } } } while (0)

struct XcdBarrier {
    unsigned* bar; unsigned x;
    volatile LAS unsigned* st;
};

__device__ __forceinline__ XcdBarrier xcd_barrier_post(unsigned* bar, volatile LAS unsigned* st) {
    XcdBarrier b; b.bar = bar; b.x = xb_xcc_id(); b.st = st;
    if (tid_() == 0) (void)xb_add(&bar[XB_XCNT(b.x)], 1u);
    return b;
}
__device__ __forceinline__ void xcd_barrier_complete(unsigned* bar, unsigned x, unsigned& nloc, unsigned& nx) {
    const unsigned G = gridDim.x * gridDim.y * gridDim.z;
    unsigned sum, cnt, mine, sp = 0u;
    for (;;) {
        sum = 0u; cnt = 0u; mine = 0u;
#pragma unroll
        for (unsigned j = 0; j < 16; ++j) { const unsigned c = xb_ld(&bar[XB_XCNT(j)]); sum += c; cnt += (c > 0u) ? 1u : 0u; mine = (j == x) ? c : mine; }
        if (sum == G) break;
        __builtin_amdgcn_s_sleep(1);
        if ((++sp & 255u) == 0u) { if (xb_ld(&bar[XB_TMO])) break; if (sp > XB_SPIN_CAP) { atomicAdd(&bar[XB_TMO], 1u); break; } }
    }
    nloc = mine > 0u ? mine : 1u; nx = cnt > 0u ? cnt : 1u;
}

__device__ __forceinline__ void xcd_barrier(const XcdBarrier& b) {
    asm volatile("s_waitcnt vmcnt(0)" ::: "memory");
    __syncthreads();
    if (tid_() == 0) {
        unsigned* bar = b.bar;
        __builtin_amdgcn_s_waitcnt(0);
        unsigned nloc = b.st[0], nx = b.st[1];
        if (nloc == 0u) { xcd_barrier_complete(bar, b.x, nloc, nx); b.st[0] = nloc; b.st[1] = nx; }
        const unsigned old = xb_add(&bar[XB_XSUB(b.x)], 1u);
        const unsigned gen = old / nloc;
        if (old + 1u == (gen + 1u) * nloc) {
            __builtin_amdgcn_fence(__ATOMIC_RELEASE, "agent");
            asm volatile("s_waitcnt vmcnt(0)" ::: "memory");
            const unsigned og = xb_add(&bar[XB_TOP], 1u);
            const unsigned tg = og / nx;
            if (og + 1u == (tg + 1u) * nx) xb_add(&bar[XB_TOPGEN], 1u);
            else XB_SPIN(xb_ld(&bar[XB_TOPGEN]) == tg, bar);
            __builtin_amdgcn_fence(__ATOMIC_ACQUIRE, "agent");
            xb_add(&bar[XB_XGEN(b.x)], 1u);
            asm volatile("s_waitcnt vmcnt(0)" ::: "memory");
        } else {
            XB_SPIN(xb_ld(&bar[XB_XGEN(b.x)]) == gen, bar);
            __builtin_amdgcn_fence(__ATOMIC_ACQUIRE, "agent");
            asm volatile("s_waitcnt vmcnt(0)" ::: "memory");
        }
    }
    __syncthreads();
}

#define OFF_BAR (252 * MIB)
#define GSYNC() do { XcdBarrier xb_; xb_.bar = (unsigned*)(P.ws + OFF_BAR); xb_.x = xb_xcc_id(); xb_.st = (volatile LAS unsigned*)&xb_words; xcd_barrier(xb_); } while (0)
__global__ void __launch_bounds__(256, 2) k_mega(Params P) {
  __shared__ __attribute__((aligned(16))) char smem[67584];
  char* ws = P.ws;
  __shared__ uint4 xb_words;
  if (tid_() == 0) xb_words = make_uint4(0u, 0u, 0u, 0u);
  __syncthreads();
  (void)xcd_barrier_post((unsigned*)(ws + OFF_BAR), (volatile LAS unsigned*)&xb_words);
  phase_prep(P, smem);
  GSYNC();
#pragma unroll 1
  for (int half = 0; half < 2; ++half) {
    phase_inproj(P, half, smem);
    GSYNC();
#if PROBE_DUP == 1
    phase_inproj(P, half, smem);
    GSYNC();
#endif
    if ((int)gridDim.x > 128) {
      const int b2 = bid_();
      if (b2 < 64) cmp_gemm1_tile(P, b2, smem);
      else for (int u = b2 - 64; u < 1024; u += (int)gridDim.x - 64) hgrn_intra_unit(P, u, smem);
    } else {
      for (int t = bid_(); t < 64; t += gridDim.x) cmp_gemm1_tile(P, t, smem);
      for (int u = bid_(); u < 1024; u += gridDim.x) hgrn_intra_unit(P, u, smem);
    }
    GSYNC();
    for (int t = bid_(); t < 32; t += gridDim.x) cmp_gemm2_tile(P, t, smem);
    hgrn_scan(P);
    if (half == 1) phase_late_weights(P, smem);
    GSYNC();
#if PROBE_DUP == 2
    for (int u = bid_(); u < 1024; u += gridDim.x) nsa_unit(P, half, u, smem);
    GSYNC();
#endif
    for (int u = bid_(); u < 1024; u += gridDim.x) nsa_unit(P, half, u, smem);
    for (int u = bid_(); u < 1024; u += gridDim.x) hgrn_out_unit(P, half, u, smem);
    GSYNC();
  }
  phase_branch_merge(P, smem);
  GSYNC();
#if PROBE_DUP == 3
  phase_branch_merge(P, smem);
  GSYNC();
  phase_gemm<2>((const u16*)(ws + OFF_MERGED), 1024, (const u16*)(ws + OFF_WOUT_T), 1024, ws + OFF_Z1, smem);
  GSYNC();
#endif
  phase_gemm_wide<2>((const u16*)(ws + OFF_MERGED), 1024, (const u16*)(ws + OFF_WOUT_T), 1024, (u16*)(ws + OFF_Z1), smem);
  GSYNC();
  phase_rownorm<0, 1>(P, (const void*)(ws + OFF_Z1), P.n_post_mix, P.n_pre_mlp, (u16*)(ws + OFF_V));
  GSYNC();
#if PROBE_DUP == 4
  phase_gemm<1>((const u16*)(ws + OFF_V), 1024, (const u16*)(ws + OFF_WUP_T), 4096, ws + OFF_FFH, smem);
  GSYNC();
#endif
  phase_gemm_wide<1>((const u16*)(ws + OFF_V), 1024, (const u16*)(ws + OFF_WUP_T), 4096, (u16*)(ws + OFF_FFH), smem);
  GSYNC();
#if PROBE_DUP == 4
  phase_gemm<2>((const u16*)(ws + OFF_FFH), 4096, (const u16*)(ws + OFF_WDOWN_T), 1024, ws + OFF_Z2, smem);
  GSYNC();
#endif
  phase_gemm_wide<2>((const u16*)(ws + OFF_FFH), 4096, (const u16*)(ws + OFF_WDOWN_T), 1024, (u16*)(ws + OFF_Z2), smem);
  GSYNC();
  phase_rownorm<1, 1>(P, (const void*)(ws + OFF_Z2), P.n_post_mlp, nullptr, (u16*)(ws + OFF_H2B));
  GSYNC();
  phase_ple(P, smem);
  GSYNC();
#if PROBE_DUP == 5
  for (int i = 0; i < 10; ++i) GSYNC();
#endif
#if PROBE_DUP == 6
  phase_prep(P, smem);
  GSYNC();
#endif
  phase_rownorm<2, 1>(P, (const void*)(P.ws + OFF_Z3), P.n_ple, nullptr, nullptr);
}

extern "C" void kernel_launch(void* const* d_in, const int* in_sizes, int n_in, void* d_out, int out_size, void* d_ws,
                              size_t ws_size, hipStream_t stream) {
  Params P{};
  P.x = (const float*)d_in[0];
  P.p = (const float*)d_in[1];
  P.w_in = (const float*)d_in[2];
  P.w_a = (const float*)d_in[3];
  P.w_b = (const float*)d_in[4];
  P.w_out = (const float*)d_in[5];
  P.n_pre_mix = (const float*)d_in[6];
  P.n_post_mix = (const float*)d_in[7];
  P.n_pre_mlp = (const float*)d_in[8];
  P.n_post_mlp = (const float*)d_in[9];
  P.lb_logits = (const float*)d_in[10];
  P.gnorm = (const float*)d_in[11];
  P.pe_k = (const float*)d_in[12];
  P.pe_v = (const float*)d_in[13];
  P.wk1 = (const float*)d_in[14];
  P.wk2 = (const float*)d_in[15];
  P.wv1 = (const float*)d_in[16];
  P.wv2 = (const float*)d_in[17];
  P.w_up = (const float*)d_in[18];
  P.w_down = (const float*)d_in[19];
  P.w_ple = (const float*)d_in[20];
  P.w_pg = (const float*)d_in[21];
  P.n_ple = (const float*)d_in[22];
  P.out = (float*)d_out;
  P.ws = (char*)d_ws;
#if MEGA
  static int grid_blocks = 0;
  if (!grid_blocks) {
    int dev = 0, cus = 0, per_cu = 0;
    hipGetDevice(&dev);
    hipDeviceGetAttribute(&cus, hipDeviceAttributeMultiprocessorCount, dev);
    hipOccupancyMaxActiveBlocksPerMultiprocessor(&per_cu, k_mega, 256, 0);
    if (per_cu > 2) per_cu = 2;
    if (per_cu < 1) per_cu = 1;
    grid_blocks = cus * per_cu;
  }
  hipMemsetAsync((char*)d_ws + OFF_BAR, 0, XCD_BAR_WORDS * sizeof(unsigned), stream);
  void* args[] = {&P};
  hipError_t e = hipLaunchCooperativeKernel((void*)k_mega, dim3(grid_blocks), dim3(256), args, 0, stream);
  if (e != hipSuccess) fprintf(stderr, "cooperative launch failed: %s (grid %d)\n", hipGetErrorString(e), grid_blocks);
#endif
}
```

```cpp
#include <hip/hip_runtime.h>
#include <hip/hip_cooperative_groups.h>
#include <cstdio>
#include <cstdint>
namespace cg = cooperative_groups;

#ifndef MEGA
#define MEGA 1
#endif
#ifndef PROBE_DUP
#define PROBE_DUP 0
#endif

typedef unsigned short u16;
typedef __attribute__((ext_vector_type(8))) short bf16x8;
typedef __attribute__((ext_vector_type(4))) float f32x4;
typedef __attribute__((ext_vector_type(4))) unsigned u32x4;
typedef __attribute__((ext_vector_type(2))) unsigned u32x2;

#define MFMA(a, b, c) __builtin_amdgcn_mfma_f32_16x16x32_bf16(a, b, c, 0, 0, 0)
#define MIB ((size_t)1 << 20)

#define OFF_U       (0 * MIB)
#define OFF_YB0     (0 * MIB)
#define OFF_WA_T    (16 * MIB)
#define OFF_WB_T    (18 * MIB)
#define OFF_WOUT_T  (20 * MIB)
#define OFF_WPG_T   (22 * MIB)
#define OFF_WPLE_T  (24 * MIB)
#define OFF_WIN_T   (32 * MIB)
#define OFF_WUP_T   (32 * MIB)
#define OFF_WDOWN_T (40 * MIB)
#define OFF_WK1T    (50 * MIB)
#define OFF_WV1T    (51 * MIB)
#define OFF_WK2T    (52 * MIB)
#define OFF_WV2T    (52 * MIB + 32768)
#define OFF_ROPE    (52 * MIB + 65536)
#define OFF_BIAS1   (52 * MIB + 65536 + 262144)
#define OFF_LB      (52 * MIB + 65536 + 262144 + 4096)
#define OFF_BIAS1P  (52 * MIB + 65536 + 262144 + 16384)
#define OFF_NGATE   (53 * MIB)
#define OFF_SG      (56 * MIB)
#define OFF_NQ      (88 * MIB)
#define OFF_QF      (120 * MIB)
#define OFF_LOGF    (136 * MIB)
#define OFF_YB1     (136 * MIB)
#define OFF_HVT     (152 * MIB)
#define OFF_ABUF    (168 * MIB)
#define OFF_UST     (176 * MIB)
#define OFF_KV      (208 * MIB)
#define OFF_NQR     (224 * MIB)
#define OFF_VST     (228 * MIB)
#define OFF_VWT     (232 * MIB)
#define OFF_DCY     (236 * MIB)
#define OFF_HIDK    (236 * MIB + 524288)
#define OFF_HIDV    (237 * MIB + 524288)
#define OFF_KCMP    (238 * MIB + 524288)
#define OFF_VCMPT   (238 * MIB + 524288 + 262144)
#define OFF_MERGED  (88 * MIB)
#define OFF_Z1      (152 * MIB)
#define OFF_V       (56 * MIB)
#define OFF_FFH     (120 * MIB)
#define OFF_Z2      (56 * MIB)
#define OFF_H2B     (120 * MIB)
#define OFF_PB      (152 * MIB)
#define OFF_Z3      (160 * MIB)

struct Params {
  const float *x, *p, *w_in, *w_a, *w_b, *w_out, *n_pre_mix, *n_post_mix, *n_pre_mlp, *n_post_mlp;
  const float *lb_logits, *gnorm, *pe_k, *pe_v, *wk1, *wk2, *wv1, *wv2, *w_up, *w_down, *w_ple, *w_pg, *n_ple;
  float* out;
  char* ws;
};

__device__ __forceinline__ int bid_() { int b = blockIdx.x; asm volatile("" : "+s"(b)); return b; }
__device__ __forceinline__ int tid_() { int t = threadIdx.x; asm volatile("" : "+v"(t)); return t; }
typedef __attribute__((ext_vector_type(2))) float f32x2_t;
typedef __attribute__((ext_vector_type(2))) __bf16 bf16x2_t;
__device__ __forceinline__ uint32_t pack2(float a, float b) {
  f32x2_t v = {a, b};
  return __builtin_bit_cast(uint32_t, __builtin_convertvector(v, bf16x2_t));
}
__device__ __forceinline__ u16 f2bf(float f) { return (u16)(pack2(f, f) & 0xffffu); }
__device__ __forceinline__ float bf2f(u16 h) { return __uint_as_float(((uint32_t)h) << 16); }
__device__ __forceinline__ float shx_f(float v, int src_lane) { return __int_as_float(__builtin_amdgcn_ds_bpermute(src_lane << 2, __float_as_int(v))); }
__device__ __forceinline__ uint32_t shx_u(uint32_t v, int src_lane) { return (uint32_t)__builtin_amdgcn_ds_bpermute(src_lane << 2, (int)v); }
#define SHX(v, m) shx_f((v), lane ^ (m))
#define SHXU(v, m) shx_u((v), lane ^ (m))
__device__ __forceinline__ float sigm(float x) { return __builtin_amdgcn_rcpf(1.f + __expf(-x)); }
__device__ __forceinline__ float siluf(float x) { return x * __builtin_amdgcn_rcpf(1.f + __expf(-x)); }
__device__ __forceinline__ float gelu_tanh(float x) {
  float u = 0.7978845608028654f * (x + 0.044715f * x * x * x);
  float t = 1.f - 2.f * __builtin_amdgcn_rcpf(__expf(2.f * u) + 1.f);
  return 0.5f * x * (1.f + t);
}
__device__ __forceinline__ bf16x8 mk8(uint32_t a, uint32_t b, uint32_t c, uint32_t d) {
  u32x4 v = {a, b, c, d};
  return __builtin_bit_cast(bf16x8, v);
}
__device__ __forceinline__ bf16x8 ld8(const u16* p) { return *(const bf16x8*)p; }

template <int AMODE, int DEEP>
__device__ __forceinline__ void gemm_tile(const u16* __restrict__ A, long lda, int m0, int M,
                                          const u16* __restrict__ Bt, long ldb, int n0, int N, int K,
                                          int coloff, f32x4 (&acc)[4][4], u16* sA, u16* sB) {
  const int tid = tid_(), lane = tid & 63, wave = tid >> 6;
  const int l15 = lane & 15, G = lane >> 4;
  const int wm = wave >> 1, wn = wave & 1;
  const int lr = tid >> 3, ch = tid & 7;
  const char* Ab = (const char*)A;
  const char* Bb = (const char*)Bt;
  unsigned oa[4], ob[4];
  int tok0[4];
#pragma unroll
  for (int i = 0; i < 4; ++i) {
    int r = m0 + lr + 32 * i;
    if (AMODE == 0) {
      if (r > M - 1) r = M - 1;
      oa[i] = (unsigned)(((long)r * lda + ch * 8) * 2);
      tok0[i] = 0;
    } else {
      int grp = r >> 8, n = r & 255;
      int bl = grp >> 2, g = grp & 3;
      tok0[i] = n * 16;
      oa[i] = (unsigned)((bl * 4096 * 1024 + coloff + g * 64 + ch * 8) * 2);
    }
    int rn = n0 + lr + 32 * i;
    if (rn > N - 1) rn = N - 1;
    ob[i] = (unsigned)(((long)rn * ldb + ch * 8) * 2);
  }
#define G_LOAD(RA, RB, KT)                                                                                   \
  {                                                                                                          \
    const char* Ak_ = Ab + (size_t)(KT) * 128;                                                               \
    const char* Bk_ = Bb + (size_t)(KT) * 128;                                                               \
    _Pragma("unroll") for (int i = 0; i < 4; ++i) {                                                          \
      if (AMODE == 0) RA[i] = *(const u32x4*)(Ak_ + oa[i]);                                                  \
      else { int tok = tok0[i] + (KT); if (tok > 4095) tok = 4095; RA[i] = *(const u32x4*)(Ab + (oa[i] + (unsigned)tok * 2048u)); } \
      RB[i] = *(const u32x4*)(Bk_ + ob[i]);                                                                  \
    }                                                                                                        \
  }
#define L_STORE(RA, RB)                                                                                      \
  _Pragma("unroll") for (int i = 0; i < 4; ++i) {                                                            \
    *(u32x4*)&sA[(lr + 32 * i) * 80 + ch * 8] = RA[i];                                                       \
    *(u32x4*)&sB[(lr + 32 * i) * 80 + ch * 8] = RB[i];                                                       \
  }
#define T_COMPUTE()                                                                                          \
  _Pragma("unroll") for (int ks = 0; ks < 2; ++ks) {                                                         \
    bf16x8 af[4], bfr[4];                                                                                    \
    _Pragma("unroll") for (int i = 0; i < 4; ++i) af[i] = ld8(&sA[(wm * 64 + 16 * i + l15) * 80 + ks * 32 + G * 8]);  \
    _Pragma("unroll") for (int j = 0; j < 4; ++j) bfr[j] = ld8(&sB[(wn * 64 + 16 * j + l15) * 80 + ks * 32 + G * 8]); \
    _Pragma("unroll") for (int i = 0; i < 4; ++i)                                                            \
      _Pragma("unroll") for (int j = 0; j < 4; ++j) acc[i][j] = MFMA(af[i], bfr[j], acc[i][j]);              \
  }                                                                                                          \
     \
  __builtin_amdgcn_sched_group_barrier(0x100, 8, 0);                                                         \
  _Pragma("unroll") for (int z = 0; z < 8; ++z) {                                                            \
    __builtin_amdgcn_sched_group_barrier(0x008, 2, 0);                                                       \
    __builtin_amdgcn_sched_group_barrier(0x100, 1, 0);                                                       \
  }                                                                                                          \
  __builtin_amdgcn_sched_group_barrier(0x008, 16, 0);
  const int nk = K >> 6;
  if (DEEP == 2) {
    u32x4 ra0[4], rb0[4], ra1[4], rb1[4];
    const int kl = nk - 1;
    G_LOAD(ra0, rb0, 0);
    G_LOAD(ra1, rb1, 1);
    for (int kt = 0; kt < nk; kt += 2) {
      L_STORE(ra0, rb0);
      __syncthreads();
      G_LOAD(ra0, rb0, (kt + 2 < kl ? kt + 2 : kl));
      T_COMPUTE();
      __syncthreads();
      L_STORE(ra1, rb1);
      __syncthreads();
      G_LOAD(ra1, rb1, (kt + 3 < kl ? kt + 3 : kl));
      T_COMPUTE();
      __syncthreads();
    }
  } else {
    u32x4 ra0[4], rb0[4];
    G_LOAD(ra0, rb0, 0);
    for (int kt = 0; kt < nk; ++kt) {
      L_STORE(ra0, rb0);
      __syncthreads();
      if (kt + 1 < nk) G_LOAD(ra0, rb0, kt + 1);
      T_COMPUTE();
      __syncthreads();
    }
  }
#undef G_LOAD
#undef L_STORE
#undef T_COMPUTE
}

__device__ __forceinline__ void zero_acc(f32x4 (&acc)[4][4]) {
#pragma unroll
  for (int i = 0; i < 4; ++i)
#pragma unroll
    for (int j = 0; j < 4; ++j) acc[i][j] = (f32x4){0.f, 0.f, 0.f, 0.f};
}

#define EPI_VARS                                                         \
  const int tid = tid_(), lane = tid & 63, wave = tid >> 6;         \
  const int l15 = lane & 15, G = lane >> 4;                              \
  const int wm = wave >> 1, wn = wave & 1;                               \
  (void)l15; (void)G; (void)wm; (void)wn;

__device__ __forceinline__ void transpose_tile(const float* __restrict__ W, int ldw, int oc0, int valid, int k0, u16* __restrict__ out,
                               long Kdim, int n0, float* s  ) {
  const int tid = tid_();
  __syncthreads();
  {
    const bool vec = (valid == 64) && (((oc0 | ldw) & 3) == 0);
    if (vec) {
      const int n4 = (tid & 15) * 4;
      float4 v[4];
#pragma unroll
      for (int i = 0; i < 4; ++i) v[i] = *(const float4*)(W + (long)(k0 + (tid >> 4) + 16 * i) * ldw + oc0 + n4);
#pragma unroll
      for (int i = 0; i < 4; ++i) {
        float* d = &s[((tid >> 4) + 16 * i) * 65 + n4];
        d[0] = v[i].x; d[1] = v[i].y; d[2] = v[i].z; d[3] = v[i].w;
      }
    } else {
      const int n = tid & 63;
      for (int kk = tid >> 6; kk < 64; kk += 4) {
        float v = 0.f;
        if (n < valid) v = W[(long)(k0 + kk) * ldw + oc0 + n];
        s[kk * 65 + n] = v;
      }
    }
  }
  __syncthreads();
  {
    const int nn = tid >> 2, kq = (tid & 3) * 16;
    uint32_t w[8];
#pragma unroll
    for (int e = 0; e < 8; ++e) w[e] = pack2(s[(kq + 2 * e) * 65 + nn], s[(kq + 2 * e + 1) * 65 + nn]);
    u16* dst = out + (long)(n0 + nn) * Kdim + k0 + kq;
    *(u32x4*)dst = (u32x4){w[0], w[1], w[2], w[3]};
    *(u32x4*)(dst + 8) = (u32x4){w[4], w[5], w[6], w[7]};
  }
}

__device__ __forceinline__ void transpose_job(const float* W, int N, int K, u16* out, int tile, float* s) {
  const int kt_n = K >> 6;
  const int nt = tile / kt_n, kt = tile % kt_n;
  transpose_tile(W, N, nt * 64, 64, kt * 64, out, K, nt * 64, s);
}

__device__ __forceinline__ void phase_prep(const Params& P, char* smem) {
  const int tid = tid_(), lane = tid & 63, wave = tid >> 6;
  char* ws = P.ws;
  float* sf = (float*)smem;
  {
    u16* U = (u16*)(ws + OFF_U);
    for (int un = bid_(); un < 1024; un += gridDim.x) {
      const int row0 = un * 16 + wave * 4;
      float4 v[4][4];
      float ss[4] = {0.f, 0.f, 0.f, 0.f};
#pragma unroll
      for (int rr = 0; rr < 4; ++rr)
#pragma unroll
        for (int j = 0; j < 4; ++j) v[rr][j] = *(const float4*)(P.x + (long)(row0 + rr) * 1024 + j * 256 + lane * 4);
#pragma unroll
      for (int rr = 0; rr < 4; ++rr) {
#pragma unroll
        for (int j = 0; j < 4; ++j)
          ss[rr] += v[rr][j].x * v[rr][j].x + v[rr][j].y * v[rr][j].y + v[rr][j].z * v[rr][j].z + v[rr][j].w * v[rr][j].w;
#pragma unroll
        for (int o = 32; o >= 1; o >>= 1) ss[rr] += SHX(ss[rr], o);
        const float r = rsqrtf(ss[rr] * (1.f / 1024.f) + 1e-6f);
#pragma unroll
        for (int j = 0; j < 4; ++j) {
          const float4 w = *(const float4*)(P.n_pre_mix + j * 256 + lane * 4);
          u32x2 o2 = {pack2(v[rr][j].x * r * w.x, v[rr][j].y * r * w.y), pack2(v[rr][j].z * r * w.z, v[rr][j].w * r * w.w)};
          *(u32x2*)(U + (long)(row0 + rr) * 1024 + j * 256 + lane * 4) = o2;
        }
      }
    }
  }
  {
    u16* WT = (u16*)(ws + OFF_WIN_T);
    for (int t = bid_(); t < 138 * 16; t += gridDim.x) {
      const int nt = t >> 4, kt = t & 15;
      const int nr0 = nt * 64;
      int oc0, valid;
      if (nr0 < 6656) { oc0 = nr0; valid = 64; }
      else if (nr0 < 8704) { oc0 = nr0 + 48; valid = 64; }
      else if (nr0 == 8704) { oc0 = 6656; valid = 48; }
      else { oc0 = 0; valid = 0; }
      transpose_tile(P.w_in, 8752, oc0, valid, kt * 64, WT, 1024, nr0, sf);
    }
    for (int t = bid_(); t < 128; t += gridDim.x) transpose_job(P.wk1, 256, 2048, (u16*)(ws + OFF_WK1T), t, sf);
    for (int t = bid_(); t < 128; t += gridDim.x) transpose_job(P.wv1, 256, 2048, (u16*)(ws + OFF_WV1T), t, sf);
    for (int t = bid_(); t < 4; t += gridDim.x) transpose_job(P.wk2, 64, 256, (u16*)(ws + OFF_WK2T), t, sf);
    for (int t = bid_(); t < 4; t += gridDim.x) transpose_job(P.wv2, 64, 256, (u16*)(ws + OFF_WV2T), t, sf);
  }
  {
    float2* RT = (float2*)(ws + OFF_ROPE);
    for (int un = bid_(); un < 128; un += gridDim.x) {
      const int idx = un * 256 + tid;
      const int t = idx >> 3, j = idx & 7;
      const float inv = (j == 0) ? 1.0f : (j == 1) ? 0.1939227432012558f : (j == 2) ? 0.03760603070259094f
                      : (j == 3) ? 0.007292664609849453f : (j == 4) ? 0.0014142135623842478f
                      : (j == 5) ? 0.00027424818836152554f : (j == 6) ? 5.3182957344688475e-05f : 1.0313385246263351e-05f;
      const float ang = (float)t * inv;
      const double ad = (double)ang;
      const double kq = rint(ad * 0.15915494309189535);
      const float rr = (float)(ad - kq * 6.283185307179586);
      float sn, cs;
      sincosf(rr, &sn, &cs);
      RT[idx] = make_float2(cs, sn);
    }
  }
  {
    float* B1P = (float*)(ws + OFF_BIAS1P);
    for (int un = bid_(); un < 16; un += gridDim.x) {
      const int kvi = un >> 3, part = un & 7;
      const float* pe = kvi ? P.pe_v : P.pe_k;
      const float* w1 = kvi ? P.wv1 : P.wk1;
      float4 a = make_float4(0.f, 0.f, 0.f, 0.f);
      const int k0 = part * 256 + wave * 64;
#pragma unroll 8
      for (int k = k0; k < k0 + 64; ++k) {
        const float pv = pe[k];
        const float4 w = *(const float4*)(w1 + (long)k * 256 + lane * 4);
        a.x += pv * w.x; a.y += pv * w.y; a.z += pv * w.z; a.w += pv * w.w;
      }
      __syncthreads();
      *(float4*)&sf[wave * 256 + lane * 4] = a;
      __syncthreads();
      B1P[un * 256 + tid] = sf[tid] + sf[256 + tid] + sf[512 + tid] + sf[768 + tid];
      __syncthreads();
    }
  }
  {
    float* LB = (float*)(ws + OFF_LB);
    for (int un = bid_(); un < 4; un += gridDim.x) {
      const int c = un * 256 + tid;
      const float l0 = P.lb_logits[c], l1 = P.lb_logits[1024 + c];
      LB[c] = 1.f / (1.f + expf(l1 - l0));
    }
  }
}

__device__ __forceinline__ void phase_late_weights(const Params& P, char* smem) {
  char* ws = P.ws;
  float* sf = (float*)smem;
  for (int t = bid_(); t < 256; t += gridDim.x) transpose_job(P.w_a, 1024, 1024, (u16*)(ws + OFF_WA_T), t, sf);
  for (int t = bid_(); t < 256; t += gridDim.x) transpose_job(P.w_b, 1024, 1024, (u16*)(ws + OFF_WB_T), t, sf);
  for (int t = bid_(); t < 256; t += gridDim.x) transpose_job(P.w_out, 1024, 1024, (u16*)(ws + OFF_WOUT_T), t, sf);
  for (int t = bid_(); t < 256; t += gridDim.x) transpose_job(P.w_pg, 1024, 1024, (u16*)(ws + OFF_WPG_T), t, sf);
  for (int t = bid_(); t < 1024; t += gridDim.x) transpose_job(P.w_up, 4096, 1024, (u16*)(ws + OFF_WUP_T), t, sf);
  for (int t = bid_(); t < 1024; t += gridDim.x) transpose_job(P.w_down, 1024, 4096, (u16*)(ws + OFF_WDOWN_T), t, sf);
  for (int t = bid_(); t < 64; t += gridDim.x) transpose_job(P.w_ple, 1024, 256, (u16*)(ws + OFF_WPLE_T), t, sf);
}

__device__ __forceinline__ void phase_inproj(const Params& P, int half, char* smem) {
  char* ws = P.ws;
  u16* sA = (u16*)smem;
  u16* sB = sA + 128 * 80;
  float* sF = (float*)smem;
  const u16* U = (const u16*)(ws + OFF_U) + (long)half * 8192 * 1024;
  const u16* WT = (const u16*)(ws + OFF_WIN_T);
  u16* QF = (u16*)(ws + OFF_QF);
  u16* LOGF = (u16*)(ws + OFF_LOGF);
  u16* HVT = (u16*)(ws + OFF_HVT);
  u16* SG = (u16*)(ws + OFF_SG) + (long)half * 8192 * 1024;
  u16* NQ = (u16*)(ws + OFF_NQ) + (long)half * 8192 * 1024;
  u16* NQR = (u16*)(ws + OFF_NQR);
  u16* KV = (u16*)(ws + OFF_KV);
  u16* VST = (u16*)(ws + OFF_VST);
  u16* VWT = (u16*)(ws + OFF_VWT);
  u16* GATES = (u16*)P.out + (long)half * 8192 * 2048;
  float* NGATE = (float*)(ws + OFF_NGATE) + (long)half * 8192 * 48;
  const float* RTf = (const float*)(ws + OFF_ROPE);
  const float* LB = (const float*)(ws + OFF_LB);
  for (int t = bid_(); t < 64 * 69; t += gridDim.x) {
    const int nt = t >> 6, mt = t & 63;
    const int m0 = mt * 128, n0 = nt * 128;
    f32x4 acc[4][4];
    zero_acc(acc);
    gemm_tile<0, 2>(U, 1024, m0, 8192, WT, 1024, n0, 8832, 1024, 0, acc, sA, sB);
    {
      EPI_VARS
#pragma unroll
      for (int i = 0; i < 4; ++i)
#pragma unroll
        for (int j = 0; j < 4; ++j)
#pragma unroll
          for (int e = 0; e < 4; ++e) sF[(wm * 64 + 16 * i + G * 4 + e) * 132 + wn * 64 + 16 * j + l15] = acc[i][j][e];
    }
    __syncthreads();
    const int tc = tid_();
    int kind = 0, op = 0, dstride = 1024, dcol = 0;
    u16* dbase = nullptr;
    u16* tbase = nullptr;
    if (nt < 8) { dbase = QF; dcol = n0; op = 0; }
    else if (nt < 16) { dbase = LOGF; dcol = n0 - 1024; op = 1; }
    else if (nt < 24) { kind = 1; tbase = HVT; }
    else if (nt < 32) { dbase = SG; dcol = n0 - 3072; op = 2; }
    else if (nt < 40) { dbase = NQ; dcol = n0 - 4096; op = 3; }
    else if (nt < 52) {
      const int c0 = n0 - 5120, sub0 = c0 >> 8;
      if (sub0 == 3 || sub0 == 5) { kind = 2; tbase = (sub0 == 3) ? VST : VWT; }
      else { dbase = KV; dcol = ((sub0 == 0) ? 0 : (sub0 == 1) ? 256 : (sub0 == 2) ? 512 : 768) + (c0 & 255); op = (sub0 >= 2) ? 5 : 4; }
    } else if (nt < 68) { dbase = GATES; dstride = 2048; dcol = n0 - 6656; op = 6; }
    else kind = 3;

    if (kind == 0) {
#pragma unroll 4
      for (int k8 = 0; k8 < 8; ++k8) {
        const int id = tc + 256 * k8;
        const int row = id >> 4, c8 = (id & 15) * 8;
        const float4 f0 = *(const float4*)&sF[row * 132 + c8];
        const float4 f1 = *(const float4*)&sF[row * 132 + c8 + 4];
        float v[8] = {f0.x, f0.y, f0.z, f0.w, f1.x, f1.y, f1.z, f1.w};
        const int hc = c8 & 63;
        if (op == 0) {
#pragma unroll
          for (int q = 0; q < 8; ++q) v[q] = siluf(v[q]) * 0.08838834764831845f;
        } else if (op == 1) {
          const float4 l0 = *(const float4*)(LB + dcol + c8);
          const float4 l1 = *(const float4*)(LB + dcol + c8 + 4);
          const float lb[8] = {l0.x, l0.y, l0.z, l0.w, l1.x, l1.y, l1.z, l1.w};
#pragma unroll
          for (int q = 0; q < 8; ++q) v[q] = __logf(lb[q] + (1.f - lb[q]) * sigm(v[q]));
        } else if (op == 2) {
#pragma unroll
          for (int q = 0; q < 8; ++q) v[q] = siluf(v[q]);
        } else if (op == 3) {
#pragma unroll
          for (int q = 0; q < 8; ++q) v[q] *= 0.18033688011112042f;
        } else if (op == 6) {
#pragma unroll
          for (int q = 0; q < 8; ++q) v[q] = sigm(v[q]);
        }
        if ((op == 3 || op == 5) && hc < 16) {
          const int pc = (hc == 0) ? c8 + 8 : c8 - 8;
          const float4 g0 = *(const float4*)&sF[row * 132 + pc];
          const float4 g1 = *(const float4*)&sF[row * 132 + pc + 4];
          float pr[8] = {g0.x, g0.y, g0.z, g0.w, g1.x, g1.y, g1.z, g1.w};
          if (op == 3) {
#pragma unroll
            for (int q = 0; q < 8; ++q) pr[q] *= 0.18033688011112042f;
          }
          const int tt = (m0 + row) & 4095;
          const float4 r0 = *(const float4*)(RTf + tt * 16);
          const float4 r1 = *(const float4*)(RTf + tt * 16 + 4);
          const float4 r2 = *(const float4*)(RTf + tt * 16 + 8);
          const float4 r3 = *(const float4*)(RTf + tt * 16 + 12);
          const float cs[8] = {r0.x, r0.z, r1.x, r1.z, r2.x, r2.z, r3.x, r3.z};
          const float sn[8] = {r0.y, r0.w, r1.y, r1.w, r2.y, r2.w, r3.y, r3.w};
          float ro[8];
#pragma unroll
          for (int q = 0; q < 8; ++q) ro[q] = (hc == 0) ? (v[q] * cs[q] - pr[q] * sn[q]) : (v[q] * cs[q] + pr[q] * sn[q]);
          if (op == 3) {
            const int head = (dcol + c8) >> 6;
            *(u32x4*)(NQR + (long)(m0 + row) * 256 + head * 16 + hc) =
                (u32x4){pack2(ro[0], ro[1]), pack2(ro[2], ro[3]), pack2(ro[4], ro[5]), pack2(ro[6], ro[7])};
          } else {
#pragma unroll
            for (int q = 0; q < 8; ++q) v[q] = ro[q];
          }
        }
        u32x4 o4;
        if (op == 1) {
          union { _Float16 h[8]; u32x4 u; } cv;
#pragma unroll
          for (int q = 0; q < 8; ++q) cv.h[q] = (_Float16)v[q];
          o4 = cv.u;
        } else {
          o4 = (u32x4){pack2(v[0], v[1]), pack2(v[2], v[3]), pack2(v[4], v[5]), pack2(v[6], v[7])};
        }
        *(u32x4*)(dbase + (long)(m0 + row) * dstride + dcol + c8) = o4;
      }
    } else if (kind == 1 || kind == 2) {
#pragma unroll 4
      for (int k8 = 0; k8 < 8; ++k8) {
        const int id = tc + 256 * k8;
        const int col = id & 127, r8 = (id >> 7) * 8;
        float v[8];
#pragma unroll
        for (int q = 0; q < 8; ++q) v[q] = sF[(r8 + q) * 132 + col];
        const int r = m0 + r8;
        const int bl = r >> 12, tt = r & 4095;
        unsigned off;
        if (kind == 1) {
          const int c = n0 + col - 2048;
          const int h = c >> 7, dv = c & 127;
          off = ((unsigned)(((bl * 8 + h) * 64 + (tt >> 6)) * 128 + dv) * 64u + (unsigned)(tt & 63)) * 2u;
        } else {
          const int cc = (n0 + col - 5120) & 255;
          const int g = cc >> 6, d = cc & 63;
          off = ((unsigned)((bl * 4 + g) * 64 + d) * 4096u + (unsigned)tt) * 2u;
        }
        *(u32x4*)((char*)tbase + off) = (u32x4){pack2(v[0], v[1]), pack2(v[2], v[3]), pack2(v[4], v[5]), pack2(v[6], v[7])};
      }
    } else {
      for (int id = tc; id < 128 * 48; id += 256) {
        const int row = id / 48, c = id - row * 48;
        NGATE[(long)(m0 + row) * 48 + c] = sigm(sF[row * 132 + c]);
      }
    }
    __syncthreads();
  }
}

__device__ __forceinline__ void hgrn_intra_unit(const Params& P, int uu, char* smem) {
  char* ws = P.ws;
  const int tid = tid_(), lane = tid & 63, wave = tid >> 6;
  const int l15 = lane & 15, G = lane >> 4;
  float* sBc = (float*)smem;
  u16* sQ = (u16*)(smem + 64 * 132 * 4);
  const int bl = uu >> 9, h = (uu >> 6) & 7, c = uu & 63;
  const long r0 = (long)bl * 4096 + c * 64;
  u16* QF = (u16*)(ws + OFF_QF);
  const _Float16* LOGF = (const _Float16*)(ws + OFF_LOGF);
  const u16* HVT = (const u16*)(ws + OFF_HVT);
  u16* ABUF = (u16*)(ws + OFF_ABUF);
  u16* UST = (u16*)(ws + OFF_UST);
  float* DCY = (float*)(ws + OFF_DCY);

  __syncthreads();
#pragma unroll
  for (int i = 0; i < 4; ++i) {
    const int id = tid + 256 * i;
    const int row = id >> 4, cc = (id & 15) * 8;
    const u32x4 lf = *(const u32x4*)(LOGF + (r0 + row) * 1024 + h * 128 + cc);
    const _Float16* hp = (const _Float16*)&lf;
#pragma unroll
    for (int e = 0; e < 8; ++e) sBc[row * 132 + cc + e] = (float)hp[e];
    *(u32x4*)&sQ[row * 136 + cc] = *(const u32x4*)(QF + (r0 + row) * 1024 + h * 128 + cc);
  }
  __syncthreads();
  {
    float* sTot = (float*)(smem + 51200);
    const int col = tid & 127, hh = tid >> 7;
    float v[32];
#pragma unroll
    for (int q = 0; q < 32; ++q) v[q] = sBc[(32 * hh + q) * 132 + col];
    float run = 0.f;
#pragma unroll
    for (int q = 0; q < 32; ++q) { run += v[q]; v[q] = run; }
    if (hh == 0) sTot[col] = run;
    __syncthreads();
    const float off = hh ? sTot[col] : 0.f;
#pragma unroll
    for (int q = 0; q < 32; ++q) sBc[(32 * hh + q) * 132 + col] = v[q] + off;
  }
  __syncthreads();
#pragma unroll
  for (int i = 0; i < 4; ++i) {
    const int id = tid + 256 * i;
    const int row = id >> 4, cc = (id & 15) * 8;
    uint32_t w[4];
#pragma unroll
    for (int e = 0; e < 4; ++e) {
      const float q0 = bf2f(sQ[row * 136 + cc + 2 * e]) * __expf(sBc[row * 132 + cc + 2 * e]);
      const float q1 = bf2f(sQ[row * 136 + cc + 2 * e + 1]) * __expf(sBc[row * 132 + cc + 2 * e + 1]);
      w[e] = pack2(q0, q1);
    }
    *(u32x4*)(QF + (r0 + row) * 1024 + h * 128 + cc) = (u32x4){w[0], w[1], w[2], w[3]};
  }
  if (tid < 128) DCY[(long)uu * 128 + tid] = __expf(sBc[63 * 132 + tid]);
  for (int idx = tid; idx < 4096; idx += 256) {
    const int t = idx >> 6, s = idx & 63;
    if ((s >> 4) > (t >> 4)) ABUF[(long)uu * 4096 + idx] = 0;
  }
  for (int ti = wave; ti < 10; ti += 4) {
    int i, j;
    if (ti == 0) { i = 0; j = 0; }
    else if (ti < 3) { i = 1; j = ti - 1; }
    else if (ti < 6) { i = 2; j = ti - 3; }
    else { i = 3; j = ti - 6; }
    f32x4 a4 = {0.f, 0.f, 0.f, 0.f};
    const int t = 16 * i + l15, s = 16 * j + l15;
#pragma unroll
    for (int ks = 0; ks < 4; ++ks) {
      const int dk0 = ks * 32 + G * 8;
      uint32_t aw[4], bw[4];
#pragma unroll
      for (int e2 = 0; e2 < 4; ++e2) {
        float av[2], bv[2];
#pragma unroll
        for (int z = 0; z < 2; ++z) {
          const int dk = dk0 + 2 * e2 + z;
          const float br = sBc[(16 * i) * 132 + dk];
          const float bt = sBc[t * 132 + dk];
          av[z] = bf2f(sQ[t * 136 + dk]) * __expf(bt - br);
          const float bs = sBc[s * 132 + dk];
          const float bp = (s > 0) ? sBc[(s - 1) * 132 + dk] : 0.f;
          const float kk = 1.f - __expf(bs - bp);
          bv[z] = kk * __expf(br - bs);
        }
        aw[e2] = pack2(av[0], av[1]);
        bw[e2] = pack2(bv[0], bv[1]);
      }
      a4 = MFMA(mk8(aw[0], aw[1], aw[2], aw[3]), mk8(bw[0], bw[1], bw[2], bw[3]), a4);
    }
#pragma unroll
    for (int e = 0; e < 4; ++e) {
      const int tr = 16 * i + G * 4 + e, sc = 16 * j + l15;
      const float v = (sc <= tr) ? a4[e] : 0.f;
      ABUF[(long)uu * 4096 + tr * 64 + sc] = f2bf(v);
    }
  }
  {
    f32x4 ua[8][2];
#pragma unroll
    for (int rt = 0; rt < 8; ++rt) { ua[rt][0] = (f32x4){0.f, 0.f, 0.f, 0.f}; ua[rt][1] = (f32x4){0.f, 0.f, 0.f, 0.f}; }
#pragma unroll
    for (int ks = 0; ks < 2; ++ks) {
      bf16x8 bfr[2];
#pragma unroll
      for (int ct = 0; ct < 2; ++ct) {
        const int dk = (2 * wave + ct) * 16 + l15;
        const float blast = sBc[63 * 132 + dk];
        const int s0 = ks * 32 + G * 8;
        float prev = (s0 > 0) ? sBc[(s0 - 1) * 132 + dk] : 0.f;
        uint32_t bw[4];
#pragma unroll
        for (int e2 = 0; e2 < 4; ++e2) {
          const float b0 = sBc[(s0 + 2 * e2) * 132 + dk];
          const float b1 = sBc[(s0 + 2 * e2 + 1) * 132 + dk];
          const float k0 = (1.f - __expf(b0 - prev)) * __expf(blast - b0);
          const float k1 = (1.f - __expf(b1 - b0)) * __expf(blast - b1);
          prev = b1;
          bw[e2] = pack2(k0, k1);
        }
        bfr[ct] = mk8(bw[0], bw[1], bw[2], bw[3]);
      }
#pragma unroll
      for (int rt = 0; rt < 8; ++rt) {
        const int dv = rt * 16 + l15;
        const bf16x8 af = ld8(HVT + ((long)uu * 128 + dv) * 64 + ks * 32 + G * 8);
        ua[rt][0] = MFMA(af, bfr[0], ua[rt][0]);
        ua[rt][1] = MFMA(af, bfr[1], ua[rt][1]);
      }
    }
    u16* sU = (u16*)smem;
    __syncthreads();
#pragma unroll
    for (int rt = 0; rt < 8; ++rt)
#pragma unroll
      for (int ct = 0; ct < 2; ++ct)
#pragma unroll
        for (int e = 0; e < 4; ++e) {
          const int dv = rt * 16 + G * 4 + e, dk = (2 * wave + ct) * 16 + l15;
          sU[dv * 136 + dk] = f2bf(ua[rt][ct][e]);
        }
    __syncthreads();
#pragma unroll 4
    for (int k8 = 0; k8 < 8; ++k8) {
      const int id = tid + 256 * k8;
      const int row = id >> 4, cch = (id & 15) * 8;
      *(u32x4*)(UST + ((long)uu * 128 + row) * 128 + cch) = *(const u32x4*)&sU[row * 136 + cch];
    }
  }
}

__device__ __forceinline__ void cmp_gemm1_tile(const Params& P, int t, char* smem) {
  char* ws = P.ws;
  u16* sA = (u16*)smem;
  u16* sB = sA + 128 * 80;
  EPI_VARS
  const int kv = t >> 5, rem = t & 31;
  const int mt = rem >> 1, nt = rem & 1;
  const int m0 = mt * 128, n0 = nt * 128;
  const u16* KV = (const u16*)(ws + OFF_KV);
  const u16* W1T = (const u16*)(ws + (kv ? OFF_WV1T : OFF_WK1T));
  u16* HID = (u16*)(ws + (kv ? OFF_HIDV : OFF_HIDK));
  const float* B1P = (const float*)(ws + OFF_BIAS1P) + kv * 2048;
  f32x4 acc[4][4];
  zero_acc(acc);
  gemm_tile<1, 2>(KV, 1024, m0, 2048, W1T, 2048, n0, 256, 2048, kv * 256, acc, sA, sB);
#pragma unroll
  for (int i = 0; i < 4; ++i)
#pragma unroll
    for (int j = 0; j < 4; ++j) {
      const int col = n0 + wn * 64 + 16 * j + l15;
      float bias = 0.f;
#pragma unroll
      for (int pp = 0; pp < 8; ++pp) bias += B1P[pp * 256 + col];
#pragma unroll
      for (int e = 0; e < 4; ++e) {
        const int row = m0 + wm * 64 + 16 * i + G * 4 + e;
        HID[(long)row * 256 + col] = f2bf(gelu_tanh(acc[i][j][e] + bias));
      }
    }
}

__device__ __forceinline__ void cmp_gemm2_tile(const Params& P, int t, char* smem) {
  char* ws = P.ws;
  u16* sA = (u16*)smem;
  u16* sB = sA + 128 * 80;
  EPI_VARS
  const int kv = t >> 4, mt = t & 15;
  const int m0 = mt * 128;
  const u16* HID = (const u16*)(ws + (kv ? OFF_HIDV : OFF_HIDK));
  const u16* W2T = (const u16*)(ws + (kv ? OFF_WV2T : OFF_WK2T));
  u16* KCMP = (u16*)(ws + OFF_KCMP);
  u16* VCMPT = (u16*)(ws + OFF_VCMPT);
  f32x4 acc[4][4];
  zero_acc(acc);
  gemm_tile<0, 1>(HID, 256, m0, 2048, W2T, 256, 0, 64, 256, 0, acc, sA, sB);
  if (wn == 0) {
#pragma unroll
    for (int i = 0; i < 4; ++i)
#pragma unroll
      for (int j = 0; j < 4; ++j) {
        const int col = 16 * j + l15;
        const int rbase = m0 + wm * 64 + 16 * i + G * 4;
        if (kv == 0) {
#pragma unroll
          for (int e = 0; e < 4; ++e) KCMP[(long)(rbase + e) * 64 + col] = f2bf(acc[i][j][e]);
        } else {
          const int grp = rbase >> 8, n = rbase & 255;
          u32x2 o2 = {pack2(acc[i][j][0], acc[i][j][1]), pack2(acc[i][j][2], acc[i][j][3])};
          *(u32x2*)(VCMPT + ((long)grp * 64 + col) * 256 + n) = o2;
        }
      }
  }
}

__device__ __forceinline__ void hgrn_scan(const Params& P) {
  char* ws = P.ws;
  u16* UST = (u16*)(ws + OFF_UST);
  const float* DCY = (const float*)(ws + OFF_DCY);
  for (int idx = bid_() * 256 + tid_(); idx < 131072; idx += gridDim.x * 256) {
    const int bh = idx >> 13, rem = idx & 8191;
    const int dv = rem >> 6, dk2 = (rem & 63) * 2;
    float s0 = 0.f, s1 = 0.f;
#pragma unroll 8
    for (int c = 0; c < 64; ++c) {
      const long uu = (long)bh * 64 + c;
      u16* ptr = UST + (uu * 128 + dv) * 128 + dk2;
      const uint32_t uv = *(const uint32_t*)ptr;
      const float2 d = *(const float2*)(DCY + uu * 128 + dk2);
      *(uint32_t*)ptr = pack2(s0, s1);
      s0 = d.x * s0 + __uint_as_float(uv << 16);
      s1 = d.y * s1 + __uint_as_float(uv & 0xffff0000u);
    }
  }
}

__device__ __forceinline__ void hgrn_out_unit(const Params& P, int half, int uu, char* smem) {
  char* ws = P.ws;
  const int tid = tid_(), lane = tid & 63, wave = tid >> 6;
  const int l15 = lane & 15, G = lane >> 4;
  float* sO = (float*)smem;
  const int bl = uu >> 9, h = (uu >> 6) & 7, c = uu & 63;
  const long r0 = (long)bl * 4096 + c * 64;
  const u16* QF = (const u16*)(ws + OFF_QF);
  const u16* HVT = (const u16*)(ws + OFF_HVT);
  const u16* ABUF = (const u16*)(ws + OFF_ABUF);
  const u16* UST = (const u16*)(ws + OFF_UST);
  u16* SG = (u16*)(ws + OFF_SG) + (long)half * 8192 * 1024;
  f32x4 acc[4][2];
#pragma unroll
  for (int i = 0; i < 4; ++i) { acc[i][0] = (f32x4){0.f, 0.f, 0.f, 0.f}; acc[i][1] = (f32x4){0.f, 0.f, 0.f, 0.f}; }
#pragma unroll
  for (int ks = 0; ks < 4; ++ks) {
    const int dk0 = ks * 32 + G * 8;
    bf16x8 bfr[2];
#pragma unroll
    for (int jt = 0; jt < 2; ++jt) bfr[jt] = ld8(UST + ((long)uu * 128 + 32 * wave + 16 * jt + l15) * 128 + dk0);
#pragma unroll
    for (int i = 0; i < 4; ++i) {
      const bf16x8 af = ld8(QF + (r0 + 16 * i + l15) * 1024 + h * 128 + dk0);
      acc[i][0] = MFMA(af, bfr[0], acc[i][0]);
      acc[i][1] = MFMA(af, bfr[1], acc[i][1]);
    }
  }
#pragma unroll
  for (int ks = 0; ks < 2; ++ks) {
    const int s0 = ks * 32 + G * 8;
    bf16x8 bfr[2];
#pragma unroll
    for (int jt = 0; jt < 2; ++jt) bfr[jt] = ld8(HVT + ((long)uu * 128 + 32 * wave + 16 * jt + l15) * 64 + s0);
#pragma unroll
    for (int i = 0; i < 4; ++i) {
      const bf16x8 af = ld8(ABUF + (long)uu * 4096 + (16 * i + l15) * 64 + s0);
      acc[i][0] = MFMA(af, bfr[0], acc[i][0]);
      acc[i][1] = MFMA(af, bfr[1], acc[i][1]);
    }
  }
  __syncthreads();
#pragma unroll
  for (int i = 0; i < 4; ++i)
#pragma unroll
    for (int jt = 0; jt < 2; ++jt)
#pragma unroll
      for (int e = 0; e < 4; ++e) sO[(16 * i + G * 4 + e) * 132 + 32 * wave + 16 * jt + l15] = acc[i][jt][e];
  __syncthreads();
  {
    const int row = tid >> 2, part = tid & 3;
    float ss = 0.f;
#pragma unroll
    for (int cc = 0; cc < 32; ++cc) { const float v = sO[row * 132 + part * 32 + cc]; ss += v * v; }
    ss += SHX(ss, 1);
    ss += SHX(ss, 2);
    const float r = rsqrtf(ss * (1.f / 128.f) + 1e-6f);
    u16* dst = SG + (r0 + row) * 1024 + h * 128 + part * 32;
#pragma unroll
    for (int q4 = 0; q4 < 4; ++q4) {
      const u32x4 sgv = *(const u32x4*)(dst + q4 * 8);
      uint32_t w[4];
#pragma unroll
      for (int e = 0; e < 4; ++e) {
        const int cc = q4 * 8 + 2 * e;
        const float g0 = __uint_as_float(sgv[e] << 16), g1 = __uint_as_float(sgv[e] & 0xffff0000u);
        const float y0 = sO[row * 132 + part * 32 + cc] * r * P.gnorm[part * 32 + cc] * g0;
        const float y1 = sO[row * 132 + part * 32 + cc + 1] * r * P.gnorm[part * 32 + cc + 1] * g1;
        w[e] = pack2(y0, y1);
      }
      *(u32x4*)(dst + q4 * 8) = (u32x4){w[0], w[1], w[2], w[3]};
    }
  }
}

__device__ __forceinline__ void stage_kv(u16* sK, u16* sV, const u16* kptr, long kstride, const u16* vptr, long vstride) {
  const int tid = tid_();
  __syncthreads();
#pragma unroll
  for (int i = 0; i < 2; ++i) {
    const int id = tid + 256 * i;
    const int row = id >> 3, ch = id & 7;
    *(u32x4*)&sK[row * 72 + ch * 8] = *(const u32x4*)(kptr + row * kstride + ch * 8);
    *(u32x4*)&sV[row * 72 + ch * 8] = *(const u32x4*)(vptr + row * vstride + ch * 8);
  }
  __syncthreads();
}

__device__ __forceinline__ void qk_scores(const u16* sK, const bf16x8 (&q)[2], f32x4 (&s)[4], int l15, int G) {
#pragma unroll
  for (int kt = 0; kt < 4; ++kt) {
    s[kt] = (f32x4){0.f, 0.f, 0.f, 0.f};
#pragma unroll
    for (int ks = 0; ks < 2; ++ks) s[kt] = MFMA(ld8(&sK[(16 * kt + l15) * 72 + ks * 32 + G * 8]), q[ks], s[kt]);
  }
}

__device__ __forceinline__ void pv_accum(const u16* sV, const f32x4 (&p)[4], f32x4 (&o)[4], int l15, int G) {
#pragma unroll
  for (int ks2 = 0; ks2 < 2; ++ks2) {
    const f32x4 pa = p[2 * ks2], pb = p[2 * ks2 + 1];
    const bf16x8 pf = mk8(pack2(pa[0], pa[1]), pack2(pa[2], pa[3]), pack2(pb[0], pb[1]), pack2(pb[2], pb[3]));
#pragma unroll
    for (int dt = 0; dt < 4; ++dt) {
      const u32x2 v0 = *(const u32x2*)&sV[(16 * dt + l15) * 72 + 32 * ks2 + 4 * G];
      const u32x2 v1 = *(const u32x2*)&sV[(16 * dt + l15) * 72 + 32 * ks2 + 16 + 4 * G];
      o[dt] = MFMA(mk8(v0[0], v0[1], v1[0], v1[1]), pf, o[dt]);
    }
  }
}

#define EX2(x) __builtin_amdgcn_exp2f(x)
typedef __attribute__((ext_vector_type(16))) float f32x16;
#define MFMA32(a, b, c) __builtin_amdgcn_mfma_f32_32x32x16_bf16((a), (b), (c), 0, 0, 0)
template <int MODE, bool EDGE>
__device__ __forceinline__ void nsa_block(const u16* sK, const u16* sV, int jb, int qb, int q, bool blk_ok,
                                          const bf16x8 (&qf)[4], f32x16 (&O)[2], float& m, float& l, int r31, int h) {
  const int lane = h * 32 + r31;
  f32x16 s[2];
#pragma unroll
  for (int kt2 = 0; kt2 < 2; ++kt2) {
#pragma unroll
    for (int e = 0; e < 16; ++e) s[kt2][e] = 0.f;
#pragma unroll
    for (int ks = 0; ks < 4; ++ks) s[kt2] = MFMA32(ld8(&sK[(32 * kt2 + r31) * 72 + 16 * ks + 8 * h]), qf[ks], s[kt2]);
  }
  float smax = -1e30f;
  if (EDGE) {
#pragma unroll
    for (int kt2 = 0; kt2 < 2; ++kt2)
#pragma unroll
      for (int e = 0; e < 16; ++e) {
        const int k = 32 * kt2 + (e & 3) + 8 * (e >> 2) + 4 * h;
        const bool a = blk_ok && ((jb == qb) ? (k <= q) : (k > q));
        if (!a) s[kt2][e] = -1e30f;
        smax = fmaxf(smax, s[kt2][e]);
      }
  } else {
#pragma unroll
    for (int kt2 = 0; kt2 < 2; ++kt2)
#pragma unroll
      for (int e = 0; e < 16; ++e) smax = fmaxf(smax, s[kt2][e]);
    if (MODE == 2 && !blk_ok) smax = -1e30f;
  }
  smax = fmaxf(smax, SHX(smax, 32));
  const float mn = fmaxf(m, smax);
  const bool need = (mn - m) > 8.f;
  if (__builtin_amdgcn_ballot_w64(need) != 0ull) {
    const float alpha = need ? EX2(m - mn) : 1.f;
    m = need ? mn : m;
    l *= alpha;
    O[0] *= alpha;
    O[1] *= alpha;
  }
  const float mref = (!EDGE && MODE == 2 && !blk_ok) ? 1e30f : m;
  float ls = 0.f;
#pragma unroll
  for (int kt2 = 0; kt2 < 2; ++kt2)
#pragma unroll
    for (int e = 0; e < 16; ++e) {
      const float sv = s[kt2][e];
      float pv;
      if (EDGE) pv = (sv > -1e29f) ? EX2(sv - m) : 0.f;
      else pv = EX2(sv - mref);
      s[kt2][e] = pv;
      ls += pv;
    }
  l += ls;
#pragma unroll
  for (int kt2 = 0; kt2 < 2; ++kt2)
#pragma unroll
    for (int st = 0; st < 2; ++st) {
      const bf16x8 pf = mk8(pack2(s[kt2][8 * st + 0], s[kt2][8 * st + 1]), pack2(s[kt2][8 * st + 2], s[kt2][8 * st + 3]),
                            pack2(s[kt2][8 * st + 4], s[kt2][8 * st + 5]), pack2(s[kt2][8 * st + 6], s[kt2][8 * st + 7]));
#pragma unroll
      for (int dt2 = 0; dt2 < 2; ++dt2) {
        const u16* vrow = &sV[(32 * dt2 + r31) * 72 + 32 * kt2 + 16 * st + 4 * h];
        const u32x2 v0 = *(const u32x2*)vrow;
        const u32x2 v1 = *(const u32x2*)(vrow + 8);
        O[dt2] = MFMA32(mk8(v0[0], v0[1], v1[0], v1[1]), pf, O[dt2]);
      }
    }
}

template <int MODE>
__device__ __forceinline__ void nsa_branch(const u16* kbase, const u16* vbase, int jb0, int jb1, int qb, int q,
                                           uint32_t mlo, uint32_t mhi, const bf16x8 (&qf)[4], const float* ngbase, int rowbase, int gidx,
                                           u16* sYl, u16* sm, float pscale = 1.f) {
  const int tid = tid_();
  const int lane = tid & 63;
  const int r31 = lane & 31, h = lane >> 5;
  const int srow = tid >> 3, sch = (tid & 7) * 8;
  f32x16 O[2];
#pragma unroll
  for (int e = 0; e < 16; ++e) { O[0][e] = 0.f; O[1][e] = 0.f; }
  float m = -1e30f, l = 0.f;
  u32x4 kr[2], vr[2];
  const unsigned koff = (unsigned)((srow * 1024 + sch) * 2);
  const unsigned voff = (unsigned)((srow * 4096 + sch) * 2);
  {
    const char* kb = (const char*)kbase + (size_t)jb0 * 131072;
    const char* vb = (const char*)vbase + (size_t)jb0 * 128;
#pragma unroll
    for (int i = 0; i < 2; ++i) {
      kr[i] = *(const u32x4*)(kb + (koff + i * 65536u));
      vr[i] = *(const u32x4*)(vb + (voff + i * 262144u));
    }
  }
  __syncthreads();
#pragma unroll
  for (int i = 0; i < 2; ++i) {
    *(u32x4*)&sm[(srow + 32 * i) * 72 + sch] = kr[i];
    *(u32x4*)&sm[4608 + (srow + 32 * i) * 72 + sch] = vr[i];
  }
  __syncthreads();
  int cur = 0;
  for (int jb = jb0; jb <= jb1; ++jb) {
    const bool more = jb < jb1;
    if (more) {
      const char* kb = (const char*)kbase + (size_t)(jb + 1) * 131072;
      const char* vb = (const char*)vbase + (size_t)(jb + 1) * 128;
#pragma unroll
      for (int i = 0; i < 2; ++i) {
        kr[i] = *(const u32x4*)(kb + (koff + i * 65536u));
        vr[i] = *(const u32x4*)(vb + (voff + i * 262144u));
      }
    }
    const u16* sK = sm + cur * 9216;
    const u16* sV = sK + 4608;
    bool blk_ok = true;
    if (MODE == 2) blk_ok = (jb < 32) ? ((mlo >> jb) & 1u) : ((mhi >> (jb - 32)) & 1u);
    const bool edge = (jb == qb) || (MODE == 3 && jb == qb - 8);
    if (edge) nsa_block<MODE, true>(sK, sV, jb, qb, q, blk_ok, qf, O, m, l, r31, h);
    else nsa_block<MODE, false>(sK, sV, jb, qb, q, blk_ok, qf, O, m, l, r31, h);
    if (more) {
      u16* dK = sm + (cur ^ 1) * 9216;
#pragma unroll
      for (int i = 0; i < 2; ++i) {
        *(u32x4*)&dK[(srow + 32 * i) * 72 + sch] = kr[i];
        *(u32x4*)&dK[4608 + (srow + 32 * i) * 72 + sch] = vr[i];
      }
    }
    __syncthreads();
    cur ^= 1;
  }
  const int tg = tid_();
  const int lg = tg & 63, hh = (lg >> 4) & 1, hg = lg >> 5;
  const float* gatep = (const float*)((const char*)ngbase + (unsigned)(rowbase + 16 * (tg >> 6) + (tg & 15)) * 192u) + gidx + hh;
  float lt = l;
  lt += shx_f(lt, lg ^ 32);
  const float sc = (lt > 0.f) ? (pscale * gatep[0] / lt) : 0.f;
  u16* yrow = sYl + (((tg >> 6) * 2 + hh) * 16 + (tg & 15)) * 64;
#pragma unroll
  for (int dt2 = 0; dt2 < 2; ++dt2)
#pragma unroll
    for (int m4 = 0; m4 < 4; ++m4) {
      u32x2* yp = (u32x2*)(yrow + 32 * dt2 + 8 * m4 + 4 * hg);
      const u32x2 yv = *yp;
      const float y0 = __uint_as_float(yv[0] << 16) + O[dt2][4 * m4 + 0] * sc;
      const float y1 = __uint_as_float(yv[0] & 0xffff0000u) + O[dt2][4 * m4 + 1] * sc;
      const float y2 = __uint_as_float(yv[1] << 16) + O[dt2][4 * m4 + 2] * sc;
      const float y3 = __uint_as_float(yv[1] & 0xffff0000u) + O[dt2][4 * m4 + 3] * sc;
      *yp = (u32x2){pack2(y0, y1), pack2(y2, y3)};
    }
}

__device__ __forceinline__ void pv_cmp(const u16* vc, int jb, const f32x4 (&p)[4], f32x4 (&o)[4], int l15, int G) {
#pragma unroll
  for (int ks2 = 0; ks2 < 2; ++ks2) {
    const f32x4 pa = p[2 * ks2], pb = p[2 * ks2 + 1];
    const bf16x8 pf = mk8(pack2(pa[0], pa[1]), pack2(pa[2], pa[3]), pack2(pb[0], pb[1]), pack2(pb[2], pb[3]));
#pragma unroll
    for (int dt = 0; dt < 4; ++dt) {
      const u16* vp = vc + (long)(16 * dt + l15) * 256 + jb * 64 + 32 * ks2 + 4 * G;
      const u32x2 v0 = *(const u32x2*)vp;
      const u32x2 v1 = *(const u32x2*)(vp + 16);
      o[dt] = MFMA(mk8(v0[0], v0[1], v1[0], v1[1]), pf, o[dt]);
    }
  }
}

__device__ __forceinline__ void nsa_unit(const Params& P, int half, int u, char* smem) {
  char* ws = P.ws;
  const int tid = tid_(), lane = tid & 63, wave = tid >> 6;
  const int l15 = lane & 15, G = lane >> 4;
  const int hp = u >> 9, rest = u & 511;
  const int bl = rest >> 8, g = (rest >> 6) & 3, xq = rest & 63;
  const int qb = hp ? xq : 63 - xq;
  const int q = 16 * wave + l15;
  const int t = qb * 64 + q;
  const int rl = bl * 4096 + t;
  const int rg = half * 8192 + rl;
  const char* NQc = (const char*)(ws + OFF_NQ);
  const unsigned qoff = (unsigned)rg * 2048u;
  u16* sm = (u16*)smem;
  float* sImp = (float*)smem;
  const u16* NQ = (const u16*)(ws + OFF_NQ);
  const u16* NQR = (const u16*)(ws + OFF_NQR);
  const u16* KV = (const u16*)(ws + OFF_KV);
  const u16* VST = (const u16*)(ws + OFF_VST);
  const u16* VWT = (const u16*)(ws + OFF_VWT);
  const u16* KCMP = (const u16*)(ws + OFF_KCMP);
  const u16* VCMPT = (const u16*)(ws + OFF_VCMPT);
  const float* NGATE = (const float*)((const char*)(ws + OFF_NGATE) + (unsigned)rg * 192u);
  u16* YB = (u16*)(ws + (half ? OFF_YB1 : OFF_YB0));

  f32x4 Y[2][4];
#pragma unroll
  for (int rr = 0; rr < 2; ++rr)
#pragma unroll
    for (int dt = 0; dt < 4; ++dt) Y[rr][dt] = (f32x4){0.f, 0.f, 0.f, 0.f};

  uint32_t mlo = 0, mhi = 0;
  u16* sYl = (u16*)(smem + 36864);
  {
    const int nblk = ((4 * qb + 2) >> 6) + 1;
    const u16* kc = KCMP + (long)(bl * 4 + g) * 256 * 64;
    const u16* vc = VCMPT + (long)(bl * 4 + g) * 64 * 256;
    float imp[4][4];
#pragma unroll
    for (int a = 0; a < 4; ++a)
#pragma unroll
      for (int b = 0; b < 4; ++b) imp[a][b] = 0.f;
    __syncthreads();
    for (int id = tid; id < nblk * 512; id += 256) {
      const int row = id >> 3, chn = (id & 7) * 8;
      *(u32x4*)&sm[row * 72 + chn] = *(const u32x4*)(kc + row * 64 + chn);
    }
    __syncthreads();
#pragma unroll 1
    for (int r = 0; r < 4; ++r) {
      bf16x8 qp[2];
#pragma unroll
      for (int ks = 0; ks < 2; ++ks) qp[ks] = *(const bf16x8*)(NQc + (qoff + (unsigned)(((4 * g + r) * 64 + ks * 32 + G * 8) * 2)));
      f32x4 s[4][4];
      float smax = -1e30f;
#pragma unroll
      for (int jb = 0; jb < 4; ++jb) {
#pragma unroll
        for (int kt = 0; kt < 4; ++kt) s[jb][kt] = (f32x4){-1e30f, -1e30f, -1e30f, -1e30f};
        if (jb < nblk) {
#pragma unroll
          for (int kt = 0; kt < 4; ++kt) {
            f32x4 a4 = {0.f, 0.f, 0.f, 0.f};
#pragma unroll
            for (int ks = 0; ks < 2; ++ks)
              a4 = MFMA(ld8(&sm[(jb * 64 + 16 * kt + l15) * 72 + ks * 32 + G * 8]), qp[ks], a4);
#pragma unroll
            for (int e = 0; e < 4; ++e) {
              const int n = jb * 64 + 16 * kt + 4 * G + e;
              const float sv = (16 * n + 31 <= t) ? a4[e] : -1e30f;
              s[jb][kt][e] = sv;
              smax = fmaxf(smax, sv);
            }
          }
        }
      }
      smax = fmaxf(smax, SHX(smax, 16));
      smax = fmaxf(smax, SHX(smax, 32));
      float l = 0.f;
#pragma unroll
      for (int jb = 0; jb < 4; ++jb) {
        if (jb < nblk) {
#pragma unroll
          for (int kt = 0; kt < 4; ++kt)
#pragma unroll
            for (int e = 0; e < 4; ++e) {
              const float sv = s[jb][kt][e];
              const float pv = (sv > -1e29f) ? EX2(sv - smax) : 0.f;
              s[jb][kt][e] = pv;
              l += pv;
            }
        }
      }
      l += SHX(l, 16);
      l += SHX(l, 32);
      const float invl = (l > 0.f) ? 1.f / l : 0.f;
      float prevup = 0.f;
#pragma unroll
      for (int jb = 0; jb < 4; ++jb) {
        if (jb < nblk) {
#pragma unroll
          for (int kt = 0; kt < 4; ++kt) {
            s[jb][kt] *= invl;
            const float sum4 = (s[jb][kt][0] + s[jb][kt][1]) + (s[jb][kt][2] + s[jb][kt][3]);
            const float upv = shx_f(s[jb][kt][3], (lane + 48) & 63);
            const float add = (G > 0) ? upv : prevup;
            imp[jb][kt] += sum4 + add;
            prevup = upv;
          }
          if (r == 2 * hp) pv_cmp(vc, jb, s[jb], Y[0], l15, G);
          else if (r == 2 * hp + 1) pv_cmp(vc, jb, s[jb], Y[1], l15, G);
        }
      }
    }
    {
      const float g0 = NGATE[0 * 16 + 4 * g + 2 * hp], g1 = NGATE[0 * 16 + 4 * g + 2 * hp + 1];
#pragma unroll
      for (int dt = 0; dt < 4; ++dt) {
        *(u32x2*)(sYl + ((wave * 2 + 0) * 16 + l15) * 64 + 16 * dt + 4 * G) = (u32x2){pack2(Y[0][dt][0] * g0, Y[0][dt][1] * g0), pack2(Y[0][dt][2] * g0, Y[0][dt][3] * g0)};
        *(u32x2*)(sYl + ((wave * 2 + 1) * 16 + l15) * 64 + 16 * dt + 4 * G) = (u32x2){pack2(Y[1][dt][0] * g1, Y[1][dt][1] * g1), pack2(Y[1][dt][2] * g1, Y[1][dt][3] * g1)};
      }
    }
    __syncthreads();
    unsigned long long* myKey = (unsigned long long*)sImp + wave * 16 * 65;
    unsigned long long vk[4][4];
#pragma unroll
    for (int jb = 0; jb < 4; ++jb)
#pragma unroll
      for (int kt = 0; kt < 4; ++kt) {
        const int s = 16 * jb + 4 * kt + G;
        vk[jb][kt] = ((unsigned long long)__float_as_uint(imp[jb][kt]) << 6) | (unsigned long long)(63 - s);
        myKey[l15 * 65 + s] = vk[jb][kt];
      }
    __syncthreads();
    const int cur = qb;
    uint32_t blo = 0, bhi = 0;
    if (cur + 1 <= 16) {
#pragma unroll
      for (int jb = 0; jb < 4; ++jb)
#pragma unroll
        for (int kt = 0; kt < 4; ++kt) {
          const int s = 16 * jb + 4 * kt + G;
          if (s <= cur) blo |= (1u << s);
        }
    } else {
      int cnt[4][4];
#pragma unroll
      for (int a = 0; a < 4; ++a)
#pragma unroll
        for (int b = 0; b < 4; ++b) cnt[a][b] = 0;
      for (int sp = 1; sp <= cur - 2; ++sp) {
        const unsigned long long xk = myKey[l15 * 65 + sp];
#pragma unroll
        for (int jb = 0; jb < 4; ++jb)
#pragma unroll
          for (int kt = 0; kt < 4; ++kt) cnt[jb][kt] += (xk > vk[jb][kt]) ? 1 : 0;
      }
#pragma unroll
      for (int jb = 0; jb < 4; ++jb)
#pragma unroll
        for (int kt = 0; kt < 4; ++kt) {
          const int s = 16 * jb + 4 * kt + G;
          const bool sel = (s == 0) || (s == cur) || (s == cur - 1) || (s >= 1 && s <= cur - 2 && cnt[jb][kt] < 13);
          if (sel) { if (s < 32) blo |= (1u << s); else bhi |= (1u << (s - 32)); }
        }
    }
    blo |= SHXU(blo, 16); blo |= SHXU(blo, 32);
    bhi |= SHXU(bhi, 16); bhi |= SHXU(bhi, 32);
    mlo = blo; mhi = bhi;
  }
  {
    const int hh = (lane >> 4) & 1, h5 = lane >> 5;
    const int head = 4 * g + 2 * hp + hh;
    bf16x8 qf[4];
    qf[0] = *(const bf16x8*)((const char*)NQR + ((unsigned)rl * 512u + (unsigned)((head * 16 + 8 * h5) * 2)));
#pragma unroll
    for (int ks = 1; ks < 4; ++ks) qf[ks] = *(const bf16x8*)(NQc + (qoff + (unsigned)((head * 64 + 16 * ks + 8 * h5) * 2)));
    const int head0 = 4 * g + 2 * hp;
    const u16* kbs = KV + (long)bl * 4096 * 1024 + 512 + g * 64;
    const u16* vbs = VST + (long)(bl * 4 + g) * 64 * 4096;
    nsa_branch<2>(kbs, vbs, 0, qb, qb, q, mlo, mhi, qf, (const float*)(ws + OFF_NGATE), half * 8192 + bl * 4096 + qb * 64, 16 + head0, sYl, sm);
    const u16* kbw = KV + (long)bl * 4096 * 1024 + 768 + g * 64;
    const u16* vbw = VWT + (long)(bl * 4 + g) * 64 * 4096;
    const int jw0 = (qb >= 8) ? qb - 8 : 0;
    nsa_branch<3>(kbw, vbw, jw0, qb, qb, q, mlo, mhi, qf, (const float*)(ws + OFF_NGATE), half * 8192 + bl * 4096 + qb * 64, 32 + head0, sYl, sm);
    const int tid2 = tid_();
    const int l2 = tid2 & 63, hh2 = (l2 >> 4) & 1, hg2 = l2 >> 5;
    const unsigned yoff = (unsigned)(bl * 4096 + qb * 64 + 16 * (tid2 >> 6) + (tid2 & 15)) * 2048u;
    const u16* yrow = sYl + (((tid2 >> 6) * 2 + hh2) * 16 + (tid2 & 15)) * 64;
#pragma unroll
    for (int dt2 = 0; dt2 < 2; ++dt2)
#pragma unroll
      for (int m4 = 0; m4 < 4; ++m4) {
        const int d0 = 32 * dt2 + 8 * m4 + 4 * hg2;
        *(u32x2*)((char*)YB + (yoff + (unsigned)(((head0 + hh2) * 64 + d0) * 2))) = *(const u32x2*)(yrow + d0);
      }
  }
}

__device__ __forceinline__ void gemm_tile_wide(const u16* __restrict__ A, long lda, int m0, const u16* __restrict__ Bt, long ldb, int n0, int K,
                                               f32x4 (&acc)[4][8], u16* sA) {
  const int tid = tid_(), lane = tid & 63, wave = tid >> 6;
  const int l15 = lane & 15, G = lane >> 4;
  const int wm = wave >> 1, wn = wave & 1;
  const int lr = tid >> 3, ch = tid & 7;
  u16* sB = sA + 128 * 80;
  const char* Ab = (const char*)A;
  const char* Bb = (const char*)Bt;
  unsigned oa[4], ob[8];
#pragma unroll
  for (int i = 0; i < 4; ++i) oa[i] = (unsigned)(((long)(m0 + lr + 32 * i) * lda + ch * 8) * 2);
#pragma unroll
  for (int i = 0; i < 8; ++i) ob[i] = (unsigned)(((long)(n0 + lr + 32 * i) * ldb + ch * 8) * 2);
  u32x4 ra[4], rb[8];
#pragma unroll
  for (int i = 0; i < 4; ++i) ra[i] = *(const u32x4*)(Ab + oa[i]);
#pragma unroll
  for (int i = 0; i < 8; ++i) rb[i] = *(const u32x4*)(Bb + ob[i]);
  const int nk = K >> 6;
  for (int kt = 0; kt < nk; ++kt) {
#pragma unroll
    for (int i = 0; i < 4; ++i) *(u32x4*)&sA[(lr + 32 * i) * 80 + ch * 8] = ra[i];
#pragma unroll
    for (int i = 0; i < 8; ++i) *(u32x4*)&sB[(lr + 32 * i) * 80 + ch * 8] = rb[i];
    __syncthreads();
    {
      const int kn = (kt + 1 < nk) ? kt + 1 : kt;
      const char* Ak = Ab + (size_t)kn * 128;
      const char* Bk = Bb + (size_t)kn * 128;
#pragma unroll
      for (int i = 0; i < 4; ++i) ra[i] = *(const u32x4*)(Ak + oa[i]);
#pragma unroll
      for (int i = 0; i < 8; ++i) rb[i] = *(const u32x4*)(Bk + ob[i]);
    }
#pragma unroll
    for (int ks = 0; ks < 2; ++ks) {
      bf16x8 af[4];
#pragma unroll
      for (int i = 0; i < 4; ++i) af[i] = ld8(&sA[(wm * 64 + 16 * i + l15) * 80 + ks * 32 + G * 8]);
#pragma unroll
      for (int jh = 0; jh < 2; ++jh) {
        bf16x8 bfr[4];
#pragma unroll
        for (int j = 0; j < 4; ++j) bfr[j] = ld8(&sB[(wn * 128 + 64 * jh + 16 * j + l15) * 80 + ks * 32 + G * 8]);
#pragma unroll
        for (int i = 0; i < 4; ++i)
#pragma unroll
          for (int j = 0; j < 4; ++j) acc[i][4 * jh + j] = MFMA(af[i], bfr[j], acc[i][4 * jh + j]);
      }
    }
    __syncthreads();
  }
}


__device__ __forceinline__ void phase_branch_merge(const Params& P, char* smem) {
  char* ws = P.ws;
  u16* sA = (u16*)smem;
  const u16* YA = (const u16*)(ws + OFF_SG);
  const u16* GATES = (const u16*)P.out;
  u16* MERGED = (u16*)(ws + OFF_MERGED);
  for (int t = bid_(); t < 512; t += gridDim.x) {
    const int nt = t >> 7, mt = t & 127;
    const int m0 = mt * 128, n0 = nt * 256;
    const u16* YBp = (m0 < 8192) ? (const u16*)(ws + OFF_YB0) : ((const u16*)(ws + OFF_YB1) - (long)8192 * 1024);
    f32x4 acc[4][8];
#pragma unroll
    for (int i = 0; i < 4; ++i)
#pragma unroll
      for (int j = 0; j < 8; ++j) acc[i][j] = (f32x4){0.f, 0.f, 0.f, 0.f};
    gemm_tile_wide(YA, 1024, m0, (const u16*)(ws + OFF_WA_T), 1024, n0, 1024, acc, sA);
    {
      const int tc = tid_();
#pragma unroll 4
      for (int k16 = 0; k16 < 16; ++k16) {
        const int id = tc + 256 * k16;
        const int row = id >> 5, cch = (id & 31) * 8;
        *(u32x4*)&sA[row * 264 + cch] = *(const u32x4*)(GATES + (long)(m0 + row) * 2048 + n0 + cch);
      }
    }
    __syncthreads();
    {
      EPI_VARS
#pragma unroll
      for (int i = 0; i < 4; ++i)
#pragma unroll
        for (int j = 0; j < 8; ++j)
#pragma unroll
          for (int e = 0; e < 4; ++e) {
            u16* sp = &sA[(wm * 64 + 16 * i + G * 4 + e) * 264 + wn * 128 + 16 * j + l15];
            *sp = f2bf(bf2f(*sp) * acc[i][j][e]);
            acc[i][j][e] = 0.f;
          }
    }
    __syncthreads();
    {
      const int tc = tid_();
#pragma unroll 4
      for (int k16 = 0; k16 < 16; ++k16) {
        const int id = tc + 256 * k16;
        const int row = id >> 5, cch = (id & 31) * 8;
        *(u32x4*)(MERGED + (long)(m0 + row) * 1024 + n0 + cch) = *(const u32x4*)&sA[row * 264 + cch];
      }
    }
    asm volatile("s_waitcnt vmcnt(0)" ::: "memory");
    __syncthreads();
    gemm_tile_wide(YBp, 1024, m0, (const u16*)(ws + OFF_WB_T), 1024, n0, 1024, acc, sA);
    {
      const int tc = tid_();
#pragma unroll 4
      for (int k16 = 0; k16 < 16; ++k16) {
        const int id = tc + 256 * k16;
        const int row = id >> 5, cch = (id & 31) * 8;
        *(u32x4*)&sA[row * 264 + cch] = *(const u32x4*)(GATES + (long)(m0 + row) * 2048 + 1024 + n0 + cch);
      }
    }
    __syncthreads();
    {
      EPI_VARS
#pragma unroll
      for (int i = 0; i < 4; ++i)
#pragma unroll
        for (int j = 0; j < 8; ++j)
#pragma unroll
          for (int e = 0; e < 4; ++e) {
            u16* sp = &sA[(wm * 64 + 16 * i + G * 4 + e) * 264 + wn * 128 + 16 * j + l15];
            *sp = f2bf(bf2f(*sp) * acc[i][j][e]);
          }
    }
    __syncthreads();
    {
      const int tc = tid_();
#pragma unroll 2
      for (int k16 = 0; k16 < 16; ++k16) {
        const int id = tc + 256 * k16;
        const int row = id >> 5, cch = (id & 31) * 8;
        u16* gp = MERGED + (long)(m0 + row) * 1024 + n0 + cch;
        const u32x4 t1 = *(const u32x4*)gp;
        const u32x4 pb = *(const u32x4*)&sA[row * 264 + cch];
        u32x4 o;
#pragma unroll
        for (int q = 0; q < 4; ++q) {
          const float lo = __uint_as_float(t1[q] << 16) + __uint_as_float(pb[q] << 16);
          const float hi = __uint_as_float(t1[q] & 0xffff0000u) + __uint_as_float(pb[q] & 0xffff0000u);
          o[q] = pack2(lo, hi);
        }
        *(u32x4*)gp = o;
      }
    }
    __syncthreads();
  }
}

template <int EPI>
__device__ __forceinline__ void phase_gemm(const u16* A, int K, const u16* Wt, int N, void* outp, char* smem) {
  u16* sA = (u16*)smem;
  u16* sB = sA + 128 * 80;
  EPI_VARS
  const int ntn = N >> 7;
  for (int t = bid_(); t < 128 * ntn; t += gridDim.x) {
    const int nt = t >> 7, mt = t & 127;
    const int m0 = mt * 128, n0 = nt * 128;
    f32x4 acc[4][4];
    zero_acc(acc);
    gemm_tile<0, 2>(A, K, m0, 16384, Wt, K, n0, N, K, 0, acc, sA, sB);
#pragma unroll
    for (int i = 0; i < 4; ++i)
#pragma unroll
      for (int j = 0; j < 4; ++j) {
        const int col = n0 + wn * 64 + 16 * j + l15;
#pragma unroll
        for (int e = 0; e < 4; ++e) {
          const long row = m0 + wm * 64 + 16 * i + G * 4 + e;
          const float v = acc[i][j][e];
          if (EPI == 0) ((float*)outp)[row * N + col] = v;
          else if (EPI == 2) ((u16*)outp)[row * N + col] = f2bf(v);
          else { const float rl = fmaxf(v, 0.f); ((u16*)outp)[row * N + col] = f2bf(rl * rl); }
        }
      }
  }
}


template <int EPI>
__device__ __forceinline__ void phase_gemm_wide(const u16* A, int K, const u16* Wt, int N, u16* outp, char* smem) {
  u16* sA = (u16*)smem;
  EPI_VARS
  const int ntn = N >> 8;
  for (int t = bid_(); t < 128 * ntn; t += gridDim.x) {
    const int nt = t >> 7, mt = t & 127;
    const int m0 = mt * 128, n0 = nt * 256;
    f32x4 acc[4][8];
#pragma unroll
    for (int i = 0; i < 4; ++i)
#pragma unroll
      for (int j = 0; j < 8; ++j) acc[i][j] = (f32x4){0.f, 0.f, 0.f, 0.f};
    gemm_tile_wide(A, K, m0, Wt, K, n0, K, acc, sA);
#pragma unroll
    for (int i = 0; i < 4; ++i)
#pragma unroll
      for (int j = 0; j < 8; ++j) {
        const int col = n0 + wn * 128 + 16 * j + l15;
#pragma unroll
        for (int e = 0; e < 4; ++e) {
          float v = acc[i][j][e];
          if (EPI == 1) { v = fmaxf(v, 0.f); v = v * v; }
          sA[(wm * 64 + 16 * i + G * 4 + e) * 264 + (col - n0)] = f2bf(v);
        }
      }
    __syncthreads();
    {
      const int tc = tid_();
#pragma unroll 4
      for (int k16 = 0; k16 < 16; ++k16) {
        const int id = tc + 256 * k16;
        const int row = id >> 5, cch = (id & 31) * 8;
        *(u32x4*)(outp + (long)(m0 + row) * N + n0 + cch) = *(const u32x4*)&sA[row * 264 + cch];
      }
    }
    __syncthreads();
  }
}

__device__ __forceinline__ void phase_ple(const Params& P, char* smem) {
  char* ws = P.ws;
  u16* sA = (u16*)smem;
  u16* Z3b = (u16*)(ws + OFF_Z3);
  for (int t = bid_(); t < 512; t += gridDim.x) {
    const int nt = t >> 7, mt = t & 127;
    const int m0 = mt * 128, n0 = nt * 256;
    f32x4 acc[4][8];
#pragma unroll
    for (int i = 0; i < 4; ++i)
#pragma unroll
      for (int j = 0; j < 8; ++j) acc[i][j] = (f32x4){0.f, 0.f, 0.f, 0.f};
    gemm_tile_wide((const u16*)(ws + OFF_PB), 256, m0, (const u16*)(ws + OFF_WPLE_T), 256, n0, 256, acc, sA);
    {
      EPI_VARS
#pragma unroll
      for (int i = 0; i < 4; ++i)
#pragma unroll
        for (int j = 0; j < 8; ++j)
#pragma unroll
          for (int e = 0; e < 4; ++e) {
            sA[(wm * 64 + 16 * i + G * 4 + e) * 264 + wn * 128 + 16 * j + l15] = f2bf(acc[i][j][e]);
            acc[i][j][e] = 0.f;
          }
    }
    __syncthreads();
    {
      const int tc = tid_();
#pragma unroll 4
      for (int k16 = 0; k16 < 16; ++k16) {
        const int id = tc + 256 * k16;
        const int row = id >> 5, cch = (id & 31) * 8;
        *(u32x4*)(Z3b + (long)(m0 + row) * 1024 + n0 + cch) = *(const u32x4*)&sA[row * 264 + cch];
      }
    }
    asm volatile("s_waitcnt vmcnt(0)" ::: "memory");
    __syncthreads();
    gemm_tile_wide((const u16*)(ws + OFF_H2B), 1024, m0, (const u16*)(ws + OFF_WPG_T), 1024, n0, 1024, acc, sA);
    {
      const int tc = tid_();
#pragma unroll 4
      for (int k16 = 0; k16 < 16; ++k16) {
        const int id = tc + 256 * k16;
        const int row = id >> 5, cch = (id & 31) * 8;
        *(u32x4*)&sA[row * 264 + cch] = *(const u32x4*)(Z3b + (long)(m0 + row) * 1024 + n0 + cch);
      }
    }
    __syncthreads();
    {
      EPI_VARS
#pragma unroll
      for (int i = 0; i < 4; ++i)
#pragma unroll
        for (int j = 0; j < 8; ++j)
#pragma unroll
          for (int e = 0; e < 4; ++e) {
            u16* sp = &sA[(wm * 64 + 16 * i + G * 4 + e) * 264 + wn * 128 + 16 * j + l15];
            *sp = f2bf(bf2f(*sp) * sigm(acc[i][j][e]));
          }
    }
    __syncthreads();
    {
      const int tc = tid_();
#pragma unroll 4
      for (int k16 = 0; k16 < 16; ++k16) {
        const int id = tc + 256 * k16;
        const int row = id >> 5, cch = (id & 31) * 8;
        *(u32x4*)(Z3b + (long)(m0 + row) * 1024 + n0 + cch) = *(const u32x4*)&sA[row * 264 + cch];
      }
    }
    __syncthreads();
  }
}

template <int MODE, int ZB>
__device__ __forceinline__ void phase_rownorm(const Params& P, const void* Zv, const float* w, const float* w2, u16* nxt) {
  const int tid = tid_(), lane = tid & 63, wave = tid >> 6;
  float* H = P.out;
  for (int un = bid_(); un < 4096; un += gridDim.x) {
    const long row = (long)un * 4 + wave;
    const float* zr = (const float*)Zv + row * 1024;
    const u16* zh = (const u16*)Zv + row * 1024;
    (void)zr; (void)zh;
    const float* hin = (MODE == 0) ? (P.x + row * 1024) : (H + row * 1024);
    float4 z[4], hv[4];
    float ss = 0.f;
#pragma unroll
    for (int j = 0; j < 4; ++j) {
      if (ZB) {
        const u32x2 zz = *(const u32x2*)(zh + j * 256 + lane * 4);
        z[j] = make_float4(__uint_as_float(zz[0] << 16), __uint_as_float(zz[0] & 0xffff0000u), __uint_as_float(zz[1] << 16), __uint_as_float(zz[1] & 0xffff0000u));
      } else z[j] = *(const float4*)(zr + j * 256 + lane * 4);
      hv[j] = *(const float4*)(hin + j * 256 + lane * 4);
      ss += z[j].x * z[j].x + z[j].y * z[j].y + z[j].z * z[j].z + z[j].w * z[j].w;
    }
#pragma unroll
    for (int o = 32; o >= 1; o >>= 1) ss += SHX(ss, o);
    const float r = rsqrtf(ss * (1.f / 1024.f) + 1e-6f);
    float s2 = 0.f;
#pragma unroll
    for (int j = 0; j < 4; ++j) {
      const float4 wv = *(const float4*)(w + j * 256 + lane * 4);
      hv[j].x += z[j].x * r * wv.x; hv[j].y += z[j].y * r * wv.y;
      hv[j].z += z[j].z * r * wv.z; hv[j].w += z[j].w * r * wv.w;
      s2 += hv[j].x * hv[j].x + hv[j].y * hv[j].y + hv[j].z * hv[j].z + hv[j].w * hv[j].w;
      *(float4*)(H + row * 1024 + j * 256 + lane * 4) = hv[j];
    }
    if (MODE == 0) {
#pragma unroll
      for (int o = 32; o >= 1; o >>= 1) s2 += SHX(s2, o);
      const float r2 = rsqrtf(s2 * (1.f / 1024.f) + 1e-6f);
#pragma unroll
      for (int j = 0; j < 4; ++j) {
        const float4 wv = *(const float4*)(w2 + j * 256 + lane * 4);
        u32x2 o2 = {pack2(hv[j].x * r2 * wv.x, hv[j].y * r2 * wv.y), pack2(hv[j].z * r2 * wv.z, hv[j].w * r2 * wv.w)};
        *(u32x2*)(nxt + row * 1024 + j * 256 + lane * 4) = o2;
      }
    } else if (MODE == 1) {
#pragma unroll
      for (int j = 0; j < 4; ++j) {
        u32x2 o2 = {pack2(hv[j].x, hv[j].y), pack2(hv[j].z, hv[j].w)};
        *(u32x2*)(nxt + row * 1024 + j * 256 + lane * 4) = o2;
      }
      const float4 pv = *(const float4*)(P.p + row * 256 + lane * 4);
      u32x2 o2 = {pack2(pv.x, pv.y), pack2(pv.z, pv.w)};
      *(u32x2*)((u16*)(P.ws + OFF_PB) + row * 256 + lane * 4) = o2;
    }
  }
}

#define XB_TMO      128
#define XB_XCNT(j)  (256  + 64 * (j))
#define XB_XSUB(j)  (1280 + 64 * (j))
#define XB_XGEN(j)  (2304 + 64 * (j))
#define XB_TOP      3328
#define XB_TOPGEN   3392
#define XCD_BAR_WORDS 3456
#define XB_SPIN_CAP (1u << 18)
#define LAS __attribute__((address_space(3)))

__device__ __forceinline__ unsigned xb_ld(unsigned* p)              { return __hip_atomic_load(p, __ATOMIC_RELAXED, __HIP_MEMORY_SCOPE_AGENT); }
__device__ __forceinline__ unsigned xb_add(unsigned* p, unsigned v) { return __hip_atomic_fetch_add(p, v, __ATOMIC_RELAXED, __HIP_MEMORY_SCOPE_AGENT); }
__device__ __forceinline__ unsigned xb_xcc_id() { return (unsigned)__builtin_amdgcn_s_getreg((3 << 11) | 20) & 0xFu; }
#define XB_SPIN(cond, bar) do { unsigned _sp = 0; while (cond) { __builtin_amdgcn_s_sleep(1); \
    if ((++_sp & 255u) == 0u) { if (xb_ld(&(bar)[XB_TMO])) break; if (_sp > XB_SPIN_CAP) { atomicAdd(&(bar)[XB_TMO], 1u); break; } } } } while (0)

struct XcdBarrier {
    unsigned* bar; unsigned x;
    volatile LAS unsigned* st;
};

__device__ __forceinline__ XcdBarrier xcd_barrier_post(unsigned* bar, volatile LAS unsigned* st) {
    XcdBarrier b; b.bar = bar; b.x = xb_xcc_id(); b.st = st;
    if (tid_() == 0) (void)xb_add(&bar[XB_XCNT(b.x)], 1u);
    return b;
}
__device__ __forceinline__ void xcd_barrier_complete(unsigned* bar, unsigned x, unsigned& nloc, unsigned& nx) {
    const unsigned G = gridDim.x * gridDim.y * gridDim.z;
    unsigned sum, cnt, mine, sp = 0u;
    for (;;) {
        sum = 0u; cnt = 0u; mine = 0u;
#pragma unroll
        for (unsigned j = 0; j < 16; ++j) { const unsigned c = xb_ld(&bar[XB_XCNT(j)]); sum += c; cnt += (c > 0u) ? 1u : 0u; mine = (j == x) ? c : mine; }
        if (sum == G) break;
        __builtin_amdgcn_s_sleep(1);
        if ((++sp & 255u) == 0u) { if (xb_ld(&bar[XB_TMO])) break; if (sp > XB_SPIN_CAP) { atomicAdd(&bar[XB_TMO], 1u); break; } }
    }
    nloc = mine > 0u ? mine : 1u; nx = cnt > 0u ? cnt : 1u;
}

__device__ __forceinline__ void xcd_barrier(const XcdBarrier& b) {
    asm volatile("s_waitcnt vmcnt(0)" ::: "memory");
    __syncthreads();
    if (tid_() == 0) {
        unsigned* bar = b.bar;
        __builtin_amdgcn_s_waitcnt(0);
        unsigned nloc = b.st[0], nx = b.st[1];
        if (nloc == 0u) { xcd_barrier_complete(bar, b.x, nloc, nx); b.st[0] = nloc; b.st[1] = nx; }
        const unsigned old = xb_add(&bar[XB_XSUB(b.x)], 1u);
        const unsigned gen = old / nloc;
        if (old + 1u == (gen + 1u) * nloc) {
            __builtin_amdgcn_fence(__ATOMIC_RELEASE, "agent");
            asm volatile("s_waitcnt vmcnt(0)" ::: "memory");
            const unsigned og = xb_add(&bar[XB_TOP], 1u);
            const unsigned tg = og / nx;
            if (og + 1u == (tg + 1u) * nx) xb_add(&bar[XB_TOPGEN], 1u);
            else XB_SPIN(xb_ld(&bar[XB_TOPGEN]) == tg, bar);
            __builtin_amdgcn_fence(__ATOMIC_ACQUIRE, "agent");
            xb_add(&bar[XB_XGEN(b.x)], 1u);
            asm volatile("s_waitcnt vmcnt(0)" ::: "memory");
        } else {
            XB_SPIN(xb_ld(&bar[XB_XGEN(b.x)]) == gen, bar);
            __builtin_amdgcn_fence(__ATOMIC_ACQUIRE, "agent");
            asm volatile("s_waitcnt vmcnt(0)" ::: "memory");
        }
    }
    __syncthreads();
}

#define OFF_BAR (252 * MIB)
#define GSYNC() do { XcdBarrier xb_; xb_.bar = (unsigned*)(P.ws + OFF_BAR); xb_.x = xb_xcc_id(); xb_.st = (volatile LAS unsigned*)&xb_words; xcd_barrier(xb_); } while (0)
__global__ void __launch_bounds__(256, 2) k_mega(Params P) {
  __shared__ __attribute__((aligned(16))) char smem[67584];
  char* ws = P.ws;
  __shared__ uint4 xb_words;
  if (tid_() == 0) xb_words = make_uint4(0u, 0u, 0u, 0u);
  __syncthreads();
  (void)xcd_barrier_post((unsigned*)(ws + OFF_BAR), (volatile LAS unsigned*)&xb_words);
  phase_prep(P, smem);
  GSYNC();
#pragma unroll 1
  for (int half = 0; half < 2; ++half) {
    phase_inproj(P, half, smem);
    GSYNC();
#if PROBE_DUP == 1
    phase_inproj(P, half, smem);
    GSYNC();
#endif
    if ((int)gridDim.x > 128) {
      const int b2 = bid_();
      if (b2 < 64) cmp_gemm1_tile(P, b2, smem);
      else for (int u = b2 - 64; u < 1024; u += (int)gridDim.x - 64) hgrn_intra_unit(P, u, smem);
    } else {
      for (int t = bid_(); t < 64; t += gridDim.x) cmp_gemm1_tile(P, t, smem);
      for (int u = bid_(); u < 1024; u += gridDim.x) hgrn_intra_unit(P, u, smem);
    }
    GSYNC();
    for (int t = bid_(); t < 32; t += gridDim.x) cmp_gemm2_tile(P, t, smem);
    hgrn_scan(P);
    if (half == 1) phase_late_weights(P, smem);
    GSYNC();
#if PROBE_DUP == 2
    for (int u = bid_(); u < 1024; u += gridDim.x) nsa_unit(P, half, u, smem);
    GSYNC();
#endif
    for (int u = bid_(); u < 1024; u += gridDim.x) nsa_unit(P, half, u, smem);
    for (int u = bid_(); u < 1024; u += gridDim.x) hgrn_out_unit(P, half, u, smem);
    GSYNC();
  }
  phase_branch_merge(P, smem);
  GSYNC();
#if PROBE_DUP == 3
  phase_branch_merge(P, smem);
  GSYNC();
  phase_gemm<2>((const u16*)(ws + OFF_MERGED), 1024, (const u16*)(ws + OFF_WOUT_T), 1024, ws + OFF_Z1, smem);
  GSYNC();
#endif
  phase_gemm_wide<2>((const u16*)(ws + OFF_MERGED), 1024, (const u16*)(ws + OFF_WOUT_T), 1024, (u16*)(ws + OFF_Z1), smem);
  GSYNC();
  phase_rownorm<0, 1>(P, (const void*)(ws + OFF_Z1), P.n_post_mix, P.n_pre_mlp, (u16*)(ws + OFF_V));
  GSYNC();
#if PROBE_DUP == 4
  phase_gemm<1>((const u16*)(ws + OFF_V), 1024, (const u16*)(ws + OFF_WUP_T), 4096, ws + OFF_FFH, smem);
  GSYNC();
#endif
  phase_gemm_wide<1>((const u16*)(ws + OFF_V), 1024, (const u16*)(ws + OFF_WUP_T), 4096, (u16*)(ws + OFF_FFH), smem);
  GSYNC();
#if PROBE_DUP == 4
  phase_gemm<2>((const u16*)(ws + OFF_FFH), 4096, (const u16*)(ws + OFF_WDOWN_T), 1024, ws + OFF_Z2, smem);
  GSYNC();
#endif
  phase_gemm_wide<2>((const u16*)(ws + OFF_FFH), 4096, (const u16*)(ws + OFF_WDOWN_T), 1024, (u16*)(ws + OFF_Z2), smem);
  GSYNC();
  phase_rownorm<1, 1>(P, (const void*)(ws + OFF_Z2), P.n_post_mlp, nullptr, (u16*)(ws + OFF_H2B));
  GSYNC();
  phase_ple(P, smem);
  GSYNC();
#if PROBE_DUP == 5
  for (int i = 0; i < 10; ++i) GSYNC();
#endif
#if PROBE_DUP == 6
  phase_prep(P, smem);
  GSYNC();
#endif
  phase_rownorm<2, 1>(P, (const void*)(P.ws + OFF_Z3), P.n_ple, nullptr, nullptr);
}

extern "C" void kernel_launch(void* const* d_in, const int* in_sizes, int n_in, void* d_out, int out_size, void* d_ws,
                              size_t ws_size, hipStream_t stream) {
  Params P{};
  P.x = (const float*)d_in[0];
  P.p = (const float*)d_in[1];
  P.w_in = (const float*)d_in[2];
  P.w_a = (const float*)d_in[3];
  P.w_b = (const float*)d_in[4];
  P.w_out = (const float*)d_in[5];
  P.n_pre_mix = (const float*)d_in[6];
  P.n_post_mix = (const float*)d_in[7];
  P.n_pre_mlp = (const float*)d_in[8];
  P.n_post_mlp = (const float*)d_in[9];
  P.lb_logits = (const float*)d_in[10];
  P.gnorm = (const float*)d_in[11];
  P.pe_k = (const float*)d_in[12];
  P.pe_v = (const float*)d_in[13];
  P.wk1 = (const float*)d_in[14];
  P.wk2 = (const float*)d_in[15];
  P.wv1 = (const float*)d_in[16];
  P.wv2 = (const float*)d_in[17];
  P.w_up = (const float*)d_in[18];
  P.w_down = (const float*)d_in[19];
  P.w_ple = (const float*)d_in[20];
  P.w_pg = (const float*)d_in[21];
  P.n_ple = (const float*)d_in[22];
  P.out = (float*)d_out;
  P.ws = (char*)d_ws;
#if MEGA
  static int grid_blocks = 0;
  if (!grid_blocks) {
    int dev = 0, cus = 0, per_cu = 0;
    hipGetDevice(&dev);
    hipDeviceGetAttribute(&cus, hipDeviceAttributeMultiprocessorCount, dev);
    hipOccupancyMaxActiveBlocksPerMultiprocessor(&per_cu, k_mega, 256, 0);
    if (per_cu > 2) per_cu = 2;
    if (per_cu < 1) per_cu = 1;
    grid_blocks = cus * per_cu;
  }
  hipMemsetAsync((char*)d_ws + OFF_BAR, 0, XCD_BAR_WORDS * sizeof(unsigned), stream);
  void* args[] = {&P};
  hipError_t e = hipLaunchCooperativeKernel((void*)k_mega, dim3(grid_blocks), dim3(256), args, 0, stream);
  if (e != hipSuccess) fprintf(stderr, "cooperative launch failed: %s (grid %d)\n", hipGetErrorString(e), grid_blocks);
#endif
}
```
